# Optimizing an MI355X kernel written in HIP

```python
import math
import jax, jax.numpy as jnp
from jax import lax
import numpy as np

D_MODEL = 1024
BATCH = 4
SEQ = 4096
DEPTH = 4

GRID_W = 64
CTX_LEN = 256

D_HYENA = 256
HYENA_ORDER = 2
HYENA_EMB = 33
HYENA_FILTER_WIDTH = 64
HYENA_TARGET = 1e-2
HYENA_MIN_DECAY = math.log(HYENA_TARGET) / 1.5
HYENA_MAX_DECAY = math.log(HYENA_TARGET) / 0.3
SHORT_CONV = 3
N_DIFF_HEADS = 8
DIFF_QK = 32
DIFF_V = 64
D_DIFF = N_DIFF_HEADS * DIFF_V
D_FNET = 256
FNET_GROUPS = 4
FNET_GROUP_W = D_FNET // FNET_GROUPS
D_MIX = D_HYENA + D_DIFF + D_FNET
ROPE_BASE = 10000.0
ATTN_BLOCK = 128

HY_W = 3 * D_HYENA
QK_W = N_DIFF_HEADS * 2 * DIFF_QK
Q_OFF = HY_W
K_OFF = Q_OFF + QK_W
V_OFF = K_OFF + QK_W
F_OFF = V_OFF + D_DIFF
D_IN = F_OFF + D_FNET

N_EXPERTS = 64
TOP_K = 8
N_GROUPS = 8
TOPK_GROUPS = 4
D_EXPERT = 256
D_SHARED = 256
ROUTED_SCALE = 2.5
MOE_BLOCK = 128

ALPHA = (2 * DEPTH) ** 0.25
BETA = (8 * DEPTH) ** -0.25
LN_EPS = 1e-5

kernel_name = "hybrid_hyena_diffattn_fnet_moe_dit"


def layer_norm(x, g=None, b=None):
    xf = x.astype(jnp.float32)
    mu = jnp.mean(xf, -1, keepdims=True)
    var = jnp.mean(jnp.square(xf - mu), -1, keepdims=True)
    y = (xf - mu) * lax.rsqrt(var + LN_EPS)
    if g is not None:
        y = y * g.astype(jnp.float32) + b.astype(jnp.float32)
    return y.astype(x.dtype)


def rms_norm(x, g):
    xf = x.astype(jnp.float32)
    y = xf * lax.rsqrt(jnp.mean(jnp.square(xf), -1, keepdims=True) + LN_EPS)
    return (y * g.astype(jnp.float32)).astype(x.dtype)


def short_conv(u, w):
    pad = SHORT_CONV // 2
    L = u.shape[1]
    up = jnp.pad(u, ((0, 0), (pad, pad), (0, 0)))
    out = up[:, 0:L] * w[0]
    for j in range(1, SHORT_CONV):
        out = out + up[:, j:j + L] * w[j]
    return out


def hyena_filters(L, w1, b1, w2, b2, w3, freq):
    f32 = jnp.float32
    w1, b1, w2, b2, w3, freq = (a.astype(f32) for a in (w1, b1, w2, b2, w3, freq))
    t = jnp.linspace(0.0, 1.0, L, dtype=f32)[:, None]
    bands = (HYENA_EMB - 1) // 2
    omega = (2.0 * math.pi / L) * jnp.arange(L, dtype=f32)[:, None]
    fb = jnp.linspace(1e-4, bands - 1, bands, dtype=f32)[None, :]
    z = jnp.concatenate([t, jnp.cos(fb * omega), -jnp.sin(fb * omega)], -1)
    a = jnp.sin(freq * (z @ w1 + b1))
    a = jnp.sin(freq * (a @ w2 + b2))
    hc = (a @ w3).reshape(L, HYENA_ORDER, 2, D_HYENA)
    deltas = jnp.abs(jnp.linspace(HYENA_MIN_DECAY, HYENA_MAX_DECAY, D_HYENA, dtype=f32))
    hc = hc * jnp.exp(-t * deltas)[:, None, None, :]
    l1 = jnp.abs(hc[:, :, 0]).sum(0) + jnp.abs(hc[1:, :, 1]).sum(0)
    return hc / l1[None, :, None, :]


def bidir_long_conv(u, h_fwd, h_bwd, bias):
    L = u.shape[1]
    k = jnp.concatenate([h_fwd, jnp.zeros_like(h_fwd[:1]), h_bwd[:0:-1]], 0)
    uf = u.astype(jnp.float32)
    y = jnp.fft.irfft(jnp.fft.rfft(uf, n=2 * L, axis=1) * jnp.fft.rfft(k, axis=0)[None],
                      n=2 * L, axis=1)[:, :L]
    return (y + uf * bias.astype(jnp.float32)).astype(u.dtype)


def hyena_mixer(u, p):
    L = u.shape[1]
    u = short_conv(u, p['short_conv_w'])
    x1, x2, v = jnp.split(u, 3, axis=-1)
    h = hyena_filters(L, p['filt_w1'], p['filt_b1'], p['filt_w2'], p['filt_b2'],
                      p['filt_w3'], p['filt_freq'])
    z = v
    for n, gate in enumerate((x1, x2)):
        z = gate * bidir_long_conv(z, h[:, n, 0], h[:, n, 1], p['hyena_bias'][n])
    return z


def axial_rope_angles(L):
    n = DIFF_QK // 4
    inv = 1.0 / (ROPE_BASE ** (jnp.arange(n, dtype=jnp.float32) / n))
    t = jnp.arange(L)
    row = (t // GRID_W).astype(jnp.float32)
    col = (t % GRID_W).astype(jnp.float32)
    ang = jnp.stack([row[:, None] * inv, col[:, None] * inv], axis=1)
    return jnp.cos(ang), jnp.sin(ang)


def apply_rope(t, cos, sin):
    shp = t.shape
    tr = t.reshape(*shp[:-1], 2, DIFF_QK // 4, 2).astype(jnp.float32)
    a, b = tr[..., 0], tr[..., 1]
    cs, sn = cos[:, None, None], sin[:, None, None]
    out = jnp.stack([a * cs - b * sn, a * sn + b * cs], -1)
    return out.reshape(shp).astype(t.dtype)


def qk_heads(t):
    B, L, _ = t.shape
    return t.reshape(B, L, N_DIFF_HEADS, 2, DIFF_QK)


def to_attn(t):
    return t.transpose(3, 0, 2, 1, 4)


def v_heads(t):
    B, L, _ = t.shape
    return t.reshape(B, L, N_DIFF_HEADS, DIFF_V).transpose(0, 2, 1, 3)


def diff_attn_core(q, k, v, lam):
    s = jnp.einsum('cbhqd,cbhkd->cbhqk', q, k).astype(jnp.float32) * (DIFF_QK ** -0.5)
    a = jax.nn.softmax(s, axis=-1)
    w = a[0] - lam * a[1]
    return jnp.einsum('bhqk,bhkd->bhqd', w.astype(v.dtype), v)


def blocked_diff_attention(q, k, v, lam):
    _, B, H, Lq, DQ = q.shape
    nb = Lq // ATTN_BLOCK
    qb = q.reshape(2, B, H, nb, ATTN_BLOCK, DQ).transpose(3, 0, 1, 2, 4, 5)
    out = lax.map(lambda qq: diff_attn_core(qq, k, v, lam), qb)
    return out.transpose(1, 2, 0, 3, 4).reshape(B, H, Lq, DIFF_V)


def diff_out(o, subln_w, lam_init):
    B, H, L, DV = o.shape
    o = rms_norm(o, subln_w) * (1.0 - lam_init)
    return o.transpose(0, 2, 1, 3).reshape(B, L, H * DV)


def fourier_mixer(u, w_lin):
    B, L, _ = u.shape
    ug = u.astype(jnp.float32).reshape(B, L, FNET_GROUPS, FNET_GROUP_W)
    f = jnp.fft.fftn(ug, axes=(1, 3), norm='ortho').real.astype(u.dtype)
    return jnp.einsum('blgc,gcd->blgd', f, w_lin).reshape(B, L, D_FNET)


def split_proj(z):
    return (z[..., :Q_OFF], z[..., Q_OFF:K_OFF], z[..., K_OFF:V_OFF],
            z[..., V_OFF:F_OFF], z[..., F_OFF:])


def token_mixer(h, hc, p, layer_idx, last):
    L = h.shape[1]
    lam_init = 0.8 - 0.6 * math.exp(-0.3 * layer_idx)
    f32 = jnp.float32
    lam = (jnp.exp(jnp.sum(p['lam_q1'].astype(f32) * p['lam_k1'].astype(f32)))
           - jnp.exp(jnp.sum(p['lam_q2'].astype(f32) * p['lam_k2'].astype(f32))) + lam_init)
    hy, q, k, v, fr = split_proj(h @ p['w_in'])
    cos, sin = axial_rope_angles(L)
    q = to_attn(apply_rope(qk_heads(q), cos, sin))
    k = to_attn(apply_rope(qk_heads(k), cos, sin))
    v = v_heads(v)
    if last:
        kvc = hc @ p['w_in'][:, K_OFF:F_OFF]
        kc, vc = kvc[..., :QK_W], kvc[..., QK_W:]
    else:
        hyc, qc, kc, vc, frc = split_proj(hc @ p['w_in'])
    kc = to_attn(qk_heads(kc))
    vc = v_heads(vc)
    att = blocked_diff_attention(q, jnp.concatenate([k, kc], axis=3),
                                 jnp.concatenate([v, vc], axis=2), lam)
    mixed = jnp.concatenate([hyena_mixer(hy, p), diff_out(att, p['subln_w'], lam_init),
                             fourier_mixer(fr, p['fnet_w'])], -1)
    out = mixed @ p['w_out']
    if last:
        return out, None
    att_c = diff_attn_core(to_attn(qk_heads(qc)), kc, vc, lam)
    mixed_c = jnp.concatenate([hyena_mixer(hyc, p), diff_out(att_c, p['subln_w'], lam_init),
                               fourier_mixer(frc, p['fnet_w'])], -1)
    return out, mixed_c @ p['w_out']


def moe_ffn(h, p):
    T, D = h.shape
    E, G = N_EXPERTS, MOE_BLOCK
    s = jax.nn.sigmoid((h @ p['router_w']).astype(jnp.float32))
    sel = s + p['router_b'].astype(jnp.float32)
    gscore = lax.top_k(sel.reshape(T, N_GROUPS, E // N_GROUPS), 2)[0].sum(-1)
    _, gidx = lax.top_k(gscore, TOPK_GROUPS)
    gmask = jnp.any(gidx[:, :, None] == jnp.arange(N_GROUPS)[None, None, :], axis=1)
    sel = jnp.where(jnp.repeat(gmask, E // N_GROUPS, axis=1), sel, -jnp.inf)
    _, eidx = lax.top_k(sel, TOP_K)
    ws = jnp.take_along_axis(s, eidx, axis=1)
    gates = ws / jnp.sum(ws, -1, keepdims=True) * ROUTED_SCALE
    A = T * TOP_K
    e_flat = eidx.reshape(-1)
    tok_flat = jnp.repeat(jnp.arange(T, dtype=jnp.int32), TOP_K)
    order = jnp.argsort(e_flat)
    e_s, tok_s, g_s = e_flat[order], tok_flat[order], gates.reshape(-1)[order]
    counts = jnp.bincount(e_flat, length=E)
    padded = (counts + G - 1) // G * G
    start = jnp.cumsum(counts) - counts
    cum_pad = jnp.cumsum(padded)
    pstart = cum_pad - padded
    pos = (pstart[e_s] + jnp.arange(A) - start[e_s]).astype(jnp.int32)
    n_blocks = (A + E * (G - 1) + G - 1) // G
    P = n_blocks * G
    rows_tok = jnp.full((P,), T, dtype=jnp.int32).at[pos].set(tok_s)
    gate_pad = jnp.zeros((P,), jnp.float32).at[pos].set(g_s)
    block_exp = jnp.minimum(jnp.searchsorted(cum_pad, jnp.arange(n_blocks) * G, side='right'),
                            E - 1)
    h_pad = jnp.concatenate([h, jnp.zeros((1, D), h.dtype)], 0)

    def expert_block(args):
        r, e = args
        xg = h_pad[r]
        a = jax.nn.silu(xg @ p['exp_w_gate'][e]) * (xg @ p['exp_w_up'][e])
        return a @ p['exp_w_down'][e]

    yb = lax.map(expert_block, (rows_tok.reshape(n_blocks, G), block_exp)).reshape(P, D)
    y = jnp.zeros((T + 1, D), jnp.float32).at[rows_tok].add(
        yb.astype(jnp.float32) * gate_pad[:, None])[:T]
    shared = (jax.nn.silu(h @ p['sh_w_gate']) * (h @ p['sh_w_up'])) @ p['sh_w_down']
    return y.astype(h.dtype) + shared


def trunk_layer(x, xc, c, c_ctx, p, layer_idx, last):
    D = D_MODEL
    B, L, _ = x.shape
    mod = (jax.nn.silu(c) @ p['w_mod'] + p['b_mod'])[:, None, :]
    sh1, sc1, g1, sh2, sc2, g2 = jnp.split(mod, 6, axis=-1)
    n_chunks = 2 if last else 6
    mod_c = jnp.split(jax.nn.silu(c_ctx) @ p['w_mod'][:, :n_chunks * D]
                      + p['b_mod'][:n_chunks * D], n_chunks)
    h = layer_norm(x) * (1.0 + sc1) + sh1
    hc = layer_norm(xc) * (1.0 + mod_c[1]) + mod_c[0]
    mix, mix_c = token_mixer(h, hc, p, layer_idx, last)
    x = layer_norm(ALPHA * x + g1 * mix, p['ln1_g'], p['ln1_b'])
    h = layer_norm(x) * (1.0 + sc2) + sh2
    if last:
        y = moe_ffn(h.reshape(B * L, D), p).reshape(B, L, D)
        return layer_norm(ALPHA * x + g2 * y, p['ln2_g'], p['ln2_b']), None
    cg1, csh2, csc2, cg2 = mod_c[2], mod_c[3], mod_c[4], mod_c[5]
    Lc = xc.shape[1]
    xc = layer_norm(ALPHA * xc + cg1 * mix_c, p['ln1_g'], p['ln1_b'])
    hc = layer_norm(xc) * (1.0 + csc2) + csh2
    y = moe_ffn(jnp.concatenate([h.reshape(B * L, D), hc.reshape(B * Lc, D)], 0), p)
    x = layer_norm(ALPHA * x + g2 * y[:B * L].reshape(B, L, D), p['ln2_g'], p['ln2_b'])
    xc = layer_norm(ALPHA * xc + cg2 * y[B * L:].reshape(B, Lc, D), p['ln2_g'], p['ln2_b'])
    return x, xc


def setup_inputs(seed: int = 0) -> dict:
    key = jax.random.key(seed)
    ks = iter(jax.random.split(key, 64))
    f32 = jnp.float32

    def nrm(shape, scale):
        return jax.random.normal(next(ks), shape, f32) * scale

    Dd, E = D_MODEL, N_EXPERTS
    col_scale = jnp.ones((D_IN,), f32).at[V_OFF:F_OFF].set(BETA)
    return {
        'x': nrm((BATCH, SEQ, Dd), 1.0),
        'c': nrm((BATCH, Dd), 1.0),
        'ctx': nrm((BATCH, CTX_LEN, Dd), 1.0),
        'c_ctx': nrm((Dd,), 1.0),
        'w_mod': nrm((DEPTH, Dd, 6 * Dd), 0.5 * Dd ** -0.5),
        'b_mod': nrm((DEPTH, 6 * Dd), 0.01),
        'w_in': nrm((DEPTH, Dd, D_IN), Dd ** -0.5) * col_scale,
        'w_out': nrm((DEPTH, D_MIX, Dd), BETA * D_MIX ** -0.5),
        'short_conv_w': nrm((DEPTH, SHORT_CONV, HY_W), SHORT_CONV ** -0.5),
        'filt_w1': nrm((DEPTH, HYENA_EMB, HYENA_FILTER_WIDTH), HYENA_EMB ** -0.5),
        'filt_b1': nrm((DEPTH, HYENA_FILTER_WIDTH), 0.01),
        'filt_w2': nrm((DEPTH, HYENA_FILTER_WIDTH, HYENA_FILTER_WIDTH), HYENA_FILTER_WIDTH ** -0.5),
        'filt_b2': nrm((DEPTH, HYENA_FILTER_WIDTH), 0.01),
        'filt_w3': nrm((DEPTH, HYENA_FILTER_WIDTH, HYENA_ORDER * 2 * D_HYENA), HYENA_FILTER_WIDTH ** -0.5),
        'filt_freq': 1.0 + nrm((DEPTH, HYENA_FILTER_WIDTH), 0.01),
        'hyena_bias': nrm((DEPTH, HYENA_ORDER, D_HYENA), 0.1),
        'lam_q1': nrm((DEPTH, DIFF_QK), 0.1),
        'lam_k1': nrm((DEPTH, DIFF_QK), 0.1),
        'lam_q2': nrm((DEPTH, DIFF_QK), 0.1),
        'lam_k2': nrm((DEPTH, DIFF_QK), 0.1),
        'subln_w': 1.0 + nrm((DEPTH, DIFF_V), 0.01),
        'fnet_w': nrm((DEPTH, FNET_GROUPS, FNET_GROUP_W, FNET_GROUP_W), FNET_GROUP_W ** -0.5),
        'ln1_g': 1.0 + nrm((DEPTH, Dd), 0.01),
        'ln1_b': nrm((DEPTH, Dd), 0.01),
        'ln2_g': 1.0 + nrm((DEPTH, Dd), 0.01),
        'ln2_b': nrm((DEPTH, Dd), 0.01),
        'router_w': nrm((DEPTH, Dd, E), Dd ** -0.5),
        'router_b': nrm((DEPTH, E), 0.01),
        'exp_w_gate': nrm((DEPTH, E, Dd, D_EXPERT), Dd ** -0.5),
        'exp_w_up': nrm((DEPTH, E, Dd, D_EXPERT), Dd ** -0.5),
        'exp_w_down': nrm((DEPTH, E, D_EXPERT, Dd), BETA * D_EXPERT ** -0.5),
        'sh_w_gate': nrm((DEPTH, Dd, D_SHARED), Dd ** -0.5),
        'sh_w_up': nrm((DEPTH, Dd, D_SHARED), Dd ** -0.5),
        'sh_w_down': nrm((DEPTH, D_SHARED, Dd), BETA * D_SHARED ** -0.5),
    }


def reference(x, c, ctx, c_ctx, w_mod, b_mod, w_in, w_out, short_conv_w, filt_w1, filt_b1,
              filt_w2, filt_b2, filt_w3, filt_freq, hyena_bias, lam_q1, lam_k1, lam_q2, lam_k2,
              subln_w, fnet_w, ln1_g, ln1_b, ln2_g, ln2_b, router_w, router_b, exp_w_gate,
              exp_w_up, exp_w_down, sh_w_gate, sh_w_up, sh_w_down):
    xc = ctx
    for i in range(DEPTH):
        p = {
            'w_mod': w_mod[i], 'b_mod': b_mod[i], 'w_in': w_in[i], 'w_out': w_out[i],
            'short_conv_w': short_conv_w[i], 'filt_w1': filt_w1[i], 'filt_b1': filt_b1[i],
            'filt_w2': filt_w2[i], 'filt_b2': filt_b2[i], 'filt_w3': filt_w3[i],
            'filt_freq': filt_freq[i], 'hyena_bias': hyena_bias[i],
            'lam_q1': lam_q1[i], 'lam_k1': lam_k1[i], 'lam_q2': lam_q2[i], 'lam_k2': lam_k2[i],
            'subln_w': subln_w[i], 'fnet_w': fnet_w[i],
            'ln1_g': ln1_g[i], 'ln1_b': ln1_b[i], 'ln2_g': ln2_g[i], 'ln2_b': ln2_b[i],
            'router_w': router_w[i], 'router_b': router_b[i],
            'exp_w_gate': exp_w_gate[i], 'exp_w_up': exp_w_up[i], 'exp_w_down': exp_w_down[i],
            'sh_w_gate': sh_w_gate[i], 'sh_w_up': sh_w_up[i], 'sh_w_down': sh_w_down[i],
        }
        x, xc = trunk_layer(x, xc, c, c_ctx, p, i, i == DEPTH - 1)
    return x
```

```cpp
#include <hip/hip_runtime.h>
#include <cstdio>
#include <cstdint>

#ifndef MK_PER_PHASE
#define MK_PER_PHASE 0
#endif

#ifndef PG8_OPAQUE_K
#define PG8_OPAQUE_K 1
#endif
#ifndef MK_OUTLINE
#define MK_OUTLINE 0
#endif
#if MK_OUTLINE
#define PHASE_FN __device__ __attribute__((noinline))
#else
#define PHASE_FN __device__ __forceinline__
#endif
#ifndef KMASK
#define KMASK 0xFFFF
#endif
#define KIND(k) ((KMASK >> (k)) & 1)
#define LAS __attribute__((address_space(3)))
typedef unsigned short bf16_t;
typedef short bf16x8 __attribute__((ext_vector_type(8)));
typedef short s16x4 __attribute__((ext_vector_type(4)));
typedef float f32x4 __attribute__((ext_vector_type(4)));
typedef float f32x16 __attribute__((ext_vector_type(16)));
typedef unsigned u32x4 __attribute__((ext_vector_type(4)));
typedef unsigned u32x2 __attribute__((ext_vector_type(2)));
#define DI __device__ __forceinline__

constexpr int NB = 4, SEQ = 4096, CTXL = 256, DM = 1024, DEPTH = 4;
constexpr int POS = SEQ + CTXL;
constexpr int RLAT = NB * SEQ, RCTX = NB * CTXL, RTOT = RLAT + RCTX;
constexpr int DIN = 2560, NWIN = 2816;
constexpr int NEXP = 64, DEXP = 256;
constexpr float LN_EPS = 1e-5f;
constexpr float ALPHA = 1.681792830507429f;
constexpr float QSCALE = 0.17677669529663687f * 1.4426950408889634f;
constexpr int MAXTILES = 680;

constexpr size_t AL(size_t x) { return (x + 255) & ~(size_t)255; }
constexpr size_t WS_CTL = 0, CTL_BYTES = 1u << 20;
constexpr size_t WS_X = WS_CTL + CTL_BYTES;
constexpr size_t WS_H = WS_X + AL((size_t)RTOT * DM * 4);
constexpr size_t WS_MOD = WS_H + AL((size_t)RTOT * DM * 2);
constexpr size_t WS_HCL = WS_MOD + AL((size_t)DEPTH * 5 * 6144 * 4);
constexpr size_t WS_HCC = WS_HCL + AL((size_t)DEPTH * 4 * 256 * SEQ * 4);
constexpr size_t WS_INVL1 = WS_HCC + AL((size_t)DEPTH * 4 * 256 * CTXL * 4);
constexpr size_t WS_DFTL = WS_INVL1 + AL((size_t)DEPTH * 2 * 2 * 256 * 4);
constexpr size_t WS_DFTC = WS_DFTL + AL((size_t)SEQ * 2 * SEQ * 2);
constexpr size_t WS_ROPE = WS_DFTC + AL((size_t)CTXL * 2 * CTXL * 2);
constexpr size_t WS_WIN = WS_ROPE + AL(64 * 8 * 2 * 4);
constexpr size_t WS_WOUT = WS_WIN + AL((size_t)NWIN * DM * 2);
constexpr size_t WS_WGU = WS_WOUT + AL((size_t)DM * DM * 2);
constexpr size_t WS_WD = WS_WGU + AL((size_t)65 * 512 * DM * 2);
constexpr size_t WS_TOPE = WS_WD + AL((size_t)65 * DM * DEXP * 2);
constexpr size_t WS_TOPG = WS_TOPE + AL((size_t)RTOT * 8 * 4);
constexpr size_t WS_LIST = WS_TOPG + AL((size_t)RTOT * 8 * 4);
constexpr size_t WS_U = WS_LIST + AL((size_t)NEXP * RTOT * 4);
constexpr size_t WS_Q = WS_U;
constexpr size_t WS_K = WS_Q + AL((size_t)NB * 8 * POS * 64 * 2);
constexpr size_t WS_V = WS_K + AL((size_t)NB * 8 * POS * 64 * 2);
constexpr size_t WS_HYT = WS_V + AL((size_t)NB * 8 * POS * 64 * 2);
constexpr size_t WS_YTL = WS_HYT + AL((size_t)NB * 768 * POS * 4);
constexpr size_t WS_YTC = WS_YTL + AL((size_t)1024 * 8192 * 2);
constexpr size_t WS_MIX = WS_YTC + AL((size_t)1024 * 512 * 2);
constexpr size_t WS_U1_END = WS_MIX + AL((size_t)RTOT * DM * 2);
constexpr size_t WS_ACT = WS_U;
constexpr size_t WS_YB = WS_ACT + AL((size_t)MAXTILES * 256 * DEXP * 2);
constexpr size_t WS_U2_END = WS_YB + AL((size_t)RTOT * 9 * DM * 2);
constexpr size_t WS_END = WS_U2_END > WS_U1_END ? WS_U2_END : WS_U1_END;

constexpr int CW_BAR = 0;
constexpr int CW_ATTN = 4096;
constexpr int CW_CNT = 8192;

DI unsigned cvt_pk_bf16(float lo, float hi) { unsigned r; asm volatile("v_cvt_pk_bf16_f32 %0, %1, %2" : "=v"(r) : "v"(lo), "v"(hi)); return r; }
DI bf16x8 pack8(float a0, float a1, float a2, float a3, float a4, float a5, float a6, float a7) {
    u32x4 p;
    asm volatile("v_cvt_pk_bf16_f32 %0, %4, %5\n\tv_cvt_pk_bf16_f32 %1, %6, %7\n\tv_cvt_pk_bf16_f32 %2, %8, %9\n\tv_cvt_pk_bf16_f32 %3, %10, %11\n\ts_nop 1"
                 : "=&v"(p[0]), "=&v"(p[1]), "=&v"(p[2]), "=&v"(p[3]) : "v"(a0), "v"(a1), "v"(a2), "v"(a3), "v"(a4), "v"(a5), "v"(a6), "v"(a7));
    return __builtin_bit_cast(bf16x8, p);
}
DI bf16_t f2bf(float x) { return (bf16_t)(cvt_pk_bf16(x, 0.f) & 0xffffu); }
DI float bf2f(unsigned short u) { return __uint_as_float(((unsigned)u) << 16); }
DI float bflo(unsigned w) { return __uint_as_float(w << 16); }
DI float bfhi(unsigned w) { return __uint_as_float(w & 0xffff0000u); }
DI float wave_sum(float v) {
#pragma unroll
    for (int o = 32; o >= 1; o >>= 1) v += __shfl_xor(v, o);
    return v;
}
DI float wave_max(float v) {
#pragma unroll
    for (int o = 32; o >= 1; o >>= 1) v = fmaxf(v, __shfl_xor(v, o));
    return v;
}

#define XB_TMO      128
#define XB_XCNT(j)  (256  + 64 * (j))
#define XB_XSUB(j)  (1280 + 64 * (j))
#define XB_XGEN(j)  (2304 + 64 * (j))
#define XB_TOP      3328
#define XB_TOPGEN   3392
#define XCD_BAR_WORDS 3456
#define XB_SPIN_CAP (1u << 18)

__device__ __forceinline__ unsigned xb_ld(unsigned* p)              { return __hip_atomic_load(p, __ATOMIC_RELAXED, __HIP_MEMORY_SCOPE_AGENT); }
__device__ __forceinline__ unsigned xb_add(unsigned* p, unsigned v) { return __hip_atomic_fetch_add(p, v, __ATOMIC_RELAXED, __HIP_MEMORY_SCOPE_AGENT); }
__device__ __forceinline__ unsigned xb_xcc_id() { return (unsigned)__builtin_amdgcn_s_getreg((3 << 11) | 20) & 0xFu; }
#define XB_SPIN(cond, bar) do { unsigned _sp = 0; while (cond) { __builtin_amdgcn_s_sleep(1); \
    if ((++_sp & 255u) == 0u) { if (xb_ld(&(bar)[XB_TMO])) break; if (_sp > XB_SPIN_CAP) { atomicAdd(&(bar)[XB_TMO], 1u); break; } } } } while (0)

struct XcdBarrier { unsigned* bar; unsigned x; volatile LAS unsigned* st; };

__device__ __forceinline__ XcdBarrier xcd_barrier_post(unsigned* bar, volatile LAS unsigned* st) {
    XcdBarrier b; b.bar = bar; b.x = xb_xcc_id(); b.st = st;
    if (threadIdx.x == 0) (void)xb_add(&bar[XB_XCNT(b.x)], 1u);
    return b;
}
__device__ __forceinline__ void xcd_barrier_complete(unsigned* bar, unsigned x, unsigned& nloc, unsigned& nx) {
    const unsigned G = gridDim.x * gridDim.y * gridDim.z;
    unsigned sum, cnt, mine, sp = 0u;
    for (;;) {
        sum = 0u; cnt = 0u; mine = 0u;
#pragma unroll
        for (unsigned j = 0; j < 16; ++j) { const unsigned c = xb_ld(&bar[XB_XCNT(j)]); sum += c; cnt += (c > 0u) ? 1u : 0u; mine = (j == x) ? c : mine; }
        if (sum == G) break;
        __builtin_amdgcn_s_sleep(1);
        if ((++sp & 255u) == 0u) { if (xb_ld(&bar[XB_TMO])) break; if (sp > XB_SPIN_CAP) { atomicAdd(&bar[XB_TMO], 1u); break; } }
    }
    nloc = mine > 0u ? mine : 1u; nx = cnt > 0u ? cnt : 1u;
}
__device__ __forceinline__ void xcd_barrier(const XcdBarrier& b) {
    asm volatile("s_waitcnt vmcnt(0)" ::: "memory");
    __syncthreads();
    if (threadIdx.x == 0) {
        unsigned* bar = b.bar;
        __builtin_amdgcn_s_waitcnt(0);
        unsigned nloc = b.st[0], nx = b.st[1];
        if (nloc == 0u) { xcd_barrier_complete(bar, b.x, nloc, nx); b.st[0] = nloc; b.st[1] = nx; }
        const unsigned old = xb_add(&bar[XB_XSUB(b.x)], 1u);
        const unsigned gen = old / nloc;
        if (old + 1u == (gen + 1u) * nloc) {
            __builtin_amdgcn_fence(__ATOMIC_RELEASE, "agent");
            asm volatile("s_waitcnt vmcnt(0)" ::: "memory");
            const unsigned og = xb_add(&bar[XB_TOP], 1u);
            const unsigned tg = og / nx;
            if (og + 1u == (tg + 1u) * nx) xb_add(&bar[XB_TOPGEN], 1u);
            else XB_SPIN(xb_ld(&bar[XB_TOPGEN]) == tg, bar);
            __builtin_amdgcn_fence(__ATOMIC_ACQUIRE, "agent");
            xb_add(&bar[XB_XGEN(b.x)], 1u);
            asm volatile("s_waitcnt vmcnt(0)" ::: "memory");
        } else {
            XB_SPIN(xb_ld(&bar[XB_XGEN(b.x)]) == gen, bar);
            __builtin_amdgcn_fence(__ATOMIC_ACQUIRE, "agent");
            asm volatile("s_waitcnt vmcnt(0)" ::: "memory");
        }
    }
    __syncthreads();
}

namespace pg8 {
constexpr int BM = 256, BK = 64, HALF = 128, HTB = HALF * BK * 2, STAGE_BYTES = 8 * HTB, NXCD = 8, WGM = 8;
__host__ __device__ __forceinline__ int lds_byte(int r, int c) { const int st = (r >> 4) * 2 + (c >> 5), rr = r & 15, cc = c & 31, ob = rr * 64 + cc * 2; return st * 1024 + (ob ^ (((ob >> 9) & 1) << 5)); }
__host__ __device__ __forceinline__ void stage_rc(int b, int& R, int& C) { const int st = b / 1024, sb = b % 1024, swz = sb ^ (((sb >> 9) & 1) << 5); R = (st >> 1) * 16 + swz / 64; C = (st & 1) * 32 + (swz % 64) / 2; }
__host__ __device__ __forceinline__ int perm32(int rho) { const int n = rho >> 4, i = rho & 15; return 8 * (i >> 2) + 4 * n + (i & 3); }

struct Unit { int pm, pn, e, lt; };
struct Gemm { const bf16_t* A; const bf16_t* Bt; int K; };

struct StaticOrder {
    static constexpr bool GATHER = false;
    int nM, nN, nwg, G, c;
    __device__ void init(int nM_, int nN_, int G_, int c_) { nM = nM_; nN = nN_; nwg = nM * nN; G = G_; c = c_; }
    __device__ bool next(int i, Unit& u) const {
        const long L = (long)i * G + c; if (L >= nwg) return false;
        int wgid = (int)L; { const int q = nwg / NXCD, r = nwg % NXCD, xcd = wgid % NXCD, off = wgid / NXCD; wgid = (xcd < r ? xcd * (q + 1) : r * (q + 1) + (xcd - r) * q) + off; }
        const int nig = WGM * nN, gid = wgid / nig, fm = gid * WGM, gsz = (nM - fm) < WGM ? (nM - fm) : WGM;
        u.pm = fm + ((wgid % nig) % gsz); u.pn = (wgid % nig) / gsz; u.e = 0; u.lt = 0; return true;
    }
    __device__ __forceinline__ int arow(const Unit& u, int r) const { return u.pm * BM + r; }
};

template <class Epi, class Sched>
__device__ __forceinline__ void gemm_phase(LAS unsigned char* lds, const Gemm g, const Sched& S, const Epi& E) {
    constexpr bool GA = Sched::GATHER;
    int tid = threadIdx.x; asm volatile("" : "+v"(tid));
    const int wid = __builtin_amdgcn_readfirstlane(tid >> 6), lane = tid & 63, wr = wid >> 2, wc = wid & 3, fr = lane & 15, fq = lane >> 4;
    int K = g.K;
#if PG8_OPAQUE_K
    asm volatile("" : "+s"(K));
#endif
    const int nt = K / BK;
    unsigned voffA[2], voffB[2];
#pragma unroll
    for (int i = 0; i < 2; ++i) { int R, C; stage_rc(tid * 16 + i * 8192, R, C); const int Rb = Epi::PERM ? ((R & ~31) + perm32(R & 31)) : R;
        voffA[i] = (unsigned)(R * K + C) * 2u; voffB[i] = (unsigned)(Rb * K + C) * 2u; }
    const size_t kstep = (size_t)(BK * 2);
    const size_t hstep = (size_t)HALF * K * 2;
    const size_t tstep = 2 * hstep;
    const unsigned ldsw = (unsigned)wid * 1024u;
    const int aoff = lds_byte(wr * 64 + fr, fq * 8), boff = lds_byte(wc * 32 + fr, fq * 8);
#define PG8_SA(b, h) (((b) * 2 + (h)) * HTB)
#define PG8_SB(b, h) ((4 + (b) * 2 + (h)) * HTB)
#define PG8_STAGE(bufoff, gbase, voff) do { _Pragma("unroll") for (int _i = 0; _i < 2; ++_i) \
        __builtin_amdgcn_global_load_lds((const unsigned*)((const char*)(gbase) + (voff)[_i]), (LAS unsigned*)(lds + (bufoff) + ldsw + _i * 8192), 16, 0, 0); } while (0)
#define PG8_STAGEA(bufoff, gbase, o0, o1) do { \
        __builtin_amdgcn_global_load_lds((const unsigned*)((const char*)(gbase) + (o0)), (LAS unsigned*)(lds + (bufoff) + ldsw), 16, 0, 0); \
        __builtin_amdgcn_global_load_lds((const unsigned*)((const char*)(gbase) + (o1)), (LAS unsigned*)(lds + (bufoff) + ldsw + 8192), 16, 0, 0); } while (0)
#define PG8_STA(bufoff, sp, gp, o0, o1) do { if constexpr (GA) PG8_STAGEA(bufoff, gp, o0, o1); else PG8_STAGE(bufoff, sp, voffA); } while (0)
#define PG8_LDA(dst, b, h) do { _Pragma("unroll") for (int m = 0; m < 4; ++m) _Pragma("unroll") for (int k = 0; k < 2; ++k) dst[m][k] = *(const LAS bf16x8*)(lds + PG8_SA(b, h) + aoff + m * 2048 + k * 1024); } while (0)
#define PG8_LDB(dst, b, h) do { _Pragma("unroll") for (int n = 0; n < 2; ++n) _Pragma("unroll") for (int k = 0; k < 2; ++k) dst[n][k] = *(const LAS bf16x8*)(lds + PG8_SB(b, h) + boff + n * 2048 + k * 1024); } while (0)
#define PG8_MMA(ai, bj, At, Bt) do { __builtin_amdgcn_s_setprio(1); _Pragma("unroll") for (int m = 0; m < 4; ++m) _Pragma("unroll") for (int n = 0; n < 2; ++n) _Pragma("unroll") for (int k = 0; k < 2; ++k) \
        acc[ai][bj][m][n] = __builtin_amdgcn_mfma_f32_16x16x32_bf16(Bt[n][k], At[m][k], acc[ai][bj][m][n], 0, 0, 0); __builtin_amdgcn_s_setprio(0); } while (0)
#define PG8_WAIT_V(n) asm volatile("s_waitcnt vmcnt(" #n ")" ::: "memory")
#define PG8_WAIT_L(n) asm volatile("s_waitcnt lgkmcnt(" #n ")" ::: "memory")
#define PG8_BAR __builtin_amdgcn_s_barrier()
#define PG8_SCHED __builtin_amdgcn_sched_barrier(0)
#define PG8_GOFF(u, o00, o01, o10, o11) do { int _tz = threadIdx.x; asm volatile("" : "+v"(_tz)); int _R0, _C0, _R1, _C1; stage_rc(_tz * 16, _R0, _C0); stage_rc(_tz * 16 + 8192, _R1, _C1); \
        o00 = (unsigned)(S.arow(u, _R0) * K + _C0) * 2u; o01 = (unsigned)(S.arow(u, _R1) * K + _C1) * 2u; \
        o10 = (unsigned)(S.arow(u, HALF + _R0) * K + _C0) * 2u; o11 = (unsigned)(S.arow(u, HALF + _R1) * K + _C1) * 2u; } while (0)
    Unit cur, nxt; int ui = 0;
    if (!S.next(0, cur)) return;
    f32x4 acc[2][2][4][2];
#pragma unroll
    for (int a = 0; a < 2; ++a)
#pragma unroll
        for (int b = 0; b < 2; ++b)
#pragma unroll
            for (int m = 0; m < 4; ++m)
#pragma unroll
                for (int n = 0; n < 2; ++n) acc[a][b][m][n] = (f32x4){0.f, 0.f, 0.f, 0.f};
    bf16x8 At[4][2], B0[2][2], B1[2][2];
    const char* const gA = (const char*)g.A;
    unsigned c00 = 0, c01 = 0, c10 = 0, c11 = 0, n00 = 0, n01 = 0, n10 = 0, n11 = 0;
    if constexpr (GA) PG8_GOFF(cur, c00, c01, c10, c11);
    const char* cA = gA + (GA ? (size_t)0 : (size_t)cur.pm * tstep); const char* cB = (const char*)g.Bt + (size_t)cur.pn * tstep;
    PG8_STAGE(PG8_SB(0, 0), cB, voffB); PG8_STAGE(PG8_SB(0, 1), cB + hstep, voffB); PG8_STA(PG8_SA(0, 0), cA, gA, c00, c01); PG8_STA(PG8_SA(0, 1), cA + hstep, gA, c10, c11);
    if (wr == 1) PG8_BAR;
    PG8_WAIT_V(2); PG8_BAR;
    PG8_STAGE(PG8_SB(1, 0), cB + kstep, voffB); PG8_STA(PG8_SA(1, 0), cA + kstep, gA + kstep, c00, c01); PG8_STAGE(PG8_SB(1, 1), cB + hstep + kstep, voffB);
    PG8_WAIT_V(6); PG8_BAR;
    for (;;) {
        const bool has_next = S.next(ui + 1, nxt);
        const char* nA = (has_next && !GA) ? gA + (size_t)nxt.pm * tstep : cA; const char* nB = has_next ? (const char*)g.Bt + (size_t)nxt.pn * tstep : cB;
        if constexpr (GA) { if (has_next) PG8_GOFF(nxt, n00, n01, n10, n11); else { n00 = c00; n01 = c01; n10 = c10; n11 = c11; } }
#pragma unroll 1
        for (int t = 0; t < nt; t += 2) {
            const bool last = (t == nt - 2);
            const char* a1 = cA + (size_t)(t + 1) * kstep;
            const char* a2 = last ? nA : cA + (size_t)(t + 2) * kstep; const char* b2 = last ? nB : cB + (size_t)(t + 2) * kstep;
            const char* a3 = a2 + kstep; const char* b3 = b2 + kstep;
            unsigned x00 = 0, x01 = 0, x10 = 0, x11 = 0;
            if constexpr (GA) { x00 = last ? n00 : c00; x01 = last ? n01 : c01; x10 = last ? n10 : c10; x11 = last ? n11 : c11; }
            PG8_LDB(B0, 0, 0); PG8_LDB(B1, 0, 1); PG8_SCHED; PG8_LDA(At, 0, 0); PG8_STA(PG8_SA(1, 1), a1 + hstep, a1, c10, c11);
            PG8_WAIT_V(8); PG8_WAIT_L(0); PG8_BAR; PG8_MMA(0, 0, At, B0); PG8_MMA(0, 1, At, B1); PG8_BAR; PG8_SCHED;
            PG8_LDA(At, 0, 1); PG8_STAGE(PG8_SB(0, 0), b2, voffB); PG8_STAGE(PG8_SB(0, 1), b2 + hstep, voffB); PG8_STA(PG8_SA(0, 0), a2, a2, x00, x01);
            PG8_WAIT_V(8); PG8_WAIT_L(0); PG8_BAR; PG8_MMA(1, 0, At, B0); PG8_MMA(1, 1, At, B1); PG8_BAR; PG8_SCHED;
            PG8_LDB(B0, 1, 0); PG8_LDB(B1, 1, 1); PG8_SCHED; PG8_LDA(At, 1, 0); PG8_STA(PG8_SA(0, 1), a2 + hstep, a2, x10, x11);
            PG8_WAIT_V(8); PG8_WAIT_L(0); PG8_BAR; PG8_MMA(0, 0, At, B0); PG8_MMA(0, 1, At, B1); PG8_BAR; PG8_SCHED;
            PG8_LDA(At, 1, 1); PG8_STAGE(PG8_SB(1, 0), b3, voffB); PG8_STAGE(PG8_SB(1, 1), b3 + hstep, voffB); PG8_STA(PG8_SA(1, 0), a3, a3, x00, x01);
            PG8_WAIT_V(8); PG8_WAIT_L(0); PG8_BAR; PG8_MMA(1, 0, At, B0); PG8_MMA(1, 1, At, B1); PG8_BAR; PG8_SCHED;
        }
        if (wr == 0) PG8_BAR;
        E(acc, cur, wr, wc, fr, fq);
        if (!has_next) break;
#pragma unroll
        for (int a = 0; a < 2; ++a)
#pragma unroll
            for (int b = 0; b < 2; ++b)
#pragma unroll
                for (int m = 0; m < 4; ++m)
#pragma unroll
                    for (int n = 0; n < 2; ++n) acc[a][b][m][n] = (f32x4){0.f, 0.f, 0.f, 0.f};
        cur = nxt; cA = nA; cB = nB; ++ui;
        if constexpr (GA) { c00 = n00; c01 = n01; c10 = n10; c11 = n11; }
        if (wr == 1) PG8_BAR;
    }
    PG8_WAIT_V(0);
    PG8_BAR;
#undef PG8_SA
#undef PG8_SB
#undef PG8_STAGE
#undef PG8_STAGEA
#undef PG8_STA
#undef PG8_GOFF
#undef PG8_LDA
#undef PG8_LDB
#undef PG8_MMA
#undef PG8_WAIT_V
#undef PG8_WAIT_L
#undef PG8_BAR
#undef PG8_SCHED
}
}

constexpr int NTHR = 512;
constexpr int LDS_MISC = pg8::STAGE_BYTES;
constexpr int LDS_TAB = LDS_MISC + 256;
constexpr int LDS_BYTES = 147456;

struct Params { const float* in[34]; float* out; unsigned char* ws; int ph_lo, ph_hi; };

struct Frame {
    const float* const* in; float* out; unsigned char* ws; LAS unsigned char* lds; unsigned* ctl;
    int tid, lane, wave, G, bid;
};

DI int row_b(int row) { return row < RLAT ? (row >> 12) : ((row - RLAT) >> 8); }
DI int row_pos(int row) { return row < RLAT ? (row & 4095) : (SEQ + ((row - RLAT) & 255)); }
DI int row_modsel(int row) { return row < RLAT ? (row >> 12) : 4; }

DI void prep_tile(const Frame& F, const float* src, int ldn, int k0, int n0, bf16_t* dst, int ldk, int dst_row0) {
    LAS float* T = (LAS float*)F.lds;
    const int t = F.tid;
    { const float* p = src + (size_t)(k0 + (t >> 3)) * ldn + n0 + (t & 7) * 8;
      const f32x4 a = *(const f32x4*)p, b = *(const f32x4*)(p + 4);
      LAS float* q = T + (t >> 3) * 65 + (t & 7) * 8;
      q[0] = a[0]; q[1] = a[1]; q[2] = a[2]; q[3] = a[3]; q[4] = b[0]; q[5] = b[1]; q[6] = b[2]; q[7] = b[3]; }
    __syncthreads();
    { const int nn = t >> 3, kc = (t & 7) * 8; float v[8];
#pragma unroll
      for (int j = 0; j < 8; ++j) v[j] = T[(kc + j) * 65 + nn];
      u32x4 w; w.x = cvt_pk_bf16(v[0], v[1]); w.y = cvt_pk_bf16(v[2], v[3]); w.z = cvt_pk_bf16(v[4], v[5]); w.w = cvt_pk_bf16(v[6], v[7]);
      *(u32x4*)(dst + (size_t)(dst_row0 + nn) * ldk + k0 + kc) = w; }
    __syncthreads();
}

DI void prep_fourier_job(const Frame& F, int ly, int g, int kt) {
    LAS float* FW = (LAS float*)F.lds;
    LAS float* CS = FW + 4096;
    LAS float* P = CS + 128;
    LAS float* W = P + 8192;
    const int t = F.tid;
    const float* fw = F.in[21] + ((size_t)ly * 4 + g) * 4096;
    for (int i = t; i < 4096; i += NTHR) FW[i] = fw[i];
    if (t < 64) { float s, c; sincospif((float)t / 32.0f, &s, &c); CS[t] = c; CS[64 + t] = s; }
    { const float* p = F.in[6] + (size_t)ly * DM * DIN + (size_t)(kt * 64 + (t >> 3)) * DIN + 2304 + g * 64 + (t & 7) * 8;
      const f32x4 a = *(const f32x4*)p, b = *(const f32x4*)(p + 4);
      LAS float* q = W + (t >> 3) * 65 + (t & 7) * 8;
      q[0] = a[0]; q[1] = a[1]; q[2] = a[2]; q[3] = a[3]; q[4] = b[0]; q[5] = b[1]; q[6] = b[2]; q[7] = b[3]; }
    __syncthreads();
    for (int i = t; i < 8192; i += NTHR) {
        const int c = i >> 7, n = i & 127, comp = n >> 6, d = n & 63;
        float s = 0.f;
        for (int j = 0; j < 64; ++j) { const int a = (j * c) & 63; const float tr = comp ? -CS[64 + a] : CS[a]; s += tr * FW[j * 64 + d]; }
        P[c * 128 + n] = s;
    }
    __syncthreads();
    bf16_t* dst = (bf16_t*)(F.ws + WS_WIN);
    { const int k = t >> 3, nb = (t & 7) * 16;
      float o[16];
#pragma unroll
      for (int j = 0; j < 16; ++j) o[j] = 0.f;
      for (int c = 0; c < 64; ++c) { const float w = W[k * 65 + c];
#pragma unroll
          for (int j = 0; j < 16; ++j) o[j] += w * P[c * 128 + nb + j]; }
#pragma unroll
      for (int j = 0; j < 16; ++j) { const int n = nb + j, comp = n >> 6, d = n & 63;
          dst[(size_t)(2304 + comp * 256 + g * 64 + d) * DM + kt * 64 + k] = f2bf(o[j]); } }
    __syncthreads();
}

DI void prep_weights(const Frame& F, int ly) {
    constexpr int J1 = 576, J2 = J1 + 256, J3 = J2 + 4160, J4 = J3 + 4160, J5 = J4 + 4160, J6 = J5 + 64;
    for (int j = F.bid; j < J6; j += F.G) {
        if (j < J1) { const int kt = j / 36, nt = j % 36;
            prep_tile(F, F.in[6] + (size_t)ly * DM * DIN, DIN, kt * 64, nt * 64, (bf16_t*)(F.ws + WS_WIN), DM, nt * 64);
        } else if (j < J2) { const int q = j - J1, kt = q >> 4, nt = q & 15;
            prep_tile(F, F.in[7] + (size_t)ly * DM * DM, DM, kt * 64, nt * 64, (bf16_t*)(F.ws + WS_WOUT), DM, nt * 64);
        } else if (j < J4) { const bool up = j >= J3; const int q = j - (up ? J3 : J2), e = q >> 6, kt = (q >> 2) & 15, nt = q & 3;
            const float* src = e < NEXP ? F.in[up ? 29 : 28] + ((size_t)ly * NEXP + e) * DM * DEXP : F.in[up ? 32 : 31] + (size_t)ly * DM * DEXP;
            const int hid0 = nt * 64, jj = hid0 >> 7;
            prep_tile(F, src, DEXP, kt * 64, hid0, (bf16_t*)(F.ws + WS_WGU), DM, e * 512 + jj * 256 + (up ? 128 : 0) + (hid0 & 127));
        } else if (j < J5) { const int q = j - J4, e = q >> 6, kt = (q >> 4) & 3, nt = q & 15;
            const float* src = e < NEXP ? F.in[30] + ((size_t)ly * NEXP + e) * DEXP * DM : F.in[33] + (size_t)ly * DEXP * DM;
            prep_tile(F, src, DM, kt * 64, nt * 64, (bf16_t*)(F.ws + WS_WD), DEXP, e * DM + nt * 64);
        } else { const int q = j - J5; prep_fourier_job(F, ly, q >> 4, q & 15); }
    }
}

DI void prep_mod(const Frame& F) {
    LAS float* S = (LAS float*)F.lds;
    LAS float* RED = S + 5 * 1024;
    const int t = F.tid;
    bool have_s = false;
    for (int u = F.bid; u < DEPTH * 96; u += F.G) {
        const int ly = u / 96, cg = u % 96;
        if (!have_s) {
            for (int i = t; i < 5 * 1024; i += NTHR) { const int r = i >> 10, k = i & 1023; const float x = r < 4 ? F.in[1][r * DM + k] : F.in[3][k]; S[i] = x / (1.f + expf(-x)); }
            __syncthreads(); have_s = true;
        }
        const int tq = t & 15, tk = t >> 4;
        const float* w = F.in[4] + (size_t)ly * DM * 6144 + cg * 64 + tq * 4;
        f32x4 acc[5];
#pragma unroll
        for (int r = 0; r < 5; ++r) acc[r] = (f32x4){0.f, 0.f, 0.f, 0.f};
        for (int kk = 0; kk < 32; ++kk) { const int k = tk * 32 + kk; const f32x4 wv = *(const f32x4*)(w + (size_t)k * 6144);
#pragma unroll
            for (int r = 0; r < 5; ++r) acc[r] += wv * S[r * 1024 + k]; }
#pragma unroll
        for (int r = 0; r < 5; ++r)
#pragma unroll
            for (int j = 0; j < 4; ++j) RED[(tk * 5 + r) * 64 + tq * 4 + j] = acc[r][j];
        __syncthreads();
        if (t < 320) { const int r = t >> 6, c = t & 63; float s = 0.f;
            for (int q = 0; q < 32; ++q) s += RED[(q * 5 + r) * 64 + c];
            const int col = cg * 64 + c;
            ((float*)(F.ws + WS_MOD))[((size_t)ly * 5 + r) * 6144 + col] = s + F.in[5][(size_t)ly * 6144 + col]; }
        __syncthreads();
    }
}

DI void prep_filters(const Frame& F) {
    LAS float* Z = (LAS float*)F.lds;
    LAS float* A1 = Z + 64 * 33;
    LAS float* A2 = A1 + 4096;
    const int t = F.tid;
    for (int u = F.bid; u < DEPTH * 68; u += F.G) {
        const int ly = u / 68, ch = u % 68; const bool lat = ch < 64; const int Lx = lat ? SEQ : CTXL, t0 = lat ? ch * 64 : (ch - 64) * 64;
        for (int i = t; i < 64 * 33; i += NTHR) { const int tt = i / 33, f = i % 33; const int ti = t0 + tt;
            float v;
            if (f == 0) v = (float)ti / (float)(Lx - 1);
            else { const int j = (f - 1) & 15; const float fb = 1e-4f + (float)j * ((15.0f - 1e-4f) / 15.0f); const float om = (6.283185307179586f / (float)Lx) * (float)ti;
                   v = f <= 16 ? cosf(fb * om) : -sinf(fb * om); }
            Z[i] = v; }
        __syncthreads();
        const float* w1 = F.in[9] + (size_t)ly * 33 * 64; const float* b1 = F.in[10] + ly * 64; const float* w2 = F.in[11] + (size_t)ly * 4096; const float* b2 = F.in[12] + ly * 64;
        const float* w3 = F.in[13] + (size_t)ly * 64 * 1024; const float* fq = F.in[14] + ly * 64;
        for (int i = t; i < 4096; i += NTHR) { const int tt = i >> 6, h = i & 63; float s = b1[h];
            for (int f = 0; f < 33; ++f) s += Z[tt * 33 + f] * w1[f * 64 + h];
            A1[i] = sinf(fq[h] * s); }
        __syncthreads();
        for (int i = t; i < 4096; i += NTHR) { const int tt = i >> 6, h = i & 63; float s = b2[h];
            for (int j = 0; j < 64; ++j) s += A1[tt * 64 + j] * w2[j * 64 + h];
            A2[i] = sinf(fq[h] * s); }
        __syncthreads();
        for (int cc = 0; cc < 2; ++cc) { const int col = t + cc * 512;
            float wr[64];
#pragma unroll
            for (int j = 0; j < 64; ++j) wr[j] = w3[j * 1024 + col];
            const int n = col >> 9, dir = (col >> 8) & 1, c = col & 255;
            const float delta = fabsf(-3.0701134573253946f + (float)c * ((-15.350567286626973f + 3.0701134573253946f) / 255.0f));
            float* dst = lat ? (float*)(F.ws + WS_HCL) + ((((size_t)ly * 2 + n) * 2 + dir) * 256 + c) * SEQ + t0
                             : (float*)(F.ws + WS_HCC) + ((((size_t)ly * 2 + n) * 2 + dir) * 256 + c) * CTXL + t0;
            for (int tt = 0; tt < 64; ++tt) { float s = 0.f;
#pragma unroll
                for (int j = 0; j < 64; ++j) s += A2[tt * 64 + j] * wr[j];
                const float tv = (float)(t0 + tt) / (float)(Lx - 1);
                dst[tt] = s * expf(-tv * delta); } }
        __syncthreads();
    }
}

DI void prep_tables(const Frame& F) {
    LAS float* CT = (LAS float*)F.lds;
    const int t = F.tid;
    for (int i = t; i < 4096; i += NTHR) CT[i] = cospif((float)i / 2048.0f);
    __syncthreads();
    bf16_t* DL = (bf16_t*)(F.ws + WS_DFTL);
    for (int k = F.bid; k < SEQ; k += F.G) {
        for (int ch = t; ch < 1024; ch += NTHR) {
            const int comp = ch >> 9, l0 = (ch & 511) * 8; float v[8];
#pragma unroll
            for (int j = 0; j < 8; ++j) { const int idx = (k * (l0 + j)) & 4095; v[j] = (comp ? CT[(idx - 1024) & 4095] : CT[idx]) * (1.0f / 512.0f); }
            u32x4 w; w.x = cvt_pk_bf16(v[0], v[1]); w.y = cvt_pk_bf16(v[2], v[3]); w.z = cvt_pk_bf16(v[4], v[5]); w.w = cvt_pk_bf16(v[6], v[7]);
            *(u32x4*)(DL + (size_t)k * 8192 + comp * 4096 + l0) = w; }
    }
    bf16_t* DC = (bf16_t*)(F.ws + WS_DFTC);
    for (int i = F.bid * NTHR + t; i < CTXL * 512; i += F.G * NTHR) { const int k = i >> 9, cl = i & 511, comp = cl >> 8, l = cl & 255;
        const int idx = ((k * l) & 255) * 16; DC[i] = f2bf((comp ? CT[(idx - 1024) & 4095] : CT[idx]) * (1.0f / 128.0f)); }
    if (F.bid == 0) { float* RT = (float*)(F.ws + WS_ROPE);
        for (int i = t; i < 512; i += NTHR) { const int p = i >> 3, n = i & 7; const float inv = powf(10000.0f, -(float)n / 8.0f); float s, c; sincosf((float)p * inv, &s, &c); RT[i * 2] = c; RT[i * 2 + 1] = s; } }
    __syncthreads();
}

DI void prep_copy_x(const Frame& F) {
    f32x4* X = (f32x4*)(F.ws + WS_X);
    const f32x4* x = (const f32x4*)F.in[0]; const f32x4* cx = (const f32x4*)F.in[2];
    const size_t n1 = (size_t)RLAT * DM / 4, n2 = (size_t)RCTX * DM / 4;
    for (size_t i = (size_t)F.bid * NTHR + F.tid; i < n1 + n2; i += (size_t)F.G * NTHR) X[i] = i < n1 ? x[i] : cx[i - n1];
}

DI void prep_invl1(const Frame& F) {
    const int gw = F.bid * 8 + F.wave, nw = F.G * 8;
    for (int j = gw; j < DEPTH * 2 * 2 * 256; j += nw) {
        const int ly = j >> 10, lt = (j >> 9) & 1, n = (j >> 8) & 1, c = j & 255;
        const int Lx = lt ? CTXL : SEQ;
        const float* base = lt ? (const float*)(F.ws + WS_HCC) : (const float*)(F.ws + WS_HCL);
        const float* f0 = base + ((((size_t)ly * 2 + n) * 2 + 0) * 256 + c) * Lx;
        const float* f1 = base + ((((size_t)ly * 2 + n) * 2 + 1) * 256 + c) * Lx;
        float s = 0.f;
        for (int i = F.lane; i < Lx; i += 64) { s += fabsf(f0[i]); if (i >= 1) s += fabsf(f1[i]); }
        s = wave_sum(s);
        if (F.lane == 0) ((float*)(F.ws + WS_INVL1))[j] = 1.0f / s;
    }
}

DI void ln_stats(const f32x4 (&v)[4], float& mu, float& rstd) {
    float s = 0.f;
#pragma unroll
    for (int j = 0; j < 4; ++j) s += (v[j][0] + v[j][1]) + (v[j][2] + v[j][3]);
    mu = wave_sum(s) * (1.0f / DM);
    float q = 0.f;
#pragma unroll
    for (int j = 0; j < 4; ++j)
#pragma unroll
        for (int e = 0; e < 4; ++e) { const float d = v[j][e] - mu; q += d * d; }
    rstd = rsqrtf(wave_sum(q) * (1.0f / DM) + LN_EPS);
}
DI void ln_mod_store(const f32x4 (&v)[4], const float* sh, const float* sc, bf16_t* hrow, int lane) {
    float mu, rstd; ln_stats(v, mu, rstd);
#pragma unroll
    for (int j = 0; j < 4; ++j) { const int c = 4 * lane + 256 * j; const f32x4 a = *(const f32x4*)(sh + c), b = *(const f32x4*)(sc + c);
        float o[4];
#pragma unroll
        for (int e = 0; e < 4; ++e) o[e] = (v[j][e] - mu) * rstd * (1.f + b[e]) + a[e];
        u32x2 w; w.x = cvt_pk_bf16(o[0], o[1]); w.y = cvt_pk_bf16(o[2], o[3]); *(u32x2*)(hrow + c) = w; }
}

DI void phase_init_h(const Frame& F) {
    const int gw = F.bid * 8 + F.wave, nw = F.G * 8;
    const float* MOD = (const float*)(F.ws + WS_MOD);
    for (int row = gw; row < RTOT; row += nw) {
        const float* xr = (const float*)(F.ws + WS_X) + (size_t)row * DM;
        f32x4 v[4];
#pragma unroll
        for (int j = 0; j < 4; ++j) v[j] = *(const f32x4*)(xr + 4 * F.lane + 256 * j);
        const float* m = MOD + (size_t)(0 * 5 + row_modsel(row)) * 6144;
        ln_mod_store(v, m, m + 1024, (bf16_t*)(F.ws + WS_H) + (size_t)row * DM, F.lane);
    }
}

struct EpiWin {
    static constexpr bool PERM = true;
    unsigned char* ws;
    DI void operator()(const f32x4 (&acc)[2][2][4][2], const pg8::Unit& u, int wr, int wc, int fr, int fq) const {
        const bool lat = u.pm < 64; const int b = lat ? (u.pm >> 4) : (u.pm - 64); const int pos0 = lat ? ((u.pm & 15) << 8) : SEQ;
        const int pn = u.pn;
        const float* RT = (const float*)(ws + WS_ROPE);
#pragma unroll
        for (int ai = 0; ai < 2; ++ai)
#pragma unroll
            for (int m = 0; m < 4; ++m) {
                const int pos = pos0 + ai * 128 + wr * 64 + m * 16 + fr;
#pragma unroll
                for (int bj = 0; bj < 2; ++bj) {
                    const int col = pn * 256 + bj * 128 + wc * 32 + fq * 8;
                    float v[8];
#pragma unroll
                    for (int e = 0; e < 4; ++e) { v[e] = acc[ai][bj][m][0][e]; v[4 + e] = acc[ai][bj][m][1][e]; }
                    if (pn < 3) {
                        float* d = (float*)(ws + WS_HYT) + ((size_t)b * 768 + col) * POS + pos;
#pragma unroll
                        for (int e = 0; e < 8; ++e) d[(size_t)e * POS] = v[e];
                    } else if (pn < 7) {
                        const bool isq = pn < 5; const int cq = col - (isq ? 768 : 1280); const int head = cq >> 6, cc = cq & 63;
                        if (lat) { const int axis = (cc >> 4) & 1, n0 = (cc & 15) >> 1; const int pa = axis ? (pos & 63) : (pos >> 6);
                            const float* rt = RT + (pa * 8 + n0) * 2;
#pragma unroll
                            for (int p = 0; p < 4; ++p) { const float cs = rt[2 * p], sn = rt[2 * p + 1]; const float a = v[2 * p], bb = v[2 * p + 1];
                                v[2 * p] = a * cs - bb * sn; v[2 * p + 1] = a * sn + bb * cs; } }
                        if (isq) {
#pragma unroll
                            for (int e = 0; e < 8; ++e) v[e] *= QSCALE; }
                        u32x4 w; w.x = cvt_pk_bf16(v[0], v[1]); w.y = cvt_pk_bf16(v[2], v[3]); w.z = cvt_pk_bf16(v[4], v[5]); w.w = cvt_pk_bf16(v[6], v[7]);
                        bf16_t* d = (bf16_t*)(ws + (isq ? WS_Q : WS_K)) + (((size_t)b * 8 + head) * POS + pos) * 64 + cc;
                        *(u32x4*)d = w;
                    } else if (pn < 9) {
                        const int cv = col - 1792; const int head = cv >> 6, cc = cv & 63;
                        u32x4 w; w.x = cvt_pk_bf16(v[0], v[1]); w.y = cvt_pk_bf16(v[2], v[3]); w.z = cvt_pk_bf16(v[4], v[5]); w.w = cvt_pk_bf16(v[6], v[7]);
                        *(u32x4*)((bf16_t*)(ws + WS_V) + (((size_t)b * 8 + head) * POS + pos) * 64 + cc) = w;
                    } else {
                        const int cy = col - 2304; const int comp = cy >> 8, gd = cy & 255;
                        if (lat) { bf16_t* d = (bf16_t*)(ws + WS_YTL) + ((size_t)b * 256 + gd) * 8192 + comp * 4096 + pos;
#pragma unroll
                            for (int e = 0; e < 8; ++e) d[(size_t)e * 8192] = f2bf(v[e]);
                        } else { bf16_t* d = (bf16_t*)(ws + WS_YTC) + ((size_t)b * 256 + gd) * 512 + comp * 256 + (pos - SEQ);
#pragma unroll
                            for (int e = 0; e < 8; ++e) d[(size_t)e * 512] = f2bf(v[e]); }
                    }
                }
            }
    }
};

struct EpiFnet {
    static constexpr bool PERM = true;
    unsigned char* ws; int ctx;
    DI void operator()(const f32x4 (&acc)[2][2][4][2], const pg8::Unit& u, int wr, int wc, int fr, int fq) const {
        const int b = u.pn;
#pragma unroll
        for (int ai = 0; ai < 2; ++ai)
#pragma unroll
            for (int m = 0; m < 4; ++m) {
                const int k = u.pm * 256 + ai * 128 + wr * 64 + m * 16 + fr;
                const size_t row = ctx ? (size_t)(RLAT + b * CTXL + k) : (size_t)(b * SEQ + k);
#pragma unroll
                for (int bj = 0; bj < 2; ++bj) { const int gd = bj * 128 + wc * 32 + fq * 8;
                    const f32x4 v0 = acc[ai][bj][m][0], v1 = acc[ai][bj][m][1];
                    u32x4 w; w.x = cvt_pk_bf16(v0[0], v0[1]); w.y = cvt_pk_bf16(v0[2], v0[3]); w.z = cvt_pk_bf16(v1[0], v1[1]); w.w = cvt_pk_bf16(v1[2], v1[3]);
                    *(u32x4*)((bf16_t*)(ws + WS_MIX) + row * DM + 768 + gd) = w; }
            }
    }
};

struct EpiWout {
    static constexpr bool PERM = false;
    unsigned char* ws; int ly;
    DI void operator()(const f32x4 (&acc)[2][2][4][2], const pg8::Unit& u, int wr, int wc, int fr, int fq) const {
        const int msel = u.pm < 64 ? (u.pm >> 4) : 4;
        const float* g1 = (const float*)(ws + WS_MOD) + ((size_t)ly * 5 + msel) * 6144 + 2048;
        const int col0 = u.pn * 256 + wc * 32 + 4 * fq;
        f32x4 gv[2][2];
#pragma unroll
        for (int bj = 0; bj < 2; ++bj)
#pragma unroll
            for (int n = 0; n < 2; ++n) gv[bj][n] = *(const f32x4*)(g1 + col0 + bj * 128 + n * 16);
#pragma unroll
        for (int ai = 0; ai < 2; ++ai)
#pragma unroll
            for (int m = 0; m < 4; ++m) { float* rowp = (float*)(ws + WS_X) + (size_t)(u.pm * 256 + ai * 128 + wr * 64 + m * 16 + fr) * DM + col0;
#pragma unroll
                for (int bj = 0; bj < 2; ++bj)
#pragma unroll
                    for (int n = 0; n < 2; ++n) { f32x4* p = (f32x4*)(rowp + bj * 128 + n * 16); *p = *p * ALPHA + gv[bj][n] * acc[ai][bj][m][n]; } }
    }
};

struct MoeTab { LAS int* cnt; LAS int* tstart; LAS int* tile_e; int ntiles; };
DI MoeTab moe_tables(const Frame& F, int ly) {
    MoeTab T; T.cnt = (LAS int*)(F.lds + LDS_TAB); T.tstart = T.cnt + 72; T.tile_e = T.tstart + 72;
    __syncthreads();
    if (F.tid < 65) T.cnt[F.tid] = F.tid < NEXP ? (int)__hip_atomic_load(F.ctl + CW_CNT + 64 * ly + F.tid, __ATOMIC_RELAXED, __HIP_MEMORY_SCOPE_AGENT) : RTOT;
    __syncthreads();
    if (F.tid == 0) { int s = 0; for (int e = 0; e < 65; ++e) { T.tstart[e] = s; s += (T.cnt[e] + 255) >> 8; } T.tstart[65] = s; }
    __syncthreads();
    const int nt = T.tstart[65];
    for (int e = F.tid; e < 65; e += NTHR) for (int q = T.tstart[e]; q < T.tstart[e + 1]; ++q) if (q < MAXTILES) T.tile_e[q] = e;
    __syncthreads();
    T.ntiles = nt < MAXTILES ? nt : MAXTILES;
    return T;
}
template <bool GATHER_> struct MoeSched {
    static constexpr bool GATHER = GATHER_;
    MoeTab T; const int* list; int G, c, nsub, shift;
    DI bool next(int i, pg8::Unit& u) const {
        const long L = (long)i * G + c; if (L >= (long)T.ntiles * nsub) return false;
        const int tile = (int)(L >> shift), j = (int)L & (nsub - 1); const int e = T.tile_e[tile];
        u.pm = tile; u.pn = e * nsub + j; u.e = e; u.lt = tile - T.tstart[e]; return true;
    }
    DI int arow(const pg8::Unit& u, int r) const {
        if (!GATHER_) return u.pm * 256 + r;
        const int idx = u.lt * 256 + r;
        if (u.e == NEXP) return idx;
        return idx < T.cnt[u.e] ? (list[(size_t)u.e * RTOT + idx] >> 3) : 0;
    }
};
DI float silu_f(float x) { return x / (1.f + __expf(-x)); }
struct EpiMoe1 {
    static constexpr bool PERM = true;
    unsigned char* ws;
    DI void operator()(const f32x4 (&acc)[2][2][4][2], const pg8::Unit& u, int wr, int wc, int fr, int fq) const {
        const int hid = (u.pn & 1) * 128 + wc * 32 + fq * 8;
#pragma unroll
        for (int ai = 0; ai < 2; ++ai)
#pragma unroll
            for (int m = 0; m < 4; ++m) { const size_t row = (size_t)u.pm * 256 + ai * 128 + wr * 64 + m * 16 + fr;
                float o[8];
#pragma unroll
                for (int n = 0; n < 2; ++n)
#pragma unroll
                    for (int e = 0; e < 4; ++e) o[n * 4 + e] = silu_f(acc[ai][0][m][n][e]) * acc[ai][1][m][n][e];
                u32x4 w; w.x = cvt_pk_bf16(o[0], o[1]); w.y = cvt_pk_bf16(o[2], o[3]); w.z = cvt_pk_bf16(o[4], o[5]); w.w = cvt_pk_bf16(o[6], o[7]);
                *(u32x4*)((bf16_t*)(ws + WS_ACT) + row * DEXP + hid) = w; }
    }
};
struct EpiMoe2 {
    static constexpr bool PERM = true;
    unsigned char* ws; MoeTab T; const int* list;
    DI void operator()(const f32x4 (&acc)[2][2][4][2], const pg8::Unit& u, int wr, int wc, int fr, int fq) const {
        const int colb = (u.pn & 3) * 256 + wc * 32 + fq * 8; const int cnt = T.cnt[u.e];
#pragma unroll
        for (int ai = 0; ai < 2; ++ai)
#pragma unroll
            for (int m = 0; m < 4; ++m) { const int idx = u.lt * 256 + ai * 128 + wr * 64 + m * 16 + fr;
                long dest = -1;
                if (u.e == NEXP) dest = (long)idx * 9 + 8;
                else if (idx < cnt) { const int id = list[(size_t)u.e * RTOT + idx]; dest = (long)(id >> 3) * 9 + (id & 7); }
                if (dest >= 0) {
#pragma unroll
                    for (int bj = 0; bj < 2; ++bj) { const f32x4 v0 = acc[ai][bj][m][0], v1 = acc[ai][bj][m][1];
                        u32x4 w; w.x = cvt_pk_bf16(v0[0], v0[1]); w.y = cvt_pk_bf16(v0[2], v0[3]); w.z = cvt_pk_bf16(v1[0], v1[1]); w.w = cvt_pk_bf16(v1[2], v1[3]);
                        *(u32x4*)((bf16_t*)(ws + WS_YB) + (size_t)dest * DM + colb + bj * 128) = w; } } }
    }
};

DI float hy_short(const float* hy, int l, int Lx, float w0, float w1, float w2) {
    const float a = l > 0 ? hy[l - 1] : 0.f, b = hy[l], c = l + 1 < Lx ? hy[l + 1] : 0.f;
    return w0 * a + w1 * b + w2 * c;
}
DI void hyena_unit(const Frame& F, int ly, int c) {
    LAS float* KF = (LAS float*)F.lds;
    LAS float* U = KF + 16384;
    const int t = F.tid;
    const float* HYT = (const float*)(F.ws + WS_HYT);
    const float* scw = F.in[8] + (size_t)ly * 3 * 768;
    const float* invl = (const float*)(F.ws + WS_INVL1) + (size_t)ly * 1024;
    const float bias0 = F.in[15][(size_t)ly * 512 + c], bias1 = F.in[15][(size_t)ly * 512 + 256 + c];
    float wx1[3], wx2[3], wv[3];
#pragma unroll
    for (int j = 0; j < 3; ++j) { wx1[j] = scw[j * 768 + c]; wx2[j] = scw[j * 768 + 256 + c]; wv[j] = scw[j * 768 + 512 + c]; }
    bf16_t* MIX = (bf16_t*)(F.ws + WS_MIX);
    {
        for (int n = 0; n < 2; ++n) { const float inv = invl[(0 * 2 + n) * 256 + c];
            const float* hf = (const float*)(F.ws + WS_HCL) + ((((size_t)ly * 2 + n) * 2 + 0) * 256 + c) * SEQ;
            const float* hb = (const float*)(F.ws + WS_HCL) + ((((size_t)ly * 2 + n) * 2 + 1) * 256 + c) * SEQ;
            for (int i = t; i < 8192; i += NTHR) { const int d = i - 4096; KF[n * 8192 + i] = d >= 0 ? hf[d] * inv : (d > -4096 ? hb[-d] * inv : 0.f); } }
        for (int i = t; i < 4 * SEQ; i += NTHR) { const int b = i >> 12, l = i & 4095;
            U[l * 4 + b] = hy_short(HYT + ((size_t)b * 768 + 512 + c) * POS, l, SEQ, wv[0], wv[1], wv[2]); }
        __syncthreads();
        const int t0 = t * 8;
        for (int n = 0; n < 2; ++n) {
            f32x4 acc[8];
#pragma unroll
            for (int j = 0; j < 8; ++j) acc[j] = (f32x4){0.f, 0.f, 0.f, 0.f};
            const LAS float* kf = KF + n * 8192;
#pragma unroll 1
            for (int s0 = 0; s0 < SEQ; s0 += 8) {
                const int base = t0 - s0 + 4088;
                float kw[16];
#pragma unroll
                for (int q = 0; q < 4; ++q) { const f32x4 x = *(const LAS f32x4*)(kf + base + 4 * q); kw[4 * q] = x[0]; kw[4 * q + 1] = x[1]; kw[4 * q + 2] = x[2]; kw[4 * q + 3] = x[3]; }
#pragma unroll
                for (int i = 0; i < 8; ++i) { const f32x4 uv = *(const LAS f32x4*)(U + (s0 + i) * 4);
#pragma unroll
                    for (int j = 0; j < 8; ++j) acc[j] += uv * kw[8 + j - i]; }
            }
            float zo[8][4];
            const int xch = n == 0 ? c : 256 + c; const float* wg = n == 0 ? wx1 : wx2; const float bias = n == 0 ? bias0 : bias1;
#pragma unroll
            for (int b = 0; b < 4; ++b) {
                const float* hp = HYT + ((size_t)b * 768 + xch) * POS;
                const f32x4 h0 = *(const f32x4*)(hp + t0), h1 = *(const f32x4*)(hp + t0 + 4);
                const float hm = t0 > 0 ? hp[t0 - 1] : 0.f, hn = t0 + 8 < SEQ ? hp[t0 + 8] : 0.f;
                const float hv[10] = {hm, h0[0], h0[1], h0[2], h0[3], h1[0], h1[1], h1[2], h1[3], hn};
#pragma unroll
                for (int j = 0; j < 8; ++j) { const float g = wg[0] * hv[j] + wg[1] * hv[j + 1] + wg[2] * hv[j + 2];
                    zo[j][b] = g * (acc[j][b] + bias * U[(t0 + j) * 4 + b]); }
            }
            __syncthreads();
            if (n == 0) {
#pragma unroll
                for (int j = 0; j < 8; ++j) *(LAS f32x4*)(U + (t0 + j) * 4) = (f32x4){zo[j][0], zo[j][1], zo[j][2], zo[j][3]};
                __syncthreads();
            } else {
#pragma unroll
                for (int j = 0; j < 8; ++j)
#pragma unroll
                    for (int b = 0; b < 4; ++b) MIX[((size_t)b * SEQ + t0 + j) * DM + c] = f2bf(zo[j][b]);
            }
        }
    }
    __syncthreads();
    {
        LAS float* KC = (LAS float*)F.lds;
        LAS float* UC = KC + 1024;
        for (int n = 0; n < 2; ++n) { const float inv = invl[(1 * 2 + n) * 256 + c];
            const float* hf = (const float*)(F.ws + WS_HCC) + ((((size_t)ly * 2 + n) * 2 + 0) * 256 + c) * CTXL;
            const float* hb = (const float*)(F.ws + WS_HCC) + ((((size_t)ly * 2 + n) * 2 + 1) * 256 + c) * CTXL;
            for (int i = t; i < 512; i += NTHR) { const int d = i - 256; KC[n * 512 + i] = d >= 0 ? hf[d] * inv : (d > -256 ? hb[-d] * inv : 0.f); } }
        for (int i = t; i < 4 * CTXL; i += NTHR) { const int b = i >> 8, l = i & 255;
            UC[l * 4 + b] = hy_short(HYT + ((size_t)b * 768 + 512 + c) * POS + SEQ, l, CTXL, wv[0], wv[1], wv[2]); }
        __syncthreads();
        const int tt = t & 255, bp = t >> 8;
        for (int n = 0; n < 2; ++n) {
            float a0 = 0.f, a1 = 0.f;
            for (int s = 0; s < CTXL; ++s) { const float k = KC[n * 512 + tt - s + 256]; a0 += k * UC[s * 4 + 2 * bp]; a1 += k * UC[s * 4 + 2 * bp + 1]; }
            const int xch = n == 0 ? c : 256 + c; const float* wg = n == 0 ? wx1 : wx2; const float bias = n == 0 ? bias0 : bias1;
            const float g0 = hy_short(HYT + ((size_t)(2 * bp) * 768 + xch) * POS + SEQ, tt, CTXL, wg[0], wg[1], wg[2]);
            const float g1 = hy_short(HYT + ((size_t)(2 * bp + 1) * 768 + xch) * POS + SEQ, tt, CTXL, wg[0], wg[1], wg[2]);
            const float z0 = g0 * (a0 + bias * UC[tt * 4 + 2 * bp]), z1 = g1 * (a1 + bias * UC[tt * 4 + 2 * bp + 1]);
            __syncthreads();
            if (n == 0) { UC[tt * 4 + 2 * bp] = z0; UC[tt * 4 + 2 * bp + 1] = z1; __syncthreads(); }
            else { MIX[((size_t)RLAT + (2 * bp) * CTXL + tt) * DM + c] = f2bf(z0); MIX[((size_t)RLAT + (2 * bp + 1) * CTXL + tt) * DM + c] = f2bf(z1); }
        }
    }
    __syncthreads();
}

DI void attn_unit(const Frame& F, int ly, int uid, float lam, float out_scale) {
    const int t = F.tid, lane = F.lane, wave = F.wave;
    LAS unsigned char* L = F.lds;
    constexpr int KOFF = 0, VOFF = 16384, RED = 32768;
    int bh, q0, k_lo, k_hi;
    if (uid < 512) { bh = uid >> 4; q0 = (uid & 15) << 8; k_lo = 0; k_hi = POS; }
    else { bh = uid - 512; q0 = SEQ; k_lo = SEQ; k_hi = POS; }
    const bf16_t* Qg = (const bf16_t*)(F.ws + WS_Q) + (size_t)bh * POS * 64;
    const bf16_t* Kg = (const bf16_t*)(F.ws + WS_K) + (size_t)bh * POS * 64;
    const bf16_t* Vg = (const bf16_t*)(F.ws + WS_V) + (size_t)bh * POS * 64;
    const int qi = lane & 31, hh = lane >> 5;
    const int qpos = q0 + wave * 32 + qi;
    bf16x8 qf[2][2];
    float q2[2] = {0.f, 0.f};
#pragma unroll
    for (int comp = 0; comp < 2; ++comp)
#pragma unroll
        for (int ks = 0; ks < 2; ++ks) { qf[comp][ks] = *(const bf16x8*)(Qg + (size_t)qpos * 64 + comp * 32 + ks * 16 + hh * 8);
#pragma unroll
            for (int j = 0; j < 8; ++j) { const float x = bf2f((unsigned short)qf[comp][ks][j]); q2[comp] += x * x; } }
    q2[0] += __shfl_xor(q2[0], 32); q2[1] += __shfl_xor(q2[1], 32);
    float km = 0.f;
    for (int key = k_lo + (t >> 3); key < k_hi; key += 64) {
        const bf16x8 kv = *(const bf16x8*)(Kg + (size_t)key * 64 + (t & 7) * 8);
        float s = 0.f;
#pragma unroll
        for (int j = 0; j < 8; ++j) { const float x = bf2f((unsigned short)kv[j]); s += x * x; }
        s += __shfl_xor(s, 1); s += __shfl_xor(s, 2);
        km = fmaxf(km, s);
    }
    km = fmaxf(km, __shfl_xor(km, 8)); km = fmaxf(km, __shfl_xor(km, 16)); km = fmaxf(km, __shfl_xor(km, 32));
    __syncthreads();
    LAS float* red = (LAS float*)(L + RED);
    if (lane == 0) red[wave * 2] = km; if (lane == 4) red[wave * 2 + 1] = km;
    __syncthreads();
    float kmax2[2] = {0.f, 0.f};
#pragma unroll
    for (int w = 0; w < 8; ++w) { kmax2[0] = fmaxf(kmax2[0], red[w * 2]); kmax2[1] = fmaxf(kmax2[1], red[w * 2 + 1]); }
    f32x16 negm[2];
#pragma unroll
    for (int comp = 0; comp < 2; ++comp) { const float m = -sqrtf(q2[comp] * kmax2[comp]) * 1.0001f;
#pragma unroll
        for (int i = 0; i < 16; ++i) negm[comp][i] = m; }
    f32x16 O[2][2];
#pragma unroll
    for (int a = 0; a < 2; ++a)
#pragma unroll
        for (int b = 0; b < 2; ++b)
#pragma unroll
            for (int i = 0; i < 16; ++i) O[a][b][i] = 0.f;
    float lsum[2] = {0.f, 0.f};
    const int sk = t >> 3, sc = t & 7;
    const unsigned kst = (unsigned)(sk * 128 + ((sc ^ ((sk >> 1) & 7)) << 4));
    const unsigned vst = (unsigned)(sk * 128 + ((((sc >> 1) ^ (sk & 3))) << 5) + ((sc & 1) << 4));
    const int ntile = (k_hi - k_lo) >> 6;
    u32x4 kreg = *(const u32x4*)(Kg + (size_t)(k_lo + sk) * 64 + sc * 8);
    u32x4 vreg = *(const u32x4*)(Vg + (size_t)(k_lo + sk) * 64 + sc * 8);
    *(LAS u32x4*)(L + KOFF + kst) = kreg; *(LAS u32x4*)(L + VOFF + vst) = vreg;
    __syncthreads();
    const int p4 = lane & 3, q4 = (lane & 15) >> 2, blk = (lane >> 4) & 1;
    for (int it = 0; it < ntile; ++it) {
        const int buf = it & 1;
        if (it + 1 < ntile) { const size_t kk = (size_t)(k_lo + (it + 1) * 64 + sk) * 64 + sc * 8; kreg = *(const u32x4*)(Kg + kk); vreg = *(const u32x4*)(Vg + kk); }
        const unsigned kb_base = KOFF + buf * 8192, vb_base = VOFF + buf * 8192;
#pragma unroll 1
        for (int kb = 0; kb < 2; ++kb) {
            bf16x8 vf[2][2];
            {
                const int keyq = 4 * hh + q4;
                const unsigned a0 = vb_base + (unsigned)((kb * 32 + keyq) * 128) + (unsigned)((((0 + blk) ^ (keyq & 3))) << 5) + (unsigned)(p4 * 8);
                const unsigned a1 = vb_base + (unsigned)((kb * 32 + keyq) * 128) + (unsigned)((((2 + blk) ^ (keyq & 3))) << 5) + (unsigned)(p4 * 8);
                s16x4 r0, r1, r2, r3, r4, r5, r6, r7;
                asm volatile("ds_read_b64_tr_b16 %0, %8\n\tds_read_b64_tr_b16 %1, %8 offset:1024\n\tds_read_b64_tr_b16 %2, %8 offset:2048\n\tds_read_b64_tr_b16 %3, %8 offset:3072\n\t"
                             "ds_read_b64_tr_b16 %4, %9\n\tds_read_b64_tr_b16 %5, %9 offset:1024\n\tds_read_b64_tr_b16 %6, %9 offset:2048\n\tds_read_b64_tr_b16 %7, %9 offset:3072\n\ts_waitcnt lgkmcnt(0)"
                             : "=&v"(r0), "=&v"(r1), "=&v"(r2), "=&v"(r3), "=&v"(r4), "=&v"(r5), "=&v"(r6), "=&v"(r7) : "v"(a0), "v"(a1) : "memory");
                vf[0][0] = __builtin_shufflevector(r0, r1, 0, 1, 2, 3, 4, 5, 6, 7); vf[1][0] = __builtin_shufflevector(r2, r3, 0, 1, 2, 3, 4, 5, 6, 7);
                vf[0][1] = __builtin_shufflevector(r4, r5, 0, 1, 2, 3, 4, 5, 6, 7); vf[1][1] = __builtin_shufflevector(r6, r7, 0, 1, 2, 3, 4, 5, 6, 7);
            }
#pragma unroll
            for (int comp = 0; comp < 2; ++comp) {
                const int key = kb * 32 + qi;
                const bf16x8 k0 = *(const LAS bf16x8*)(L + kb_base + key * 128 + (((comp * 4 + 0 + hh) ^ ((key >> 1) & 7)) << 4));
                const bf16x8 k1 = *(const LAS bf16x8*)(L + kb_base + key * 128 + (((comp * 4 + 2 + hh) ^ ((key >> 1) & 7)) << 4));
                f32x16 S = __builtin_amdgcn_mfma_f32_32x32x16_bf16(k0, qf[comp][0], negm[comp], 0, 0, 0);
                S = __builtin_amdgcn_mfma_f32_32x32x16_bf16(k1, qf[comp][1], S, 0, 0, 0);
                float ps = 0.f;
#pragma unroll
                for (int i = 0; i < 16; ++i) { S[i] = __builtin_amdgcn_exp2f(S[i]); ps += S[i]; }
                lsum[comp] += ps;
#pragma unroll
                for (int s = 0; s < 2; ++s) {
                    const bf16x8 pf = pack8(S[8 * s], S[8 * s + 1], S[8 * s + 2], S[8 * s + 3], S[8 * s + 4], S[8 * s + 5], S[8 * s + 6], S[8 * s + 7]);
                    O[comp][0] = __builtin_amdgcn_mfma_f32_32x32x16_bf16(vf[s][0], pf, O[comp][0], 0, 0, 0);
                    O[comp][1] = __builtin_amdgcn_mfma_f32_32x32x16_bf16(vf[s][1], pf, O[comp][1], 0, 0, 0);
                }
            }
        }
        if (it + 1 < ntile) { *(LAS u32x4*)(L + KOFF + (buf ^ 1) * 8192 + kst) = kreg; *(LAS u32x4*)(L + VOFF + (buf ^ 1) * 8192 + vst) = vreg; }
        __syncthreads();
    }
    const float l0 = lsum[0] + __shfl_xor(lsum[0], 32), l1 = lsum[1] + __shfl_xor(lsum[1], 32);
    const float i0 = 1.0f / l0, i1 = lam / l1;
    float ss = 0.f;
#pragma unroll
    for (int dvb = 0; dvb < 2; ++dvb)
#pragma unroll
        for (int i = 0; i < 16; ++i) { const float o = O[0][dvb][i] * i0 - O[1][dvb][i] * i1; O[0][dvb][i] = o; ss += o * o; }
    ss += __shfl_xor(ss, 32);
    const float rn = rsqrtf(ss * (1.0f / 64.0f) + LN_EPS) * out_scale;
    const float* sw = F.in[20] + (size_t)ly * 64;
    const int b = bh >> 3, head = bh & 7;
    const size_t row = qpos < SEQ ? (size_t)b * SEQ + qpos : (size_t)RLAT + b * CTXL + (qpos - SEQ);
    bf16_t* dst = (bf16_t*)(F.ws + WS_MIX) + row * DM + 256 + head * 64;
#pragma unroll
    for (int dvb = 0; dvb < 2; ++dvb)
#pragma unroll
        for (int g = 0; g < 4; ++g) { const int dv = dvb * 32 + 8 * g + 4 * hh;
            const f32x4 w4 = *(const f32x4*)(sw + dv);
            u32x2 w; w.x = cvt_pk_bf16(O[0][dvb][4 * g] * rn * w4[0], O[0][dvb][4 * g + 1] * rn * w4[1]); w.y = cvt_pk_bf16(O[0][dvb][4 * g + 2] * rn * w4[2], O[0][dvb][4 * g + 3] * rn * w4[3]);
            *(u32x2*)(dst + dv) = w; }
    __syncthreads();
}

DI void phase_rows_router(const Frame& F, int ly) {
    LAS float* HS = (LAS float*)F.lds;
    LAS float* PART = HS + 16 * 1024;
    LAS float* LOG = PART + 8 * 16 * 64;
    const int lane = F.lane, wave = F.wave;
    const float* MOD = (const float*)(F.ws + WS_MOD);
    const float* g1 = F.in[22] + (size_t)ly * DM; const float* b1 = F.in[23] + (size_t)ly * DM;
    const float* rw = F.in[26] + (size_t)ly * DM * NEXP; const float* rb = F.in[27] + (size_t)ly * NEXP;
    const bool last = ly == DEPTH - 1;
    const int nrows = last ? RLAT : RTOT;
    for (int r0 = F.bid * 16; r0 < nrows; r0 += F.G * 16) {
#pragma unroll
        for (int rr = 0; rr < 2; ++rr) { const int rl = wave * 2 + rr, row = r0 + rl;
            float* xr = (float*)(F.ws + WS_X) + (size_t)row * DM;
            f32x4 v[4];
#pragma unroll
            for (int j = 0; j < 4; ++j) v[j] = *(const f32x4*)(xr + 4 * lane + 256 * j);
            float mu, rstd; ln_stats(v, mu, rstd);
#pragma unroll
            for (int j = 0; j < 4; ++j) { const int c = 4 * lane + 256 * j; const f32x4 g = *(const f32x4*)(g1 + c), bb = *(const f32x4*)(b1 + c);
#pragma unroll
                for (int e = 0; e < 4; ++e) v[j][e] = (v[j][e] - mu) * rstd * g[e] + bb[e];
                *(f32x4*)(xr + c) = v[j]; }
            ln_stats(v, mu, rstd);
            const float* m = MOD + ((size_t)ly * 5 + row_modsel(row)) * 6144;
            bf16_t* hrow = (bf16_t*)(F.ws + WS_H) + (size_t)row * DM;
#pragma unroll
            for (int j = 0; j < 4; ++j) { const int c = 4 * lane + 256 * j; const f32x4 a = *(const f32x4*)(m + 3072 + c), bsc = *(const f32x4*)(m + 4096 + c);
                f32x4 o;
#pragma unroll
                for (int e = 0; e < 4; ++e) o[e] = (v[j][e] - mu) * rstd * (1.f + bsc[e]) + a[e];
                u32x2 w; w.x = cvt_pk_bf16(o[0], o[1]); w.y = cvt_pk_bf16(o[2], o[3]); *(u32x2*)(hrow + c) = w;
                *(LAS f32x4*)(HS + rl * 1024 + c) = o; } }
        __syncthreads();
        { float acc[16];
#pragma unroll
          for (int r = 0; r < 16; ++r) acc[r] = 0.f;
          for (int k4 = 0; k4 < 32; ++k4) { const int k = wave * 128 + k4 * 4;
              const float w0 = rw[(size_t)(k + 0) * NEXP + lane], w1 = rw[(size_t)(k + 1) * NEXP + lane], w2 = rw[(size_t)(k + 2) * NEXP + lane], w3 = rw[(size_t)(k + 3) * NEXP + lane];
#pragma unroll
              for (int r = 0; r < 16; ++r) { const f32x4 h = *(const LAS f32x4*)(HS + r * 1024 + k); acc[r] += h[0] * w0 + h[1] * w1 + h[2] * w2 + h[3] * w3; } }
#pragma unroll
          for (int r = 0; r < 16; ++r) PART[(wave * 16 + r) * 64 + lane] = acc[r]; }
        __syncthreads();
#pragma unroll
        for (int rr = 0; rr < 2; ++rr) { const int rl = wave * 2 + rr, row = r0 + rl;
            float lg = 0.f;
#pragma unroll
            for (int w = 0; w < 8; ++w) lg += PART[(w * 16 + rl) * 64 + lane];
            const float s = 1.0f / (1.0f + expf(-lg));
            const float sel = s + rb[lane];
            float m1 = sel;
            m1 = fmaxf(m1, __shfl_xor(m1, 1)); m1 = fmaxf(m1, __shfl_xor(m1, 2)); m1 = fmaxf(m1, __shfl_xor(m1, 4));
            const unsigned long long bal = __ballot(sel == m1);
            const int gbase = lane & ~7;
            const unsigned gmask = (unsigned)((bal >> gbase) & 0xffull);
            const int first = gbase + __builtin_ctz(gmask);
            float m2 = (lane == first) ? -INFINITY : sel;
            m2 = fmaxf(m2, __shfl_xor(m2, 1)); m2 = fmaxf(m2, __shfl_xor(m2, 2)); m2 = fmaxf(m2, __shfl_xor(m2, 4));
            const float gs = m1 + m2;
            const int mygrp = lane >> 3;
            int grank = 0;
#pragma unroll
            for (int g = 0; g < 8; ++g) { const float o = __shfl(gs, g * 8); grank += (o > gs || (o == gs && g < mygrp)) ? 1 : 0; }
            const float msel = grank < 4 ? sel : -INFINITY;
            int rank = 0;
            for (int e = 0; e < 64; ++e) { const float o = __shfl(msel, e); rank += (o > msel || (o == msel && e < lane)) ? 1 : 0; }
            const bool chosen = rank < 8;
            const float wsum = wave_sum(chosen ? s : 0.f);
            if (chosen) { const float gate = s / wsum * 2.5f;
                ((int*)(F.ws + WS_TOPE))[(size_t)row * 8 + rank] = lane;
                ((float*)(F.ws + WS_TOPG))[(size_t)row * 8 + rank] = gate;
                const unsigned p = atomicAdd(F.ctl + CW_CNT + 64 * ly + lane, 1u);
                ((int*)(F.ws + WS_LIST))[(size_t)lane * RTOT + p] = row * 8 + rank; } }
        __syncthreads();
    }
}

DI void phase_combine(const Frame& F, int ly) {
    const int gw = F.bid * 8 + F.wave, nw = F.G * 8, lane = F.lane;
    const bool last = ly == DEPTH - 1;
    const int nrows = last ? RLAT : RTOT;
    const float* MOD = (const float*)(F.ws + WS_MOD);
    const float* g2w = F.in[24] + (size_t)ly * DM; const float* b2w = F.in[25] + (size_t)ly * DM;
    const bf16_t* YB = (const bf16_t*)(F.ws + WS_YB);
    for (int row = gw; row < nrows; row += nw) {
        const float* gates = (const float*)(F.ws + WS_TOPG) + (size_t)row * 8;
        float gt[8];
#pragma unroll
        for (int s = 0; s < 8; ++s) gt[s] = gates[s];
        f32x4 y[4];
#pragma unroll
        for (int j = 0; j < 4; ++j) { const u32x2 w = *(const u32x2*)(YB + ((size_t)row * 9 + 8) * DM + 4 * lane + 256 * j); y[j] = (f32x4){bflo(w.x), bfhi(w.x), bflo(w.y), bfhi(w.y)}; }
#pragma unroll
        for (int s = 0; s < 8; ++s)
#pragma unroll
            for (int j = 0; j < 4; ++j) { const u32x2 w = *(const u32x2*)(YB + ((size_t)row * 9 + s) * DM + 4 * lane + 256 * j);
                y[j] += (f32x4){bflo(w.x), bfhi(w.x), bflo(w.y), bfhi(w.y)} * gt[s]; }
        const float* m = MOD + ((size_t)ly * 5 + row_modsel(row)) * 6144;
        float* xr = (float*)(F.ws + WS_X) + (size_t)row * DM;
        f32x4 v[4];
#pragma unroll
        for (int j = 0; j < 4; ++j) { const int c = 4 * lane + 256 * j; const f32x4 x = *(const f32x4*)(xr + c), g2 = *(const f32x4*)(m + 5120 + c); v[j] = x * ALPHA + g2 * y[j]; }
        float mu, rstd; ln_stats(v, mu, rstd);
#pragma unroll
        for (int j = 0; j < 4; ++j) { const int c = 4 * lane + 256 * j; const f32x4 g = *(const f32x4*)(g2w + c), bb = *(const f32x4*)(b2w + c);
#pragma unroll
            for (int e = 0; e < 4; ++e) v[j][e] = (v[j][e] - mu) * rstd * g[e] + bb[e];
            if (last) *(f32x4*)(F.out + (size_t)row * DM + c) = v[j]; else *(f32x4*)(xr + c) = v[j]; }
        if (!last) { const float* mn = MOD + ((size_t)(ly + 1) * 5 + row_modsel(row)) * 6144;
            ln_mod_store(v, mn, mn + 1024, (bf16_t*)(F.ws + WS_H) + (size_t)row * DM, lane); }
    }
}


DI Frame relaunder(const Frame& F0) {
    Frame F = F0; int t = threadIdx.x; asm volatile("" : "+v"(t)); F.tid = t; F.lane = t & 63; F.wave = __builtin_amdgcn_readfirstlane(t >> 6);
    unsigned char* w = F0.ws; asm volatile("" : "+s"(w)); F.ws = w; F.ctl = (unsigned*)(w + WS_CTL);
    int b = F0.bid, g = F0.G; asm volatile("" : "+s"(b), "+s"(g)); F.bid = b; F.G = g;
    return F;
}
PHASE_FN void ph_pre0(const Frame& F0) { const Frame F = relaunder(F0); prep_weights(F, 0); prep_mod(F); prep_filters(F); prep_tables(F); prep_copy_x(F); }
PHASE_FN void ph_pre1(const Frame& F0) { const Frame F = relaunder(F0); prep_invl1(F); phase_init_h(F); }
PHASE_FN void ph_win(const Frame& F0) { const Frame F = relaunder(F0);
    pg8::Gemm g{(const bf16_t*)(F.ws + WS_H), (const bf16_t*)(F.ws + WS_WIN), DM};
    pg8::StaticOrder S; S.init(RTOT / 256, NWIN / 256, F.G, F.bid);
    EpiWin E{F.ws};
    pg8::gemm_phase<EpiWin, pg8::StaticOrder>(F.lds, g, S, E);
}
PHASE_FN void ph_fnet(const Frame& F0) { const Frame F = relaunder(F0);
    { pg8::Gemm g{(const bf16_t*)(F.ws + WS_DFTL), (const bf16_t*)(F.ws + WS_YTL), 2 * SEQ};
      pg8::StaticOrder S; S.init(SEQ / 256, 4, F.G, F.bid);
      EpiFnet E{F.ws, 0};
      pg8::gemm_phase<EpiFnet, pg8::StaticOrder>(F.lds, g, S, E); }
    { pg8::Gemm g{(const bf16_t*)(F.ws + WS_DFTC), (const bf16_t*)(F.ws + WS_YTC), 2 * CTXL};
      pg8::StaticOrder S; S.init(1, 4, F.G, (F.bid + F.G - 64) % F.G);
      EpiFnet E{F.ws, 1};
      pg8::gemm_phase<EpiFnet, pg8::StaticOrder>(F.lds, g, S, E); }
    __syncthreads();
}
PHASE_FN void ph_hyena(const Frame& F0, int ly) { const Frame F = relaunder(F0); for (int c = F.bid; c < 256; c += F.G) hyena_unit(F, ly, c); }
PHASE_FN void ph_attn(const Frame& F0, int ly) { const Frame F = relaunder(F0);
    volatile LAS unsigned* MISC = (volatile LAS unsigned*)(F.lds + LDS_MISC);
    const float lam_init = 0.8f - 0.6f * expf(-0.3f * (float)ly);
    float lam;
    { float s1 = 0.f, s2 = 0.f;
      for (int i = 0; i < 32; ++i) { s1 += F.in[16][ly * 32 + i] * F.in[17][ly * 32 + i]; s2 += F.in[18][ly * 32 + i] * F.in[19][ly * 32 + i]; }
      lam = expf(s1) - expf(s2) + lam_init; }
    for (;;) {
        __syncthreads();
        if (F.tid == 0) MISC[16] = atomicAdd(F.ctl + CW_ATTN + 64 * ly, 1u);
        __syncthreads();
        const int uid = (int)MISC[16];
        if (uid >= 544) break;
        attn_unit(F, ly, uid, lam, 1.0f - lam_init);
    }
}
PHASE_FN void ph_wout(const Frame& F0, int ly) { const Frame F = relaunder(F0);
    pg8::Gemm g{(const bf16_t*)(F.ws + WS_MIX), (const bf16_t*)(F.ws + WS_WOUT), DM};
    pg8::StaticOrder S; S.init(RTOT / 256, DM / 256, F.G, F.bid);
    EpiWout E{F.ws, ly};
    pg8::gemm_phase<EpiWout, pg8::StaticOrder>(F.lds, g, S, E);
}
PHASE_FN void ph_router(const Frame& F0, int ly) { const Frame F = relaunder(F0); phase_rows_router(F, ly); }
PHASE_FN void ph_moe1(const Frame& F0, int ly) { const Frame F = relaunder(F0);
    const MoeTab T = moe_tables(F, ly);
    pg8::Gemm g{(const bf16_t*)(F.ws + WS_H), (const bf16_t*)(F.ws + WS_WGU), DM};
    MoeSched<true> S{T, (const int*)(F.ws + WS_LIST), F.G, F.bid, 2, 1};
    EpiMoe1 E{F.ws};
    pg8::gemm_phase<EpiMoe1, MoeSched<true>>(F.lds, g, S, E);
}
PHASE_FN void ph_moe2(const Frame& F0, int ly) { const Frame F = relaunder(F0);
    const MoeTab T = moe_tables(F, ly);
    pg8::Gemm g{(const bf16_t*)(F.ws + WS_ACT), (const bf16_t*)(F.ws + WS_WD), DEXP};
    MoeSched<false> S{T, (const int*)(F.ws + WS_LIST), F.G, F.bid, 4, 2};
    EpiMoe2 E{F.ws, T, (const int*)(F.ws + WS_LIST)};
    pg8::gemm_phase<EpiMoe2, MoeSched<false>>(F.lds, g, S, E);
}
PHASE_FN void ph_combine(const Frame& F0, int ly) { const Frame F = relaunder(F0); phase_combine(F, ly); if (ly + 1 < DEPTH) prep_weights(F, ly + 1); }

constexpr int PH_PER_LAYER = 7, N_PHASES = 2 + DEPTH * PH_PER_LAYER;

__global__ void __launch_bounds__(NTHR, 2) hybrid_fwd(Params prm) {
    extern __shared__ __attribute__((aligned(16))) unsigned char lds_raw[];
    Frame F;
    F.in = prm.in; F.out = prm.out; F.ws = prm.ws; F.lds = (LAS unsigned char*)lds_raw; F.ctl = (unsigned*)(prm.ws + WS_CTL);
    F.tid = threadIdx.x; F.lane = F.tid & 63; F.wave = __builtin_amdgcn_readfirstlane(F.tid >> 6); F.G = gridDim.x; F.bid = blockIdx.x;
    volatile LAS unsigned* MISC = (volatile LAS unsigned*)(F.lds + LDS_MISC);
    if (F.tid < 64) MISC[F.tid] = 0u;
    __syncthreads();
    const int lo = prm.ph_lo, hi = prm.ph_hi;
    XcdBarrier bar; bar.bar = F.ctl + CW_BAR; bar.x = 0; bar.st = nullptr;
    if (hi - lo > 1) bar = xcd_barrier_post(F.ctl + CW_BAR, MISC);
#define IN(k) (lo <= (k) && (k) < hi)
#define SEAM(k) do { if (IN(k) && IN((k) + 1)) xcd_barrier(bar); } while (0)

    if (IN(0) && KIND(0)) ph_pre0(F);
    SEAM(0);
    if (IN(1) && KIND(1)) ph_pre1(F);
    SEAM(1);

    for (int ly = 0; ly < DEPTH; ++ly) {
        const int p0 = 2 + ly * PH_PER_LAYER;
        if (IN(p0) && KIND(2)) ph_win(F);
        SEAM(p0);
        if (IN(p0 + 1)) { if (KIND(3)) ph_fnet(F); if (KIND(4)) ph_hyena(F, ly); if (KIND(5)) ph_attn(F, ly); }
        SEAM(p0 + 1);
        if (IN(p0 + 2) && KIND(6)) ph_wout(F, ly);
        SEAM(p0 + 2);
        if (IN(p0 + 3) && KIND(7)) ph_router(F, ly);
        SEAM(p0 + 3);
        if (IN(p0 + 4) && KIND(8)) ph_moe1(F, ly);
        SEAM(p0 + 4);
        if (IN(p0 + 5) && KIND(9)) ph_moe2(F, ly);
        SEAM(p0 + 5);
        if (IN(p0 + 6) && KIND(10)) ph_combine(F, ly);
        SEAM(p0 + 6);
    }
#undef IN
#undef SEAM
}

extern "C" void kernel_launch(void* const* d_in, const int* in_sizes, int n_in, void* d_out, int out_size, void* d_ws, size_t ws_size, hipStream_t stream) {
    static int grid = 0;
    if (grid == 0) {
        if (n_in != 34 || out_size != RLAT * DM || ws_size < WS_END) { fprintf(stderr, "kernel_launch: unexpected problem shape (n_in %d out %d ws %zu need %zu)\n", n_in, out_size, ws_size, (size_t)WS_END); grid = -1; return; }
        int dev = 0, cus = 0, per_cu = 0;
        if (hipGetDevice(&dev) != hipSuccess || hipDeviceGetAttribute(&cus, hipDeviceAttributeMultiprocessorCount, dev) != hipSuccess) { grid = -1; return; }
        if (hipFuncSetAttribute((const void*)hybrid_fwd, hipFuncAttributeMaxDynamicSharedMemorySize, LDS_BYTES) != hipSuccess) { fprintf(stderr, "kernel_launch: hipFuncSetAttribute failed\n"); grid = -1; return; }
        if (hipOccupancyMaxActiveBlocksPerMultiprocessor(&per_cu, (const void*)hybrid_fwd, NTHR, LDS_BYTES) != hipSuccess || per_cu < 1)
            fprintf(stderr, "kernel_launch: occupancy query reports %d workgroups per CU\n", per_cu);
        (void)hipGetLastError();
        grid = cus;
    }
    if (grid < 0) return;
    (void)hipMemsetAsync((char*)d_ws + WS_CTL, 0, CTL_BYTES, stream);
    Params p{};
    for (int i = 0; i < 34; ++i) p.in[i] = (const float*)d_in[i];
    p.out = (float*)d_out; p.ws = (unsigned char*)d_ws;
#if MK_PER_PHASE
    for (int ph = 0; ph < N_PHASES; ++ph) { p.ph_lo = ph; p.ph_hi = ph + 1; hipLaunchKernelGGL(hybrid_fwd, dim3(grid), dim3(NTHR), LDS_BYTES, stream, p); }
#else
    p.ph_lo = 0; p.ph_hi = N_PHASES;
    hipLaunchKernelGGL(hybrid_fwd, dim3(grid), dim3(NTHR), LDS_BYTES, stream, p);
#endif
}
```

```cpp
#include <hip/hip_runtime.h>
#include <cstdio>
#include <cstdint>

#ifndef MK_PER_PHASE
#define MK_PER_PHASE 0
#endif

#ifndef PG8_OPAQUE_K
#define PG8_OPAQUE_K 1
#endif
#ifndef MK_OUTLINE
#define MK_OUTLINE 0
#endif
#if MK_OUTLINE
#define PHASE_FN __device__ __attribute__((noinline))
#else
#define PHASE_FN __device__ __forceinline__
#endif
#ifndef PROBE_KINDS
#define PROBE_KINDS 0
#endif
#ifndef PROBE_AMP
#define PROBE_AMP 4
#endif
#ifndef KMASK
#define KMASK 0xFFFF
#endif
#define KIND(k) ((KMASK >> (k)) & 1)
#define LAS __attribute__((address_space(3)))
typedef unsigned short bf16_t;
typedef short bf16x8 __attribute__((ext_vector_type(8)));
typedef short s16x4 __attribute__((ext_vector_type(4)));
typedef float f32x4 __attribute__((ext_vector_type(4)));
typedef float f32x16 __attribute__((ext_vector_type(16)));
typedef unsigned u32x4 __attribute__((ext_vector_type(4)));
typedef unsigned u32x2 __attribute__((ext_vector_type(2)));
#define DI __device__ __forceinline__

constexpr int NB = 4, SEQ = 4096, CTXL = 256, DM = 1024, DEPTH = 4;
constexpr int POS = SEQ + CTXL;
constexpr int RLAT = NB * SEQ, RCTX = NB * CTXL, RTOT = RLAT + RCTX;
constexpr int DIN = 2560, NWIN = 2816;
constexpr int NEXP = 64, DEXP = 256;
constexpr float LN_EPS = 1e-5f;
constexpr float ALPHA = 1.681792830507429f;
constexpr float QSCALE = 0.17677669529663687f * 1.4426950408889634f;
constexpr int MAXTILES = 680;

constexpr size_t AL(size_t x) { return (x + 255) & ~(size_t)255; }
constexpr size_t WS_CTL = 0, CTL_BYTES = 1u << 20;
constexpr size_t WS_X = WS_CTL + CTL_BYTES;
constexpr size_t WS_H = WS_X + AL((size_t)RTOT * DM * 4);
constexpr size_t WS_MOD = WS_H + AL((size_t)RTOT * DM * 2);
constexpr size_t WS_HCL = WS_MOD + AL((size_t)DEPTH * 5 * 6144 * 4);
constexpr size_t WS_HCC = WS_HCL + AL((size_t)DEPTH * 4 * 256 * SEQ * 4);
constexpr size_t WS_INVL1 = WS_HCC + AL((size_t)DEPTH * 4 * 256 * CTXL * 4);
constexpr size_t WS_DFTL = WS_INVL1 + AL((size_t)DEPTH * 2 * 2 * 256 * 4);
constexpr size_t WS_DFTC = WS_DFTL + 256;
constexpr size_t WS_ROPE = WS_DFTC + AL((size_t)CTXL * 2 * CTXL * 2);
constexpr size_t WS_WIN = WS_ROPE + AL(64 * 8 * 2 * 4);
constexpr size_t WS_WOUT = WS_WIN + AL((size_t)NWIN * DM * 2);
constexpr size_t WS_WGU = WS_WOUT + AL((size_t)DM * DM * 2);
constexpr size_t WS_WD = WS_WGU + AL((size_t)65 * 512 * DM * 2);
constexpr size_t WS_TOPE = WS_WD + AL((size_t)65 * DM * DEXP * 2);
constexpr size_t WS_TOPG = WS_TOPE + AL((size_t)RTOT * 8 * 4);
constexpr size_t WS_LIST = WS_TOPG + AL((size_t)RTOT * 8 * 4);
constexpr size_t WS_SPEC = WS_LIST + AL((size_t)NEXP * RTOT * 4);
constexpr size_t WS_Z1 = WS_SPEC + AL((size_t)256 * 2 * 8192 * 8);
constexpr size_t WS_U = WS_Z1 + AL((size_t)256 * SEQ * 4 * 4);
constexpr size_t WS_Q = WS_U;
constexpr size_t WS_K = WS_Q + AL((size_t)NB * 8 * POS * 64 * 2);
constexpr size_t WS_V = WS_K + AL((size_t)NB * 8 * POS * 64 * 2);
constexpr size_t WS_HYT = WS_V + AL((size_t)NB * 8 * POS * 64 * 2);
constexpr size_t WS_YTL = WS_HYT + AL((size_t)NB * 768 * POS * 4);
constexpr size_t WS_YTC = WS_YTL + AL((size_t)1024 * 8192 * 2);
constexpr size_t WS_MIX = WS_YTC + AL((size_t)1024 * 512 * 2);
constexpr size_t WS_U1_END = WS_MIX + AL((size_t)RTOT * DM * 2);
constexpr size_t WS_ACT = WS_U;
constexpr size_t WS_YB = WS_ACT + AL((size_t)MAXTILES * 256 * DEXP * 2);
constexpr size_t WS_U2_END = WS_YB + AL((size_t)RTOT * 9 * DM * 2);
constexpr size_t WS_END = WS_U2_END > WS_U1_END ? WS_U2_END : WS_U1_END;

constexpr int CW_BAR = 0;
constexpr int CW_ATTN = 4096;
constexpr int CW_CNT = 8192;

DI unsigned cvt_pk_bf16(float lo, float hi) { unsigned r; asm volatile("v_cvt_pk_bf16_f32 %0, %1, %2" : "=v"(r) : "v"(lo), "v"(hi)); return r; }
DI bf16x8 pack8(float a0, float a1, float a2, float a3, float a4, float a5, float a6, float a7) {
    u32x4 p;
    asm volatile("v_cvt_pk_bf16_f32 %0, %4, %5\n\tv_cvt_pk_bf16_f32 %1, %6, %7\n\tv_cvt_pk_bf16_f32 %2, %8, %9\n\tv_cvt_pk_bf16_f32 %3, %10, %11\n\ts_nop 1"
                 : "=&v"(p[0]), "=&v"(p[1]), "=&v"(p[2]), "=&v"(p[3]) : "v"(a0), "v"(a1), "v"(a2), "v"(a3), "v"(a4), "v"(a5), "v"(a6), "v"(a7));
    return __builtin_bit_cast(bf16x8, p);
}
DI bf16_t f2bf(float x) { return (bf16_t)(cvt_pk_bf16(x, 0.f) & 0xffffu); }
DI float bf2f(unsigned short u) { return __uint_as_float(((unsigned)u) << 16); }
DI float bflo(unsigned w) { return __uint_as_float(w << 16); }
DI float bfhi(unsigned w) { return __uint_as_float(w & 0xffff0000u); }
DI float wave_sum(float v) {
#pragma unroll
    for (int o = 32; o >= 1; o >>= 1) v += __shfl_xor(v, o);
    return v;
}
DI float wave_max(float v) {
#pragma unroll
    for (int o = 32; o >= 1; o >>= 1) v = fmaxf(v, __shfl_xor(v, o));
    return v;
}

#define XB_TMO      128
#define XB_XCNT(j)  (256  + 64 * (j))
#define XB_XSUB(j)  (1280 + 64 * (j))
#define XB_XGEN(j)  (2304 + 64 * (j))
#define XB_TOP      3328
#define XB_TOPGEN   3392
#define XCD_BAR_WORDS 3456
#define XB_SPIN_CAP (1u << 18)

__device__ __forceinline__ unsigned xb_ld(unsigned* p)              { return __hip_atomic_load(p, __ATOMIC_RELAXED, __HIP_MEMORY_SCOPE_AGENT); }
__device__ __forceinline__ unsigned xb_add(unsigned* p, unsigned v) { return __hip_atomic_fetch_add(p, v, __ATOMIC_RELAXED, __HIP_MEMORY_SCOPE_AGENT); }
__device__ __forceinline__ unsigned xb_xcc_id() { return (unsigned)__builtin_amdgcn_s_getreg((3 << 11) | 20) & 0xFu; }
#define XB_SPIN(cond, bar) do { unsigned _sp = 0; while (cond) { __builtin_amdgcn_s_sleep(1); \
    if ((++_sp & 255u) == 0u) { if (xb_ld(&(bar)[XB_TMO])) break; if (_sp > XB_SPIN_CAP) { atomicAdd(&(bar)[XB_TMO], 1u); break; } } } } while (0)

struct XcdBarrier { unsigned* bar; unsigned x; volatile LAS unsigned* st; };

__device__ __forceinline__ XcdBarrier xcd_barrier_post(unsigned* bar, volatile LAS unsigned* st) {
    XcdBarrier b; b.bar = bar; b.x = xb_xcc_id(); b.st = st;
    if (threadIdx.x == 0) (void)xb_add(&bar[XB_XCNT(b.x)], 1u);
    return b;
}
__device__ __forceinline__ void xcd_barrier_complete(unsigned* bar, unsigned x, unsigned& nloc, unsigned& nx) {
    const unsigned G = gridDim.x * gridDim.y * gridDim.z;
    unsigned sum, cnt, mine, sp = 0u;
    for (;;) {
        sum = 0u; cnt = 0u; mine = 0u;
#pragma unroll
        for (unsigned j = 0; j < 16; ++j) { const unsigned c = xb_ld(&bar[XB_XCNT(j)]); sum += c; cnt += (c > 0u) ? 1u : 0u; mine = (j == x) ? c : mine; }
        if (sum == G) break;
        __builtin_amdgcn_s_sleep(1);
        if ((++sp & 255u) == 0u) { if (xb_ld(&bar[XB_TMO])) break; if (sp > XB_SPIN_CAP) { atomicAdd(&bar[XB_TMO], 1u); break; } }
    }
    nloc = mine > 0u ? mine : 1u; nx = cnt > 0u ? cnt : 1u;
}
__device__ __forceinline__ void xcd_barrier(const XcdBarrier& b) {
    asm volatile("s_waitcnt vmcnt(0)" ::: "memory");
    __syncthreads();
    if (threadIdx.x == 0) {
        unsigned* bar = b.bar;
        __builtin_amdgcn_s_waitcnt(0);
        unsigned nloc = b.st[0], nx = b.st[1];
        if (nloc == 0u) { xcd_barrier_complete(bar, b.x, nloc, nx); b.st[0] = nloc; b.st[1] = nx; }
        const unsigned old = xb_add(&bar[XB_XSUB(b.x)], 1u);
        const unsigned gen = old / nloc;
        if (old + 1u == (gen + 1u) * nloc) {
            __builtin_amdgcn_fence(__ATOMIC_RELEASE, "agent");
            asm volatile("s_waitcnt vmcnt(0)" ::: "memory");
            const unsigned og = xb_add(&bar[XB_TOP], 1u);
            const unsigned tg = og / nx;
            if (og + 1u == (tg + 1u) * nx) xb_add(&bar[XB_TOPGEN], 1u);
            else XB_SPIN(xb_ld(&bar[XB_TOPGEN]) == tg, bar);
            __builtin_amdgcn_fence(__ATOMIC_ACQUIRE, "agent");
            xb_add(&bar[XB_XGEN(b.x)], 1u);
            asm volatile("s_waitcnt vmcnt(0)" ::: "memory");
        } else {
            XB_SPIN(xb_ld(&bar[XB_XGEN(b.x)]) == gen, bar);
            __builtin_amdgcn_fence(__ATOMIC_ACQUIRE, "agent");
            asm volatile("s_waitcnt vmcnt(0)" ::: "memory");
        }
    }
    __syncthreads();
}

namespace pg8 {
constexpr int BM = 256, BK = 64, HALF = 128, HTB = HALF * BK * 2, STAGE_BYTES = 8 * HTB, NXCD = 8, WGM = 8;
__host__ __device__ __forceinline__ int lds_byte(int r, int c) { const int st = (r >> 4) * 2 + (c >> 5), rr = r & 15, cc = c & 31, ob = rr * 64 + cc * 2; return st * 1024 + (ob ^ (((ob >> 9) & 1) << 5)); }
__host__ __device__ __forceinline__ void stage_rc(int b, int& R, int& C) { const int st = b / 1024, sb = b % 1024, swz = sb ^ (((sb >> 9) & 1) << 5); R = (st >> 1) * 16 + swz / 64; C = (st & 1) * 32 + (swz % 64) / 2; }
__host__ __device__ __forceinline__ int perm32(int rho) { const int n = rho >> 4, i = rho & 15; return 8 * (i >> 2) + 4 * n + (i & 3); }

struct Unit { int pm, pn, e, lt; };
struct Gemm { const bf16_t* A; const bf16_t* Bt; int K; int tid; };

struct StaticOrder {
    static constexpr bool GATHER = false;
    int nM, nN, nwg, G, c;
    __device__ void init(int nM_, int nN_, int G_, int c_) { nM = nM_; nN = nN_; nwg = nM * nN; G = G_; c = c_; }
    __device__ bool next(int i, Unit& u) const {
        const long L = (long)i * G + c; if (L >= nwg) return false;
        int wgid = (int)L; { const int q = nwg / NXCD, r = nwg % NXCD, xcd = wgid % NXCD, off = wgid / NXCD; wgid = (xcd < r ? xcd * (q + 1) : r * (q + 1) + (xcd - r) * q) + off; }
        const int nig = WGM * nN, gid = wgid / nig, fm = gid * WGM, gsz = (nM - fm) < WGM ? (nM - fm) : WGM;
        u.pm = fm + ((wgid % nig) % gsz); u.pn = (wgid % nig) / gsz; u.e = 0; u.lt = 0; return true;
    }
    __device__ __forceinline__ int arow(const Unit& u, int r) const { return u.pm * BM + r; }
};

template <class Epi, class Sched>
__device__ __forceinline__ void gemm_phase(LAS unsigned char* lds, const Gemm g, const Sched& S, const Epi& E) {
    constexpr bool GA = Sched::GATHER;
    int tid = g.tid; asm volatile("" : "+v"(tid));
    const int wid = __builtin_amdgcn_readfirstlane(tid >> 6), lane = tid & 63, wr = wid >> 2, wc = wid & 3, fr = lane & 15, fq = lane >> 4;
    int K = g.K;
#if PG8_OPAQUE_K
    asm volatile("" : "+s"(K));
#endif
    const int nt = K / BK;
    unsigned voffA[2], voffB[2];
#pragma unroll
    for (int i = 0; i < 2; ++i) { int R, C; stage_rc(tid * 16 + i * 8192, R, C); const int Rb = Epi::PERM ? ((R & ~31) + perm32(R & 31)) : R;
        voffA[i] = (unsigned)(R * K + C) * 2u; voffB[i] = (unsigned)(Rb * K + C) * 2u; }
    const size_t kstep = (size_t)(BK * 2);
    const size_t hstep = (size_t)HALF * K * 2;
    const size_t tstep = 2 * hstep;
    const unsigned ldsw = (unsigned)wid * 1024u;
    const int aoff = lds_byte(wr * 64 + fr, fq * 8), boff = lds_byte(wc * 32 + fr, fq * 8);
#define PG8_SA(b, h) (((b) * 2 + (h)) * HTB)
#define PG8_SB(b, h) ((4 + (b) * 2 + (h)) * HTB)
#define PG8_STAGE(bufoff, gbase, voff) do { _Pragma("unroll") for (int _i = 0; _i < 2; ++_i) \
        __builtin_amdgcn_global_load_lds((const unsigned*)((const char*)(gbase) + (voff)[_i]), (LAS unsigned*)(lds + (bufoff) + ldsw + _i * 8192), 16, 0, 0); } while (0)
#define PG8_STAGEA(bufoff, gbase, o0, o1) do { \
        __builtin_amdgcn_global_load_lds((const unsigned*)((const char*)(gbase) + (o0)), (LAS unsigned*)(lds + (bufoff) + ldsw), 16, 0, 0); \
        __builtin_amdgcn_global_load_lds((const unsigned*)((const char*)(gbase) + (o1)), (LAS unsigned*)(lds + (bufoff) + ldsw + 8192), 16, 0, 0); } while (0)
#define PG8_STA(bufoff, sp, gp, o0, o1) do { if constexpr (GA) PG8_STAGEA(bufoff, gp, o0, o1); else PG8_STAGE(bufoff, sp, voffA); } while (0)
#define PG8_LDA(dst, b, h) do { _Pragma("unroll") for (int m = 0; m < 4; ++m) _Pragma("unroll") for (int k = 0; k < 2; ++k) dst[m][k] = *(const LAS bf16x8*)(lds + PG8_SA(b, h) + aoff + m * 2048 + k * 1024); } while (0)
#define PG8_LDB(dst, b, h) do { _Pragma("unroll") for (int n = 0; n < 2; ++n) _Pragma("unroll") for (int k = 0; k < 2; ++k) dst[n][k] = *(const LAS bf16x8*)(lds + PG8_SB(b, h) + boff + n * 2048 + k * 1024); } while (0)
#define PG8_MMA(ai, bj, At, Bt) do { __builtin_amdgcn_s_setprio(1); _Pragma("unroll") for (int m = 0; m < 4; ++m) _Pragma("unroll") for (int n = 0; n < 2; ++n) _Pragma("unroll") for (int k = 0; k < 2; ++k) \
        acc[ai][bj][m][n] = __builtin_amdgcn_mfma_f32_16x16x32_bf16(Bt[n][k], At[m][k], acc[ai][bj][m][n], 0, 0, 0); __builtin_amdgcn_s_setprio(0); } while (0)
#define PG8_WAIT_V(n) asm volatile("s_waitcnt vmcnt(" #n ")" ::: "memory")
#define PG8_WAIT_L(n) asm volatile("s_waitcnt lgkmcnt(" #n ")" ::: "memory")
#define PG8_BAR __builtin_amdgcn_s_barrier()
#define PG8_SCHED __builtin_amdgcn_sched_barrier(0)
#define PG8_GOFF(u, o00, o01, o10, o11) do { int _tz = g.tid; asm volatile("" : "+v"(_tz)); int _R0, _C0, _R1, _C1; stage_rc(_tz * 16, _R0, _C0); stage_rc(_tz * 16 + 8192, _R1, _C1); \
        o00 = (unsigned)(S.arow(u, _R0) * K + _C0) * 2u; o01 = (unsigned)(S.arow(u, _R1) * K + _C1) * 2u; \
        o10 = (unsigned)(S.arow(u, HALF + _R0) * K + _C0) * 2u; o11 = (unsigned)(S.arow(u, HALF + _R1) * K + _C1) * 2u; } while (0)
    Unit cur, nxt; int ui = 0;
    if (!S.next(0, cur)) return;
    f32x4 acc[2][2][4][2];
#pragma unroll
    for (int a = 0; a < 2; ++a)
#pragma unroll
        for (int b = 0; b < 2; ++b)
#pragma unroll
            for (int m = 0; m < 4; ++m)
#pragma unroll
                for (int n = 0; n < 2; ++n) acc[a][b][m][n] = (f32x4){0.f, 0.f, 0.f, 0.f};
    bf16x8 At[4][2], B0[2][2], B1[2][2];
    const char* const gA = (const char*)g.A;
    unsigned c00 = 0, c01 = 0, c10 = 0, c11 = 0, n00 = 0, n01 = 0, n10 = 0, n11 = 0;
    if constexpr (GA) PG8_GOFF(cur, c00, c01, c10, c11);
    const char* cA = gA + (GA ? (size_t)0 : (size_t)cur.pm * tstep); const char* cB = (const char*)g.Bt + (size_t)cur.pn * tstep;
    PG8_STAGE(PG8_SB(0, 0), cB, voffB); PG8_STAGE(PG8_SB(0, 1), cB + hstep, voffB); PG8_STA(PG8_SA(0, 0), cA, gA, c00, c01); PG8_STA(PG8_SA(0, 1), cA + hstep, gA, c10, c11);
    if (wr == 1) PG8_BAR;
    PG8_WAIT_V(2); PG8_BAR;
    PG8_STAGE(PG8_SB(1, 0), cB + kstep, voffB); PG8_STA(PG8_SA(1, 0), cA + kstep, gA + kstep, c00, c01); PG8_STAGE(PG8_SB(1, 1), cB + hstep + kstep, voffB);
    PG8_WAIT_V(6); PG8_BAR;
    for (;;) {
        const bool has_next = S.next(ui + 1, nxt);
        const char* nA = (has_next && !GA) ? gA + (size_t)nxt.pm * tstep : cA; const char* nB = has_next ? (const char*)g.Bt + (size_t)nxt.pn * tstep : cB;
        if constexpr (GA) { if (has_next) PG8_GOFF(nxt, n00, n01, n10, n11); else { n00 = c00; n01 = c01; n10 = c10; n11 = c11; } }
#pragma unroll 1
        for (int t = 0; t < nt; t += 2) {
            const bool last = (t == nt - 2);
            const char* a1 = cA + (size_t)(t + 1) * kstep;
            const char* a2 = last ? nA : cA + (size_t)(t + 2) * kstep; const char* b2 = last ? nB : cB + (size_t)(t + 2) * kstep;
            const char* a3 = a2 + kstep; const char* b3 = b2 + kstep;
            unsigned x00 = 0, x01 = 0, x10 = 0, x11 = 0;
            if constexpr (GA) { x00 = last ? n00 : c00; x01 = last ? n01 : c01; x10 = last ? n10 : c10; x11 = last ? n11 : c11; }
            PG8_LDB(B0, 0, 0); PG8_LDB(B1, 0, 1); PG8_SCHED; PG8_LDA(At, 0, 0); PG8_STA(PG8_SA(1, 1), a1 + hstep, a1, c10, c11);
            PG8_WAIT_V(8); PG8_WAIT_L(0); PG8_BAR; PG8_MMA(0, 0, At, B0); PG8_MMA(0, 1, At, B1); PG8_BAR; PG8_SCHED;
            PG8_LDA(At, 0, 1); PG8_STAGE(PG8_SB(0, 0), b2, voffB); PG8_STAGE(PG8_SB(0, 1), b2 + hstep, voffB); PG8_STA(PG8_SA(0, 0), a2, a2, x00, x01);
            PG8_WAIT_V(8); PG8_WAIT_L(0); PG8_BAR; PG8_MMA(1, 0, At, B0); PG8_MMA(1, 1, At, B1); PG8_BAR; PG8_SCHED;
            PG8_LDB(B0, 1, 0); PG8_LDB(B1, 1, 1); PG8_SCHED; PG8_LDA(At, 1, 0); PG8_STA(PG8_SA(0, 1), a2 + hstep, a2, x10, x11);
            PG8_WAIT_V(8); PG8_WAIT_L(0); PG8_BAR; PG8_MMA(0, 0, At, B0); PG8_MMA(0, 1, At, B1); PG8_BAR; PG8_SCHED;
            PG8_LDA(At, 1, 1); PG8_STAGE(PG8_SB(1, 0), b3, voffB); PG8_STAGE(PG8_SB(1, 1), b3 + hstep, voffB); PG8_STA(PG8_SA(1, 0), a3, a3, x00, x01);
            PG8_WAIT_V(8); PG8_WAIT_L(0); PG8_BAR; PG8_MMA(1, 0, At, B0); PG8_MMA(1, 1, At, B1); PG8_BAR; PG8_SCHED;
        }
        if (wr == 0) PG8_BAR;
        { int ln = (int)__builtin_amdgcn_mbcnt_hi(~0u, __builtin_amdgcn_mbcnt_lo(~0u, 0u)); asm volatile("" : "+v"(ln));
          E(acc, cur, wr, wc, ln & 15, ln >> 4); }
        if (!has_next) break;
#pragma unroll
        for (int a = 0; a < 2; ++a)
#pragma unroll
            for (int b = 0; b < 2; ++b)
#pragma unroll
                for (int m = 0; m < 4; ++m)
#pragma unroll
                    for (int n = 0; n < 2; ++n) acc[a][b][m][n] = (f32x4){0.f, 0.f, 0.f, 0.f};
        cur = nxt; cA = nA; cB = nB; ++ui;
        if constexpr (GA) { c00 = n00; c01 = n01; c10 = n10; c11 = n11; }
        if (wr == 1) PG8_BAR;
    }
    PG8_WAIT_V(0);
    PG8_BAR;
#undef PG8_SA
#undef PG8_SB
#undef PG8_STAGE
#undef PG8_STAGEA
#undef PG8_STA
#undef PG8_GOFF
#undef PG8_LDA
#undef PG8_LDB
#undef PG8_MMA
#undef PG8_WAIT_V
#undef PG8_WAIT_L
#undef PG8_BAR
#undef PG8_SCHED
}
}

constexpr int NTHR = 512;
constexpr int LDS_SCRATCH = 139264;
constexpr int LDS_MISC = LDS_SCRATCH;
constexpr int LDS_TAB = LDS_MISC + 256;
constexpr int LDS_BYTES = LDS_TAB + 8192;

struct Params { const float* in[34]; float* out; unsigned char* ws; int ph_lo, ph_hi; };

struct Frame {
    const float* const* in; float* out; unsigned char* ws; LAS unsigned char* lds; unsigned* ctl;
    int tid, lane, wave, G, bid;
};

DI int row_b(int row) { return row < RLAT ? (row >> 12) : ((row - RLAT) >> 8); }
DI int row_pos(int row) { return row < RLAT ? (row & 4095) : (SEQ + ((row - RLAT) & 255)); }
DI int row_modsel(int row) { return row < RLAT ? (row >> 12) : 4; }

DI void prep_tile(const Frame& F, const float* src, int ldn, int k0, int n0, bf16_t* dst, int ldk, int dst_row0) {
    LAS float* T = (LAS float*)F.lds;
    const int t = F.tid;
    { const float* p = src + (size_t)(k0 + (t >> 3)) * ldn + n0 + (t & 7) * 8;
      const f32x4 a = *(const f32x4*)p, b = *(const f32x4*)(p + 4);
      LAS float* q = T + (t >> 3) * 65 + (t & 7) * 8;
      q[0] = a[0]; q[1] = a[1]; q[2] = a[2]; q[3] = a[3]; q[4] = b[0]; q[5] = b[1]; q[6] = b[2]; q[7] = b[3]; }
    __syncthreads();
    { const int nn = t >> 3, kc = (t & 7) * 8; float v[8];
#pragma unroll
      for (int j = 0; j < 8; ++j) v[j] = T[(kc + j) * 65 + nn];
      u32x4 w; w.x = cvt_pk_bf16(v[0], v[1]); w.y = cvt_pk_bf16(v[2], v[3]); w.z = cvt_pk_bf16(v[4], v[5]); w.w = cvt_pk_bf16(v[6], v[7]);
      *(u32x4*)(dst + (size_t)(dst_row0 + nn) * ldk + k0 + kc) = w; }
    __syncthreads();
}

DI void prep_fourier_job(const Frame& F, int ly, int g, int kt) {
    LAS float* FW = (LAS float*)F.lds;
    LAS float* CS = FW + 4096;
    LAS float* P = CS + 128;
    LAS float* W = P + 8192;
    const int t = F.tid;
    const float* fw = F.in[21] + ((size_t)ly * 4 + g) * 4096;
    for (int i = t; i < 4096; i += NTHR) FW[i] = fw[i];
    if (t < 64) { float s, c; sincospif((float)t / 32.0f, &s, &c); CS[t] = c; CS[64 + t] = s; }
    { const float* p = F.in[6] + (size_t)ly * DM * DIN + (size_t)(kt * 64 + (t >> 3)) * DIN + 2304 + g * 64 + (t & 7) * 8;
      const f32x4 a = *(const f32x4*)p, b = *(const f32x4*)(p + 4);
      LAS float* q = W + (t >> 3) * 65 + (t & 7) * 8;
      q[0] = a[0]; q[1] = a[1]; q[2] = a[2]; q[3] = a[3]; q[4] = b[0]; q[5] = b[1]; q[6] = b[2]; q[7] = b[3]; }
    __syncthreads();
    for (int i = t; i < 8192; i += NTHR) {
        const int c = i >> 7, n = i & 127, comp = n >> 6, d = n & 63;
        float s = 0.f;
        for (int j = 0; j < 64; ++j) { const int a = (j * c) & 63; const float tr = comp ? -CS[64 + a] : CS[a]; s += tr * FW[j * 64 + d]; }
        P[c * 128 + n] = s;
    }
    __syncthreads();
    bf16_t* dst = (bf16_t*)(F.ws + WS_WIN);
    { const int k = t >> 3, nb = (t & 7) * 16;
      float o[16];
#pragma unroll
      for (int j = 0; j < 16; ++j) o[j] = 0.f;
      for (int c = 0; c < 64; ++c) { const float w = W[k * 65 + c];
#pragma unroll
          for (int j = 0; j < 16; ++j) o[j] += w * P[c * 128 + nb + j]; }
#pragma unroll
      for (int j = 0; j < 16; ++j) { const int n = nb + j, comp = n >> 6, d = n & 63;
          dst[(size_t)(2304 + comp * 256 + g * 64 + d) * DM + kt * 64 + k] = f2bf(o[j]); } }
    __syncthreads();
}

DI void prep_weights(const Frame& F, int ly) {
    constexpr int J1 = 576, J2 = J1 + 256, J3 = J2 + 4160, J4 = J3 + 4160, J5 = J4 + 4160, J6 = J5 + 64;
    for (int j = F.bid; j < J6; j += F.G) {
        if (j < J1) { const int kt = j / 36, nt = j % 36;
            prep_tile(F, F.in[6] + (size_t)ly * DM * DIN, DIN, kt * 64, nt * 64, (bf16_t*)(F.ws + WS_WIN), DM, nt * 64);
        } else if (j < J2) { const int q = j - J1, kt = q >> 4, nt = q & 15;
            prep_tile(F, F.in[7] + (size_t)ly * DM * DM, DM, kt * 64, nt * 64, (bf16_t*)(F.ws + WS_WOUT), DM, nt * 64);
        } else if (j < J4) { const bool up = j >= J3; const int q = j - (up ? J3 : J2), e = q >> 6, kt = (q >> 2) & 15, nt = q & 3;
            const float* src = e < NEXP ? F.in[up ? 29 : 28] + ((size_t)ly * NEXP + e) * DM * DEXP : F.in[up ? 32 : 31] + (size_t)ly * DM * DEXP;
            const int hid0 = nt * 64, jj = hid0 >> 7;
            prep_tile(F, src, DEXP, kt * 64, hid0, (bf16_t*)(F.ws + WS_WGU), DM, e * 512 + jj * 256 + (up ? 128 : 0) + (hid0 & 127));
        } else if (j < J5) { const int q = j - J4, e = q >> 6, kt = (q >> 4) & 3, nt = q & 15;
            const float* src = e < NEXP ? F.in[30] + ((size_t)ly * NEXP + e) * DEXP * DM : F.in[33] + (size_t)ly * DEXP * DM;
            prep_tile(F, src, DM, kt * 64, nt * 64, (bf16_t*)(F.ws + WS_WD), DEXP, e * DM + nt * 64);
        } else { const int q = j - J5; prep_fourier_job(F, ly, q >> 4, q & 15); }
    }
}

DI void prep_mod(const Frame& F) {
    LAS float* S = (LAS float*)F.lds;
    LAS float* RED = S + 5 * 1024;
    const int t = F.tid;
    bool have_s = false;
    for (int u = F.bid; u < DEPTH * 96; u += F.G) {
        const int ly = u / 96, cg = u % 96;
        if (!have_s) {
            for (int i = t; i < 5 * 1024; i += NTHR) { const int r = i >> 10, k = i & 1023; const float x = r < 4 ? F.in[1][r * DM + k] : F.in[3][k]; S[i] = x / (1.f + expf(-x)); }
            __syncthreads(); have_s = true;
        }
        const int tq = t & 15, tk = t >> 4;
        const float* w = F.in[4] + (size_t)ly * DM * 6144 + cg * 64 + tq * 4;
        f32x4 acc[5];
#pragma unroll
        for (int r = 0; r < 5; ++r) acc[r] = (f32x4){0.f, 0.f, 0.f, 0.f};
        for (int kk = 0; kk < 32; ++kk) { const int k = tk * 32 + kk; const f32x4 wv = *(const f32x4*)(w + (size_t)k * 6144);
#pragma unroll
            for (int r = 0; r < 5; ++r) acc[r] += wv * S[r * 1024 + k]; }
#pragma unroll
        for (int r = 0; r < 5; ++r)
#pragma unroll
            for (int j = 0; j < 4; ++j) RED[(tk * 5 + r) * 64 + tq * 4 + j] = acc[r][j];
        __syncthreads();
        if (t < 320) { const int r = t >> 6, c = t & 63; float s = 0.f;
            for (int q = 0; q < 32; ++q) s += RED[(q * 5 + r) * 64 + c];
            const int col = cg * 64 + c;
            ((float*)(F.ws + WS_MOD))[((size_t)ly * 5 + r) * 6144 + col] = s + F.in[5][(size_t)ly * 6144 + col]; }
        __syncthreads();
    }
}

DI void prep_filters(const Frame& F) {
    LAS float* Z = (LAS float*)F.lds;
    LAS float* A1 = Z + 64 * 33;
    LAS float* A2 = A1 + 4096;
    const int t = F.tid;
    for (int u = F.bid; u < DEPTH * 68; u += F.G) {
        const int ly = u / 68, ch = u % 68; const bool lat = ch < 64; const int Lx = lat ? SEQ : CTXL, t0 = lat ? ch * 64 : (ch - 64) * 64;
        for (int i = t; i < 64 * 33; i += NTHR) { const int tt = i / 33, f = i % 33; const int ti = t0 + tt;
            float v;
            if (f == 0) v = (float)ti / (float)(Lx - 1);
            else { const int j = (f - 1) & 15; const float fb = 1e-4f + (float)j * ((15.0f - 1e-4f) / 15.0f); const float om = (6.283185307179586f / (float)Lx) * (float)ti;
                   v = f <= 16 ? cosf(fb * om) : -sinf(fb * om); }
            Z[i] = v; }
        __syncthreads();
        const float* w1 = F.in[9] + (size_t)ly * 33 * 64; const float* b1 = F.in[10] + ly * 64; const float* w2 = F.in[11] + (size_t)ly * 4096; const float* b2 = F.in[12] + ly * 64;
        const float* w3 = F.in[13] + (size_t)ly * 64 * 1024; const float* fq = F.in[14] + ly * 64;
        for (int i = t; i < 4096; i += NTHR) { const int tt = i >> 6, h = i & 63; float s = b1[h];
            for (int f = 0; f < 33; ++f) s += Z[tt * 33 + f] * w1[f * 64 + h];
            A1[i] = sinf(fq[h] * s); }
        __syncthreads();
        for (int i = t; i < 4096; i += NTHR) { const int tt = i >> 6, h = i & 63; float s = b2[h];
            for (int j = 0; j < 64; ++j) s += A1[tt * 64 + j] * w2[j * 64 + h];
            A2[i] = sinf(fq[h] * s); }
        __syncthreads();
        for (int cc = 0; cc < 2; ++cc) { const int col = t + cc * 512;
            float wr[64];
#pragma unroll
            for (int j = 0; j < 64; ++j) wr[j] = w3[j * 1024 + col];
            const int n = col >> 9, dir = (col >> 8) & 1, c = col & 255;
            const float delta = fabsf(-3.0701134573253946f + (float)c * ((-15.350567286626973f + 3.0701134573253946f) / 255.0f));
            float* dst = lat ? (float*)(F.ws + WS_HCL) + ((((size_t)ly * 2 + n) * 2 + dir) * 256 + c) * SEQ + t0
                             : (float*)(F.ws + WS_HCC) + ((((size_t)ly * 2 + n) * 2 + dir) * 256 + c) * CTXL + t0;
            for (int tt = 0; tt < 64; ++tt) { float s = 0.f;
#pragma unroll
                for (int j = 0; j < 64; ++j) s += A2[tt * 64 + j] * wr[j];
                const float tv = (float)(t0 + tt) / (float)(Lx - 1);
                dst[tt] = s * expf(-tv * delta); } }
        __syncthreads();
    }
}

DI void prep_tables(const Frame& F) {
    LAS float* CT = (LAS float*)F.lds;
    const int t = F.tid;
    for (int i = t; i < 4096; i += NTHR) CT[i] = cospif((float)i / 2048.0f);
    __syncthreads();
    bf16_t* DC = (bf16_t*)(F.ws + WS_DFTC);
    for (int i = F.bid * NTHR + t; i < CTXL * 512; i += F.G * NTHR) { const int k = i >> 9, cl = i & 511, comp = cl >> 8, l = cl & 255;
        const int idx = ((k * l) & 255) * 16; DC[i] = f2bf((comp ? CT[(idx - 1024) & 4095] : CT[idx]) * (1.0f / 128.0f)); }
    if (F.bid == 0) { float* RT = (float*)(F.ws + WS_ROPE);
        for (int i = t; i < 512; i += NTHR) { const int p = i >> 3, n = i & 7; const float inv = powf(10000.0f, -(float)n / 8.0f); float s, c; sincosf((float)p * inv, &s, &c); RT[i * 2] = c; RT[i * 2 + 1] = s; } }
    __syncthreads();
}

DI void prep_copy_x(const Frame& F) {
    f32x4* X = (f32x4*)(F.ws + WS_X);
    const f32x4* x = (const f32x4*)F.in[0]; const f32x4* cx = (const f32x4*)F.in[2];
    const size_t n1 = (size_t)RLAT * DM / 4, n2 = (size_t)RCTX * DM / 4;
    for (size_t i = (size_t)F.bid * NTHR + F.tid; i < n1 + n2; i += (size_t)F.G * NTHR) X[i] = i < n1 ? x[i] : cx[i - n1];
}

DI void prep_invl1(const Frame& F) {
    const int gw = F.bid * 8 + F.wave, nw = F.G * 8;
    for (int j = gw; j < DEPTH * 2 * 2 * 256; j += nw) {
        const int ly = j >> 10, lt = (j >> 9) & 1, n = (j >> 8) & 1, c = j & 255;
        const int Lx = lt ? CTXL : SEQ;
        const float* base = lt ? (const float*)(F.ws + WS_HCC) : (const float*)(F.ws + WS_HCL);
        const float* f0 = base + ((((size_t)ly * 2 + n) * 2 + 0) * 256 + c) * Lx;
        const float* f1 = base + ((((size_t)ly * 2 + n) * 2 + 1) * 256 + c) * Lx;
        float s = 0.f;
        for (int i = F.lane; i < Lx; i += 64) { s += fabsf(f0[i]); if (i >= 1) s += fabsf(f1[i]); }
        s = wave_sum(s);
        if (F.lane == 0) ((float*)(F.ws + WS_INVL1))[j] = 1.0f / s;
    }
}

DI void ln_stats(const f32x4 (&v)[4], float& mu, float& rstd) {
    float s = 0.f;
#pragma unroll
    for (int j = 0; j < 4; ++j) s += (v[j][0] + v[j][1]) + (v[j][2] + v[j][3]);
    mu = wave_sum(s) * (1.0f / DM);
    float q = 0.f;
#pragma unroll
    for (int j = 0; j < 4; ++j)
#pragma unroll
        for (int e = 0; e < 4; ++e) { const float d = v[j][e] - mu; q += d * d; }
    rstd = rsqrtf(wave_sum(q) * (1.0f / DM) + LN_EPS);
}
DI void ln_mod_store(const f32x4 (&v)[4], const float* sh, const float* sc, bf16_t* hrow, int lane) {
    float mu, rstd; ln_stats(v, mu, rstd);
#pragma unroll
    for (int j = 0; j < 4; ++j) { const int c = 4 * lane + 256 * j; const f32x4 a = *(const f32x4*)(sh + c), b = *(const f32x4*)(sc + c);
        float o[4];
#pragma unroll
        for (int e = 0; e < 4; ++e) o[e] = (v[j][e] - mu) * rstd * (1.f + b[e]) + a[e];
        u32x2 w; w.x = cvt_pk_bf16(o[0], o[1]); w.y = cvt_pk_bf16(o[2], o[3]); *(u32x2*)(hrow + c) = w; }
}

DI void phase_init_h(const Frame& F) {
    const int gw = F.bid * 8 + F.wave, nw = F.G * 8;
    const float* MOD = (const float*)(F.ws + WS_MOD);
    for (int row = gw; row < RTOT; row += nw) {
        const float* xr = (const float*)(F.ws + WS_X) + (size_t)row * DM;
        f32x4 v[4];
#pragma unroll
        for (int j = 0; j < 4; ++j) v[j] = *(const f32x4*)(xr + 4 * F.lane + 256 * j);
        const float* m = MOD + (size_t)(0 * 5 + row_modsel(row)) * 6144;
        ln_mod_store(v, m, m + 1024, (bf16_t*)(F.ws + WS_H) + (size_t)row * DM, F.lane);
    }
}

struct EpiWin {
    static constexpr bool PERM = true;
    unsigned char* ws;
    DI void operator()(const f32x4 (&acc)[2][2][4][2], const pg8::Unit& u, int wr, int wc, int fr, int fq) const {
        const bool lat = u.pm < 64; const int b = lat ? (u.pm >> 4) : (u.pm - 64); const int pos0 = lat ? ((u.pm & 15) << 8) : SEQ;
        const int pn = u.pn;
        const float* RT = (const float*)(ws + WS_ROPE);
#pragma unroll
        for (int ai = 0; ai < 2; ++ai)
#pragma unroll
            for (int m = 0; m < 4; ++m) {
                const int pos = pos0 + ai * 128 + wr * 64 + m * 16 + fr;
#pragma unroll
                for (int bj = 0; bj < 2; ++bj) {
                    const int col = pn * 256 + bj * 128 + wc * 32 + fq * 8;
                    float v[8];
#pragma unroll
                    for (int e = 0; e < 4; ++e) { v[e] = acc[ai][bj][m][0][e]; v[4 + e] = acc[ai][bj][m][1][e]; }
                    if (pn < 3) {
                        float* d = (float*)(ws + WS_HYT) + ((size_t)b * 768 + col) * POS + pos;
#pragma unroll
                        for (int e = 0; e < 8; ++e) d[(size_t)e * POS] = v[e];
                    } else if (pn < 7) {
                        const bool isq = pn < 5; const int cq = col - (isq ? 768 : 1280); const int head = cq >> 6, cc = cq & 63;
                        if (lat) { const int axis = (cc >> 4) & 1, n0 = (cc & 15) >> 1; const int pa = axis ? (pos & 63) : (pos >> 6);
                            const float* rt = RT + (pa * 8 + n0) * 2;
#pragma unroll
                            for (int p = 0; p < 4; ++p) { const float cs = rt[2 * p], sn = rt[2 * p + 1]; const float a = v[2 * p], bb = v[2 * p + 1];
                                v[2 * p] = a * cs - bb * sn; v[2 * p + 1] = a * sn + bb * cs; } }
                        if (isq) {
#pragma unroll
                            for (int e = 0; e < 8; ++e) v[e] *= QSCALE; }
                        u32x4 w; w.x = cvt_pk_bf16(v[0], v[1]); w.y = cvt_pk_bf16(v[2], v[3]); w.z = cvt_pk_bf16(v[4], v[5]); w.w = cvt_pk_bf16(v[6], v[7]);
                        bf16_t* d = (bf16_t*)(ws + (isq ? WS_Q : WS_K)) + (((size_t)b * 8 + head) * POS + pos) * 64 + cc;
                        *(u32x4*)d = w;
                    } else if (pn < 9) {
                        const int cv = col - 1792; const int head = cv >> 6, cc = cv & 63;
                        u32x4 w; w.x = cvt_pk_bf16(v[0], v[1]); w.y = cvt_pk_bf16(v[2], v[3]); w.z = cvt_pk_bf16(v[4], v[5]); w.w = cvt_pk_bf16(v[6], v[7]);
                        *(u32x4*)((bf16_t*)(ws + WS_V) + (((size_t)b * 8 + head) * POS + pos) * 64 + cc) = w;
                    } else {
                        const int cy = col - 2304; const int comp = cy >> 8, gd = cy & 255;
                        if (lat) { bf16_t* d = (bf16_t*)(ws + WS_YTL) + ((size_t)b * 256 + gd) * 8192 + comp * 4096 + pos;
#pragma unroll
                            for (int e = 0; e < 8; ++e) d[(size_t)e * 8192] = f2bf(v[e]);
                        } else { bf16_t* d = (bf16_t*)(ws + WS_YTC) + ((size_t)b * 256 + gd) * 512 + comp * 256 + (pos - SEQ);
#pragma unroll
                            for (int e = 0; e < 8; ++e) d[(size_t)e * 512] = f2bf(v[e]); }
                    }
                }
            }
    }
};

struct EpiFnet {
    static constexpr bool PERM = true;
    unsigned char* ws; int ctx;
    DI void operator()(const f32x4 (&acc)[2][2][4][2], const pg8::Unit& u, int wr, int wc, int fr, int fq) const {
        const int b = u.pn;
#pragma unroll
        for (int ai = 0; ai < 2; ++ai)
#pragma unroll
            for (int m = 0; m < 4; ++m) {
                const int k = u.pm * 256 + ai * 128 + wr * 64 + m * 16 + fr;
                const size_t row = ctx ? (size_t)(RLAT + b * CTXL + k) : (size_t)(b * SEQ + k);
#pragma unroll
                for (int bj = 0; bj < 2; ++bj) { const int gd = bj * 128 + wc * 32 + fq * 8;
                    const f32x4 v0 = acc[ai][bj][m][0], v1 = acc[ai][bj][m][1];
                    u32x4 w; w.x = cvt_pk_bf16(v0[0], v0[1]); w.y = cvt_pk_bf16(v0[2], v0[3]); w.z = cvt_pk_bf16(v1[0], v1[1]); w.w = cvt_pk_bf16(v1[2], v1[3]);
                    *(u32x4*)((bf16_t*)(ws + WS_MIX) + row * DM + 768 + gd) = w; }
            }
    }
};

struct EpiWout {
    static constexpr bool PERM = false;
    unsigned char* ws; int ly;
    DI void operator()(const f32x4 (&acc)[2][2][4][2], const pg8::Unit& u, int wr, int wc, int fr, int fq) const {
        const int msel = u.pm < 64 ? (u.pm >> 4) : 4;
        const float* g1 = (const float*)(ws + WS_MOD) + ((size_t)ly * 5 + msel) * 6144 + 2048;
        const int col0 = u.pn * 256 + wc * 32 + 4 * fq;
        f32x4 gv[2][2];
#pragma unroll
        for (int bj = 0; bj < 2; ++bj)
#pragma unroll
            for (int n = 0; n < 2; ++n) gv[bj][n] = *(const f32x4*)(g1 + col0 + bj * 128 + n * 16);
#pragma unroll
        for (int ai = 0; ai < 2; ++ai)
#pragma unroll
            for (int m = 0; m < 4; ++m) { float* rowp = (float*)(ws + WS_X) + (size_t)(u.pm * 256 + ai * 128 + wr * 64 + m * 16 + fr) * DM + col0;
#pragma unroll
                for (int bj = 0; bj < 2; ++bj)
#pragma unroll
                    for (int n = 0; n < 2; ++n) { f32x4* p = (f32x4*)(rowp + bj * 128 + n * 16); *p = *p * ALPHA + gv[bj][n] * acc[ai][bj][m][n]; } }
    }
};

struct MoeTab { LAS int* cnt; LAS int* tstart; LAS int* tile_e; int ntiles; };
DI MoeTab moe_tables(const Frame& F, int ly) {
    MoeTab T; T.cnt = (LAS int*)(F.lds + LDS_TAB); T.tstart = T.cnt + 72; T.tile_e = T.tstart + 72;
    __syncthreads();
    if (F.tid < 65) T.cnt[F.tid] = F.tid < NEXP ? (int)__hip_atomic_load(F.ctl + CW_CNT + 64 * ly + F.tid, __ATOMIC_RELAXED, __HIP_MEMORY_SCOPE_AGENT) : RTOT;
    __syncthreads();
    if (F.tid == 0) { int s = 0; for (int e = 0; e < 65; ++e) { T.tstart[e] = s; s += (T.cnt[e] + 255) >> 8; } T.tstart[65] = s; }
    __syncthreads();
    const int nt = T.tstart[65];
    for (int e = F.tid; e < 65; e += NTHR) for (int q = T.tstart[e]; q < T.tstart[e + 1]; ++q) if (q < MAXTILES) T.tile_e[q] = e;
    __syncthreads();
    T.ntiles = nt < MAXTILES ? nt : MAXTILES;
    return T;
}
template <bool GATHER_> struct MoeSched {
    static constexpr bool GATHER = GATHER_;
    MoeTab T; const int* list; int G, c, nsub, shift;
    DI bool next(int i, pg8::Unit& u) const {
        const long L = (long)i * G + c; if (L >= (long)T.ntiles * nsub) return false;
        const int tile = (int)(L >> shift), j = (int)L & (nsub - 1); const int e = T.tile_e[tile];
        u.pm = tile; u.pn = e * nsub + j; u.e = e; u.lt = tile - T.tstart[e]; return true;
    }
    DI int arow(const pg8::Unit& u, int r) const {
        if (!GATHER_) return u.pm * 256 + r;
        const int idx = u.lt * 256 + r;
        if (u.e == NEXP) return idx;
        return idx < T.cnt[u.e] ? (list[(size_t)u.e * RTOT + idx] >> 3) : 0;
    }
};
DI float silu_f(float x) { return x / (1.f + __expf(-x)); }
struct EpiMoe1 {
    static constexpr bool PERM = true;
    unsigned char* ws;
    DI void operator()(const f32x4 (&acc)[2][2][4][2], const pg8::Unit& u, int wr, int wc, int fr, int fq) const {
        const int hid = (u.pn & 1) * 128 + wc * 32 + fq * 8;
#pragma unroll
        for (int ai = 0; ai < 2; ++ai)
#pragma unroll
            for (int m = 0; m < 4; ++m) { const size_t row = (size_t)u.pm * 256 + ai * 128 + wr * 64 + m * 16 + fr;
                float o[8];
#pragma unroll
                for (int n = 0; n < 2; ++n)
#pragma unroll
                    for (int e = 0; e < 4; ++e) o[n * 4 + e] = silu_f(acc[ai][0][m][n][e]) * acc[ai][1][m][n][e];
                u32x4 w; w.x = cvt_pk_bf16(o[0], o[1]); w.y = cvt_pk_bf16(o[2], o[3]); w.z = cvt_pk_bf16(o[4], o[5]); w.w = cvt_pk_bf16(o[6], o[7]);
                *(u32x4*)((bf16_t*)(ws + WS_ACT) + row * DEXP + hid) = w; }
    }
};
struct EpiMoe2 {
    static constexpr bool PERM = true;
    unsigned char* ws; MoeTab T; const int* list;
    DI void operator()(const f32x4 (&acc)[2][2][4][2], const pg8::Unit& u, int wr, int wc, int fr, int fq) const {
        const int colb = (u.pn & 3) * 256 + wc * 32 + fq * 8; const int cnt = T.cnt[u.e];
#pragma unroll
        for (int ai = 0; ai < 2; ++ai)
#pragma unroll
            for (int m = 0; m < 4; ++m) { const int idx = u.lt * 256 + ai * 128 + wr * 64 + m * 16 + fr;
                long dest = -1;
                if (u.e == NEXP) dest = (long)idx * 9 + 8;
                else if (idx < cnt) { const int id = list[(size_t)u.e * RTOT + idx]; dest = (long)(id >> 3) * 9 + (id & 7); }
                if (dest >= 0) {
#pragma unroll
                    for (int bj = 0; bj < 2; ++bj) { const f32x4 v0 = acc[ai][bj][m][0], v1 = acc[ai][bj][m][1];
                        u32x4 w; w.x = cvt_pk_bf16(v0[0], v0[1]); w.y = cvt_pk_bf16(v0[2], v0[3]); w.z = cvt_pk_bf16(v1[0], v1[1]); w.w = cvt_pk_bf16(v1[2], v1[3]);
                        *(u32x4*)((bf16_t*)(ws + WS_YB) + (size_t)dest * DM + colb + bj * 128) = w; } } }
    }
};

DI float hy_short(const float* hy, int l, int Lx, float w0, float w1, float w2) {
    const float a = l > 0 ? hy[l - 1] : 0.f, b = hy[l], c = l + 1 < Lx ? hy[l + 1] : 0.f;
    return w0 * a + w1 * b + w2 * c;
}
#if 0
DI void hyena_unit(const Frame& F, int ly, int c) {
    LAS float* KF = (LAS float*)F.lds;
    LAS float* U = KF + 16384;
    const int t = F.tid;
    const float* HYT = (const float*)(F.ws + WS_HYT);
    const float* scw = F.in[8] + (size_t)ly * 3 * 768;
    const float* invl = (const float*)(F.ws + WS_INVL1) + (size_t)ly * 1024;
    const float bias0 = F.in[15][(size_t)ly * 512 + c], bias1 = F.in[15][(size_t)ly * 512 + 256 + c];
    float wx1[3], wx2[3], wv[3];
#pragma unroll
    for (int j = 0; j < 3; ++j) { wx1[j] = scw[j * 768 + c]; wx2[j] = scw[j * 768 + 256 + c]; wv[j] = scw[j * 768 + 512 + c]; }
    bf16_t* MIX = (bf16_t*)(F.ws + WS_MIX);
    {
        for (int n = 0; n < 2; ++n) { const float inv = invl[(0 * 2 + n) * 256 + c];
            const float* hf = (const float*)(F.ws + WS_HCL) + ((((size_t)ly * 2 + n) * 2 + 0) * 256 + c) * SEQ;
            const float* hb = (const float*)(F.ws + WS_HCL) + ((((size_t)ly * 2 + n) * 2 + 1) * 256 + c) * SEQ;
            for (int i = t; i < 8192; i += NTHR) { const int d = i - 4096; KF[n * 8192 + i] = d >= 0 ? hf[d] * inv : (d > -4096 ? hb[-d] * inv : 0.f); } }
        for (int i = t; i < 4 * SEQ; i += NTHR) { const int b = i >> 12, l = i & 4095;
            U[l * 4 + b] = hy_short(HYT + ((size_t)b * 768 + 512 + c) * POS, l, SEQ, wv[0], wv[1], wv[2]); }
        __syncthreads();
        const int t0 = t * 8;
        for (int n = 0; n < 2; ++n) {
            f32x4 acc[8];
#pragma unroll
            for (int j = 0; j < 8; ++j) acc[j] = (f32x4){0.f, 0.f, 0.f, 0.f};
            const LAS float* kf = KF + n * 8192;
#pragma unroll 1
            for (int s0 = 0; s0 < SEQ; s0 += 8) {
                const int base = t0 - s0 + 4088;
                float kw[16];
#pragma unroll
                for (int q = 0; q < 4; ++q) { const f32x4 x = *(const LAS f32x4*)(kf + base + 4 * q); kw[4 * q] = x[0]; kw[4 * q + 1] = x[1]; kw[4 * q + 2] = x[2]; kw[4 * q + 3] = x[3]; }
#pragma unroll
                for (int i = 0; i < 8; ++i) { const f32x4 uv = *(const LAS f32x4*)(U + (s0 + i) * 4);
#pragma unroll
                    for (int j = 0; j < 8; ++j) acc[j] += uv * kw[8 + j - i]; }
            }
            float zo[8][4];
            const int xch = n == 0 ? c : 256 + c; const float* wg = n == 0 ? wx1 : wx2; const float bias = n == 0 ? bias0 : bias1;
#pragma unroll
            for (int b = 0; b < 4; ++b) {
                const float* hp = HYT + ((size_t)b * 768 + xch) * POS;
                const f32x4 h0 = *(const f32x4*)(hp + t0), h1 = *(const f32x4*)(hp + t0 + 4);
                const float hm = t0 > 0 ? hp[t0 - 1] : 0.f, hn = t0 + 8 < SEQ ? hp[t0 + 8] : 0.f;
                const float hv[10] = {hm, h0[0], h0[1], h0[2], h0[3], h1[0], h1[1], h1[2], h1[3], hn};
#pragma unroll
                for (int j = 0; j < 8; ++j) { const float g = wg[0] * hv[j] + wg[1] * hv[j + 1] + wg[2] * hv[j + 2];
                    zo[j][b] = g * (acc[j][b] + bias * U[(t0 + j) * 4 + b]); }
            }
            __syncthreads();
            if (n == 0) {
#pragma unroll
                for (int j = 0; j < 8; ++j) *(LAS f32x4*)(U + (t0 + j) * 4) = (f32x4){zo[j][0], zo[j][1], zo[j][2], zo[j][3]};
                __syncthreads();
            } else {
#pragma unroll
                for (int j = 0; j < 8; ++j)
#pragma unroll
                    for (int b = 0; b < 4; ++b) MIX[((size_t)b * SEQ + t0 + j) * DM + c] = f2bf(zo[j][b]);
            }
        }
    }
    __syncthreads();
}
#endif
DI void hyena_ctx_unit(const Frame& F, int ly, int c) {
    LAS float* KF = (LAS float*)F.lds;
    LAS float* U = KF + 16384;
    const int t = F.tid;
    const float* HYT = (const float*)(F.ws + WS_HYT);
    const float* scw = F.in[8] + (size_t)ly * 3 * 768;
    const float* invl = (const float*)(F.ws + WS_INVL1) + (size_t)ly * 1024;
    const float bias0 = F.in[15][(size_t)ly * 512 + c], bias1 = F.in[15][(size_t)ly * 512 + 256 + c];
    float wx1[3], wx2[3], wv[3];
#pragma unroll
    for (int j = 0; j < 3; ++j) { wx1[j] = scw[j * 768 + c]; wx2[j] = scw[j * 768 + 256 + c]; wv[j] = scw[j * 768 + 512 + c]; }
    bf16_t* MIX = (bf16_t*)(F.ws + WS_MIX);
    {
        LAS float* KC = (LAS float*)F.lds;
        LAS float* UC = KC + 1024;
        for (int n = 0; n < 2; ++n) { const float inv = invl[(1 * 2 + n) * 256 + c];
            const float* hf = (const float*)(F.ws + WS_HCC) + ((((size_t)ly * 2 + n) * 2 + 0) * 256 + c) * CTXL;
            const float* hb = (const float*)(F.ws + WS_HCC) + ((((size_t)ly * 2 + n) * 2 + 1) * 256 + c) * CTXL;
            for (int i = t; i < 512; i += NTHR) { const int d = i - 256; KC[n * 512 + i] = d >= 0 ? hf[d] * inv : (d > -256 ? hb[-d] * inv : 0.f); } }
        for (int i = t; i < 4 * CTXL; i += NTHR) { const int b = i >> 8, l = i & 255;
            UC[l * 4 + b] = hy_short(HYT + ((size_t)b * 768 + 512 + c) * POS + SEQ, l, CTXL, wv[0], wv[1], wv[2]); }
        __syncthreads();
        const int tt = t & 255, bp = t >> 8;
        for (int n = 0; n < 2; ++n) {
            float a0 = 0.f, a1 = 0.f;
            for (int s = 0; s < CTXL; ++s) { const float k = KC[n * 512 + tt - s + 256]; a0 += k * UC[s * 4 + 2 * bp]; a1 += k * UC[s * 4 + 2 * bp + 1]; }
            const int xch = n == 0 ? c : 256 + c; const float* wg = n == 0 ? wx1 : wx2; const float bias = n == 0 ? bias0 : bias1;
            const float g0 = hy_short(HYT + ((size_t)(2 * bp) * 768 + xch) * POS + SEQ, tt, CTXL, wg[0], wg[1], wg[2]);
            const float g1 = hy_short(HYT + ((size_t)(2 * bp + 1) * 768 + xch) * POS + SEQ, tt, CTXL, wg[0], wg[1], wg[2]);
            const float z0 = g0 * (a0 + bias * UC[tt * 4 + 2 * bp]), z1 = g1 * (a1 + bias * UC[tt * 4 + 2 * bp + 1]);
            __syncthreads();
            if (n == 0) { UC[tt * 4 + 2 * bp] = z0; UC[tt * 4 + 2 * bp + 1] = z1; __syncthreads(); }
            else { MIX[((size_t)RLAT + (2 * bp) * CTXL + tt) * DM + c] = f2bf(z0); MIX[((size_t)RLAT + (2 * bp + 1) * CTXL + tt) * DM + c] = f2bf(z1); }
        }
    }
    __syncthreads();
}


DI unsigned cx_addr(unsigned e) { return e * 8u + (e >> 5) * 16u; }
constexpr int cx_bytes(int n) { return n * 8 + (n / 32) * 16; }
typedef float f32x2 __attribute__((ext_vector_type(2)));
template <int R> DI constexpr int brev(int q) { int r = 0; for (int i = 1, j = R >> 1; i < R; i <<= 1, j >>= 1) if (q & i) r |= j; return r; }
template <int R, bool INV> DI void dft_inreg(float (&re)[R], float (&im)[R]) {
#pragma unroll
    for (int len = R; len >= 2; len >>= 1) { const int half = len >> 1;
#pragma unroll
        for (int base = 0; base < R; base += len)
#pragma unroll
            for (int j = 0; j < half; ++j) {
                const float ar = re[base + j], ai = im[base + j], br = re[base + j + half], bi = im[base + j + half];
                re[base + j] = ar + br; im[base + j] = ai + bi;
                const float dr = ar - br, di = ai - bi;
                if (j == 0) { re[base + j + half] = dr; im[base + j + half] = di; }
                else if (4 * j == len) { if (INV) { re[base + j + half] = -di; im[base + j + half] = dr; } else { re[base + j + half] = di; im[base + j + half] = -dr; } }
                else { const float c = __builtin_cosf(6.283185307179586f * (float)j / (float)len), sn = (INV ? 1.f : -1.f) * __builtin_sinf(6.283185307179586f * (float)j / (float)len);
                    re[base + j + half] = dr * c - di * sn; im[base + j + half] = dr * sn + di * c; }
            }
    }
}
template <int R, bool INV> DI void fft_bfly(LAS unsigned char* seq, int j, int s, int lg_s, int Lcur) {
    int jj = j; asm volatile("" : "+v"(jj));
    const int blk = jj >> lg_s, o = jj & (s - 1); const int e0 = blk * Lcur + o;
    float re[R], im[R];
    if (s == 1) {
#pragma unroll
        for (int r = 0; r < R; r += 2) { const f32x4 v = *(const LAS f32x4*)(seq + cx_addr(e0 + r)); re[r] = v[0]; im[r] = v[1]; re[r + 1] = v[2]; im[r + 1] = v[3]; }
    } else {
#pragma unroll
        for (int r = 0; r < R; ++r) { const f32x2 v = *(const LAS f32x2*)(seq + cx_addr(e0 + r * s)); re[r] = v[0]; im[r] = v[1]; }
    }
    if (s == 1) {
        dft_inreg<R, INV>(re, im);
    } else {
        const int oo = o;
        float ws, wc; sincospif(2.0f * (float)oo / (float)Lcur, &ws, &wc); if (!INV) ws = -ws;
        if (!INV) {
            dft_inreg<R, false>(re, im);
            float cr = wc, ci = ws;
#pragma unroll
            for (int q = 1; q < R; ++q) { const int k = brev<R>(q); const float xr = re[k], xi = im[k]; re[k] = xr * cr - xi * ci; im[k] = xr * ci + xi * cr;
                const float nr = cr * wc - ci * ws, ni = cr * ws + ci * wc; cr = nr; ci = ni; }
        } else {
            float cr = wc, ci = ws;
#pragma unroll
            for (int q = 1; q < R; ++q) { const float xr = re[q], xi = im[q]; re[q] = xr * cr - xi * ci; im[q] = xr * ci + xi * cr;
                const float nr = cr * wc - ci * ws, ni = cr * ws + ci * wc; cr = nr; ci = ni; }
            dft_inreg<R, true>(re, im);
        }
    }
    if (s == 1) {
#pragma unroll
        for (int r = 0; r < R; r += 2) { const int k0 = brev<R>(r), k1 = brev<R>(r + 1); *(LAS f32x4*)(seq + cx_addr(e0 + r)) = (f32x4){re[k0], im[k0], re[k1], im[k1]}; }
    } else {
#pragma unroll
        for (int r = 0; r < R; ++r) { const int k = brev<R>(r); *(LAS f32x2*)(seq + cx_addr(e0 + r * s)) = (f32x2){re[k], im[k]}; }
    }
}
template <bool INV> DI void fft8192x2(LAS unsigned char* lds, int tid) {
    constexpr int SB = cx_bytes(8192);
    if (!INV) {
        fft_bfly<16, false>(lds, tid, 512, 9, 8192); __builtin_amdgcn_sched_barrier(0); fft_bfly<16, false>(lds + SB, tid, 512, 9, 8192); __syncthreads();
        fft_bfly<16, false>(lds, tid, 32, 5, 512); __builtin_amdgcn_sched_barrier(0); fft_bfly<16, false>(lds + SB, tid, 32, 5, 512); __syncthreads();
        fft_bfly<32, false>(lds + (tid >> 8) * SB, tid & 255, 1, 0, 32); __syncthreads();
    } else {
        fft_bfly<32, true>(lds + (tid >> 8) * SB, tid & 255, 1, 0, 32); __syncthreads();
        fft_bfly<16, true>(lds, tid, 32, 5, 512); __builtin_amdgcn_sched_barrier(0); fft_bfly<16, true>(lds + SB, tid, 32, 5, 512); __syncthreads();
        fft_bfly<16, true>(lds, tid, 512, 9, 8192); __builtin_amdgcn_sched_barrier(0); fft_bfly<16, true>(lds + SB, tid, 512, 9, 8192); __syncthreads();
    }
}
DI void fft4096x4(LAS unsigned char* lds, int tid) {
    constexpr int SB = cx_bytes(4096);
    const int sq = tid >> 8, j = tid & 255;
    fft_bfly<16, false>(lds + sq * SB, j, 256, 8, 4096); __builtin_amdgcn_sched_barrier(0); fft_bfly<16, false>(lds + (sq + 2) * SB, j, 256, 8, 4096); __syncthreads();
    fft_bfly<16, false>(lds + sq * SB, j, 16, 4, 256); __builtin_amdgcn_sched_barrier(0); fft_bfly<16, false>(lds + (sq + 2) * SB, j, 16, 4, 256); __syncthreads();
    fft_bfly<16, false>(lds + sq * SB, j, 1, 0, 16); __builtin_amdgcn_sched_barrier(0); fft_bfly<16, false>(lds + (sq + 2) * SB, j, 1, 0, 16); __syncthreads();
}

DI void hyena_fft_unit(const Frame& F, int ly, int c) {
    LAS unsigned char* L = F.lds; constexpr int SB = cx_bytes(8192);
    const int t = F.tid;
    const float* HYT = (const float*)(F.ws + WS_HYT);
    const float* scw = F.in[8] + (size_t)ly * 3 * 768;
    const float* invl = (const float*)(F.ws + WS_INVL1) + (size_t)ly * 1024;
    const float bias0 = F.in[15][(size_t)ly * 512 + c], bias1 = F.in[15][(size_t)ly * 512 + 256 + c];
    float wx1[3], wx2[3], wv[3];
#pragma unroll
    for (int j = 0; j < 3; ++j) { wx1[j] = scw[j * 768 + c]; wx2[j] = scw[j * 768 + 256 + c]; wv[j] = scw[j * 768 + 512 + c]; }
    f32x2* SPEC = (f32x2*)(F.ws + WS_SPEC) + (size_t)c * 2 * 8192;
    for (int n = 0; n < 2; ++n) { const float inv = invl[(0 * 2 + n) * 256 + c];
        const float* hf = (const float*)(F.ws + WS_HCL) + ((((size_t)ly * 2 + n) * 2 + 0) * 256 + c) * SEQ;
        const float* hb = (const float*)(F.ws + WS_HCL) + ((((size_t)ly * 2 + n) * 2 + 1) * 256 + c) * SEQ;
#pragma unroll 2
    for (int i = t; i < 8192; i += NTHR) { const float v = i < SEQ ? hf[i] * inv : (i > SEQ ? hb[8192 - i] * inv : 0.f);
            *(LAS f32x2*)(L + n * SB + cx_addr(i)) = (f32x2){v * (1.0f / 8192.0f), 0.f}; } }
    __syncthreads();
    fft8192x2<false>(L, t);
    for (int n = 0; n < 2; ++n)
#pragma unroll 4
        for (int i = t; i < 8192; i += NTHR) SPEC[n * 8192 + i] = *(const LAS f32x2*)(L + n * SB + cx_addr(i));
    __syncthreads();
#pragma unroll 2
    for (int i = t; i < 8192; i += NTHR) {
        f32x2 a = {0.f, 0.f}, b = {0.f, 0.f};
        if (i < SEQ) { a[0] = hy_short(HYT + ((size_t)0 * 768 + 512 + c) * POS, i, SEQ, wv[0], wv[1], wv[2]); a[1] = hy_short(HYT + ((size_t)1 * 768 + 512 + c) * POS, i, SEQ, wv[0], wv[1], wv[2]);
                       b[0] = hy_short(HYT + ((size_t)2 * 768 + 512 + c) * POS, i, SEQ, wv[0], wv[1], wv[2]); b[1] = hy_short(HYT + ((size_t)3 * 768 + 512 + c) * POS, i, SEQ, wv[0], wv[1], wv[2]); }
        *(LAS f32x2*)(L + cx_addr(i)) = a; *(LAS f32x2*)(L + SB + cx_addr(i)) = b; }
    __syncthreads();
    f32x4* Z1 = (f32x4*)(F.ws + WS_Z1) + (size_t)c * SEQ;
    bf16_t* MIX = (bf16_t*)(F.ws + WS_MIX);
#pragma unroll 1
    for (int n = 0; n < 2; ++n) {
        fft8192x2<false>(L, t);
#pragma unroll 2
    for (int i = t; i < 8192; i += NTHR) { const f32x2 h = SPEC[n * 8192 + i];
            f32x2 a = *(const LAS f32x2*)(L + cx_addr(i)), b = *(const LAS f32x2*)(L + SB + cx_addr(i));
            *(LAS f32x2*)(L + cx_addr(i)) = (f32x2){a[0] * h[0] - a[1] * h[1], a[0] * h[1] + a[1] * h[0]};
            *(LAS f32x2*)(L + SB + cx_addr(i)) = (f32x2){b[0] * h[0] - b[1] * h[1], b[0] * h[1] + b[1] * h[0]}; }
        __syncthreads();
        fft8192x2<true>(L, t);
        const int xch = n == 0 ? c : 256 + c; const float* wg = n == 0 ? wx1 : wx2; const float bias = n == 0 ? bias0 : bias1;
#pragma unroll 1
        for (int i = 0; i < 8; ++i) { const int l = t + 512 * i;
            const f32x2 a = *(const LAS f32x2*)(L + cx_addr(l)), b = *(const LAS f32x2*)(L + SB + cx_addr(l));
            const float y[4] = {a[0], a[1], b[0], b[1]};
            f32x4 zin;
            if (n == 0) {
#pragma unroll
                for (int bb = 0; bb < 4; ++bb) zin[bb] = hy_short(HYT + ((size_t)bb * 768 + 512 + c) * POS, l, SEQ, wv[0], wv[1], wv[2]);
            } else zin = Z1[l];
            f32x4 zo;
#pragma unroll
            for (int bb = 0; bb < 4; ++bb) { const float g = hy_short(HYT + ((size_t)bb * 768 + xch) * POS, l, SEQ, wg[0], wg[1], wg[2]);
                zo[bb] = g * (y[bb] + bias * zin[bb]); }
            if (n == 0) { Z1[l] = zo; }
            else {
#pragma unroll
                for (int bb = 0; bb < 4; ++bb) MIX[((size_t)bb * SEQ + l) * DM + c] = f2bf(zo[bb]); }
            asm volatile("" ::: "memory");
            if (n == 0) { *(LAS f32x2*)(L + cx_addr(l)) = (f32x2){zo[0], zo[1]}; *(LAS f32x2*)(L + SB + cx_addr(l)) = (f32x2){zo[2], zo[3]};
                *(LAS f32x2*)(L + cx_addr(l + SEQ)) = (f32x2){0.f, 0.f}; *(LAS f32x2*)(L + SB + cx_addr(l + SEQ)) = (f32x2){0.f, 0.f}; }
        }
        __syncthreads();
    }
    __syncthreads();
}

DI void fnet_fft_unit(const Frame& F, int u) {
    LAS unsigned char* L = F.lds; constexpr int SB = cx_bytes(4096);
    const int t = F.tid, b = u >> 6, gd0 = (u & 63) * 4;
    const bf16_t* YT = (const bf16_t*)(F.ws + WS_YTL) + ((size_t)b * 256 + gd0) * 8192;
    for (int i = t; i < 4 * 512; i += NTHR) { const int q = i >> 9, l0 = (i & 511) * 8;
        const u32x4 r = *(const u32x4*)(YT + (size_t)q * 8192 + l0), m = *(const u32x4*)(YT + (size_t)q * 8192 + 4096 + l0);
        const float rr[8] = {bflo(r.x), bfhi(r.x), bflo(r.y), bfhi(r.y), bflo(r.z), bfhi(r.z), bflo(r.w), bfhi(r.w)};
        const float mm[8] = {bflo(m.x), bfhi(m.x), bflo(m.y), bfhi(m.y), bflo(m.z), bfhi(m.z), bflo(m.w), bfhi(m.w)};
#pragma unroll
        for (int j = 0; j < 8; j += 2) *(LAS f32x4*)(L + q * SB + cx_addr(l0 + j)) = (f32x4){rr[j], mm[j], rr[j + 1], mm[j + 1]}; }
    __syncthreads();
    fft4096x4(L, t);
    bf16_t* MIX = (bf16_t*)(F.ws + WS_MIX);
#pragma unroll
    for (int i = 0; i < 8; ++i) { const int p = t + 512 * i; const int f = (p >> 8) + 16 * ((p >> 4) & 15) + 256 * (p & 15);
        float v[4];
#pragma unroll
        for (int q = 0; q < 4; ++q) v[q] = (*(const LAS f32x2*)(L + q * SB + cx_addr(p)))[0] * (1.0f / 512.0f);
        u32x2 w; w.x = cvt_pk_bf16(v[0], v[1]); w.y = cvt_pk_bf16(v[2], v[3]);
        *(u32x2*)(MIX + ((size_t)b * SEQ + f) * DM + 768 + gd0) = w; }
    __syncthreads();
}

DI void attn_unit(const Frame& F, int ly, int uid, float lam, float out_scale) {
    const int t = F.tid, lane = F.lane, wave = F.wave;
    LAS unsigned char* L = F.lds;
    constexpr int KOFF = 0, VOFF = 16384, RED = 32768;
    int bh, q0, k_lo, k_hi;
    if (uid < 512) { bh = uid >> 4; q0 = (uid & 15) << 8; k_lo = 0; k_hi = POS; }
    else { bh = uid - 512; q0 = SEQ; k_lo = SEQ; k_hi = POS; }
    const bf16_t* Qg = (const bf16_t*)(F.ws + WS_Q) + (size_t)bh * POS * 64;
    const bf16_t* Kg = (const bf16_t*)(F.ws + WS_K) + (size_t)bh * POS * 64;
    const bf16_t* Vg = (const bf16_t*)(F.ws + WS_V) + (size_t)bh * POS * 64;
    const int qi = lane & 31, hh = lane >> 5;
    const int qpos = q0 + wave * 32 + qi;
    bf16x8 qf[2][2];
    float q2[2] = {0.f, 0.f};
#pragma unroll
    for (int comp = 0; comp < 2; ++comp)
#pragma unroll
        for (int ks = 0; ks < 2; ++ks) { qf[comp][ks] = *(const bf16x8*)(Qg + (size_t)qpos * 64 + comp * 32 + ks * 16 + hh * 8);
#pragma unroll
            for (int j = 0; j < 8; ++j) { const float x = bf2f((unsigned short)qf[comp][ks][j]); q2[comp] += x * x; } }
    q2[0] += __shfl_xor(q2[0], 32); q2[1] += __shfl_xor(q2[1], 32);
    float km = 0.f;
    for (int key = k_lo + (t >> 3); key < k_hi; key += 64) {
        const bf16x8 kv = *(const bf16x8*)(Kg + (size_t)key * 64 + (t & 7) * 8);
        float s = 0.f;
#pragma unroll
        for (int j = 0; j < 8; ++j) { const float x = bf2f((unsigned short)kv[j]); s += x * x; }
        s += __shfl_xor(s, 1); s += __shfl_xor(s, 2);
        km = fmaxf(km, s);
    }
    km = fmaxf(km, __shfl_xor(km, 8)); km = fmaxf(km, __shfl_xor(km, 16)); km = fmaxf(km, __shfl_xor(km, 32));
    __syncthreads();
    LAS float* red = (LAS float*)(L + RED);
    if (lane == 0) red[wave * 2] = km; if (lane == 4) red[wave * 2 + 1] = km;
    __syncthreads();
    float kmax2[2] = {0.f, 0.f};
#pragma unroll
    for (int w = 0; w < 8; ++w) { kmax2[0] = fmaxf(kmax2[0], red[w * 2]); kmax2[1] = fmaxf(kmax2[1], red[w * 2 + 1]); }
    f32x16 negm[2];
#pragma unroll
    for (int comp = 0; comp < 2; ++comp) { const float m = -sqrtf(q2[comp] * kmax2[comp]) * 1.0001f;
#pragma unroll
        for (int i = 0; i < 16; ++i) negm[comp][i] = m; }
    f32x16 O[2][2];
#pragma unroll
    for (int a = 0; a < 2; ++a)
#pragma unroll
        for (int b = 0; b < 2; ++b)
#pragma unroll
            for (int i = 0; i < 16; ++i) O[a][b][i] = 0.f;
    float lsum[2] = {0.f, 0.f};
    const int sk = t >> 3, sc = t & 7;
    const unsigned kst = (unsigned)(sk * 128 + ((sc ^ ((sk >> 1) & 7)) << 4));
    const unsigned vst = (unsigned)(sk * 128 + ((((sc >> 1) ^ (sk & 3))) << 5) + ((sc & 1) << 4));
    const int ntile = (k_hi - k_lo) >> 6;
    u32x4 kreg = *(const u32x4*)(Kg + (size_t)(k_lo + sk) * 64 + sc * 8);
    u32x4 vreg = *(const u32x4*)(Vg + (size_t)(k_lo + sk) * 64 + sc * 8);
    *(LAS u32x4*)(L + KOFF + kst) = kreg; *(LAS u32x4*)(L + VOFF + vst) = vreg;
    __syncthreads();
    const int p4 = lane & 3, q4 = (lane & 15) >> 2, blk = (lane >> 4) & 1;
    for (int it = 0; it < ntile; ++it) {
        const int buf = it & 1;
        if (it + 1 < ntile) { const size_t kk = (size_t)(k_lo + (it + 1) * 64 + sk) * 64 + sc * 8; kreg = *(const u32x4*)(Kg + kk); vreg = *(const u32x4*)(Vg + kk); }
        const unsigned kb_base = KOFF + buf * 8192, vb_base = VOFF + buf * 8192;
#pragma unroll 1
        for (int kb = 0; kb < 2; ++kb) {
            bf16x8 vf[2][2];
            {
                const int keyq = 4 * hh + q4;
                const unsigned a0 = vb_base + (unsigned)((kb * 32 + keyq) * 128) + (unsigned)((((0 + blk) ^ (keyq & 3))) << 5) + (unsigned)(p4 * 8);
                const unsigned a1 = vb_base + (unsigned)((kb * 32 + keyq) * 128) + (unsigned)((((2 + blk) ^ (keyq & 3))) << 5) + (unsigned)(p4 * 8);
                s16x4 r0, r1, r2, r3, r4, r5, r6, r7;
                asm volatile("ds_read_b64_tr_b16 %0, %8\n\tds_read_b64_tr_b16 %1, %8 offset:1024\n\tds_read_b64_tr_b16 %2, %8 offset:2048\n\tds_read_b64_tr_b16 %3, %8 offset:3072\n\t"
                             "ds_read_b64_tr_b16 %4, %9\n\tds_read_b64_tr_b16 %5, %9 offset:1024\n\tds_read_b64_tr_b16 %6, %9 offset:2048\n\tds_read_b64_tr_b16 %7, %9 offset:3072\n\ts_waitcnt lgkmcnt(0)"
                             : "=&v"(r0), "=&v"(r1), "=&v"(r2), "=&v"(r3), "=&v"(r4), "=&v"(r5), "=&v"(r6), "=&v"(r7) : "v"(a0), "v"(a1) : "memory");
                vf[0][0] = __builtin_shufflevector(r0, r1, 0, 1, 2, 3, 4, 5, 6, 7); vf[1][0] = __builtin_shufflevector(r2, r3, 0, 1, 2, 3, 4, 5, 6, 7);
                vf[0][1] = __builtin_shufflevector(r4, r5, 0, 1, 2, 3, 4, 5, 6, 7); vf[1][1] = __builtin_shufflevector(r6, r7, 0, 1, 2, 3, 4, 5, 6, 7);
            }
#pragma unroll
            for (int comp = 0; comp < 2; ++comp) {
                const int key = kb * 32 + qi;
                const bf16x8 k0 = *(const LAS bf16x8*)(L + kb_base + key * 128 + (((comp * 4 + 0 + hh) ^ ((key >> 1) & 7)) << 4));
                const bf16x8 k1 = *(const LAS bf16x8*)(L + kb_base + key * 128 + (((comp * 4 + 2 + hh) ^ ((key >> 1) & 7)) << 4));
                f32x16 S = __builtin_amdgcn_mfma_f32_32x32x16_bf16(k0, qf[comp][0], negm[comp], 0, 0, 0);
                S = __builtin_amdgcn_mfma_f32_32x32x16_bf16(k1, qf[comp][1], S, 0, 0, 0);
                float ps = 0.f;
#pragma unroll
                for (int i = 0; i < 16; ++i) { S[i] = __builtin_amdgcn_exp2f(S[i]); ps += S[i]; }
                lsum[comp] += ps;
#pragma unroll
                for (int s = 0; s < 2; ++s) {
                    const bf16x8 pf = pack8(S[8 * s], S[8 * s + 1], S[8 * s + 2], S[8 * s + 3], S[8 * s + 4], S[8 * s + 5], S[8 * s + 6], S[8 * s + 7]);
                    O[comp][0] = __builtin_amdgcn_mfma_f32_32x32x16_bf16(vf[s][0], pf, O[comp][0], 0, 0, 0);
                    O[comp][1] = __builtin_amdgcn_mfma_f32_32x32x16_bf16(vf[s][1], pf, O[comp][1], 0, 0, 0);
                }
            }
        }
        if (it + 1 < ntile) { *(LAS u32x4*)(L + KOFF + (buf ^ 1) * 8192 + kst) = kreg; *(LAS u32x4*)(L + VOFF + (buf ^ 1) * 8192 + vst) = vreg; }
        __syncthreads();
    }
    const float l0 = lsum[0] + __shfl_xor(lsum[0], 32), l1 = lsum[1] + __shfl_xor(lsum[1], 32);
    const float i0 = 1.0f / l0, i1 = lam / l1;
    float ss = 0.f;
#pragma unroll
    for (int dvb = 0; dvb < 2; ++dvb)
#pragma unroll
        for (int i = 0; i < 16; ++i) { const float o = O[0][dvb][i] * i0 - O[1][dvb][i] * i1; O[0][dvb][i] = o; ss += o * o; }
    ss += __shfl_xor(ss, 32);
    const float rn = rsqrtf(ss * (1.0f / 64.0f) + LN_EPS) * out_scale;
    const float* sw = F.in[20] + (size_t)ly * 64;
    const int b = bh >> 3, head = bh & 7;
    const size_t row = qpos < SEQ ? (size_t)b * SEQ + qpos : (size_t)RLAT + b * CTXL + (qpos - SEQ);
    bf16_t* dst = (bf16_t*)(F.ws + WS_MIX) + row * DM + 256 + head * 64;
#pragma unroll
    for (int dvb = 0; dvb < 2; ++dvb)
#pragma unroll
        for (int g = 0; g < 4; ++g) { const int dv = dvb * 32 + 8 * g + 4 * hh;
            const f32x4 w4 = *(const f32x4*)(sw + dv);
            u32x2 w; w.x = cvt_pk_bf16(O[0][dvb][4 * g] * rn * w4[0], O[0][dvb][4 * g + 1] * rn * w4[1]); w.y = cvt_pk_bf16(O[0][dvb][4 * g + 2] * rn * w4[2], O[0][dvb][4 * g + 3] * rn * w4[3]);
            *(u32x2*)(dst + dv) = w; }
    __syncthreads();
}

DI void phase_rows_router(const Frame& F, int ly) {
    LAS float* HS = (LAS float*)F.lds;
    LAS float* PART = HS + 16 * 1024;
    LAS float* LOG = PART + 8 * 16 * 64;
    const int lane = F.lane, wave = F.wave;
    const float* MOD = (const float*)(F.ws + WS_MOD);
    const float* g1 = F.in[22] + (size_t)ly * DM; const float* b1 = F.in[23] + (size_t)ly * DM;
    const float* rw = F.in[26] + (size_t)ly * DM * NEXP; const float* rb = F.in[27] + (size_t)ly * NEXP;
    const bool last = ly == DEPTH - 1;
    const int nrows = last ? RLAT : RTOT;
    for (int r0 = F.bid * 16; r0 < nrows; r0 += F.G * 16) {
#pragma unroll
        for (int rr = 0; rr < 2; ++rr) { const int rl = wave * 2 + rr, row = r0 + rl;
            float* xr = (float*)(F.ws + WS_X) + (size_t)row * DM;
            f32x4 v[4];
#pragma unroll
            for (int j = 0; j < 4; ++j) v[j] = *(const f32x4*)(xr + 4 * lane + 256 * j);
            float mu, rstd; ln_stats(v, mu, rstd);
#pragma unroll
            for (int j = 0; j < 4; ++j) { const int c = 4 * lane + 256 * j; const f32x4 g = *(const f32x4*)(g1 + c), bb = *(const f32x4*)(b1 + c);
#pragma unroll
                for (int e = 0; e < 4; ++e) v[j][e] = (v[j][e] - mu) * rstd * g[e] + bb[e];
                *(f32x4*)(xr + c) = v[j]; }
            ln_stats(v, mu, rstd);
            const float* m = MOD + ((size_t)ly * 5 + row_modsel(row)) * 6144;
            bf16_t* hrow = (bf16_t*)(F.ws + WS_H) + (size_t)row * DM;
#pragma unroll
            for (int j = 0; j < 4; ++j) { const int c = 4 * lane + 256 * j; const f32x4 a = *(const f32x4*)(m + 3072 + c), bsc = *(const f32x4*)(m + 4096 + c);
                f32x4 o;
#pragma unroll
                for (int e = 0; e < 4; ++e) o[e] = (v[j][e] - mu) * rstd * (1.f + bsc[e]) + a[e];
                u32x2 w; w.x = cvt_pk_bf16(o[0], o[1]); w.y = cvt_pk_bf16(o[2], o[3]); *(u32x2*)(hrow + c) = w;
                *(LAS f32x4*)(HS + rl * 1024 + c) = o; } }
        __syncthreads();
        { float acc[16];
#pragma unroll
          for (int r = 0; r < 16; ++r) acc[r] = 0.f;
          for (int k4 = 0; k4 < 32; ++k4) { const int k = wave * 128 + k4 * 4;
              const float w0 = rw[(size_t)(k + 0) * NEXP + lane], w1 = rw[(size_t)(k + 1) * NEXP + lane], w2 = rw[(size_t)(k + 2) * NEXP + lane], w3 = rw[(size_t)(k + 3) * NEXP + lane];
#pragma unroll
              for (int r = 0; r < 16; ++r) { const f32x4 h = *(const LAS f32x4*)(HS + r * 1024 + k); acc[r] += h[0] * w0 + h[1] * w1 + h[2] * w2 + h[3] * w3; } }
#pragma unroll
          for (int r = 0; r < 16; ++r) PART[(wave * 16 + r) * 64 + lane] = acc[r]; }
        __syncthreads();
#pragma unroll
        for (int rr = 0; rr < 2; ++rr) { const int rl = wave * 2 + rr, row = r0 + rl;
            float lg = 0.f;
#pragma unroll
            for (int w = 0; w < 8; ++w) lg += PART[(w * 16 + rl) * 64 + lane];
            const float s = 1.0f / (1.0f + expf(-lg));
            const float sel = s + rb[lane];
            float m1 = sel;
            m1 = fmaxf(m1, __shfl_xor(m1, 1)); m1 = fmaxf(m1, __shfl_xor(m1, 2)); m1 = fmaxf(m1, __shfl_xor(m1, 4));
            const unsigned long long bal = __ballot(sel == m1);
            const int gbase = lane & ~7;
            const unsigned gmask = (unsigned)((bal >> gbase) & 0xffull);
            const int first = gbase + __builtin_ctz(gmask);
            float m2 = (lane == first) ? -INFINITY : sel;
            m2 = fmaxf(m2, __shfl_xor(m2, 1)); m2 = fmaxf(m2, __shfl_xor(m2, 2)); m2 = fmaxf(m2, __shfl_xor(m2, 4));
            const float gs = m1 + m2;
            const int mygrp = lane >> 3;
            int grank = 0;
#pragma unroll
            for (int g = 0; g < 8; ++g) { const float o = __shfl(gs, g * 8); grank += (o > gs || (o == gs && g < mygrp)) ? 1 : 0; }
            const float msel = grank < 4 ? sel : -INFINITY;
            int rank = 0;
            for (int e = 0; e < 64; ++e) { const float o = __shfl(msel, e); rank += (o > msel || (o == msel && e < lane)) ? 1 : 0; }
            const bool chosen = rank < 8;
            const float wsum = wave_sum(chosen ? s : 0.f);
            if (chosen) { const float gate = s / wsum * 2.5f;
                ((int*)(F.ws + WS_TOPE))[(size_t)row * 8 + rank] = lane;
                ((float*)(F.ws + WS_TOPG))[(size_t)row * 8 + rank] = gate;
                const unsigned p = atomicAdd(F.ctl + CW_CNT + 64 * ly + lane, 1u);
                ((int*)(F.ws + WS_LIST))[(size_t)lane * RTOT + p] = row * 8 + rank; } }
        __syncthreads();
    }
}

DI void phase_combine(const Frame& F, int ly) {
    const int gw = F.bid * 8 + F.wave, nw = F.G * 8, lane = F.lane;
    const bool last = ly == DEPTH - 1;
    const int nrows = last ? RLAT : RTOT;
    const float* MOD = (const float*)(F.ws + WS_MOD);
    const float* g2w = F.in[24] + (size_t)ly * DM; const float* b2w = F.in[25] + (size_t)ly * DM;
    const bf16_t* YB = (const bf16_t*)(F.ws + WS_YB);
    for (int row = gw; row < nrows; row += nw) {
        const float* gates = (const float*)(F.ws + WS_TOPG) + (size_t)row * 8;
        float gt[8];
#pragma unroll
        for (int s = 0; s < 8; ++s) gt[s] = gates[s];
        f32x4 y[4];
#pragma unroll
        for (int j = 0; j < 4; ++j) { const u32x2 w = *(const u32x2*)(YB + ((size_t)row * 9 + 8) * DM + 4 * lane + 256 * j); y[j] = (f32x4){bflo(w.x), bfhi(w.x), bflo(w.y), bfhi(w.y)}; }
#pragma unroll
        for (int s = 0; s < 8; ++s)
#pragma unroll
            for (int j = 0; j < 4; ++j) { const u32x2 w = *(const u32x2*)(YB + ((size_t)row * 9 + s) * DM + 4 * lane + 256 * j);
                y[j] += (f32x4){bflo(w.x), bfhi(w.x), bflo(w.y), bfhi(w.y)} * gt[s]; }
        const float* m = MOD + ((size_t)ly * 5 + row_modsel(row)) * 6144;
        float* xr = (float*)(F.ws + WS_X) + (size_t)row * DM;
        f32x4 v[4];
#pragma unroll
        for (int j = 0; j < 4; ++j) { const int c = 4 * lane + 256 * j; const f32x4 x = *(const f32x4*)(xr + c), g2 = *(const f32x4*)(m + 5120 + c); v[j] = x * ALPHA + g2 * y[j]; }
        float mu, rstd; ln_stats(v, mu, rstd);
#pragma unroll
        for (int j = 0; j < 4; ++j) { const int c = 4 * lane + 256 * j; const f32x4 g = *(const f32x4*)(g2w + c), bb = *(const f32x4*)(b2w + c);
#pragma unroll
            for (int e = 0; e < 4; ++e) v[j][e] = (v[j][e] - mu) * rstd * g[e] + bb[e];
            if (last) *(f32x4*)(F.out + (size_t)row * DM + c) = v[j]; else *(f32x4*)(xr + c) = v[j]; }
        if (!last) { const float* mn = MOD + ((size_t)(ly + 1) * 5 + row_modsel(row)) * 6144;
            ln_mod_store(v, mn, mn + 1024, (bf16_t*)(F.ws + WS_H) + (size_t)row * DM, lane); }
    }
}


DI Frame relaunder(const Frame& F0) {
    Frame F = F0; int wv = F0.wave; asm volatile("" : "+s"(wv));
    int ln = (int)__builtin_amdgcn_mbcnt_hi(~0u, __builtin_amdgcn_mbcnt_lo(~0u, 0u)); asm volatile("" : "+v"(ln));
    F.wave = wv; F.lane = ln; F.tid = wv * 64 + ln;
    unsigned char* w = F0.ws; asm volatile("" : "+s"(w)); F.ws = w; F.ctl = (unsigned*)(w + WS_CTL);
    int b = F0.bid, g = F0.G; asm volatile("" : "+s"(b), "+s"(g)); F.bid = b; F.G = g;
    return F;
}
PHASE_FN void ph_pre0(const Frame& F0) { const Frame F = relaunder(F0); prep_weights(F, 0); prep_mod(F); prep_filters(F); prep_tables(F); prep_copy_x(F); }
PHASE_FN void ph_pre1(const Frame& F0) { const Frame F = relaunder(F0); prep_invl1(F); phase_init_h(F); }
PHASE_FN void ph_win(const Frame& F0) { const Frame F = relaunder(F0);
    pg8::Gemm g{(const bf16_t*)(F.ws + WS_H), (const bf16_t*)(F.ws + WS_WIN), DM, F.tid};
    pg8::StaticOrder S; S.init(RTOT / 256, NWIN / 256, F.G, F.bid);
    EpiWin E{F.ws};
    pg8::gemm_phase<EpiWin, pg8::StaticOrder>(F.lds, g, S, E);
}
PHASE_FN void ph_fnet(const Frame& F0) { const Frame F = relaunder(F0);
    { pg8::Gemm g{(const bf16_t*)(F.ws + WS_DFTC), (const bf16_t*)(F.ws + WS_YTC), 2 * CTXL, F.tid};
      pg8::StaticOrder S; S.init(1, 4, F.G, (F.bid + F.G - 64) % F.G);
      EpiFnet E{F.ws, 1};
      pg8::gemm_phase<EpiFnet, pg8::StaticOrder>(F.lds, g, S, E); }
    __syncthreads();
    for (int u = F.bid; u < 256; u += F.G) fnet_fft_unit(F, u);
}
PHASE_FN void ph_hyena(const Frame& F0, int ly) { const Frame F = relaunder(F0); for (int c = F.bid; c < 256; c += F.G) { hyena_fft_unit(F, ly, c); hyena_ctx_unit(F, ly, c); } }
PHASE_FN void ph_attn(const Frame& F0, int ly) { const Frame F = relaunder(F0);
    volatile LAS unsigned* MISC = (volatile LAS unsigned*)(F.lds + LDS_MISC);
    const float lam_init = 0.8f - 0.6f * expf(-0.3f * (float)ly);
    float lam;
    { float s1 = 0.f, s2 = 0.f;
      for (int i = 0; i < 32; ++i) { s1 += F.in[16][ly * 32 + i] * F.in[17][ly * 32 + i]; s2 += F.in[18][ly * 32 + i] * F.in[19][ly * 32 + i]; }
      lam = expf(s1) - expf(s2) + lam_init; }
    for (;;) {
        __syncthreads();
        if (F.tid == 0) MISC[16] = atomicAdd(F.ctl + CW_ATTN + 64 * ly, 1u);
        __syncthreads();
        const int uid = (int)MISC[16];
        if (uid >= 544) break;
        attn_unit(F, ly, uid, lam, 1.0f - lam_init);
    }
}
PHASE_FN void ph_wout(const Frame& F0, int ly) { const Frame F = relaunder(F0);
    pg8::Gemm g{(const bf16_t*)(F.ws + WS_MIX), (const bf16_t*)(F.ws + WS_WOUT), DM, F.tid};
    pg8::StaticOrder S; S.init(RTOT / 256, DM / 256, F.G, F.bid);
    EpiWout E{F.ws, ly};
    pg8::gemm_phase<EpiWout, pg8::StaticOrder>(F.lds, g, S, E);
}
PHASE_FN void ph_router(const Frame& F0, int ly) { const Frame F = relaunder(F0); phase_rows_router(F, ly); }
PHASE_FN void ph_moe1(const Frame& F0, int ly) { const Frame F = relaunder(F0);
    const MoeTab T = moe_tables(F, ly);
    pg8::Gemm g{(const bf16_t*)(F.ws + WS_H), (const bf16_t*)(F.ws + WS_WGU), DM, F.tid};
    MoeSched<true> S{T, (const int*)(F.ws + WS_LIST), F.G, F.bid, 2, 1};
    EpiMoe1 E{F.ws};
    pg8::gemm_phase<EpiMoe1, MoeSched<true>>(F.lds, g, S, E);
}
PHASE_FN void ph_moe2(const Frame& F0, int ly) { const Frame F = relaunder(F0);
    const MoeTab T = moe_tables(F, ly);
    pg8::Gemm g{(const bf16_t*)(F.ws + WS_ACT), (const bf16_t*)(F.ws + WS_WD), DEXP, F.tid};
    MoeSched<false> S{T, (const int*)(F.ws + WS_LIST), F.G, F.bid, 4, 2};
    EpiMoe2 E{F.ws, T, (const int*)(F.ws + WS_LIST)};
    pg8::gemm_phase<EpiMoe2, MoeSched<false>>(F.lds, g, S, E);
}
PHASE_FN void ph_combine(const Frame& F0, int ly) { const Frame F = relaunder(F0); phase_combine(F, ly); if (ly + 1 < DEPTH) prep_weights(F, ly + 1); }

constexpr int PH_PER_LAYER = 7, N_PHASES = 2 + DEPTH * PH_PER_LAYER;

__global__ void __launch_bounds__(NTHR, 2) hybrid_fwd(Params prm) {
    extern __shared__ __attribute__((aligned(16))) unsigned char lds_raw[];
    Frame F;
    F.in = prm.in; F.out = prm.out; F.ws = prm.ws; F.lds = (LAS unsigned char*)lds_raw; F.ctl = (unsigned*)(prm.ws + WS_CTL);
    F.tid = threadIdx.x; F.lane = F.tid & 63; F.wave = __builtin_amdgcn_readfirstlane(F.tid >> 6); F.G = gridDim.x; F.bid = blockIdx.x;
    volatile LAS unsigned* MISC = (volatile LAS unsigned*)(F.lds + LDS_MISC);
    if (F.tid < 64) MISC[F.tid] = 0u;
    __syncthreads();
    const int lo = prm.ph_lo, hi = prm.ph_hi;
    XcdBarrier bar; bar.bar = F.ctl + CW_BAR; bar.x = 0; bar.st = nullptr;
    if (hi - lo > 1) bar = xcd_barrier_post(F.ctl + CW_BAR, MISC);
#define IN(k) (lo <= (k) && (k) < hi)
#define SEAM(k) do { if (IN(k) && IN((k) + 1)) xcd_barrier(bar); } while (0)
    unsigned long long pr_acc = 0ull, pr_t0 = 0ull;
#define PR_BEGIN(kind) do { if ((PROBE_KINDS >> (kind)) & 1) pr_t0 = __builtin_amdgcn_s_memrealtime(); } while (0)
#define PR_END(kind) do { if ((PROBE_KINDS >> (kind)) & 1) pr_acc += __builtin_amdgcn_s_memrealtime() - pr_t0; } while (0)

    PR_BEGIN(0); if (IN(0) && KIND(0)) ph_pre0(F);
    SEAM(0); PR_END(0);
    PR_BEGIN(1); if (IN(1) && KIND(1)) ph_pre1(F);
    SEAM(1); PR_END(1);

    for (int ly = 0; ly < DEPTH; ++ly) {
        const int p0 = 2 + ly * PH_PER_LAYER;
        PR_BEGIN(2); if (IN(p0) && KIND(2)) ph_win(F);
        SEAM(p0); PR_END(2);
        if (IN(p0 + 1)) { PR_BEGIN(3); if (KIND(3)) ph_fnet(F); PR_END(3); PR_BEGIN(4); if (KIND(4)) ph_hyena(F, ly); PR_END(4); PR_BEGIN(5); if (KIND(5)) ph_attn(F, ly); }
        SEAM(p0 + 1); PR_END(5);
        PR_BEGIN(6); if (IN(p0 + 2) && KIND(6)) ph_wout(F, ly);
        SEAM(p0 + 2); PR_END(6);
        PR_BEGIN(7); if (IN(p0 + 3) && KIND(7)) ph_router(F, ly);
        SEAM(p0 + 3); PR_END(7);
        PR_BEGIN(8); if (IN(p0 + 4) && KIND(8)) ph_moe1(F, ly);
        SEAM(p0 + 4); PR_END(8);
        PR_BEGIN(9); if (IN(p0 + 5) && KIND(9)) ph_moe2(F, ly);
        SEAM(p0 + 5); PR_END(9);
        PR_BEGIN(10); if (IN(p0 + 6) && KIND(10)) ph_combine(F, ly);
        SEAM(p0 + 6); PR_END(10);
    }
    if (PROBE_KINDS != 0 && blockIdx.x == 0) {
        const unsigned long long t0 = __builtin_amdgcn_s_memrealtime(), wait = pr_acc * (unsigned long long)PROBE_AMP;
        while (__builtin_amdgcn_s_memrealtime() - t0 < wait) __builtin_amdgcn_s_sleep(8);
    }
#undef IN
#undef SEAM
}

extern "C" void kernel_launch(void* const* d_in, const int* in_sizes, int n_in, void* d_out, int out_size, void* d_ws, size_t ws_size, hipStream_t stream) {
    static int grid = 0;
    if (grid == 0) {
        if (n_in != 34 || out_size != RLAT * DM || ws_size < WS_END) { fprintf(stderr, "kernel_launch: unexpected problem shape (n_in %d out %d ws %zu need %zu)\n", n_in, out_size, ws_size, (size_t)WS_END); grid = -1; return; }
        int dev = 0, cus = 0, per_cu = 0;
        if (hipGetDevice(&dev) != hipSuccess || hipDeviceGetAttribute(&cus, hipDeviceAttributeMultiprocessorCount, dev) != hipSuccess) { grid = -1; return; }
        if (hipFuncSetAttribute((const void*)hybrid_fwd, hipFuncAttributeMaxDynamicSharedMemorySize, LDS_BYTES) != hipSuccess) { fprintf(stderr, "kernel_launch: hipFuncSetAttribute failed\n"); grid = -1; return; }
        if (hipOccupancyMaxActiveBlocksPerMultiprocessor(&per_cu, (const void*)hybrid_fwd, NTHR, LDS_BYTES) != hipSuccess || per_cu < 1)
            fprintf(stderr, "kernel_launch: occupancy query reports %d workgroups per CU\n", per_cu);
        (void)hipGetLastError();
        grid = cus;
    }
    if (grid < 0) return;
    (void)hipMemsetAsync((char*)d_ws + WS_CTL, 0, CTL_BYTES, stream);
    Params p{};
    for (int i = 0; i < 34; ++i) p.in[i] = (const float*)d_in[i];
    p.out = (float*)d_out; p.ws = (unsigned char*)d_ws;
#if MK_PER_PHASE
    for (int ph = 0; ph < N_PHASES; ++ph) { p.ph_lo = ph; p.ph_hi = ph + 1; hipLaunchKernelGGL(hybrid_fwd, dim3(grid), dim3(NTHR), LDS_BYTES, stream, p); }
#else
    p.ph_lo = 0; p.ph_hi = N_PHASES;
    hipLaunchKernelGGL(hybrid_fwd, dim3(grid), dim3(NTHR), LDS_BYTES, stream, p);
#endif
}
```

```cpp
#include <hip/hip_runtime.h>
#include <cstdio>
#include <cstdint>

#ifndef MK_PER_PHASE
#define MK_PER_PHASE 0
#endif

#ifndef PG8_OPAQUE_K
#define PG8_OPAQUE_K 1
#endif
#ifndef MK_OUTLINE
#define MK_OUTLINE 0
#endif
#if MK_OUTLINE
#define PHASE_FN __device__ __attribute__((noinline))
#else
#define PHASE_FN __device__ __forceinline__
#endif
#ifndef PROBE_KINDS
#define PROBE_KINDS 0
#endif
#ifndef PROBE_AMP
#define PROBE_AMP 4
#endif
#ifndef KMASK
#define KMASK 0xFFFF
#endif
#define KIND(k) ((KMASK >> (k)) & 1)
#define LAS __attribute__((address_space(3)))
typedef unsigned short bf16_t;
typedef short bf16x8 __attribute__((ext_vector_type(8)));
typedef short s16x4 __attribute__((ext_vector_type(4)));
typedef float f32x4 __attribute__((ext_vector_type(4)));
typedef float f32x16 __attribute__((ext_vector_type(16)));
typedef unsigned u32x4 __attribute__((ext_vector_type(4)));
typedef unsigned u32x2 __attribute__((ext_vector_type(2)));
#define DI __device__ __forceinline__

constexpr int NB = 4, SEQ = 4096, CTXL = 256, DM = 1024, DEPTH = 4;
constexpr int POS = SEQ + CTXL;
constexpr int RLAT = NB * SEQ, RCTX = NB * CTXL, RTOT = RLAT + RCTX;
constexpr int DIN = 2560, NWIN = 2816;
constexpr int NEXP = 64, DEXP = 256;
constexpr float LN_EPS = 1e-5f;
constexpr float ALPHA = 1.681792830507429f;
constexpr float QSCALE = 0.17677669529663687f * 1.4426950408889634f;
constexpr int MAXTILES = 680;

constexpr size_t AL(size_t x) { return (x + 255) & ~(size_t)255; }
constexpr size_t WS_CTL = 0, CTL_BYTES = 1u << 20;
constexpr size_t WS_X = WS_CTL + CTL_BYTES;
constexpr size_t WS_H = WS_X + AL((size_t)RTOT * DM * 4);
constexpr size_t WS_MOD = WS_H + AL((size_t)RTOT * DM * 2);
constexpr size_t WS_HCL = WS_MOD + AL((size_t)DEPTH * 5 * 6144 * 4);
constexpr size_t WS_HCC = WS_HCL + AL((size_t)DEPTH * 4 * 256 * SEQ * 4);
constexpr size_t WS_INVL1 = WS_HCC + AL((size_t)DEPTH * 4 * 256 * CTXL * 4);
constexpr size_t WS_DFTL = WS_INVL1 + AL((size_t)DEPTH * 2 * 2 * 256 * 4);
constexpr size_t WS_DFTC = WS_DFTL + 256;
constexpr size_t WS_ROPE = WS_DFTC + AL((size_t)CTXL * 2 * CTXL * 2);
constexpr size_t WS_WIN = WS_ROPE + AL(64 * 8 * 2 * 4);
constexpr size_t WS_WOUT = WS_WIN + AL((size_t)NWIN * DM * 2);
constexpr size_t WS_WGU = WS_WOUT + AL((size_t)DM * DM * 2);
constexpr size_t WS_WD = WS_WGU + AL((size_t)65 * 512 * DM * 2);
constexpr size_t WS_TOPE = WS_WD + AL((size_t)65 * DM * DEXP * 2);
constexpr size_t WS_TOPG = WS_TOPE + AL((size_t)RTOT * 8 * 4);
constexpr size_t WS_LIST = WS_TOPG + AL((size_t)RTOT * 8 * 4);
constexpr size_t WS_SPEC = WS_LIST + AL((size_t)NEXP * RTOT * 4);
constexpr size_t WS_Z1 = WS_SPEC + AL((size_t)256 * 2 * 8192 * 8);
constexpr size_t WS_U = WS_Z1 + AL((size_t)256 * SEQ * 4 * 4);
constexpr size_t WS_Q = WS_U;
constexpr size_t WS_K = WS_Q + AL((size_t)NB * 8 * POS * 64 * 2);
constexpr size_t WS_V = WS_K + AL((size_t)NB * 8 * POS * 64 * 2);
constexpr size_t WS_HYT = WS_V + AL((size_t)NB * 8 * POS * 64 * 2);
constexpr size_t WS_YTL = WS_HYT + AL((size_t)NB * 768 * POS * 4);
constexpr size_t WS_YTC = WS_YTL + AL((size_t)1024 * 8192 * 2);
constexpr size_t WS_MIX = WS_YTC + AL((size_t)1024 * 512 * 2);
constexpr size_t WS_U1_END = WS_MIX + AL((size_t)RTOT * DM * 2);
constexpr size_t WS_ACT = WS_U;
constexpr size_t WS_YB = WS_ACT + AL((size_t)MAXTILES * 256 * DEXP * 2);
constexpr size_t WS_U2_END = WS_YB + AL((size_t)RTOT * 9 * DM * 2);
constexpr size_t WS_END = WS_U2_END > WS_U1_END ? WS_U2_END : WS_U1_END;

constexpr int CW_BAR = 0;
constexpr int CW_ATTN = 4096;
constexpr int CW_KMAX = 4096 + 512;
constexpr int CW_CNT = 8192;
constexpr int CNT_STRIDE = 64;

DI unsigned cvt_pk_bf16(float lo, float hi) { unsigned r; asm volatile("v_cvt_pk_bf16_f32 %0, %1, %2" : "=v"(r) : "v"(lo), "v"(hi)); return r; }
DI bf16x8 pack8(float a0, float a1, float a2, float a3, float a4, float a5, float a6, float a7) {
    u32x4 p;
    asm volatile("v_cvt_pk_bf16_f32 %0, %4, %5\n\tv_cvt_pk_bf16_f32 %1, %6, %7\n\tv_cvt_pk_bf16_f32 %2, %8, %9\n\tv_cvt_pk_bf16_f32 %3, %10, %11\n\ts_nop 1"
                 : "=&v"(p[0]), "=&v"(p[1]), "=&v"(p[2]), "=&v"(p[3]) : "v"(a0), "v"(a1), "v"(a2), "v"(a3), "v"(a4), "v"(a5), "v"(a6), "v"(a7));
    return __builtin_bit_cast(bf16x8, p);
}
DI bf16_t f2bf(float x) { return (bf16_t)(cvt_pk_bf16(x, 0.f) & 0xffffu); }
DI float bf2f(unsigned short u) { return __uint_as_float(((unsigned)u) << 16); }
DI float bflo(unsigned w) { return __uint_as_float(w << 16); }
DI float bfhi(unsigned w) { return __uint_as_float(w & 0xffff0000u); }
DI float wave_sum(float v) {
#pragma unroll
    for (int o = 32; o >= 1; o >>= 1) v += __shfl_xor(v, o);
    return v;
}
DI float wave_max(float v) {
#pragma unroll
    for (int o = 32; o >= 1; o >>= 1) v = fmaxf(v, __shfl_xor(v, o));
    return v;
}

#define XB_TMO      128
#define XB_XCNT(j)  (256  + 64 * (j))
#define XB_XSUB(j)  (1280 + 64 * (j))
#define XB_XGEN(j)  (2304 + 64 * (j))
#define XB_TOP      3328
#define XB_TOPGEN   3392
#define XCD_BAR_WORDS 3456
#define XB_SPIN_CAP (1u << 18)

__device__ __forceinline__ unsigned xb_ld(unsigned* p)              { return __hip_atomic_load(p, __ATOMIC_RELAXED, __HIP_MEMORY_SCOPE_AGENT); }
__device__ __forceinline__ unsigned xb_add(unsigned* p, unsigned v) { return __hip_atomic_fetch_add(p, v, __ATOMIC_RELAXED, __HIP_MEMORY_SCOPE_AGENT); }
__device__ __forceinline__ unsigned xb_xcc_id() { return (unsigned)__builtin_amdgcn_s_getreg((3 << 11) | 20) & 0xFu; }
#define XB_SPIN(cond, bar) do { unsigned _sp = 0; while (cond) { __builtin_amdgcn_s_sleep(1); \
    if ((++_sp & 255u) == 0u) { if (xb_ld(&(bar)[XB_TMO])) break; if (_sp > XB_SPIN_CAP) { atomicAdd(&(bar)[XB_TMO], 1u); break; } } } } while (0)

struct XcdBarrier { unsigned* bar; unsigned x; volatile LAS unsigned* st; };

__device__ __forceinline__ XcdBarrier xcd_barrier_post(unsigned* bar, volatile LAS unsigned* st) {
    XcdBarrier b; b.bar = bar; b.x = xb_xcc_id(); b.st = st;
    if (threadIdx.x == 0) (void)xb_add(&bar[XB_XCNT(b.x)], 1u);
    return b;
}
__device__ __forceinline__ void xcd_barrier_complete(unsigned* bar, unsigned x, unsigned& nloc, unsigned& nx) {
    const unsigned G = gridDim.x * gridDim.y * gridDim.z;
    unsigned sum, cnt, mine, sp = 0u;
    for (;;) {
        sum = 0u; cnt = 0u; mine = 0u;
#pragma unroll
        for (unsigned j = 0; j < 16; ++j) { const unsigned c = xb_ld(&bar[XB_XCNT(j)]); sum += c; cnt += (c > 0u) ? 1u : 0u; mine = (j == x) ? c : mine; }
        if (sum == G) break;
        __builtin_amdgcn_s_sleep(1);
        if ((++sp & 255u) == 0u) { if (xb_ld(&bar[XB_TMO])) break; if (sp > XB_SPIN_CAP) { atomicAdd(&bar[XB_TMO], 1u); break; } }
    }
    nloc = mine > 0u ? mine : 1u; nx = cnt > 0u ? cnt : 1u;
}
__device__ __forceinline__ void xcd_barrier(const XcdBarrier& b) {
    asm volatile("s_waitcnt vmcnt(0)" ::: "memory");
    __syncthreads();
    if (threadIdx.x == 0) {
        unsigned* bar = b.bar;
        __builtin_amdgcn_s_waitcnt(0);
        unsigned nloc = b.st[0], nx = b.st[1];
        if (nloc == 0u) { xcd_barrier_complete(bar, b.x, nloc, nx); b.st[0] = nloc; b.st[1] = nx; }
        const unsigned old = xb_add(&bar[XB_XSUB(b.x)], 1u);
        const unsigned gen = old / nloc;
        if (old + 1u == (gen + 1u) * nloc) {
            __builtin_amdgcn_fence(__ATOMIC_RELEASE, "agent");
            asm volatile("s_waitcnt vmcnt(0)" ::: "memory");
            const unsigned og = xb_add(&bar[XB_TOP], 1u);
            const unsigned tg = og / nx;
            if (og + 1u == (tg + 1u) * nx) xb_add(&bar[XB_TOPGEN], 1u);
            else XB_SPIN(xb_ld(&bar[XB_TOPGEN]) == tg, bar);
            __builtin_amdgcn_fence(__ATOMIC_ACQUIRE, "agent");
            xb_add(&bar[XB_XGEN(b.x)], 1u);
            asm volatile("s_waitcnt vmcnt(0)" ::: "memory");
        } else {
            XB_SPIN(xb_ld(&bar[XB_XGEN(b.x)]) == gen, bar);
            __builtin_amdgcn_fence(__ATOMIC_ACQUIRE, "agent");
            asm volatile("s_waitcnt vmcnt(0)" ::: "memory");
        }
    }
    __syncthreads();
}

namespace pg8 {
constexpr int BM = 256, BK = 64, HALF = 128, HTB = HALF * BK * 2, STAGE_BYTES = 8 * HTB, NXCD = 8, WGM = 8;
__host__ __device__ __forceinline__ int lds_byte(int r, int c) { const int st = (r >> 4) * 2 + (c >> 5), rr = r & 15, cc = c & 31, ob = rr * 64 + cc * 2; return st * 1024 + (ob ^ (((ob >> 9) & 1) << 5)); }
__host__ __device__ __forceinline__ void stage_rc(int b, int& R, int& C) { const int st = b / 1024, sb = b % 1024, swz = sb ^ (((sb >> 9) & 1) << 5); R = (st >> 1) * 16 + swz / 64; C = (st & 1) * 32 + (swz % 64) / 2; }
__host__ __device__ __forceinline__ int perm32(int rho) { const int n = rho >> 4, i = rho & 15; return 8 * (i >> 2) + 4 * n + (i & 3); }

struct Unit { int pm, pn, e, lt; };
struct Gemm { const bf16_t* A; const bf16_t* Bt; int K; int tid; };

struct StaticOrder {
    static constexpr bool GATHER = false;
    int nM, nN, nwg, G, c;
    __device__ void init(int nM_, int nN_, int G_, int c_) { nM = nM_; nN = nN_; nwg = nM * nN; G = G_; c = c_; }
    __device__ bool next(int i, Unit& u) const {
        const long L = (long)i * G + c; if (L >= nwg) return false;
        int wgid = (int)L; { const int q = nwg / NXCD, r = nwg % NXCD, xcd = wgid % NXCD, off = wgid / NXCD; wgid = (xcd < r ? xcd * (q + 1) : r * (q + 1) + (xcd - r) * q) + off; }
        const int nig = WGM * nN, gid = wgid / nig, fm = gid * WGM, gsz = (nM - fm) < WGM ? (nM - fm) : WGM;
        u.pm = fm + ((wgid % nig) % gsz); u.pn = (wgid % nig) / gsz; u.e = 0; u.lt = 0; return true;
    }
    __device__ __forceinline__ int arow(const Unit& u, int r) const { return u.pm * BM + r; }
};

template <class Epi, class Sched>
__device__ __forceinline__ void gemm_phase(LAS unsigned char* lds, const Gemm g, const Sched& S, const Epi& E) {
    constexpr bool GA = Sched::GATHER;
    int tid = g.tid; asm volatile("" : "+v"(tid));
    const int wid = __builtin_amdgcn_readfirstlane(tid >> 6), lane = tid & 63, wr = wid >> 2, wc = wid & 3, fr = lane & 15, fq = lane >> 4;
    int K = g.K;
#if PG8_OPAQUE_K
    asm volatile("" : "+s"(K));
#endif
    const int nt = K / BK;
    unsigned voffA[2], voffB[2];
#pragma unroll
    for (int i = 0; i < 2; ++i) { int R, C; stage_rc(tid * 16 + i * 8192, R, C); const int Rb = Epi::PERM ? ((R & ~31) + perm32(R & 31)) : R;
        voffA[i] = (unsigned)(R * K + C) * 2u; voffB[i] = (unsigned)(Rb * K + C) * 2u; }
    const size_t kstep = (size_t)(BK * 2);
    const size_t hstep = (size_t)HALF * K * 2;
    const size_t tstep = 2 * hstep;
    const unsigned ldsw = (unsigned)wid * 1024u;
    const int aoff = lds_byte(wr * 64 + fr, fq * 8), boff = lds_byte(wc * 32 + fr, fq * 8);
#define PG8_SA(b, h) (((b) * 2 + (h)) * HTB)
#define PG8_SB(b, h) ((4 + (b) * 2 + (h)) * HTB)
#define PG8_STAGE(bufoff, gbase, voff) do { _Pragma("unroll") for (int _i = 0; _i < 2; ++_i) \
        __builtin_amdgcn_global_load_lds((const unsigned*)((const char*)(gbase) + (voff)[_i]), (LAS unsigned*)(lds + (bufoff) + ldsw + _i * 8192), 16, 0, 0); } while (0)
#define PG8_STAGEA(bufoff, gbase, o0, o1) do { \
        __builtin_amdgcn_global_load_lds((const unsigned*)((const char*)(gbase) + (o0)), (LAS unsigned*)(lds + (bufoff) + ldsw), 16, 0, 0); \
        __builtin_amdgcn_global_load_lds((const unsigned*)((const char*)(gbase) + (o1)), (LAS unsigned*)(lds + (bufoff) + ldsw + 8192), 16, 0, 0); } while (0)
#define PG8_STA(bufoff, sp, gp, o0, o1) do { if constexpr (GA) PG8_STAGEA(bufoff, gp, o0, o1); else PG8_STAGE(bufoff, sp, voffA); } while (0)
#define PG8_LDA(dst, b, h) do { _Pragma("unroll") for (int m = 0; m < 4; ++m) _Pragma("unroll") for (int k = 0; k < 2; ++k) dst[m][k] = *(const LAS bf16x8*)(lds + PG8_SA(b, h) + aoff + m * 2048 + k * 1024); } while (0)
#define PG8_LDB(dst, b, h) do { _Pragma("unroll") for (int n = 0; n < 2; ++n) _Pragma("unroll") for (int k = 0; k < 2; ++k) dst[n][k] = *(const LAS bf16x8*)(lds + PG8_SB(b, h) + boff + n * 2048 + k * 1024); } while (0)
#define PG8_MMA(ai, bj, At, Bt) do { __builtin_amdgcn_s_setprio(1); _Pragma("unroll") for (int m = 0; m < 4; ++m) _Pragma("unroll") for (int n = 0; n < 2; ++n) _Pragma("unroll") for (int k = 0; k < 2; ++k) \
        acc[ai][bj][m][n] = __builtin_amdgcn_mfma_f32_16x16x32_bf16(Bt[n][k], At[m][k], acc[ai][bj][m][n], 0, 0, 0); __builtin_amdgcn_s_setprio(0); } while (0)
#define PG8_WAIT_V(n) asm volatile("s_waitcnt vmcnt(" #n ")" ::: "memory")
#define PG8_WAIT_L(n) asm volatile("s_waitcnt lgkmcnt(" #n ")" ::: "memory")
#define PG8_BAR __builtin_amdgcn_s_barrier()
#define PG8_SCHED __builtin_amdgcn_sched_barrier(0)
#define PG8_GOFF(u, o00, o01, o10, o11) do { int _tz = g.tid; asm volatile("" : "+v"(_tz)); int _R0, _C0, _R1, _C1; stage_rc(_tz * 16, _R0, _C0); stage_rc(_tz * 16 + 8192, _R1, _C1); \
        o00 = (unsigned)(S.arow(u, _R0) * K + _C0) * 2u; o01 = (unsigned)(S.arow(u, _R1) * K + _C1) * 2u; \
        o10 = (unsigned)(S.arow(u, HALF + _R0) * K + _C0) * 2u; o11 = (unsigned)(S.arow(u, HALF + _R1) * K + _C1) * 2u; } while (0)
    Unit cur, nxt; int ui = 0;
    if (!S.next(0, cur)) return;
    f32x4 acc[2][2][4][2];
#pragma unroll
    for (int a = 0; a < 2; ++a)
#pragma unroll
        for (int b = 0; b < 2; ++b)
#pragma unroll
            for (int m = 0; m < 4; ++m)
#pragma unroll
                for (int n = 0; n < 2; ++n) acc[a][b][m][n] = (f32x4){0.f, 0.f, 0.f, 0.f};
    bf16x8 At[4][2], B0[2][2], B1[2][2];
    const char* const gA = (const char*)g.A;
    unsigned c00 = 0, c01 = 0, c10 = 0, c11 = 0, n00 = 0, n01 = 0, n10 = 0, n11 = 0;
    if constexpr (GA) PG8_GOFF(cur, c00, c01, c10, c11);
    const char* cA = gA + (GA ? (size_t)0 : (size_t)cur.pm * tstep); const char* cB = (const char*)g.Bt + (size_t)cur.pn * tstep;
    PG8_STAGE(PG8_SB(0, 0), cB, voffB); PG8_STAGE(PG8_SB(0, 1), cB + hstep, voffB); PG8_STA(PG8_SA(0, 0), cA, gA, c00, c01); PG8_STA(PG8_SA(0, 1), cA + hstep, gA, c10, c11);
    if (wr == 1) PG8_BAR;
    PG8_WAIT_V(2); PG8_BAR;
    PG8_STAGE(PG8_SB(1, 0), cB + kstep, voffB); PG8_STA(PG8_SA(1, 0), cA + kstep, gA + kstep, c00, c01); PG8_STAGE(PG8_SB(1, 1), cB + hstep + kstep, voffB);
    PG8_WAIT_V(6); PG8_BAR;
    for (;;) {
        const bool has_next = S.next(ui + 1, nxt);
        const char* nA = (has_next && !GA) ? gA + (size_t)nxt.pm * tstep : cA; const char* nB = has_next ? (const char*)g.Bt + (size_t)nxt.pn * tstep : cB;
        if constexpr (GA) { if (has_next) PG8_GOFF(nxt, n00, n01, n10, n11); else { n00 = c00; n01 = c01; n10 = c10; n11 = c11; } }
#pragma unroll 1
        for (int t = 0; t < nt; t += 2) {
            const bool last = (t == nt - 2);
            const char* a1 = cA + (size_t)(t + 1) * kstep;
            const char* a2 = last ? nA : cA + (size_t)(t + 2) * kstep; const char* b2 = last ? nB : cB + (size_t)(t + 2) * kstep;
            const char* a3 = a2 + kstep; const char* b3 = b2 + kstep;
            unsigned x00 = 0, x01 = 0, x10 = 0, x11 = 0;
            if constexpr (GA) { x00 = last ? n00 : c00; x01 = last ? n01 : c01; x10 = last ? n10 : c10; x11 = last ? n11 : c11; }
            PG8_LDB(B0, 0, 0); PG8_LDB(B1, 0, 1); PG8_SCHED; PG8_LDA(At, 0, 0); PG8_STA(PG8_SA(1, 1), a1 + hstep, a1, c10, c11);
            PG8_WAIT_V(8); PG8_WAIT_L(0); PG8_BAR; PG8_MMA(0, 0, At, B0); PG8_MMA(0, 1, At, B1); PG8_BAR; PG8_SCHED;
            PG8_LDA(At, 0, 1); PG8_STAGE(PG8_SB(0, 0), b2, voffB); PG8_STAGE(PG8_SB(0, 1), b2 + hstep, voffB); PG8_STA(PG8_SA(0, 0), a2, a2, x00, x01);
            PG8_WAIT_V(8); PG8_WAIT_L(0); PG8_BAR; PG8_MMA(1, 0, At, B0); PG8_MMA(1, 1, At, B1); PG8_BAR; PG8_SCHED;
            PG8_LDB(B0, 1, 0); PG8_LDB(B1, 1, 1); PG8_SCHED; PG8_LDA(At, 1, 0); PG8_STA(PG8_SA(0, 1), a2 + hstep, a2, x10, x11);
            PG8_WAIT_V(8); PG8_WAIT_L(0); PG8_BAR; PG8_MMA(0, 0, At, B0); PG8_MMA(0, 1, At, B1); PG8_BAR; PG8_SCHED;
            PG8_LDA(At, 1, 1); PG8_STAGE(PG8_SB(1, 0), b3, voffB); PG8_STAGE(PG8_SB(1, 1), b3 + hstep, voffB); PG8_STA(PG8_SA(1, 0), a3, a3, x00, x01);
            PG8_WAIT_V(8); PG8_WAIT_L(0); PG8_BAR; PG8_MMA(1, 0, At, B0); PG8_MMA(1, 1, At, B1); PG8_BAR; PG8_SCHED;
        }
        if (wr == 0) PG8_BAR;
        { int ln = (int)__builtin_amdgcn_mbcnt_hi(~0u, __builtin_amdgcn_mbcnt_lo(~0u, 0u)); asm volatile("" : "+v"(ln));
          E(acc, cur, wr, wc, ln & 15, ln >> 4); }
        if (!has_next) break;
#pragma unroll
        for (int a = 0; a < 2; ++a)
#pragma unroll
            for (int b = 0; b < 2; ++b)
#pragma unroll
                for (int m = 0; m < 4; ++m)
#pragma unroll
                    for (int n = 0; n < 2; ++n) acc[a][b][m][n] = (f32x4){0.f, 0.f, 0.f, 0.f};
        cur = nxt; cA = nA; cB = nB; ++ui;
        if constexpr (GA) { c00 = n00; c01 = n01; c10 = n10; c11 = n11; }
        if (wr == 1) PG8_BAR;
    }
    PG8_WAIT_V(0);
    PG8_BAR;
#undef PG8_SA
#undef PG8_SB
#undef PG8_STAGE
#undef PG8_STAGEA
#undef PG8_STA
#undef PG8_GOFF
#undef PG8_LDA
#undef PG8_LDB
#undef PG8_MMA
#undef PG8_WAIT_V
#undef PG8_WAIT_L
#undef PG8_BAR
#undef PG8_SCHED
}
}

constexpr int NTHR = 512;
constexpr int LDS_SCRATCH = 139264;
constexpr int LDS_MISC = LDS_SCRATCH;
constexpr int LDS_TAB = LDS_MISC + 256;
constexpr int LDS_BYTES = LDS_TAB + 8192;

struct Params { const float* in[34]; float* out; unsigned char* ws; int ph_lo, ph_hi; };

struct Frame {
    const float* const* in; float* out; unsigned char* ws; LAS unsigned char* lds; unsigned* ctl;
    int tid, lane, wave, G, bid;
};

DI int row_b(int row) { return row < RLAT ? (row >> 12) : ((row - RLAT) >> 8); }
DI int row_pos(int row) { return row < RLAT ? (row & 4095) : (SEQ + ((row - RLAT) & 255)); }
DI int row_modsel(int row) { return row < RLAT ? (row >> 12) : 4; }

DI void prep_tile(const Frame& F, const float* src, int ldn, int k0, int n0, bf16_t* dst, int ldk, int dst_row0) {
    LAS float* T = (LAS float*)F.lds;
    const int t = F.tid;
    { const float* p = src + (size_t)(k0 + (t >> 3)) * ldn + n0 + (t & 7) * 8;
      const f32x4 a = *(const f32x4*)p, b = *(const f32x4*)(p + 4);
      LAS float* q = T + (t >> 3) * 65 + (t & 7) * 8;
      q[0] = a[0]; q[1] = a[1]; q[2] = a[2]; q[3] = a[3]; q[4] = b[0]; q[5] = b[1]; q[6] = b[2]; q[7] = b[3]; }
    __syncthreads();
    { const int nn = t >> 3, kc = (t & 7) * 8; float v[8];
#pragma unroll
      for (int j = 0; j < 8; ++j) v[j] = T[(kc + j) * 65 + nn];
      u32x4 w; w.x = cvt_pk_bf16(v[0], v[1]); w.y = cvt_pk_bf16(v[2], v[3]); w.z = cvt_pk_bf16(v[4], v[5]); w.w = cvt_pk_bf16(v[6], v[7]);
      *(u32x4*)(dst + (size_t)(dst_row0 + nn) * ldk + k0 + kc) = w; }
    __syncthreads();
}

DI void prep_fourier_job(const Frame& F, int ly, int g, int kt) {
    LAS float* FW = (LAS float*)F.lds;
    LAS float* CS = FW + 4096;
    LAS float* P = CS + 128;
    LAS float* W = P + 8192;
    const int t = F.tid;
    const float* fw = F.in[21] + ((size_t)ly * 4 + g) * 4096;
    for (int i = t; i < 4096; i += NTHR) FW[i] = fw[i];
    if (t < 64) { float s, c; sincospif((float)t / 32.0f, &s, &c); CS[t] = c; CS[64 + t] = s; }
    { const float* p = F.in[6] + (size_t)ly * DM * DIN + (size_t)(kt * 64 + (t >> 3)) * DIN + 2304 + g * 64 + (t & 7) * 8;
      const f32x4 a = *(const f32x4*)p, b = *(const f32x4*)(p + 4);
      LAS float* q = W + (t >> 3) * 65 + (t & 7) * 8;
      q[0] = a[0]; q[1] = a[1]; q[2] = a[2]; q[3] = a[3]; q[4] = b[0]; q[5] = b[1]; q[6] = b[2]; q[7] = b[3]; }
    __syncthreads();
    for (int i = t; i < 8192; i += NTHR) {
        const int c = i >> 7, n = i & 127, comp = n >> 6, d = n & 63;
        float s = 0.f;
        for (int j = 0; j < 64; ++j) { const int a = (j * c) & 63; const float tr = comp ? -CS[64 + a] : CS[a]; s += tr * FW[j * 64 + d]; }
        P[c * 128 + n] = s;
    }
    __syncthreads();
    bf16_t* dst = (bf16_t*)(F.ws + WS_WIN);
    { const int k = t >> 3, nb = (t & 7) * 16;
      float o[16];
#pragma unroll
      for (int j = 0; j < 16; ++j) o[j] = 0.f;
      for (int c = 0; c < 64; ++c) { const float w = W[k * 65 + c];
#pragma unroll
          for (int j = 0; j < 16; ++j) o[j] += w * P[c * 128 + nb + j]; }
#pragma unroll
      for (int j = 0; j < 16; ++j) { const int n = nb + j, comp = n >> 6, d = n & 63;
          dst[(size_t)(2304 + comp * 256 + g * 64 + d) * DM + kt * 64 + k] = f2bf(o[j]); } }
    __syncthreads();
}

DI void prep_block(const Frame& F, const float* src, int ldn, int k0, int n0, bf16_t* dst, int ldk, int dst_row0) {
    LAS unsigned char* T = F.lds;
    const int kk = F.wave * 32;
    const float* p = src + (size_t)(k0 + kk) * ldn + n0 + F.lane;
    float v[32];
#pragma unroll
    for (int i = 0; i < 32; ++i) v[i] = p[(size_t)i * ldn];
#pragma unroll
    for (int j = 0; j < 4; ++j) { u32x4 w; w.x = cvt_pk_bf16(v[8 * j], v[8 * j + 1]); w.y = cvt_pk_bf16(v[8 * j + 2], v[8 * j + 3]); w.z = cvt_pk_bf16(v[8 * j + 4], v[8 * j + 5]); w.w = cvt_pk_bf16(v[8 * j + 6], v[8 * j + 7]);
        *(LAS u32x4*)(T + F.lane * 528 + (kk + 8 * j) * 2) = w; }
    __syncthreads();
#pragma unroll
    for (int q = 0; q < 4; ++q) { const int n = q * 16 + (F.tid >> 5), ch = F.tid & 31;
        const u32x4 w = *(const LAS u32x4*)(T + n * 528 + ch * 16);
        *(u32x4*)(dst + (size_t)(dst_row0 + n) * ldk + k0 + ch * 8) = w; }
    __syncthreads();
}
DI void prep_weights(const Frame& F, int ly) {
    constexpr int J1 = 144, J2 = J1 + 64, J3 = J2 + 1040, J4 = J3 + 1040, J5 = J4 + 1040, J6 = J5 + 64;
    for (int j = F.bid; j < J6; j += F.G) {
        if (j < J1) { const int kb = j / 36, nb = j % 36;
            prep_block(F, F.in[6] + (size_t)ly * DM * DIN, DIN, kb * 256, nb * 64, (bf16_t*)(F.ws + WS_WIN), DM, nb * 64);
        } else if (j < J2) { const int q = j - J1, kb = q >> 4, nb = q & 15;
            prep_block(F, F.in[7] + (size_t)ly * DM * DM, DM, kb * 256, nb * 64, (bf16_t*)(F.ws + WS_WOUT), DM, nb * 64);
        } else if (j < J4) { const bool up = j >= J3; const int q = j - (up ? J3 : J2), e = q >> 4, kb = (q >> 2) & 3, nb = q & 3;
            const float* src = e < NEXP ? F.in[up ? 29 : 28] + ((size_t)ly * NEXP + e) * DM * DEXP : F.in[up ? 32 : 31] + (size_t)ly * DM * DEXP;
            const int hid0 = nb * 64, jj = hid0 >> 7;
            prep_block(F, src, DEXP, kb * 256, hid0, (bf16_t*)(F.ws + WS_WGU), DM, e * 512 + jj * 256 + (up ? 128 : 0) + (hid0 & 127));
        } else if (j < J5) { const int q = j - J4, e = q >> 4, nb = q & 15;
            const float* src = e < NEXP ? F.in[30] + ((size_t)ly * NEXP + e) * DEXP * DM : F.in[33] + (size_t)ly * DEXP * DM;
            prep_block(F, src, DM, 0, nb * 64, (bf16_t*)(F.ws + WS_WD), DEXP, e * DM + nb * 64);
        } else { const int q = j - J5; prep_fourier_job(F, ly, q >> 4, q & 15); }
    }
}

DI void prep_mod(const Frame& F) {
    LAS float* S = (LAS float*)F.lds;
    LAS float* RED = S + 5 * 1024;
    const int t = F.tid;
    bool have_s = false;
    for (int u = F.bid; u < DEPTH * 96; u += F.G) {
        const int ly = u / 96, cg = u % 96;
        if (!have_s) {
            for (int i = t; i < 5 * 1024; i += NTHR) { const int r = i >> 10, k = i & 1023; const float x = r < 4 ? F.in[1][r * DM + k] : F.in[3][k]; S[i] = x / (1.f + expf(-x)); }
            __syncthreads(); have_s = true;
        }
        const int tq = t & 15, tk = t >> 4;
        const float* w = F.in[4] + (size_t)ly * DM * 6144 + cg * 64 + tq * 4;
        f32x4 acc[5];
#pragma unroll
        for (int r = 0; r < 5; ++r) acc[r] = (f32x4){0.f, 0.f, 0.f, 0.f};
        for (int kk = 0; kk < 32; ++kk) { const int k = tk * 32 + kk; const f32x4 wv = *(const f32x4*)(w + (size_t)k * 6144);
#pragma unroll
            for (int r = 0; r < 5; ++r) acc[r] += wv * S[r * 1024 + k]; }
#pragma unroll
        for (int r = 0; r < 5; ++r)
#pragma unroll
            for (int j = 0; j < 4; ++j) RED[(tk * 5 + r) * 64 + tq * 4 + j] = acc[r][j];
        __syncthreads();
        if (t < 320) { const int r = t >> 6, c = t & 63; float s = 0.f;
            for (int q = 0; q < 32; ++q) s += RED[(q * 5 + r) * 64 + c];
            const int col = cg * 64 + c;
            ((float*)(F.ws + WS_MOD))[((size_t)ly * 5 + r) * 6144 + col] = s + F.in[5][(size_t)ly * 6144 + col]; }
        __syncthreads();
    }
}

DI void prep_filters(const Frame& F) {
    LAS float* Z = (LAS float*)F.lds;
    LAS float* A1 = Z + 64 * 33;
    LAS float* A2 = A1 + 4096;
    const int t = F.tid;
    for (int u = F.bid; u < DEPTH * 68; u += F.G) {
        const int ly = u / 68, ch = u % 68; const bool lat = ch < 64; const int Lx = lat ? SEQ : CTXL, t0 = lat ? ch * 64 : (ch - 64) * 64;
        for (int i = t; i < 64 * 33; i += NTHR) { const int tt = i / 33, f = i % 33; const int ti = t0 + tt;
            float v;
            if (f == 0) v = (float)ti / (float)(Lx - 1);
            else { const int j = (f - 1) & 15; const float fb = 1e-4f + (float)j * ((15.0f - 1e-4f) / 15.0f); const float om = (6.283185307179586f / (float)Lx) * (float)ti;
                   v = f <= 16 ? cosf(fb * om) : -sinf(fb * om); }
            Z[i] = v; }
        __syncthreads();
        const float* w1 = F.in[9] + (size_t)ly * 33 * 64; const float* b1 = F.in[10] + ly * 64; const float* w2 = F.in[11] + (size_t)ly * 4096; const float* b2 = F.in[12] + ly * 64;
        const float* w3 = F.in[13] + (size_t)ly * 64 * 1024; const float* fq = F.in[14] + ly * 64;
        for (int i = t; i < 4096; i += NTHR) { const int tt = i >> 6, h = i & 63; float s = b1[h];
            for (int f = 0; f < 33; ++f) s += Z[tt * 33 + f] * w1[f * 64 + h];
            A1[i] = sinf(fq[h] * s); }
        __syncthreads();
        for (int i = t; i < 4096; i += NTHR) { const int tt = i >> 6, h = i & 63; float s = b2[h];
            for (int j = 0; j < 64; ++j) s += A1[tt * 64 + j] * w2[j * 64 + h];
            A2[i] = sinf(fq[h] * s); }
        __syncthreads();
        for (int cc = 0; cc < 2; ++cc) { const int col = t + cc * 512;
            float wr[64];
#pragma unroll
            for (int j = 0; j < 64; ++j) wr[j] = w3[j * 1024 + col];
            const int n = col >> 9, dir = (col >> 8) & 1, c = col & 255;
            const float delta = fabsf(-3.0701134573253946f + (float)c * ((-15.350567286626973f + 3.0701134573253946f) / 255.0f));
            float* dst = lat ? (float*)(F.ws + WS_HCL) + ((((size_t)ly * 2 + n) * 2 + dir) * 256 + c) * SEQ + t0
                             : (float*)(F.ws + WS_HCC) + ((((size_t)ly * 2 + n) * 2 + dir) * 256 + c) * CTXL + t0;
            for (int tt = 0; tt < 64; ++tt) { float s = 0.f;
#pragma unroll
                for (int j = 0; j < 64; ++j) s += A2[tt * 64 + j] * wr[j];
                const float tv = (float)(t0 + tt) / (float)(Lx - 1);
                dst[tt] = s * expf(-tv * delta); } }
        __syncthreads();
    }
}

DI void prep_tables(const Frame& F) {
    LAS float* CT = (LAS float*)F.lds;
    const int t = F.tid;
    for (int i = t; i < 4096; i += NTHR) CT[i] = cospif((float)i / 2048.0f);
    __syncthreads();
    bf16_t* DC = (bf16_t*)(F.ws + WS_DFTC);
    for (int i = F.bid * NTHR + t; i < CTXL * 512; i += F.G * NTHR) { const int k = i >> 9, cl = i & 511, comp = cl >> 8, l = cl & 255;
        const int idx = ((k * l) & 255) * 16; DC[i] = f2bf((comp ? CT[(idx - 1024) & 4095] : CT[idx]) * (1.0f / 128.0f)); }
    if (F.bid == 0) { float* RT = (float*)(F.ws + WS_ROPE);
        for (int i = t; i < 512; i += NTHR) { const int p = i >> 3, n = i & 7; const float inv = powf(10000.0f, -(float)n / 8.0f); float s, c; sincosf((float)p * inv, &s, &c); RT[i * 2] = c; RT[i * 2 + 1] = s; } }
    __syncthreads();
}

DI void prep_copy_x(const Frame& F) {
    f32x4* X = (f32x4*)(F.ws + WS_X);
    const f32x4* x = (const f32x4*)F.in[0]; const f32x4* cx = (const f32x4*)F.in[2];
    const size_t n1 = (size_t)RLAT * DM / 4, n2 = (size_t)RCTX * DM / 4;
    for (size_t i = (size_t)F.bid * NTHR + F.tid; i < n1 + n2; i += (size_t)F.G * NTHR) X[i] = i < n1 ? x[i] : cx[i - n1];
}

DI void prep_invl1(const Frame& F) {
    const int gw = F.bid * 8 + F.wave, nw = F.G * 8;
    for (int j = gw; j < DEPTH * 2 * 2 * 256; j += nw) {
        const int ly = j >> 10, lt = (j >> 9) & 1, n = (j >> 8) & 1, c = j & 255;
        const int Lx = lt ? CTXL : SEQ;
        const float* base = lt ? (const float*)(F.ws + WS_HCC) : (const float*)(F.ws + WS_HCL);
        const float* f0 = base + ((((size_t)ly * 2 + n) * 2 + 0) * 256 + c) * Lx;
        const float* f1 = base + ((((size_t)ly * 2 + n) * 2 + 1) * 256 + c) * Lx;
        float s = 0.f;
        for (int i = F.lane; i < Lx; i += 64) { s += fabsf(f0[i]); if (i >= 1) s += fabsf(f1[i]); }
        s = wave_sum(s);
        if (F.lane == 0) ((float*)(F.ws + WS_INVL1))[j] = 1.0f / s;
    }
}

DI void ln_stats(const f32x4 (&v)[4], float& mu, float& rstd) {
    float s = 0.f;
#pragma unroll
    for (int j = 0; j < 4; ++j) s += (v[j][0] + v[j][1]) + (v[j][2] + v[j][3]);
    mu = wave_sum(s) * (1.0f / DM);
    float q = 0.f;
#pragma unroll
    for (int j = 0; j < 4; ++j)
#pragma unroll
        for (int e = 0; e < 4; ++e) { const float d = v[j][e] - mu; q += d * d; }
    rstd = rsqrtf(wave_sum(q) * (1.0f / DM) + LN_EPS);
}
DI void ln_mod_store(const f32x4 (&v)[4], const float* sh, const float* sc, bf16_t* hrow, int lane) {
    float mu, rstd; ln_stats(v, mu, rstd);
#pragma unroll
    for (int j = 0; j < 4; ++j) { const int c = 4 * lane + 256 * j; const f32x4 a = *(const f32x4*)(sh + c), b = *(const f32x4*)(sc + c);
        float o[4];
#pragma unroll
        for (int e = 0; e < 4; ++e) o[e] = (v[j][e] - mu) * rstd * (1.f + b[e]) + a[e];
        u32x2 w; w.x = cvt_pk_bf16(o[0], o[1]); w.y = cvt_pk_bf16(o[2], o[3]); *(u32x2*)(hrow + c) = w; }
}

DI void phase_init_h(const Frame& F) {
    const int gw = F.bid * 8 + F.wave, nw = F.G * 8;
    const float* MOD = (const float*)(F.ws + WS_MOD);
    for (int row = gw; row < RTOT; row += nw) {
        const float* xr = (const float*)(F.ws + WS_X) + (size_t)row * DM;
        f32x4 v[4];
#pragma unroll
        for (int j = 0; j < 4; ++j) v[j] = *(const f32x4*)(xr + 4 * F.lane + 256 * j);
        const float* m = MOD + (size_t)(0 * 5 + row_modsel(row)) * 6144;
        ln_mod_store(v, m, m + 1024, (bf16_t*)(F.ws + WS_H) + (size_t)row * DM, F.lane);
    }
}

struct EpiWin {
    static constexpr bool PERM = true;
    unsigned char* ws; int ly;
    DI void operator()(const f32x4 (&acc)[2][2][4][2], const pg8::Unit& u, int wr, int wc, int fr, int fq) const {
        const bool lat = u.pm < 64; const int b = lat ? (u.pm >> 4) : (u.pm - 64); const int pos0 = lat ? ((u.pm & 15) << 8) : SEQ;
        const int pn = u.pn;
        const float* RT = (const float*)(ws + WS_ROPE);
        float kn[2] = {0.f, 0.f};
#pragma unroll
        for (int ai = 0; ai < 2; ++ai)
#pragma unroll
            for (int m = 0; m < 4; ++m) {
                const int pos = pos0 + ai * 128 + wr * 64 + m * 16 + fr;
#pragma unroll
                for (int bj = 0; bj < 2; ++bj) {
                    const int col = pn * 256 + bj * 128 + wc * 32 + fq * 8;
                    float v[8];
#pragma unroll
                    for (int e = 0; e < 4; ++e) { v[e] = acc[ai][bj][m][0][e]; v[4 + e] = acc[ai][bj][m][1][e]; }
                    if (pn < 3) {
                        float* d = (float*)(ws + WS_HYT) + ((size_t)b * 768 + col) * POS + pos;
#pragma unroll
                        for (int e = 0; e < 8; ++e) d[(size_t)e * POS] = v[e];
                    } else if (pn < 7) {
                        const bool isq = pn < 5; const int cq = col - (isq ? 768 : 1280); const int head = cq >> 6, cc = cq & 63;
                        if (lat) { const int axis = (cc >> 4) & 1, n0 = (cc & 15) >> 1; const int pa = axis ? (pos & 63) : (pos >> 6);
                            const float* rt = RT + (pa * 8 + n0) * 2;
#pragma unroll
                            for (int p = 0; p < 4; ++p) { const float cs = rt[2 * p], sn = rt[2 * p + 1]; const float a = v[2 * p], bb = v[2 * p + 1];
                                v[2 * p] = a * cs - bb * sn; v[2 * p + 1] = a * sn + bb * cs; } }
                        if (isq) {
#pragma unroll
                            for (int e = 0; e < 8; ++e) v[e] *= QSCALE; }
                        u32x4 w; w.x = cvt_pk_bf16(v[0], v[1]); w.y = cvt_pk_bf16(v[2], v[3]); w.z = cvt_pk_bf16(v[4], v[5]); w.w = cvt_pk_bf16(v[6], v[7]);
                        bf16_t* d = (bf16_t*)(ws + (isq ? WS_Q : WS_K)) + (((size_t)b * 8 + head) * POS + pos) * 64 + cc;
                        *(u32x4*)d = w;
                        if (!isq) {
                            float s2 = bflo(w.x) * bflo(w.x) + bfhi(w.x) * bfhi(w.x) + bflo(w.y) * bflo(w.y) + bfhi(w.y) * bfhi(w.y) + bflo(w.z) * bflo(w.z) + bfhi(w.z) * bfhi(w.z) + bflo(w.w) * bflo(w.w) + bfhi(w.w) * bfhi(w.w);
                            s2 += __shfl_xor(s2, 16); s2 += __shfl_xor(s2, 32);
                            kn[bj] = fmaxf(kn[bj], s2); }
                    } else if (pn < 9) {
                        const int cv = col - 1792; const int head = cv >> 6, cc = cv & 63;
                        u32x4 w; w.x = cvt_pk_bf16(v[0], v[1]); w.y = cvt_pk_bf16(v[2], v[3]); w.z = cvt_pk_bf16(v[4], v[5]); w.w = cvt_pk_bf16(v[6], v[7]);
                        *(u32x4*)((bf16_t*)(ws + WS_V) + (((size_t)b * 8 + head) * POS + pos) * 64 + cc) = w;
                    } else {
                        const int cy = col - 2304; const int comp = cy >> 8, gd = cy & 255;
                        if (lat) { bf16_t* d = (bf16_t*)(ws + WS_YTL) + ((size_t)b * 256 + gd) * 8192 + comp * 4096 + pos;
#pragma unroll
                            for (int e = 0; e < 8; ++e) d[(size_t)e * 8192] = f2bf(v[e]);
                        } else { bf16_t* d = (bf16_t*)(ws + WS_YTC) + ((size_t)b * 256 + gd) * 512 + comp * 256 + (pos - SEQ);
#pragma unroll
                            for (int e = 0; e < 8; ++e) d[(size_t)e * 512] = f2bf(v[e]); }
                    }
                }
            }
        if (pn == 5 || pn == 6) {
#pragma unroll
            for (int bj = 0; bj < 2; ++bj) { float m = kn[bj];
                m = fmaxf(m, __shfl_xor(m, 1)); m = fmaxf(m, __shfl_xor(m, 2)); m = fmaxf(m, __shfl_xor(m, 4)); m = fmaxf(m, __shfl_xor(m, 8));
                const int cq = pn * 256 + bj * 128 + wc * 32 - 1280; const int head = cq >> 6, comp = (cq >> 5) & 1;
                if (fr == 0 && fq == 0) atomicMax((unsigned*)(ws + WS_CTL) + CW_KMAX + 64 * ly + (b * 8 + head) * 2 + comp, __float_as_uint(m)); }
        }
    }
};

struct EpiFnet {
    static constexpr bool PERM = true;
    unsigned char* ws; int ctx;
    DI void operator()(const f32x4 (&acc)[2][2][4][2], const pg8::Unit& u, int wr, int wc, int fr, int fq) const {
        const int b = u.pn;
#pragma unroll
        for (int ai = 0; ai < 2; ++ai)
#pragma unroll
            for (int m = 0; m < 4; ++m) {
                const int k = u.pm * 256 + ai * 128 + wr * 64 + m * 16 + fr;
                const size_t row = ctx ? (size_t)(RLAT + b * CTXL + k) : (size_t)(b * SEQ + k);
#pragma unroll
                for (int bj = 0; bj < 2; ++bj) { const int gd = bj * 128 + wc * 32 + fq * 8;
                    const f32x4 v0 = acc[ai][bj][m][0], v1 = acc[ai][bj][m][1];
                    u32x4 w; w.x = cvt_pk_bf16(v0[0], v0[1]); w.y = cvt_pk_bf16(v0[2], v0[3]); w.z = cvt_pk_bf16(v1[0], v1[1]); w.w = cvt_pk_bf16(v1[2], v1[3]);
                    *(u32x4*)((bf16_t*)(ws + WS_MIX) + row * DM + 768 + gd) = w; }
            }
    }
};

struct EpiWout {
    static constexpr bool PERM = false;
    unsigned char* ws; int ly;
    DI void operator()(const f32x4 (&acc)[2][2][4][2], const pg8::Unit& u, int wr, int wc, int fr, int fq) const {
        const int msel = u.pm < 64 ? (u.pm >> 4) : 4;
        const float* g1 = (const float*)(ws + WS_MOD) + ((size_t)ly * 5 + msel) * 6144 + 2048;
        const int col0 = u.pn * 256 + wc * 32 + 4 * fq;
        f32x4 gv[2][2];
#pragma unroll
        for (int bj = 0; bj < 2; ++bj)
#pragma unroll
            for (int n = 0; n < 2; ++n) gv[bj][n] = *(const f32x4*)(g1 + col0 + bj * 128 + n * 16);
#pragma unroll
        for (int ai = 0; ai < 2; ++ai)
#pragma unroll
            for (int m = 0; m < 4; ++m) { float* rowp = (float*)(ws + WS_X) + (size_t)(u.pm * 256 + ai * 128 + wr * 64 + m * 16 + fr) * DM + col0;
#pragma unroll
                for (int bj = 0; bj < 2; ++bj)
#pragma unroll
                    for (int n = 0; n < 2; ++n) { f32x4* p = (f32x4*)(rowp + bj * 128 + n * 16); *p = *p * ALPHA + gv[bj][n] * acc[ai][bj][m][n]; } }
    }
};

struct MoeTab { LAS int* cnt; LAS int* tstart; LAS int* tile_e; int ntiles; };
DI MoeTab moe_tables(const Frame& F, int ly) {
    MoeTab T; T.cnt = (LAS int*)(F.lds + LDS_TAB); T.tstart = T.cnt + 72; T.tile_e = T.tstart + 72;
    __syncthreads();
    if (F.tid < 65) T.cnt[F.tid] = F.tid < NEXP ? (int)__hip_atomic_load(F.ctl + CW_CNT + (ly * 64 + F.tid) * CNT_STRIDE, __ATOMIC_RELAXED, __HIP_MEMORY_SCOPE_AGENT) : RTOT;
    __syncthreads();
    if (F.tid == 0) { int s = 0; for (int e = 0; e < 65; ++e) { T.tstart[e] = s; s += (T.cnt[e] + 255) >> 8; } T.tstart[65] = s; }
    __syncthreads();
    const int nt = T.tstart[65];
    for (int e = F.tid; e < 65; e += NTHR) for (int q = T.tstart[e]; q < T.tstart[e + 1]; ++q) if (q < MAXTILES) T.tile_e[q] = e;
    __syncthreads();
    T.ntiles = __builtin_amdgcn_readfirstlane(nt < MAXTILES ? nt : MAXTILES);
    return T;
}
template <bool GATHER_> struct MoeSched {
    static constexpr bool GATHER = GATHER_;
    MoeTab T; const int* list; int G, c, nsub, shift;
    DI bool next(int i, pg8::Unit& u) const {
        const int L = i * G + c; if (L >= T.ntiles * nsub) return false;
        const int tile = L >> shift, j = L & (nsub - 1); const int e = __builtin_amdgcn_readfirstlane(T.tile_e[tile]);
        u.pm = tile; u.pn = e * nsub + j; u.e = e; u.lt = tile - __builtin_amdgcn_readfirstlane(T.tstart[e]); return true;
    }
    DI int arow(const pg8::Unit& u, int r) const {
        if (!GATHER_) return u.pm * 256 + r;
        const int idx = u.lt * 256 + r;
        if (u.e == NEXP) return idx;
        return idx < T.cnt[u.e] ? (list[(size_t)u.e * RTOT + idx] >> 3) : 0;
    }
};
DI float silu_f(float x) { return x / (1.f + __expf(-x)); }
struct EpiMoe1 {
    static constexpr bool PERM = true;
    unsigned char* ws;
    DI void operator()(const f32x4 (&acc)[2][2][4][2], const pg8::Unit& u, int wr, int wc, int fr, int fq) const {
        const int hid = (u.pn & 1) * 128 + wc * 32 + fq * 8;
#pragma unroll
        for (int ai = 0; ai < 2; ++ai)
#pragma unroll
            for (int m = 0; m < 4; ++m) { const size_t row = (size_t)u.pm * 256 + ai * 128 + wr * 64 + m * 16 + fr;
                float o[8];
#pragma unroll
                for (int n = 0; n < 2; ++n)
#pragma unroll
                    for (int e = 0; e < 4; ++e) o[n * 4 + e] = silu_f(acc[ai][0][m][n][e]) * acc[ai][1][m][n][e];
                u32x4 w; w.x = cvt_pk_bf16(o[0], o[1]); w.y = cvt_pk_bf16(o[2], o[3]); w.z = cvt_pk_bf16(o[4], o[5]); w.w = cvt_pk_bf16(o[6], o[7]);
                *(u32x4*)((bf16_t*)(ws + WS_ACT) + row * DEXP + hid) = w; }
    }
};
struct EpiMoe2 {
    static constexpr bool PERM = true;
    unsigned char* ws; MoeTab T; const int* list;
    DI void operator()(const f32x4 (&acc)[2][2][4][2], const pg8::Unit& u, int wr, int wc, int fr, int fq) const {
        const int colb = (u.pn & 3) * 256 + wc * 32 + fq * 8; const int cnt = T.cnt[u.e];
#pragma unroll
        for (int ai = 0; ai < 2; ++ai)
#pragma unroll
            for (int m = 0; m < 4; ++m) { const int idx = u.lt * 256 + ai * 128 + wr * 64 + m * 16 + fr;
                long dest = -1;
                if (u.e == NEXP) dest = (long)idx * 9 + 8;
                else if (idx < cnt) { const int id = list[(size_t)u.e * RTOT + idx]; dest = (long)(id >> 3) * 9 + (id & 7); }
                if (dest >= 0) {
#pragma unroll
                    for (int bj = 0; bj < 2; ++bj) { const f32x4 v0 = acc[ai][bj][m][0], v1 = acc[ai][bj][m][1];
                        u32x4 w; w.x = cvt_pk_bf16(v0[0], v0[1]); w.y = cvt_pk_bf16(v0[2], v0[3]); w.z = cvt_pk_bf16(v1[0], v1[1]); w.w = cvt_pk_bf16(v1[2], v1[3]);
                        *(u32x4*)((bf16_t*)(ws + WS_YB) + (size_t)dest * DM + colb + bj * 128) = w; } } }
    }
};

DI float hy_short(const float* hy, int l, int Lx, float w0, float w1, float w2) {
    const float a = l > 0 ? hy[l - 1] : 0.f, b = hy[l], c = l + 1 < Lx ? hy[l + 1] : 0.f;
    return w0 * a + w1 * b + w2 * c;
}
#if 0
DI void hyena_unit(const Frame& F, int ly, int c) {
    LAS float* KF = (LAS float*)F.lds;
    LAS float* U = KF + 16384;
    const int t = F.tid;
    const float* HYT = (const float*)(F.ws + WS_HYT);
    const float* scw = F.in[8] + (size_t)ly * 3 * 768;
    const float* invl = (const float*)(F.ws + WS_INVL1) + (size_t)ly * 1024;
    const float bias0 = F.in[15][(size_t)ly * 512 + c], bias1 = F.in[15][(size_t)ly * 512 + 256 + c];
    float wx1[3], wx2[3], wv[3];
#pragma unroll
    for (int j = 0; j < 3; ++j) { wx1[j] = scw[j * 768 + c]; wx2[j] = scw[j * 768 + 256 + c]; wv[j] = scw[j * 768 + 512 + c]; }
    bf16_t* MIX = (bf16_t*)(F.ws + WS_MIX);
    {
        for (int n = 0; n < 2; ++n) { const float inv = invl[(0 * 2 + n) * 256 + c];
            const float* hf = (const float*)(F.ws + WS_HCL) + ((((size_t)ly * 2 + n) * 2 + 0) * 256 + c) * SEQ;
            const float* hb = (const float*)(F.ws + WS_HCL) + ((((size_t)ly * 2 + n) * 2 + 1) * 256 + c) * SEQ;
            for (int i = t; i < 8192; i += NTHR) { const int d = i - 4096; KF[n * 8192 + i] = d >= 0 ? hf[d] * inv : (d > -4096 ? hb[-d] * inv : 0.f); } }
        for (int i = t; i < 4 * SEQ; i += NTHR) { const int b = i >> 12, l = i & 4095;
            U[l * 4 + b] = hy_short(HYT + ((size_t)b * 768 + 512 + c) * POS, l, SEQ, wv[0], wv[1], wv[2]); }
        __syncthreads();
        const int t0 = t * 8;
        for (int n = 0; n < 2; ++n) {
            f32x4 acc[8];
#pragma unroll
            for (int j = 0; j < 8; ++j) acc[j] = (f32x4){0.f, 0.f, 0.f, 0.f};
            const LAS float* kf = KF + n * 8192;
#pragma unroll 1
            for (int s0 = 0; s0 < SEQ; s0 += 8) {
                const int base = t0 - s0 + 4088;
                float kw[16];
#pragma unroll
                for (int q = 0; q < 4; ++q) { const f32x4 x = *(const LAS f32x4*)(kf + base + 4 * q); kw[4 * q] = x[0]; kw[4 * q + 1] = x[1]; kw[4 * q + 2] = x[2]; kw[4 * q + 3] = x[3]; }
#pragma unroll
                for (int i = 0; i < 8; ++i) { const f32x4 uv = *(const LAS f32x4*)(U + (s0 + i) * 4);
#pragma unroll
                    for (int j = 0; j < 8; ++j) acc[j] += uv * kw[8 + j - i]; }
            }
            float zo[8][4];
            const int xch = n == 0 ? c : 256 + c; const float* wg = n == 0 ? wx1 : wx2; const float bias = n == 0 ? bias0 : bias1;
#pragma unroll
            for (int b = 0; b < 4; ++b) {
                const float* hp = HYT + ((size_t)b * 768 + xch) * POS;
                const f32x4 h0 = *(const f32x4*)(hp + t0), h1 = *(const f32x4*)(hp + t0 + 4);
                const float hm = t0 > 0 ? hp[t0 - 1] : 0.f, hn = t0 + 8 < SEQ ? hp[t0 + 8] : 0.f;
                const float hv[10] = {hm, h0[0], h0[1], h0[2], h0[3], h1[0], h1[1], h1[2], h1[3], hn};
#pragma unroll
                for (int j = 0; j < 8; ++j) { const float g = wg[0] * hv[j] + wg[1] * hv[j + 1] + wg[2] * hv[j + 2];
                    zo[j][b] = g * (acc[j][b] + bias * U[(t0 + j) * 4 + b]); }
            }
            __syncthreads();
            if (n == 0) {
#pragma unroll
                for (int j = 0; j < 8; ++j) *(LAS f32x4*)(U + (t0 + j) * 4) = (f32x4){zo[j][0], zo[j][1], zo[j][2], zo[j][3]};
                __syncthreads();
            } else {
#pragma unroll
                for (int j = 0; j < 8; ++j)
#pragma unroll
                    for (int b = 0; b < 4; ++b) MIX[((size_t)b * SEQ + t0 + j) * DM + c] = f2bf(zo[j][b]);
            }
        }
    }
    __syncthreads();
}
#endif
DI void hyena_ctx_unit(const Frame& F, int ly, int c) {
    LAS float* KF = (LAS float*)F.lds;
    LAS float* U = KF + 16384;
    const int t = F.tid;
    const float* HYT = (const float*)(F.ws + WS_HYT);
    const float* scw = F.in[8] + (size_t)ly * 3 * 768;
    const float* invl = (const float*)(F.ws + WS_INVL1) + (size_t)ly * 1024;
    const float bias0 = F.in[15][(size_t)ly * 512 + c], bias1 = F.in[15][(size_t)ly * 512 + 256 + c];
    float wx1[3], wx2[3], wv[3];
#pragma unroll
    for (int j = 0; j < 3; ++j) { wx1[j] = scw[j * 768 + c]; wx2[j] = scw[j * 768 + 256 + c]; wv[j] = scw[j * 768 + 512 + c]; }
    bf16_t* MIX = (bf16_t*)(F.ws + WS_MIX);
    {
        LAS float* KC = (LAS float*)F.lds;
        LAS float* UC = KC + 1024;
        for (int n = 0; n < 2; ++n) { const float inv = invl[(1 * 2 + n) * 256 + c];
            const float* hf = (const float*)(F.ws + WS_HCC) + ((((size_t)ly * 2 + n) * 2 + 0) * 256 + c) * CTXL;
            const float* hb = (const float*)(F.ws + WS_HCC) + ((((size_t)ly * 2 + n) * 2 + 1) * 256 + c) * CTXL;
            for (int i = t; i < 512; i += NTHR) { const int d = i - 256; KC[n * 512 + i] = d >= 0 ? hf[d] * inv : (d > -256 ? hb[-d] * inv : 0.f); } }
        for (int i = t; i < 4 * CTXL; i += NTHR) { const int b = i >> 8, l = i & 255;
            UC[l * 4 + b] = hy_short(HYT + ((size_t)b * 768 + 512 + c) * POS + SEQ, l, CTXL, wv[0], wv[1], wv[2]); }
        __syncthreads();
        const int tt = t & 255, bp = t >> 8;
        for (int n = 0; n < 2; ++n) {
            float a0 = 0.f, a1 = 0.f;
            for (int s = 0; s < CTXL; ++s) { const float k = KC[n * 512 + tt - s + 256]; a0 += k * UC[s * 4 + 2 * bp]; a1 += k * UC[s * 4 + 2 * bp + 1]; }
            const int xch = n == 0 ? c : 256 + c; const float* wg = n == 0 ? wx1 : wx2; const float bias = n == 0 ? bias0 : bias1;
            const float g0 = hy_short(HYT + ((size_t)(2 * bp) * 768 + xch) * POS + SEQ, tt, CTXL, wg[0], wg[1], wg[2]);
            const float g1 = hy_short(HYT + ((size_t)(2 * bp + 1) * 768 + xch) * POS + SEQ, tt, CTXL, wg[0], wg[1], wg[2]);
            const float z0 = g0 * (a0 + bias * UC[tt * 4 + 2 * bp]), z1 = g1 * (a1 + bias * UC[tt * 4 + 2 * bp + 1]);
            __syncthreads();
            if (n == 0) { UC[tt * 4 + 2 * bp] = z0; UC[tt * 4 + 2 * bp + 1] = z1; __syncthreads(); }
            else { MIX[((size_t)RLAT + (2 * bp) * CTXL + tt) * DM + c] = f2bf(z0); MIX[((size_t)RLAT + (2 * bp + 1) * CTXL + tt) * DM + c] = f2bf(z1); }
        }
    }
    __syncthreads();
}


DI unsigned cx_addr(unsigned e) { return e * 8u + (e >> 5) * 16u; }
constexpr int cx_bytes(int n) { return n * 8 + (n / 32) * 16; }
typedef float f32x2 __attribute__((ext_vector_type(2)));
template <int R> DI constexpr int brev(int q) { int r = 0; for (int i = 1, j = R >> 1; i < R; i <<= 1, j >>= 1) if (q & i) r |= j; return r; }
template <int R, bool INV> DI void dft_inreg(float (&re)[R], float (&im)[R]) {
#pragma unroll
    for (int len = R; len >= 2; len >>= 1) { const int half = len >> 1;
#pragma unroll
        for (int base = 0; base < R; base += len)
#pragma unroll
            for (int j = 0; j < half; ++j) {
                const float ar = re[base + j], ai = im[base + j], br = re[base + j + half], bi = im[base + j + half];
                re[base + j] = ar + br; im[base + j] = ai + bi;
                const float dr = ar - br, di = ai - bi;
                if (j == 0) { re[base + j + half] = dr; im[base + j + half] = di; }
                else if (4 * j == len) { if (INV) { re[base + j + half] = -di; im[base + j + half] = dr; } else { re[base + j + half] = di; im[base + j + half] = -dr; } }
                else { const float c = __builtin_cosf(6.283185307179586f * (float)j / (float)len), sn = (INV ? 1.f : -1.f) * __builtin_sinf(6.283185307179586f * (float)j / (float)len);
                    re[base + j + half] = dr * c - di * sn; im[base + j + half] = dr * sn + di * c; }
            }
    }
}
template <int R, bool INV, int S> DI void fft_bfly(LAS unsigned char* seq, int j) {
    constexpr int Lcur = R * S;
    int jj = j; asm volatile("" : "+v"(jj));
    const int blk = jj / S, o = jj % S;
    LAS unsigned char* p = seq + cx_addr((unsigned)(blk * Lcur + o));
#define FFT_OFF(r) ((r) * S * 8 + ((((r) * S) >> 5) * 16))
    float re[R], im[R];
    if (S == 1) {
#pragma unroll
        for (int r = 0; r < R; r += 2) { const f32x4 v = *(const LAS f32x4*)(p + FFT_OFF(r)); re[r] = v[0]; im[r] = v[1]; re[r + 1] = v[2]; im[r + 1] = v[3]; }
    } else {
#pragma unroll
        for (int r = 0; r < R; ++r) { const f32x2 v = *(const LAS f32x2*)(p + FFT_OFF(r)); re[r] = v[0]; im[r] = v[1]; }
    }
    if (S == 1) {
        dft_inreg<R, INV>(re, im);
    } else {
        const float fr = (float)o * (1.0f / (float)Lcur);
        float wr[R], wi[R];
        wr[1] = __builtin_amdgcn_cosf(fr); wi[1] = INV ? __builtin_amdgcn_sinf(fr) : -__builtin_amdgcn_sinf(fr);
#pragma unroll
        for (int q = 2; q < R; ++q) { const int a = (q & (q - 1)) ? (q & -q) : (q >> 1), bq = q - a;
            wr[q] = wr[a] * wr[bq] - wi[a] * wi[bq]; wi[q] = wr[a] * wi[bq] + wi[a] * wr[bq]; }
        if (!INV) {
            dft_inreg<R, false>(re, im);
#pragma unroll
            for (int q = 1; q < R; ++q) { const int k = brev<R>(q); const float xr = re[k], xi = im[k]; re[k] = xr * wr[q] - xi * wi[q]; im[k] = xr * wi[q] + xi * wr[q]; }
        } else {
#pragma unroll
            for (int q = 1; q < R; ++q) { const float xr = re[q], xi = im[q]; re[q] = xr * wr[q] - xi * wi[q]; im[q] = xr * wi[q] + xi * wr[q]; }
            dft_inreg<R, true>(re, im);
        }
    }
    if (S == 1) {
#pragma unroll
        for (int r = 0; r < R; r += 2) { const int k0 = brev<R>(r), k1 = brev<R>(r + 1); *(LAS f32x4*)(p + FFT_OFF(r)) = (f32x4){re[k0], im[k0], re[k1], im[k1]}; }
    } else {
#pragma unroll
        for (int r = 0; r < R; ++r) { const int k = brev<R>(r); *(LAS f32x2*)(p + FFT_OFF(r)) = (f32x2){re[k], im[k]}; }
    }
#undef FFT_OFF
}
template <bool INV> DI void fft8192x2(LAS unsigned char* lds, int tid) {
    constexpr int SB = cx_bytes(8192);
    if (!INV) {
        fft_bfly<16, false, 512>(lds, tid); __builtin_amdgcn_sched_barrier(0); fft_bfly<16, false, 512>(lds + SB, tid); __syncthreads();
        fft_bfly<16, false, 32>(lds, tid); __builtin_amdgcn_sched_barrier(0); fft_bfly<16, false, 32>(lds + SB, tid); __syncthreads();
        fft_bfly<32, false, 1>(lds + (tid >> 8) * SB, tid & 255); __syncthreads();
    } else {
        fft_bfly<32, true, 1>(lds + (tid >> 8) * SB, tid & 255); __syncthreads();
        fft_bfly<16, true, 32>(lds, tid); __builtin_amdgcn_sched_barrier(0); fft_bfly<16, true, 32>(lds + SB, tid); __syncthreads();
        fft_bfly<16, true, 512>(lds, tid); __builtin_amdgcn_sched_barrier(0); fft_bfly<16, true, 512>(lds + SB, tid); __syncthreads();
    }
}
DI void fft4096x4(LAS unsigned char* lds, int tid) {
    constexpr int SB = cx_bytes(4096);
    const int sq = tid >> 8, j = tid & 255;
    fft_bfly<16, false, 256>(lds + sq * SB, j); __builtin_amdgcn_sched_barrier(0); fft_bfly<16, false, 256>(lds + (sq + 2) * SB, j); __syncthreads();
    fft_bfly<16, false, 16>(lds + sq * SB, j); __builtin_amdgcn_sched_barrier(0); fft_bfly<16, false, 16>(lds + (sq + 2) * SB, j); __syncthreads();
    fft_bfly<16, false, 1>(lds + sq * SB, j); __builtin_amdgcn_sched_barrier(0); fft_bfly<16, false, 1>(lds + (sq + 2) * SB, j); __syncthreads();
}

DI void hy_short8(const float* hp, int l0, float w0, float w1, float w2, float (&out)[8]) {
    const f32x4 h0 = *(const f32x4*)(hp + l0), h1 = *(const f32x4*)(hp + l0 + 4);
    const float hm = l0 > 0 ? hp[l0 - 1] : 0.f, hn = l0 + 8 < SEQ ? hp[l0 + 8] : 0.f;
    const float hv[10] = {hm, h0[0], h0[1], h0[2], h0[3], h1[0], h1[1], h1[2], h1[3], hn};
#pragma unroll
    for (int j = 0; j < 8; ++j) out[j] = w0 * hv[j] + w1 * hv[j + 1] + w2 * hv[j + 2];
}
DI void hyena_fft_unit(const Frame& F, int ly, int c) {
    LAS unsigned char* L = F.lds; constexpr int SB = cx_bytes(8192);
    const int t = F.tid;
    const unsigned pt = cx_addr((unsigned)t), pl = cx_addr((unsigned)t * 8u);
    const float* HYT = (const float*)(F.ws + WS_HYT);
    const float* scw = F.in[8] + (size_t)ly * 3 * 768;
    const float* invl = (const float*)(F.ws + WS_INVL1) + (size_t)ly * 1024;
    const float bias0 = F.in[15][(size_t)ly * 512 + c], bias1 = F.in[15][(size_t)ly * 512 + 256 + c];
    float wx1[3], wx2[3], wv[3];
#pragma unroll
    for (int j = 0; j < 3; ++j) { wx1[j] = scw[j * 768 + c]; wx2[j] = scw[j * 768 + 256 + c]; wv[j] = scw[j * 768 + 512 + c]; }
    f32x2* SPEC = (f32x2*)(F.ws + WS_SPEC) + (size_t)c * 2 * 8192;
#pragma unroll
    for (int n = 0; n < 2; ++n) { const float inv = invl[(0 * 2 + n) * 256 + c] * (1.0f / 8192.0f);
        const float* hf = (const float*)(F.ws + WS_HCL) + ((((size_t)ly * 2 + n) * 2 + 0) * 256 + c) * SEQ;
        const float* hb = (const float*)(F.ws + WS_HCL) + ((((size_t)ly * 2 + n) * 2 + 1) * 256 + c) * SEQ;
        float fv[16];
#pragma unroll
        for (int k = 0; k < 8; ++k) { fv[k] = hf[t + 512 * k]; const int i = SEQ + t + 512 * k; fv[8 + k] = i > SEQ ? hb[8192 - i] : 0.f; }
#pragma unroll
        for (int k = 0; k < 16; ++k) *(LAS f32x2*)(L + n * SB + (pt + 4352u * (unsigned)(k))) = (f32x2){fv[k] * inv, 0.f}; }
    __syncthreads();
    fft8192x2<false>(L, t);
#pragma unroll
    for (int n = 0; n < 2; ++n)
#pragma unroll
        for (int k = 0; k < 16; ++k) SPEC[n * 8192 + t + 512 * k] = *(const LAS f32x2*)(L + n * SB + (pt + 4352u * (unsigned)(k)));
    __syncthreads();
    const int l0 = t * 8;
#pragma unroll 1
    for (int sp = 0; sp < 2; ++sp) {
        float za[8], zb[8];
        hy_short8(HYT + ((size_t)(2 * sp) * 768 + 512 + c) * POS, l0, wv[0], wv[1], wv[2], za);
        hy_short8(HYT + ((size_t)(2 * sp + 1) * 768 + 512 + c) * POS, l0, wv[0], wv[1], wv[2], zb);
#pragma unroll
        for (int j = 0; j < 8; j += 2) {
            *(LAS f32x4*)(L + sp * SB + (pl + 8u * (unsigned)(j))) = (f32x4){za[j], zb[j], za[j + 1], zb[j + 1]};
            *(LAS f32x4*)(L + sp * SB + (pl + 34816u + 8u * (unsigned)(j))) = (f32x4){0.f, 0.f, 0.f, 0.f}; }
    }
    __syncthreads();
    float* Z1 = (float*)(F.ws + WS_Z1) + (size_t)c * 4 * SEQ;
    bf16_t* MIX = (bf16_t*)(F.ws + WS_MIX);
#pragma unroll 1
    for (int n = 0; n < 2; ++n) {
        fft8192x2<false>(L, t);
#pragma unroll 1
        for (int k0 = 0; k0 < 16; k0 += 8) { f32x2 h[8];
#pragma unroll
          for (int k = 0; k < 8; ++k) h[k] = SPEC[n * 8192 + t + 512 * (k0 + k)];
#pragma unroll
          for (int k = 0; k < 8; ++k) { const unsigned ad = (pt + 4352u * (unsigned)(k0 + k));
            const f32x2 a = *(const LAS f32x2*)(L + ad), b = *(const LAS f32x2*)(L + SB + ad);
            *(LAS f32x2*)(L + ad) = (f32x2){a[0] * h[k][0] - a[1] * h[k][1], a[0] * h[k][1] + a[1] * h[k][0]};
            *(LAS f32x2*)(L + SB + ad) = (f32x2){b[0] * h[k][0] - b[1] * h[k][1], b[0] * h[k][1] + b[1] * h[k][0]}; } }
        __syncthreads();
        fft8192x2<true>(L, t);
        const int xch = n == 0 ? c : 256 + c; const float* wg = n == 0 ? wx1 : wx2; const float bias = n == 0 ? bias0 : bias1;
#pragma unroll 1
        for (int sp = 0; sp < 2; ++sp) {
            float zo[2][8];
#pragma unroll
            for (int h2 = 0; h2 < 2; ++h2) { const int bb = 2 * sp + h2;
                float g[8], zin[8];
                hy_short8(HYT + ((size_t)bb * 768 + xch) * POS, l0, wg[0], wg[1], wg[2], g);
                if (n == 0) hy_short8(HYT + ((size_t)bb * 768 + 512 + c) * POS, l0, wv[0], wv[1], wv[2], zin);
                else { const f32x4 q0 = *(const f32x4*)(Z1 + (size_t)bb * SEQ + l0), q1 = *(const f32x4*)(Z1 + (size_t)bb * SEQ + l0 + 4);
                    zin[0] = q0[0]; zin[1] = q0[1]; zin[2] = q0[2]; zin[3] = q0[3]; zin[4] = q1[0]; zin[5] = q1[1]; zin[6] = q1[2]; zin[7] = q1[3]; }
#pragma unroll
                for (int j = 0; j < 8; ++j) { const float y = ((const LAS float*)(L + sp * SB + (pl + 8u * (unsigned)(j))))[h2]; zo[h2][j] = g[j] * (y + bias * zin[j]); }
                if (n == 0) { *(f32x4*)(Z1 + (size_t)bb * SEQ + l0) = (f32x4){zo[h2][0], zo[h2][1], zo[h2][2], zo[h2][3]}; *(f32x4*)(Z1 + (size_t)bb * SEQ + l0 + 4) = (f32x4){zo[h2][4], zo[h2][5], zo[h2][6], zo[h2][7]}; }
                else {
#pragma unroll
                    for (int j = 0; j < 8; ++j) MIX[((size_t)bb * SEQ + l0 + j) * DM + c] = f2bf(zo[h2][j]); }
            }
            if (n == 0) {
#pragma unroll
                for (int j = 0; j < 8; j += 2) {
                    *(LAS f32x4*)(L + sp * SB + (pl + 8u * (unsigned)(j))) = (f32x4){zo[0][j], zo[1][j], zo[0][j + 1], zo[1][j + 1]};
                    *(LAS f32x4*)(L + sp * SB + (pl + 34816u + 8u * (unsigned)(j))) = (f32x4){0.f, 0.f, 0.f, 0.f}; }
            }
        }
        __syncthreads();
    }
}

DI void fnet_fft_unit(const Frame& F, int u) {
    LAS unsigned char* L = F.lds; constexpr int SB = cx_bytes(4096);
    const int t = F.tid, b = u >> 6, gd0 = (u & 63) * 4;
    const bf16_t* YT = (const bf16_t*)(F.ws + WS_YTL) + ((size_t)b * 256 + gd0) * 8192;
    for (int i = t; i < 4 * 512; i += NTHR) { const int q = i >> 9, l0 = (i & 511) * 8;
        const u32x4 r = *(const u32x4*)(YT + (size_t)q * 8192 + l0), m = *(const u32x4*)(YT + (size_t)q * 8192 + 4096 + l0);
        const float rr[8] = {bflo(r.x), bfhi(r.x), bflo(r.y), bfhi(r.y), bflo(r.z), bfhi(r.z), bflo(r.w), bfhi(r.w)};
        const float mm[8] = {bflo(m.x), bfhi(m.x), bflo(m.y), bfhi(m.y), bflo(m.z), bfhi(m.z), bflo(m.w), bfhi(m.w)};
#pragma unroll
        for (int j = 0; j < 8; j += 2) *(LAS f32x4*)(L + q * SB + cx_addr(l0 + j)) = (f32x4){rr[j], mm[j], rr[j + 1], mm[j + 1]}; }
    __syncthreads();
    fft4096x4(L, t);
    bf16_t* MIX = (bf16_t*)(F.ws + WS_MIX);
#pragma unroll
    for (int i = 0; i < 8; ++i) { const int p = t + 512 * i; const int f = (p >> 8) + 16 * ((p >> 4) & 15) + 256 * (p & 15);
        float v[4];
#pragma unroll
        for (int q = 0; q < 4; ++q) v[q] = (*(const LAS f32x2*)(L + q * SB + cx_addr(p)))[0] * (1.0f / 512.0f);
        u32x2 w; w.x = cvt_pk_bf16(v[0], v[1]); w.y = cvt_pk_bf16(v[2], v[3]);
        *(u32x2*)(MIX + ((size_t)b * SEQ + f) * DM + 768 + gd0) = w; }
    __syncthreads();
}

DI void attn_unit(const Frame& F, int ly, int uid, float lam, float out_scale) {
    const int t = F.tid, lane = F.lane, wave = F.wave;
    LAS unsigned char* L = F.lds;
    constexpr int KOFF = 0, VOFF = 32768, TB = 16384;
    int bh, q0, k_lo, k_hi;
    if (uid < 512) { bh = uid >> 4; q0 = (uid & 15) << 8; k_lo = 0; k_hi = POS; }
    else { bh = uid - 512; q0 = SEQ; k_lo = SEQ; k_hi = POS; }
    const bf16_t* Qg = (const bf16_t*)(F.ws + WS_Q) + (size_t)bh * POS * 64;
    const bf16_t* Kg = (const bf16_t*)(F.ws + WS_K) + (size_t)bh * POS * 64;
    const bf16_t* Vg = (const bf16_t*)(F.ws + WS_V) + (size_t)bh * POS * 64;
    const int qi = lane & 31, hh = lane >> 5;
    const int qpos = q0 + wave * 32 + qi;
    bf16x8 qf[2][2];
    float q2[2] = {0.f, 0.f};
#pragma unroll
    for (int comp = 0; comp < 2; ++comp)
#pragma unroll
        for (int ks = 0; ks < 2; ++ks) { qf[comp][ks] = *(const bf16x8*)(Qg + (size_t)qpos * 64 + comp * 32 + ks * 16 + hh * 8);
#pragma unroll
            for (int j = 0; j < 8; ++j) { const float x = bf2f((unsigned short)qf[comp][ks][j]); q2[comp] += x * x; } }
    q2[0] += __shfl_xor(q2[0], 32); q2[1] += __shfl_xor(q2[1], 32);
    float kmax2[2];
    kmax2[0] = __uint_as_float(F.ctl[CW_KMAX + 64 * ly + bh * 2]); kmax2[1] = __uint_as_float(F.ctl[CW_KMAX + 64 * ly + bh * 2 + 1]);
    f32x16 negm[2];
#pragma unroll
    for (int comp = 0; comp < 2; ++comp) { const float m = -sqrtf(q2[comp] * kmax2[comp]) * 1.0001f;
#pragma unroll
        for (int i = 0; i < 16; ++i) negm[comp][i] = m; }
    f32x16 O[2][2];
#pragma unroll
    for (int a = 0; a < 2; ++a)
#pragma unroll
        for (int b = 0; b < 2; ++b)
#pragma unroll
            for (int i = 0; i < 16; ++i) O[a][b][i] = 0.f;
    float lsum[2] = {0.f, 0.f};
    const int sk = t >> 3, sc = t & 7;
    const unsigned kst = (unsigned)(sk * 128 + ((sc ^ ((sk >> 1) & 7)) << 4));
    const unsigned vst = (unsigned)(sk * 128 + ((((sc >> 1) ^ (sk & 3))) << 5) + ((sc & 1) << 4));
    const int ntile = (k_hi - k_lo) >> 7;
    u32x4 kreg = *(const u32x4*)(Kg + (size_t)(k_lo + sk) * 64 + sc * 8), kreg2 = *(const u32x4*)(Kg + (size_t)(k_lo + 64 + sk) * 64 + sc * 8);
    u32x4 vreg = *(const u32x4*)(Vg + (size_t)(k_lo + sk) * 64 + sc * 8), vreg2 = *(const u32x4*)(Vg + (size_t)(k_lo + 64 + sk) * 64 + sc * 8);
    *(LAS u32x4*)(L + KOFF + kst) = kreg; *(LAS u32x4*)(L + VOFF + vst) = vreg; *(LAS u32x4*)(L + KOFF + 8192 + kst) = kreg2; *(LAS u32x4*)(L + VOFF + 8192 + vst) = vreg2;
    __syncthreads();
    const int p4 = lane & 3, q4 = (lane & 15) >> 2, blk = (lane >> 4) & 1;
    for (int it = 0; it < ntile; ++it) {
        const int buf = it & 1;
        if (it + 1 < ntile) { const size_t kk = (size_t)(k_lo + (it + 1) * 128 + sk) * 64 + sc * 8; kreg = *(const u32x4*)(Kg + kk); vreg = *(const u32x4*)(Vg + kk); kreg2 = *(const u32x4*)(Kg + kk + 4096); vreg2 = *(const u32x4*)(Vg + kk + 4096); }
        const unsigned kb_base = KOFF + buf * TB, vb_base = VOFF + buf * TB;
#pragma unroll 1
        for (int kb = 0; kb < 4; ++kb) {
            bf16x8 vf[2][2];
            s16x4 r0, r1, r2, r3, r4, r5, r6, r7;
            {
                const int keyq = 4 * hh + q4;
                const unsigned a0 = vb_base + (unsigned)((kb * 32 + keyq) * 128) + (unsigned)((((0 + blk) ^ (keyq & 3))) << 5) + (unsigned)(p4 * 8);
                const unsigned a1 = vb_base + (unsigned)((kb * 32 + keyq) * 128) + (unsigned)((((2 + blk) ^ (keyq & 3))) << 5) + (unsigned)(p4 * 8);
                asm volatile("ds_read_b64_tr_b16 %0, %8\n\tds_read_b64_tr_b16 %1, %8 offset:1024\n\tds_read_b64_tr_b16 %2, %8 offset:2048\n\tds_read_b64_tr_b16 %3, %8 offset:3072\n\t"
                             "ds_read_b64_tr_b16 %4, %9\n\tds_read_b64_tr_b16 %5, %9 offset:1024\n\tds_read_b64_tr_b16 %6, %9 offset:2048\n\tds_read_b64_tr_b16 %7, %9 offset:3072"
                             : "=&v"(r0), "=&v"(r1), "=&v"(r2), "=&v"(r3), "=&v"(r4), "=&v"(r5), "=&v"(r6), "=&v"(r7) : "v"(a0), "v"(a1) : "memory");
            }
            {
                const int key = kb * 32 + qi; const unsigned krow = kb_base + key * 128; const int sw = (key >> 1) & 7;
                const bf16x8 k00 = *(const LAS bf16x8*)(L + krow + (((0 + hh) ^ sw) << 4)), k01 = *(const LAS bf16x8*)(L + krow + (((2 + hh) ^ sw) << 4));
                const bf16x8 k10 = *(const LAS bf16x8*)(L + krow + (((4 + hh) ^ sw) << 4)), k11 = *(const LAS bf16x8*)(L + krow + (((6 + hh) ^ sw) << 4));
                f32x16 S0 = __builtin_amdgcn_mfma_f32_32x32x16_bf16(k00, qf[0][0], negm[0], 0, 0, 0);
                f32x16 S1 = __builtin_amdgcn_mfma_f32_32x32x16_bf16(k10, qf[1][0], negm[1], 0, 0, 0);
                S0 = __builtin_amdgcn_mfma_f32_32x32x16_bf16(k01, qf[0][1], S0, 0, 0, 0);
                S1 = __builtin_amdgcn_mfma_f32_32x32x16_bf16(k11, qf[1][1], S1, 0, 0, 0);
                __builtin_amdgcn_sched_barrier(0);
                float ps = 0.f;
#pragma unroll
                for (int i = 0; i < 16; ++i) { S0[i] = __builtin_amdgcn_exp2f(S0[i]); ps += S0[i]; }
                lsum[0] += ps;
                const bf16x8 p00 = pack8(S0[0], S0[1], S0[2], S0[3], S0[4], S0[5], S0[6], S0[7]);
                const bf16x8 p01 = pack8(S0[8], S0[9], S0[10], S0[11], S0[12], S0[13], S0[14], S0[15]);
                asm volatile("s_waitcnt lgkmcnt(0)" : "+v"(r0), "+v"(r1), "+v"(r2), "+v"(r3), "+v"(r4), "+v"(r5), "+v"(r6), "+v"(r7));
                vf[0][0] = __builtin_shufflevector(r0, r1, 0, 1, 2, 3, 4, 5, 6, 7); vf[1][0] = __builtin_shufflevector(r2, r3, 0, 1, 2, 3, 4, 5, 6, 7);
                vf[0][1] = __builtin_shufflevector(r4, r5, 0, 1, 2, 3, 4, 5, 6, 7); vf[1][1] = __builtin_shufflevector(r6, r7, 0, 1, 2, 3, 4, 5, 6, 7);
                __builtin_amdgcn_sched_barrier(0);
                O[0][0] = __builtin_amdgcn_mfma_f32_32x32x16_bf16(vf[0][0], p00, O[0][0], 0, 0, 0);
                O[0][1] = __builtin_amdgcn_mfma_f32_32x32x16_bf16(vf[0][1], p00, O[0][1], 0, 0, 0);
                O[0][0] = __builtin_amdgcn_mfma_f32_32x32x16_bf16(vf[1][0], p01, O[0][0], 0, 0, 0);
                O[0][1] = __builtin_amdgcn_mfma_f32_32x32x16_bf16(vf[1][1], p01, O[0][1], 0, 0, 0);
                float ps1 = 0.f;
#pragma unroll
                for (int i = 0; i < 16; ++i) { S1[i] = __builtin_amdgcn_exp2f(S1[i]); ps1 += S1[i]; }
                lsum[1] += ps1;
                const bf16x8 p10 = pack8(S1[0], S1[1], S1[2], S1[3], S1[4], S1[5], S1[6], S1[7]);
                const bf16x8 p11 = pack8(S1[8], S1[9], S1[10], S1[11], S1[12], S1[13], S1[14], S1[15]);
                __builtin_amdgcn_sched_barrier(0);
                O[1][0] = __builtin_amdgcn_mfma_f32_32x32x16_bf16(vf[0][0], p10, O[1][0], 0, 0, 0);
                O[1][1] = __builtin_amdgcn_mfma_f32_32x32x16_bf16(vf[0][1], p10, O[1][1], 0, 0, 0);
                O[1][0] = __builtin_amdgcn_mfma_f32_32x32x16_bf16(vf[1][0], p11, O[1][0], 0, 0, 0);
                O[1][1] = __builtin_amdgcn_mfma_f32_32x32x16_bf16(vf[1][1], p11, O[1][1], 0, 0, 0);
            }
        }
        if (it + 1 < ntile) { *(LAS u32x4*)(L + KOFF + (buf ^ 1) * TB + kst) = kreg; *(LAS u32x4*)(L + VOFF + (buf ^ 1) * TB + vst) = vreg; *(LAS u32x4*)(L + KOFF + (buf ^ 1) * TB + 8192 + kst) = kreg2; *(LAS u32x4*)(L + VOFF + (buf ^ 1) * TB + 8192 + vst) = vreg2; }
        __syncthreads();
    }
    const float l0 = lsum[0] + __shfl_xor(lsum[0], 32), l1 = lsum[1] + __shfl_xor(lsum[1], 32);
    const float i0 = 1.0f / l0, i1 = lam / l1;
    float ss = 0.f;
#pragma unroll
    for (int dvb = 0; dvb < 2; ++dvb)
#pragma unroll
        for (int i = 0; i < 16; ++i) { const float o = O[0][dvb][i] * i0 - O[1][dvb][i] * i1; O[0][dvb][i] = o; ss += o * o; }
    ss += __shfl_xor(ss, 32);
    const float rn = rsqrtf(ss * (1.0f / 64.0f) + LN_EPS) * out_scale;
    const float* sw = F.in[20] + (size_t)ly * 64;
    const int b = bh >> 3, head = bh & 7;
    const size_t row = qpos < SEQ ? (size_t)b * SEQ + qpos : (size_t)RLAT + b * CTXL + (qpos - SEQ);
    bf16_t* dst = (bf16_t*)(F.ws + WS_MIX) + row * DM + 256 + head * 64;
#pragma unroll
    for (int dvb = 0; dvb < 2; ++dvb)
#pragma unroll
        for (int g = 0; g < 4; ++g) { const int dv = dvb * 32 + 8 * g + 4 * hh;
            const f32x4 w4 = *(const f32x4*)(sw + dv);
            u32x2 w; w.x = cvt_pk_bf16(O[0][dvb][4 * g] * rn * w4[0], O[0][dvb][4 * g + 1] * rn * w4[1]); w.y = cvt_pk_bf16(O[0][dvb][4 * g + 2] * rn * w4[2], O[0][dvb][4 * g + 3] * rn * w4[3]);
            *(u32x2*)(dst + dv) = w; }
    __syncthreads();
}

DI void phase_rows_router(const Frame& F, int ly) {
    LAS float* HS = (LAS float*)F.lds;
    LAS float* PART = HS + 16 * 1028;
    LAS int* LCNT = (LAS int*)(PART + 8 * 16 * 64);
    LAS int* LBASE = LCNT + 64;
    LAS int* ASG = LBASE + 64;
    const int lane = F.lane, wave = F.wave;
    const float* MOD = (const float*)(F.ws + WS_MOD);
    const float* g1 = F.in[22] + (size_t)ly * DM; const float* b1 = F.in[23] + (size_t)ly * DM;
    const float* rw = F.in[26] + (size_t)ly * DM * NEXP; const float* rb = F.in[27] + (size_t)ly * NEXP;
    const bool last = ly == DEPTH - 1;
    const int nrows = last ? RLAT : RTOT;
    if (F.tid < 64) LCNT[F.tid] = 0;
    constexpr int HSS = 1028;
    float wreg[128];
#pragma unroll
    for (int i = 0; i < 128; ++i) wreg[i] = rw[(size_t)(wave * 128 + 4 * (i >> 2) + (lane >> 4)) * NEXP + 16 * (i & 3) + (lane & 15)];
    __syncthreads();
    int itn = 0;
    for (int r0 = F.bid * 16; r0 < nrows; r0 += F.G * 16, ++itn) {
        f32x4 va[2][4];
#pragma unroll
        for (int rr = 0; rr < 2; ++rr) { const float* xr = (const float*)(F.ws + WS_X) + (size_t)(r0 + wave * 2 + rr) * DM;
#pragma unroll
            for (int j = 0; j < 4; ++j) va[rr][j] = *(const f32x4*)(xr + 4 * lane + 256 * j); }
#pragma unroll
        for (int rr = 0; rr < 2; ++rr) { const int rl = wave * 2 + rr, row = r0 + rl;
            float* xr = (float*)(F.ws + WS_X) + (size_t)row * DM;
            f32x4 (&v)[4] = va[rr];
            float mu, rstd; ln_stats(v, mu, rstd);
#pragma unroll
            for (int j = 0; j < 4; ++j) { const int c = 4 * lane + 256 * j; const f32x4 g = *(const f32x4*)(g1 + c), bb = *(const f32x4*)(b1 + c);
#pragma unroll
                for (int e = 0; e < 4; ++e) v[j][e] = (v[j][e] - mu) * rstd * g[e] + bb[e];
                *(f32x4*)(xr + c) = v[j]; }
            ln_stats(v, mu, rstd);
            const float* m = MOD + ((size_t)ly * 5 + row_modsel(row)) * 6144;
            bf16_t* hrow = (bf16_t*)(F.ws + WS_H) + (size_t)row * DM;
#pragma unroll
            for (int j = 0; j < 4; ++j) { const int c = 4 * lane + 256 * j; const f32x4 a = *(const f32x4*)(m + 3072 + c), bsc = *(const f32x4*)(m + 4096 + c);
                f32x4 o;
#pragma unroll
                for (int e = 0; e < 4; ++e) o[e] = (v[j][e] - mu) * rstd * (1.f + bsc[e]) + a[e];
                u32x2 w; w.x = cvt_pk_bf16(o[0], o[1]); w.y = cvt_pk_bf16(o[2], o[3]); *(u32x2*)(hrow + c) = w;
                *(LAS f32x4*)(HS + rl * HSS + c) = o; } }
        __syncthreads();
        { f32x4 acc[4];
#pragma unroll
          for (int nb = 0; nb < 4; ++nb) acc[nb] = (f32x4){0.f, 0.f, 0.f, 0.f};
          const LAS float* hp = HS + (lane & 15) * HSS + wave * 128 + (lane >> 4);
#pragma unroll
          for (int g = 0; g < 32; ++g) { const float a = hp[4 * g];
#pragma unroll
              for (int nb = 0; nb < 4; ++nb) acc[nb] = __builtin_amdgcn_mfma_f32_16x16x4f32(a, wreg[g * 4 + nb], acc[nb], 0, 0, 0); }
#pragma unroll
          for (int nb = 0; nb < 4; ++nb)
#pragma unroll
              for (int e = 0; e < 4; ++e) PART[(wave * 16 + (lane >> 4) * 4 + e) * 64 + nb * 16 + (lane & 15)] = acc[nb][e]; }
        __syncthreads();
#pragma unroll
        for (int rr = 0; rr < 2; ++rr) { const int rl = wave * 2 + rr, row = r0 + rl;
            float lg = 0.f;
#pragma unroll
            for (int w = 0; w < 8; ++w) lg += PART[(w * 16 + rl) * 64 + lane];
            const float s = 1.0f / (1.0f + expf(-lg));
            const float sel = s + rb[lane];
            float m1 = sel;
            m1 = fmaxf(m1, __shfl_xor(m1, 1)); m1 = fmaxf(m1, __shfl_xor(m1, 2)); m1 = fmaxf(m1, __shfl_xor(m1, 4));
            const unsigned long long bal = __ballot(sel == m1);
            const int gbase = lane & ~7;
            const unsigned gmask = (unsigned)((bal >> gbase) & 0xffull);
            const int first = gbase + __builtin_ctz(gmask);
            float m2 = (lane == first) ? -INFINITY : sel;
            m2 = fmaxf(m2, __shfl_xor(m2, 1)); m2 = fmaxf(m2, __shfl_xor(m2, 2)); m2 = fmaxf(m2, __shfl_xor(m2, 4));
            const float gs = m1 + m2;
            const int mygrp = lane >> 3;
            int grank = 0;
#pragma unroll
            for (int g = 0; g < 8; ++g) { const float o = __shfl(gs, g * 8); grank += (o > gs || (o == gs && g < mygrp)) ? 1 : 0; }
            const float msel = grank < 4 ? sel : -INFINITY;
            int rank = 0;
#pragma unroll 8
            for (int e = 0; e < 64; ++e) { const float o = __shfl(msel, e); rank += (o > msel || (o == msel && e < lane)) ? 1 : 0; }
            const bool chosen = rank < 8;
            const float wsum = wave_sum(chosen ? s : 0.f);
            if (chosen) { const float gate = s / wsum * 2.5f;
                ((int*)(F.ws + WS_TOPE))[(size_t)row * 8 + rank] = lane;
                ((float*)(F.ws + WS_TOPG))[(size_t)row * 8 + rank] = gate;
                const int lp = __hip_atomic_fetch_add(LCNT + lane, 1, __ATOMIC_RELAXED, __HIP_MEMORY_SCOPE_WORKGROUP);
                ASG[(itn * 16 + rl) * 8 + rank] = (lane << 20) | lp; } }
        __syncthreads();
    }
    if (F.tid < 64) { const int n = LCNT[F.tid]; LBASE[F.tid] = n ? (int)atomicAdd(F.ctl + CW_CNT + (ly * 64 + F.tid) * CNT_STRIDE, (unsigned)n) : 0; }
    __syncthreads();
    for (int a = F.tid; a < itn * 128; a += NTHR) { const int it = a >> 7, rl = (a >> 3) & 15, slot = a & 7; const int row = F.bid * 16 + it * F.G * 16 + rl;
        const int v = ASG[a], e = v >> 20, lp = v & 0xfffff;
        ((int*)(F.ws + WS_LIST))[(size_t)e * RTOT + LBASE[e] + lp] = row * 8 + slot; }
    __syncthreads();
}

DI void bf8_fma(const u32x4 w, float g, float (&y)[8]) {
    y[0] += bflo(w.x) * g; y[1] += bfhi(w.x) * g; y[2] += bflo(w.y) * g; y[3] += bfhi(w.y) * g; y[4] += bflo(w.z) * g; y[5] += bfhi(w.z) * g; y[6] += bflo(w.w) * g; y[7] += bfhi(w.w) * g;
}
DI void phase_combine(const Frame& F, int ly) {
    const int gw = F.bid * 8 + F.wave, nw = F.G * 8, lane = F.lane;
    const bool last = ly == DEPTH - 1;
    const int nrows = last ? RLAT : RTOT;
    const float* MOD = (const float*)(F.ws + WS_MOD);
    const float* g2w = F.in[24] + (size_t)ly * DM; const float* b2w = F.in[25] + (size_t)ly * DM;
    const bf16_t* YB = (const bf16_t*)(F.ws + WS_YB);
    for (int row = gw; row < nrows; row += nw) {
        const float* gates = (const float*)(F.ws + WS_TOPG) + (size_t)row * 8;
        u32x4 yr[9][2];
#pragma unroll
        for (int s9 = 0; s9 < 9; ++s9)
#pragma unroll
            for (int hf = 0; hf < 2; ++hf) yr[s9][hf] = *(const u32x4*)(YB + ((size_t)row * 9 + s9) * DM + hf * 512 + 8 * lane);
        float* xr = (float*)(F.ws + WS_X) + (size_t)row * DM;
        f32x4 xv[4];
#pragma unroll
        for (int hf = 0; hf < 2; ++hf) { xv[2 * hf] = *(const f32x4*)(xr + hf * 512 + 8 * lane); xv[2 * hf + 1] = *(const f32x4*)(xr + hf * 512 + 8 * lane + 4); }
        float y[2][8];
#pragma unroll
        for (int hf = 0; hf < 2; ++hf) {
#pragma unroll
            for (int e = 0; e < 8; ++e) y[hf][e] = 0.f;
            bf8_fma(yr[8][hf], 1.0f, y[hf]);
#pragma unroll
            for (int s8 = 0; s8 < 8; ++s8) bf8_fma(yr[s8][hf], gates[s8], y[hf]); }
        const float* m = MOD + ((size_t)ly * 5 + row_modsel(row)) * 6144;
        f32x4 v[4];
#pragma unroll
        for (int q = 0; q < 4; ++q) { const int c = (q >> 1) * 512 + 8 * lane + (q & 1) * 4; const f32x4 g2 = *(const f32x4*)(m + 5120 + c);
#pragma unroll
            for (int e = 0; e < 4; ++e) v[q][e] = xv[q][e] * ALPHA + g2[e] * y[q >> 1][(q & 1) * 4 + e]; }
        float mu, rstd; ln_stats(v, mu, rstd);
#pragma unroll
        for (int q = 0; q < 4; ++q) { const int c = (q >> 1) * 512 + 8 * lane + (q & 1) * 4; const f32x4 g = *(const f32x4*)(g2w + c), bb = *(const f32x4*)(b2w + c);
#pragma unroll
            for (int e = 0; e < 4; ++e) v[q][e] = (v[q][e] - mu) * rstd * g[e] + bb[e];
            if (last) *(f32x4*)(F.out + (size_t)row * DM + c) = v[q]; else *(f32x4*)(xr + c) = v[q]; }
        if (!last) { const float* mn = MOD + ((size_t)(ly + 1) * 5 + row_modsel(row)) * 6144;
            ln_stats(v, mu, rstd);
            bf16_t* hrow = (bf16_t*)(F.ws + WS_H) + (size_t)row * DM;
#pragma unroll
            for (int hf = 0; hf < 2; ++hf) { const int c = hf * 512 + 8 * lane; float o[8];
#pragma unroll
                for (int q = 0; q < 2; ++q) { const f32x4 sh = *(const f32x4*)(mn + c + 4 * q), sc = *(const f32x4*)(mn + 1024 + c + 4 * q);
#pragma unroll
                    for (int e = 0; e < 4; ++e) o[4 * q + e] = (v[2 * hf + q][e] - mu) * rstd * (1.f + sc[e]) + sh[e]; }
                u32x4 w; w.x = cvt_pk_bf16(o[0], o[1]); w.y = cvt_pk_bf16(o[2], o[3]); w.z = cvt_pk_bf16(o[4], o[5]); w.w = cvt_pk_bf16(o[6], o[7]);
                *(u32x4*)(hrow + c) = w; } }
    }
}

DI Frame relaunder(const Frame& F0) {
    Frame F = F0; int wv = F0.wave; asm volatile("" : "+s"(wv));
    int ln = (int)__builtin_amdgcn_mbcnt_hi(~0u, __builtin_amdgcn_mbcnt_lo(~0u, 0u)); asm volatile("" : "+v"(ln));
    F.wave = wv; F.lane = ln; F.tid = wv * 64 + ln;
    unsigned char* w = F0.ws; asm volatile("" : "+s"(w)); F.ws = w; F.ctl = (unsigned*)(w + WS_CTL);
    int b = F0.bid, g = F0.G; asm volatile("" : "+s"(b), "+s"(g)); F.bid = b; F.G = g;
    return F;
}
PHASE_FN void ph_pre0(const Frame& F0) { const Frame F = relaunder(F0); prep_weights(F, 0); prep_mod(F); prep_filters(F); prep_tables(F); prep_copy_x(F); }
PHASE_FN void ph_pre1(const Frame& F0) { const Frame F = relaunder(F0); prep_invl1(F); phase_init_h(F); }
PHASE_FN void ph_win(const Frame& F0, int ly) { const Frame F = relaunder(F0);
    pg8::Gemm g{(const bf16_t*)(F.ws + WS_H), (const bf16_t*)(F.ws + WS_WIN), DM, F.tid};
    pg8::StaticOrder S; S.init(RTOT / 256, NWIN / 256, F.G, F.bid);
    EpiWin E{F.ws, ly};
    pg8::gemm_phase<EpiWin, pg8::StaticOrder>(F.lds, g, S, E);
}
PHASE_FN void ph_fnet(const Frame& F0) { const Frame F = relaunder(F0);
    { pg8::Gemm g{(const bf16_t*)(F.ws + WS_DFTC), (const bf16_t*)(F.ws + WS_YTC), 2 * CTXL, F.tid};
      pg8::StaticOrder S; S.init(1, 4, F.G, (F.bid + F.G - 64) % F.G);
      EpiFnet E{F.ws, 1};
      pg8::gemm_phase<EpiFnet, pg8::StaticOrder>(F.lds, g, S, E); }
    __syncthreads();
    for (int u = F.bid; u < 256; u += F.G) fnet_fft_unit(F, u);
}
PHASE_FN void ph_hyena(const Frame& F0, int ly) { const Frame F = relaunder(F0); for (int c = F.bid; c < 256; c += F.G) { hyena_fft_unit(F, ly, c); hyena_ctx_unit(F, ly, c); } }
PHASE_FN void ph_attn(const Frame& F0, int ly) { const Frame F = relaunder(F0);
    volatile LAS unsigned* MISC = (volatile LAS unsigned*)(F.lds + LDS_MISC);
    const float lam_init = 0.8f - 0.6f * expf(-0.3f * (float)ly);
    float lam;
    { float s1 = 0.f, s2 = 0.f;
      for (int i = 0; i < 32; ++i) { s1 += F.in[16][ly * 32 + i] * F.in[17][ly * 32 + i]; s2 += F.in[18][ly * 32 + i] * F.in[19][ly * 32 + i]; }
      lam = expf(s1) - expf(s2) + lam_init; }
    for (;;) {
        __syncthreads();
        if (F.tid == 0) MISC[16] = atomicAdd(F.ctl + CW_ATTN + 64 * ly, 1u);
        __syncthreads();
        const int uid = (int)MISC[16];
        if (uid >= 544) break;
        attn_unit(F, ly, uid, lam, 1.0f - lam_init);
    }
}
PHASE_FN void ph_wout(const Frame& F0, int ly) { const Frame F = relaunder(F0);
    pg8::Gemm g{(const bf16_t*)(F.ws + WS_MIX), (const bf16_t*)(F.ws + WS_WOUT), DM, F.tid};
    pg8::StaticOrder S; S.init(RTOT / 256, DM / 256, F.G, F.bid);
    EpiWout E{F.ws, ly};
    pg8::gemm_phase<EpiWout, pg8::StaticOrder>(F.lds, g, S, E);
}
PHASE_FN void ph_router(const Frame& F0, int ly) { const Frame F = relaunder(F0); phase_rows_router(F, ly); }
PHASE_FN void ph_moe1(const Frame& F0, int ly) { const Frame F = relaunder(F0);
    const MoeTab T = moe_tables(F, ly);
    pg8::Gemm g{(const bf16_t*)(F.ws + WS_H), (const bf16_t*)(F.ws + WS_WGU), DM, F.tid};
    MoeSched<true> S{T, (const int*)(F.ws + WS_LIST), F.G, F.bid, 2, 1};
    EpiMoe1 E{F.ws};
    pg8::gemm_phase<EpiMoe1, MoeSched<true>>(F.lds, g, S, E);
}
PHASE_FN void ph_moe2(const Frame& F0, int ly) { const Frame F = relaunder(F0);
    const MoeTab T = moe_tables(F, ly);
    pg8::Gemm g{(const bf16_t*)(F.ws + WS_ACT), (const bf16_t*)(F.ws + WS_WD), DEXP, F.tid};
    MoeSched<false> S{T, (const int*)(F.ws + WS_LIST), F.G, F.bid, 4, 2};
    EpiMoe2 E{F.ws, T, (const int*)(F.ws + WS_LIST)};
    pg8::gemm_phase<EpiMoe2, MoeSched<false>>(F.lds, g, S, E);
}
PHASE_FN void ph_combine(const Frame& F0, int ly) { const Frame F = relaunder(F0); phase_combine(F, ly); if (ly + 1 < DEPTH) prep_weights(F, ly + 1); }

constexpr int PH_PER_LAYER = 7, N_PHASES = 2 + DEPTH * PH_PER_LAYER;

__global__ void __launch_bounds__(NTHR, 2) hybrid_fwd(Params prm) {
    extern __shared__ __attribute__((aligned(16))) unsigned char lds_raw[];
    Frame F;
    F.in = prm.in; F.out = prm.out; F.ws = prm.ws; F.lds = (LAS unsigned char*)lds_raw; F.ctl = (unsigned*)(prm.ws + WS_CTL);
    F.tid = threadIdx.x; F.lane = F.tid & 63; F.wave = __builtin_amdgcn_readfirstlane(F.tid >> 6); F.G = gridDim.x; F.bid = blockIdx.x;
    volatile LAS unsigned* MISC = (volatile LAS unsigned*)(F.lds + LDS_MISC);
    if (F.tid < 64) MISC[F.tid] = 0u;
    __syncthreads();
    const int lo = prm.ph_lo, hi = prm.ph_hi;
    XcdBarrier bar; bar.bar = F.ctl + CW_BAR; bar.x = 0; bar.st = nullptr;
    if (hi - lo > 1) bar = xcd_barrier_post(F.ctl + CW_BAR, MISC);
#define IN(k) (lo <= (k) && (k) < hi)
    unsigned long long pr_acc = 0ull, pr_t0 = 0ull;
#define SEAM(k) do { if (IN(k) && IN((k) + 1)) { unsigned long long _b0 = 0; if ((PROBE_KINDS >> 12) & 1) _b0 = __builtin_amdgcn_s_memrealtime(); xcd_barrier(bar); if ((PROBE_KINDS >> 12) & 1) pr_acc += __builtin_amdgcn_s_memrealtime() - _b0; } } while (0)
#define PR_BEGIN(kind) do { if ((PROBE_KINDS >> (kind)) & 1) pr_t0 = __builtin_amdgcn_s_memrealtime(); } while (0)
#define PR_END(kind) do { if ((PROBE_KINDS >> (kind)) & 1) pr_acc += __builtin_amdgcn_s_memrealtime() - pr_t0; } while (0)

    PR_BEGIN(0); if (IN(0) && KIND(0)) ph_pre0(F);
    PR_END(0); SEAM(0);
    PR_BEGIN(1); if (IN(1) && KIND(1)) ph_pre1(F);
    PR_END(1); SEAM(1);

    for (int ly = 0; ly < DEPTH; ++ly) {
        const int p0 = 2 + ly * PH_PER_LAYER;
        PR_BEGIN(2); if (IN(p0) && KIND(2)) ph_win(F, ly);
        PR_END(2); SEAM(p0);
        if (IN(p0 + 1)) { PR_BEGIN(3); if (KIND(3)) ph_fnet(F); PR_END(3); PR_BEGIN(4); if (KIND(4)) ph_hyena(F, ly); PR_END(4); PR_BEGIN(5); if (KIND(5)) ph_attn(F, ly); }
        PR_END(5); SEAM(p0 + 1);
        PR_BEGIN(6); if (IN(p0 + 2) && KIND(6)) ph_wout(F, ly);
        PR_END(6); SEAM(p0 + 2);
        PR_BEGIN(7); if (IN(p0 + 3) && KIND(7)) ph_router(F, ly);
        PR_END(7); SEAM(p0 + 3);
        PR_BEGIN(8); if (IN(p0 + 4) && KIND(8)) ph_moe1(F, ly);
        PR_END(8); SEAM(p0 + 4);
        PR_BEGIN(9); if (IN(p0 + 5) && KIND(9)) ph_moe2(F, ly);
        PR_END(9); SEAM(p0 + 5);
        PR_BEGIN(10); if (IN(p0 + 6) && KIND(10)) ph_combine(F, ly);
        PR_END(10); SEAM(p0 + 6);
    }
    if (PROBE_KINDS != 0 && blockIdx.x == 0) {
        const unsigned long long t0 = __builtin_amdgcn_s_memrealtime(), wait = pr_acc * (unsigned long long)PROBE_AMP;
        while (__builtin_amdgcn_s_memrealtime() - t0 < wait) __builtin_amdgcn_s_sleep(8);
    }
#undef IN
#undef SEAM
}

extern "C" void kernel_launch(void* const* d_in, const int* in_sizes, int n_in, void* d_out, int out_size, void* d_ws, size_t ws_size, hipStream_t stream) {
    static int grid = 0;
    if (grid == 0) {
        if (n_in != 34 || out_size != RLAT * DM || ws_size < WS_END) { fprintf(stderr, "kernel_launch: unexpected problem shape (n_in %d out %d ws %zu need %zu)\n", n_in, out_size, ws_size, (size_t)WS_END); grid = -1; return; }
        int dev = 0, cus = 0, per_cu = 0;
        if (hipGetDevice(&dev) != hipSuccess || hipDeviceGetAttribute(&cus, hipDeviceAttributeMultiprocessorCount, dev) != hipSuccess) { grid = -1; return; }
        if (hipFuncSetAttribute((const void*)hybrid_fwd, hipFuncAttributeMaxDynamicSharedMemorySize, LDS_BYTES) != hipSuccess) { fprintf(stderr, "kernel_launch: hipFuncSetAttribute failed\n"); grid = -1; return; }
        if (hipOccupancyMaxActiveBlocksPerMultiprocessor(&per_cu, (const void*)hybrid_fwd, NTHR, LDS_BYTES) != hipSuccess || per_cu < 1)
            fprintf(stderr, "kernel_launch: occupancy query reports %d workgroups per CU\n", per_cu);
        (void)hipGetLastError();
        grid = cus;
    }
    if (grid < 0) return;
    (void)hipMemsetAsync((char*)d_ws + WS_CTL, 0, CTL_BYTES, stream);
    Params p{};
    for (int i = 0; i < 34; ++i) p.in[i] = (const float*)d_in[i];
    p.out = (float*)d_out; p.ws = (unsigned char*)d_ws;
#if MK_PER_PHASE
    for (int ph = 0; ph < N_PHASES; ++ph) { p.ph_lo = ph; p.ph_hi = ph + 1; hipLaunchKernelGGL(hybrid_fwd, dim3(grid), dim3(NTHR), LDS_BYTES, stream, p); }
#else
    p.ph_lo = 0; p.ph_hi = N_PHASES;
    hipLaunchKernelGGL(hybrid_fwd, dim3(grid), dim3(NTHR), LDS_BYTES, stream, p);
#endif
}
```

```cpp
#include <hip/hip_runtime.h>
#include <cstdio>
#include <cstdint>

#ifndef MK_PER_PHASE
#define MK_PER_PHASE 0
#endif

#ifndef PG8_OPAQUE_K
#define PG8_OPAQUE_K 1
#endif
#ifndef MK_OUTLINE
#define MK_OUTLINE 0
#endif
#if MK_OUTLINE
#define PHASE_FN __device__ __attribute__((noinline))
#else
#define PHASE_FN __device__ __forceinline__
#endif
#ifndef PROBE_KINDS
#define PROBE_KINDS 0
#endif
#ifndef PROBE_AMP
#define PROBE_AMP 4
#endif
#ifndef KMASK
#define KMASK 0xFFFF
#endif
#define KIND(k) ((KMASK >> (k)) & 1)
#define LAS __attribute__((address_space(3)))
typedef unsigned short bf16_t;
typedef short bf16x8 __attribute__((ext_vector_type(8)));
typedef short s16x4 __attribute__((ext_vector_type(4)));
typedef float f32x4 __attribute__((ext_vector_type(4)));
typedef float f32x16 __attribute__((ext_vector_type(16)));
typedef unsigned u32x4 __attribute__((ext_vector_type(4)));
typedef unsigned u32x2 __attribute__((ext_vector_type(2)));
#define DI __device__ __forceinline__

constexpr int NB = 4, SEQ = 4096, CTXL = 256, DM = 1024, DEPTH = 4;
constexpr int POS = SEQ + CTXL;
constexpr int RLAT = NB * SEQ, RCTX = NB * CTXL, RTOT = RLAT + RCTX;
constexpr int DIN = 2560, NWIN = 2816;
constexpr int NEXP = 64, DEXP = 256;
constexpr float LN_EPS = 1e-5f;
constexpr float ALPHA = 1.681792830507429f;
constexpr float QSCALE = 0.17677669529663687f * 1.4426950408889634f;
constexpr int MAXTILES = 680;

constexpr size_t AL(size_t x) { return (x + 255) & ~(size_t)255; }
constexpr size_t WS_CTL = 0, CTL_BYTES = 1u << 20;
constexpr size_t WS_X = WS_CTL + CTL_BYTES;
constexpr size_t WS_H = WS_X + AL((size_t)RTOT * DM * 4);
constexpr size_t WS_MOD = WS_H + AL((size_t)RTOT * DM * 2);
constexpr size_t WS_HCL = WS_MOD + AL((size_t)DEPTH * 5 * 6144 * 4);
constexpr size_t WS_HCC = WS_HCL + AL((size_t)DEPTH * 4 * 256 * SEQ * 4);
constexpr size_t WS_INVL1 = WS_HCC + AL((size_t)DEPTH * 4 * 256 * CTXL * 4);
constexpr size_t WS_DFTL = WS_INVL1 + AL((size_t)DEPTH * 2 * 2 * 256 * 4);
constexpr size_t WS_DFTC = WS_DFTL + 256;
constexpr size_t WS_ROPE = WS_DFTC + AL((size_t)CTXL * 2 * CTXL * 2);
constexpr size_t WS_LAM = WS_ROPE + AL(64 * 8 * 2 * 4);
constexpr size_t WS_WIN = WS_LAM + 256;
constexpr size_t WS_WOUT = WS_WIN + AL((size_t)NWIN * DM * 2);
constexpr size_t WS_WGU = WS_WOUT + AL((size_t)DM * DM * 2);
constexpr size_t WS_WD = WS_WGU + AL((size_t)65 * 512 * DM * 2);
constexpr size_t WS_TOPE = WS_WD + AL((size_t)65 * DM * DEXP * 2);
constexpr size_t WS_TOPG = WS_TOPE + AL((size_t)RTOT * 8 * 4);
constexpr size_t WS_LIST = WS_TOPG + AL((size_t)RTOT * 8 * 4);
constexpr size_t WS_SPEC = WS_LIST + AL((size_t)NEXP * RTOT * 4);
constexpr size_t WS_Z1 = WS_SPEC + AL((size_t)256 * 2 * 8192 * 8);
constexpr size_t WS_U = WS_Z1 + AL((size_t)256 * SEQ * 4 * 4);
constexpr size_t WS_Q = WS_U;
constexpr size_t WS_K = WS_Q + AL((size_t)NB * 8 * POS * 64 * 2);
constexpr size_t WS_V = WS_K + AL((size_t)NB * 8 * POS * 64 * 2);
constexpr size_t WS_HYT = WS_V + AL((size_t)NB * 8 * POS * 64 * 2);
constexpr size_t WS_YTL = WS_HYT + AL((size_t)NB * 768 * POS * 4);
constexpr size_t WS_YTC = WS_YTL + AL((size_t)1024 * 8192 * 2);
constexpr size_t WS_MIX = WS_YTC + AL((size_t)1024 * 512 * 2);
constexpr size_t WS_U1_END = WS_MIX + AL((size_t)RTOT * DM * 2);
constexpr size_t WS_ACT = WS_U;
constexpr size_t WS_YB = WS_ACT + AL((size_t)MAXTILES * 256 * DEXP * 2);
constexpr size_t WS_U2_END = WS_YB + AL((size_t)MAXTILES * 256 * DM * 2);
constexpr size_t WS_END = WS_U2_END > WS_U1_END ? WS_U2_END : WS_U1_END;

constexpr int CW_BAR = 0;
constexpr int CW_ATTN = 4096;
constexpr int CW_PREPQ = 4096 + 1024;
constexpr int CW_PREPQ2 = 4096 + 1536;
constexpr int PREP_SPLIT = 1440;
constexpr int CW_KMAX = 4096 + 512;
constexpr int CW_CNT = 8192;
constexpr int CNT_STRIDE = 64;

DI unsigned cvt_pk_bf16(float lo, float hi) { unsigned r; asm volatile("v_cvt_pk_bf16_f32 %0, %1, %2" : "=v"(r) : "v"(lo), "v"(hi)); return r; }
DI bf16x8 pack8(float a0, float a1, float a2, float a3, float a4, float a5, float a6, float a7) {
    u32x4 p;
    asm volatile("v_cvt_pk_bf16_f32 %0, %4, %5\n\tv_cvt_pk_bf16_f32 %1, %6, %7\n\tv_cvt_pk_bf16_f32 %2, %8, %9\n\tv_cvt_pk_bf16_f32 %3, %10, %11\n\ts_nop 1"
                 : "=&v"(p[0]), "=&v"(p[1]), "=&v"(p[2]), "=&v"(p[3]) : "v"(a0), "v"(a1), "v"(a2), "v"(a3), "v"(a4), "v"(a5), "v"(a6), "v"(a7));
    return __builtin_bit_cast(bf16x8, p);
}
DI bf16_t f2bf(float x) { return (bf16_t)(cvt_pk_bf16(x, 0.f) & 0xffffu); }
DI float bf2f(unsigned short u) { return __uint_as_float(((unsigned)u) << 16); }
DI float bflo(unsigned w) { return __uint_as_float(w << 16); }
DI float bfhi(unsigned w) { return __uint_as_float(w & 0xffff0000u); }
DI float wave_sum(float v) {
#pragma unroll
    for (int o = 32; o >= 1; o >>= 1) v += __shfl_xor(v, o);
    return v;
}
DI float wave_max(float v) {
#pragma unroll
    for (int o = 32; o >= 1; o >>= 1) v = fmaxf(v, __shfl_xor(v, o));
    return v;
}

#define XB_TMO      128
#define XB_XCNT(j)  (256  + 64 * (j))
#define XB_XSUB(j)  (1280 + 64 * (j))
#define XB_XGEN(j)  (2304 + 64 * (j))
#define XB_TOP      3328
#define XB_TOPGEN   3392
#define XCD_BAR_WORDS 3456
#define XB_SPIN_CAP (1u << 18)

__device__ __forceinline__ unsigned xb_ld(unsigned* p)              { return __hip_atomic_load(p, __ATOMIC_RELAXED, __HIP_MEMORY_SCOPE_AGENT); }
__device__ __forceinline__ unsigned xb_add(unsigned* p, unsigned v) { return __hip_atomic_fetch_add(p, v, __ATOMIC_RELAXED, __HIP_MEMORY_SCOPE_AGENT); }
__device__ __forceinline__ unsigned xb_xcc_id() { return (unsigned)__builtin_amdgcn_s_getreg((3 << 11) | 20) & 0xFu; }
#define XB_SPIN(cond, bar) do { unsigned _sp = 0; while (cond) { __builtin_amdgcn_s_sleep(1); \
    if ((++_sp & 255u) == 0u) { if (xb_ld(&(bar)[XB_TMO])) break; if (_sp > XB_SPIN_CAP) { atomicAdd(&(bar)[XB_TMO], 1u); break; } } } } while (0)

struct XcdBarrier { unsigned* bar; unsigned x; volatile LAS unsigned* st; };

__device__ __forceinline__ XcdBarrier xcd_barrier_post(unsigned* bar, volatile LAS unsigned* st) {
    XcdBarrier b; b.bar = bar; b.x = xb_xcc_id(); b.st = st;
    if (threadIdx.x == 0) (void)xb_add(&bar[XB_XCNT(b.x)], 1u);
    return b;
}
__device__ __forceinline__ void xcd_barrier_complete(unsigned* bar, unsigned x, unsigned& nloc, unsigned& nx) {
    const unsigned G = gridDim.x * gridDim.y * gridDim.z;
    unsigned sum, cnt, mine, sp = 0u;
    for (;;) {
        sum = 0u; cnt = 0u; mine = 0u;
#pragma unroll
        for (unsigned j = 0; j < 16; ++j) { const unsigned c = xb_ld(&bar[XB_XCNT(j)]); sum += c; cnt += (c > 0u) ? 1u : 0u; mine = (j == x) ? c : mine; }
        if (sum == G) break;
        __builtin_amdgcn_s_sleep(1);
        if ((++sp & 255u) == 0u) { if (xb_ld(&bar[XB_TMO])) break; if (sp > XB_SPIN_CAP) { atomicAdd(&bar[XB_TMO], 1u); break; } }
    }
    nloc = mine > 0u ? mine : 1u; nx = cnt > 0u ? cnt : 1u;
}
__device__ __forceinline__ void xcd_barrier(const XcdBarrier& b) {
    asm volatile("s_waitcnt vmcnt(0)" ::: "memory");
    __syncthreads();
    if (threadIdx.x == 0) {
        unsigned* bar = b.bar;
        __builtin_amdgcn_s_waitcnt(0);
        unsigned nloc = b.st[0], nx = b.st[1];
        if (nloc == 0u) { xcd_barrier_complete(bar, b.x, nloc, nx); b.st[0] = nloc; b.st[1] = nx; }
        const unsigned old = xb_add(&bar[XB_XSUB(b.x)], 1u);
        const unsigned gen = old / nloc;
        if (old + 1u == (gen + 1u) * nloc) {
            __builtin_amdgcn_fence(__ATOMIC_RELEASE, "agent");
            asm volatile("s_waitcnt vmcnt(0)" ::: "memory");
            const unsigned og = xb_add(&bar[XB_TOP], 1u);
            const unsigned tg = og / nx;
            if (og + 1u == (tg + 1u) * nx) xb_add(&bar[XB_TOPGEN], 1u);
            else XB_SPIN(xb_ld(&bar[XB_TOPGEN]) == tg, bar);
            __builtin_amdgcn_fence(__ATOMIC_ACQUIRE, "agent");
            xb_add(&bar[XB_XGEN(b.x)], 1u);
            asm volatile("s_waitcnt vmcnt(0)" ::: "memory");
        } else {
            XB_SPIN(xb_ld(&bar[XB_XGEN(b.x)]) == gen, bar);
            __builtin_amdgcn_fence(__ATOMIC_ACQUIRE, "agent");
            asm volatile("s_waitcnt vmcnt(0)" ::: "memory");
        }
    }
    __syncthreads();
}

namespace pg8 {
constexpr int BM = 256, BK = 64, HALF = 128, HTB = HALF * BK * 2, STAGE_BYTES = 8 * HTB, NXCD = 8, WGM = 8;
__host__ __device__ __forceinline__ int lds_byte(int r, int c) { const int st = (r >> 4) * 2 + (c >> 5), rr = r & 15, cc = c & 31, ob = rr * 64 + cc * 2; return st * 1024 + (ob ^ (((ob >> 9) & 1) << 5)); }
__host__ __device__ __forceinline__ void stage_rc(int b, int& R, int& C) { const int st = b / 1024, sb = b % 1024, swz = sb ^ (((sb >> 9) & 1) << 5); R = (st >> 1) * 16 + swz / 64; C = (st & 1) * 32 + (swz % 64) / 2; }
__host__ __device__ __forceinline__ int perm32(int rho) { const int n = rho >> 4, i = rho & 15; return 8 * (i >> 2) + 4 * n + (i & 3); }

struct Unit { int pm, pn, e, lt; };
struct Gemm { const bf16_t* A; const bf16_t* Bt; int K; int tid; };

struct StaticOrder {
    static constexpr bool GATHER = false;
    int nM, nN, nwg, G, c;
    __device__ void init(int nM_, int nN_, int G_, int c_) { nM = nM_; nN = nN_; nwg = nM * nN; G = G_; c = c_; }
    __device__ bool next(int i, Unit& u) const {
        const long L = (long)i * G + c; if (L >= nwg) return false;
        int wgid = (int)L; { const int q = nwg / NXCD, r = nwg % NXCD, xcd = wgid % NXCD, off = wgid / NXCD; wgid = (xcd < r ? xcd * (q + 1) : r * (q + 1) + (xcd - r) * q) + off; }
        const int nig = WGM * nN, gid = wgid / nig, fm = gid * WGM, gsz = (nM - fm) < WGM ? (nM - fm) : WGM;
        u.pm = fm + ((wgid % nig) % gsz); u.pn = (wgid % nig) / gsz; u.e = 0; u.lt = 0; return true;
    }
    __device__ __forceinline__ int arow(const Unit& u, int r) const { return u.pm * BM + r; }
};

template <class Epi, class Sched>
__device__ __forceinline__ void gemm_phase(LAS unsigned char* lds, const Gemm g, const Sched& S, const Epi& E) {
    constexpr bool GA = Sched::GATHER;
    int tid = g.tid; asm volatile("" : "+v"(tid));
    const int wid = __builtin_amdgcn_readfirstlane(tid >> 6), lane = tid & 63, wr = wid >> 2, wc = wid & 3, fr = lane & 15, fq = lane >> 4;
    int K = g.K;
#if PG8_OPAQUE_K
    asm volatile("" : "+s"(K));
#endif
    const int nt = K / BK;
    unsigned voffA[2], voffB[2];
#pragma unroll
    for (int i = 0; i < 2; ++i) { int R, C; stage_rc(tid * 16 + i * 8192, R, C); const int Rb = Epi::PERM ? ((R & ~31) + perm32(R & 31)) : R;
        voffA[i] = (unsigned)(R * K + C) * 2u; voffB[i] = (unsigned)(Rb * K + C) * 2u; }
    const size_t kstep = (size_t)(BK * 2);
    const size_t hstep = (size_t)HALF * K * 2;
    const size_t tstep = 2 * hstep;
    const unsigned ldsw = (unsigned)wid * 1024u;
    const int aoff = lds_byte(wr * 64 + fr, fq * 8), boff = lds_byte(wc * 32 + fr, fq * 8);
#define PG8_SA(b, h) (((b) * 2 + (h)) * HTB)
#define PG8_SB(b, h) ((4 + (b) * 2 + (h)) * HTB)
#define PG8_STAGE(bufoff, gbase, voff) do { _Pragma("unroll") for (int _i = 0; _i < 2; ++_i) \
        __builtin_amdgcn_global_load_lds((const unsigned*)((const char*)(gbase) + (voff)[_i]), (LAS unsigned*)(lds + (bufoff) + ldsw + _i * 8192), 16, 0, 0); } while (0)
#define PG8_STAGEA(bufoff, gbase, o0, o1) do { \
        __builtin_amdgcn_global_load_lds((const unsigned*)((const char*)(gbase) + (o0)), (LAS unsigned*)(lds + (bufoff) + ldsw), 16, 0, 0); \
        __builtin_amdgcn_global_load_lds((const unsigned*)((const char*)(gbase) + (o1)), (LAS unsigned*)(lds + (bufoff) + ldsw + 8192), 16, 0, 0); } while (0)
#define PG8_STA(bufoff, sp, gp, o0, o1) do { if constexpr (GA) PG8_STAGEA(bufoff, gp, o0, o1); else PG8_STAGE(bufoff, sp, voffA); } while (0)
#define PG8_LDA(dst, b, h) do { _Pragma("unroll") for (int m = 0; m < 4; ++m) _Pragma("unroll") for (int k = 0; k < 2; ++k) dst[m][k] = *(const LAS bf16x8*)(lds + PG8_SA(b, h) + aoff + m * 2048 + k * 1024); } while (0)
#define PG8_LDB(dst, b, h) do { _Pragma("unroll") for (int n = 0; n < 2; ++n) _Pragma("unroll") for (int k = 0; k < 2; ++k) dst[n][k] = *(const LAS bf16x8*)(lds + PG8_SB(b, h) + boff + n * 2048 + k * 1024); } while (0)
#define PG8_MMA(ai, bj, At, Bt) do { __builtin_amdgcn_s_setprio(1); _Pragma("unroll") for (int m = 0; m < 4; ++m) _Pragma("unroll") for (int n = 0; n < 2; ++n) _Pragma("unroll") for (int k = 0; k < 2; ++k) \
        acc[ai][bj][m][n] = __builtin_amdgcn_mfma_f32_16x16x32_bf16(Bt[n][k], At[m][k], acc[ai][bj][m][n], 0, 0, 0); __builtin_amdgcn_s_setprio(0); } while (0)
#define PG8_WAIT_V(n) asm volatile("s_waitcnt vmcnt(" #n ")" ::: "memory")
#define PG8_WAIT_L(n) asm volatile("s_waitcnt lgkmcnt(" #n ")" ::: "memory")
#define PG8_BAR __builtin_amdgcn_s_barrier()
#define PG8_SCHED __builtin_amdgcn_sched_barrier(0)
#define PG8_GOFF(u, o00, o01, o10, o11) do { int _tz = g.tid; asm volatile("" : "+v"(_tz)); int _R0, _C0, _R1, _C1; stage_rc(_tz * 16, _R0, _C0); stage_rc(_tz * 16 + 8192, _R1, _C1); \
        o00 = (unsigned)(S.arow(u, _R0) * K + _C0) * 2u; o01 = (unsigned)(S.arow(u, _R1) * K + _C1) * 2u; \
        o10 = (unsigned)(S.arow(u, HALF + _R0) * K + _C0) * 2u; o11 = (unsigned)(S.arow(u, HALF + _R1) * K + _C1) * 2u; } while (0)
    Unit cur, nxt; int ui = 0;
    if (!S.next(0, cur)) return;
    f32x4 acc[2][2][4][2];
#pragma unroll
    for (int a = 0; a < 2; ++a)
#pragma unroll
        for (int b = 0; b < 2; ++b)
#pragma unroll
            for (int m = 0; m < 4; ++m)
#pragma unroll
                for (int n = 0; n < 2; ++n) acc[a][b][m][n] = (f32x4){0.f, 0.f, 0.f, 0.f};
    bf16x8 At[4][2], B0[2][2], B1[2][2];
    const char* const gA = (const char*)g.A;
    unsigned c00 = 0, c01 = 0, c10 = 0, c11 = 0, n00 = 0, n01 = 0, n10 = 0, n11 = 0;
    if constexpr (GA) PG8_GOFF(cur, c00, c01, c10, c11);
    const char* cA = gA + (GA ? (size_t)0 : (size_t)cur.pm * tstep); const char* cB = (const char*)g.Bt + (size_t)cur.pn * tstep;
    PG8_STAGE(PG8_SB(0, 0), cB, voffB); PG8_STAGE(PG8_SB(0, 1), cB + hstep, voffB); PG8_STA(PG8_SA(0, 0), cA, gA, c00, c01); PG8_STA(PG8_SA(0, 1), cA + hstep, gA, c10, c11);
    if (wr == 1) PG8_BAR;
    PG8_WAIT_V(2); PG8_BAR;
    PG8_STAGE(PG8_SB(1, 0), cB + kstep, voffB); PG8_STA(PG8_SA(1, 0), cA + kstep, gA + kstep, c00, c01); PG8_STAGE(PG8_SB(1, 1), cB + hstep + kstep, voffB);
    PG8_WAIT_V(6); PG8_BAR;
    for (;;) {
        const bool has_next = S.next(ui + 1, nxt);
        const char* nA = (has_next && !GA) ? gA + (size_t)nxt.pm * tstep : cA; const char* nB = has_next ? (const char*)g.Bt + (size_t)nxt.pn * tstep : cB;
        if constexpr (GA) { if (has_next) PG8_GOFF(nxt, n00, n01, n10, n11); else { n00 = c00; n01 = c01; n10 = c10; n11 = c11; } }
#pragma unroll 1
        for (int t = 0; t < nt; t += 2) {
            const bool last = (t == nt - 2);
            const char* a1 = cA + (size_t)(t + 1) * kstep;
            const char* a2 = last ? nA : cA + (size_t)(t + 2) * kstep; const char* b2 = last ? nB : cB + (size_t)(t + 2) * kstep;
            const char* a3 = a2 + kstep; const char* b3 = b2 + kstep;
            unsigned x00 = 0, x01 = 0, x10 = 0, x11 = 0;
            if constexpr (GA) { x00 = last ? n00 : c00; x01 = last ? n01 : c01; x10 = last ? n10 : c10; x11 = last ? n11 : c11; }
            PG8_LDB(B0, 0, 0); PG8_LDB(B1, 0, 1); PG8_SCHED; PG8_LDA(At, 0, 0); PG8_STA(PG8_SA(1, 1), a1 + hstep, a1, c10, c11);
            PG8_WAIT_V(8); PG8_WAIT_L(0); PG8_BAR; PG8_MMA(0, 0, At, B0); PG8_MMA(0, 1, At, B1); PG8_BAR; PG8_SCHED;
            PG8_LDA(At, 0, 1); PG8_STAGE(PG8_SB(0, 0), b2, voffB); PG8_STAGE(PG8_SB(0, 1), b2 + hstep, voffB); PG8_STA(PG8_SA(0, 0), a2, a2, x00, x01);
            PG8_WAIT_V(8); PG8_WAIT_L(0); PG8_BAR; PG8_MMA(1, 0, At, B0); PG8_MMA(1, 1, At, B1); PG8_BAR; PG8_SCHED;
            PG8_LDB(B0, 1, 0); PG8_LDB(B1, 1, 1); PG8_SCHED; PG8_LDA(At, 1, 0); PG8_STA(PG8_SA(0, 1), a2 + hstep, a2, x10, x11);
            PG8_WAIT_V(8); PG8_WAIT_L(0); PG8_BAR; PG8_MMA(0, 0, At, B0); PG8_MMA(0, 1, At, B1); PG8_BAR; PG8_SCHED;
            PG8_LDA(At, 1, 1); PG8_STAGE(PG8_SB(1, 0), b3, voffB); PG8_STAGE(PG8_SB(1, 1), b3 + hstep, voffB); PG8_STA(PG8_SA(1, 0), a3, a3, x00, x01);
            PG8_WAIT_V(8); PG8_WAIT_L(0); PG8_BAR; PG8_MMA(1, 0, At, B0); PG8_MMA(1, 1, At, B1); PG8_BAR; PG8_SCHED;
        }
        if (wr == 0) PG8_BAR;
        { int ln = (int)__builtin_amdgcn_mbcnt_hi(~0u, __builtin_amdgcn_mbcnt_lo(~0u, 0u)); asm volatile("" : "+v"(ln));
          E(acc, cur, wr, wc, ln & 15, ln >> 4); }
        if (!has_next) break;
#pragma unroll
        for (int a = 0; a < 2; ++a)
#pragma unroll
            for (int b = 0; b < 2; ++b)
#pragma unroll
                for (int m = 0; m < 4; ++m)
#pragma unroll
                    for (int n = 0; n < 2; ++n) acc[a][b][m][n] = (f32x4){0.f, 0.f, 0.f, 0.f};
        cur = nxt; cA = nA; cB = nB; ++ui;
        if constexpr (GA) { c00 = n00; c01 = n01; c10 = n10; c11 = n11; }
        if (wr == 1) PG8_BAR;
    }
    PG8_WAIT_V(0);
    PG8_BAR;
#undef PG8_SA
#undef PG8_SB
#undef PG8_STAGE
#undef PG8_STAGEA
#undef PG8_STA
#undef PG8_GOFF
#undef PG8_LDA
#undef PG8_LDB
#undef PG8_MMA
#undef PG8_WAIT_V
#undef PG8_WAIT_L
#undef PG8_BAR
#undef PG8_SCHED
}
}

constexpr int NTHR = 512;
constexpr int LDS_SCRATCH = 139264;
constexpr int LDS_MISC = LDS_SCRATCH;
constexpr int LDS_TAB = LDS_MISC + 256;
constexpr int LDS_BYTES = LDS_TAB + 8192;

struct Params { const float* in[34]; float* out; unsigned char* ws; int ph_lo, ph_hi; };

struct Frame {
    const float* const* in; float* out; unsigned char* ws; LAS unsigned char* lds; unsigned* ctl;
    int tid, lane, wave, G, bid;
};

DI int row_b(int row) { return row < RLAT ? (row >> 12) : ((row - RLAT) >> 8); }
DI int row_pos(int row) { return row < RLAT ? (row & 4095) : (SEQ + ((row - RLAT) & 255)); }
DI int row_modsel(int row) { return row < RLAT ? (row >> 12) : 4; }

DI Frame relaunder(const Frame& F0) {
    Frame F = F0; int wv = F0.wave; asm volatile("" : "+s"(wv));
    int ln = (int)__builtin_amdgcn_mbcnt_hi(~0u, __builtin_amdgcn_mbcnt_lo(~0u, 0u)); asm volatile("" : "+v"(ln));
    F.wave = wv; F.lane = ln; F.tid = wv * 64 + ln;
    unsigned char* w = F0.ws; asm volatile("" : "+s"(w)); F.ws = w; F.ctl = (unsigned*)(w + WS_CTL);
    int b = F0.bid, g = F0.G; asm volatile("" : "+s"(b), "+s"(g)); F.bid = b; F.G = g;
    return F;
}

DI void prep_tile(const Frame& F, const float* src, int ldn, int k0, int n0, bf16_t* dst, int ldk, int dst_row0) {
    LAS float* T = (LAS float*)F.lds;
    const int t = F.tid;
    { const float* p = src + (size_t)(k0 + (t >> 3)) * ldn + n0 + (t & 7) * 8;
      const f32x4 a = *(const f32x4*)p, b = *(const f32x4*)(p + 4);
      LAS float* q = T + (t >> 3) * 65 + (t & 7) * 8;
      q[0] = a[0]; q[1] = a[1]; q[2] = a[2]; q[3] = a[3]; q[4] = b[0]; q[5] = b[1]; q[6] = b[2]; q[7] = b[3]; }
    __syncthreads();
    { const int nn = t >> 3, kc = (t & 7) * 8; float v[8];
#pragma unroll
      for (int j = 0; j < 8; ++j) v[j] = T[(kc + j) * 65 + nn];
      u32x4 w; w.x = cvt_pk_bf16(v[0], v[1]); w.y = cvt_pk_bf16(v[2], v[3]); w.z = cvt_pk_bf16(v[4], v[5]); w.w = cvt_pk_bf16(v[6], v[7]);
      *(u32x4*)(dst + (size_t)(dst_row0 + nn) * ldk + k0 + kc) = w; }
    __syncthreads();
}

DI void prep_fourier_job(const Frame& F, int ly, int g, int kt) {
    LAS float* FW = (LAS float*)F.lds;
    LAS float* CS = FW + 4096;
    LAS float* P = CS + 128;
    LAS float* W = P + 8192;
    const int t = F.tid;
    const float* fw = F.in[21] + ((size_t)ly * 4 + g) * 4096;
    for (int i = t; i < 4096; i += NTHR) FW[i] = fw[i];
    if (t < 64) { float s, c; sincospif((float)t / 32.0f, &s, &c); CS[t] = c; CS[64 + t] = s; }
    { const float* p = F.in[6] + (size_t)ly * DM * DIN + (size_t)(kt * 64 + (t >> 3)) * DIN + 2304 + g * 64 + (t & 7) * 8;
      const f32x4 a = *(const f32x4*)p, b = *(const f32x4*)(p + 4);
      LAS float* q = W + (t >> 3) * 65 + (t & 7) * 8;
      q[0] = a[0]; q[1] = a[1]; q[2] = a[2]; q[3] = a[3]; q[4] = b[0]; q[5] = b[1]; q[6] = b[2]; q[7] = b[3]; }
    __syncthreads();
    for (int i = t; i < 8192; i += NTHR) {
        const int c = i >> 7, n = i & 127, comp = n >> 6, d = n & 63;
        float s = 0.f;
        for (int j = 0; j < 64; ++j) { const int a = (j * c) & 63; const float tr = comp ? -CS[64 + a] : CS[a]; s += tr * FW[j * 64 + d]; }
        P[c * 128 + n] = s;
    }
    __syncthreads();
    bf16_t* dst = (bf16_t*)(F.ws + WS_WIN);
    { const int k = t >> 3, nb = (t & 7) * 16;
      float o[16];
#pragma unroll
      for (int j = 0; j < 16; ++j) o[j] = 0.f;
      for (int c = 0; c < 64; ++c) { const float w = W[k * 65 + c];
#pragma unroll
          for (int j = 0; j < 16; ++j) o[j] += w * P[c * 128 + nb + j]; }
#pragma unroll
      for (int j = 0; j < 16; ++j) { const int n = nb + j, comp = n >> 6, d = n & 63;
          dst[(size_t)(2304 + comp * 256 + g * 64 + d) * DM + kt * 64 + k] = f2bf(o[j]); } }
    __syncthreads();
}

struct PrepJob { const float* src; bf16_t* dst; int ldn, ldk, row0, hi_step; };
DI PrepJob prep_job(const Frame& F, int ly, int j) {
    constexpr int J1 = 144, J2 = J1 + 64, J3 = J2 + 1040, J4 = J3 + 1040;
    PrepJob r;
    if (j < J1) { const int kb = j / 9, nb = j % 9;
        r.src = F.in[6] + (size_t)ly * DM * DIN + (size_t)kb * 64 * DIN + nb * 256; r.ldn = DIN; r.dst = (bf16_t*)(F.ws + WS_WIN) + kb * 64; r.ldk = DM; r.row0 = nb * 256; r.hi_step = 128;
    } else if (j < J2) { const int q = j - J1, kb = q >> 2, nb = q & 3;
        r.src = F.in[7] + (size_t)ly * DM * DM + (size_t)kb * 64 * DM + nb * 256; r.ldn = DM; r.dst = (bf16_t*)(F.ws + WS_WOUT) + kb * 64; r.ldk = DM; r.row0 = nb * 256; r.hi_step = 128;
    } else if (j < J4) { const bool up = j >= J3; const int q = j - (up ? J3 : J2), e = q >> 4, kb = q & 15;
        const float* src = e < NEXP ? F.in[up ? 29 : 28] + ((size_t)ly * NEXP + e) * DM * DEXP : F.in[up ? 32 : 31] + (size_t)ly * DM * DEXP;
        r.src = src + (size_t)kb * 64 * DEXP; r.ldn = DEXP; r.dst = (bf16_t*)(F.ws + WS_WGU) + kb * 64; r.ldk = DM; r.row0 = e * 512 + (up ? 128 : 0); r.hi_step = 256;
    } else { const int q = j - J4, e = q >> 4, kb = (q >> 2) & 3, nb = q & 3;
        const float* src = e < NEXP ? F.in[30] + ((size_t)ly * NEXP + e) * DEXP * DM : F.in[33] + (size_t)ly * DEXP * DM;
        r.src = src + (size_t)kb * 64 * DM + nb * 256; r.ldn = DM; r.dst = (bf16_t*)(F.ws + WS_WD) + kb * 64; r.ldk = DEXP; r.row0 = e * DM + nb * 256; r.hi_step = 128; }
    return r;
}
DI void prep_load(const Frame& F, const PrepJob& jb, f32x4 (&v)[8]) {
    const float* p = jb.src + (size_t)(8 * (F.tid >> 6)) * jb.ldn + 4 * (F.tid & 63);
#pragma unroll
    for (int i = 0; i < 8; ++i) v[i] = *(const f32x4*)(p + (size_t)i * jb.ldn);
}
DI void prep_store(const Frame& F, const PrepJob& jb, const f32x4 (&v)[8]) {
    LAS unsigned char* T = F.lds;
    const int t = F.tid, ln = t & 63, w = t >> 6;
#pragma unroll
    for (int pr = 0; pr < 4; ++pr)
#pragma unroll
        for (int e = 0; e < 4; ++e) *(LAS unsigned*)(T + (4 * ln + e) * 132 + (8 * w + 2 * pr) * 2) = cvt_pk_bf16(v[2 * pr][e], v[2 * pr + 1][e]);
    asm volatile("s_waitcnt lgkmcnt(0)" ::: "memory"); __builtin_amdgcn_s_barrier();
#pragma unroll
    for (int q = 0; q < 4; ++q) { const int n = q * 64 + (t >> 3), ch = t & 7;
        const LAS unsigned* r = (const LAS unsigned*)(T + n * 132 + ch * 16);
        u32x4 o; o.x = r[0]; o.y = r[1]; o.z = r[2]; o.w = r[3];
        *(u32x4*)(jb.dst + (size_t)(jb.row0 + (n >> 7) * jb.hi_step + (n & 127)) * jb.ldk + ch * 8) = o; }
    asm volatile("s_waitcnt lgkmcnt(0)" ::: "memory"); __builtin_amdgcn_s_barrier();
}
DI void prep_small(const Frame& F, int ly) {
    for (int j = F.bid; j < 208; j += F.G) { const PrepJob jb = prep_job(F, ly, j); f32x4 v[8]; prep_load(F, jb, v); prep_store(F, jb, v); }
    for (int q = F.G - 1 - F.bid; q < 64; q += F.G) prep_fourier_job(F, ly, q >> 4, q & 15);
}
constexpr int PREP_CHUNK = 8, PREP_NJOBS = 3 * 1040;
DI void prep_experts(const Frame& F0, int ly, int cw, int j_lo, int j_hi) {
    const Frame F = relaunder(F0);
    volatile LAS unsigned* MISC = (volatile LAS unsigned*)(F.lds + LDS_MISC);
    for (;;) {
        __syncthreads();
        if (F.tid == 0) MISC[17] = atomicAdd(F.ctl + cw + 64 * ly, (unsigned)PREP_CHUNK);
        __syncthreads();
        const int base = j_lo + (int)MISC[17];
        if (base >= j_hi) break;
        const int end = base + PREP_CHUNK < j_hi ? base + PREP_CHUNK : j_hi;
        int j = base;
        PrepJob cur = prep_job(F, ly, 208 + j); f32x4 va[8]; prep_load(F, cur, va);
#pragma unroll 1
        for (;;) {
            const int jn = j + 1; const bool more = jn < end;
            PrepJob nxt = cur; f32x4 vb[8];
            if (more) { nxt = prep_job(F, ly, 208 + jn); prep_load(F, nxt, vb); }
            prep_store(F, cur, va);
            if (!more) break;
            cur = nxt; j = jn;
#pragma unroll
            for (int i = 0; i < 8; ++i) va[i] = vb[i];
        }
    }
}

DI void prep_mod(const Frame& F) {
    LAS float* S = (LAS float*)F.lds;
    LAS float* RED = S + 5 * 1024;
    const int t = F.tid;
    bool have_s = false;
    for (int u = F.bid; u < DEPTH * 96; u += F.G) {
        const int ly = u / 96, cg = u % 96;
        if (!have_s) {
            for (int i = t; i < 5 * 1024; i += NTHR) { const int r = i >> 10, k = i & 1023; const float x = r < 4 ? F.in[1][r * DM + k] : F.in[3][k]; S[i] = x / (1.f + expf(-x)); }
            __syncthreads(); have_s = true;
        }
        const int tq = t & 15, tk = t >> 4;
        const float* w = F.in[4] + (size_t)ly * DM * 6144 + cg * 64 + tq * 4;
        f32x4 acc[5];
#pragma unroll
        for (int r = 0; r < 5; ++r) acc[r] = (f32x4){0.f, 0.f, 0.f, 0.f};
#pragma unroll 1
        for (int k8 = 0; k8 < 32; k8 += 8) { f32x4 wv[8];
#pragma unroll
            for (int q = 0; q < 8; ++q) wv[q] = *(const f32x4*)(w + (size_t)(tk * 32 + k8 + q) * 6144);
#pragma unroll
            for (int q = 0; q < 8; ++q)
#pragma unroll
                for (int r = 0; r < 5; ++r) acc[r] += wv[q] * S[r * 1024 + tk * 32 + k8 + q]; }
#pragma unroll
        for (int r = 0; r < 5; ++r)
#pragma unroll
            for (int j = 0; j < 4; ++j) RED[(tk * 5 + r) * 64 + tq * 4 + j] = acc[r][j];
        __syncthreads();
        if (t < 320) { const int r = t >> 6, c = t & 63; float s = 0.f;
            for (int q = 0; q < 32; ++q) s += RED[(q * 5 + r) * 64 + c];
            const int col = cg * 64 + c;
            ((float*)(F.ws + WS_MOD))[((size_t)ly * 5 + r) * 6144 + col] = s + F.in[5][(size_t)ly * 6144 + col]; }
        __syncthreads();
    }
}

DI void prep_filters(const Frame& F) {
    LAS float* Z = (LAS float*)F.lds;
    LAS float* A1 = Z + 64 * 33;
    LAS float* A2 = A1 + 4096;
    const int t = F.tid;
    for (int u = F.G - 1 - F.bid; u < DEPTH * 68; u += F.G) {
        const int ly = u / 68, ch = u % 68; const bool lat = ch < 64; const int Lx = lat ? SEQ : CTXL, t0 = lat ? ch * 64 : (ch - 64) * 64;
        for (int i = t; i < 64 * 33; i += NTHR) { const int tt = i / 33, f = i % 33; const int ti = t0 + tt;
            float v;
            if (f == 0) v = (float)ti / (float)(Lx - 1);
            else { const int j = (f - 1) & 15; const float fb = 1e-4f + (float)j * ((15.0f - 1e-4f) / 15.0f); const float om = (6.283185307179586f / (float)Lx) * (float)ti;
                   v = f <= 16 ? cosf(fb * om) : -sinf(fb * om); }
            Z[i] = v; }
        __syncthreads();
        const float* w1 = F.in[9] + (size_t)ly * 33 * 64; const float* b1 = F.in[10] + ly * 64; const float* w2 = F.in[11] + (size_t)ly * 4096; const float* b2 = F.in[12] + ly * 64;
        const float* w3 = F.in[13] + (size_t)ly * 64 * 1024; const float* fq = F.in[14] + ly * 64;
        for (int i = t; i < 4096; i += NTHR) { const int tt = i >> 6, h = i & 63; float s = b1[h];
            for (int f = 0; f < 33; ++f) s += Z[tt * 33 + f] * w1[f * 64 + h];
            A1[i] = sinf(fq[h] * s); }
        __syncthreads();
        for (int i = t; i < 4096; i += NTHR) { const int tt = i >> 6, h = i & 63; float s = b2[h];
            for (int j = 0; j < 64; ++j) s += A1[tt * 64 + j] * w2[j * 64 + h];
            A2[i] = sinf(fq[h] * s); }
        __syncthreads();
        for (int cc = 0; cc < 2; ++cc) { const int col = t + cc * 512;
            float wr[64];
#pragma unroll
            for (int j = 0; j < 64; ++j) wr[j] = w3[j * 1024 + col];
            const int n = col >> 9, dir = (col >> 8) & 1, c = col & 255;
            const float delta = fabsf(-3.0701134573253946f + (float)c * ((-15.350567286626973f + 3.0701134573253946f) / 255.0f));
            float* dst = lat ? (float*)(F.ws + WS_HCL) + ((((size_t)ly * 2 + n) * 2 + dir) * 256 + c) * SEQ + t0
                             : (float*)(F.ws + WS_HCC) + ((((size_t)ly * 2 + n) * 2 + dir) * 256 + c) * CTXL + t0;
            for (int tt = 0; tt < 64; ++tt) { float s = 0.f;
#pragma unroll
                for (int j = 0; j < 64; ++j) s += A2[tt * 64 + j] * wr[j];
                const float tv = (float)(t0 + tt) / (float)(Lx - 1);
                dst[tt] = s * expf(-tv * delta); } }
        __syncthreads();
    }
}

DI void prep_tables(const Frame& F) {
    LAS float* CT = (LAS float*)F.lds;
    const int t = F.tid;
    for (int i = t; i < 4096; i += NTHR) CT[i] = cospif((float)i / 2048.0f);
    __syncthreads();
    bf16_t* DC = (bf16_t*)(F.ws + WS_DFTC);
    for (int i = F.bid * NTHR + t; i < CTXL * 512; i += F.G * NTHR) { const int k = i >> 9, cl = i & 511, comp = cl >> 8, l = cl & 255;
        const int idx = ((k * l) & 255) * 16; DC[i] = f2bf((comp ? CT[(idx - 1024) & 4095] : CT[idx]) * (1.0f / 128.0f)); }
    if (F.bid == (F.G > 1 ? 1 : 0) && t < DEPTH) { const int ly = t; const float lam_init = 0.8f - 0.6f * expf(-0.3f * (float)ly); float s1 = 0.f, s2 = 0.f;
        for (int i = 0; i < 32; ++i) { s1 += F.in[16][ly * 32 + i] * F.in[17][ly * 32 + i]; s2 += F.in[18][ly * 32 + i] * F.in[19][ly * 32 + i]; }
        ((float*)(F.ws + WS_LAM))[2 * ly] = expf(s1) - expf(s2) + lam_init; ((float*)(F.ws + WS_LAM))[2 * ly + 1] = lam_init; }
    if (F.bid == 0) { float* RT = (float*)(F.ws + WS_ROPE);
        for (int i = t; i < 512; i += NTHR) { const int p = i >> 3, n = i & 7; const float inv = powf(10000.0f, -(float)n / 8.0f); float s, c; sincosf((float)p * inv, &s, &c); RT[i * 2] = c; RT[i * 2 + 1] = s; } }
    __syncthreads();
}

DI void prep_copy_x(const Frame& F) {
    f32x4* X = (f32x4*)(F.ws + WS_X);
    const f32x4* x = (const f32x4*)F.in[0]; const f32x4* cx = (const f32x4*)F.in[2];
    const size_t n1 = (size_t)RLAT * DM / 4, n2 = (size_t)RCTX * DM / 4;
    for (size_t i = (size_t)F.bid * NTHR + F.tid; i < n1 + n2; i += (size_t)F.G * NTHR) X[i] = i < n1 ? x[i] : cx[i - n1];
}

DI void prep_invl1(const Frame& F) {
    const int gw = F.bid * 8 + F.wave, nw = F.G * 8;
    for (int j = gw; j < DEPTH * 2 * 2 * 256; j += nw) {
        const int ly = j >> 10, lt = (j >> 9) & 1, n = (j >> 8) & 1, c = j & 255;
        const int Lx = lt ? CTXL : SEQ;
        const float* base = lt ? (const float*)(F.ws + WS_HCC) : (const float*)(F.ws + WS_HCL);
        const float* f0 = base + ((((size_t)ly * 2 + n) * 2 + 0) * 256 + c) * Lx;
        const float* f1 = base + ((((size_t)ly * 2 + n) * 2 + 1) * 256 + c) * Lx;
        float s = 0.f;
        for (int i = F.lane; i < Lx; i += 64) { s += fabsf(f0[i]); if (i >= 1) s += fabsf(f1[i]); }
        s = wave_sum(s);
        if (F.lane == 0) ((float*)(F.ws + WS_INVL1))[j] = 1.0f / s;
    }
}

DI void ln_stats(const f32x4 (&v)[4], float& mu, float& rstd) {
    float s = 0.f;
#pragma unroll
    for (int j = 0; j < 4; ++j) s += (v[j][0] + v[j][1]) + (v[j][2] + v[j][3]);
    mu = wave_sum(s) * (1.0f / DM);
    float q = 0.f;
#pragma unroll
    for (int j = 0; j < 4; ++j)
#pragma unroll
        for (int e = 0; e < 4; ++e) { const float d = v[j][e] - mu; q += d * d; }
    rstd = rsqrtf(wave_sum(q) * (1.0f / DM) + LN_EPS);
}
DI void ln_mod_store(const f32x4 (&v)[4], const float* sh, const float* sc, bf16_t* hrow, int lane) {
    float mu, rstd; ln_stats(v, mu, rstd);
#pragma unroll
    for (int j = 0; j < 4; ++j) { const int c = 4 * lane + 256 * j; const f32x4 a = *(const f32x4*)(sh + c), b = *(const f32x4*)(sc + c);
        float o[4];
#pragma unroll
        for (int e = 0; e < 4; ++e) o[e] = (v[j][e] - mu) * rstd * (1.f + b[e]) + a[e];
        u32x2 w; w.x = cvt_pk_bf16(o[0], o[1]); w.y = cvt_pk_bf16(o[2], o[3]); *(u32x2*)(hrow + c) = w; }
}

DI void phase_init_h(const Frame& F) {
    const int gw = F.bid * 8 + F.wave, nw = F.G * 8;
    const float* MOD = (const float*)(F.ws + WS_MOD);
    for (int row = gw; row < RTOT; row += nw) {
        const float* xr = row < RLAT ? F.in[0] + (size_t)row * DM : F.in[2] + (size_t)(row - RLAT) * DM;
        f32x4 v[4];
#pragma unroll
        for (int j = 0; j < 4; ++j) v[j] = *(const f32x4*)(xr + 4 * F.lane + 256 * j);
        const float* m = MOD + (size_t)(0 * 5 + row_modsel(row)) * 6144;
        ln_mod_store(v, m, m + 1024, (bf16_t*)(F.ws + WS_H) + (size_t)row * DM, F.lane);
    }
}

struct EpiWin {
    static constexpr bool PERM = true;
    unsigned char* ws; int ly;
    DI void operator()(const f32x4 (&acc)[2][2][4][2], const pg8::Unit& u, int wr, int wc, int fr, int fq) const {
        const bool lat = u.pm < 64; const int b = lat ? (u.pm >> 4) : (u.pm - 64); const int pos0 = lat ? ((u.pm & 15) << 8) : SEQ;
        const int pn = u.pn;
        const float* RT = (const float*)(ws + WS_ROPE);
        float kn[2] = {0.f, 0.f};
#pragma unroll
        for (int ai = 0; ai < 2; ++ai)
#pragma unroll
            for (int m = 0; m < 4; ++m) {
                const int pos = pos0 + ai * 128 + wr * 64 + m * 16 + fr;
#pragma unroll
                for (int bj = 0; bj < 2; ++bj) {
                    const int col = pn * 256 + bj * 128 + wc * 32 + fq * 8;
                    float v[8];
#pragma unroll
                    for (int e = 0; e < 4; ++e) { v[e] = acc[ai][bj][m][0][e]; v[4 + e] = acc[ai][bj][m][1][e]; }
                    if (pn < 3) {
                        float* d = (float*)(ws + WS_HYT) + ((size_t)b * 768 + col) * POS + pos;
#pragma unroll
                        for (int e = 0; e < 8; ++e) d[(size_t)e * POS] = v[e];
                    } else if (pn < 7) {
                        const bool isq = pn < 5; const int cq = col - (isq ? 768 : 1280); const int head = cq >> 6, cc = cq & 63;
                        if (lat) { const int axis = (cc >> 4) & 1, n0 = (cc & 15) >> 1; const int pa = axis ? (pos & 63) : (pos >> 6);
                            const float* rt = RT + (pa * 8 + n0) * 2;
#pragma unroll
                            for (int p = 0; p < 4; ++p) { const float cs = rt[2 * p], sn = rt[2 * p + 1]; const float a = v[2 * p], bb = v[2 * p + 1];
                                v[2 * p] = a * cs - bb * sn; v[2 * p + 1] = a * sn + bb * cs; } }
                        if (isq) {
#pragma unroll
                            for (int e = 0; e < 8; ++e) v[e] *= QSCALE; }
                        u32x4 w; w.x = cvt_pk_bf16(v[0], v[1]); w.y = cvt_pk_bf16(v[2], v[3]); w.z = cvt_pk_bf16(v[4], v[5]); w.w = cvt_pk_bf16(v[6], v[7]);
                        bf16_t* d = (bf16_t*)(ws + (isq ? WS_Q : WS_K)) + (((size_t)b * 8 + head) * POS + pos) * 64 + cc;
                        *(u32x4*)d = w;
                        if (!isq) {
                            float s2 = bflo(w.x) * bflo(w.x) + bfhi(w.x) * bfhi(w.x) + bflo(w.y) * bflo(w.y) + bfhi(w.y) * bfhi(w.y) + bflo(w.z) * bflo(w.z) + bfhi(w.z) * bfhi(w.z) + bflo(w.w) * bflo(w.w) + bfhi(w.w) * bfhi(w.w);
                            s2 += __shfl_xor(s2, 16); s2 += __shfl_xor(s2, 32);
                            kn[bj] = fmaxf(kn[bj], s2); }
                    } else if (pn < 9) {
                        const int cv = col - 1792; const int head = cv >> 6, cc = cv & 63;
                        u32x4 w; w.x = cvt_pk_bf16(v[0], v[1]); w.y = cvt_pk_bf16(v[2], v[3]); w.z = cvt_pk_bf16(v[4], v[5]); w.w = cvt_pk_bf16(v[6], v[7]);
                        *(u32x4*)((bf16_t*)(ws + WS_V) + (((size_t)b * 8 + head) * POS + pos) * 64 + cc) = w;
                    } else {
                        const int cy = col - 2304; const int comp = cy >> 8, gd = cy & 255;
                        if (lat) { bf16_t* d = (bf16_t*)(ws + WS_YTL) + ((size_t)b * 256 + gd) * 8192 + comp * 4096 + pos;
#pragma unroll
                            for (int e = 0; e < 8; ++e) d[(size_t)e * 8192] = f2bf(v[e]);
                        } else { bf16_t* d = (bf16_t*)(ws + WS_YTC) + ((size_t)b * 256 + gd) * 512 + comp * 256 + (pos - SEQ);
#pragma unroll
                            for (int e = 0; e < 8; ++e) d[(size_t)e * 512] = f2bf(v[e]); }
                    }
                }
            }
        if (pn == 5 || pn == 6) {
#pragma unroll
            for (int bj = 0; bj < 2; ++bj) { float m = kn[bj];
                m = fmaxf(m, __shfl_xor(m, 1)); m = fmaxf(m, __shfl_xor(m, 2)); m = fmaxf(m, __shfl_xor(m, 4)); m = fmaxf(m, __shfl_xor(m, 8));
                const int cq = pn * 256 + bj * 128 + wc * 32 - 1280; const int head = cq >> 6, comp = (cq >> 5) & 1;
                if (fr == 0 && fq == 0) atomicMax((unsigned*)(ws + WS_CTL) + CW_KMAX + 64 * ly + (b * 8 + head) * 2 + comp, __float_as_uint(m)); }
        }
    }
};

struct EpiFnet {
    static constexpr bool PERM = true;
    unsigned char* ws; int ctx;
    DI void operator()(const f32x4 (&acc)[2][2][4][2], const pg8::Unit& u, int wr, int wc, int fr, int fq) const {
        const int b = u.pn;
#pragma unroll
        for (int ai = 0; ai < 2; ++ai)
#pragma unroll
            for (int m = 0; m < 4; ++m) {
                const int k = u.pm * 256 + ai * 128 + wr * 64 + m * 16 + fr;
                const size_t row = ctx ? (size_t)(RLAT + b * CTXL + k) : (size_t)(b * SEQ + k);
#pragma unroll
                for (int bj = 0; bj < 2; ++bj) { const int gd = bj * 128 + wc * 32 + fq * 8;
                    const f32x4 v0 = acc[ai][bj][m][0], v1 = acc[ai][bj][m][1];
                    u32x4 w; w.x = cvt_pk_bf16(v0[0], v0[1]); w.y = cvt_pk_bf16(v0[2], v0[3]); w.z = cvt_pk_bf16(v1[0], v1[1]); w.w = cvt_pk_bf16(v1[2], v1[3]);
                    *(u32x4*)((bf16_t*)(ws + WS_MIX) + row * DM + 768 + gd) = w; }
            }
    }
};

struct EpiWout {
    static constexpr bool PERM = false;
    unsigned char* ws; int ly; const float* xlat; const float* xctx;
    DI void operator()(const f32x4 (&acc)[2][2][4][2], const pg8::Unit& u, int wr, int wc, int fr, int fq) const {
        const int msel = u.pm < 64 ? (u.pm >> 4) : 4;
        const float* g1 = (const float*)(ws + WS_MOD) + ((size_t)ly * 5 + msel) * 6144 + 2048;
        const int col0 = u.pn * 256 + wc * 32 + 4 * fq;
        const float* src = ly == 0 ? (u.pm < 64 ? xlat + (size_t)u.pm * 256 * DM : xctx + (size_t)(u.pm - 64) * 256 * DM) : (const float*)(ws + WS_X) + (size_t)u.pm * 256 * DM;
        f32x4 gv[2][2];
#pragma unroll
        for (int bj = 0; bj < 2; ++bj)
#pragma unroll
            for (int n = 0; n < 2; ++n) gv[bj][n] = *(const f32x4*)(g1 + col0 + bj * 128 + n * 16);
#pragma unroll
        for (int ai = 0; ai < 2; ++ai)
#pragma unroll
            for (int m = 0; m < 4; ++m) { const size_t ro = (size_t)(ai * 128 + wr * 64 + m * 16 + fr) * DM + col0;
                float* rowp = (float*)(ws + WS_X) + (size_t)u.pm * 256 * DM + ro;
#pragma unroll
                for (int bj = 0; bj < 2; ++bj)
#pragma unroll
                    for (int n = 0; n < 2; ++n) { const f32x4 xin = *(const f32x4*)(src + ro + bj * 128 + n * 16); *(f32x4*)(rowp + bj * 128 + n * 16) = xin * ALPHA + gv[bj][n] * acc[ai][bj][m][n]; } }
    }
};

struct MoeTab { LAS int* cnt; LAS int* tstart; LAS int* tile_e; int ntiles; };
DI MoeTab moe_tables(const Frame& F, int ly) {
    MoeTab T; T.cnt = (LAS int*)(F.lds + LDS_TAB); T.tstart = T.cnt + 72; T.tile_e = T.tstart + 72;
    __syncthreads();
    if (F.tid < 65) T.cnt[F.tid] = F.tid < NEXP ? (int)__hip_atomic_load(F.ctl + CW_CNT + (ly * 64 + F.tid) * CNT_STRIDE, __ATOMIC_RELAXED, __HIP_MEMORY_SCOPE_AGENT) : RTOT;
    __syncthreads();
    if (F.tid == 0) { int s = 0; for (int e = 0; e < 65; ++e) { T.tstart[e] = s; s += (T.cnt[e] + 255) >> 8; } T.tstart[65] = s; }
    __syncthreads();
    const int nt = T.tstart[65];
    for (int e = F.tid; e < 65; e += NTHR) for (int q = T.tstart[e]; q < T.tstart[e + 1]; ++q) if (q < MAXTILES) T.tile_e[q] = e;
    __syncthreads();
    T.ntiles = __builtin_amdgcn_readfirstlane(nt < MAXTILES ? nt : MAXTILES);
    return T;
}
template <bool GATHER_> struct MoeSched {
    static constexpr bool GATHER = GATHER_;
    MoeTab T; const int* list; int G, c, nsub, shift;
    DI bool next(int i, pg8::Unit& u) const {
        const int L = i * G + c; if (L >= T.ntiles * nsub) return false;
        const int tile = L >> shift, j = L & (nsub - 1); const int e = __builtin_amdgcn_readfirstlane(T.tile_e[tile]);
        u.pm = tile; u.pn = e * nsub + j; u.e = e; u.lt = tile - __builtin_amdgcn_readfirstlane(T.tstart[e]); return true;
    }
    DI int arow(const pg8::Unit& u, int r) const {
        if (!GATHER_) return u.pm * 256 + r;
        const int idx = u.lt * 256 + r;
        if (u.e == NEXP) return idx;
        return idx < T.cnt[u.e] ? (list[(size_t)u.e * RTOT + idx] >> 3) : 0;
    }
};
DI float silu_f(float x) { return x / (1.f + __expf(-x)); }
struct EpiMoe1 {
    static constexpr bool PERM = true;
    unsigned char* ws;
    DI void operator()(const f32x4 (&acc)[2][2][4][2], const pg8::Unit& u, int wr, int wc, int fr, int fq) const {
        const int hid = (u.pn & 1) * 128 + wc * 32 + fq * 8;
#pragma unroll
        for (int ai = 0; ai < 2; ++ai)
#pragma unroll
            for (int m = 0; m < 4; ++m) { const size_t row = (size_t)u.pm * 256 + ai * 128 + wr * 64 + m * 16 + fr;
                float o[8];
#pragma unroll
                for (int n = 0; n < 2; ++n)
#pragma unroll
                    for (int e = 0; e < 4; ++e) o[n * 4 + e] = silu_f(acc[ai][0][m][n][e]) * acc[ai][1][m][n][e];
                u32x4 w; w.x = cvt_pk_bf16(o[0], o[1]); w.y = cvt_pk_bf16(o[2], o[3]); w.z = cvt_pk_bf16(o[4], o[5]); w.w = cvt_pk_bf16(o[6], o[7]);
                *(u32x4*)((bf16_t*)(ws + WS_ACT) + row * DEXP + hid) = w; }
    }
};
struct EpiMoe2 {
    static constexpr bool PERM = true;
    unsigned char* ws;
    DI void operator()(const f32x4 (&acc)[2][2][4][2], const pg8::Unit& u, int wr, int wc, int fr, int fq) const {
        const int colb = (u.pn & 3) * 256 + wc * 32 + fq * 8;
#pragma unroll
        for (int ai = 0; ai < 2; ++ai)
#pragma unroll
            for (int m = 0; m < 4; ++m) { const size_t row = (size_t)u.pm * 256 + ai * 128 + wr * 64 + m * 16 + fr;
#pragma unroll
                for (int bj = 0; bj < 2; ++bj) { const f32x4 v0 = acc[ai][bj][m][0], v1 = acc[ai][bj][m][1];
                    u32x4 w; w.x = cvt_pk_bf16(v0[0], v0[1]); w.y = cvt_pk_bf16(v0[2], v0[3]); w.z = cvt_pk_bf16(v1[0], v1[1]); w.w = cvt_pk_bf16(v1[2], v1[3]);
                    *(u32x4*)((bf16_t*)(ws + WS_YB) + row * DM + colb + bj * 128) = w; } }
    }
};

DI float hy_short(const float* hy, int l, int Lx, float w0, float w1, float w2) {
    const float a = l > 0 ? hy[l - 1] : 0.f, b = hy[l], c = l + 1 < Lx ? hy[l + 1] : 0.f;
    return w0 * a + w1 * b + w2 * c;
}
#if 0
DI void hyena_unit(const Frame& F, int ly, int c) {
    LAS float* KF = (LAS float*)F.lds;
    LAS float* U = KF + 16384;
    const int t = F.tid;
    const float* HYT = (const float*)(F.ws + WS_HYT);
    const float* scw = F.in[8] + (size_t)ly * 3 * 768;
    const float* invl = (const float*)(F.ws + WS_INVL1) + (size_t)ly * 1024;
    const float bias0 = F.in[15][(size_t)ly * 512 + c], bias1 = F.in[15][(size_t)ly * 512 + 256 + c];
    float wx1[3], wx2[3], wv[3];
#pragma unroll
    for (int j = 0; j < 3; ++j) { wx1[j] = scw[j * 768 + c]; wx2[j] = scw[j * 768 + 256 + c]; wv[j] = scw[j * 768 + 512 + c]; }
    bf16_t* MIX = (bf16_t*)(F.ws + WS_MIX);
    {
        for (int n = 0; n < 2; ++n) { const float inv = invl[(0 * 2 + n) * 256 + c];
            const float* hf = (const float*)(F.ws + WS_HCL) + ((((size_t)ly * 2 + n) * 2 + 0) * 256 + c) * SEQ;
            const float* hb = (const float*)(F.ws + WS_HCL) + ((((size_t)ly * 2 + n) * 2 + 1) * 256 + c) * SEQ;
            for (int i = t; i < 8192; i += NTHR) { const int d = i - 4096; KF[n * 8192 + i] = d >= 0 ? hf[d] * inv : (d > -4096 ? hb[-d] * inv : 0.f); } }
        for (int i = t; i < 4 * SEQ; i += NTHR) { const int b = i >> 12, l = i & 4095;
            U[l * 4 + b] = hy_short(HYT + ((size_t)b * 768 + 512 + c) * POS, l, SEQ, wv[0], wv[1], wv[2]); }
        __syncthreads();
        const int t0 = t * 8;
        for (int n = 0; n < 2; ++n) {
            f32x4 acc[8];
#pragma unroll
            for (int j = 0; j < 8; ++j) acc[j] = (f32x4){0.f, 0.f, 0.f, 0.f};
            const LAS float* kf = KF + n * 8192;
#pragma unroll 1
            for (int s0 = 0; s0 < SEQ; s0 += 8) {
                const int base = t0 - s0 + 4088;
                float kw[16];
#pragma unroll
                for (int q = 0; q < 4; ++q) { const f32x4 x = *(const LAS f32x4*)(kf + base + 4 * q); kw[4 * q] = x[0]; kw[4 * q + 1] = x[1]; kw[4 * q + 2] = x[2]; kw[4 * q + 3] = x[3]; }
#pragma unroll
                for (int i = 0; i < 8; ++i) { const f32x4 uv = *(const LAS f32x4*)(U + (s0 + i) * 4);
#pragma unroll
                    for (int j = 0; j < 8; ++j) acc[j] += uv * kw[8 + j - i]; }
            }
            float zo[8][4];
            const int xch = n == 0 ? c : 256 + c; const float* wg = n == 0 ? wx1 : wx2; const float bias = n == 0 ? bias0 : bias1;
#pragma unroll
            for (int b = 0; b < 4; ++b) {
                const float* hp = HYT + ((size_t)b * 768 + xch) * POS;
                const f32x4 h0 = *(const f32x4*)(hp + t0), h1 = *(const f32x4*)(hp + t0 + 4);
                const float hm = t0 > 0 ? hp[t0 - 1] : 0.f, hn = t0 + 8 < SEQ ? hp[t0 + 8] : 0.f;
                const float hv[10] = {hm, h0[0], h0[1], h0[2], h0[3], h1[0], h1[1], h1[2], h1[3], hn};
#pragma unroll
                for (int j = 0; j < 8; ++j) { const float g = wg[0] * hv[j] + wg[1] * hv[j + 1] + wg[2] * hv[j + 2];
                    zo[j][b] = g * (acc[j][b] + bias * U[(t0 + j) * 4 + b]); }
            }
            __syncthreads();
            if (n == 0) {
#pragma unroll
                for (int j = 0; j < 8; ++j) *(LAS f32x4*)(U + (t0 + j) * 4) = (f32x4){zo[j][0], zo[j][1], zo[j][2], zo[j][3]};
                __syncthreads();
            } else {
#pragma unroll
                for (int j = 0; j < 8; ++j)
#pragma unroll
                    for (int b = 0; b < 4; ++b) MIX[((size_t)b * SEQ + t0 + j) * DM + c] = f2bf(zo[j][b]);
            }
        }
    }
    __syncthreads();
}
#endif
DI void hyena_ctx_unit(const Frame& F, int ly, int c) {
    LAS float* KF = (LAS float*)F.lds;
    LAS float* U = KF + 16384;
    const int t = F.tid;
    const float* HYT = (const float*)(F.ws + WS_HYT);
    const float* scw = F.in[8] + (size_t)ly * 3 * 768;
    const float* invl = (const float*)(F.ws + WS_INVL1) + (size_t)ly * 1024;
    const float bias0 = F.in[15][(size_t)ly * 512 + c], bias1 = F.in[15][(size_t)ly * 512 + 256 + c];
    float wx1[3], wx2[3], wv[3];
#pragma unroll
    for (int j = 0; j < 3; ++j) { wx1[j] = scw[j * 768 + c]; wx2[j] = scw[j * 768 + 256 + c]; wv[j] = scw[j * 768 + 512 + c]; }
    bf16_t* MIX = (bf16_t*)(F.ws + WS_MIX);
    {
        LAS float* KC = (LAS float*)F.lds;
        LAS float* UC = KC + 1024;
        for (int n = 0; n < 2; ++n) { const float inv = invl[(1 * 2 + n) * 256 + c];
            const float* hf = (const float*)(F.ws + WS_HCC) + ((((size_t)ly * 2 + n) * 2 + 0) * 256 + c) * CTXL;
            const float* hb = (const float*)(F.ws + WS_HCC) + ((((size_t)ly * 2 + n) * 2 + 1) * 256 + c) * CTXL;
            for (int i = t; i < 512; i += NTHR) { const int d = i - 256; KC[n * 512 + i] = d >= 0 ? hf[d] * inv : (d > -256 ? hb[-d] * inv : 0.f); } }
        for (int i = t; i < 4 * CTXL; i += NTHR) { const int b = i >> 8, l = i & 255;
            UC[l * 4 + b] = hy_short(HYT + ((size_t)b * 768 + 512 + c) * POS + SEQ, l, CTXL, wv[0], wv[1], wv[2]); }
        __syncthreads();
        const int tt = t & 255, bp = t >> 8;
        for (int n = 0; n < 2; ++n) {
            float a0 = 0.f, a1 = 0.f;
            for (int s = 0; s < CTXL; ++s) { const float k = KC[n * 512 + tt - s + 256]; a0 += k * UC[s * 4 + 2 * bp]; a1 += k * UC[s * 4 + 2 * bp + 1]; }
            const int xch = n == 0 ? c : 256 + c; const float* wg = n == 0 ? wx1 : wx2; const float bias = n == 0 ? bias0 : bias1;
            const float g0 = hy_short(HYT + ((size_t)(2 * bp) * 768 + xch) * POS + SEQ, tt, CTXL, wg[0], wg[1], wg[2]);
            const float g1 = hy_short(HYT + ((size_t)(2 * bp + 1) * 768 + xch) * POS + SEQ, tt, CTXL, wg[0], wg[1], wg[2]);
            const float z0 = g0 * (a0 + bias * UC[tt * 4 + 2 * bp]), z1 = g1 * (a1 + bias * UC[tt * 4 + 2 * bp + 1]);
            __syncthreads();
            if (n == 0) { UC[tt * 4 + 2 * bp] = z0; UC[tt * 4 + 2 * bp + 1] = z1; __syncthreads(); }
            else { MIX[((size_t)RLAT + (2 * bp) * CTXL + tt) * DM + c] = f2bf(z0); MIX[((size_t)RLAT + (2 * bp + 1) * CTXL + tt) * DM + c] = f2bf(z1); }
        }
    }
    __syncthreads();
}


DI unsigned cx_addr(unsigned e) { return e * 8u + (e >> 5) * 16u; }
constexpr int cx_bytes(int n) { return n * 8 + (n / 32) * 16; }
typedef float f32x2 __attribute__((ext_vector_type(2)));
template <int R> DI constexpr int brev(int q) { int r = 0; for (int i = 1, j = R >> 1; i < R; i <<= 1, j >>= 1) if (q & i) r |= j; return r; }
template <int R, bool INV> DI void dft_inreg(float (&re)[R], float (&im)[R]) {
#pragma unroll
    for (int len = R; len >= 2; len >>= 1) { const int half = len >> 1;
#pragma unroll
        for (int base = 0; base < R; base += len)
#pragma unroll
            for (int j = 0; j < half; ++j) {
                const float ar = re[base + j], ai = im[base + j], br = re[base + j + half], bi = im[base + j + half];
                re[base + j] = ar + br; im[base + j] = ai + bi;
                const float dr = ar - br, di = ai - bi;
                if (j == 0) { re[base + j + half] = dr; im[base + j + half] = di; }
                else if (4 * j == len) { if (INV) { re[base + j + half] = -di; im[base + j + half] = dr; } else { re[base + j + half] = di; im[base + j + half] = -dr; } }
                else { const float c = __builtin_cosf(6.283185307179586f * (float)j / (float)len), sn = (INV ? 1.f : -1.f) * __builtin_sinf(6.283185307179586f * (float)j / (float)len);
                    re[base + j + half] = dr * c - di * sn; im[base + j + half] = dr * sn + di * c; }
            }
    }
}
template <int R, bool INV, int S> DI void fft_bfly(LAS unsigned char* seq, int j) {
    constexpr int Lcur = R * S;
    int jj = j; asm volatile("" : "+v"(jj));
    const int blk = jj / S, o = jj % S;
    LAS unsigned char* p = seq + cx_addr((unsigned)(blk * Lcur + o));
#define FFT_OFF(r) ((r) * S * 8 + ((((r) * S) >> 5) * 16))
    float re[R], im[R];
    if (S == 1) {
#pragma unroll
        for (int r = 0; r < R; r += 2) { const f32x4 v = *(const LAS f32x4*)(p + FFT_OFF(r)); re[r] = v[0]; im[r] = v[1]; re[r + 1] = v[2]; im[r + 1] = v[3]; }
    } else {
#pragma unroll
        for (int r = 0; r < R; ++r) { const f32x2 v = *(const LAS f32x2*)(p + FFT_OFF(r)); re[r] = v[0]; im[r] = v[1]; }
    }
    if (S == 1) {
        dft_inreg<R, INV>(re, im);
    } else {
        const float fr = (float)o * (1.0f / (float)Lcur);
        float wr[R], wi[R];
        wr[1] = __builtin_amdgcn_cosf(fr); wi[1] = INV ? __builtin_amdgcn_sinf(fr) : -__builtin_amdgcn_sinf(fr);
#pragma unroll
        for (int q = 2; q < R; ++q) { const int a = (q & (q - 1)) ? (q & -q) : (q >> 1), bq = q - a;
            wr[q] = wr[a] * wr[bq] - wi[a] * wi[bq]; wi[q] = wr[a] * wi[bq] + wi[a] * wr[bq]; }
        if (!INV) {
            dft_inreg<R, false>(re, im);
#pragma unroll
            for (int q = 1; q < R; ++q) { const int k = brev<R>(q); const float xr = re[k], xi = im[k]; re[k] = xr * wr[q] - xi * wi[q]; im[k] = xr * wi[q] + xi * wr[q]; }
        } else {
#pragma unroll
            for (int q = 1; q < R; ++q) { const float xr = re[q], xi = im[q]; re[q] = xr * wr[q] - xi * wi[q]; im[q] = xr * wi[q] + xi * wr[q]; }
            dft_inreg<R, true>(re, im);
        }
    }
    if (S == 1) {
#pragma unroll
        for (int r = 0; r < R; r += 2) { const int k0 = brev<R>(r), k1 = brev<R>(r + 1); *(LAS f32x4*)(p + FFT_OFF(r)) = (f32x4){re[k0], im[k0], re[k1], im[k1]}; }
    } else {
#pragma unroll
        for (int r = 0; r < R; ++r) { const int k = brev<R>(r); *(LAS f32x2*)(p + FFT_OFF(r)) = (f32x2){re[k], im[k]}; }
    }
#undef FFT_OFF
}
template <bool INV> DI void fft8192x2(LAS unsigned char* lds, int tid) {
    constexpr int SB = cx_bytes(8192);
    if (!INV) {
        fft_bfly<16, false, 512>(lds, tid); __builtin_amdgcn_sched_barrier(0); fft_bfly<16, false, 512>(lds + SB, tid); __syncthreads();
        fft_bfly<16, false, 32>(lds, tid); __builtin_amdgcn_sched_barrier(0); fft_bfly<16, false, 32>(lds + SB, tid); __syncthreads();
        fft_bfly<32, false, 1>(lds + (tid >> 8) * SB, tid & 255); __syncthreads();
    } else {
        fft_bfly<32, true, 1>(lds + (tid >> 8) * SB, tid & 255); __syncthreads();
        fft_bfly<16, true, 32>(lds, tid); __builtin_amdgcn_sched_barrier(0); fft_bfly<16, true, 32>(lds + SB, tid); __syncthreads();
        fft_bfly<16, true, 512>(lds, tid); __builtin_amdgcn_sched_barrier(0); fft_bfly<16, true, 512>(lds + SB, tid); __syncthreads();
    }
}
DI void fft4096x4(LAS unsigned char* lds, int tid) {
    constexpr int SB = cx_bytes(4096);
    const int sq = tid >> 8, j = tid & 255;
    fft_bfly<16, false, 256>(lds + sq * SB, j); __builtin_amdgcn_sched_barrier(0); fft_bfly<16, false, 256>(lds + (sq + 2) * SB, j); __syncthreads();
    fft_bfly<16, false, 16>(lds + sq * SB, j); __builtin_amdgcn_sched_barrier(0); fft_bfly<16, false, 16>(lds + (sq + 2) * SB, j); __syncthreads();
    fft_bfly<16, false, 1>(lds + sq * SB, j); __builtin_amdgcn_sched_barrier(0); fft_bfly<16, false, 1>(lds + (sq + 2) * SB, j); __syncthreads();
}

DI void hy_short8(const float* hp, int l0, float w0, float w1, float w2, float (&out)[8]) {
    const f32x4 h0 = *(const f32x4*)(hp + l0), h1 = *(const f32x4*)(hp + l0 + 4);
    const float hm = l0 > 0 ? hp[l0 - 1] : 0.f, hn = l0 + 8 < SEQ ? hp[l0 + 8] : 0.f;
    const float hv[10] = {hm, h0[0], h0[1], h0[2], h0[3], h1[0], h1[1], h1[2], h1[3], hn};
#pragma unroll
    for (int j = 0; j < 8; ++j) out[j] = w0 * hv[j] + w1 * hv[j + 1] + w2 * hv[j + 2];
}
DI void hyena_fft_unit(const Frame& F, int ly, int c) {
    LAS unsigned char* L = F.lds; constexpr int SB = cx_bytes(8192);
    const int t = F.tid;
    const unsigned pt = cx_addr((unsigned)t), pl = cx_addr((unsigned)t * 8u);
    const float* HYT = (const float*)(F.ws + WS_HYT);
    const float* scw = F.in[8] + (size_t)ly * 3 * 768;
    const float* invl = (const float*)(F.ws + WS_INVL1) + (size_t)ly * 1024;
    const float bias0 = F.in[15][(size_t)ly * 512 + c], bias1 = F.in[15][(size_t)ly * 512 + 256 + c];
    float wx1[3], wx2[3], wv[3];
#pragma unroll
    for (int j = 0; j < 3; ++j) { wx1[j] = scw[j * 768 + c]; wx2[j] = scw[j * 768 + 256 + c]; wv[j] = scw[j * 768 + 512 + c]; }
    f32x2* SPEC = (f32x2*)(F.ws + WS_SPEC) + (size_t)c * 2 * 8192;
#pragma unroll
    for (int n = 0; n < 2; ++n) { const float inv = invl[(0 * 2 + n) * 256 + c] * (1.0f / 8192.0f);
        const float* hf = (const float*)(F.ws + WS_HCL) + ((((size_t)ly * 2 + n) * 2 + 0) * 256 + c) * SEQ;
        const float* hb = (const float*)(F.ws + WS_HCL) + ((((size_t)ly * 2 + n) * 2 + 1) * 256 + c) * SEQ;
        float fv[16];
#pragma unroll
        for (int k = 0; k < 8; ++k) { fv[k] = hf[t + 512 * k]; const int i = SEQ + t + 512 * k; fv[8 + k] = i > SEQ ? hb[8192 - i] : 0.f; }
#pragma unroll
        for (int k = 0; k < 16; ++k) *(LAS f32x2*)(L + n * SB + (pt + 4352u * (unsigned)(k))) = (f32x2){fv[k] * inv, 0.f}; }
    __syncthreads();
    fft8192x2<false>(L, t);
#pragma unroll
    for (int n = 0; n < 2; ++n)
#pragma unroll
        for (int k = 0; k < 16; ++k) SPEC[n * 8192 + t + 512 * k] = *(const LAS f32x2*)(L + n * SB + (pt + 4352u * (unsigned)(k)));
    __syncthreads();
    const int l0 = t * 8;
#pragma unroll 1
    for (int sp = 0; sp < 2; ++sp) {
        float za[8], zb[8];
        hy_short8(HYT + ((size_t)(2 * sp) * 768 + 512 + c) * POS, l0, wv[0], wv[1], wv[2], za);
        hy_short8(HYT + ((size_t)(2 * sp + 1) * 768 + 512 + c) * POS, l0, wv[0], wv[1], wv[2], zb);
#pragma unroll
        for (int j = 0; j < 8; j += 2) {
            *(LAS f32x4*)(L + sp * SB + (pl + 8u * (unsigned)(j))) = (f32x4){za[j], zb[j], za[j + 1], zb[j + 1]};
            *(LAS f32x4*)(L + sp * SB + (pl + 34816u + 8u * (unsigned)(j))) = (f32x4){0.f, 0.f, 0.f, 0.f}; }
    }
    __syncthreads();
    float* Z1 = (float*)(F.ws + WS_Z1) + (size_t)c * 4 * SEQ;
    bf16_t* MIX = (bf16_t*)(F.ws + WS_MIX);
#pragma unroll 1
    for (int n = 0; n < 2; ++n) {
        fft8192x2<false>(L, t);
#pragma unroll 1
        for (int k0 = 0; k0 < 16; k0 += 8) { f32x2 h[8];
#pragma unroll
          for (int k = 0; k < 8; ++k) h[k] = SPEC[n * 8192 + t + 512 * (k0 + k)];
#pragma unroll
          for (int k = 0; k < 8; ++k) { const unsigned ad = (pt + 4352u * (unsigned)(k0 + k));
            const f32x2 a = *(const LAS f32x2*)(L + ad), b = *(const LAS f32x2*)(L + SB + ad);
            *(LAS f32x2*)(L + ad) = (f32x2){a[0] * h[k][0] - a[1] * h[k][1], a[0] * h[k][1] + a[1] * h[k][0]};
            *(LAS f32x2*)(L + SB + ad) = (f32x2){b[0] * h[k][0] - b[1] * h[k][1], b[0] * h[k][1] + b[1] * h[k][0]}; } }
        __syncthreads();
        fft8192x2<true>(L, t);
        const int xch = n == 0 ? c : 256 + c; const float* wg = n == 0 ? wx1 : wx2; const float bias = n == 0 ? bias0 : bias1;
#pragma unroll 1
        for (int sp = 0; sp < 2; ++sp) {
            float zo[2][8];
#pragma unroll
            for (int h2 = 0; h2 < 2; ++h2) { const int bb = 2 * sp + h2;
                float g[8], zin[8];
                hy_short8(HYT + ((size_t)bb * 768 + xch) * POS, l0, wg[0], wg[1], wg[2], g);
                if (n == 0) hy_short8(HYT + ((size_t)bb * 768 + 512 + c) * POS, l0, wv[0], wv[1], wv[2], zin);
                else { const f32x4 q0 = *(const f32x4*)(Z1 + (size_t)bb * SEQ + l0), q1 = *(const f32x4*)(Z1 + (size_t)bb * SEQ + l0 + 4);
                    zin[0] = q0[0]; zin[1] = q0[1]; zin[2] = q0[2]; zin[3] = q0[3]; zin[4] = q1[0]; zin[5] = q1[1]; zin[6] = q1[2]; zin[7] = q1[3]; }
#pragma unroll
                for (int j = 0; j < 8; ++j) { const float y = ((const LAS float*)(L + sp * SB + (pl + 8u * (unsigned)(j))))[h2]; zo[h2][j] = g[j] * (y + bias * zin[j]); }
                if (n == 0) { *(f32x4*)(Z1 + (size_t)bb * SEQ + l0) = (f32x4){zo[h2][0], zo[h2][1], zo[h2][2], zo[h2][3]}; *(f32x4*)(Z1 + (size_t)bb * SEQ + l0 + 4) = (f32x4){zo[h2][4], zo[h2][5], zo[h2][6], zo[h2][7]}; }
                else {
#pragma unroll
                    for (int j = 0; j < 8; ++j) MIX[((size_t)bb * SEQ + l0 + j) * DM + c] = f2bf(zo[h2][j]); }
            }
            if (n == 0) {
#pragma unroll
                for (int j = 0; j < 8; j += 2) {
                    *(LAS f32x4*)(L + sp * SB + (pl + 8u * (unsigned)(j))) = (f32x4){zo[0][j], zo[1][j], zo[0][j + 1], zo[1][j + 1]};
                    *(LAS f32x4*)(L + sp * SB + (pl + 34816u + 8u * (unsigned)(j))) = (f32x4){0.f, 0.f, 0.f, 0.f}; }
            }
        }
        __syncthreads();
    }
}

DI void fnet_fft_unit(const Frame& F, int u) {
    LAS unsigned char* L = F.lds; constexpr int SB = cx_bytes(4096);
    const int t = F.tid, b = u >> 6, gd0 = (u & 63) * 4;
    const bf16_t* YT = (const bf16_t*)(F.ws + WS_YTL) + ((size_t)b * 256 + gd0) * 8192;
    for (int i = t; i < 4 * 512; i += NTHR) { const int q = i >> 9, l0 = (i & 511) * 8;
        const u32x4 r = *(const u32x4*)(YT + (size_t)q * 8192 + l0), m = *(const u32x4*)(YT + (size_t)q * 8192 + 4096 + l0);
        const float rr[8] = {bflo(r.x), bfhi(r.x), bflo(r.y), bfhi(r.y), bflo(r.z), bfhi(r.z), bflo(r.w), bfhi(r.w)};
        const float mm[8] = {bflo(m.x), bfhi(m.x), bflo(m.y), bfhi(m.y), bflo(m.z), bfhi(m.z), bflo(m.w), bfhi(m.w)};
#pragma unroll
        for (int j = 0; j < 8; j += 2) *(LAS f32x4*)(L + q * SB + cx_addr(l0 + j)) = (f32x4){rr[j], mm[j], rr[j + 1], mm[j + 1]}; }
    __syncthreads();
    fft4096x4(L, t);
    bf16_t* MIX = (bf16_t*)(F.ws + WS_MIX);
#pragma unroll
    for (int i = 0; i < 8; ++i) { const int p = t + 512 * i; const int f = (p >> 8) + 16 * ((p >> 4) & 15) + 256 * (p & 15);
        float v[4];
#pragma unroll
        for (int q = 0; q < 4; ++q) v[q] = (*(const LAS f32x2*)(L + q * SB + cx_addr(p)))[0] * (1.0f / 512.0f);
        u32x2 w; w.x = cvt_pk_bf16(v[0], v[1]); w.y = cvt_pk_bf16(v[2], v[3]);
        *(u32x2*)(MIX + ((size_t)b * SEQ + f) * DM + 768 + gd0) = w; }
    __syncthreads();
}

DI void attn_unit(const Frame& F, int ly, int uid, float lam, float out_scale) {
    const int t = F.tid, lane = F.lane, wave = F.wave;
    LAS unsigned char* L = F.lds;
    constexpr int KOFF = 0, VOFF = 16384, TB = 32768, NBUF = 4;
    int bh, q0, k_lo, k_hi;
    if (uid < 512) { bh = uid >> 4; q0 = (uid & 15) << 8; k_lo = 0; k_hi = POS; }
    else { bh = uid - 512; q0 = SEQ; k_lo = SEQ; k_hi = POS; }
    const bf16_t* Qg = (const bf16_t*)(F.ws + WS_Q) + (size_t)bh * POS * 64;
    const bf16_t* Kg = (const bf16_t*)(F.ws + WS_K) + (size_t)bh * POS * 64;
    const bf16_t* Vg = (const bf16_t*)(F.ws + WS_V) + (size_t)bh * POS * 64;
    const int qi = lane & 31, hh = lane >> 5;
    const int qpos = q0 + wave * 32 + qi;
    bf16x8 qf[2][2];
    float q2[2] = {0.f, 0.f};
#pragma unroll
    for (int comp = 0; comp < 2; ++comp)
#pragma unroll
        for (int ks = 0; ks < 2; ++ks) { qf[comp][ks] = *(const bf16x8*)(Qg + (size_t)qpos * 64 + comp * 32 + ks * 16 + hh * 8);
#pragma unroll
            for (int j = 0; j < 8; ++j) { const float x = bf2f((unsigned short)qf[comp][ks][j]); q2[comp] += x * x; } }
    q2[0] += __shfl_xor(q2[0], 32); q2[1] += __shfl_xor(q2[1], 32);
    float kmax2[2];
    kmax2[0] = __uint_as_float(F.ctl[CW_KMAX + 64 * ly + bh * 2]); kmax2[1] = __uint_as_float(F.ctl[CW_KMAX + 64 * ly + bh * 2 + 1]);
    f32x16 negm;
    { const float m = -fmaxf(sqrtf(q2[0] * kmax2[0]), sqrtf(q2[1] * kmax2[1])) * 1.0001f;
#pragma unroll
      for (int i = 0; i < 16; ++i) negm[i] = m; }
    f32x16 O[2][2];
#pragma unroll
    for (int a = 0; a < 2; ++a)
#pragma unroll
        for (int b = 0; b < 2; ++b)
#pragma unroll
            for (int i = 0; i < 16; ++i) O[a][b][i] = 0.f;
    float lsum[2] = {0.f, 0.f};
    const int sk = t >> 3, sl = t & 7;
    const int kch = sl ^ ((sk >> 1) & 7);
    const int vch = (((sl >> 1) ^ (sk & 3)) << 1) | (sl & 1);
    const bf16_t* kgp = Kg + (size_t)(k_lo + sk) * 64 + kch * 8;
    const bf16_t* vgp = Vg + (size_t)(k_lo + sk) * 64 + vch * 8;
    const unsigned wvb = (unsigned)wave * 1024u;
    const int ntile = (k_hi - k_lo) >> 7;
#define ATT_DMA(tile, bufi) do { const size_t go = (size_t)(tile) * 128 * 64; \
        __builtin_amdgcn_global_load_lds((const unsigned*)(kgp + go), (LAS unsigned*)(L + KOFF + (bufi) * TB + wvb), 16, 0, 0); \
        __builtin_amdgcn_global_load_lds((const unsigned*)(kgp + go + 4096), (LAS unsigned*)(L + KOFF + (bufi) * TB + 8192 + wvb), 16, 0, 0); \
        __builtin_amdgcn_global_load_lds((const unsigned*)(vgp + go), (LAS unsigned*)(L + VOFF + (bufi) * TB + wvb), 16, 0, 0); \
        __builtin_amdgcn_global_load_lds((const unsigned*)(vgp + go + 4096), (LAS unsigned*)(L + VOFF + (bufi) * TB + 8192 + wvb), 16, 0, 0); } while (0)
    ATT_DMA(0, 0);
    if (ntile > 1) ATT_DMA(1, 1);
    if (ntile > 2) ATT_DMA(2, 2);
    if (ntile > 2) asm volatile("s_waitcnt vmcnt(8)" ::: "memory"); else if (ntile > 1) asm volatile("s_waitcnt vmcnt(4)" ::: "memory"); else asm volatile("s_waitcnt vmcnt(0)" ::: "memory");
    __builtin_amdgcn_s_barrier();
    const int p4 = lane & 3, q4 = (lane & 15) >> 2, blk = (lane >> 4) & 1;
    const int keyq = 4 * hh + q4;
    const unsigned va0 = (unsigned)(keyq * 128 + (((0 + blk) ^ (keyq & 3)) << 5) + p4 * 8), va1 = (unsigned)(keyq * 128 + (((2 + blk) ^ (keyq & 3)) << 5) + p4 * 8);
    const int ksw = (qi >> 1) & 7;
    const unsigned ka00 = (unsigned)(qi * 128 + (((0 + hh) ^ ksw) << 4)), ka01 = (unsigned)(qi * 128 + (((2 + hh) ^ ksw) << 4));
    const unsigned ka10 = (unsigned)(qi * 128 + (((4 + hh) ^ ksw) << 4)), ka11 = (unsigned)(qi * 128 + (((6 + hh) ^ ksw) << 4));
    typedef __bf16 bf16x8n __attribute__((ext_vector_type(8)));
    typedef float f32x8 __attribute__((ext_vector_type(8)));
#define ATT_PACK(S, s8) __builtin_bit_cast(bf16x8, __builtin_convertvector((f32x8){S[8 * (s8)], S[8 * (s8) + 1], S[8 * (s8) + 2], S[8 * (s8) + 3], S[8 * (s8) + 4], S[8 * (s8) + 5], S[8 * (s8) + 6], S[8 * (s8) + 7]}, bf16x8n))
#define ATT_MFMA(a, b, c) __builtin_amdgcn_mfma_f32_32x32x16_bf16((a), (b), (c), 0, 0, 0)
    f32x16 S0, S1;
    bf16x8 p1a, p1b, vp00, vp01, vp10, vp11;
#pragma unroll
    for (int j = 0; j < 8; ++j) { p1a[j] = 0; p1b[j] = 0; vp00[j] = 0; vp01[j] = 0; vp10[j] = 0; vp11[j] = 0; }
    for (int it = 0; it < ntile; ++it) {
        const int buf = it & (NBUF - 1);
        if (it + 3 < ntile) ATT_DMA(it + 3, (it + 3) & (NBUF - 1));
        const unsigned kbb = KOFF + buf * TB, vbb = VOFF + buf * TB;
        { const bf16x8 k00 = *(const LAS bf16x8*)(L + kbb + ka00), k01 = *(const LAS bf16x8*)(L + kbb + ka01);
          S0 = ATT_MFMA(k00, qf[0][0], negm); S0 = ATT_MFMA(k01, qf[0][1], S0); }
#pragma unroll 1
        for (int kb = 0; kb < 4; ++kb) {
            const unsigned kro = kbb + kb * 4096, vro = vbb + kb * 4096;
            s16x4 r0, r1, r2, r3, r4, r5, r6, r7;
            { const unsigned a0 = vro + va0, a1 = vro + va1;
              asm volatile("ds_read_b64_tr_b16 %0, %8\n\tds_read_b64_tr_b16 %1, %8 offset:1024\n\tds_read_b64_tr_b16 %2, %8 offset:2048\n\tds_read_b64_tr_b16 %3, %8 offset:3072\n\t"
                           "ds_read_b64_tr_b16 %4, %9\n\tds_read_b64_tr_b16 %5, %9 offset:1024\n\tds_read_b64_tr_b16 %6, %9 offset:2048\n\tds_read_b64_tr_b16 %7, %9 offset:3072"
                           : "=&v"(r0), "=&v"(r1), "=&v"(r2), "=&v"(r3), "=&v"(r4), "=&v"(r5), "=&v"(r6), "=&v"(r7) : "v"(a0), "v"(a1) : "memory"); }
            const bf16x8 k10 = *(const LAS bf16x8*)(L + kro + ka10), k11 = *(const LAS bf16x8*)(L + kro + ka11);
            O[1][0] = ATT_MFMA(vp00, p1a, O[1][0]); O[1][1] = ATT_MFMA(vp01, p1a, O[1][1]);
            O[1][0] = ATT_MFMA(vp10, p1b, O[1][0]); O[1][1] = ATT_MFMA(vp11, p1b, O[1][1]);
            S1 = ATT_MFMA(k10, qf[1][0], negm); S1 = ATT_MFMA(k11, qf[1][1], S1);
            float ps0 = 0.f;
#pragma unroll
            for (int i = 0; i < 16; ++i) { S0[i] = __builtin_amdgcn_exp2f(S0[i]); ps0 += S0[i]; }
            lsum[0] += ps0;
            const bf16x8 p0a = ATT_PACK(S0, 0), p0b = ATT_PACK(S0, 1);
            __builtin_amdgcn_sched_group_barrier(0x008, 1, 0); __builtin_amdgcn_sched_group_barrier(0x400, 3, 0);
            __builtin_amdgcn_sched_group_barrier(0x008, 1, 0); __builtin_amdgcn_sched_group_barrier(0x400, 3, 0);
            __builtin_amdgcn_sched_group_barrier(0x008, 1, 0); __builtin_amdgcn_sched_group_barrier(0x400, 3, 0);
            __builtin_amdgcn_sched_group_barrier(0x008, 1, 0); __builtin_amdgcn_sched_group_barrier(0x400, 3, 0);
            __builtin_amdgcn_sched_group_barrier(0x008, 1, 0); __builtin_amdgcn_sched_group_barrier(0x400, 2, 0);
            __builtin_amdgcn_sched_group_barrier(0x008, 1, 0); __builtin_amdgcn_sched_group_barrier(0x400, 2, 0);
            asm volatile("s_waitcnt lgkmcnt(0)" : "+v"(r0), "+v"(r1), "+v"(r2), "+v"(r3), "+v"(r4), "+v"(r5), "+v"(r6), "+v"(r7));
            vp00 = __builtin_shufflevector(r0, r1, 0, 1, 2, 3, 4, 5, 6, 7); vp10 = __builtin_shufflevector(r2, r3, 0, 1, 2, 3, 4, 5, 6, 7);
            vp01 = __builtin_shufflevector(r4, r5, 0, 1, 2, 3, 4, 5, 6, 7); vp11 = __builtin_shufflevector(r6, r7, 0, 1, 2, 3, 4, 5, 6, 7);
            O[0][0] = ATT_MFMA(vp00, p0a, O[0][0]); O[0][1] = ATT_MFMA(vp01, p0a, O[0][1]);
            O[0][0] = ATT_MFMA(vp10, p0b, O[0][0]); O[0][1] = ATT_MFMA(vp11, p0b, O[0][1]);
            { const bf16x8 k00 = *(const LAS bf16x8*)(L + kro + 4096 + ka00), k01 = *(const LAS bf16x8*)(L + kro + 4096 + ka01);
                S0 = ATT_MFMA(k00, qf[0][0], negm); S0 = ATT_MFMA(k01, qf[0][1], S0); }
            float ps1 = 0.f;
#pragma unroll
            for (int i = 0; i < 16; ++i) { S1[i] = __builtin_amdgcn_exp2f(S1[i]); ps1 += S1[i]; }
            lsum[1] += ps1;
            p1a = ATT_PACK(S1, 0); p1b = ATT_PACK(S1, 1);
            __builtin_amdgcn_sched_group_barrier(0x008, 1, 1); __builtin_amdgcn_sched_group_barrier(0x400, 3, 1);
            __builtin_amdgcn_sched_group_barrier(0x008, 1, 1); __builtin_amdgcn_sched_group_barrier(0x400, 3, 1);
            __builtin_amdgcn_sched_group_barrier(0x008, 1, 1); __builtin_amdgcn_sched_group_barrier(0x400, 3, 1);
            __builtin_amdgcn_sched_group_barrier(0x008, 1, 1); __builtin_amdgcn_sched_group_barrier(0x400, 3, 1);
            __builtin_amdgcn_sched_group_barrier(0x008, 1, 1); __builtin_amdgcn_sched_group_barrier(0x400, 2, 1);
            __builtin_amdgcn_sched_group_barrier(0x008, 1, 1); __builtin_amdgcn_sched_group_barrier(0x400, 2, 1);
        }
        if (it + 3 < ntile) asm volatile("s_waitcnt vmcnt(8)\n\ts_waitcnt lgkmcnt(0)" ::: "memory");
        else if (it + 2 < ntile) asm volatile("s_waitcnt vmcnt(4)\n\ts_waitcnt lgkmcnt(0)" ::: "memory");
        else asm volatile("s_waitcnt vmcnt(0)\n\ts_waitcnt lgkmcnt(0)" ::: "memory");
        __builtin_amdgcn_s_barrier();
    }
    O[1][0] = ATT_MFMA(vp00, p1a, O[1][0]); O[1][1] = ATT_MFMA(vp01, p1a, O[1][1]);
    O[1][0] = ATT_MFMA(vp10, p1b, O[1][0]); O[1][1] = ATT_MFMA(vp11, p1b, O[1][1]);
#undef ATT_DMA
#undef ATT_PACK
#undef ATT_MFMA
    const float l0 = lsum[0] + __shfl_xor(lsum[0], 32), l1 = lsum[1] + __shfl_xor(lsum[1], 32);
    const float i0 = 1.0f / l0, i1 = lam / l1;
    float ss = 0.f;
#pragma unroll
    for (int dvb = 0; dvb < 2; ++dvb)
#pragma unroll
        for (int i = 0; i < 16; ++i) { const float o = O[0][dvb][i] * i0 - O[1][dvb][i] * i1; O[0][dvb][i] = o; ss += o * o; }
    ss += __shfl_xor(ss, 32);
    const float rn = rsqrtf(ss * (1.0f / 64.0f) + LN_EPS) * out_scale;
    const float* sw = F.in[20] + (size_t)ly * 64;
    const int b = bh >> 3, head = bh & 7;
    const size_t row = qpos < SEQ ? (size_t)b * SEQ + qpos : (size_t)RLAT + b * CTXL + (qpos - SEQ);
    bf16_t* dst = (bf16_t*)(F.ws + WS_MIX) + row * DM + 256 + head * 64;
#pragma unroll
    for (int dvb = 0; dvb < 2; ++dvb)
#pragma unroll
        for (int g = 0; g < 4; ++g) { const int dv = dvb * 32 + 8 * g + 4 * hh;
            const f32x4 w4 = *(const f32x4*)(sw + dv);
            u32x2 w; w.x = cvt_pk_bf16(O[0][dvb][4 * g] * rn * w4[0], O[0][dvb][4 * g + 1] * rn * w4[1]); w.y = cvt_pk_bf16(O[0][dvb][4 * g + 2] * rn * w4[2], O[0][dvb][4 * g + 3] * rn * w4[3]);
            *(u32x2*)(dst + dv) = w; }
    __syncthreads();
}

DI void phase_rows_router(const Frame& F, int ly) {
    LAS float* HS = (LAS float*)F.lds;
    LAS float* PART = HS + 16 * 1028;
    LAS int* LCNT = (LAS int*)(PART + 8 * 16 * 64);
    LAS int* LBASE = LCNT + 64;
    LAS int* ASG = LBASE + 64;
    const int lane = F.lane, wave = F.wave;
    const float* MOD = (const float*)(F.ws + WS_MOD);
    const float* g1 = F.in[22] + (size_t)ly * DM; const float* b1 = F.in[23] + (size_t)ly * DM;
    const float* rw = F.in[26] + (size_t)ly * DM * NEXP; const float* rb = F.in[27] + (size_t)ly * NEXP;
    const bool last = ly == DEPTH - 1;
    const int nrows = last ? RLAT : RTOT;
    if (F.tid < 64) LCNT[F.tid] = 0;
    constexpr int HSS = 1028;
    float wreg[128];
#pragma unroll
    for (int i = 0; i < 128; ++i) wreg[i] = rw[(size_t)(wave * 128 + 4 * (i >> 2) + (lane >> 4)) * NEXP + 16 * (i & 3) + (lane & 15)];
    __syncthreads();
    int itn = 0;
    f32x4 va[2][4];
    if (F.bid * 16 < nrows) {
#pragma unroll
        for (int rr = 0; rr < 2; ++rr) { const float* xr = (const float*)(F.ws + WS_X) + (size_t)(F.bid * 16 + wave * 2 + rr) * DM;
#pragma unroll
            for (int j = 0; j < 4; ++j) va[rr][j] = *(const f32x4*)(xr + 4 * lane + 256 * j); } }
    for (int r0 = F.bid * 16; r0 < nrows; r0 += F.G * 16, ++itn) {
#pragma unroll
        for (int rr = 0; rr < 2; ++rr) { const int rl = wave * 2 + rr, row = r0 + rl;
            float* xr = (float*)(F.ws + WS_X) + (size_t)row * DM;
            f32x4 (&v)[4] = va[rr];
            float mu, rstd; ln_stats(v, mu, rstd);
#pragma unroll
            for (int j = 0; j < 4; ++j) { const int c = 4 * lane + 256 * j; const f32x4 g = *(const f32x4*)(g1 + c), bb = *(const f32x4*)(b1 + c);
#pragma unroll
                for (int e = 0; e < 4; ++e) v[j][e] = (v[j][e] - mu) * rstd * g[e] + bb[e];
                *(f32x4*)(xr + c) = v[j]; }
            ln_stats(v, mu, rstd);
            const float* m = MOD + ((size_t)ly * 5 + row_modsel(row)) * 6144;
            bf16_t* hrow = (bf16_t*)(F.ws + WS_H) + (size_t)row * DM;
#pragma unroll
            for (int j = 0; j < 4; ++j) { const int c = 4 * lane + 256 * j; const f32x4 a = *(const f32x4*)(m + 3072 + c), bsc = *(const f32x4*)(m + 4096 + c);
                f32x4 o;
#pragma unroll
                for (int e = 0; e < 4; ++e) o[e] = (v[j][e] - mu) * rstd * (1.f + bsc[e]) + a[e];
                u32x2 w; w.x = cvt_pk_bf16(o[0], o[1]); w.y = cvt_pk_bf16(o[2], o[3]); *(u32x2*)(hrow + c) = w;
                *(LAS f32x4*)(HS + rl * HSS + c) = o; } }
        { const int rn = r0 + F.G * 16;
          if (rn < nrows) {
#pragma unroll
            for (int rr = 0; rr < 2; ++rr) { const float* xr = (const float*)(F.ws + WS_X) + (size_t)(rn + wave * 2 + rr) * DM;
#pragma unroll
                for (int j = 0; j < 4; ++j) va[rr][j] = *(const f32x4*)(xr + 4 * lane + 256 * j); } } }
        asm volatile("s_waitcnt lgkmcnt(0)" ::: "memory"); __builtin_amdgcn_s_barrier();
        { f32x4 acc[4];
#pragma unroll
          for (int nb = 0; nb < 4; ++nb) acc[nb] = (f32x4){0.f, 0.f, 0.f, 0.f};
          const LAS float* hp = HS + (lane & 15) * HSS + wave * 128 + (lane >> 4);
#pragma unroll
          for (int g = 0; g < 32; ++g) { const float a = hp[4 * g];
#pragma unroll
              for (int nb = 0; nb < 4; ++nb) acc[nb] = __builtin_amdgcn_mfma_f32_16x16x4f32(a, wreg[g * 4 + nb], acc[nb], 0, 0, 0); }
#pragma unroll
          for (int nb = 0; nb < 4; ++nb)
#pragma unroll
              for (int e = 0; e < 4; ++e) PART[(wave * 16 + (lane >> 4) * 4 + e) * 64 + nb * 16 + (lane & 15)] = acc[nb][e]; }
        asm volatile("s_waitcnt lgkmcnt(0)" ::: "memory"); __builtin_amdgcn_s_barrier();
#pragma unroll
        for (int rr = 0; rr < 2; ++rr) { const int rl = wave * 2 + rr, row = r0 + rl;
            float lg = 0.f;
#pragma unroll
            for (int w = 0; w < 8; ++w) lg += PART[(w * 16 + rl) * 64 + lane];
            const float s = 1.0f / (1.0f + expf(-lg));
            const float sel = s + rb[lane];
            float m1 = sel;
            m1 = fmaxf(m1, __shfl_xor(m1, 1)); m1 = fmaxf(m1, __shfl_xor(m1, 2)); m1 = fmaxf(m1, __shfl_xor(m1, 4));
            const unsigned long long bal = __ballot(sel == m1);
            const int gbase = lane & ~7;
            const unsigned gmask = (unsigned)((bal >> gbase) & 0xffull);
            const int first = gbase + __builtin_ctz(gmask);
            float m2 = (lane == first) ? -INFINITY : sel;
            m2 = fmaxf(m2, __shfl_xor(m2, 1)); m2 = fmaxf(m2, __shfl_xor(m2, 2)); m2 = fmaxf(m2, __shfl_xor(m2, 4));
            const float gs = m1 + m2;
            const int mygrp = lane >> 3;
            int grank = 0;
#pragma unroll
            for (int g = 0; g < 8; ++g) { const float o = __shfl(gs, g * 8); grank += (o > gs || (o == gs && g < mygrp)) ? 1 : 0; }
            const float msel = grank < 4 ? sel : -INFINITY;
            int rank = 64;
            { float cur = msel;
#pragma unroll 1
              for (int it = 0; it < 8; ++it) { const float m = wave_max(cur); const unsigned long long bl = __ballot(cur == m); const int first2 = (int)__builtin_ctzll(bl);
                  if (lane == first2) { rank = it; cur = -INFINITY; } } }
            const bool chosen = rank < 8;
            const float wsum = wave_sum(chosen ? s : 0.f);
            if (chosen) { const float gate = s / wsum * 2.5f;
                ((float*)(F.ws + WS_TOPG))[(size_t)row * 8 + rank] = gate;
                const int lp = __hip_atomic_fetch_add(LCNT + lane, 1, __ATOMIC_RELAXED, __HIP_MEMORY_SCOPE_WORKGROUP);
                ASG[(itn * 16 + rl) * 8 + rank] = (lane << 20) | lp; } }
        asm volatile("s_waitcnt lgkmcnt(0)" ::: "memory"); __builtin_amdgcn_s_barrier();
    }
    if (F.tid < 64) { const int n = LCNT[F.tid]; LBASE[F.tid] = n ? (int)atomicAdd(F.ctl + CW_CNT + (ly * 64 + F.tid) * CNT_STRIDE, (unsigned)n) : 0; }
    __syncthreads();
    for (int a = F.tid; a < itn * 128; a += NTHR) { const int it = a >> 7, rl = (a >> 3) & 15, slot = a & 7; const int row = F.bid * 16 + it * F.G * 16 + rl;
        const int v = ASG[a], e = v >> 20, lp = v & 0xfffff;
        ((int*)(F.ws + WS_LIST))[(size_t)e * RTOT + LBASE[e] + lp] = row * 8 + slot;
        ((int*)(F.ws + WS_TOPE))[(size_t)row * 8 + slot] = (e << 20) | (LBASE[e] + lp); }
    __syncthreads();
}

DI void bf8_fma(const u32x4 w, float g, float (&y)[8]) {
    y[0] += bflo(w.x) * g; y[1] += bfhi(w.x) * g; y[2] += bflo(w.y) * g; y[3] += bfhi(w.y) * g; y[4] += bflo(w.z) * g; y[5] += bfhi(w.z) * g; y[6] += bflo(w.w) * g; y[7] += bfhi(w.w) * g;
}
DI void phase_combine(const Frame& F, int ly) {
    const int gw = F.bid * 8 + F.wave, nw = F.G * 8, lane = F.lane;
    const bool last = ly == DEPTH - 1;
    const int nrows = last ? RLAT : RTOT;
    const float* MOD = (const float*)(F.ws + WS_MOD);
    const float* g2w = F.in[24] + (size_t)ly * DM; const float* b2w = F.in[25] + (size_t)ly * DM;
    const bf16_t* YB = (const bf16_t*)(F.ws + WS_YB);
    const MoeTab T = moe_tables(F, ly);
    for (int row = gw; row < nrows; row += nw) {
        const float* gates = (const float*)(F.ws + WS_TOPG) + (size_t)row * 8;
        const int* posr = (const int*)(F.ws + WS_TOPE) + (size_t)row * 8;
        u32x4 yr[9][2];
#pragma unroll
        for (int s9 = 0; s9 < 9; ++s9) { size_t yrow;
            if (s9 < 8) { const int v = posr[s9]; yrow = (size_t)T.tstart[v >> 20] * 256 + (v & 0xfffff); } else yrow = (size_t)T.tstart[NEXP] * 256 + row;
#pragma unroll
            for (int hf = 0; hf < 2; ++hf) yr[s9][hf] = *(const u32x4*)(YB + yrow * DM + hf * 512 + 8 * lane); }
        float* xr = (float*)(F.ws + WS_X) + (size_t)row * DM;
        f32x4 xv[4];
#pragma unroll
        for (int hf = 0; hf < 2; ++hf) { xv[2 * hf] = *(const f32x4*)(xr + hf * 512 + 8 * lane); xv[2 * hf + 1] = *(const f32x4*)(xr + hf * 512 + 8 * lane + 4); }
        float y[2][8];
#pragma unroll
        for (int hf = 0; hf < 2; ++hf) {
#pragma unroll
            for (int e = 0; e < 8; ++e) y[hf][e] = 0.f;
            bf8_fma(yr[8][hf], 1.0f, y[hf]);
#pragma unroll
            for (int s8 = 0; s8 < 8; ++s8) bf8_fma(yr[s8][hf], gates[s8], y[hf]); }
        const float* m = MOD + ((size_t)ly * 5 + row_modsel(row)) * 6144;
        f32x4 v[4];
#pragma unroll
        for (int q = 0; q < 4; ++q) { const int c = (q >> 1) * 512 + 8 * lane + (q & 1) * 4; const f32x4 g2 = *(const f32x4*)(m + 5120 + c);
#pragma unroll
            for (int e = 0; e < 4; ++e) v[q][e] = xv[q][e] * ALPHA + g2[e] * y[q >> 1][(q & 1) * 4 + e]; }
        float mu, rstd; ln_stats(v, mu, rstd);
#pragma unroll
        for (int q = 0; q < 4; ++q) { const int c = (q >> 1) * 512 + 8 * lane + (q & 1) * 4; const f32x4 g = *(const f32x4*)(g2w + c), bb = *(const f32x4*)(b2w + c);
#pragma unroll
            for (int e = 0; e < 4; ++e) v[q][e] = (v[q][e] - mu) * rstd * g[e] + bb[e];
            if (last) *(f32x4*)(F.out + (size_t)row * DM + c) = v[q]; else *(f32x4*)(xr + c) = v[q]; }
        if (!last) { const float* mn = MOD + ((size_t)(ly + 1) * 5 + row_modsel(row)) * 6144;
            ln_stats(v, mu, rstd);
            bf16_t* hrow = (bf16_t*)(F.ws + WS_H) + (size_t)row * DM;
#pragma unroll
            for (int hf = 0; hf < 2; ++hf) { const int c = hf * 512 + 8 * lane; float o[8];
#pragma unroll
                for (int q = 0; q < 2; ++q) { const f32x4 sh = *(const f32x4*)(mn + c + 4 * q), sc = *(const f32x4*)(mn + 1024 + c + 4 * q);
#pragma unroll
                    for (int e = 0; e < 4; ++e) o[4 * q + e] = (v[2 * hf + q][e] - mu) * rstd * (1.f + sc[e]) + sh[e]; }
                u32x4 w; w.x = cvt_pk_bf16(o[0], o[1]); w.y = cvt_pk_bf16(o[2], o[3]); w.z = cvt_pk_bf16(o[4], o[5]); w.w = cvt_pk_bf16(o[6], o[7]);
                *(u32x4*)(hrow + c) = w; } }
    }
}

PHASE_FN void ph_pre0(const Frame& F0) { const Frame F = relaunder(F0); prep_small(F, 0); prep_mod(F); prep_filters(F); prep_tables(F); }
PHASE_FN void ph_pre1(const Frame& F0) { const Frame F = relaunder(F0); prep_invl1(F); phase_init_h(F); }
PHASE_FN void ph_win(const Frame& F0, int ly) { const Frame F = relaunder(F0);
    pg8::Gemm g{(const bf16_t*)(F.ws + WS_H), (const bf16_t*)(F.ws + WS_WIN), DM, F.tid};
    pg8::StaticOrder S; S.init(RTOT / 256, NWIN / 256, F.G, F.bid);
    EpiWin E{F.ws, ly};
    pg8::gemm_phase<EpiWin, pg8::StaticOrder>(F.lds, g, S, E);
}
constexpr int NSTREAM = 0;
PHASE_FN void ph_mix(const Frame& F0, int ly) { const Frame F = relaunder(F0);
    volatile LAS unsigned* MISC = (volatile LAS unsigned*)(F.lds + LDS_MISC);
    { pg8::Gemm g{(const bf16_t*)(F.ws + WS_DFTC), (const bf16_t*)(F.ws + WS_YTC), 2 * CTXL, F.tid};
      pg8::StaticOrder S; S.init(1, 4, F.G, (F.bid + F.G - 64) % F.G);
      EpiFnet E{F.ws, 1};
      pg8::gemm_phase<EpiFnet, pg8::StaticOrder>(F.lds, g, S, E); }
    __syncthreads();
    for (;;) {
        __syncthreads();
        if (F.tid == 0) MISC[16] = atomicAdd(F.ctl + CW_ATTN + 64 * ly, 1u);
        __syncthreads();
        const int uid = (int)MISC[16];
        if (uid >= 256 + 256 + 544) break;
        const Frame Fu = relaunder(F);
        if (uid < 256) { if (KIND(4)) { hyena_fft_unit(Fu, ly, uid); hyena_ctx_unit(Fu, ly, uid); } }
        else if (uid < 512) { if (KIND(3)) fnet_fft_unit(Fu, uid - 256); }
        else if (KIND(5)) { const float* lm = (const float*)(Fu.ws + WS_LAM) + 2 * ly; attn_unit(Fu, ly, uid - 512, lm[0], 1.0f - lm[1]); }
    }
    prep_experts(F, ly, CW_PREPQ, 0, PREP_SPLIT);
}
PHASE_FN void ph_wout(const Frame& F0, int ly) { const Frame F = relaunder(F0);
    pg8::Gemm g{(const bf16_t*)(F.ws + WS_MIX), (const bf16_t*)(F.ws + WS_WOUT), DM, F.tid};
    pg8::StaticOrder S; S.init(RTOT / 256, DM / 256, F.G, F.bid);
    EpiWout E{F.ws, ly, F.in[0], F.in[2]};
    pg8::gemm_phase<EpiWout, pg8::StaticOrder>(F.lds, g, S, E);
    __syncthreads();
    prep_experts(F, ly, CW_PREPQ2, PREP_SPLIT, PREP_NJOBS);
}
PHASE_FN void ph_router(const Frame& F0, int ly) { const Frame F = relaunder(F0); phase_rows_router(F, ly); }
PHASE_FN void ph_moe1(const Frame& F0, int ly) { const Frame F = relaunder(F0);
    const MoeTab T = moe_tables(F, ly);
    pg8::Gemm g{(const bf16_t*)(F.ws + WS_H), (const bf16_t*)(F.ws + WS_WGU), DM, F.tid};
    MoeSched<true> S{T, (const int*)(F.ws + WS_LIST), F.G, F.bid, 2, 1};
    EpiMoe1 E{F.ws};
    pg8::gemm_phase<EpiMoe1, MoeSched<true>>(F.lds, g, S, E);
}
PHASE_FN void ph_moe2(const Frame& F0, int ly) { const Frame F = relaunder(F0);
    const MoeTab T = moe_tables(F, ly);
    pg8::Gemm g{(const bf16_t*)(F.ws + WS_ACT), (const bf16_t*)(F.ws + WS_WD), DEXP, F.tid};
    MoeSched<false> S{T, (const int*)(F.ws + WS_LIST), F.G, F.bid, 4, 2};
    EpiMoe2 E{F.ws};
    pg8::gemm_phase<EpiMoe2, MoeSched<false>>(F.lds, g, S, E);
}
PHASE_FN void ph_combine(const Frame& F0, int ly) { const Frame F = relaunder(F0); phase_combine(F, ly); if (ly + 1 < DEPTH) prep_small(F, ly + 1); }

constexpr int PH_PER_LAYER = 7, N_PHASES = 2 + DEPTH * PH_PER_LAYER;

__global__ void __launch_bounds__(NTHR, 2) hybrid_fwd(Params prm) {
    extern __shared__ __attribute__((aligned(16))) unsigned char lds_raw[];
    Frame F;
    F.in = prm.in; F.out = prm.out; F.ws = prm.ws; F.lds = (LAS unsigned char*)lds_raw; F.ctl = (unsigned*)(prm.ws + WS_CTL);
    F.tid = threadIdx.x; F.lane = F.tid & 63; F.wave = __builtin_amdgcn_readfirstlane(F.tid >> 6); F.G = gridDim.x; F.bid = blockIdx.x;
    volatile LAS unsigned* MISC = (volatile LAS unsigned*)(F.lds + LDS_MISC);
    if (F.tid < 64) MISC[F.tid] = 0u;
    __syncthreads();
    const int lo = prm.ph_lo, hi = prm.ph_hi;
    XcdBarrier bar; bar.bar = F.ctl + CW_BAR; bar.x = 0; bar.st = nullptr;
    if (hi - lo > 1) bar = xcd_barrier_post(F.ctl + CW_BAR, MISC);
#define IN(k) (lo <= (k) && (k) < hi)
    unsigned long long pr_acc = 0ull, pr_t0 = 0ull;
#define SEAM(k) do { if (IN(k) && IN((k) + 1)) { unsigned long long _b0 = 0; if ((PROBE_KINDS >> 12) & 1) _b0 = __builtin_amdgcn_s_memrealtime(); xcd_barrier(bar); if ((PROBE_KINDS >> 12) & 1) pr_acc += __builtin_amdgcn_s_memrealtime() - _b0; } } while (0)
#define PR_BEGIN(kind) do { if ((PROBE_KINDS >> (kind)) & 1) pr_t0 = __builtin_amdgcn_s_memrealtime(); } while (0)
#define PR_END(kind) do { if ((PROBE_KINDS >> (kind)) & 1) pr_acc += __builtin_amdgcn_s_memrealtime() - pr_t0; } while (0)

    PR_BEGIN(0); if (IN(0) && KIND(0)) { const Frame Fp = relaunder(F); PR_BEGIN(13); prep_small(Fp, 0); PR_END(13); PR_BEGIN(14); prep_mod(Fp); PR_END(14); PR_BEGIN(15); prep_filters(Fp); PR_END(15); PR_BEGIN(16); prep_tables(Fp); PR_END(16); }
    PR_END(0); SEAM(0);
    PR_BEGIN(1); if (IN(1) && KIND(1)) ph_pre1(F);
    PR_END(1); SEAM(1);

    for (int ly = 0; ly < DEPTH; ++ly) {
        const int p0 = 2 + ly * PH_PER_LAYER;
        PR_BEGIN(2); if (IN(p0) && KIND(2)) ph_win(F, ly);
        PR_END(2); SEAM(p0);
        if (IN(p0 + 1)) { PR_BEGIN(5); ph_mix(F, ly); }
        PR_END(5); SEAM(p0 + 1);
        PR_BEGIN(6); if (IN(p0 + 2) && KIND(6)) ph_wout(F, ly);
        PR_END(6); SEAM(p0 + 2);
        PR_BEGIN(7); if (IN(p0 + 3) && KIND(7)) ph_router(F, ly);
        PR_END(7); SEAM(p0 + 3);
        PR_BEGIN(8); if (IN(p0 + 4) && KIND(8)) ph_moe1(F, ly);
        PR_END(8); SEAM(p0 + 4);
        PR_BEGIN(9); if (IN(p0 + 5) && KIND(9)) ph_moe2(F, ly);
        PR_END(9); SEAM(p0 + 5);
        PR_BEGIN(10); if (IN(p0 + 6) && KIND(10)) { const Frame Fc = relaunder(F); PR_BEGIN(17); phase_combine(Fc, ly); PR_END(17); PR_BEGIN(18); if (ly + 1 < DEPTH) prep_small(Fc, ly + 1); PR_END(18); }
        PR_END(10); SEAM(p0 + 6);
    }
    if (PROBE_KINDS != 0 && blockIdx.x == 0) {
        const unsigned long long t0 = __builtin_amdgcn_s_memrealtime(), wait = pr_acc * (unsigned long long)PROBE_AMP;
        while (__builtin_amdgcn_s_memrealtime() - t0 < wait) __builtin_amdgcn_s_sleep(8);
    }
#undef IN
#undef SEAM
}

extern "C" void kernel_launch(void* const* d_in, const int* in_sizes, int n_in, void* d_out, int out_size, void* d_ws, size_t ws_size, hipStream_t stream) {
    static int grid = 0;
    if (grid == 0) {
        if (n_in != 34 || out_size != RLAT * DM || ws_size < WS_END) { fprintf(stderr, "kernel_launch: unexpected problem shape (n_in %d out %d ws %zu need %zu)\n", n_in, out_size, ws_size, (size_t)WS_END); grid = -1; return; }
        int dev = 0, cus = 0, per_cu = 0;
        if (hipGetDevice(&dev) != hipSuccess || hipDeviceGetAttribute(&cus, hipDeviceAttributeMultiprocessorCount, dev) != hipSuccess) { grid = -1; return; }
        if (hipFuncSetAttribute((const void*)hybrid_fwd, hipFuncAttributeMaxDynamicSharedMemorySize, LDS_BYTES) != hipSuccess) { fprintf(stderr, "kernel_launch: hipFuncSetAttribute failed\n"); grid = -1; return; }
        if (hipOccupancyMaxActiveBlocksPerMultiprocessor(&per_cu, (const void*)hybrid_fwd, NTHR, LDS_BYTES) != hipSuccess || per_cu < 1)
            fprintf(stderr, "kernel_launch: occupancy query reports %d workgroups per CU\n", per_cu);
        (void)hipGetLastError();
        grid = cus;
    }
    if (grid < 0) return;
    (void)hipMemsetAsync((char*)d_ws + WS_CTL, 0, CTL_BYTES, stream);
    Params p{};
    for (int i = 0; i < 34; ++i) p.in[i] = (const float*)d_in[i];
    p.out = (float*)d_out; p.ws = (unsigned char*)d_ws;
#if MK_PER_PHASE
    for (int ph = 0; ph < N_PHASES; ++ph) { p.ph_lo = ph; p.ph_hi = ph + 1; hipLaunchKernelGGL(hybrid_fwd, dim3(grid), dim3(NTHR), LDS_BYTES, stream, p); }
#else
    p.ph_lo = 0; p.ph_hi = N_PHASES;
    hipLaunchKernelGGL(hybrid_fwd, dim3(grid), dim3(NTHR), LDS_BYTES, stream, p);
#endif
}
```

```cpp
#include <hip/hip_runtime.h>
#include <cstdio>
#include <cstdint>

#ifndef MK_PER_PHASE
#define MK_PER_PHASE 0
#endif

#ifndef PG8_OPAQUE_K
#define PG8_OPAQUE_K 1
#endif
#ifndef MK_OUTLINE
#define MK_OUTLINE 0
#endif
#if MK_OUTLINE
#define PHASE_FN __device__ __attribute__((noinline))
#else
#define PHASE_FN __device__ __forceinline__
#endif
#ifndef PROBE_KINDS
#define PROBE_KINDS 0
#endif
#ifndef PROBE_AMP
#define PROBE_AMP 4
#endif
#ifndef KMASK
#define KMASK 0xFFFF
#endif
#define KIND(k) ((KMASK >> (k)) & 1)
#define LAS __attribute__((address_space(3)))
typedef unsigned short bf16_t;
typedef short bf16x8 __attribute__((ext_vector_type(8)));
typedef short s16x4 __attribute__((ext_vector_type(4)));
typedef float f32x4 __attribute__((ext_vector_type(4)));
typedef float f32x16 __attribute__((ext_vector_type(16)));
typedef unsigned u32x4 __attribute__((ext_vector_type(4)));
typedef unsigned u32x2 __attribute__((ext_vector_type(2)));
#define DI __device__ __forceinline__

constexpr int NB = 4, SEQ = 4096, CTXL = 256, DM = 1024, DEPTH = 4;
constexpr int POS = SEQ + CTXL;
constexpr int RLAT = NB * SEQ, RCTX = NB * CTXL, RTOT = RLAT + RCTX;
constexpr int DIN = 2560, NWIN = 2816;
constexpr int NEXP = 64, DEXP = 256;
constexpr float LN_EPS = 1e-5f;
constexpr float ALPHA = 1.681792830507429f;
constexpr float QSCALE = 0.17677669529663687f * 1.4426950408889634f;
constexpr int MAXTILES = 680;

constexpr size_t AL(size_t x) { return (x + 255) & ~(size_t)255; }
constexpr size_t WS_CTL = 0, CTL_BYTES = 1u << 17;
constexpr size_t WS_X = WS_CTL + CTL_BYTES;
constexpr size_t WS_H = WS_X + AL((size_t)RTOT * DM * 4);
constexpr size_t WS_MOD = WS_H + AL((size_t)RTOT * DM * 2);
constexpr size_t WS_HCL = WS_MOD + AL((size_t)DEPTH * 5 * 6144 * 4);
constexpr size_t WS_HCC = WS_HCL + AL((size_t)DEPTH * 4 * 256 * SEQ * 4);
constexpr size_t WS_INVL1 = WS_HCC + AL((size_t)DEPTH * 4 * 256 * CTXL * 4);
constexpr size_t WS_DFTL = WS_INVL1 + AL((size_t)DEPTH * 2 * 2 * 256 * 4);
constexpr size_t WS_DFTC = WS_DFTL + 256;
constexpr size_t WS_ROPE = WS_DFTC + AL((size_t)CTXL * 2 * CTXL * 2);
constexpr size_t WS_LAM = WS_ROPE + AL(64 * 8 * 2 * 4);
constexpr size_t WS_WIN = WS_LAM + 256;
constexpr size_t WS_WOUT = WS_WIN + AL((size_t)NWIN * DM * 2);
constexpr size_t WS_WGU = WS_WOUT + AL((size_t)DM * DM * 2);
constexpr size_t WS_WD = WS_WGU + AL((size_t)65 * 512 * DM * 2);
constexpr size_t WS_TOPE = WS_WD + AL((size_t)65 * DM * DEXP * 2);
constexpr size_t WS_TOPG = WS_TOPE + AL((size_t)RTOT * 8 * 4);
constexpr size_t WS_LIST = WS_TOPG + AL((size_t)RTOT * 8 * 4);
constexpr size_t WS_SPEC = WS_LIST + AL((size_t)NEXP * RTOT * 4);
constexpr size_t WS_Z1 = WS_SPEC + AL((size_t)256 * 2 * 8192 * 8);
constexpr size_t WS_U = WS_Z1 + AL((size_t)256 * SEQ * 4 * 4);
constexpr size_t WS_Q = WS_U;
constexpr size_t WS_K = WS_Q + AL((size_t)NB * 8 * POS * 64 * 2);
constexpr size_t WS_V = WS_K + AL((size_t)NB * 8 * POS * 64 * 2);
constexpr size_t WS_HYT = WS_V + AL((size_t)NB * 8 * POS * 64 * 2);
constexpr size_t WS_YTL = WS_HYT + AL((size_t)NB * 768 * POS * 4);
constexpr size_t WS_YTC = WS_YTL + AL((size_t)1024 * 8192 * 2);
constexpr size_t WS_MIX = WS_YTC + AL((size_t)1024 * 512 * 2);
constexpr size_t WS_U1_END = WS_MIX + AL((size_t)RTOT * DM * 2);
constexpr size_t WS_ACT = WS_U;
constexpr size_t WS_YB = WS_ACT + AL((size_t)MAXTILES * 256 * DEXP * 2);
constexpr size_t WS_U2_END = WS_YB + AL((size_t)MAXTILES * 256 * DM * 2);
constexpr size_t WS_END = WS_U2_END > WS_U1_END ? WS_U2_END : WS_U1_END;

constexpr int CW_BAR = 0;
constexpr int CW_ATTN = 4096;
constexpr int CW_PREPQ = 4096 + 1024;
constexpr int CW_PREPQ2 = 4096 + 1536;
constexpr int CW_PREPQ3 = 4096 + 2048;
constexpr int CW_PREPQ4 = 4096 + 2560;
constexpr int PREP_SPLIT2 = 2640;
constexpr int PREP_SPLIT = 1200;
constexpr int CW_KMAX = 4096 + 512;
constexpr int CW_CNT = 8192;
constexpr int CNT_STRIDE = 64;

DI unsigned cvt_pk_bf16(float lo, float hi) { unsigned r; asm volatile("v_cvt_pk_bf16_f32 %0, %1, %2" : "=v"(r) : "v"(lo), "v"(hi)); return r; }
DI bf16x8 pack8(float a0, float a1, float a2, float a3, float a4, float a5, float a6, float a7) {
    u32x4 p;
    asm volatile("v_cvt_pk_bf16_f32 %0, %4, %5\n\tv_cvt_pk_bf16_f32 %1, %6, %7\n\tv_cvt_pk_bf16_f32 %2, %8, %9\n\tv_cvt_pk_bf16_f32 %3, %10, %11\n\ts_nop 1"
                 : "=&v"(p[0]), "=&v"(p[1]), "=&v"(p[2]), "=&v"(p[3]) : "v"(a0), "v"(a1), "v"(a2), "v"(a3), "v"(a4), "v"(a5), "v"(a6), "v"(a7));
    return __builtin_bit_cast(bf16x8, p);
}
DI bf16_t f2bf(float x) { return (bf16_t)(cvt_pk_bf16(x, 0.f) & 0xffffu); }
DI float bf2f(unsigned short u) { return __uint_as_float(((unsigned)u) << 16); }
DI float bflo(unsigned w) { return __uint_as_float(w << 16); }
DI float bfhi(unsigned w) { return __uint_as_float(w & 0xffff0000u); }
DI float wave_sum(float v) {
#pragma unroll
    for (int o = 32; o >= 1; o >>= 1) v += __shfl_xor(v, o);
    return v;
}
DI float wave_max(float v) {
#pragma unroll
    for (int o = 32; o >= 1; o >>= 1) v = fmaxf(v, __shfl_xor(v, o));
    return v;
}

#define XB_TMO      128
#define XB_XCNT(j)  (256  + 64 * (j))
#define XB_XSUB(j)  (1280 + 64 * (j))
#define XB_XGEN(j)  (2304 + 64 * (j))
#define XB_TOP      3328
#define XB_TOPGEN   3392
#define XCD_BAR_WORDS 3456
#define XB_SPIN_CAP (1u << 18)

__device__ __forceinline__ unsigned xb_ld(unsigned* p)              { return __hip_atomic_load(p, __ATOMIC_RELAXED, __HIP_MEMORY_SCOPE_AGENT); }
__device__ __forceinline__ unsigned xb_add(unsigned* p, unsigned v) { return __hip_atomic_fetch_add(p, v, __ATOMIC_RELAXED, __HIP_MEMORY_SCOPE_AGENT); }
__device__ __forceinline__ unsigned xb_xcc_id() { return (unsigned)__builtin_amdgcn_s_getreg((3 << 11) | 20) & 0xFu; }
#define XB_SPIN(cond, bar) do { unsigned _sp = 0; while (cond) { __builtin_amdgcn_s_sleep(1); \
    if ((++_sp & 255u) == 0u) { if (xb_ld(&(bar)[XB_TMO])) break; if (_sp > XB_SPIN_CAP) { atomicAdd(&(bar)[XB_TMO], 1u); break; } } } } while (0)

struct XcdBarrier { unsigned* bar; unsigned x; volatile LAS unsigned* st; };

__device__ __forceinline__ XcdBarrier xcd_barrier_post(unsigned* bar, volatile LAS unsigned* st) {
    XcdBarrier b; b.bar = bar; b.x = xb_xcc_id(); b.st = st;
    if (threadIdx.x == 0) (void)xb_add(&bar[XB_XCNT(b.x)], 1u);
    return b;
}
__device__ __forceinline__ void xcd_barrier_complete(unsigned* bar, unsigned x, unsigned& nloc, unsigned& nx) {
    const unsigned G = gridDim.x * gridDim.y * gridDim.z;
    unsigned sum, cnt, mine, sp = 0u;
    for (;;) {
        sum = 0u; cnt = 0u; mine = 0u;
#pragma unroll
        for (unsigned j = 0; j < 16; ++j) { const unsigned c = xb_ld(&bar[XB_XCNT(j)]); sum += c; cnt += (c > 0u) ? 1u : 0u; mine = (j == x) ? c : mine; }
        if (sum == G) break;
        __builtin_amdgcn_s_sleep(1);
        if ((++sp & 255u) == 0u) { if (xb_ld(&bar[XB_TMO])) break; if (sp > XB_SPIN_CAP) { atomicAdd(&bar[XB_TMO], 1u); break; } }
    }
    nloc = mine > 0u ? mine : 1u; nx = cnt > 0u ? cnt : 1u;
}
__device__ __forceinline__ void xcd_barrier(const XcdBarrier& b) {
    asm volatile("s_waitcnt vmcnt(0)" ::: "memory");
    __syncthreads();
    if (threadIdx.x == 0) {
        unsigned* bar = b.bar;
        __builtin_amdgcn_s_waitcnt(0);
        unsigned nloc = b.st[0], nx = b.st[1];
        if (nloc == 0u) { xcd_barrier_complete(bar, b.x, nloc, nx); b.st[0] = nloc; b.st[1] = nx; }
        const unsigned old = xb_add(&bar[XB_XSUB(b.x)], 1u);
        const unsigned gen = old / nloc;
        if (old + 1u == (gen + 1u) * nloc) {
            __builtin_amdgcn_fence(__ATOMIC_RELEASE, "agent");
            asm volatile("s_waitcnt vmcnt(0)" ::: "memory");
            const unsigned og = xb_add(&bar[XB_TOP], 1u);
            const unsigned tg = og / nx;
            if (og + 1u == (tg + 1u) * nx) xb_add(&bar[XB_TOPGEN], 1u);
            else XB_SPIN(xb_ld(&bar[XB_TOPGEN]) == tg, bar);
            __builtin_amdgcn_fence(__ATOMIC_ACQUIRE, "agent");
            xb_add(&bar[XB_XGEN(b.x)], 1u);
            asm volatile("s_waitcnt vmcnt(0)" ::: "memory");
        } else {
            XB_SPIN(xb_ld(&bar[XB_XGEN(b.x)]) == gen, bar);
            __builtin_amdgcn_fence(__ATOMIC_ACQUIRE, "agent");
            asm volatile("s_waitcnt vmcnt(0)" ::: "memory");
        }
    }
    __syncthreads();
}

namespace pg8 {
constexpr int BM = 256, BK = 64, HALF = 128, HTB = HALF * BK * 2, STAGE_BYTES = 8 * HTB, NXCD = 8, WGM = 8;
__host__ __device__ __forceinline__ int lds_byte(int r, int c) { const int st = (r >> 4) * 2 + (c >> 5), rr = r & 15, cc = c & 31, ob = rr * 64 + cc * 2; return st * 1024 + (ob ^ (((ob >> 9) & 1) << 5)); }
__host__ __device__ __forceinline__ void stage_rc(int b, int& R, int& C) { const int st = b / 1024, sb = b % 1024, swz = sb ^ (((sb >> 9) & 1) << 5); R = (st >> 1) * 16 + swz / 64; C = (st & 1) * 32 + (swz % 64) / 2; }
__host__ __device__ __forceinline__ int perm32(int rho) { const int n = rho >> 4, i = rho & 15; return 8 * (i >> 2) + 4 * n + (i & 3); }

struct Unit { int pm, pn, e, lt; };
struct Gemm { const bf16_t* A; const bf16_t* Bt; int K; int tid; };

struct StaticOrder {
    static constexpr bool GATHER = false;
    int nM, nN, nwg, G, c;
    __device__ void init(int nM_, int nN_, int G_, int c_) { nM = nM_; nN = nN_; nwg = nM * nN; G = G_; c = c_; }
    __device__ bool next(int i, Unit& u) const {
        const long L = (long)i * G + c; if (L >= nwg) return false;
        int wgid = (int)L; { const int q = nwg / NXCD, r = nwg % NXCD, xcd = wgid % NXCD, off = wgid / NXCD; wgid = (xcd < r ? xcd * (q + 1) : r * (q + 1) + (xcd - r) * q) + off; }
        const int nig = WGM * nN, gid = wgid / nig, fm = gid * WGM, gsz = (nM - fm) < WGM ? (nM - fm) : WGM;
        u.pm = fm + ((wgid % nig) % gsz); u.pn = (wgid % nig) / gsz; u.e = 0; u.lt = 0; return true;
    }
    __device__ __forceinline__ int arow(const Unit& u, int r) const { return u.pm * BM + r; }
};

template <class Epi, class Sched>
__device__ __forceinline__ void gemm_phase(LAS unsigned char* lds, const Gemm g, const Sched& S, const Epi& E) {
    constexpr bool GA = Sched::GATHER;
    int tid = g.tid; asm volatile("" : "+v"(tid));
    const int wid = __builtin_amdgcn_readfirstlane(tid >> 6), lane = tid & 63, wr = wid >> 2, wc = wid & 3, fr = lane & 15, fq = lane >> 4;
    int K = g.K;
#if PG8_OPAQUE_K
    asm volatile("" : "+s"(K));
#endif
    const int nt = K / BK;
    unsigned voffA[2], voffB[2];
#pragma unroll
    for (int i = 0; i < 2; ++i) { int R, C; stage_rc(tid * 16 + i * 8192, R, C); const int Rb = Epi::PERM ? ((R & ~31) + perm32(R & 31)) : R;
        voffA[i] = (unsigned)(R * K + C) * 2u; voffB[i] = (unsigned)(Rb * K + C) * 2u; }
    const size_t kstep = (size_t)(BK * 2);
    const size_t hstep = (size_t)HALF * K * 2;
    const size_t tstep = 2 * hstep;
    const unsigned ldsw = (unsigned)wid * 1024u;
    const int aoff = lds_byte(wr * 64 + fr, fq * 8), boff = lds_byte(wc * 32 + fr, fq * 8);
#define PG8_SA(b, h) (((b) * 2 + (h)) * HTB)
#define PG8_SB(b, h) ((4 + (b) * 2 + (h)) * HTB)
#define PG8_STAGE(bufoff, gbase, voff) do { _Pragma("unroll") for (int _i = 0; _i < 2; ++_i) \
        __builtin_amdgcn_global_load_lds((const unsigned*)((const char*)(gbase) + (voff)[_i]), (LAS unsigned*)(lds + (bufoff) + ldsw + _i * 8192), 16, 0, 0); } while (0)
#define PG8_STAGEA(bufoff, gbase, o0, o1) do { \
        __builtin_amdgcn_global_load_lds((const unsigned*)((const char*)(gbase) + (o0)), (LAS unsigned*)(lds + (bufoff) + ldsw), 16, 0, 0); \
        __builtin_amdgcn_global_load_lds((const unsigned*)((const char*)(gbase) + (o1)), (LAS unsigned*)(lds + (bufoff) + ldsw + 8192), 16, 0, 0); } while (0)
#define PG8_STA(bufoff, sp, gp, o0, o1) do { if constexpr (GA) PG8_STAGEA(bufoff, gp, o0, o1); else PG8_STAGE(bufoff, sp, voffA); } while (0)
#define PG8_LDA(dst, b, h) do { _Pragma("unroll") for (int m = 0; m < 4; ++m) _Pragma("unroll") for (int k = 0; k < 2; ++k) dst[m][k] = *(const LAS bf16x8*)(lds + PG8_SA(b, h) + aoff + m * 2048 + k * 1024); } while (0)
#define PG8_LDB(dst, b, h) do { _Pragma("unroll") for (int n = 0; n < 2; ++n) _Pragma("unroll") for (int k = 0; k < 2; ++k) dst[n][k] = *(const LAS bf16x8*)(lds + PG8_SB(b, h) + boff + n * 2048 + k * 1024); } while (0)
#define PG8_MMA(ai, bj, At, Bt) do { __builtin_amdgcn_s_setprio(1); _Pragma("unroll") for (int m = 0; m < 4; ++m) _Pragma("unroll") for (int n = 0; n < 2; ++n) _Pragma("unroll") for (int k = 0; k < 2; ++k) \
        acc[ai][bj][m][n] = __builtin_amdgcn_mfma_f32_16x16x32_bf16(Bt[n][k], At[m][k], acc[ai][bj][m][n], 0, 0, 0); __builtin_amdgcn_s_setprio(0); } while (0)
#define PG8_WAIT_V(n) asm volatile("s_waitcnt vmcnt(" #n ")" ::: "memory")
#define PG8_WAIT_L(n) asm volatile("s_waitcnt lgkmcnt(" #n ")" ::: "memory")
#define PG8_BAR __builtin_amdgcn_s_barrier()
#define PG8_SCHED __builtin_amdgcn_sched_barrier(0)
#define PG8_GOFF(u, o00, o01, o10, o11) do { int _tz = g.tid; asm volatile("" : "+v"(_tz)); int _R0, _C0, _R1, _C1; stage_rc(_tz * 16, _R0, _C0); stage_rc(_tz * 16 + 8192, _R1, _C1); \
        o00 = (unsigned)(S.arow(u, _R0) * K + _C0) * 2u; o01 = (unsigned)(S.arow(u, _R1) * K + _C1) * 2u; \
        o10 = (unsigned)(S.arow(u, HALF + _R0) * K + _C0) * 2u; o11 = (unsigned)(S.arow(u, HALF + _R1) * K + _C1) * 2u; } while (0)
    Unit cur, nxt; int ui = 0;
    if (!S.next(0, cur)) return;
    f32x4 acc[2][2][4][2];
#pragma unroll
    for (int a = 0; a < 2; ++a)
#pragma unroll
        for (int b = 0; b < 2; ++b)
#pragma unroll
            for (int m = 0; m < 4; ++m)
#pragma unroll
                for (int n = 0; n < 2; ++n) acc[a][b][m][n] = (f32x4){0.f, 0.f, 0.f, 0.f};
    bf16x8 At[4][2], B0[2][2], B1[2][2];
    const char* const gA = (const char*)g.A;
    unsigned c00 = 0, c01 = 0, c10 = 0, c11 = 0, n00 = 0, n01 = 0, n10 = 0, n11 = 0;
    if constexpr (GA) PG8_GOFF(cur, c00, c01, c10, c11);
    const char* cA = gA + (GA ? (size_t)0 : (size_t)cur.pm * tstep); const char* cB = (const char*)g.Bt + (size_t)cur.pn * tstep;
    PG8_STAGE(PG8_SB(0, 0), cB, voffB); PG8_STAGE(PG8_SB(0, 1), cB + hstep, voffB); PG8_STA(PG8_SA(0, 0), cA, gA, c00, c01); PG8_STA(PG8_SA(0, 1), cA + hstep, gA, c10, c11);
    if (wr == 1) PG8_BAR;
    PG8_WAIT_V(2); PG8_BAR;
    PG8_STAGE(PG8_SB(1, 0), cB + kstep, voffB); PG8_STA(PG8_SA(1, 0), cA + kstep, gA + kstep, c00, c01); PG8_STAGE(PG8_SB(1, 1), cB + hstep + kstep, voffB);
    PG8_WAIT_V(6); PG8_BAR;
    for (;;) {
        const bool has_next = S.next(ui + 1, nxt);
        const char* nA = (has_next && !GA) ? gA + (size_t)nxt.pm * tstep : cA; const char* nB = has_next ? (const char*)g.Bt + (size_t)nxt.pn * tstep : cB;
        if constexpr (GA) { if (has_next) PG8_GOFF(nxt, n00, n01, n10, n11); else { n00 = c00; n01 = c01; n10 = c10; n11 = c11; } }
#pragma unroll 1
        for (int t = 0; t < nt; t += 2) {
            const bool last = (t == nt - 2);
            const char* a1 = cA + (size_t)(t + 1) * kstep;
            const char* a2 = last ? nA : cA + (size_t)(t + 2) * kstep; const char* b2 = last ? nB : cB + (size_t)(t + 2) * kstep;
            const char* a3 = a2 + kstep; const char* b3 = b2 + kstep;
            unsigned x00 = 0, x01 = 0, x10 = 0, x11 = 0;
            if constexpr (GA) { x00 = last ? n00 : c00; x01 = last ? n01 : c01; x10 = last ? n10 : c10; x11 = last ? n11 : c11; }
            PG8_LDB(B0, 0, 0); PG8_LDB(B1, 0, 1); PG8_SCHED; PG8_LDA(At, 0, 0); PG8_STA(PG8_SA(1, 1), a1 + hstep, a1, c10, c11);
            PG8_WAIT_V(8); PG8_WAIT_L(0); PG8_BAR; PG8_MMA(0, 0, At, B0); PG8_MMA(0, 1, At, B1); PG8_BAR; PG8_SCHED;
            PG8_LDA(At, 0, 1); PG8_STAGE(PG8_SB(0, 0), b2, voffB); PG8_STAGE(PG8_SB(0, 1), b2 + hstep, voffB); PG8_STA(PG8_SA(0, 0), a2, a2, x00, x01);
            PG8_WAIT_V(8); PG8_WAIT_L(0); PG8_BAR; PG8_MMA(1, 0, At, B0); PG8_MMA(1, 1, At, B1); PG8_BAR; PG8_SCHED;
            PG8_LDB(B0, 1, 0); PG8_LDB(B1, 1, 1); PG8_SCHED; PG8_LDA(At, 1, 0); PG8_STA(PG8_SA(0, 1), a2 + hstep, a2, x10, x11);
            PG8_WAIT_V(8); PG8_WAIT_L(0); PG8_BAR; PG8_MMA(0, 0, At, B0); PG8_MMA(0, 1, At, B1); PG8_BAR; PG8_SCHED;
            PG8_LDA(At, 1, 1); PG8_STAGE(PG8_SB(1, 0), b3, voffB); PG8_STAGE(PG8_SB(1, 1), b3 + hstep, voffB); PG8_STA(PG8_SA(1, 0), a3, a3, x00, x01);
            PG8_WAIT_V(8); PG8_WAIT_L(0); PG8_BAR; PG8_MMA(1, 0, At, B0); PG8_MMA(1, 1, At, B1); PG8_BAR; PG8_SCHED;
        }
        if (wr == 0) PG8_BAR;
        { int ln = (int)__builtin_amdgcn_mbcnt_hi(~0u, __builtin_amdgcn_mbcnt_lo(~0u, 0u)); asm volatile("" : "+v"(ln));
          E(acc, cur, wr, wc, ln & 15, ln >> 4); }
        if (!has_next) break;
#pragma unroll
        for (int a = 0; a < 2; ++a)
#pragma unroll
            for (int b = 0; b < 2; ++b)
#pragma unroll
                for (int m = 0; m < 4; ++m)
#pragma unroll
                    for (int n = 0; n < 2; ++n) acc[a][b][m][n] = (f32x4){0.f, 0.f, 0.f, 0.f};
        cur = nxt; cA = nA; cB = nB; ++ui;
        if constexpr (GA) { c00 = n00; c01 = n01; c10 = n10; c11 = n11; }
        if (wr == 1) PG8_BAR;
    }
    PG8_WAIT_V(0);
    PG8_BAR;
#undef PG8_SA
#undef PG8_SB
#undef PG8_STAGE
#undef PG8_STAGEA
#undef PG8_STA
#undef PG8_GOFF
#undef PG8_LDA
#undef PG8_LDB
#undef PG8_MMA
#undef PG8_WAIT_V
#undef PG8_WAIT_L
#undef PG8_BAR
#undef PG8_SCHED
}
}

constexpr int NTHR = 512;
constexpr int LDS_SCRATCH = 139264;
constexpr int LDS_MISC = LDS_SCRATCH;
constexpr int LDS_TAB = LDS_MISC + 256;
constexpr int LDS_BYTES = LDS_TAB + 8192;

struct Params { const float* in[34]; float* out; unsigned char* ws; int ph_lo, ph_hi; };

struct Frame {
    const float* const* in; float* out; unsigned char* ws; LAS unsigned char* lds; unsigned* ctl;
    int tid, lane, wave, G, bid;
};

DI int row_b(int row) { return row < RLAT ? (row >> 12) : ((row - RLAT) >> 8); }
DI int row_pos(int row) { return row < RLAT ? (row & 4095) : (SEQ + ((row - RLAT) & 255)); }
DI int row_modsel(int row) { return row < RLAT ? (row >> 12) : 4; }

DI Frame relaunder(const Frame& F0) {
    Frame F = F0; int wv = F0.wave; asm volatile("" : "+s"(wv));
    int ln = (int)__builtin_amdgcn_mbcnt_hi(~0u, __builtin_amdgcn_mbcnt_lo(~0u, 0u)); asm volatile("" : "+v"(ln));
    F.wave = wv; F.lane = ln; F.tid = wv * 64 + ln;
    unsigned char* w = F0.ws; asm volatile("" : "+s"(w)); F.ws = w; F.ctl = (unsigned*)(w + WS_CTL);
    int b = F0.bid, g = F0.G; asm volatile("" : "+s"(b), "+s"(g)); F.bid = b; F.G = g;
    return F;
}

DI void prep_tile(const Frame& F, const float* src, int ldn, int k0, int n0, bf16_t* dst, int ldk, int dst_row0) {
    LAS float* T = (LAS float*)F.lds;
    const int t = F.tid;
    { const float* p = src + (size_t)(k0 + (t >> 3)) * ldn + n0 + (t & 7) * 8;
      const f32x4 a = *(const f32x4*)p, b = *(const f32x4*)(p + 4);
      LAS float* q = T + (t >> 3) * 65 + (t & 7) * 8;
      q[0] = a[0]; q[1] = a[1]; q[2] = a[2]; q[3] = a[3]; q[4] = b[0]; q[5] = b[1]; q[6] = b[2]; q[7] = b[3]; }
    __syncthreads();
    { const int nn = t >> 3, kc = (t & 7) * 8; float v[8];
#pragma unroll
      for (int j = 0; j < 8; ++j) v[j] = T[(kc + j) * 65 + nn];
      u32x4 w; w.x = cvt_pk_bf16(v[0], v[1]); w.y = cvt_pk_bf16(v[2], v[3]); w.z = cvt_pk_bf16(v[4], v[5]); w.w = cvt_pk_bf16(v[6], v[7]);
      *(u32x4*)(dst + (size_t)(dst_row0 + nn) * ldk + k0 + kc) = w; }
    __syncthreads();
}

DI void prep_fourier_job(const Frame& F, int ly, int g, int kt) {
    LAS float* FW = (LAS float*)F.lds;
    LAS float* CS = FW + 4096;
    LAS float* P = CS + 128;
    LAS float* W = P + 8192;
    const int t = F.tid;
    const float* fw = F.in[21] + ((size_t)ly * 4 + g) * 4096;
    for (int i = t; i < 4096; i += NTHR) FW[i] = fw[i];
    if (t < 64) { float s, c; sincospif((float)t / 32.0f, &s, &c); CS[t] = c; CS[64 + t] = s; }
    { const float* p = F.in[6] + (size_t)ly * DM * DIN + (size_t)(kt * 64 + (t >> 3)) * DIN + 2304 + g * 64 + (t & 7) * 8;
      const f32x4 a = *(const f32x4*)p, b = *(const f32x4*)(p + 4);
      LAS float* q = W + (t >> 3) * 65 + (t & 7) * 8;
      q[0] = a[0]; q[1] = a[1]; q[2] = a[2]; q[3] = a[3]; q[4] = b[0]; q[5] = b[1]; q[6] = b[2]; q[7] = b[3]; }
    __syncthreads();
    for (int i = t; i < 8192; i += NTHR) {
        const int c = i >> 7, n = i & 127, comp = n >> 6, d = n & 63;
        float s = 0.f;
        for (int j = 0; j < 64; ++j) { const int a = (j * c) & 63; const float tr = comp ? -CS[64 + a] : CS[a]; s += tr * FW[j * 64 + d]; }
        P[c * 128 + n] = s;
    }
    __syncthreads();
    bf16_t* dst = (bf16_t*)(F.ws + WS_WIN);
    { const int k = t >> 3, nb = (t & 7) * 16;
      float o[16];
#pragma unroll
      for (int j = 0; j < 16; ++j) o[j] = 0.f;
      for (int c = 0; c < 64; ++c) { const float w = W[k * 65 + c];
#pragma unroll
          for (int j = 0; j < 16; ++j) o[j] += w * P[c * 128 + nb + j]; }
#pragma unroll
      for (int j = 0; j < 16; ++j) { const int n = nb + j, comp = n >> 6, d = n & 63;
          dst[(size_t)(2304 + comp * 256 + g * 64 + d) * DM + kt * 64 + k] = f2bf(o[j]); } }
    __syncthreads();
}

struct PrepJob { const float* src; bf16_t* dst; int ldn, ldk, row0, hi_step; };
DI PrepJob prep_job(const Frame& F, int ly, int j) {
    constexpr int J1 = 144, J2 = J1 + 64, J3 = J2 + 1040, J4 = J3 + 1040;
    PrepJob r;
    if (j < J1) { const int kb = j / 9, nb = j % 9;
        r.src = F.in[6] + (size_t)ly * DM * DIN + (size_t)kb * 64 * DIN + nb * 256; r.ldn = DIN; r.dst = (bf16_t*)(F.ws + WS_WIN) + kb * 64; r.ldk = DM; r.row0 = nb * 256; r.hi_step = 128;
    } else if (j < J2) { const int q = j - J1, kb = q >> 2, nb = q & 3;
        r.src = F.in[7] + (size_t)ly * DM * DM + (size_t)kb * 64 * DM + nb * 256; r.ldn = DM; r.dst = (bf16_t*)(F.ws + WS_WOUT) + kb * 64; r.ldk = DM; r.row0 = nb * 256; r.hi_step = 128;
    } else if (j < J4) { const bool up = j >= J3; const int q = j - (up ? J3 : J2), e = q >> 4, kb = q & 15;
        const float* src = e < NEXP ? F.in[up ? 29 : 28] + ((size_t)ly * NEXP + e) * DM * DEXP : F.in[up ? 32 : 31] + (size_t)ly * DM * DEXP;
        r.src = src + (size_t)kb * 64 * DEXP; r.ldn = DEXP; r.dst = (bf16_t*)(F.ws + WS_WGU) + kb * 64; r.ldk = DM; r.row0 = e * 512 + (up ? 128 : 0); r.hi_step = 256;
    } else { const int q = j - J4, e = q >> 4, kb = (q >> 2) & 3, nb = q & 3;
        const float* src = e < NEXP ? F.in[30] + ((size_t)ly * NEXP + e) * DEXP * DM : F.in[33] + (size_t)ly * DEXP * DM;
        r.src = src + (size_t)kb * 64 * DM + nb * 256; r.ldn = DM; r.dst = (bf16_t*)(F.ws + WS_WD) + kb * 64; r.ldk = DEXP; r.row0 = e * DM + nb * 256; r.hi_step = 128; }
    return r;
}
DI void prep_load(const Frame& F, const PrepJob& jb, f32x4 (&v)[8]) {
    const float* p = jb.src + (size_t)(8 * (F.tid >> 6)) * jb.ldn + 4 * (F.tid & 63);
#pragma unroll
    for (int i = 0; i < 8; ++i) v[i] = *(const f32x4*)(p + (size_t)i * jb.ldn);
}
DI void prep_store(const Frame& F, const PrepJob& jb, const f32x4 (&v)[8]) {
    LAS unsigned char* T = F.lds;
    const int t = F.tid, ln = t & 63, w = t >> 6;
#pragma unroll
    for (int pr = 0; pr < 4; ++pr)
#pragma unroll
        for (int e = 0; e < 4; ++e) *(LAS unsigned*)(T + (4 * ln + e) * 132 + (8 * w + 2 * pr) * 2) = cvt_pk_bf16(v[2 * pr][e], v[2 * pr + 1][e]);
    asm volatile("s_waitcnt lgkmcnt(0)" ::: "memory"); __builtin_amdgcn_s_barrier();
#pragma unroll
    for (int q = 0; q < 4; ++q) { const int n = q * 64 + (t >> 3), ch = t & 7;
        const LAS unsigned* r = (const LAS unsigned*)(T + n * 132 + ch * 16);
        u32x4 o; o.x = r[0]; o.y = r[1]; o.z = r[2]; o.w = r[3];
        *(u32x4*)(jb.dst + (size_t)(jb.row0 + (n >> 7) * jb.hi_step + (n & 127)) * jb.ldk + ch * 8) = o; }
    asm volatile("s_waitcnt lgkmcnt(0)" ::: "memory"); __builtin_amdgcn_s_barrier();
}
DI void prep_small(const Frame& F, int ly) {
    for (int j = F.bid; j < 208; j += F.G) { const PrepJob jb = prep_job(F, ly, j); f32x4 v[8]; prep_load(F, jb, v); prep_store(F, jb, v); }
    for (int q = F.G - 1 - F.bid; q < 64; q += F.G) prep_fourier_job(F, ly, q >> 4, q & 15);
}
DI void prep_small_dyn(const Frame& F0, int ly) {
    const Frame F = relaunder(F0);
    volatile LAS unsigned* MISC = (volatile LAS unsigned*)(F.lds + LDS_MISC);
    for (;;) {
        __syncthreads();
        if (F.tid == 0) MISC[18] = atomicAdd(F.ctl + CW_PREPQ3 + 64 * ly, 1u);
        __syncthreads();
        const int j = (int)MISC[18];
        if (j >= 272) break;
        if (j < 64) prep_fourier_job(F, ly, j >> 4, j & 15);
        else { const PrepJob jb = prep_job(F, ly, j - 64); f32x4 v[8]; prep_load(F, jb, v); prep_store(F, jb, v); }
    }
}
constexpr int PREP_CHUNK = 2, PREP_NJOBS = 3 * 1040;
DI void prep_experts(const Frame& F0, int ly, int cw, int j_lo, int j_hi) {
    const Frame F = relaunder(F0);
    volatile LAS unsigned* MISC = (volatile LAS unsigned*)(F.lds + LDS_MISC);
    for (;;) {
        __syncthreads();
        if (F.tid == 0) MISC[17] = atomicAdd(F.ctl + cw + 64 * ly, (unsigned)PREP_CHUNK);
        __syncthreads();
        const int base = j_lo + (int)MISC[17];
        if (base >= j_hi) break;
        const int end = base + PREP_CHUNK < j_hi ? base + PREP_CHUNK : j_hi;
        int j = base;
        PrepJob cur = prep_job(F, ly, 208 + j); f32x4 va[8]; prep_load(F, cur, va);
#pragma unroll 1
        for (;;) {
            const int jn = j + 1; const bool more = jn < end;
            PrepJob nxt = cur; f32x4 vb[8];
            if (more) { nxt = prep_job(F, ly, 208 + jn); prep_load(F, nxt, vb); }
            prep_store(F, cur, va);
            if (!more) break;
            cur = nxt; j = jn;
#pragma unroll
            for (int i = 0; i < 8; ++i) va[i] = vb[i];
        }
    }
}

DI void prep_mod(const Frame& F) {
    LAS float* S = (LAS float*)F.lds;
    LAS float* RED = S + 5 * 1024;
    const int t = F.tid;
    bool have_s = false;
    for (int u = F.bid; u < DEPTH * 96; u += F.G) {
        const int ly = u / 96, cg = u % 96;
        if (!have_s) {
            for (int i = t; i < 5 * 1024; i += NTHR) { const int r = i >> 10, k = i & 1023; const float x = r < 4 ? F.in[1][r * DM + k] : F.in[3][k]; S[i] = x / (1.f + expf(-x)); }
            __syncthreads(); have_s = true;
        }
        const int tq = t & 15, tk = t >> 4;
        const float* w = F.in[4] + (size_t)ly * DM * 6144 + cg * 64 + tq * 4;
        f32x4 acc[5];
#pragma unroll
        for (int r = 0; r < 5; ++r) acc[r] = (f32x4){0.f, 0.f, 0.f, 0.f};
#pragma unroll 1
        for (int k8 = 0; k8 < 32; k8 += 8) { f32x4 wv[8];
#pragma unroll
            for (int q = 0; q < 8; ++q) wv[q] = *(const f32x4*)(w + (size_t)(tk * 32 + k8 + q) * 6144);
#pragma unroll
            for (int q = 0; q < 8; ++q)
#pragma unroll
                for (int r = 0; r < 5; ++r) acc[r] += wv[q] * S[r * 1024 + tk * 32 + k8 + q]; }
#pragma unroll
        for (int r = 0; r < 5; ++r)
#pragma unroll
            for (int j = 0; j < 4; ++j) RED[(tk * 5 + r) * 64 + tq * 4 + j] = acc[r][j];
        __syncthreads();
        if (t < 320) { const int r = t >> 6, c = t & 63; float s = 0.f;
            for (int q = 0; q < 32; ++q) s += RED[(q * 5 + r) * 64 + c];
            const int col = cg * 64 + c;
            ((float*)(F.ws + WS_MOD))[((size_t)ly * 5 + r) * 6144 + col] = s + F.in[5][(size_t)ly * 6144 + col]; }
        __syncthreads();
    }
}

DI void prep_filters(const Frame& F) {
    LAS float* Z = (LAS float*)F.lds;
    LAS float* A1 = Z + 64 * 33;
    LAS float* A2 = A1 + 4096;
    for (int u = F.G - 1 - F.bid; u < DEPTH * 68; u += F.G) {
        int t = F.tid; asm volatile("" : "+v"(t));
        const int ly = u / 68, ch = u % 68; const bool lat = ch < 64; const int Lx = lat ? SEQ : CTXL, t0 = lat ? ch * 64 : (ch - 64) * 64;
        for (int i = t; i < 64 * 33; i += NTHR) { const int tt = i / 33, f = i % 33; const int ti = t0 + tt;
            float v;
            if (f == 0) v = (float)ti / (float)(Lx - 1);
            else { const int j = (f - 1) & 15; const float fb = 1e-4f + (float)j * ((15.0f - 1e-4f) / 15.0f); const float om = (6.283185307179586f / (float)Lx) * (float)ti;
                   v = f <= 16 ? cosf(fb * om) : -sinf(fb * om); }
            Z[i] = v; }
        __syncthreads();
        const float* w1 = F.in[9] + (size_t)ly * 33 * 64; const float* b1 = F.in[10] + ly * 64; const float* w2 = F.in[11] + (size_t)ly * 4096; const float* b2 = F.in[12] + ly * 64;
        const float* w3 = F.in[13] + (size_t)ly * 64 * 1024; const float* fq = F.in[14] + ly * 64;
        for (int i = t; i < 4096; i += NTHR) { const int tt = i >> 6, h = i & 63; float s = b1[h];
            for (int f = 0; f < 33; ++f) s += Z[tt * 33 + f] * w1[f * 64 + h];
            A1[i] = sinf(fq[h] * s); }
        __syncthreads();
        for (int i = t; i < 4096; i += NTHR) { const int tt = i >> 6, h = i & 63; float s = b2[h];
            for (int j = 0; j < 64; ++j) s += A1[tt * 64 + j] * w2[j * 64 + h];
            A2[i] = sinf(fq[h] * s); }
        __syncthreads();
        { float wr0[64], wr1[64];
#pragma unroll
          for (int j = 0; j < 64; ++j) { wr0[j] = w3[j * 1024 + t]; wr1[j] = w3[j * 1024 + 512 + t]; }
          const int c = t & 255, dir = t >> 8;
          const float delta = fabsf(-3.0701134573253946f + (float)c * ((-15.350567286626973f + 3.0701134573253946f) / 255.0f));
          float* d0 = lat ? (float*)(F.ws + WS_HCL) + ((((size_t)ly * 2 + 0) * 2 + dir) * 256 + c) * SEQ + t0 : (float*)(F.ws + WS_HCC) + ((((size_t)ly * 2 + 0) * 2 + dir) * 256 + c) * CTXL + t0;
          float* d1 = lat ? (float*)(F.ws + WS_HCL) + ((((size_t)ly * 2 + 1) * 2 + dir) * 256 + c) * SEQ + t0 : (float*)(F.ws + WS_HCC) + ((((size_t)ly * 2 + 1) * 2 + dir) * 256 + c) * CTXL + t0;
#pragma unroll 1
          for (int tt = 0; tt < 64; ++tt) { float s0 = 0.f, s1 = 0.f;
#pragma unroll
            for (int j = 0; j < 64; j += 4) { const f32x4 a = *(const LAS f32x4*)(A2 + tt * 64 + j);
                s0 += a[0] * wr0[j] + a[1] * wr0[j + 1] + a[2] * wr0[j + 2] + a[3] * wr0[j + 3]; s1 += a[0] * wr1[j] + a[1] * wr1[j + 1] + a[2] * wr1[j + 2] + a[3] * wr1[j + 3];
                if ((j & 12) == 12) asm volatile("" ::: "memory"); }
            const float dec = expf(-((float)(t0 + tt) / (float)(Lx - 1)) * delta);
            d0[tt] = s0 * dec; d1[tt] = s1 * dec; } }
        __syncthreads();
    }
}

DI void prep_tables(const Frame& F) {
    LAS float* CT = (LAS float*)F.lds;
    const int t = F.tid;
    for (int i = t; i < 4096; i += NTHR) CT[i] = cospif((float)i / 2048.0f);
    __syncthreads();
    bf16_t* DC = (bf16_t*)(F.ws + WS_DFTC);
    for (int i = F.bid * NTHR + t; i < CTXL * 512; i += F.G * NTHR) { const int k = i >> 9, cl = i & 511, comp = cl >> 8, l = cl & 255;
        const int idx = ((k * l) & 255) * 16; DC[i] = f2bf((comp ? CT[(idx - 1024) & 4095] : CT[idx]) * (1.0f / 128.0f)); }
    if (F.bid == (F.G > 1 ? 1 : 0) && t < DEPTH) { const int ly = t; const float lam_init = 0.8f - 0.6f * expf(-0.3f * (float)ly); float s1 = 0.f, s2 = 0.f;
        for (int i = 0; i < 32; ++i) { s1 += F.in[16][ly * 32 + i] * F.in[17][ly * 32 + i]; s2 += F.in[18][ly * 32 + i] * F.in[19][ly * 32 + i]; }
        ((float*)(F.ws + WS_LAM))[2 * ly] = expf(s1) - expf(s2) + lam_init; ((float*)(F.ws + WS_LAM))[2 * ly + 1] = lam_init; }
    if (F.bid == 0) { float* RT = (float*)(F.ws + WS_ROPE);
        for (int i = t; i < 512; i += NTHR) { const int p = i >> 3, n = i & 7; const float inv = powf(10000.0f, -(float)n / 8.0f); float s, c; sincosf((float)p * inv, &s, &c); RT[i * 2] = c; RT[i * 2 + 1] = s; } }
    __syncthreads();
}

DI void prep_copy_x(const Frame& F) {
    f32x4* X = (f32x4*)(F.ws + WS_X);
    const f32x4* x = (const f32x4*)F.in[0]; const f32x4* cx = (const f32x4*)F.in[2];
    const size_t n1 = (size_t)RLAT * DM / 4, n2 = (size_t)RCTX * DM / 4;
    for (size_t i = (size_t)F.bid * NTHR + F.tid; i < n1 + n2; i += (size_t)F.G * NTHR) X[i] = i < n1 ? x[i] : cx[i - n1];
}

DI void prep_invl1(const Frame& F) {
    const int gw = F.bid * 8 + F.wave, nw = F.G * 8;
    for (int j = gw; j < DEPTH * 2 * 2 * 256; j += nw) {
        const int ly = j >> 10, lt = (j >> 9) & 1, n = (j >> 8) & 1, c = j & 255;
        const int Lx = lt ? CTXL : SEQ;
        const float* base = lt ? (const float*)(F.ws + WS_HCC) : (const float*)(F.ws + WS_HCL);
        const f32x4* f0 = (const f32x4*)(base + ((((size_t)ly * 2 + n) * 2 + 0) * 256 + c) * Lx);
        const f32x4* f1 = (const f32x4*)(base + ((((size_t)ly * 2 + n) * 2 + 1) * 256 + c) * Lx);
        float s = 0.f;
        if (lt) { const f32x4 a = f0[F.lane], b = f1[F.lane];
            s = fabsf(a[0]) + fabsf(a[1]) + fabsf(a[2]) + fabsf(a[3]) + (F.lane == 0 ? 0.f : fabsf(b[0])) + fabsf(b[1]) + fabsf(b[2]) + fabsf(b[3]);
        } else { f32x4 a[16], b[16];
#pragma unroll
            for (int q = 0; q < 16; ++q) { a[q] = f0[F.lane + 64 * q]; b[q] = f1[F.lane + 64 * q]; }
#pragma unroll
            for (int q = 0; q < 16; ++q) s += fabsf(a[q][0]) + fabsf(a[q][1]) + fabsf(a[q][2]) + fabsf(a[q][3]) + ((q == 0 && F.lane == 0) ? 0.f : fabsf(b[q][0])) + fabsf(b[q][1]) + fabsf(b[q][2]) + fabsf(b[q][3]); }
        s = wave_sum(s);
        if (F.lane == 0) ((float*)(F.ws + WS_INVL1))[j] = 1.0f / s;
    }
}

DI void ln_stats(const f32x4 (&v)[4], float& mu, float& rstd) {
    float s = 0.f;
#pragma unroll
    for (int j = 0; j < 4; ++j) s += (v[j][0] + v[j][1]) + (v[j][2] + v[j][3]);
    mu = wave_sum(s) * (1.0f / DM);
    float q = 0.f;
#pragma unroll
    for (int j = 0; j < 4; ++j)
#pragma unroll
        for (int e = 0; e < 4; ++e) { const float d = v[j][e] - mu; q += d * d; }
    rstd = rsqrtf(wave_sum(q) * (1.0f / DM) + LN_EPS);
}
DI void ln_mod_store(const f32x4 (&v)[4], const float* sh, const float* sc, bf16_t* hrow, int lane) {
    float mu, rstd; ln_stats(v, mu, rstd);
#pragma unroll
    for (int j = 0; j < 4; ++j) { const int c = 4 * lane + 256 * j; const f32x4 a = *(const f32x4*)(sh + c), b = *(const f32x4*)(sc + c);
        float o[4];
#pragma unroll
        for (int e = 0; e < 4; ++e) o[e] = (v[j][e] - mu) * rstd * (1.f + b[e]) + a[e];
        u32x2 w; w.x = cvt_pk_bf16(o[0], o[1]); w.y = cvt_pk_bf16(o[2], o[3]); *(u32x2*)(hrow + c) = w; }
}

DI void phase_init_h(const Frame& F) {
    const int gw = F.bid * 8 + F.wave, nw = F.G * 8;
    const float* MOD = (const float*)(F.ws + WS_MOD);
    for (int row = gw; row < RTOT; row += nw) {
        const float* xr = row < RLAT ? F.in[0] + (size_t)row * DM : F.in[2] + (size_t)(row - RLAT) * DM;
        f32x4 v[4];
#pragma unroll
        for (int j = 0; j < 4; ++j) v[j] = *(const f32x4*)(xr + 4 * F.lane + 256 * j);
        const float* m = MOD + (size_t)(0 * 5 + row_modsel(row)) * 6144;
        ln_mod_store(v, m, m + 1024, (bf16_t*)(F.ws + WS_H) + (size_t)row * DM, F.lane);
    }
}

struct EpiWin {
    static constexpr bool PERM = true;
    unsigned char* ws; int ly;
    DI void operator()(const f32x4 (&acc)[2][2][4][2], const pg8::Unit& u, int wr, int wc, int fr, int fq) const {
        const bool lat = u.pm < 64; const int b = lat ? (u.pm >> 4) : (u.pm - 64); const int pos0 = lat ? ((u.pm & 15) << 8) : SEQ;
        const int pn = u.pn;
        const float* RT = (const float*)(ws + WS_ROPE);
        float kn[2] = {0.f, 0.f};
#pragma unroll
        for (int ai = 0; ai < 2; ++ai)
#pragma unroll
            for (int m = 0; m < 4; ++m) {
                const int pos = pos0 + ai * 128 + wr * 64 + m * 16 + fr;
#pragma unroll
                for (int bj = 0; bj < 2; ++bj) {
                    const int col = pn * 256 + bj * 128 + wc * 32 + fq * 8;
                    float v[8];
#pragma unroll
                    for (int e = 0; e < 4; ++e) { v[e] = acc[ai][bj][m][0][e]; v[4 + e] = acc[ai][bj][m][1][e]; }
                    if (pn < 3) {
                        float* d = (float*)(ws + WS_HYT) + ((size_t)b * 768 + col) * POS + pos;
#pragma unroll
                        for (int e = 0; e < 8; ++e) d[(size_t)e * POS] = v[e];
                    } else if (pn < 7) {
                        const bool isq = pn < 5; const int cq = col - (isq ? 768 : 1280); const int head = cq >> 6, cc = cq & 63;
                        if (lat) { const int axis = (cc >> 4) & 1, n0 = (cc & 15) >> 1; const int pa = axis ? (pos & 63) : (pos >> 6);
                            const float* rt = RT + (pa * 8 + n0) * 2;
#pragma unroll
                            for (int p = 0; p < 4; ++p) { const float cs = rt[2 * p], sn = rt[2 * p + 1]; const float a = v[2 * p], bb = v[2 * p + 1];
                                v[2 * p] = a * cs - bb * sn; v[2 * p + 1] = a * sn + bb * cs; } }
                        if (isq) {
#pragma unroll
                            for (int e = 0; e < 8; ++e) v[e] *= QSCALE; }
                        u32x4 w; w.x = cvt_pk_bf16(v[0], v[1]); w.y = cvt_pk_bf16(v[2], v[3]); w.z = cvt_pk_bf16(v[4], v[5]); w.w = cvt_pk_bf16(v[6], v[7]);
                        bf16_t* d = (bf16_t*)(ws + (isq ? WS_Q : WS_K)) + (((size_t)b * 8 + head) * POS + pos) * 64 + cc;
                        *(u32x4*)d = w;
                        if (!isq) {
                            float s2 = bflo(w.x) * bflo(w.x) + bfhi(w.x) * bfhi(w.x) + bflo(w.y) * bflo(w.y) + bfhi(w.y) * bfhi(w.y) + bflo(w.z) * bflo(w.z) + bfhi(w.z) * bfhi(w.z) + bflo(w.w) * bflo(w.w) + bfhi(w.w) * bfhi(w.w);
                            s2 += __shfl_xor(s2, 16); s2 += __shfl_xor(s2, 32);
                            kn[bj] = fmaxf(kn[bj], s2); }
                    } else if (pn < 9) {
                        const int cv = col - 1792; const int head = cv >> 6, cc = cv & 63;
                        u32x4 w; w.x = cvt_pk_bf16(v[0], v[1]); w.y = cvt_pk_bf16(v[2], v[3]); w.z = cvt_pk_bf16(v[4], v[5]); w.w = cvt_pk_bf16(v[6], v[7]);
                        *(u32x4*)((bf16_t*)(ws + WS_V) + (((size_t)b * 8 + head) * POS + pos) * 64 + cc) = w;
                    } else {
                        const int cy = col - 2304; const int comp = cy >> 8, gd = cy & 255;
                        if (lat) { bf16_t* d = (bf16_t*)(ws + WS_YTL) + ((size_t)b * 256 + gd) * 8192 + comp * 4096 + pos;
#pragma unroll
                            for (int e = 0; e < 8; ++e) d[(size_t)e * 8192] = f2bf(v[e]);
                        } else { bf16_t* d = (bf16_t*)(ws + WS_YTC) + ((size_t)b * 256 + gd) * 512 + comp * 256 + (pos - SEQ);
#pragma unroll
                            for (int e = 0; e < 8; ++e) d[(size_t)e * 512] = f2bf(v[e]); }
                    }
                }
            }
        if (pn == 5 || pn == 6) {
#pragma unroll
            for (int bj = 0; bj < 2; ++bj) { float m = kn[bj];
                m = fmaxf(m, __shfl_xor(m, 1)); m = fmaxf(m, __shfl_xor(m, 2)); m = fmaxf(m, __shfl_xor(m, 4)); m = fmaxf(m, __shfl_xor(m, 8));
                const int cq = pn * 256 + bj * 128 + wc * 32 - 1280; const int head = cq >> 6, comp = (cq >> 5) & 1;
                if (fr == 0 && fq == 0) atomicMax((unsigned*)(ws + WS_CTL) + CW_KMAX + 64 * ly + (b * 8 + head) * 2 + comp, __float_as_uint(m)); }
        }
    }
};

struct EpiFnet {
    static constexpr bool PERM = true;
    unsigned char* ws; int ctx;
    DI void operator()(const f32x4 (&acc)[2][2][4][2], const pg8::Unit& u, int wr, int wc, int fr, int fq) const {
        const int b = u.pn;
#pragma unroll
        for (int ai = 0; ai < 2; ++ai)
#pragma unroll
            for (int m = 0; m < 4; ++m) {
                const int k = u.pm * 256 + ai * 128 + wr * 64 + m * 16 + fr;
                const size_t row = ctx ? (size_t)(RLAT + b * CTXL + k) : (size_t)(b * SEQ + k);
#pragma unroll
                for (int bj = 0; bj < 2; ++bj) { const int gd = bj * 128 + wc * 32 + fq * 8;
                    const f32x4 v0 = acc[ai][bj][m][0], v1 = acc[ai][bj][m][1];
                    u32x4 w; w.x = cvt_pk_bf16(v0[0], v0[1]); w.y = cvt_pk_bf16(v0[2], v0[3]); w.z = cvt_pk_bf16(v1[0], v1[1]); w.w = cvt_pk_bf16(v1[2], v1[3]);
                    *(u32x4*)((bf16_t*)(ws + WS_MIX) + row * DM + 768 + gd) = w; }
            }
    }
};

struct EpiWout {
    static constexpr bool PERM = false;
    unsigned char* ws; int ly; const float* xlat; const float* xctx;
    DI void operator()(const f32x4 (&acc)[2][2][4][2], const pg8::Unit& u, int wr, int wc, int fr, int fq) const {
        const int msel = u.pm < 64 ? (u.pm >> 4) : 4;
        const float* g1 = (const float*)(ws + WS_MOD) + ((size_t)ly * 5 + msel) * 6144 + 2048;
        const int col0 = u.pn * 256 + wc * 32 + 4 * fq;
        const float* src = ly == 0 ? (u.pm < 64 ? xlat + (size_t)u.pm * 256 * DM : xctx + (size_t)(u.pm - 64) * 256 * DM) : (const float*)(ws + WS_X) + (size_t)u.pm * 256 * DM;
        f32x4 gv[2][2];
#pragma unroll
        for (int bj = 0; bj < 2; ++bj)
#pragma unroll
            for (int n = 0; n < 2; ++n) gv[bj][n] = *(const f32x4*)(g1 + col0 + bj * 128 + n * 16);
#pragma unroll
        for (int ai = 0; ai < 2; ++ai)
#pragma unroll
            for (int m = 0; m < 4; ++m) { const size_t ro = (size_t)(ai * 128 + wr * 64 + m * 16 + fr) * DM + col0;
                float* rowp = (float*)(ws + WS_X) + (size_t)u.pm * 256 * DM + ro;
#pragma unroll
                for (int bj = 0; bj < 2; ++bj)
#pragma unroll
                    for (int n = 0; n < 2; ++n) { const f32x4 xin = *(const f32x4*)(src + ro + bj * 128 + n * 16); *(f32x4*)(rowp + bj * 128 + n * 16) = xin * ALPHA + gv[bj][n] * acc[ai][bj][m][n]; } }
    }
};

struct MoeTab { LAS int* cnt; LAS int* tstart; LAS int* tile_e; int ntiles; };
DI MoeTab moe_tables(const Frame& F, int ly) {
    MoeTab T; T.cnt = (LAS int*)(F.lds + LDS_TAB); T.tstart = T.cnt + 72; T.tile_e = T.tstart + 72;
    __syncthreads();
    if (F.tid < 65) T.cnt[F.tid] = F.tid < NEXP ? (int)__hip_atomic_load(F.ctl + CW_CNT + (ly * 64 + F.tid) * CNT_STRIDE, __ATOMIC_RELAXED, __HIP_MEMORY_SCOPE_AGENT) : (ly == DEPTH - 1 ? RLAT : RTOT);
    __syncthreads();
    if (F.tid == 0) { int s = 0; for (int e = 0; e < 65; ++e) { T.tstart[e] = s; s += (T.cnt[e] + 255) >> 8; } T.tstart[65] = s; }
    __syncthreads();
    const int nt = T.tstart[65];
    for (int e = F.tid; e < 65; e += NTHR) for (int q = T.tstart[e]; q < T.tstart[e + 1]; ++q) if (q < MAXTILES) T.tile_e[q] = e;
    __syncthreads();
    T.ntiles = __builtin_amdgcn_readfirstlane(nt < MAXTILES ? nt : MAXTILES);
    return T;
}
template <bool GATHER_> struct MoeSched {
    static constexpr bool GATHER = GATHER_;
    MoeTab T; const int* list; int G, c, nsub, shift;
    DI bool next(int i, pg8::Unit& u) const {
        const int L = i * G + c; if (L >= T.ntiles * nsub) return false;
        const int tile = L >> shift, j = L & (nsub - 1); const int e = __builtin_amdgcn_readfirstlane(T.tile_e[tile]);
        u.pm = tile; u.pn = e * nsub + j; u.e = e; u.lt = tile - __builtin_amdgcn_readfirstlane(T.tstart[e]); return true;
    }
    DI int arow(const pg8::Unit& u, int r) const {
        if (!GATHER_) return u.pm * 256 + r;
        const int idx = u.lt * 256 + r;
        if (u.e == NEXP) return idx;
        return idx < T.cnt[u.e] ? (list[(size_t)u.e * RTOT + idx] >> 3) : 0;
    }
};
DI float silu_f(float x) { return x / (1.f + __expf(-x)); }
struct EpiMoe1 {
    static constexpr bool PERM = true;
    unsigned char* ws;
    DI void operator()(const f32x4 (&acc)[2][2][4][2], const pg8::Unit& u, int wr, int wc, int fr, int fq) const {
        const int hid = (u.pn & 1) * 128 + wc * 32 + fq * 8;
#pragma unroll
        for (int ai = 0; ai < 2; ++ai)
#pragma unroll
            for (int m = 0; m < 4; ++m) { const size_t row = (size_t)u.pm * 256 + ai * 128 + wr * 64 + m * 16 + fr;
                float o[8];
#pragma unroll
                for (int n = 0; n < 2; ++n)
#pragma unroll
                    for (int e = 0; e < 4; ++e) o[n * 4 + e] = silu_f(acc[ai][0][m][n][e]) * acc[ai][1][m][n][e];
                u32x4 w; w.x = cvt_pk_bf16(o[0], o[1]); w.y = cvt_pk_bf16(o[2], o[3]); w.z = cvt_pk_bf16(o[4], o[5]); w.w = cvt_pk_bf16(o[6], o[7]);
                *(u32x4*)((bf16_t*)(ws + WS_ACT) + row * DEXP + hid) = w; }
    }
};
struct EpiMoe2 {
    static constexpr bool PERM = true;
    unsigned char* ws;
    DI void operator()(const f32x4 (&acc)[2][2][4][2], const pg8::Unit& u, int wr, int wc, int fr, int fq) const {
        const int colb = (u.pn & 3) * 256 + wc * 32 + fq * 8;
#pragma unroll
        for (int ai = 0; ai < 2; ++ai)
#pragma unroll
            for (int m = 0; m < 4; ++m) { const size_t row = (size_t)u.pm * 256 + ai * 128 + wr * 64 + m * 16 + fr;
#pragma unroll
                for (int bj = 0; bj < 2; ++bj) { const f32x4 v0 = acc[ai][bj][m][0], v1 = acc[ai][bj][m][1];
                    u32x4 w; w.x = cvt_pk_bf16(v0[0], v0[1]); w.y = cvt_pk_bf16(v0[2], v0[3]); w.z = cvt_pk_bf16(v1[0], v1[1]); w.w = cvt_pk_bf16(v1[2], v1[3]);
                    *(u32x4*)((bf16_t*)(ws + WS_YB) + row * DM + colb + bj * 128) = w; } }
    }
};

DI float hy_short(const float* hy, int l, int Lx, float w0, float w1, float w2) {
    const float a = l > 0 ? hy[l - 1] : 0.f, b = hy[l], c = l + 1 < Lx ? hy[l + 1] : 0.f;
    return w0 * a + w1 * b + w2 * c;
}
#if 0
DI void hyena_unit(const Frame& F, int ly, int c) {
    LAS float* KF = (LAS float*)F.lds;
    LAS float* U = KF + 16384;
    const int t = F.tid;
    const float* HYT = (const float*)(F.ws + WS_HYT);
    const float* scw = F.in[8] + (size_t)ly * 3 * 768;
    const float* invl = (const float*)(F.ws + WS_INVL1) + (size_t)ly * 1024;
    const float bias0 = F.in[15][(size_t)ly * 512 + c], bias1 = F.in[15][(size_t)ly * 512 + 256 + c];
    float wx1[3], wx2[3], wv[3];
#pragma unroll
    for (int j = 0; j < 3; ++j) { wx1[j] = scw[j * 768 + c]; wx2[j] = scw[j * 768 + 256 + c]; wv[j] = scw[j * 768 + 512 + c]; }
    bf16_t* MIX = (bf16_t*)(F.ws + WS_MIX);
    {
        for (int n = 0; n < 2; ++n) { const float inv = invl[(0 * 2 + n) * 256 + c];
            const float* hf = (const float*)(F.ws + WS_HCL) + ((((size_t)ly * 2 + n) * 2 + 0) * 256 + c) * SEQ;
            const float* hb = (const float*)(F.ws + WS_HCL) + ((((size_t)ly * 2 + n) * 2 + 1) * 256 + c) * SEQ;
            for (int i = t; i < 8192; i += NTHR) { const int d = i - 4096; KF[n * 8192 + i] = d >= 0 ? hf[d] * inv : (d > -4096 ? hb[-d] * inv : 0.f); } }
        for (int i = t; i < 4 * SEQ; i += NTHR) { const int b = i >> 12, l = i & 4095;
            U[l * 4 + b] = hy_short(HYT + ((size_t)b * 768 + 512 + c) * POS, l, SEQ, wv[0], wv[1], wv[2]); }
        __syncthreads();
        const int t0 = t * 8;
        for (int n = 0; n < 2; ++n) {
            f32x4 acc[8];
#pragma unroll
            for (int j = 0; j < 8; ++j) acc[j] = (f32x4){0.f, 0.f, 0.f, 0.f};
            const LAS float* kf = KF + n * 8192;
#pragma unroll 1
            for (int s0 = 0; s0 < SEQ; s0 += 8) {
                const int base = t0 - s0 + 4088;
                float kw[16];
#pragma unroll
                for (int q = 0; q < 4; ++q) { const f32x4 x = *(const LAS f32x4*)(kf + base + 4 * q); kw[4 * q] = x[0]; kw[4 * q + 1] = x[1]; kw[4 * q + 2] = x[2]; kw[4 * q + 3] = x[3]; }
#pragma unroll
                for (int i = 0; i < 8; ++i) { const f32x4 uv = *(const LAS f32x4*)(U + (s0 + i) * 4);
#pragma unroll
                    for (int j = 0; j < 8; ++j) acc[j] += uv * kw[8 + j - i]; }
            }
            float zo[8][4];
            const int xch = n == 0 ? c : 256 + c; const float* wg = n == 0 ? wx1 : wx2; const float bias = n == 0 ? bias0 : bias1;
#pragma unroll
            for (int b = 0; b < 4; ++b) {
                const float* hp = HYT + ((size_t)b * 768 + xch) * POS;
                const f32x4 h0 = *(const f32x4*)(hp + t0), h1 = *(const f32x4*)(hp + t0 + 4);
                const float hm = t0 > 0 ? hp[t0 - 1] : 0.f, hn = t0 + 8 < SEQ ? hp[t0 + 8] : 0.f;
                const float hv[10] = {hm, h0[0], h0[1], h0[2], h0[3], h1[0], h1[1], h1[2], h1[3], hn};
#pragma unroll
                for (int j = 0; j < 8; ++j) { const float g = wg[0] * hv[j] + wg[1] * hv[j + 1] + wg[2] * hv[j + 2];
                    zo[j][b] = g * (acc[j][b] + bias * U[(t0 + j) * 4 + b]); }
            }
            __syncthreads();
            if (n == 0) {
#pragma unroll
                for (int j = 0; j < 8; ++j) *(LAS f32x4*)(U + (t0 + j) * 4) = (f32x4){zo[j][0], zo[j][1], zo[j][2], zo[j][3]};
                __syncthreads();
            } else {
#pragma unroll
                for (int j = 0; j < 8; ++j)
#pragma unroll
                    for (int b = 0; b < 4; ++b) MIX[((size_t)b * SEQ + t0 + j) * DM + c] = f2bf(zo[j][b]);
            }
        }
    }
    __syncthreads();
}
#endif
DI void hyena_ctx_unit(const Frame& F, int ly, int c) {
    LAS float* KC = (LAS float*)F.lds;
    LAS float* UC = KC + 1024;
    LAS float* PS = UC + 1024;
    const int t = F.tid;
    const float* HYT = (const float*)(F.ws + WS_HYT);
    const float* scw = F.in[8] + (size_t)ly * 3 * 768;
    const float* invl = (const float*)(F.ws + WS_INVL1) + (size_t)ly * 1024;
    const float bias0 = F.in[15][(size_t)ly * 512 + c], bias1 = F.in[15][(size_t)ly * 512 + 256 + c];
    float wx1[3], wx2[3], wv[3];
#pragma unroll
    for (int j = 0; j < 3; ++j) { wx1[j] = scw[j * 768 + c]; wx2[j] = scw[j * 768 + 256 + c]; wv[j] = scw[j * 768 + 512 + c]; }
    bf16_t* MIX = (bf16_t*)(F.ws + WS_MIX);
    for (int n = 0; n < 2; ++n) { const float inv = invl[(1 * 2 + n) * 256 + c];
        const float* hf = (const float*)(F.ws + WS_HCC) + ((((size_t)ly * 2 + n) * 2 + 0) * 256 + c) * CTXL;
        const float* hb = (const float*)(F.ws + WS_HCC) + ((((size_t)ly * 2 + n) * 2 + 1) * 256 + c) * CTXL;
        for (int i = t; i < 512; i += NTHR) { const int d = i - 256; KC[n * 512 + i] = d >= 0 ? hf[d] * inv : (d > -256 ? hb[-d] * inv : 0.f); } }
    for (int i = t; i < 4 * CTXL; i += NTHR) { const int b = i >> 8, l = i & 255;
        UC[l * 4 + b] = hy_short(HYT + ((size_t)b * 768 + 512 + c) * POS + SEQ, l, CTXL, wv[0], wv[1], wv[2]); }
    __syncthreads();
    const int t0 = (t & 63) * 4, bp = (t >> 6) & 1, sq = t >> 7;
    const int tt = t & 255, bq = t >> 8;
    for (int n = 0; n < 2; ++n) {
        float a[4][2];
#pragma unroll
        for (int j = 0; j < 4; ++j) { a[j][0] = 0.f; a[j][1] = 0.f; }
        const LAS float* kf = KC + n * 512 + 256 + t0;
#pragma unroll 4
        for (int s = sq * 64; s < sq * 64 + 64; ++s) { const float u0 = UC[s * 4 + 2 * bp], u1 = UC[s * 4 + 2 * bp + 1];
#pragma unroll
            for (int j = 0; j < 4; ++j) { const float k = kf[j - s]; a[j][0] += k * u0; a[j][1] += k * u1; } }
#pragma unroll
        for (int j = 0; j < 4; ++j) { PS[(sq * 256 + t0 + j) * 4 + 2 * bp] = a[j][0]; PS[(sq * 256 + t0 + j) * 4 + 2 * bp + 1] = a[j][1]; }
        __syncthreads();
        float y0 = 0.f, y1 = 0.f;
#pragma unroll
        for (int q = 0; q < 4; ++q) { y0 += PS[(q * 256 + tt) * 4 + 2 * bq]; y1 += PS[(q * 256 + tt) * 4 + 2 * bq + 1]; }
        const int xch = n == 0 ? c : 256 + c; const float* wg = n == 0 ? wx1 : wx2; const float bias = n == 0 ? bias0 : bias1;
        const float g0 = hy_short(HYT + ((size_t)(2 * bq) * 768 + xch) * POS + SEQ, tt, CTXL, wg[0], wg[1], wg[2]);
        const float g1 = hy_short(HYT + ((size_t)(2 * bq + 1) * 768 + xch) * POS + SEQ, tt, CTXL, wg[0], wg[1], wg[2]);
        const float z0 = g0 * (y0 + bias * UC[tt * 4 + 2 * bq]), z1 = g1 * (y1 + bias * UC[tt * 4 + 2 * bq + 1]);
        __syncthreads();
        if (n == 0) { UC[tt * 4 + 2 * bq] = z0; UC[tt * 4 + 2 * bq + 1] = z1; __syncthreads(); }
        else { MIX[((size_t)RLAT + (2 * bq) * CTXL + tt) * DM + c] = f2bf(z0); MIX[((size_t)RLAT + (2 * bq + 1) * CTXL + tt) * DM + c] = f2bf(z1); }
    }
    __syncthreads();
}

DI unsigned cx_addr(unsigned e) { return e * 8u + (e >> 5) * 16u; }
constexpr int cx_bytes(int n) { return n * 8 + (n / 32) * 16; }
typedef float f32x2 __attribute__((ext_vector_type(2)));
template <int R> DI constexpr int brev(int q) { int r = 0; for (int i = 1, j = R >> 1; i < R; i <<= 1, j >>= 1) if (q & i) r |= j; return r; }
template <int R, bool INV> DI void dft_inreg(float (&re)[R], float (&im)[R]) {
#pragma unroll
    for (int len = R; len >= 2; len >>= 1) { const int half = len >> 1;
#pragma unroll
        for (int base = 0; base < R; base += len)
#pragma unroll
            for (int j = 0; j < half; ++j) {
                const float ar = re[base + j], ai = im[base + j], br = re[base + j + half], bi = im[base + j + half];
                re[base + j] = ar + br; im[base + j] = ai + bi;
                const float dr = ar - br, di = ai - bi;
                if (j == 0) { re[base + j + half] = dr; im[base + j + half] = di; }
                else if (4 * j == len) { if (INV) { re[base + j + half] = -di; im[base + j + half] = dr; } else { re[base + j + half] = di; im[base + j + half] = -dr; } }
                else { const float c = __builtin_cosf(6.283185307179586f * (float)j / (float)len), sn = (INV ? 1.f : -1.f) * __builtin_sinf(6.283185307179586f * (float)j / (float)len);
                    re[base + j + half] = dr * c - di * sn; im[base + j + half] = dr * sn + di * c; }
            }
    }
}
template <int R, bool INV, int S> DI void fft_bfly(LAS unsigned char* seq, int j) {
    constexpr int Lcur = R * S;
    int jj = j; asm volatile("" : "+v"(jj));
    const int blk = jj / S, o = jj % S;
    LAS unsigned char* p = seq + cx_addr((unsigned)(blk * Lcur + o));
#define FFT_OFF(r) ((r) * S * 8 + ((((r) * S) >> 5) * 16))
    float re[R], im[R];
    if (S == 1) {
#pragma unroll
        for (int r = 0; r < R; r += 2) { const f32x4 v = *(const LAS f32x4*)(p + FFT_OFF(r)); re[r] = v[0]; im[r] = v[1]; re[r + 1] = v[2]; im[r + 1] = v[3]; }
    } else {
#pragma unroll
        for (int r = 0; r < R; ++r) { const f32x2 v = *(const LAS f32x2*)(p + FFT_OFF(r)); re[r] = v[0]; im[r] = v[1]; }
    }
    if (S == 1) {
        dft_inreg<R, INV>(re, im);
    } else {
        const float fr = (float)o * (1.0f / (float)Lcur);
        float wr[R], wi[R];
        wr[1] = __builtin_amdgcn_cosf(fr); wi[1] = INV ? __builtin_amdgcn_sinf(fr) : -__builtin_amdgcn_sinf(fr);
#pragma unroll
        for (int q = 2; q < R; ++q) { const int a = (q & (q - 1)) ? (q & -q) : (q >> 1), bq = q - a;
            wr[q] = wr[a] * wr[bq] - wi[a] * wi[bq]; wi[q] = wr[a] * wi[bq] + wi[a] * wr[bq]; }
        if (!INV) {
            dft_inreg<R, false>(re, im);
#pragma unroll
            for (int q = 1; q < R; ++q) { const int k = brev<R>(q); const float xr = re[k], xi = im[k]; re[k] = xr * wr[q] - xi * wi[q]; im[k] = xr * wi[q] + xi * wr[q]; }
        } else {
#pragma unroll
            for (int q = 1; q < R; ++q) { const float xr = re[q], xi = im[q]; re[q] = xr * wr[q] - xi * wi[q]; im[q] = xr * wi[q] + xi * wr[q]; }
            dft_inreg<R, true>(re, im);
        }
    }
    if (S == 1) {
#pragma unroll
        for (int r = 0; r < R; r += 2) { const int k0 = brev<R>(r), k1 = brev<R>(r + 1); *(LAS f32x4*)(p + FFT_OFF(r)) = (f32x4){re[k0], im[k0], re[k1], im[k1]}; }
    } else {
#pragma unroll
        for (int r = 0; r < R; ++r) { const int k = brev<R>(r); *(LAS f32x2*)(p + FFT_OFF(r)) = (f32x2){re[k], im[k]}; }
    }
#undef FFT_OFF
}
DI void fft_mid32(LAS unsigned char* seq, int j, const f32x2* h) {
    int jj = j; asm volatile("" : "+v"(jj));
    LAS unsigned char* p = seq + cx_addr((unsigned)(jj * 32));
    const f32x4* hp = (const f32x4*)(h + jj * 32);
    float re[32], im[32];
#pragma unroll
    for (int r = 0; r < 32; r += 2) { const f32x4 v = *(const LAS f32x4*)(p + r * 8); re[r] = v[0]; im[r] = v[1]; re[r + 1] = v[2]; im[r + 1] = v[3]; }
    dft_inreg<32, false>(re, im);
    float r2[32], i2[32];
#pragma unroll
    for (int q = 0; q < 32; q += 2) { const f32x4 hv = hp[q >> 1]; const int k0 = brev<32>(q), k1 = brev<32>(q + 1);
        r2[q] = re[k0] * hv[0] - im[k0] * hv[1]; i2[q] = re[k0] * hv[1] + im[k0] * hv[0];
        r2[q + 1] = re[k1] * hv[2] - im[k1] * hv[3]; i2[q + 1] = re[k1] * hv[3] + im[k1] * hv[2]; }
    dft_inreg<32, true>(r2, i2);
#pragma unroll
    for (int r = 0; r < 32; r += 2) { const int k0 = brev<32>(r), k1 = brev<32>(r + 1); *(LAS f32x4*)(p + r * 8) = (f32x4){r2[k0], i2[k0], r2[k1], i2[k1]}; }
}
DI void conv8192x2(LAS unsigned char* lds, int tid, const f32x2* h) {
    constexpr int SB = cx_bytes(8192);
    fft_bfly<16, false, 512>(lds, tid); __builtin_amdgcn_sched_barrier(0); fft_bfly<16, false, 512>(lds + SB, tid); __syncthreads();
    fft_bfly<16, false, 32>(lds, tid); __builtin_amdgcn_sched_barrier(0); fft_bfly<16, false, 32>(lds + SB, tid); __syncthreads();
    fft_mid32(lds + (tid >> 8) * SB, tid & 255, h); __syncthreads();
    fft_bfly<16, true, 32>(lds, tid); __builtin_amdgcn_sched_barrier(0); fft_bfly<16, true, 32>(lds + SB, tid); __syncthreads();
    fft_bfly<16, true, 512>(lds, tid); __builtin_amdgcn_sched_barrier(0); fft_bfly<16, true, 512>(lds + SB, tid); __syncthreads();
}
template <bool INV> DI void fft8192x2(LAS unsigned char* lds, int tid) {
    constexpr int SB = cx_bytes(8192);
    if (!INV) {
        fft_bfly<16, false, 512>(lds, tid); __builtin_amdgcn_sched_barrier(0); fft_bfly<16, false, 512>(lds + SB, tid); __syncthreads();
        fft_bfly<16, false, 32>(lds, tid); __builtin_amdgcn_sched_barrier(0); fft_bfly<16, false, 32>(lds + SB, tid); __syncthreads();
        fft_bfly<32, false, 1>(lds + (tid >> 8) * SB, tid & 255); __syncthreads();
    } else {
        fft_bfly<32, true, 1>(lds + (tid >> 8) * SB, tid & 255); __syncthreads();
        fft_bfly<16, true, 32>(lds, tid); __builtin_amdgcn_sched_barrier(0); fft_bfly<16, true, 32>(lds + SB, tid); __syncthreads();
        fft_bfly<16, true, 512>(lds, tid); __builtin_amdgcn_sched_barrier(0); fft_bfly<16, true, 512>(lds + SB, tid); __syncthreads();
    }
}
DI void fft4096x4(LAS unsigned char* lds, int tid) {
    constexpr int SB = cx_bytes(4096);
    const int sq = tid >> 8, j = tid & 255;
    fft_bfly<16, false, 256>(lds + sq * SB, j); __builtin_amdgcn_sched_barrier(0); fft_bfly<16, false, 256>(lds + (sq + 2) * SB, j); __syncthreads();
    fft_bfly<16, false, 16>(lds + sq * SB, j); __builtin_amdgcn_sched_barrier(0); fft_bfly<16, false, 16>(lds + (sq + 2) * SB, j); __syncthreads();
    fft_bfly<16, false, 1>(lds + sq * SB, j); __builtin_amdgcn_sched_barrier(0); fft_bfly<16, false, 1>(lds + (sq + 2) * SB, j); __syncthreads();
}

DI void hy_short8(const float* hp, int l0, float w0, float w1, float w2, float (&out)[8]) {
    const f32x4 h0 = *(const f32x4*)(hp + l0), h1 = *(const f32x4*)(hp + l0 + 4);
    const float hm = l0 > 0 ? hp[l0 - 1] : 0.f, hn = l0 + 8 < SEQ ? hp[l0 + 8] : 0.f;
    const float hv[10] = {hm, h0[0], h0[1], h0[2], h0[3], h1[0], h1[1], h1[2], h1[3], hn};
#pragma unroll
    for (int j = 0; j < 8; ++j) out[j] = w0 * hv[j] + w1 * hv[j + 1] + w2 * hv[j + 2];
}
DI void hyena_fft_unit(const Frame& F, int ly, int c) {
    LAS unsigned char* L = F.lds; constexpr int SB = cx_bytes(8192);
    const int t = F.tid;
    const unsigned pt = cx_addr((unsigned)t), pl = cx_addr((unsigned)t * 8u);
    const float* HYT = (const float*)(F.ws + WS_HYT);
    const float* scw = F.in[8] + (size_t)ly * 3 * 768;
    const float* invl = (const float*)(F.ws + WS_INVL1) + (size_t)ly * 1024;
    const float bias0 = F.in[15][(size_t)ly * 512 + c], bias1 = F.in[15][(size_t)ly * 512 + 256 + c];
    float wx1[3], wx2[3], wv[3];
#pragma unroll
    for (int j = 0; j < 3; ++j) { wx1[j] = scw[j * 768 + c]; wx2[j] = scw[j * 768 + 256 + c]; wv[j] = scw[j * 768 + 512 + c]; }
    f32x2* SPEC = (f32x2*)(F.ws + WS_SPEC) + (size_t)c * 2 * 8192;
#pragma unroll
    for (int n = 0; n < 2; ++n) { const float inv = invl[(0 * 2 + n) * 256 + c] * (1.0f / 8192.0f);
        const float* hf = (const float*)(F.ws + WS_HCL) + ((((size_t)ly * 2 + n) * 2 + 0) * 256 + c) * SEQ;
        const float* hb = (const float*)(F.ws + WS_HCL) + ((((size_t)ly * 2 + n) * 2 + 1) * 256 + c) * SEQ;
        float fv[16];
#pragma unroll
        for (int k = 0; k < 8; ++k) { fv[k] = hf[t + 512 * k]; const int i = SEQ + t + 512 * k; fv[8 + k] = i > SEQ ? hb[8192 - i] : 0.f; }
#pragma unroll
        for (int k = 0; k < 16; ++k) *(LAS f32x2*)(L + n * SB + (pt + 4352u * (unsigned)(k))) = (f32x2){fv[k] * inv, 0.f}; }
    __syncthreads();
    fft8192x2<false>(L, t);
#pragma unroll
    for (int n = 0; n < 2; ++n)
#pragma unroll
        for (int k = 0; k < 16; ++k) SPEC[n * 8192 + t + 512 * k] = *(const LAS f32x2*)(L + n * SB + (pt + 4352u * (unsigned)(k)));
    __syncthreads();
    const int l0 = t * 8;
#pragma unroll 1
    for (int sp = 0; sp < 2; ++sp) {
        float za[8], zb[8];
        hy_short8(HYT + ((size_t)(2 * sp) * 768 + 512 + c) * POS, l0, wv[0], wv[1], wv[2], za);
        hy_short8(HYT + ((size_t)(2 * sp + 1) * 768 + 512 + c) * POS, l0, wv[0], wv[1], wv[2], zb);
#pragma unroll
        for (int j = 0; j < 8; j += 2) {
            *(LAS f32x4*)(L + sp * SB + (pl + 8u * (unsigned)(j))) = (f32x4){za[j], zb[j], za[j + 1], zb[j + 1]};
            *(LAS f32x4*)(L + sp * SB + (pl + 34816u + 8u * (unsigned)(j))) = (f32x4){0.f, 0.f, 0.f, 0.f}; }
    }
    __syncthreads();
    float* Z1 = (float*)(F.ws + WS_Z1) + (size_t)c * 4 * SEQ;
    bf16_t* MIX = (bf16_t*)(F.ws + WS_MIX);
#pragma unroll 1
    for (int n = 0; n < 2; ++n) {
        fft8192x2<false>(L, t);
#pragma unroll 1
        for (int k0 = 0; k0 < 16; k0 += 8) { f32x2 h[8];
#pragma unroll
          for (int k = 0; k < 8; ++k) h[k] = SPEC[n * 8192 + t + 512 * (k0 + k)];
#pragma unroll
          for (int k = 0; k < 8; ++k) { const unsigned ad = (pt + 4352u * (unsigned)(k0 + k));
            const f32x2 a = *(const LAS f32x2*)(L + ad), b = *(const LAS f32x2*)(L + SB + ad);
            *(LAS f32x2*)(L + ad) = (f32x2){a[0] * h[k][0] - a[1] * h[k][1], a[0] * h[k][1] + a[1] * h[k][0]};
            *(LAS f32x2*)(L + SB + ad) = (f32x2){b[0] * h[k][0] - b[1] * h[k][1], b[0] * h[k][1] + b[1] * h[k][0]}; } }
        __syncthreads();
        fft8192x2<true>(L, t);
        const int xch = n == 0 ? c : 256 + c; const float* wg = n == 0 ? wx1 : wx2; const float bias = n == 0 ? bias0 : bias1;
#pragma unroll 1
        for (int sp = 0; sp < 2; ++sp) {
            float zo[2][8];
#pragma unroll
            for (int h2 = 0; h2 < 2; ++h2) { const int bb = 2 * sp + h2;
                float g[8], zin[8];
                hy_short8(HYT + ((size_t)bb * 768 + xch) * POS, l0, wg[0], wg[1], wg[2], g);
                if (n == 0) hy_short8(HYT + ((size_t)bb * 768 + 512 + c) * POS, l0, wv[0], wv[1], wv[2], zin);
                else { const f32x4 q0 = *(const f32x4*)(Z1 + (size_t)bb * SEQ + l0), q1 = *(const f32x4*)(Z1 + (size_t)bb * SEQ + l0 + 4);
                    zin[0] = q0[0]; zin[1] = q0[1]; zin[2] = q0[2]; zin[3] = q0[3]; zin[4] = q1[0]; zin[5] = q1[1]; zin[6] = q1[2]; zin[7] = q1[3]; }
#pragma unroll
                for (int j = 0; j < 8; ++j) { const float y = ((const LAS float*)(L + sp * SB + (pl + 8u * (unsigned)(j))))[h2]; zo[h2][j] = g[j] * (y + bias * zin[j]); }
                if (n == 0) { *(f32x4*)(Z1 + (size_t)bb * SEQ + l0) = (f32x4){zo[h2][0], zo[h2][1], zo[h2][2], zo[h2][3]}; *(f32x4*)(Z1 + (size_t)bb * SEQ + l0 + 4) = (f32x4){zo[h2][4], zo[h2][5], zo[h2][6], zo[h2][7]}; }
                else {
#pragma unroll
                    for (int j = 0; j < 8; ++j) MIX[((size_t)bb * SEQ + l0 + j) * DM + c] = f2bf(zo[h2][j]); }
            }
            if (n == 0) {
#pragma unroll
                for (int j = 0; j < 8; j += 2) {
                    *(LAS f32x4*)(L + sp * SB + (pl + 8u * (unsigned)(j))) = (f32x4){zo[0][j], zo[1][j], zo[0][j + 1], zo[1][j + 1]};
                    *(LAS f32x4*)(L + sp * SB + (pl + 34816u + 8u * (unsigned)(j))) = (f32x4){0.f, 0.f, 0.f, 0.f}; }
            }
        }
        __syncthreads();
    }
}

DI void fnet_fft_unit(const Frame& F, int u) {
    LAS unsigned char* L = F.lds; constexpr int SB = cx_bytes(4096);
    const int t = F.tid, b = u >> 6, gd0 = (u & 63) * 4;
    const bf16_t* YT = (const bf16_t*)(F.ws + WS_YTL) + ((size_t)b * 256 + gd0) * 8192;
    for (int i = t; i < 4 * 512; i += NTHR) { const int q = i >> 9, l0 = (i & 511) * 8;
        const u32x4 r = *(const u32x4*)(YT + (size_t)q * 8192 + l0), m = *(const u32x4*)(YT + (size_t)q * 8192 + 4096 + l0);
        const float rr[8] = {bflo(r.x), bfhi(r.x), bflo(r.y), bfhi(r.y), bflo(r.z), bfhi(r.z), bflo(r.w), bfhi(r.w)};
        const float mm[8] = {bflo(m.x), bfhi(m.x), bflo(m.y), bfhi(m.y), bflo(m.z), bfhi(m.z), bflo(m.w), bfhi(m.w)};
#pragma unroll
        for (int j = 0; j < 8; j += 2) *(LAS f32x4*)(L + q * SB + cx_addr(l0 + j)) = (f32x4){rr[j], mm[j], rr[j + 1], mm[j + 1]}; }
    __syncthreads();
    fft4096x4(L, t);
    bf16_t* MIX = (bf16_t*)(F.ws + WS_MIX);
#pragma unroll
    for (int i = 0; i < 8; ++i) { const int p = t + 512 * i; const int f = (p >> 8) + 16 * ((p >> 4) & 15) + 256 * (p & 15);
        float v[4];
#pragma unroll
        for (int q = 0; q < 4; ++q) v[q] = (*(const LAS f32x2*)(L + q * SB + cx_addr(p)))[0] * (1.0f / 512.0f);
        u32x2 w; w.x = cvt_pk_bf16(v[0], v[1]); w.y = cvt_pk_bf16(v[2], v[3]);
        *(u32x2*)(MIX + ((size_t)b * SEQ + f) * DM + 768 + gd0) = w; }
    __syncthreads();
}

DI void attn_unit(const Frame& F, int ly, int uid, float lam, float out_scale) {
    const int t = F.tid, lane = F.lane, wave = F.wave;
    LAS unsigned char* L = F.lds;
    constexpr int KOFF = 0, VOFF = 16384, TB = 32768, NBUF = 4;
    int bh, q0, k_lo, k_hi;
    if (uid < 512) { bh = uid >> 4; q0 = (uid & 15) << 8; k_lo = 0; k_hi = POS; }
    else { bh = uid - 512; q0 = SEQ; k_lo = SEQ; k_hi = POS; }
    const bf16_t* Qg = (const bf16_t*)(F.ws + WS_Q) + (size_t)bh * POS * 64;
    const bf16_t* Kg = (const bf16_t*)(F.ws + WS_K) + (size_t)bh * POS * 64;
    const bf16_t* Vg = (const bf16_t*)(F.ws + WS_V) + (size_t)bh * POS * 64;
    const int qi = lane & 31, hh = lane >> 5;
    const int qpos = q0 + wave * 32 + qi;
    bf16x8 qf[2][2];
    float q2[2] = {0.f, 0.f};
#pragma unroll
    for (int comp = 0; comp < 2; ++comp)
#pragma unroll
        for (int ks = 0; ks < 2; ++ks) { qf[comp][ks] = *(const bf16x8*)(Qg + (size_t)qpos * 64 + comp * 32 + ks * 16 + hh * 8);
#pragma unroll
            for (int j = 0; j < 8; ++j) { const float x = bf2f((unsigned short)qf[comp][ks][j]); q2[comp] += x * x; } }
    q2[0] += __shfl_xor(q2[0], 32); q2[1] += __shfl_xor(q2[1], 32);
    float kmax2[2];
    kmax2[0] = __uint_as_float(F.ctl[CW_KMAX + 64 * ly + bh * 2]); kmax2[1] = __uint_as_float(F.ctl[CW_KMAX + 64 * ly + bh * 2 + 1]);
    f32x16 negm;
    { const float m = -fmaxf(sqrtf(q2[0] * kmax2[0]), sqrtf(q2[1] * kmax2[1])) * 1.0001f;
#pragma unroll
      for (int i = 0; i < 16; ++i) negm[i] = m; }
    f32x16 O[2][2];
#pragma unroll
    for (int a = 0; a < 2; ++a)
#pragma unroll
        for (int b = 0; b < 2; ++b)
#pragma unroll
            for (int i = 0; i < 16; ++i) O[a][b][i] = 0.f;
    float lsum[2] = {0.f, 0.f};
    const int sk = t >> 3, sl = t & 7;
    const int kch = sl ^ ((sk >> 1) & 7);
    const int vch = (((sl >> 1) ^ (sk & 3)) << 1) | (sl & 1);
    const bf16_t* kgp = Kg + (size_t)(k_lo + sk) * 64 + kch * 8;
    const bf16_t* vgp = Vg + (size_t)(k_lo + sk) * 64 + vch * 8;
    const unsigned wvb = (unsigned)wave * 1024u;
    const int ntile = (k_hi - k_lo) >> 7;
#define ATT_DMA(tile, bufi) do { const size_t go = (size_t)(tile) * 128 * 64; \
        __builtin_amdgcn_global_load_lds((const unsigned*)(kgp + go), (LAS unsigned*)(L + KOFF + (bufi) * TB + wvb), 16, 0, 0); \
        __builtin_amdgcn_global_load_lds((const unsigned*)(kgp + go + 4096), (LAS unsigned*)(L + KOFF + (bufi) * TB + 8192 + wvb), 16, 0, 0); \
        __builtin_amdgcn_global_load_lds((const unsigned*)(vgp + go), (LAS unsigned*)(L + VOFF + (bufi) * TB + wvb), 16, 0, 0); \
        __builtin_amdgcn_global_load_lds((const unsigned*)(vgp + go + 4096), (LAS unsigned*)(L + VOFF + (bufi) * TB + 8192 + wvb), 16, 0, 0); } while (0)
    ATT_DMA(0, 0);
    if (ntile > 1) ATT_DMA(1, 1);
    if (ntile > 2) ATT_DMA(2, 2);
    if (ntile > 2) asm volatile("s_waitcnt vmcnt(8)" ::: "memory"); else if (ntile > 1) asm volatile("s_waitcnt vmcnt(4)" ::: "memory"); else asm volatile("s_waitcnt vmcnt(0)" ::: "memory");
    __builtin_amdgcn_s_barrier();
    const int p4 = lane & 3, q4 = (lane & 15) >> 2, blk = (lane >> 4) & 1;
    const int keyq = 4 * hh + q4;
    const unsigned va0 = (unsigned)(keyq * 128 + (((0 + blk) ^ (keyq & 3)) << 5) + p4 * 8), va1 = (unsigned)(keyq * 128 + (((2 + blk) ^ (keyq & 3)) << 5) + p4 * 8);
    const int ksw = (qi >> 1) & 7;
    const unsigned ka00 = (unsigned)(qi * 128 + (((0 + hh) ^ ksw) << 4)), ka01 = (unsigned)(qi * 128 + (((2 + hh) ^ ksw) << 4));
    const unsigned ka10 = (unsigned)(qi * 128 + (((4 + hh) ^ ksw) << 4)), ka11 = (unsigned)(qi * 128 + (((6 + hh) ^ ksw) << 4));
    typedef __bf16 bf16x8n __attribute__((ext_vector_type(8)));
    typedef float f32x8 __attribute__((ext_vector_type(8)));
#define ATT_PACK(S, s8) __builtin_bit_cast(bf16x8, __builtin_convertvector((f32x8){S[8 * (s8)], S[8 * (s8) + 1], S[8 * (s8) + 2], S[8 * (s8) + 3], S[8 * (s8) + 4], S[8 * (s8) + 5], S[8 * (s8) + 6], S[8 * (s8) + 7]}, bf16x8n))
#define ATT_MFMA(a, b, c) __builtin_amdgcn_mfma_f32_32x32x16_bf16((a), (b), (c), 0, 0, 0)
    f32x16 S0, S1;
    bf16x8 p1a, p1b, vp00, vp01, vp10, vp11;
#pragma unroll
    for (int j = 0; j < 8; ++j) { p1a[j] = 0; p1b[j] = 0; vp00[j] = 0; vp01[j] = 0; vp10[j] = 0; vp11[j] = 0; }
    for (int it = 0; it < ntile; ++it) {
        const int buf = it & (NBUF - 1);
        if (it + 3 < ntile) ATT_DMA(it + 3, (it + 3) & (NBUF - 1));
        const unsigned kbb = KOFF + buf * TB, vbb = VOFF + buf * TB;
        { const bf16x8 k00 = *(const LAS bf16x8*)(L + kbb + ka00), k01 = *(const LAS bf16x8*)(L + kbb + ka01);
          S0 = ATT_MFMA(k00, qf[0][0], negm); S0 = ATT_MFMA(k01, qf[0][1], S0); }
#pragma unroll 1
        for (int kb = 0; kb < 4; ++kb) {
            const unsigned kro = kbb + kb * 4096, vro = vbb + kb * 4096;
            s16x4 r0, r1, r2, r3, r4, r5, r6, r7;
            { const unsigned a0 = vro + va0, a1 = vro + va1;
              asm volatile("ds_read_b64_tr_b16 %0, %8\n\tds_read_b64_tr_b16 %1, %8 offset:1024\n\tds_read_b64_tr_b16 %2, %8 offset:2048\n\tds_read_b64_tr_b16 %3, %8 offset:3072\n\t"
                           "ds_read_b64_tr_b16 %4, %9\n\tds_read_b64_tr_b16 %5, %9 offset:1024\n\tds_read_b64_tr_b16 %6, %9 offset:2048\n\tds_read_b64_tr_b16 %7, %9 offset:3072"
                           : "=&v"(r0), "=&v"(r1), "=&v"(r2), "=&v"(r3), "=&v"(r4), "=&v"(r5), "=&v"(r6), "=&v"(r7) : "v"(a0), "v"(a1) : "memory"); }
            const bf16x8 k10 = *(const LAS bf16x8*)(L + kro + ka10), k11 = *(const LAS bf16x8*)(L + kro + ka11);
            O[1][0] = ATT_MFMA(vp00, p1a, O[1][0]); O[1][1] = ATT_MFMA(vp01, p1a, O[1][1]);
            O[1][0] = ATT_MFMA(vp10, p1b, O[1][0]); O[1][1] = ATT_MFMA(vp11, p1b, O[1][1]);
            S1 = ATT_MFMA(k10, qf[1][0], negm); S1 = ATT_MFMA(k11, qf[1][1], S1);
            float ps0 = 0.f;
#pragma unroll
            for (int i = 0; i < 16; ++i) { S0[i] = __builtin_amdgcn_exp2f(S0[i]); ps0 += S0[i]; }
            lsum[0] += ps0;
            const bf16x8 p0a = ATT_PACK(S0, 0), p0b = ATT_PACK(S0, 1);
            __builtin_amdgcn_sched_group_barrier(0x008, 1, 0); __builtin_amdgcn_sched_group_barrier(0x400, 3, 0);
            __builtin_amdgcn_sched_group_barrier(0x008, 1, 0); __builtin_amdgcn_sched_group_barrier(0x400, 3, 0);
            __builtin_amdgcn_sched_group_barrier(0x008, 1, 0); __builtin_amdgcn_sched_group_barrier(0x400, 3, 0);
            __builtin_amdgcn_sched_group_barrier(0x008, 1, 0); __builtin_amdgcn_sched_group_barrier(0x400, 3, 0);
            __builtin_amdgcn_sched_group_barrier(0x008, 1, 0); __builtin_amdgcn_sched_group_barrier(0x400, 2, 0);
            __builtin_amdgcn_sched_group_barrier(0x008, 1, 0); __builtin_amdgcn_sched_group_barrier(0x400, 2, 0);
            asm volatile("s_waitcnt lgkmcnt(0)" : "+v"(r0), "+v"(r1), "+v"(r2), "+v"(r3), "+v"(r4), "+v"(r5), "+v"(r6), "+v"(r7));
            vp00 = __builtin_shufflevector(r0, r1, 0, 1, 2, 3, 4, 5, 6, 7); vp10 = __builtin_shufflevector(r2, r3, 0, 1, 2, 3, 4, 5, 6, 7);
            vp01 = __builtin_shufflevector(r4, r5, 0, 1, 2, 3, 4, 5, 6, 7); vp11 = __builtin_shufflevector(r6, r7, 0, 1, 2, 3, 4, 5, 6, 7);
            O[0][0] = ATT_MFMA(vp00, p0a, O[0][0]); O[0][1] = ATT_MFMA(vp01, p0a, O[0][1]);
            O[0][0] = ATT_MFMA(vp10, p0b, O[0][0]); O[0][1] = ATT_MFMA(vp11, p0b, O[0][1]);
            { const bf16x8 k00 = *(const LAS bf16x8*)(L + kro + 4096 + ka00), k01 = *(const LAS bf16x8*)(L + kro + 4096 + ka01);
                S0 = ATT_MFMA(k00, qf[0][0], negm); S0 = ATT_MFMA(k01, qf[0][1], S0); }
            float ps1 = 0.f;
#pragma unroll
            for (int i = 0; i < 16; ++i) { S1[i] = __builtin_amdgcn_exp2f(S1[i]); ps1 += S1[i]; }
            lsum[1] += ps1;
            p1a = ATT_PACK(S1, 0); p1b = ATT_PACK(S1, 1);
            __builtin_amdgcn_sched_group_barrier(0x008, 1, 1); __builtin_amdgcn_sched_group_barrier(0x400, 3, 1);
            __builtin_amdgcn_sched_group_barrier(0x008, 1, 1); __builtin_amdgcn_sched_group_barrier(0x400, 3, 1);
            __builtin_amdgcn_sched_group_barrier(0x008, 1, 1); __builtin_amdgcn_sched_group_barrier(0x400, 3, 1);
            __builtin_amdgcn_sched_group_barrier(0x008, 1, 1); __builtin_amdgcn_sched_group_barrier(0x400, 3, 1);
            __builtin_amdgcn_sched_group_barrier(0x008, 1, 1); __builtin_amdgcn_sched_group_barrier(0x400, 2, 1);
            __builtin_amdgcn_sched_group_barrier(0x008, 1, 1); __builtin_amdgcn_sched_group_barrier(0x400, 2, 1);
        }
        if (it + 3 < ntile) asm volatile("s_waitcnt vmcnt(8)\n\ts_waitcnt lgkmcnt(0)" ::: "memory");
        else if (it + 2 < ntile) asm volatile("s_waitcnt vmcnt(4)\n\ts_waitcnt lgkmcnt(0)" ::: "memory");
        else asm volatile("s_waitcnt vmcnt(0)\n\ts_waitcnt lgkmcnt(0)" ::: "memory");
        __builtin_amdgcn_s_barrier();
    }
    O[1][0] = ATT_MFMA(vp00, p1a, O[1][0]); O[1][1] = ATT_MFMA(vp01, p1a, O[1][1]);
    O[1][0] = ATT_MFMA(vp10, p1b, O[1][0]); O[1][1] = ATT_MFMA(vp11, p1b, O[1][1]);
#undef ATT_DMA
#undef ATT_PACK
#undef ATT_MFMA
    const float l0 = lsum[0] + __shfl_xor(lsum[0], 32), l1 = lsum[1] + __shfl_xor(lsum[1], 32);
    const float i0 = 1.0f / l0, i1 = lam / l1;
    float ss = 0.f;
#pragma unroll
    for (int dvb = 0; dvb < 2; ++dvb)
#pragma unroll
        for (int i = 0; i < 16; ++i) { const float o = O[0][dvb][i] * i0 - O[1][dvb][i] * i1; O[0][dvb][i] = o; ss += o * o; }
    ss += __shfl_xor(ss, 32);
    const float rn = rsqrtf(ss * (1.0f / 64.0f) + LN_EPS) * out_scale;
    const float* sw = F.in[20] + (size_t)ly * 64;
    const int b = bh >> 3, head = bh & 7;
    const size_t row = qpos < SEQ ? (size_t)b * SEQ + qpos : (size_t)RLAT + b * CTXL + (qpos - SEQ);
    bf16_t* dst = (bf16_t*)(F.ws + WS_MIX) + row * DM + 256 + head * 64;
#pragma unroll
    for (int dvb = 0; dvb < 2; ++dvb)
#pragma unroll
        for (int g = 0; g < 4; ++g) { const int dv = dvb * 32 + 8 * g + 4 * hh;
            const f32x4 w4 = *(const f32x4*)(sw + dv);
            u32x2 w; w.x = cvt_pk_bf16(O[0][dvb][4 * g] * rn * w4[0], O[0][dvb][4 * g + 1] * rn * w4[1]); w.y = cvt_pk_bf16(O[0][dvb][4 * g + 2] * rn * w4[2], O[0][dvb][4 * g + 3] * rn * w4[3]);
            *(u32x2*)(dst + dv) = w; }
    __syncthreads();
}

DI void phase_rows_router(const Frame& F, int ly) {
    LAS float* HS = (LAS float*)F.lds;
    LAS float* PART = HS + 16 * 1028;
    LAS int* LCNT = (LAS int*)(PART + 8 * 16 * 64);
    LAS int* LBASE = LCNT + 64;
    LAS int* ASG = LBASE + 64;
    const int lane = F.lane, wave = F.wave;
    const float* MOD = (const float*)(F.ws + WS_MOD);
    const float* g1 = F.in[22] + (size_t)ly * DM; const float* b1 = F.in[23] + (size_t)ly * DM;
    const float* rw = F.in[26] + (size_t)ly * DM * NEXP; const float* rb = F.in[27] + (size_t)ly * NEXP;
    const bool last = ly == DEPTH - 1;
    const int nrows = last ? RLAT : RTOT;
    if (F.tid < 64) LCNT[F.tid] = 0;
    constexpr int HSS = 1028;
    float wreg[128];
#pragma unroll
    for (int i = 0; i < 128; ++i) wreg[i] = rw[(size_t)(wave * 128 + 4 * (i >> 2) + (lane >> 4)) * NEXP + 16 * (i & 3) + (lane & 15)];
    __syncthreads();
    int itn = 0;
    f32x4 va[2][4];
    if (F.bid * 16 < nrows) {
#pragma unroll
        for (int rr = 0; rr < 2; ++rr) { const float* xr = (const float*)(F.ws + WS_X) + (size_t)(F.bid * 16 + wave * 2 + rr) * DM;
#pragma unroll
            for (int j = 0; j < 4; ++j) va[rr][j] = *(const f32x4*)(xr + 4 * lane + 256 * j); } }
    for (int r0 = F.bid * 16; r0 < nrows; r0 += F.G * 16, ++itn) {
#pragma unroll
        for (int rr = 0; rr < 2; ++rr) { const int rl = wave * 2 + rr, row = r0 + rl;
            float* xr = (float*)(F.ws + WS_X) + (size_t)row * DM;
            f32x4 (&v)[4] = va[rr];
            float mu, rstd; ln_stats(v, mu, rstd);
#pragma unroll
            for (int j = 0; j < 4; ++j) { const int c = 4 * lane + 256 * j; const f32x4 g = *(const f32x4*)(g1 + c), bb = *(const f32x4*)(b1 + c);
#pragma unroll
                for (int e = 0; e < 4; ++e) v[j][e] = (v[j][e] - mu) * rstd * g[e] + bb[e];
                *(f32x4*)(xr + c) = v[j]; }
            ln_stats(v, mu, rstd);
            const float* m = MOD + ((size_t)ly * 5 + row_modsel(row)) * 6144;
            bf16_t* hrow = (bf16_t*)(F.ws + WS_H) + (size_t)row * DM;
#pragma unroll
            for (int j = 0; j < 4; ++j) { const int c = 4 * lane + 256 * j; const f32x4 a = *(const f32x4*)(m + 3072 + c), bsc = *(const f32x4*)(m + 4096 + c);
                f32x4 o;
#pragma unroll
                for (int e = 0; e < 4; ++e) o[e] = (v[j][e] - mu) * rstd * (1.f + bsc[e]) + a[e];
                u32x2 w; w.x = cvt_pk_bf16(o[0], o[1]); w.y = cvt_pk_bf16(o[2], o[3]); *(u32x2*)(hrow + c) = w;
                *(LAS f32x4*)(HS + rl * HSS + c) = o; } }
        { const int rn = r0 + F.G * 16;
          if (rn < nrows) {
#pragma unroll
            for (int rr = 0; rr < 2; ++rr) { const float* xr = (const float*)(F.ws + WS_X) + (size_t)(rn + wave * 2 + rr) * DM;
#pragma unroll
                for (int j = 0; j < 4; ++j) va[rr][j] = *(const f32x4*)(xr + 4 * lane + 256 * j); } } }
        asm volatile("s_waitcnt lgkmcnt(0)" ::: "memory"); __builtin_amdgcn_s_barrier();
        { f32x4 acc[4];
#pragma unroll
          for (int nb = 0; nb < 4; ++nb) acc[nb] = (f32x4){0.f, 0.f, 0.f, 0.f};
          const LAS float* hp = HS + (lane & 15) * HSS + wave * 128 + (lane >> 4);
#pragma unroll
          for (int g = 0; g < 32; ++g) { const float a = hp[4 * g];
#pragma unroll
              for (int nb = 0; nb < 4; ++nb) acc[nb] = __builtin_amdgcn_mfma_f32_16x16x4f32(a, wreg[g * 4 + nb], acc[nb], 0, 0, 0); }
#pragma unroll
          for (int nb = 0; nb < 4; ++nb)
#pragma unroll
              for (int e = 0; e < 4; ++e) PART[(wave * 16 + (lane >> 4) * 4 + e) * 64 + nb * 16 + (lane & 15)] = acc[nb][e]; }
        asm volatile("s_waitcnt lgkmcnt(0)" ::: "memory"); __builtin_amdgcn_s_barrier();
#pragma unroll
        for (int rr = 0; rr < 2; ++rr) { const int rl = wave * 2 + rr, row = r0 + rl;
            float lg = 0.f;
#pragma unroll
            for (int w = 0; w < 8; ++w) lg += PART[(w * 16 + rl) * 64 + lane];
            const float s = 1.0f / (1.0f + expf(-lg));
            const float sel = s + rb[lane];
            float m1 = sel;
            m1 = fmaxf(m1, __shfl_xor(m1, 1)); m1 = fmaxf(m1, __shfl_xor(m1, 2)); m1 = fmaxf(m1, __shfl_xor(m1, 4));
            const unsigned long long bal = __ballot(sel == m1);
            const int gbase = lane & ~7;
            const unsigned gmask = (unsigned)((bal >> gbase) & 0xffull);
            const int first = gbase + __builtin_ctz(gmask);
            float m2 = (lane == first) ? -INFINITY : sel;
            m2 = fmaxf(m2, __shfl_xor(m2, 1)); m2 = fmaxf(m2, __shfl_xor(m2, 2)); m2 = fmaxf(m2, __shfl_xor(m2, 4));
            const float gs = m1 + m2;
            const int mygrp = lane >> 3;
            int grank = 0;
#pragma unroll
            for (int g = 0; g < 8; ++g) { const float o = __shfl(gs, g * 8); grank += (o > gs || (o == gs && g < mygrp)) ? 1 : 0; }
            const float msel = grank < 4 ? sel : -INFINITY;
            int rank = 64;
            { float cur = msel;
#pragma unroll 1
              for (int it = 0; it < 8; ++it) { const float m = wave_max(cur); const unsigned long long bl = __ballot(cur == m); const int first2 = (int)__builtin_ctzll(bl);
                  if (lane == first2) { rank = it; cur = -INFINITY; } } }
            const bool chosen = rank < 8;
            const float wsum = wave_sum(chosen ? s : 0.f);
            if (chosen) { const float gate = s / wsum * 2.5f;
                ((float*)(F.ws + WS_TOPG))[(size_t)row * 8 + rank] = gate;
                const int lp = __hip_atomic_fetch_add(LCNT + lane, 1, __ATOMIC_RELAXED, __HIP_MEMORY_SCOPE_WORKGROUP);
                ASG[(itn * 16 + rl) * 8 + rank] = (lane << 20) | lp; } }
        asm volatile("s_waitcnt lgkmcnt(0)" ::: "memory"); __builtin_amdgcn_s_barrier();
    }
    if (F.tid < 64) { const int n = LCNT[F.tid]; LBASE[F.tid] = n ? (int)atomicAdd(F.ctl + CW_CNT + (ly * 64 + F.tid) * CNT_STRIDE, (unsigned)n) : 0; }
    __syncthreads();
    for (int a = F.tid; a < itn * 128; a += NTHR) { const int it = a >> 7, rl = (a >> 3) & 15, slot = a & 7; const int row = F.bid * 16 + it * F.G * 16 + rl;
        const int v = ASG[a], e = v >> 20, lp = v & 0xfffff;
        ((int*)(F.ws + WS_LIST))[(size_t)e * RTOT + LBASE[e] + lp] = row * 8 + slot;
        ((int*)(F.ws + WS_TOPE))[(size_t)row * 8 + slot] = (e << 20) | (LBASE[e] + lp); }
    __syncthreads();
}

DI void bf8_fma(const u32x4 w, float g, float (&y)[8]) {
    y[0] += bflo(w.x) * g; y[1] += bfhi(w.x) * g; y[2] += bflo(w.y) * g; y[3] += bfhi(w.y) * g; y[4] += bflo(w.z) * g; y[5] += bfhi(w.z) * g; y[6] += bflo(w.w) * g; y[7] += bfhi(w.w) * g;
}
DI void phase_combine(const Frame& F, int ly) {
    const int gw = F.bid * 8 + F.wave, nw = F.G * 8, lane = F.lane;
    const bool last = ly == DEPTH - 1;
    const int nrows = last ? RLAT : RTOT;
    const float* MOD = (const float*)(F.ws + WS_MOD);
    const float* g2w = F.in[24] + (size_t)ly * DM; const float* b2w = F.in[25] + (size_t)ly * DM;
    const bf16_t* YB = (const bf16_t*)(F.ws + WS_YB);
    const MoeTab T = moe_tables(F, ly);
    for (int row = gw; row < nrows; row += nw) {
        const float* gates = (const float*)(F.ws + WS_TOPG) + (size_t)row * 8;
        const int* posr = (const int*)(F.ws + WS_TOPE) + (size_t)row * 8;
        u32x4 yr[9][2];
#pragma unroll
        for (int s9 = 0; s9 < 9; ++s9) { size_t yrow;
            if (s9 < 8) { const int v = posr[s9]; yrow = (size_t)T.tstart[v >> 20] * 256 + (v & 0xfffff); } else yrow = (size_t)T.tstart[NEXP] * 256 + row;
#pragma unroll
            for (int hf = 0; hf < 2; ++hf) yr[s9][hf] = *(const u32x4*)(YB + yrow * DM + hf * 512 + 8 * lane); }
        float* xr = (float*)(F.ws + WS_X) + (size_t)row * DM;
        f32x4 xv[4];
#pragma unroll
        for (int hf = 0; hf < 2; ++hf) { xv[2 * hf] = *(const f32x4*)(xr + hf * 512 + 8 * lane); xv[2 * hf + 1] = *(const f32x4*)(xr + hf * 512 + 8 * lane + 4); }
        float y[2][8];
#pragma unroll
        for (int hf = 0; hf < 2; ++hf) {
#pragma unroll
            for (int e = 0; e < 8; ++e) y[hf][e] = 0.f;
            bf8_fma(yr[8][hf], 1.0f, y[hf]);
#pragma unroll
            for (int s8 = 0; s8 < 8; ++s8) bf8_fma(yr[s8][hf], gates[s8], y[hf]); }
        const float* m = MOD + ((size_t)ly * 5 + row_modsel(row)) * 6144;
        f32x4 v[4];
#pragma unroll
        for (int q = 0; q < 4; ++q) { const int c = (q >> 1) * 512 + 8 * lane + (q & 1) * 4; const f32x4 g2 = *(const f32x4*)(m + 5120 + c);
#pragma unroll
            for (int e = 0; e < 4; ++e) v[q][e] = xv[q][e] * ALPHA + g2[e] * y[q >> 1][(q & 1) * 4 + e]; }
        float mu, rstd; ln_stats(v, mu, rstd);
#pragma unroll
        for (int q = 0; q < 4; ++q) { const int c = (q >> 1) * 512 + 8 * lane + (q & 1) * 4; const f32x4 g = *(const f32x4*)(g2w + c), bb = *(const f32x4*)(b2w + c);
#pragma unroll
            for (int e = 0; e < 4; ++e) v[q][e] = (v[q][e] - mu) * rstd * g[e] + bb[e];
            if (last) *(f32x4*)(F.out + (size_t)row * DM + c) = v[q]; else *(f32x4*)(xr + c) = v[q]; }
        if (!last) { const float* mn = MOD + ((size_t)(ly + 1) * 5 + row_modsel(row)) * 6144;
            ln_stats(v, mu, rstd);
            bf16_t* hrow = (bf16_t*)(F.ws + WS_H) + (size_t)row * DM;
#pragma unroll
            for (int hf = 0; hf < 2; ++hf) { const int c = hf * 512 + 8 * lane; float o[8];
#pragma unroll
                for (int q = 0; q < 2; ++q) { const f32x4 sh = *(const f32x4*)(mn + c + 4 * q), sc = *(const f32x4*)(mn + 1024 + c + 4 * q);
#pragma unroll
                    for (int e = 0; e < 4; ++e) o[4 * q + e] = (v[2 * hf + q][e] - mu) * rstd * (1.f + sc[e]) + sh[e]; }
                u32x4 w; w.x = cvt_pk_bf16(o[0], o[1]); w.y = cvt_pk_bf16(o[2], o[3]); w.z = cvt_pk_bf16(o[4], o[5]); w.w = cvt_pk_bf16(o[6], o[7]);
                *(u32x4*)(hrow + c) = w; } }
    }
}

PHASE_FN void ph_pre0(const Frame& F0) { const Frame F = relaunder(F0); prep_small(F, 0); prep_mod(F); prep_filters(F); prep_tables(F); }
PHASE_FN void ph_pre1(const Frame& F0) { const Frame F = relaunder(F0); prep_invl1(F); phase_init_h(F); }
PHASE_FN void ph_win(const Frame& F0, int ly) { const Frame F = relaunder(F0);
    pg8::Gemm g{(const bf16_t*)(F.ws + WS_H), (const bf16_t*)(F.ws + WS_WIN), DM, F.tid};
    pg8::StaticOrder S; S.init(RTOT / 256, NWIN / 256, F.G, F.bid);
    EpiWin E{F.ws, ly};
    pg8::gemm_phase<EpiWin, pg8::StaticOrder>(F.lds, g, S, E);
}
constexpr int NSTREAM = 0;
PHASE_FN void ph_mix(const Frame& F0, int ly) { const Frame F = relaunder(F0);
    volatile LAS unsigned* MISC = (volatile LAS unsigned*)(F.lds + LDS_MISC);
    const bool last = ly == DEPTH - 1;
    if (!last) { pg8::Gemm g{(const bf16_t*)(F.ws + WS_DFTC), (const bf16_t*)(F.ws + WS_YTC), 2 * CTXL, F.tid};
      pg8::StaticOrder S; S.init(1, 4, F.G, (F.bid + F.G - 64) % F.G);
      EpiFnet E{F.ws, 1};
      pg8::gemm_phase<EpiFnet, pg8::StaticOrder>(F.lds, g, S, E); }
    __syncthreads();
    for (;;) {
        __syncthreads();
        if (F.tid == 0) MISC[16] = atomicAdd(F.ctl + CW_ATTN + 64 * ly, 1u);
        __syncthreads();
        const int uid = (int)MISC[16];
        if (uid >= 256 + 256 + (last ? 512 : 544)) break;
        const Frame Fu = relaunder(F);
        if (uid < 256) { if (KIND(4)) { hyena_fft_unit(Fu, ly, uid); if (!last) hyena_ctx_unit(Fu, ly, uid); } }
        else if (uid < 512) { if (KIND(3)) fnet_fft_unit(Fu, uid - 256); }
        else if (KIND(5)) { const float* lm = (const float*)(Fu.ws + WS_LAM) + 2 * ly; attn_unit(Fu, ly, uid - 512, lm[0], 1.0f - lm[1]); }
    }
    prep_experts(F, ly, CW_PREPQ, 0, PREP_SPLIT);
}
PHASE_FN void ph_wout(const Frame& F0, int ly) { const Frame F = relaunder(F0);
    pg8::Gemm g{(const bf16_t*)(F.ws + WS_MIX), (const bf16_t*)(F.ws + WS_WOUT), DM, F.tid};
    pg8::StaticOrder S; S.init(ly == DEPTH - 1 ? RLAT / 256 : RTOT / 256, DM / 256, F.G, F.bid);
    EpiWout E{F.ws, ly, F.in[0], F.in[2]};
    pg8::gemm_phase<EpiWout, pg8::StaticOrder>(F.lds, g, S, E);
    __syncthreads();
    prep_experts(F, ly, CW_PREPQ2, PREP_SPLIT, PREP_SPLIT2);
}
PHASE_FN void ph_router(const Frame& F0, int ly) { const Frame F = relaunder(F0); phase_rows_router(F, ly); prep_experts(F, ly, CW_PREPQ4, PREP_SPLIT2, 3 * 1040); }
PHASE_FN void ph_moe1(const Frame& F0, int ly) { const Frame F = relaunder(F0);
    const MoeTab T = moe_tables(F, ly);
    pg8::Gemm g{(const bf16_t*)(F.ws + WS_H), (const bf16_t*)(F.ws + WS_WGU), DM, F.tid};
    MoeSched<true> S{T, (const int*)(F.ws + WS_LIST), F.G, F.bid, 2, 1};
    EpiMoe1 E{F.ws};
    pg8::gemm_phase<EpiMoe1, MoeSched<true>>(F.lds, g, S, E);
    __syncthreads();
    if (ly + 1 < DEPTH) prep_small_dyn(F, ly + 1);
}
PHASE_FN void ph_moe2(const Frame& F0, int ly) { const Frame F = relaunder(F0);
    const MoeTab T = moe_tables(F, ly);
    pg8::Gemm g{(const bf16_t*)(F.ws + WS_ACT), (const bf16_t*)(F.ws + WS_WD), DEXP, F.tid};
    MoeSched<false> S{T, (const int*)(F.ws + WS_LIST), F.G, F.bid, 4, 2};
    EpiMoe2 E{F.ws};
    pg8::gemm_phase<EpiMoe2, MoeSched<false>>(F.lds, g, S, E);
}
PHASE_FN void ph_combine(const Frame& F0, int ly) { const Frame F = relaunder(F0); phase_combine(F, ly); }

constexpr int PH_PER_LAYER = 7, N_PHASES = 2 + DEPTH * PH_PER_LAYER;

__global__ void __launch_bounds__(NTHR, 2) hybrid_fwd(Params prm) {
    extern __shared__ __attribute__((aligned(16))) unsigned char lds_raw[];
    Frame F;
    F.in = prm.in; F.out = prm.out; F.ws = prm.ws; F.lds = (LAS unsigned char*)lds_raw; F.ctl = (unsigned*)(prm.ws + WS_CTL);
    F.tid = threadIdx.x; F.lane = F.tid & 63; F.wave = __builtin_amdgcn_readfirstlane(F.tid >> 6); F.G = gridDim.x; F.bid = blockIdx.x;
    volatile LAS unsigned* MISC = (volatile LAS unsigned*)(F.lds + LDS_MISC);
    if (F.tid < 64) MISC[F.tid] = 0u;
    __syncthreads();
    const int lo = prm.ph_lo, hi = prm.ph_hi;
    XcdBarrier bar; bar.bar = F.ctl + CW_BAR; bar.x = 0; bar.st = nullptr;
    if (hi - lo > 1) bar = xcd_barrier_post(F.ctl + CW_BAR, MISC);
#define IN(k) (lo <= (k) && (k) < hi)
    unsigned long long pr_acc = 0ull, pr_t0 = 0ull;
#define SEAM(k) do { if (IN(k) && IN((k) + 1)) { unsigned long long _b0 = 0; if ((PROBE_KINDS >> 12) & 1) _b0 = __builtin_amdgcn_s_memrealtime(); xcd_barrier(bar); if ((PROBE_KINDS >> 12) & 1) pr_acc += __builtin_amdgcn_s_memrealtime() - _b0; } } while (0)
#define PR_BEGIN(kind) do { if ((PROBE_KINDS >> (kind)) & 1) pr_t0 = __builtin_amdgcn_s_memrealtime(); } while (0)
#define PR_END(kind) do { if ((PROBE_KINDS >> (kind)) & 1) pr_acc += __builtin_amdgcn_s_memrealtime() - pr_t0; } while (0)

    PR_BEGIN(0); if (IN(0) && KIND(0)) { const Frame Fp = relaunder(F); PR_BEGIN(13); prep_small(Fp, 0); PR_END(13); PR_BEGIN(14); prep_mod(Fp); PR_END(14); PR_BEGIN(15); prep_filters(Fp); PR_END(15); PR_BEGIN(16); prep_tables(Fp); PR_END(16); }
    PR_END(0); SEAM(0);
    PR_BEGIN(1); if (IN(1) && KIND(1)) ph_pre1(F);
    PR_END(1); SEAM(1);

    for (int ly = 0; ly < DEPTH; ++ly) {
        const int p0 = 2 + ly * PH_PER_LAYER;
        PR_BEGIN(2); if (IN(p0) && KIND(2)) ph_win(F, ly);
        PR_END(2); SEAM(p0);
        if (IN(p0 + 1)) { PR_BEGIN(5); ph_mix(F, ly); }
        PR_END(5); SEAM(p0 + 1);
        PR_BEGIN(6); if (IN(p0 + 2) && KIND(6)) ph_wout(F, ly);
        PR_END(6); SEAM(p0 + 2);
        PR_BEGIN(7); if (IN(p0 + 3) && KIND(7)) ph_router(F, ly);
        PR_END(7); SEAM(p0 + 3);
        PR_BEGIN(8); if (IN(p0 + 4) && KIND(8)) ph_moe1(F, ly);
        PR_END(8); SEAM(p0 + 4);
        PR_BEGIN(9); if (IN(p0 + 5) && KIND(9)) ph_moe2(F, ly);
        PR_END(9); SEAM(p0 + 5);
        PR_BEGIN(10); if (IN(p0 + 6) && KIND(10)) { const Frame Fc = relaunder(F); PR_BEGIN(17); phase_combine(Fc, ly); PR_END(17);  }
        PR_END(10); SEAM(p0 + 6);
    }
    if (PROBE_KINDS != 0 && blockIdx.x == 0) {
        const unsigned long long t0 = __builtin_amdgcn_s_memrealtime(), wait = pr_acc * (unsigned long long)PROBE_AMP;
        while (__builtin_amdgcn_s_memrealtime() - t0 < wait) __builtin_amdgcn_s_sleep(8);
    }
#undef IN
#undef SEAM
}

extern "C" void kernel_launch(void* const* d_in, const int* in_sizes, int n_in, void* d_out, int out_size, void* d_ws, size_t ws_size, hipStream_t stream) {
    static int grid = 0;
    if (grid == 0) {
        if (n_in != 34 || out_size != RLAT * DM || ws_size < WS_END) { fprintf(stderr, "kernel_launch: unexpected problem shape (n_in %d out %d ws %zu need %zu)\n", n_in, out_size, ws_size, (size_t)WS_END); grid = -1; return; }
        int dev = 0, cus = 0, per_cu = 0;
        if (hipGetDevice(&dev) != hipSuccess || hipDeviceGetAttribute(&cus, hipDeviceAttributeMultiprocessorCount, dev) != hipSuccess) { grid = -1; return; }
        if (hipFuncSetAttribute((const void*)hybrid_fwd, hipFuncAttributeMaxDynamicSharedMemorySize, LDS_BYTES) != hipSuccess) { fprintf(stderr, "kernel_launch: hipFuncSetAttribute failed\n"); grid = -1; return; }
        if (hipOccupancyMaxActiveBlocksPerMultiprocessor(&per_cu, (const void*)hybrid_fwd, NTHR, LDS_BYTES) != hipSuccess || per_cu < 1)
            fprintf(stderr, "kernel_launch: occupancy query reports %d workgroups per CU\n", per_cu);
        (void)hipGetLastError();
        grid = cus;
    }
    if (grid < 0) return;
    (void)hipMemsetAsync((char*)d_ws + WS_CTL, 0, CTL_BYTES, stream);
    Params p{};
    for (int i = 0; i < 34; ++i) p.in[i] = (const float*)d_in[i];
    p.out = (float*)d_out; p.ws = (unsigned char*)d_ws;
#if MK_PER_PHASE
    for (int ph = 0; ph < N_PHASES; ++ph) { p.ph_lo = ph; p.ph_hi = ph + 1; hipLaunchKernelGGL(hybrid_fwd, dim3(grid), dim3(NTHR), LDS_BYTES, stream, p); }
#else
    p.ph_lo = 0; p.ph_hi = N_PHASES;
    hipLaunchKernelGGL(hybrid_fwd, dim3(grid), dim3(NTHR), LDS_BYTES, stream, p);
#endif
}
```

```cpp
#include <hip/hip_runtime.h>
#include <cstdio>
#include <cstdint>

#ifndef MK_PER_PHASE
#define MK_PER_PHASE 0
#endif

#ifndef PG8_OPAQUE_K
#define PG8_OPAQUE_K 1
#endif
#ifndef MK_OUTLINE
#define MK_OUTLINE 0
#endif
#if MK_OUTLINE
#define PHASE_FN __device__ __attribute__((noinline))
#else
#define PHASE_FN __device__ __forceinline__
#endif
#ifndef PROBE_KINDS
#define PROBE_KINDS 0
#endif
#ifndef PROBE_AMP
#define PROBE_AMP 4
#endif
#ifndef KMASK
#define KMASK 0xFFFF
#endif
#define KIND(k) ((KMASK >> (k)) & 1)
#define LAS __attribute__((address_space(3)))
typedef unsigned short bf16_t;
typedef short bf16x8 __attribute__((ext_vector_type(8)));
typedef short s16x4 __attribute__((ext_vector_type(4)));
typedef float f32x4 __attribute__((ext_vector_type(4)));
typedef float f32x16 __attribute__((ext_vector_type(16)));
typedef unsigned u32x4 __attribute__((ext_vector_type(4)));
typedef unsigned u32x2 __attribute__((ext_vector_type(2)));
#define DI __device__ __forceinline__

constexpr int NB = 4, SEQ = 4096, CTXL = 256, DM = 1024, DEPTH = 4;
constexpr int POS = SEQ + CTXL;
constexpr int RLAT = NB * SEQ, RCTX = NB * CTXL, RTOT = RLAT + RCTX;
constexpr int DIN = 2560, NWIN = 2816;
constexpr int NEXP = 64, DEXP = 256;
constexpr float LN_EPS = 1e-5f;
constexpr float ALPHA = 1.681792830507429f;
constexpr float QSCALE = 0.17677669529663687f * 1.4426950408889634f;
constexpr int MAXTILES = 680;

constexpr size_t AL(size_t x) { return (x + 255) & ~(size_t)255; }
constexpr size_t WS_CTL = 0, CTL_BYTES = 1u << 17;
constexpr size_t WS_X = WS_CTL + CTL_BYTES;
constexpr size_t WS_H = WS_X + AL((size_t)RTOT * DM * 4);
constexpr size_t WS_MOD = WS_H + AL((size_t)RTOT * DM * 2);
constexpr size_t WS_HCL = WS_MOD + AL((size_t)DEPTH * 5 * 6144 * 4);
constexpr size_t WS_HCC = WS_HCL + AL((size_t)DEPTH * 4 * 256 * SEQ * 4);
constexpr size_t WS_INVL1 = WS_HCC + AL((size_t)DEPTH * 4 * 256 * CTXL * 4);
constexpr size_t WS_DFTL = WS_INVL1 + AL((size_t)DEPTH * 2 * 2 * 256 * 4);
constexpr size_t WS_DFTC = WS_DFTL + 256;
constexpr size_t WS_ROPE = WS_DFTC + AL((size_t)CTXL * 2 * CTXL * 2);
constexpr size_t WS_LAM = WS_ROPE + AL(64 * 8 * 2 * 4);
constexpr size_t WS_WIN = WS_LAM + 256;
constexpr size_t WS_WOUT = WS_WIN + AL((size_t)NWIN * DM * 2);
constexpr size_t WS_WGU = WS_WOUT + AL((size_t)DM * DM * 2);
constexpr size_t WS_WD = WS_WGU + AL((size_t)65 * 512 * DM * 2);
constexpr size_t WS_TOPE = WS_WD + AL((size_t)65 * DM * DEXP * 2);
constexpr size_t WS_TOPG = WS_TOPE + AL((size_t)RTOT * 8 * 4);
constexpr size_t WS_LIST = WS_TOPG + AL((size_t)RTOT * 8 * 4);
constexpr size_t WS_SPEC = WS_LIST + AL((size_t)NEXP * RTOT * 4);
constexpr size_t WS_Z1 = WS_SPEC + AL((size_t)256 * 2 * 8192 * 8);
constexpr size_t WS_U = WS_Z1 + AL((size_t)256 * SEQ * 4 * 4);
constexpr size_t WS_Q = WS_U;
constexpr size_t WS_K = WS_Q + AL((size_t)NB * 8 * POS * 64 * 2);
constexpr size_t WS_V = WS_K + AL((size_t)NB * 8 * POS * 64 * 2);
constexpr size_t WS_HYT = WS_V + AL((size_t)NB * 8 * POS * 64 * 2);
constexpr size_t WS_YTL = WS_HYT + AL((size_t)NB * 768 * POS * 4);
constexpr size_t WS_YTC = WS_YTL + AL((size_t)1024 * 8192 * 2);
constexpr size_t WS_MIX = WS_YTC + AL((size_t)1024 * 512 * 2);
constexpr size_t WS_U1_END = WS_MIX + AL((size_t)RTOT * DM * 2);
constexpr size_t WS_ACT = WS_U;
constexpr size_t WS_YB = WS_ACT + AL((size_t)MAXTILES * 256 * DEXP * 2);
constexpr size_t WS_U2_END = WS_YB + AL((size_t)MAXTILES * 256 * DM * 2);
constexpr size_t WS_END = WS_U2_END > WS_U1_END ? WS_U2_END : WS_U1_END;

constexpr int CW_BAR = 0;
constexpr int CW_ATTN = 4096;
constexpr int CW_PREPQ = 4096 + 1024;
constexpr int CW_PREPQ2 = 4096 + 1536;
constexpr int CW_PREPQ3 = 4096 + 2048;
constexpr int CW_PREPQ4 = 4096 + 2560;
constexpr int PREP_SPLIT2 = 2640;
constexpr int PREP_SPLIT = 1200;
constexpr int CW_KMAX = 4096 + 512;
constexpr int CW_CNT = 8192;
constexpr int CNT_STRIDE = 64;

DI unsigned cvt_pk_bf16(float lo, float hi) { unsigned r; asm volatile("v_cvt_pk_bf16_f32 %0, %1, %2" : "=v"(r) : "v"(lo), "v"(hi)); return r; }
DI bf16x8 pack8(float a0, float a1, float a2, float a3, float a4, float a5, float a6, float a7) {
    u32x4 p;
    asm volatile("v_cvt_pk_bf16_f32 %0, %4, %5\n\tv_cvt_pk_bf16_f32 %1, %6, %7\n\tv_cvt_pk_bf16_f32 %2, %8, %9\n\tv_cvt_pk_bf16_f32 %3, %10, %11\n\ts_nop 1"
                 : "=&v"(p[0]), "=&v"(p[1]), "=&v"(p[2]), "=&v"(p[3]) : "v"(a0), "v"(a1), "v"(a2), "v"(a3), "v"(a4), "v"(a5), "v"(a6), "v"(a7));
    return __builtin_bit_cast(bf16x8, p);
}
DI bf16_t f2bf(float x) { return (bf16_t)(cvt_pk_bf16(x, 0.f) & 0xffffu); }
DI float bf2f(unsigned short u) { return __uint_as_float(((unsigned)u) << 16); }
DI float bflo(unsigned w) { return __uint_as_float(w << 16); }
DI float bfhi(unsigned w) { return __uint_as_float(w & 0xffff0000u); }
DI float wave_sum(float v) {
#pragma unroll
    for (int o = 32; o >= 1; o >>= 1) v += __shfl_xor(v, o);
    return v;
}
DI float wave_max(float v) {
#pragma unroll
    for (int o = 32; o >= 1; o >>= 1) v = fmaxf(v, __shfl_xor(v, o));
    return v;
}

#define XB_TMO      128
#define XB_XCNT(j)  (256  + 64 * (j))
#define XB_XSUB(j)  (1280 + 64 * (j))
#define XB_XGEN(j)  (2304 + 64 * (j))
#define XB_TOP      3328
#define XB_TOPGEN   3392
#define XCD_BAR_WORDS 3456
#define XB_SPIN_CAP (1u << 18)

__device__ __forceinline__ unsigned xb_ld(unsigned* p)              { return __hip_atomic_load(p, __ATOMIC_RELAXED, __HIP_MEMORY_SCOPE_AGENT); }
__device__ __forceinline__ unsigned xb_add(unsigned* p, unsigned v) { return __hip_atomic_fetch_add(p, v, __ATOMIC_RELAXED, __HIP_MEMORY_SCOPE_AGENT); }
__device__ __forceinline__ unsigned xb_xcc_id() { return (unsigned)__builtin_amdgcn_s_getreg((3 << 11) | 20) & 0xFu; }
#define XB_SPIN(cond, bar) do { unsigned _sp = 0; while (cond) { __builtin_amdgcn_s_sleep(1); \
    if ((++_sp & 255u) == 0u) { if (xb_ld(&(bar)[XB_TMO])) break; if (_sp > XB_SPIN_CAP) { atomicAdd(&(bar)[XB_TMO], 1u); break; } } } } while (0)

struct XcdBarrier { unsigned* bar; unsigned x; volatile LAS unsigned* st; };

__device__ __forceinline__ XcdBarrier xcd_barrier_post(unsigned* bar, volatile LAS unsigned* st) {
    XcdBarrier b; b.bar = bar; b.x = xb_xcc_id(); b.st = st;
    if (threadIdx.x == 0) (void)xb_add(&bar[XB_XCNT(b.x)], 1u);
    return b;
}
__device__ __forceinline__ void xcd_barrier_complete(unsigned* bar, unsigned x, unsigned& nloc, unsigned& nx) {
    const unsigned G = gridDim.x * gridDim.y * gridDim.z;
    unsigned sum, cnt, mine, sp = 0u;
    for (;;) {
        sum = 0u; cnt = 0u; mine = 0u;
#pragma unroll
        for (unsigned j = 0; j < 16; ++j) { const unsigned c = xb_ld(&bar[XB_XCNT(j)]); sum += c; cnt += (c > 0u) ? 1u : 0u; mine = (j == x) ? c : mine; }
        if (sum == G) break;
        __builtin_amdgcn_s_sleep(1);
        if ((++sp & 255u) == 0u) { if (xb_ld(&bar[XB_TMO])) break; if (sp > XB_SPIN_CAP) { atomicAdd(&bar[XB_TMO], 1u); break; } }
    }
    nloc = mine > 0u ? mine : 1u; nx = cnt > 0u ? cnt : 1u;
}
__device__ __forceinline__ void xcd_barrier(const XcdBarrier& b) {
    asm volatile("s_waitcnt vmcnt(0)" ::: "memory");
    __syncthreads();
    if (threadIdx.x == 0) {
        unsigned* bar = b.bar;
        __builtin_amdgcn_s_waitcnt(0);
        unsigned nloc = b.st[0], nx = b.st[1];
        if (nloc == 0u) { xcd_barrier_complete(bar, b.x, nloc, nx); b.st[0] = nloc; b.st[1] = nx; }
        const unsigned old = xb_add(&bar[XB_XSUB(b.x)], 1u);
        const unsigned gen = old / nloc;
        if (old + 1u == (gen + 1u) * nloc) {
            __builtin_amdgcn_fence(__ATOMIC_RELEASE, "agent");
            asm volatile("s_waitcnt vmcnt(0)" ::: "memory");
            const unsigned og = xb_add(&bar[XB_TOP], 1u);
            const unsigned tg = og / nx;
            if (og + 1u == (tg + 1u) * nx) xb_add(&bar[XB_TOPGEN], 1u);
            else XB_SPIN(xb_ld(&bar[XB_TOPGEN]) == tg, bar);
            __builtin_amdgcn_fence(__ATOMIC_ACQUIRE, "agent");
            xb_add(&bar[XB_XGEN(b.x)], 1u);
            asm volatile("s_waitcnt vmcnt(0)" ::: "memory");
        } else {
            XB_SPIN(xb_ld(&bar[XB_XGEN(b.x)]) == gen, bar);
            __builtin_amdgcn_fence(__ATOMIC_ACQUIRE, "agent");
            asm volatile("s_waitcnt vmcnt(0)" ::: "memory");
        }
    }
    __syncthreads();
}

namespace pg8 {
constexpr int BM = 256, BK = 64, HALF = 128, HTB = HALF * BK * 2, STAGE_BYTES = 8 * HTB, NXCD = 8, WGM = 8;
__host__ __device__ __forceinline__ int lds_byte(int r, int c) { const int st = (r >> 4) * 2 + (c >> 5), rr = r & 15, cc = c & 31, ob = rr * 64 + cc * 2; return st * 1024 + (ob ^ (((ob >> 9) & 1) << 5)); }
__host__ __device__ __forceinline__ void stage_rc(int b, int& R, int& C) { const int st = b / 1024, sb = b % 1024, swz = sb ^ (((sb >> 9) & 1) << 5); R = (st >> 1) * 16 + swz / 64; C = (st & 1) * 32 + (swz % 64) / 2; }
__host__ __device__ __forceinline__ int perm32(int rho) { const int n = rho >> 4, i = rho & 15; return 8 * (i >> 2) + 4 * n + (i & 3); }

struct Unit { int pm, pn, e, lt; };
struct Gemm { const bf16_t* A; const bf16_t* Bt; int K; int tid; };

struct StaticOrder {
    static constexpr bool GATHER = false;
    int nM, nN, nwg, G, c;
    __device__ void init(int nM_, int nN_, int G_, int c_) { nM = nM_; nN = nN_; nwg = nM * nN; G = G_; c = c_; }
    __device__ bool next(int i, Unit& u) const {
        const long L = (long)i * G + c; if (L >= nwg) return false;
        int wgid = (int)L; { const int q = nwg / NXCD, r = nwg % NXCD, xcd = wgid % NXCD, off = wgid / NXCD; wgid = (xcd < r ? xcd * (q + 1) : r * (q + 1) + (xcd - r) * q) + off; }
        const int nig = WGM * nN, gid = wgid / nig, fm = gid * WGM, gsz = (nM - fm) < WGM ? (nM - fm) : WGM;
        u.pm = fm + ((wgid % nig) % gsz); u.pn = (wgid % nig) / gsz; u.e = 0; u.lt = 0; return true;
    }
    __device__ __forceinline__ int arow(const Unit& u, int r) const { return u.pm * BM + r; }
};

template <class Epi, class Sched>
__device__ __forceinline__ void gemm_phase(LAS unsigned char* lds, const Gemm g, const Sched& S, const Epi& E) {
    constexpr bool GA = Sched::GATHER;
    int tid = g.tid; asm volatile("" : "+v"(tid));
    const int wid = __builtin_amdgcn_readfirstlane(tid >> 6), lane = tid & 63, wr = wid >> 2, wc = wid & 3, fr = lane & 15, fq = lane >> 4;
    int K = g.K;
#if PG8_OPAQUE_K
    asm volatile("" : "+s"(K));
#endif
    const int nt = K / BK;
    unsigned voffA[2], voffB[2];
#pragma unroll
    for (int i = 0; i < 2; ++i) { int R, C; stage_rc(tid * 16 + i * 8192, R, C); const int Rb = Epi::PERM ? ((R & ~31) + perm32(R & 31)) : R;
        voffA[i] = (unsigned)(R * K + C) * 2u; voffB[i] = (unsigned)(Rb * K + C) * 2u; }
    const size_t kstep = (size_t)(BK * 2);
    const size_t hstep = (size_t)HALF * K * 2;
    const size_t tstep = 2 * hstep;
    const unsigned ldsw = (unsigned)wid * 1024u;
    const int aoff = lds_byte(wr * 64 + fr, fq * 8), boff = lds_byte(wc * 32 + fr, fq * 8);
#define PG8_SA(b, h) (((b) * 2 + (h)) * HTB)
#define PG8_SB(b, h) ((4 + (b) * 2 + (h)) * HTB)
#define PG8_STAGE(bufoff, gbase, voff) do { _Pragma("unroll") for (int _i = 0; _i < 2; ++_i) \
        __builtin_amdgcn_global_load_lds((const unsigned*)((const char*)(gbase) + (voff)[_i]), (LAS unsigned*)(lds + (bufoff) + ldsw + _i * 8192), 16, 0, 0); } while (0)
#define PG8_STAGEA(bufoff, gbase, o0, o1) do { \
        __builtin_amdgcn_global_load_lds((const unsigned*)((const char*)(gbase) + (o0)), (LAS unsigned*)(lds + (bufoff) + ldsw), 16, 0, 0); \
        __builtin_amdgcn_global_load_lds((const unsigned*)((const char*)(gbase) + (o1)), (LAS unsigned*)(lds + (bufoff) + ldsw + 8192), 16, 0, 0); } while (0)
#define PG8_STA(bufoff, sp, gp, o0, o1) do { if constexpr (GA) PG8_STAGEA(bufoff, gp, o0, o1); else PG8_STAGE(bufoff, sp, voffA); } while (0)
#define PG8_LDA(dst, b, h) do { _Pragma("unroll") for (int m = 0; m < 4; ++m) _Pragma("unroll") for (int k = 0; k < 2; ++k) dst[m][k] = *(const LAS bf16x8*)(lds + PG8_SA(b, h) + aoff + m * 2048 + k * 1024); } while (0)
#define PG8_LDB(dst, b, h) do { _Pragma("unroll") for (int n = 0; n < 2; ++n) _Pragma("unroll") for (int k = 0; k < 2; ++k) dst[n][k] = *(const LAS bf16x8*)(lds + PG8_SB(b, h) + boff + n * 2048 + k * 1024); } while (0)
#define PG8_MMA(ai, bj, At, Bt) do { __builtin_amdgcn_s_setprio(1); _Pragma("unroll") for (int m = 0; m < 4; ++m) _Pragma("unroll") for (int n = 0; n < 2; ++n) _Pragma("unroll") for (int k = 0; k < 2; ++k) \
        acc[ai][bj][m][n] = __builtin_amdgcn_mfma_f32_16x16x32_bf16(Bt[n][k], At[m][k], acc[ai][bj][m][n], 0, 0, 0); __builtin_amdgcn_s_setprio(0); } while (0)
#define PG8_WAIT_V(n) asm volatile("s_waitcnt vmcnt(" #n ")" ::: "memory")
#define PG8_WAIT_L(n) asm volatile("s_waitcnt lgkmcnt(" #n ")" ::: "memory")
#define PG8_BAR __builtin_amdgcn_s_barrier()
#define PG8_SCHED __builtin_amdgcn_sched_barrier(0)
#define PG8_GOFF(u, o00, o01, o10, o11) do { int _tz = g.tid; asm volatile("" : "+v"(_tz)); int _R0, _C0, _R1, _C1; stage_rc(_tz * 16, _R0, _C0); stage_rc(_tz * 16 + 8192, _R1, _C1); \
        o00 = (unsigned)(S.arow(u, _R0) * K + _C0) * 2u; o01 = (unsigned)(S.arow(u, _R1) * K + _C1) * 2u; \
        o10 = (unsigned)(S.arow(u, HALF + _R0) * K + _C0) * 2u; o11 = (unsigned)(S.arow(u, HALF + _R1) * K + _C1) * 2u; } while (0)
    Unit cur, nxt; int ui = 0;
    if (!S.next(0, cur)) return;
    f32x4 acc[2][2][4][2];
#pragma unroll
    for (int a = 0; a < 2; ++a)
#pragma unroll
        for (int b = 0; b < 2; ++b)
#pragma unroll
            for (int m = 0; m < 4; ++m)
#pragma unroll
                for (int n = 0; n < 2; ++n) acc[a][b][m][n] = (f32x4){0.f, 0.f, 0.f, 0.f};
    bf16x8 At[4][2], B0[2][2], B1[2][2];
    const char* const gA = (const char*)g.A;
    unsigned c00 = 0, c01 = 0, c10 = 0, c11 = 0, n00 = 0, n01 = 0, n10 = 0, n11 = 0;
    if constexpr (GA) PG8_GOFF(cur, c00, c01, c10, c11);
    const char* cA = gA + (GA ? (size_t)0 : (size_t)cur.pm * tstep); const char* cB = (const char*)g.Bt + (size_t)cur.pn * tstep;
    PG8_STAGE(PG8_SB(0, 0), cB, voffB); PG8_STAGE(PG8_SB(0, 1), cB + hstep, voffB); PG8_STA(PG8_SA(0, 0), cA, gA, c00, c01); PG8_STA(PG8_SA(0, 1), cA + hstep, gA, c10, c11);
    if (wr == 1) PG8_BAR;
    PG8_WAIT_V(2); PG8_BAR;
    PG8_STAGE(PG8_SB(1, 0), cB + kstep, voffB); PG8_STA(PG8_SA(1, 0), cA + kstep, gA + kstep, c00, c01); PG8_STAGE(PG8_SB(1, 1), cB + hstep + kstep, voffB);
    PG8_WAIT_V(6); PG8_BAR;
    for (;;) {
        const bool has_next = S.next(ui + 1, nxt);
        const char* nA = (has_next && !GA) ? gA + (size_t)nxt.pm * tstep : cA; const char* nB = has_next ? (const char*)g.Bt + (size_t)nxt.pn * tstep : cB;
        if constexpr (GA) { if (has_next) PG8_GOFF(nxt, n00, n01, n10, n11); else { n00 = c00; n01 = c01; n10 = c10; n11 = c11; } }
#pragma unroll 1
        for (int t = 0; t < nt; t += 2) {
            const bool last = (t == nt - 2);
            const char* a1 = cA + (size_t)(t + 1) * kstep;
            const char* a2 = last ? nA : cA + (size_t)(t + 2) * kstep; const char* b2 = last ? nB : cB + (size_t)(t + 2) * kstep;
            const char* a3 = a2 + kstep; const char* b3 = b2 + kstep;
            unsigned x00 = 0, x01 = 0, x10 = 0, x11 = 0;
            if constexpr (GA) { x00 = last ? n00 : c00; x01 = last ? n01 : c01; x10 = last ? n10 : c10; x11 = last ? n11 : c11; }
            PG8_LDB(B0, 0, 0); PG8_LDB(B1, 0, 1); PG8_SCHED; PG8_LDA(At, 0, 0); PG8_STA(PG8_SA(1, 1), a1 + hstep, a1, c10, c11);
            PG8_WAIT_V(8); PG8_WAIT_L(0); PG8_BAR; PG8_MMA(0, 0, At, B0); PG8_MMA(0, 1, At, B1); PG8_BAR; PG8_SCHED;
            PG8_LDA(At, 0, 1); PG8_STAGE(PG8_SB(0, 0), b2, voffB); PG8_STAGE(PG8_SB(0, 1), b2 + hstep, voffB); PG8_STA(PG8_SA(0, 0), a2, a2, x00, x01);
            PG8_WAIT_V(8); PG8_WAIT_L(0); PG8_BAR; PG8_MMA(1, 0, At, B0); PG8_MMA(1, 1, At, B1); PG8_BAR; PG8_SCHED;
            PG8_LDB(B0, 1, 0); PG8_LDB(B1, 1, 1); PG8_SCHED; PG8_LDA(At, 1, 0); PG8_STA(PG8_SA(0, 1), a2 + hstep, a2, x10, x11);
            PG8_WAIT_V(8); PG8_WAIT_L(0); PG8_BAR; PG8_MMA(0, 0, At, B0); PG8_MMA(0, 1, At, B1); PG8_BAR; PG8_SCHED;
            PG8_LDA(At, 1, 1); PG8_STAGE(PG8_SB(1, 0), b3, voffB); PG8_STAGE(PG8_SB(1, 1), b3 + hstep, voffB); PG8_STA(PG8_SA(1, 0), a3, a3, x00, x01);
            PG8_WAIT_V(8); PG8_WAIT_L(0); PG8_BAR; PG8_MMA(1, 0, At, B0); PG8_MMA(1, 1, At, B1); PG8_BAR; PG8_SCHED;
        }
        if (wr == 0) PG8_BAR;
        { int ln = (int)__builtin_amdgcn_mbcnt_hi(~0u, __builtin_amdgcn_mbcnt_lo(~0u, 0u)); asm volatile("" : "+v"(ln));
          E(acc, cur, wr, wc, ln & 15, ln >> 4); }
        if (!has_next) break;
#pragma unroll
        for (int a = 0; a < 2; ++a)
#pragma unroll
            for (int b = 0; b < 2; ++b)
#pragma unroll
                for (int m = 0; m < 4; ++m)
#pragma unroll
                    for (int n = 0; n < 2; ++n) acc[a][b][m][n] = (f32x4){0.f, 0.f, 0.f, 0.f};
        cur = nxt; cA = nA; cB = nB; ++ui;
        if constexpr (GA) { c00 = n00; c01 = n01; c10 = n10; c11 = n11; }
        if (wr == 1) PG8_BAR;
    }
    PG8_WAIT_V(0);
    PG8_BAR;
#undef PG8_SA
#undef PG8_SB
#undef PG8_STAGE
#undef PG8_STAGEA
#undef PG8_STA
#undef PG8_GOFF
#undef PG8_LDA
#undef PG8_LDB
#undef PG8_MMA
#undef PG8_WAIT_V
#undef PG8_WAIT_L
#undef PG8_BAR
#undef PG8_SCHED
}
}

constexpr int NTHR = 512;
constexpr int LDS_SCRATCH = 139264;
constexpr int LDS_MISC = LDS_SCRATCH;
constexpr int LDS_TAB = LDS_MISC + 256;
constexpr int LDS_BYTES = LDS_TAB + 8192;

struct Params { const float* in[34]; float* out; unsigned char* ws; int ph_lo, ph_hi; };

struct Frame {
    const float* const* in; float* out; unsigned char* ws; LAS unsigned char* lds; unsigned* ctl;
    int tid, lane, wave, G, bid;
};

DI int row_b(int row) { return row < RLAT ? (row >> 12) : ((row - RLAT) >> 8); }
DI int row_pos(int row) { return row < RLAT ? (row & 4095) : (SEQ + ((row - RLAT) & 255)); }
DI int row_modsel(int row) { return row < RLAT ? (row >> 12) : 4; }

DI Frame relaunder(const Frame& F0) {
    Frame F = F0; int wv = F0.wave; asm volatile("" : "+s"(wv));
    int ln = (int)__builtin_amdgcn_mbcnt_hi(~0u, __builtin_amdgcn_mbcnt_lo(~0u, 0u)); asm volatile("" : "+v"(ln));
    F.wave = wv; F.lane = ln; F.tid = wv * 64 + ln;
    __attribute__((address_space(1))) unsigned char* w = (__attribute__((address_space(1))) unsigned char*)F0.ws; asm volatile("" : "+s"(w)); F.ws = (unsigned char*)w;
    F.ctl = (unsigned*)(F.ws + WS_CTL);
    int b = F0.bid, g = F0.G; asm volatile("" : "+s"(b), "+s"(g)); F.bid = b; F.G = g;
    return F;
}

DI void prep_fourier_job(const Frame& F, int ly, int g, int kt) {
    LAS float* FW = (LAS float*)F.lds;
    LAS float* CS = FW + 4096;
    LAS float* P = CS + 128;
    LAS float* W = P + 8192;
    const int t = F.tid;
    const float* fw = F.in[21] + ((size_t)ly * 4 + g) * 4096;
    for (int i = t; i < 4096; i += NTHR) FW[i] = fw[i];
    if (t < 64) { float s, c; sincospif((float)t / 32.0f, &s, &c); CS[t] = c; CS[64 + t] = s; }
    { const float* p = F.in[6] + (size_t)ly * DM * DIN + (size_t)(kt * 64 + (t >> 3)) * DIN + 2304 + g * 64 + (t & 7) * 8;
      const f32x4 a = *(const f32x4*)p, b = *(const f32x4*)(p + 4);
      LAS float* q = W + (t >> 3) * 65 + (t & 7) * 8;
      q[0] = a[0]; q[1] = a[1]; q[2] = a[2]; q[3] = a[3]; q[4] = b[0]; q[5] = b[1]; q[6] = b[2]; q[7] = b[3]; }
    __syncthreads();
    for (int i = t; i < 8192; i += NTHR) {
        const int c = i >> 7, n = i & 127, comp = n >> 6, d = n & 63;
        float s = 0.f;
        for (int j = 0; j < 64; ++j) { const int a = (j * c) & 63; const float tr = comp ? -CS[64 + a] : CS[a]; s += tr * FW[j * 64 + d]; }
        P[c * 128 + n] = s;
    }
    __syncthreads();
    bf16_t* dst = (bf16_t*)(F.ws + WS_WIN);
    { const int k = t >> 3, nb = (t & 7) * 16;
      float o[16];
#pragma unroll
      for (int j = 0; j < 16; ++j) o[j] = 0.f;
      for (int c = 0; c < 64; ++c) { const float w = W[k * 65 + c];
#pragma unroll
          for (int j = 0; j < 16; ++j) o[j] += w * P[c * 128 + nb + j]; }
#pragma unroll
      for (int j = 0; j < 16; ++j) { const int n = nb + j, comp = n >> 6, d = n & 63;
          dst[(size_t)(2304 + comp * 256 + g * 64 + d) * DM + kt * 64 + k] = f2bf(o[j]); } }
    __syncthreads();
}

struct PrepJob { const float* src; bf16_t* dst; int ldn, ldk, row0, hi_step; };
DI PrepJob prep_job(const Frame& F, int ly, int j) {
    constexpr int J1 = 144, J2 = J1 + 64, J3 = J2 + 1040, J4 = J3 + 1040;
    PrepJob r;
    if (j < J1) { const int kb = j / 9, nb = j % 9;
        r.src = F.in[6] + (size_t)ly * DM * DIN + (size_t)kb * 64 * DIN + nb * 256; r.ldn = DIN; r.dst = (bf16_t*)(F.ws + WS_WIN) + kb * 64; r.ldk = DM; r.row0 = nb * 256; r.hi_step = 128;
    } else if (j < J2) { const int q = j - J1, kb = q >> 2, nb = q & 3;
        r.src = F.in[7] + (size_t)ly * DM * DM + (size_t)kb * 64 * DM + nb * 256; r.ldn = DM; r.dst = (bf16_t*)(F.ws + WS_WOUT) + kb * 64; r.ldk = DM; r.row0 = nb * 256; r.hi_step = 128;
    } else if (j < J4) { const bool up = j >= J3; const int q = j - (up ? J3 : J2), e = q >> 4, kb = q & 15;
        const float* src = e < NEXP ? F.in[up ? 29 : 28] + ((size_t)ly * NEXP + e) * DM * DEXP : F.in[up ? 32 : 31] + (size_t)ly * DM * DEXP;
        r.src = src + (size_t)kb * 64 * DEXP; r.ldn = DEXP; r.dst = (bf16_t*)(F.ws + WS_WGU) + kb * 64; r.ldk = DM; r.row0 = e * 512 + (up ? 128 : 0); r.hi_step = 256;
    } else { const int q = j - J4, e = q >> 4, kb = (q >> 2) & 3, nb = q & 3;
        const float* src = e < NEXP ? F.in[30] + ((size_t)ly * NEXP + e) * DEXP * DM : F.in[33] + (size_t)ly * DEXP * DM;
        r.src = src + (size_t)kb * 64 * DM + nb * 256; r.ldn = DM; r.dst = (bf16_t*)(F.ws + WS_WD) + kb * 64; r.ldk = DEXP; r.row0 = e * DM + nb * 256; r.hi_step = 128; }
    return r;
}
DI void prep_load(const Frame& F, const PrepJob& jb, f32x4 (&v)[8]) {
    const float* p = jb.src + (size_t)(8 * (F.tid >> 6)) * jb.ldn + 4 * (F.tid & 63);
#pragma unroll
    for (int i = 0; i < 8; ++i) v[i] = __builtin_nontemporal_load((const f32x4*)(p + (size_t)i * jb.ldn));
}
DI void prep_store(const Frame& F, const PrepJob& jb, const f32x4 (&v)[8]) {
    LAS unsigned char* T = F.lds;
    const int t = F.tid, ln = t & 63, w = t >> 6;
#pragma unroll
    for (int pr = 0; pr < 4; ++pr)
#pragma unroll
        for (int e = 0; e < 4; ++e) *(LAS unsigned*)(T + (4 * ln + e) * 132 + (8 * w + 2 * pr) * 2) = cvt_pk_bf16(v[2 * pr][e], v[2 * pr + 1][e]);
    asm volatile("s_waitcnt lgkmcnt(0)" ::: "memory"); __builtin_amdgcn_s_barrier();
#pragma unroll
    for (int q = 0; q < 4; ++q) { const int n = q * 64 + (t >> 3), ch = t & 7;
        const LAS unsigned* r = (const LAS unsigned*)(T + n * 132 + ch * 16);
        u32x4 o; o.x = r[0]; o.y = r[1]; o.z = r[2]; o.w = r[3];
        *(u32x4*)(jb.dst + (size_t)(jb.row0 + (n >> 7) * jb.hi_step + (n & 127)) * jb.ldk + ch * 8) = o; }
    asm volatile("s_waitcnt lgkmcnt(0)" ::: "memory"); __builtin_amdgcn_s_barrier();
}
DI void prep_small(const Frame& F, int ly) {
    for (int j = F.bid; j < 208; j += F.G) { const PrepJob jb = prep_job(F, ly, j); f32x4 v[8]; prep_load(F, jb, v); prep_store(F, jb, v); }
    for (int q = F.G - 1 - F.bid; q < 64; q += F.G) prep_fourier_job(F, ly, q >> 4, q & 15);
}
DI void prep_small_dyn(const Frame& F0, int ly) {
    const Frame F = relaunder(F0);
    volatile LAS unsigned* MISC = (volatile LAS unsigned*)(F.lds + LDS_MISC);
    for (;;) {
        __syncthreads();
        if (F.tid == 0) MISC[18] = atomicAdd(F.ctl + CW_PREPQ3 + 64 * ly, 1u);
        __syncthreads();
        const int j = (int)MISC[18];
        if (j >= 272) break;
        if (j < 64) prep_fourier_job(F, ly, j >> 4, j & 15);
        else { const PrepJob jb = prep_job(F, ly, j - 64); f32x4 v[8]; prep_load(F, jb, v); prep_store(F, jb, v); }
    }
}
constexpr int PREP_CHUNK = 2, PREP_NJOBS = 3 * 1040;
DI void prep_experts(const Frame& F0, int ly, int cw, int j_lo, int j_hi) {
    const Frame F = relaunder(F0);
    volatile LAS unsigned* MISC = (volatile LAS unsigned*)(F.lds + LDS_MISC);
    for (;;) {
        __syncthreads();
        if (F.tid == 0) MISC[17] = atomicAdd(F.ctl + cw + 64 * ly, (unsigned)PREP_CHUNK);
        __syncthreads();
        const int base = j_lo + (int)MISC[17];
        if (base >= j_hi) break;
        const int end = base + PREP_CHUNK < j_hi ? base + PREP_CHUNK : j_hi;
        int j = base;
        PrepJob cur = prep_job(F, ly, 208 + j); f32x4 va[8]; prep_load(F, cur, va);
#pragma unroll 1
        for (;;) {
            const int jn = j + 1; const bool more = jn < end;
            PrepJob nxt = cur; f32x4 vb[8];
            if (more) { nxt = prep_job(F, ly, 208 + jn); prep_load(F, nxt, vb); }
            prep_store(F, cur, va);
            if (!more) break;
            cur = nxt; j = jn;
#pragma unroll
            for (int i = 0; i < 8; ++i) va[i] = vb[i];
        }
    }
}

DI void prep_mod(const Frame& F) {
    LAS float* S = (LAS float*)F.lds;
    LAS float* RED = S + 5 * 1024;
    const int t = F.tid;
    bool have_s = false;
    for (int u = F.bid; u < DEPTH * 96; u += F.G) {
        const int ly = u / 96, cg = u % 96;
        if (!have_s) {
            for (int i = t; i < 5 * 1024; i += NTHR) { const int r = i >> 10, k = i & 1023; const float x = r < 4 ? F.in[1][r * DM + k] : F.in[3][k]; S[i] = x / (1.f + expf(-x)); }
            __syncthreads(); have_s = true;
        }
        const int tq = t & 15, tk = t >> 4;
        const float* w = F.in[4] + (size_t)ly * DM * 6144 + cg * 64 + tq * 4;
        f32x4 acc[5];
#pragma unroll
        for (int r = 0; r < 5; ++r) acc[r] = (f32x4){0.f, 0.f, 0.f, 0.f};
#pragma unroll 1
        for (int k8 = 0; k8 < 32; k8 += 8) { f32x4 wv[8];
#pragma unroll
            for (int q = 0; q < 8; ++q) wv[q] = *(const f32x4*)(w + (size_t)(tk * 32 + k8 + q) * 6144);
#pragma unroll
            for (int q = 0; q < 8; ++q)
#pragma unroll
                for (int r = 0; r < 5; ++r) acc[r] += wv[q] * S[r * 1024 + tk * 32 + k8 + q]; }
#pragma unroll
        for (int r = 0; r < 5; ++r)
#pragma unroll
            for (int j = 0; j < 4; ++j) RED[(tk * 5 + r) * 64 + tq * 4 + j] = acc[r][j];
        __syncthreads();
        if (t < 320) { const int r = t >> 6, c = t & 63; float s = 0.f;
            for (int q = 0; q < 32; ++q) s += RED[(q * 5 + r) * 64 + c];
            const int col = cg * 64 + c;
            ((float*)(F.ws + WS_MOD))[((size_t)ly * 5 + r) * 6144 + col] = s + F.in[5][(size_t)ly * 6144 + col]; }
        __syncthreads();
    }
}

DI void prep_filters(const Frame& F) {
    LAS float* Z = (LAS float*)F.lds;
    LAS float* A1 = Z + 64 * 33;
    LAS float* A2 = A1 + 4096;
    for (int u = F.G - 1 - F.bid; u < DEPTH * 68; u += F.G) {
        int t = F.tid; asm volatile("" : "+v"(t));
        const int ly = u / 68, ch = u % 68; const bool lat = ch < 64; const int Lx = lat ? SEQ : CTXL, t0 = lat ? ch * 64 : (ch - 64) * 64;
        for (int i = t; i < 64 * 33; i += NTHR) { const int tt = i / 33, f = i % 33; const int ti = t0 + tt;
            float v;
            if (f == 0) v = (float)ti / (float)(Lx - 1);
            else { const int j = (f - 1) & 15; const float fb = 1e-4f + (float)j * ((15.0f - 1e-4f) / 15.0f); const float om = (6.283185307179586f / (float)Lx) * (float)ti;
                   v = f <= 16 ? cosf(fb * om) : -sinf(fb * om); }
            Z[i] = v; }
        __syncthreads();
        const float* w1 = F.in[9] + (size_t)ly * 33 * 64; const float* b1 = F.in[10] + ly * 64; const float* w2 = F.in[11] + (size_t)ly * 4096; const float* b2 = F.in[12] + ly * 64;
        const float* w3 = F.in[13] + (size_t)ly * 64 * 1024; const float* fq = F.in[14] + ly * 64;
        for (int i = t; i < 4096; i += NTHR) { const int tt = i >> 6, h = i & 63; float s = b1[h];
            for (int f = 0; f < 33; ++f) s += Z[tt * 33 + f] * w1[f * 64 + h];
            A1[i] = sinf(fq[h] * s); }
        __syncthreads();
        for (int i = t; i < 4096; i += NTHR) { const int tt = i >> 6, h = i & 63; float s = b2[h];
            for (int j = 0; j < 64; ++j) s += A1[tt * 64 + j] * w2[j * 64 + h];
            A2[i] = sinf(fq[h] * s); }
        __syncthreads();
        { float wr0[64], wr1[64];
#pragma unroll
          for (int j = 0; j < 64; ++j) { wr0[j] = w3[j * 1024 + t]; wr1[j] = w3[j * 1024 + 512 + t]; }
          const int c = t & 255, dir = t >> 8;
          const float delta = fabsf(-3.0701134573253946f + (float)c * ((-15.350567286626973f + 3.0701134573253946f) / 255.0f));
          float* d0 = lat ? (float*)(F.ws + WS_HCL) + ((((size_t)ly * 2 + 0) * 2 + dir) * 256 + c) * SEQ + t0 : (float*)(F.ws + WS_HCC) + ((((size_t)ly * 2 + 0) * 2 + dir) * 256 + c) * CTXL + t0;
          float* d1 = lat ? (float*)(F.ws + WS_HCL) + ((((size_t)ly * 2 + 1) * 2 + dir) * 256 + c) * SEQ + t0 : (float*)(F.ws + WS_HCC) + ((((size_t)ly * 2 + 1) * 2 + dir) * 256 + c) * CTXL + t0;
#pragma unroll 1
          for (int tt = 0; tt < 64; ++tt) { float s0 = 0.f, s1 = 0.f;
#pragma unroll
            for (int j = 0; j < 64; j += 4) { const f32x4 a = *(const LAS f32x4*)(A2 + tt * 64 + j);
                s0 += a[0] * wr0[j] + a[1] * wr0[j + 1] + a[2] * wr0[j + 2] + a[3] * wr0[j + 3]; s1 += a[0] * wr1[j] + a[1] * wr1[j + 1] + a[2] * wr1[j + 2] + a[3] * wr1[j + 3];
                if ((j & 12) == 12) asm volatile("" ::: "memory"); }
            const float dec = expf(-((float)(t0 + tt) / (float)(Lx - 1)) * delta);
            d0[tt] = s0 * dec; d1[tt] = s1 * dec; } }
        __syncthreads();
    }
}

DI void prep_tables(const Frame& F) {
    LAS float* CT = (LAS float*)F.lds;
    const int t = F.tid;
    for (int i = t; i < 4096; i += NTHR) CT[i] = cospif((float)i / 2048.0f);
    __syncthreads();
    bf16_t* DC = (bf16_t*)(F.ws + WS_DFTC);
    for (int i = F.bid * NTHR + t; i < CTXL * 512; i += F.G * NTHR) { const int k = i >> 9, cl = i & 511, comp = cl >> 8, l = cl & 255;
        const int idx = ((k * l) & 255) * 16; DC[i] = f2bf((comp ? CT[(idx - 1024) & 4095] : CT[idx]) * (1.0f / 128.0f)); }
    if (F.bid == (F.G > 1 ? 1 : 0) && t < DEPTH) { const int ly = t; const float lam_init = 0.8f - 0.6f * expf(-0.3f * (float)ly); float s1 = 0.f, s2 = 0.f;
        for (int i = 0; i < 32; ++i) { s1 += F.in[16][ly * 32 + i] * F.in[17][ly * 32 + i]; s2 += F.in[18][ly * 32 + i] * F.in[19][ly * 32 + i]; }
        ((float*)(F.ws + WS_LAM))[2 * ly] = expf(s1) - expf(s2) + lam_init; ((float*)(F.ws + WS_LAM))[2 * ly + 1] = lam_init; }
    if (F.bid == 0) { float* RT = (float*)(F.ws + WS_ROPE);
        for (int i = t; i < 512; i += NTHR) { const int p = i >> 3, n = i & 7; const float inv = powf(10000.0f, -(float)n / 8.0f); float s, c; sincosf((float)p * inv, &s, &c); RT[i * 2] = c; RT[i * 2 + 1] = s; } }
    __syncthreads();
}

DI void prep_invl1(const Frame& F) {
    const int gw = F.bid * 8 + F.wave, nw = F.G * 8;
    for (int j = gw; j < DEPTH * 2 * 2 * 256; j += nw) {
        const int ly = j >> 10, lt = (j >> 9) & 1, n = (j >> 8) & 1, c = j & 255;
        const int Lx = lt ? CTXL : SEQ;
        const float* base = lt ? (const float*)(F.ws + WS_HCC) : (const float*)(F.ws + WS_HCL);
        const f32x4* f0 = (const f32x4*)(base + ((((size_t)ly * 2 + n) * 2 + 0) * 256 + c) * Lx);
        const f32x4* f1 = (const f32x4*)(base + ((((size_t)ly * 2 + n) * 2 + 1) * 256 + c) * Lx);
        float s = 0.f;
        if (lt) { const f32x4 a = f0[F.lane], b = f1[F.lane];
            s = fabsf(a[0]) + fabsf(a[1]) + fabsf(a[2]) + fabsf(a[3]) + (F.lane == 0 ? 0.f : fabsf(b[0])) + fabsf(b[1]) + fabsf(b[2]) + fabsf(b[3]);
        } else { f32x4 a[16], b[16];
#pragma unroll
            for (int q = 0; q < 16; ++q) { a[q] = f0[F.lane + 64 * q]; b[q] = f1[F.lane + 64 * q]; }
#pragma unroll
            for (int q = 0; q < 16; ++q) s += fabsf(a[q][0]) + fabsf(a[q][1]) + fabsf(a[q][2]) + fabsf(a[q][3]) + ((q == 0 && F.lane == 0) ? 0.f : fabsf(b[q][0])) + fabsf(b[q][1]) + fabsf(b[q][2]) + fabsf(b[q][3]); }
        s = wave_sum(s);
        if (F.lane == 0) ((float*)(F.ws + WS_INVL1))[j] = 1.0f / s;
    }
}

DI void ln_stats(const f32x4 (&v)[4], float& mu, float& rstd) {
    float s = 0.f;
#pragma unroll
    for (int j = 0; j < 4; ++j) s += (v[j][0] + v[j][1]) + (v[j][2] + v[j][3]);
    mu = wave_sum(s) * (1.0f / DM);
    float q = 0.f;
#pragma unroll
    for (int j = 0; j < 4; ++j)
#pragma unroll
        for (int e = 0; e < 4; ++e) { const float d = v[j][e] - mu; q += d * d; }
    rstd = rsqrtf(wave_sum(q) * (1.0f / DM) + LN_EPS);
}
DI void ln_mod_store(const f32x4 (&v)[4], const float* sh, const float* sc, bf16_t* hrow, int lane) {
    float mu, rstd; ln_stats(v, mu, rstd);
#pragma unroll
    for (int j = 0; j < 4; ++j) { const int c = 4 * lane + 256 * j; const f32x4 a = *(const f32x4*)(sh + c), b = *(const f32x4*)(sc + c);
        float o[4];
#pragma unroll
        for (int e = 0; e < 4; ++e) o[e] = (v[j][e] - mu) * rstd * (1.f + b[e]) + a[e];
        u32x2 w; w.x = cvt_pk_bf16(o[0], o[1]); w.y = cvt_pk_bf16(o[2], o[3]); *(u32x2*)(hrow + c) = w; }
}

DI void phase_init_h(const Frame& F) {
    const int gw = F.bid * 8 + F.wave, nw = F.G * 8;
    const float* MOD = (const float*)(F.ws + WS_MOD);
    for (int row = gw; row < RTOT; row += nw) {
        const float* xr = row < RLAT ? F.in[0] + (size_t)row * DM : F.in[2] + (size_t)(row - RLAT) * DM;
        f32x4 v[4];
#pragma unroll
        for (int j = 0; j < 4; ++j) v[j] = *(const f32x4*)(xr + 4 * F.lane + 256 * j);
        const float* m = MOD + (size_t)(0 * 5 + row_modsel(row)) * 6144;
        ln_mod_store(v, m, m + 1024, (bf16_t*)(F.ws + WS_H) + (size_t)row * DM, F.lane);
    }
}

struct EpiWin {
    static constexpr bool PERM = true;
    unsigned char* ws; int ly;
    DI void operator()(const f32x4 (&acc)[2][2][4][2], const pg8::Unit& u, int wr, int wc, int fr, int fq) const {
        const bool lat = u.pm < 64; const int b = lat ? (u.pm >> 4) : (u.pm - 64); const int pos0 = lat ? ((u.pm & 15) << 8) : SEQ;
        const int pn = u.pn;
        const float* RT = (const float*)(ws + WS_ROPE);
        float kn[2] = {0.f, 0.f};
#pragma unroll
        for (int ai = 0; ai < 2; ++ai)
#pragma unroll
            for (int m = 0; m < 4; ++m) {
                const int pos = pos0 + ai * 128 + wr * 64 + m * 16 + fr;
#pragma unroll
                for (int bj = 0; bj < 2; ++bj) {
                    const int col = pn * 256 + bj * 128 + wc * 32 + fq * 8;
                    float v[8];
#pragma unroll
                    for (int e = 0; e < 4; ++e) { v[e] = acc[ai][bj][m][0][e]; v[4 + e] = acc[ai][bj][m][1][e]; }
                    if (pn < 3) {
                        float* d = (float*)(ws + WS_HYT) + ((size_t)b * 768 + col) * POS + pos;
#pragma unroll
                        for (int e = 0; e < 8; ++e) d[(size_t)e * POS] = v[e];
                    } else if (pn < 7) {
                        const bool isq = pn < 5; const int cq = col - (isq ? 768 : 1280); const int head = cq >> 6, cc = cq & 63;
                        if (lat) { const int axis = (cc >> 4) & 1, n0 = (cc & 15) >> 1; const int pa = axis ? (pos & 63) : (pos >> 6);
                            const float* rt = RT + (pa * 8 + n0) * 2;
#pragma unroll
                            for (int p = 0; p < 4; ++p) { const float cs = rt[2 * p], sn = rt[2 * p + 1]; const float a = v[2 * p], bb = v[2 * p + 1];
                                v[2 * p] = a * cs - bb * sn; v[2 * p + 1] = a * sn + bb * cs; } }
                        if (isq) {
#pragma unroll
                            for (int e = 0; e < 8; ++e) v[e] *= QSCALE; }
                        u32x4 w; w.x = cvt_pk_bf16(v[0], v[1]); w.y = cvt_pk_bf16(v[2], v[3]); w.z = cvt_pk_bf16(v[4], v[5]); w.w = cvt_pk_bf16(v[6], v[7]);
                        bf16_t* d = (bf16_t*)(ws + (isq ? WS_Q : WS_K)) + (((size_t)b * 8 + head) * POS + pos) * 64 + cc;
                        *(u32x4*)d = w;
                        if (!isq) {
                            float s2 = bflo(w.x) * bflo(w.x) + bfhi(w.x) * bfhi(w.x) + bflo(w.y) * bflo(w.y) + bfhi(w.y) * bfhi(w.y) + bflo(w.z) * bflo(w.z) + bfhi(w.z) * bfhi(w.z) + bflo(w.w) * bflo(w.w) + bfhi(w.w) * bfhi(w.w);
                            s2 += __shfl_xor(s2, 16); s2 += __shfl_xor(s2, 32);
                            kn[bj] = fmaxf(kn[bj], s2); }
                    } else if (pn < 9) {
                        const int cv = col - 1792; const int head = cv >> 6, cc = cv & 63;
                        u32x4 w; w.x = cvt_pk_bf16(v[0], v[1]); w.y = cvt_pk_bf16(v[2], v[3]); w.z = cvt_pk_bf16(v[4], v[5]); w.w = cvt_pk_bf16(v[6], v[7]);
                        *(u32x4*)((bf16_t*)(ws + WS_V) + (((size_t)b * 8 + head) * POS + pos) * 64 + cc) = w;
                    } else {
                        const int cy = col - 2304; const int comp = cy >> 8, gd = cy & 255;
                        if (lat) { bf16_t* d = (bf16_t*)(ws + WS_YTL) + ((size_t)b * 256 + gd) * 8192 + comp * 4096 + pos;
#pragma unroll
                            for (int e = 0; e < 8; ++e) d[(size_t)e * 8192] = f2bf(v[e]);
                        } else { bf16_t* d = (bf16_t*)(ws + WS_YTC) + ((size_t)b * 256 + gd) * 512 + comp * 256 + (pos - SEQ);
#pragma unroll
                            for (int e = 0; e < 8; ++e) d[(size_t)e * 512] = f2bf(v[e]); }
                    }
                }
            }
        if (pn == 5 || pn == 6) {
#pragma unroll
            for (int bj = 0; bj < 2; ++bj) { float m = kn[bj];
                m = fmaxf(m, __shfl_xor(m, 1)); m = fmaxf(m, __shfl_xor(m, 2)); m = fmaxf(m, __shfl_xor(m, 4)); m = fmaxf(m, __shfl_xor(m, 8));
                const int cq = pn * 256 + bj * 128 + wc * 32 - 1280; const int head = cq >> 6, comp = (cq >> 5) & 1;
                if (fr == 0 && fq == 0) atomicMax((unsigned*)(ws + WS_CTL) + CW_KMAX + 64 * ly + (b * 8 + head) * 2 + comp, __float_as_uint(m)); }
        }
    }
};

struct EpiFnet {
    static constexpr bool PERM = true;
    unsigned char* ws; int ctx;
    DI void operator()(const f32x4 (&acc)[2][2][4][2], const pg8::Unit& u, int wr, int wc, int fr, int fq) const {
        const int b = u.pn;
#pragma unroll
        for (int ai = 0; ai < 2; ++ai)
#pragma unroll
            for (int m = 0; m < 4; ++m) {
                const int k = u.pm * 256 + ai * 128 + wr * 64 + m * 16 + fr;
                const size_t row = ctx ? (size_t)(RLAT + b * CTXL + k) : (size_t)(b * SEQ + k);
#pragma unroll
                for (int bj = 0; bj < 2; ++bj) { const int gd = bj * 128 + wc * 32 + fq * 8;
                    const f32x4 v0 = acc[ai][bj][m][0], v1 = acc[ai][bj][m][1];
                    u32x4 w; w.x = cvt_pk_bf16(v0[0], v0[1]); w.y = cvt_pk_bf16(v0[2], v0[3]); w.z = cvt_pk_bf16(v1[0], v1[1]); w.w = cvt_pk_bf16(v1[2], v1[3]);
                    *(u32x4*)((bf16_t*)(ws + WS_MIX) + row * DM + 768 + gd) = w; }
            }
    }
};

struct EpiWout {
    static constexpr bool PERM = false;
    unsigned char* ws; int ly; const float* xlat; const float* xctx;
    DI void operator()(const f32x4 (&acc)[2][2][4][2], const pg8::Unit& u, int wr, int wc, int fr, int fq) const {
        const int msel = u.pm < 64 ? (u.pm >> 4) : 4;
        const float* g1 = (const float*)(ws + WS_MOD) + ((size_t)ly * 5 + msel) * 6144 + 2048;
        const int col0 = u.pn * 256 + wc * 32 + 4 * fq;
        const float* src = ly == 0 ? (u.pm < 64 ? xlat + (size_t)u.pm * 256 * DM : xctx + (size_t)(u.pm - 64) * 256 * DM) : (const float*)(ws + WS_X) + (size_t)u.pm * 256 * DM;
        f32x4 gv[2][2];
#pragma unroll
        for (int bj = 0; bj < 2; ++bj)
#pragma unroll
            for (int n = 0; n < 2; ++n) gv[bj][n] = *(const f32x4*)(g1 + col0 + bj * 128 + n * 16);
#pragma unroll
        for (int ai = 0; ai < 2; ++ai)
#pragma unroll
            for (int m = 0; m < 4; ++m) { const size_t ro = (size_t)(ai * 128 + wr * 64 + m * 16 + fr) * DM + col0;
                float* rowp = (float*)(ws + WS_X) + (size_t)u.pm * 256 * DM + ro;
#pragma unroll
                for (int bj = 0; bj < 2; ++bj)
#pragma unroll
                    for (int n = 0; n < 2; ++n) { const f32x4 xin = *(const f32x4*)(src + ro + bj * 128 + n * 16); *(f32x4*)(rowp + bj * 128 + n * 16) = xin * ALPHA + gv[bj][n] * acc[ai][bj][m][n]; } }
    }
};

struct MoeTab { LAS int* cnt; LAS int* tstart; LAS int* tile_e; int ntiles; };
DI MoeTab moe_tables(const Frame& F, int ly) {
    MoeTab T; T.cnt = (LAS int*)(F.lds + LDS_TAB); T.tstart = T.cnt + 72; T.tile_e = T.tstart + 72;
    __syncthreads();
    if (F.tid < 65) T.cnt[F.tid] = F.tid < NEXP ? (int)__hip_atomic_load(F.ctl + CW_CNT + (ly * 64 + F.tid) * CNT_STRIDE, __ATOMIC_RELAXED, __HIP_MEMORY_SCOPE_AGENT) : (ly == DEPTH - 1 ? RLAT : RTOT);
    __syncthreads();
    if (F.tid == 0) { int s = 0; for (int e = 0; e < 65; ++e) { T.tstart[e] = s; s += (T.cnt[e] + 255) >> 8; } T.tstart[65] = s; }
    __syncthreads();
    const int nt = T.tstart[65];
    for (int e = F.tid; e < 65; e += NTHR) for (int q = T.tstart[e]; q < T.tstart[e + 1]; ++q) if (q < MAXTILES) T.tile_e[q] = e;
    __syncthreads();
    T.ntiles = __builtin_amdgcn_readfirstlane(nt < MAXTILES ? nt : MAXTILES);
    return T;
}
template <bool GATHER_> struct MoeSched {
    static constexpr bool GATHER = GATHER_;
    MoeTab T; const int* list; int G, c, nsub, shift;
    DI bool next(int i, pg8::Unit& u) const {
        const int L = i * G + c; if (L >= T.ntiles * nsub) return false;
        const int tile = L >> shift, j = L & (nsub - 1); const int e = __builtin_amdgcn_readfirstlane(T.tile_e[tile]);
        u.pm = tile; u.pn = e * nsub + j; u.e = e; u.lt = tile - __builtin_amdgcn_readfirstlane(T.tstart[e]); return true;
    }
    DI int arow(const pg8::Unit& u, int r) const {
        if (!GATHER_) return u.pm * 256 + r;
        const int idx = u.lt * 256 + r;
        if (u.e == NEXP) return idx;
        return idx < T.cnt[u.e] ? (list[(size_t)u.e * RTOT + idx] >> 3) : 0;
    }
};
DI float silu_f(float x) { return x / (1.f + __expf(-x)); }
struct EpiMoe1 {
    static constexpr bool PERM = true;
    unsigned char* ws;
    DI void operator()(const f32x4 (&acc)[2][2][4][2], const pg8::Unit& u, int wr, int wc, int fr, int fq) const {
        const int hid = (u.pn & 1) * 128 + wc * 32 + fq * 8;
#pragma unroll
        for (int ai = 0; ai < 2; ++ai)
#pragma unroll
            for (int m = 0; m < 4; ++m) { const size_t row = (size_t)u.pm * 256 + ai * 128 + wr * 64 + m * 16 + fr;
                float o[8];
#pragma unroll
                for (int n = 0; n < 2; ++n)
#pragma unroll
                    for (int e = 0; e < 4; ++e) o[n * 4 + e] = silu_f(acc[ai][0][m][n][e]) * acc[ai][1][m][n][e];
                u32x4 w; w.x = cvt_pk_bf16(o[0], o[1]); w.y = cvt_pk_bf16(o[2], o[3]); w.z = cvt_pk_bf16(o[4], o[5]); w.w = cvt_pk_bf16(o[6], o[7]);
                *(u32x4*)((bf16_t*)(ws + WS_ACT) + row * DEXP + hid) = w; }
    }
};
struct EpiMoe2 {
    static constexpr bool PERM = true;
    unsigned char* ws;
    DI void operator()(const f32x4 (&acc)[2][2][4][2], const pg8::Unit& u, int wr, int wc, int fr, int fq) const {
        const int colb = (u.pn & 3) * 256 + wc * 32 + fq * 8;
#pragma unroll
        for (int ai = 0; ai < 2; ++ai)
#pragma unroll
            for (int m = 0; m < 4; ++m) { const size_t row = (size_t)u.pm * 256 + ai * 128 + wr * 64 + m * 16 + fr;
#pragma unroll
                for (int bj = 0; bj < 2; ++bj) { const f32x4 v0 = acc[ai][bj][m][0], v1 = acc[ai][bj][m][1];
                    u32x4 w; w.x = cvt_pk_bf16(v0[0], v0[1]); w.y = cvt_pk_bf16(v0[2], v0[3]); w.z = cvt_pk_bf16(v1[0], v1[1]); w.w = cvt_pk_bf16(v1[2], v1[3]);
                    __builtin_nontemporal_store(w, (u32x4*)((bf16_t*)(ws + WS_YB) + row * DM + colb + bj * 128)); } }
    }
};

DI float hy_short(const float* hy, int l, int Lx, float w0, float w1, float w2) {
    const float a = l > 0 ? hy[l - 1] : 0.f, b = hy[l], c = l + 1 < Lx ? hy[l + 1] : 0.f;
    return w0 * a + w1 * b + w2 * c;
}
DI void hyena_ctx_unit(const Frame& F, int ly, int c) {
    LAS float* KC = (LAS float*)F.lds;
    LAS float* UC = KC + 1024;
    LAS float* PS = UC + 1024;
    const int t = F.tid;
    const float* HYT = (const float*)(F.ws + WS_HYT);
    const float* scw = F.in[8] + (size_t)ly * 3 * 768;
    const float* invl = (const float*)(F.ws + WS_INVL1) + (size_t)ly * 1024;
    const float bias0 = F.in[15][(size_t)ly * 512 + c], bias1 = F.in[15][(size_t)ly * 512 + 256 + c];
    float wx1[3], wx2[3], wv[3];
#pragma unroll
    for (int j = 0; j < 3; ++j) { wx1[j] = scw[j * 768 + c]; wx2[j] = scw[j * 768 + 256 + c]; wv[j] = scw[j * 768 + 512 + c]; }
    bf16_t* MIX = (bf16_t*)(F.ws + WS_MIX);
    for (int n = 0; n < 2; ++n) { const float inv = invl[(1 * 2 + n) * 256 + c];
        const float* hf = (const float*)(F.ws + WS_HCC) + ((((size_t)ly * 2 + n) * 2 + 0) * 256 + c) * CTXL;
        const float* hb = (const float*)(F.ws + WS_HCC) + ((((size_t)ly * 2 + n) * 2 + 1) * 256 + c) * CTXL;
        for (int i = t; i < 512; i += NTHR) { const int d = i - 256; KC[n * 512 + i] = d >= 0 ? hf[d] * inv : (d > -256 ? hb[-d] * inv : 0.f); } }
    for (int i = t; i < 4 * CTXL; i += NTHR) { const int b = i >> 8, l = i & 255;
        UC[l * 4 + b] = hy_short(HYT + ((size_t)b * 768 + 512 + c) * POS + SEQ, l, CTXL, wv[0], wv[1], wv[2]); }
    __syncthreads();
    const int t0 = (t & 63) * 4, bp = (t >> 6) & 1, sq = t >> 7;
    const int tt = t & 255, bq = t >> 8;
    for (int n = 0; n < 2; ++n) {
        float a[4][2];
#pragma unroll
        for (int j = 0; j < 4; ++j) { a[j][0] = 0.f; a[j][1] = 0.f; }
        const LAS float* kf = KC + n * 512 + 256 + t0;
#pragma unroll 4
        for (int s = sq * 64; s < sq * 64 + 64; ++s) { const float u0 = UC[s * 4 + 2 * bp], u1 = UC[s * 4 + 2 * bp + 1];
#pragma unroll
            for (int j = 0; j < 4; ++j) { const float k = kf[j - s]; a[j][0] += k * u0; a[j][1] += k * u1; } }
#pragma unroll
        for (int j = 0; j < 4; ++j) { PS[(sq * 256 + t0 + j) * 4 + 2 * bp] = a[j][0]; PS[(sq * 256 + t0 + j) * 4 + 2 * bp + 1] = a[j][1]; }
        __syncthreads();
        float y0 = 0.f, y1 = 0.f;
#pragma unroll
        for (int q = 0; q < 4; ++q) { y0 += PS[(q * 256 + tt) * 4 + 2 * bq]; y1 += PS[(q * 256 + tt) * 4 + 2 * bq + 1]; }
        const int xch = n == 0 ? c : 256 + c; const float* wg = n == 0 ? wx1 : wx2; const float bias = n == 0 ? bias0 : bias1;
        const float g0 = hy_short(HYT + ((size_t)(2 * bq) * 768 + xch) * POS + SEQ, tt, CTXL, wg[0], wg[1], wg[2]);
        const float g1 = hy_short(HYT + ((size_t)(2 * bq + 1) * 768 + xch) * POS + SEQ, tt, CTXL, wg[0], wg[1], wg[2]);
        const float z0 = g0 * (y0 + bias * UC[tt * 4 + 2 * bq]), z1 = g1 * (y1 + bias * UC[tt * 4 + 2 * bq + 1]);
        __syncthreads();
        if (n == 0) { UC[tt * 4 + 2 * bq] = z0; UC[tt * 4 + 2 * bq + 1] = z1; __syncthreads(); }
        else { MIX[((size_t)RLAT + (2 * bq) * CTXL + tt) * DM + c] = f2bf(z0); MIX[((size_t)RLAT + (2 * bq + 1) * CTXL + tt) * DM + c] = f2bf(z1); }
    }
    __syncthreads();
}

DI unsigned cx_addr(unsigned e) { return e * 8u + (e >> 5) * 16u; }
constexpr int cx_bytes(int n) { return n * 8 + (n / 32) * 16; }
typedef float f32x2 __attribute__((ext_vector_type(2)));
template <int R> DI constexpr int brev(int q) { int r = 0; for (int i = 1, j = R >> 1; i < R; i <<= 1, j >>= 1) if (q & i) r |= j; return r; }
template <int R, bool INV> DI void dft_inreg(float (&re)[R], float (&im)[R]) {
#pragma unroll
    for (int len = R; len >= 2; len >>= 1) { const int half = len >> 1;
#pragma unroll
        for (int base = 0; base < R; base += len)
#pragma unroll
            for (int j = 0; j < half; ++j) {
                const float ar = re[base + j], ai = im[base + j], br = re[base + j + half], bi = im[base + j + half];
                re[base + j] = ar + br; im[base + j] = ai + bi;
                const float dr = ar - br, di = ai - bi;
                if (j == 0) { re[base + j + half] = dr; im[base + j + half] = di; }
                else if (4 * j == len) { if (INV) { re[base + j + half] = -di; im[base + j + half] = dr; } else { re[base + j + half] = di; im[base + j + half] = -dr; } }
                else { const float c = __builtin_cosf(6.283185307179586f * (float)j / (float)len), sn = (INV ? 1.f : -1.f) * __builtin_sinf(6.283185307179586f * (float)j / (float)len);
                    re[base + j + half] = dr * c - di * sn; im[base + j + half] = dr * sn + di * c; }
            }
    }
}
template <int R, bool INV, int S> DI void fft_bfly(LAS unsigned char* seq, int j) {
    constexpr int Lcur = R * S;
    int jj = j; asm volatile("" : "+v"(jj));
    const int blk = jj / S, o = jj % S;
    LAS unsigned char* p = seq + cx_addr((unsigned)(blk * Lcur + o));
#define FFT_OFF(r) ((r) * S * 8 + ((((r) * S) >> 5) * 16))
    float re[R], im[R];
    if (S == 1) {
#pragma unroll
        for (int r = 0; r < R; r += 2) { const f32x4 v = *(const LAS f32x4*)(p + FFT_OFF(r)); re[r] = v[0]; im[r] = v[1]; re[r + 1] = v[2]; im[r + 1] = v[3]; }
    } else {
#pragma unroll
        for (int r = 0; r < R; ++r) { const f32x2 v = *(const LAS f32x2*)(p + FFT_OFF(r)); re[r] = v[0]; im[r] = v[1]; }
    }
    if (S == 1) {
        dft_inreg<R, INV>(re, im);
    } else {
        const float fr = (float)o * (1.0f / (float)Lcur);
        float wr[R], wi[R];
        wr[1] = __builtin_amdgcn_cosf(fr); wi[1] = INV ? __builtin_amdgcn_sinf(fr) : -__builtin_amdgcn_sinf(fr);
#pragma unroll
        for (int q = 2; q < R; ++q) { const int a = (q & (q - 1)) ? (q & -q) : (q >> 1), bq = q - a;
            wr[q] = wr[a] * wr[bq] - wi[a] * wi[bq]; wi[q] = wr[a] * wi[bq] + wi[a] * wr[bq]; }
        if (!INV) {
            dft_inreg<R, false>(re, im);
#pragma unroll
            for (int q = 1; q < R; ++q) { const int k = brev<R>(q); const float xr = re[k], xi = im[k]; re[k] = xr * wr[q] - xi * wi[q]; im[k] = xr * wi[q] + xi * wr[q]; }
        } else {
#pragma unroll
            for (int q = 1; q < R; ++q) { const float xr = re[q], xi = im[q]; re[q] = xr * wr[q] - xi * wi[q]; im[q] = xr * wi[q] + xi * wr[q]; }
            dft_inreg<R, true>(re, im);
        }
    }
    if (S == 1) {
#pragma unroll
        for (int r = 0; r < R; r += 2) { const int k0 = brev<R>(r), k1 = brev<R>(r + 1); *(LAS f32x4*)(p + FFT_OFF(r)) = (f32x4){re[k0], im[k0], re[k1], im[k1]}; }
    } else {
#pragma unroll
        for (int r = 0; r < R; ++r) { const int k = brev<R>(r); *(LAS f32x2*)(p + FFT_OFF(r)) = (f32x2){re[k], im[k]}; }
    }
#undef FFT_OFF
}
template <bool INV> DI void fft8192x2(LAS unsigned char* lds, int tid) {
    constexpr int SB = cx_bytes(8192);
    if (!INV) {
        fft_bfly<16, false, 512>(lds, tid); __builtin_amdgcn_sched_barrier(0); fft_bfly<16, false, 512>(lds + SB, tid); __syncthreads();
        fft_bfly<16, false, 32>(lds, tid); __builtin_amdgcn_sched_barrier(0); fft_bfly<16, false, 32>(lds + SB, tid); __syncthreads();
        fft_bfly<32, false, 1>(lds + (tid >> 8) * SB, tid & 255); __syncthreads();
    } else {
        fft_bfly<32, true, 1>(lds + (tid >> 8) * SB, tid & 255); __syncthreads();
        fft_bfly<16, true, 32>(lds, tid); __builtin_amdgcn_sched_barrier(0); fft_bfly<16, true, 32>(lds + SB, tid); __syncthreads();
        fft_bfly<16, true, 512>(lds, tid); __builtin_amdgcn_sched_barrier(0); fft_bfly<16, true, 512>(lds + SB, tid); __syncthreads();
    }
}
DI void fft4096x4(LAS unsigned char* lds, int tid) {
    constexpr int SB = cx_bytes(4096);
    const int sq = tid >> 8, j = tid & 255;
    fft_bfly<16, false, 256>(lds + sq * SB, j); __builtin_amdgcn_sched_barrier(0); fft_bfly<16, false, 256>(lds + (sq + 2) * SB, j); __syncthreads();
    fft_bfly<16, false, 16>(lds + sq * SB, j); __builtin_amdgcn_sched_barrier(0); fft_bfly<16, false, 16>(lds + (sq + 2) * SB, j); __syncthreads();
    fft_bfly<16, false, 1>(lds + sq * SB, j); __builtin_amdgcn_sched_barrier(0); fft_bfly<16, false, 1>(lds + (sq + 2) * SB, j); __syncthreads();
}

DI void hy_short8(const float* hp, int l0, float w0, float w1, float w2, float (&out)[8]) {
    const f32x4 h0 = *(const f32x4*)(hp + l0), h1 = *(const f32x4*)(hp + l0 + 4);
    const float hm = l0 > 0 ? hp[l0 - 1] : 0.f, hn = l0 + 8 < SEQ ? hp[l0 + 8] : 0.f;
    const float hv[10] = {hm, h0[0], h0[1], h0[2], h0[3], h1[0], h1[1], h1[2], h1[3], hn};
#pragma unroll
    for (int j = 0; j < 8; ++j) out[j] = w0 * hv[j] + w1 * hv[j + 1] + w2 * hv[j + 2];
}
DI void hyena_fft_unit(const Frame& F, int ly, int c) {
    LAS unsigned char* L = F.lds; constexpr int SB = cx_bytes(8192);
    const int t = F.tid;
    const unsigned pt = cx_addr((unsigned)t), pl = cx_addr((unsigned)t * 8u);
    const float* HYT = (const float*)(F.ws + WS_HYT);
    const float* scw = F.in[8] + (size_t)ly * 3 * 768;
    const float* invl = (const float*)(F.ws + WS_INVL1) + (size_t)ly * 1024;
    const float bias0 = F.in[15][(size_t)ly * 512 + c], bias1 = F.in[15][(size_t)ly * 512 + 256 + c];
    float wx1[3], wx2[3], wv[3];
#pragma unroll
    for (int j = 0; j < 3; ++j) { wx1[j] = scw[j * 768 + c]; wx2[j] = scw[j * 768 + 256 + c]; wv[j] = scw[j * 768 + 512 + c]; }
    f32x2* SPEC = (f32x2*)(F.ws + WS_SPEC) + (size_t)c * 2 * 8192;
#pragma unroll
    for (int n = 0; n < 2; ++n) { const float inv = invl[(0 * 2 + n) * 256 + c] * (1.0f / 8192.0f);
        const float* hf = (const float*)(F.ws + WS_HCL) + ((((size_t)ly * 2 + n) * 2 + 0) * 256 + c) * SEQ;
        const float* hb = (const float*)(F.ws + WS_HCL) + ((((size_t)ly * 2 + n) * 2 + 1) * 256 + c) * SEQ;
        float fv[16];
#pragma unroll
        for (int k = 0; k < 8; ++k) { fv[k] = hf[t + 512 * k]; const int i = SEQ + t + 512 * k; fv[8 + k] = i > SEQ ? hb[8192 - i] : 0.f; }
#pragma unroll
        for (int k = 0; k < 16; ++k) *(LAS f32x2*)(L + n * SB + (pt + 4352u * (unsigned)(k))) = (f32x2){fv[k] * inv, 0.f}; }
    __syncthreads();
    fft8192x2<false>(L, t);
#pragma unroll
    for (int n = 0; n < 2; ++n)
#pragma unroll
        for (int k = 0; k < 16; ++k) SPEC[n * 8192 + t + 512 * k] = *(const LAS f32x2*)(L + n * SB + (pt + 4352u * (unsigned)(k)));
    __syncthreads();
    const int l0 = t * 8;
#pragma unroll 1
    for (int sp = 0; sp < 2; ++sp) {
        float za[8], zb[8];
        hy_short8(HYT + ((size_t)(2 * sp) * 768 + 512 + c) * POS, l0, wv[0], wv[1], wv[2], za);
        hy_short8(HYT + ((size_t)(2 * sp + 1) * 768 + 512 + c) * POS, l0, wv[0], wv[1], wv[2], zb);
#pragma unroll
        for (int j = 0; j < 8; j += 2) {
            *(LAS f32x4*)(L + sp * SB + (pl + 8u * (unsigned)(j))) = (f32x4){za[j], zb[j], za[j + 1], zb[j + 1]};
            *(LAS f32x4*)(L + sp * SB + (pl + 34816u + 8u * (unsigned)(j))) = (f32x4){0.f, 0.f, 0.f, 0.f}; }
    }
    __syncthreads();
    float* Z1 = (float*)(F.ws + WS_Z1) + (size_t)c * 4 * SEQ;
    bf16_t* MIX = (bf16_t*)(F.ws + WS_MIX);
#pragma unroll 1
    for (int n = 0; n < 2; ++n) {
        fft8192x2<false>(L, t);
#pragma unroll 1
        for (int k0 = 0; k0 < 16; k0 += 8) { f32x2 h[8];
#pragma unroll
          for (int k = 0; k < 8; ++k) h[k] = SPEC[n * 8192 + t + 512 * (k0 + k)];
#pragma unroll
          for (int k = 0; k < 8; ++k) { const unsigned ad = (pt + 4352u * (unsigned)(k0 + k));
            const f32x2 a = *(const LAS f32x2*)(L + ad), b = *(const LAS f32x2*)(L + SB + ad);
            *(LAS f32x2*)(L + ad) = (f32x2){a[0] * h[k][0] - a[1] * h[k][1], a[0] * h[k][1] + a[1] * h[k][0]};
            *(LAS f32x2*)(L + SB + ad) = (f32x2){b[0] * h[k][0] - b[1] * h[k][1], b[0] * h[k][1] + b[1] * h[k][0]}; } }
        __syncthreads();
        fft8192x2<true>(L, t);
        const int xch = n == 0 ? c : 256 + c; const float* wg = n == 0 ? wx1 : wx2; const float bias = n == 0 ? bias0 : bias1;
#pragma unroll 1
        for (int sp = 0; sp < 2; ++sp) {
            float zo[2][8];
#pragma unroll
            for (int h2 = 0; h2 < 2; ++h2) { const int bb = 2 * sp + h2;
                float g[8], zin[8];
                hy_short8(HYT + ((size_t)bb * 768 + xch) * POS, l0, wg[0], wg[1], wg[2], g);
                if (n == 0) hy_short8(HYT + ((size_t)bb * 768 + 512 + c) * POS, l0, wv[0], wv[1], wv[2], zin);
                else { const f32x4 q0 = *(const f32x4*)(Z1 + (size_t)bb * SEQ + l0), q1 = *(const f32x4*)(Z1 + (size_t)bb * SEQ + l0 + 4);
                    zin[0] = q0[0]; zin[1] = q0[1]; zin[2] = q0[2]; zin[3] = q0[3]; zin[4] = q1[0]; zin[5] = q1[1]; zin[6] = q1[2]; zin[7] = q1[3]; }
#pragma unroll
                for (int j = 0; j < 8; ++j) { const float y = ((const LAS float*)(L + sp * SB + (pl + 8u * (unsigned)(j))))[h2]; zo[h2][j] = g[j] * (y + bias * zin[j]); }
                if (n == 0) { *(f32x4*)(Z1 + (size_t)bb * SEQ + l0) = (f32x4){zo[h2][0], zo[h2][1], zo[h2][2], zo[h2][3]}; *(f32x4*)(Z1 + (size_t)bb * SEQ + l0 + 4) = (f32x4){zo[h2][4], zo[h2][5], zo[h2][6], zo[h2][7]}; }
                else {
#pragma unroll
                    for (int j = 0; j < 8; ++j) MIX[((size_t)bb * SEQ + l0 + j) * DM + c] = f2bf(zo[h2][j]); }
            }
            if (n == 0) {
#pragma unroll
                for (int j = 0; j < 8; j += 2) {
                    *(LAS f32x4*)(L + sp * SB + (pl + 8u * (unsigned)(j))) = (f32x4){zo[0][j], zo[1][j], zo[0][j + 1], zo[1][j + 1]};
                    *(LAS f32x4*)(L + sp * SB + (pl + 34816u + 8u * (unsigned)(j))) = (f32x4){0.f, 0.f, 0.f, 0.f}; }
            }
        }
        __syncthreads();
    }
}

DI void fnet_fft_unit(const Frame& F, int u) {
    LAS unsigned char* L = F.lds; constexpr int SB = cx_bytes(4096);
    const int t = F.tid, b = u >> 6, gd0 = (u & 63) * 4;
    const bf16_t* YT = (const bf16_t*)(F.ws + WS_YTL) + ((size_t)b * 256 + gd0) * 8192;
    for (int i = t; i < 4 * 512; i += NTHR) { const int q = i >> 9, l0 = (i & 511) * 8;
        const u32x4 r = *(const u32x4*)(YT + (size_t)q * 8192 + l0), m = *(const u32x4*)(YT + (size_t)q * 8192 + 4096 + l0);
        const float rr[8] = {bflo(r.x), bfhi(r.x), bflo(r.y), bfhi(r.y), bflo(r.z), bfhi(r.z), bflo(r.w), bfhi(r.w)};
        const float mm[8] = {bflo(m.x), bfhi(m.x), bflo(m.y), bfhi(m.y), bflo(m.z), bfhi(m.z), bflo(m.w), bfhi(m.w)};
#pragma unroll
        for (int j = 0; j < 8; j += 2) *(LAS f32x4*)(L + q * SB + cx_addr(l0 + j)) = (f32x4){rr[j], mm[j], rr[j + 1], mm[j + 1]}; }
    __syncthreads();
    fft4096x4(L, t);
    bf16_t* MIX = (bf16_t*)(F.ws + WS_MIX);
#pragma unroll
    for (int i = 0; i < 8; ++i) { const int p = t + 512 * i; const int f = (p >> 8) + 16 * ((p >> 4) & 15) + 256 * (p & 15);
        float v[4];
#pragma unroll
        for (int q = 0; q < 4; ++q) v[q] = (*(const LAS f32x2*)(L + q * SB + cx_addr(p)))[0] * (1.0f / 512.0f);
        u32x2 w; w.x = cvt_pk_bf16(v[0], v[1]); w.y = cvt_pk_bf16(v[2], v[3]);
        *(u32x2*)(MIX + ((size_t)b * SEQ + f) * DM + 768 + gd0) = w; }
    __syncthreads();
}

DI void attn_unit(const Frame& F, int ly, int uid, float lam, float out_scale) {
    const int t = F.tid, lane = F.lane, wave = F.wave;
    LAS unsigned char* L = F.lds;
    constexpr int KOFF = 0, VOFF = 16384, TB = 32768, NBUF = 4;
    int bh, q0, k_lo, k_hi;
    if (uid < 512) { bh = uid >> 4; q0 = (uid & 15) << 8; k_lo = 0; k_hi = POS; }
    else { bh = uid - 512; q0 = SEQ; k_lo = SEQ; k_hi = POS; }
    const bf16_t* Qg = (const bf16_t*)(F.ws + WS_Q) + (size_t)bh * POS * 64;
    const bf16_t* Kg = (const bf16_t*)(F.ws + WS_K) + (size_t)bh * POS * 64;
    const bf16_t* Vg = (const bf16_t*)(F.ws + WS_V) + (size_t)bh * POS * 64;
    const int qi = lane & 31, hh = lane >> 5;
    const int qpos = q0 + wave * 32 + qi;
    bf16x8 qf[2][2];
    float q2[2] = {0.f, 0.f};
#pragma unroll
    for (int comp = 0; comp < 2; ++comp)
#pragma unroll
        for (int ks = 0; ks < 2; ++ks) { qf[comp][ks] = *(const bf16x8*)(Qg + (size_t)qpos * 64 + comp * 32 + ks * 16 + hh * 8);
#pragma unroll
            for (int j = 0; j < 8; ++j) { const float x = bf2f((unsigned short)qf[comp][ks][j]); q2[comp] += x * x; } }
    q2[0] += __shfl_xor(q2[0], 32); q2[1] += __shfl_xor(q2[1], 32);
    float kmax2[2];
    kmax2[0] = __uint_as_float(F.ctl[CW_KMAX + 64 * ly + bh * 2]); kmax2[1] = __uint_as_float(F.ctl[CW_KMAX + 64 * ly + bh * 2 + 1]);
    f32x16 negm;
    { const float m = -fmaxf(sqrtf(q2[0] * kmax2[0]), sqrtf(q2[1] * kmax2[1])) * 1.0001f;
#pragma unroll
      for (int i = 0; i < 16; ++i) negm[i] = m; }
    f32x16 O[2][2];
#pragma unroll
    for (int a = 0; a < 2; ++a)
#pragma unroll
        for (int b = 0; b < 2; ++b)
#pragma unroll
            for (int i = 0; i < 16; ++i) O[a][b][i] = 0.f;
    float lsum[2] = {0.f, 0.f};
    const int sk = t >> 3, sl = t & 7;
    const int kch = sl ^ ((sk >> 1) & 7);
    const int vch = (((sl >> 1) ^ (sk & 3)) << 1) | (sl & 1);
    const bf16_t* kgp = Kg + (size_t)(k_lo + sk) * 64 + kch * 8;
    const bf16_t* vgp = Vg + (size_t)(k_lo + sk) * 64 + vch * 8;
    const unsigned wvb = (unsigned)wave * 1024u;
    const int ntile = (k_hi - k_lo) >> 7;
#define ATT_DMA(tile, bufi) do { const size_t go = (size_t)(tile) * 128 * 64; \
        __builtin_amdgcn_global_load_lds((const unsigned*)(kgp + go), (LAS unsigned*)(L + KOFF + (bufi) * TB + wvb), 16, 0, 0); \
        __builtin_amdgcn_global_load_lds((const unsigned*)(kgp + go + 4096), (LAS unsigned*)(L + KOFF + (bufi) * TB + 8192 + wvb), 16, 0, 0); \
        __builtin_amdgcn_global_load_lds((const unsigned*)(vgp + go), (LAS unsigned*)(L + VOFF + (bufi) * TB + wvb), 16, 0, 0); \
        __builtin_amdgcn_global_load_lds((const unsigned*)(vgp + go + 4096), (LAS unsigned*)(L + VOFF + (bufi) * TB + 8192 + wvb), 16, 0, 0); } while (0)
    ATT_DMA(0, 0);
    if (ntile > 1) ATT_DMA(1, 1);
    if (ntile > 2) ATT_DMA(2, 2);
    if (ntile > 2) asm volatile("s_waitcnt vmcnt(8)" ::: "memory"); else if (ntile > 1) asm volatile("s_waitcnt vmcnt(4)" ::: "memory"); else asm volatile("s_waitcnt vmcnt(0)" ::: "memory");
    __builtin_amdgcn_s_barrier();
    const int p4 = lane & 3, q4 = (lane & 15) >> 2, blk = (lane >> 4) & 1;
    const int keyq = 4 * hh + q4;
    const unsigned va0 = (unsigned)(keyq * 128 + (((0 + blk) ^ (keyq & 3)) << 5) + p4 * 8), va1 = (unsigned)(keyq * 128 + (((2 + blk) ^ (keyq & 3)) << 5) + p4 * 8);
    const int ksw = (qi >> 1) & 7;
    const unsigned ka00 = (unsigned)(qi * 128 + (((0 + hh) ^ ksw) << 4)), ka01 = (unsigned)(qi * 128 + (((2 + hh) ^ ksw) << 4));
    const unsigned ka10 = (unsigned)(qi * 128 + (((4 + hh) ^ ksw) << 4)), ka11 = (unsigned)(qi * 128 + (((6 + hh) ^ ksw) << 4));
    typedef __bf16 bf16x8n __attribute__((ext_vector_type(8)));
    typedef float f32x8 __attribute__((ext_vector_type(8)));
#define ATT_PACK(S, s8) __builtin_bit_cast(bf16x8, __builtin_convertvector((f32x8){S[8 * (s8)], S[8 * (s8) + 1], S[8 * (s8) + 2], S[8 * (s8) + 3], S[8 * (s8) + 4], S[8 * (s8) + 5], S[8 * (s8) + 6], S[8 * (s8) + 7]}, bf16x8n))
#define ATT_MFMA(a, b, c) __builtin_amdgcn_mfma_f32_32x32x16_bf16((a), (b), (c), 0, 0, 0)
    f32x16 S0, S1;
    bf16x8 p1a, p1b, vp00, vp01, vp10, vp11;
#pragma unroll
    for (int j = 0; j < 8; ++j) { p1a[j] = 0; p1b[j] = 0; vp00[j] = 0; vp01[j] = 0; vp10[j] = 0; vp11[j] = 0; }
    for (int it = 0; it < ntile; ++it) {
        const int buf = it & (NBUF - 1);
        if (it + 3 < ntile) ATT_DMA(it + 3, (it + 3) & (NBUF - 1));
        const unsigned kbb = KOFF + buf * TB, vbb = VOFF + buf * TB;
        { const bf16x8 k00 = *(const LAS bf16x8*)(L + kbb + ka00), k01 = *(const LAS bf16x8*)(L + kbb + ka01);
          S0 = ATT_MFMA(k00, qf[0][0], negm); S0 = ATT_MFMA(k01, qf[0][1], S0); }
#pragma unroll 2
        for (int kb = 0; kb < 4; ++kb) {
            const unsigned kro = kbb + kb * 4096, vro = vbb + kb * 4096;
            s16x4 r0, r1, r2, r3, r4, r5, r6, r7;
            { const unsigned a0 = vro + va0, a1 = vro + va1;
              asm volatile("ds_read_b64_tr_b16 %0, %8\n\tds_read_b64_tr_b16 %1, %8 offset:1024\n\tds_read_b64_tr_b16 %2, %8 offset:2048\n\tds_read_b64_tr_b16 %3, %8 offset:3072\n\t"
                           "ds_read_b64_tr_b16 %4, %9\n\tds_read_b64_tr_b16 %5, %9 offset:1024\n\tds_read_b64_tr_b16 %6, %9 offset:2048\n\tds_read_b64_tr_b16 %7, %9 offset:3072"
                           : "=&v"(r0), "=&v"(r1), "=&v"(r2), "=&v"(r3), "=&v"(r4), "=&v"(r5), "=&v"(r6), "=&v"(r7) : "v"(a0), "v"(a1) : "memory"); }
            const bf16x8 k10 = *(const LAS bf16x8*)(L + kro + ka10), k11 = *(const LAS bf16x8*)(L + kro + ka11);
            O[1][0] = ATT_MFMA(vp00, p1a, O[1][0]); O[1][1] = ATT_MFMA(vp01, p1a, O[1][1]);
            O[1][0] = ATT_MFMA(vp10, p1b, O[1][0]); O[1][1] = ATT_MFMA(vp11, p1b, O[1][1]);
            S1 = ATT_MFMA(k10, qf[1][0], negm); S1 = ATT_MFMA(k11, qf[1][1], S1);
            float ps0 = 0.f;
#pragma unroll
            for (int i = 0; i < 16; ++i) { S0[i] = __builtin_amdgcn_exp2f(S0[i]); ps0 += S0[i]; }
            lsum[0] += ps0;
            const bf16x8 p0a = ATT_PACK(S0, 0), p0b = ATT_PACK(S0, 1);
            __builtin_amdgcn_sched_group_barrier(0x008, 1, 0); __builtin_amdgcn_sched_group_barrier(0x400, 3, 0);
            __builtin_amdgcn_sched_group_barrier(0x008, 1, 0); __builtin_amdgcn_sched_group_barrier(0x400, 3, 0);
            __builtin_amdgcn_sched_group_barrier(0x008, 1, 0); __builtin_amdgcn_sched_group_barrier(0x400, 3, 0);
            __builtin_amdgcn_sched_group_barrier(0x008, 1, 0); __builtin_amdgcn_sched_group_barrier(0x400, 3, 0);
            __builtin_amdgcn_sched_group_barrier(0x008, 1, 0); __builtin_amdgcn_sched_group_barrier(0x400, 2, 0);
            __builtin_amdgcn_sched_group_barrier(0x008, 1, 0); __builtin_amdgcn_sched_group_barrier(0x400, 2, 0);
            asm volatile("s_waitcnt lgkmcnt(0)" : "+v"(r0), "+v"(r1), "+v"(r2), "+v"(r3), "+v"(r4), "+v"(r5), "+v"(r6), "+v"(r7));
            vp00 = __builtin_shufflevector(r0, r1, 0, 1, 2, 3, 4, 5, 6, 7); vp10 = __builtin_shufflevector(r2, r3, 0, 1, 2, 3, 4, 5, 6, 7);
            vp01 = __builtin_shufflevector(r4, r5, 0, 1, 2, 3, 4, 5, 6, 7); vp11 = __builtin_shufflevector(r6, r7, 0, 1, 2, 3, 4, 5, 6, 7);
            O[0][0] = ATT_MFMA(vp00, p0a, O[0][0]); O[0][1] = ATT_MFMA(vp01, p0a, O[0][1]);
            O[0][0] = ATT_MFMA(vp10, p0b, O[0][0]); O[0][1] = ATT_MFMA(vp11, p0b, O[0][1]);
            { const bf16x8 k00 = *(const LAS bf16x8*)(L + kro + 4096 + ka00), k01 = *(const LAS bf16x8*)(L + kro + 4096 + ka01);
                S0 = ATT_MFMA(k00, qf[0][0], negm); S0 = ATT_MFMA(k01, qf[0][1], S0); }
            float ps1 = 0.f;
#pragma unroll
            for (int i = 0; i < 16; ++i) { S1[i] = __builtin_amdgcn_exp2f(S1[i]); ps1 += S1[i]; }
            lsum[1] += ps1;
            p1a = ATT_PACK(S1, 0); p1b = ATT_PACK(S1, 1);
            __builtin_amdgcn_sched_group_barrier(0x008, 1, 1); __builtin_amdgcn_sched_group_barrier(0x400, 3, 1);
            __builtin_amdgcn_sched_group_barrier(0x008, 1, 1); __builtin_amdgcn_sched_group_barrier(0x400, 3, 1);
            __builtin_amdgcn_sched_group_barrier(0x008, 1, 1); __builtin_amdgcn_sched_group_barrier(0x400, 3, 1);
            __builtin_amdgcn_sched_group_barrier(0x008, 1, 1); __builtin_amdgcn_sched_group_barrier(0x400, 3, 1);
            __builtin_amdgcn_sched_group_barrier(0x008, 1, 1); __builtin_amdgcn_sched_group_barrier(0x400, 2, 1);
            __builtin_amdgcn_sched_group_barrier(0x008, 1, 1); __builtin_amdgcn_sched_group_barrier(0x400, 2, 1);
        }
        if (it + 3 < ntile) asm volatile("s_waitcnt vmcnt(8)\n\ts_waitcnt lgkmcnt(0)" ::: "memory");
        else if (it + 2 < ntile) asm volatile("s_waitcnt vmcnt(4)\n\ts_waitcnt lgkmcnt(0)" ::: "memory");
        else asm volatile("s_waitcnt vmcnt(0)\n\ts_waitcnt lgkmcnt(0)" ::: "memory");
        __builtin_amdgcn_s_barrier();
    }
    O[1][0] = ATT_MFMA(vp00, p1a, O[1][0]); O[1][1] = ATT_MFMA(vp01, p1a, O[1][1]);
    O[1][0] = ATT_MFMA(vp10, p1b, O[1][0]); O[1][1] = ATT_MFMA(vp11, p1b, O[1][1]);
#undef ATT_DMA
#undef ATT_PACK
#undef ATT_MFMA
    const float l0 = lsum[0] + __shfl_xor(lsum[0], 32), l1 = lsum[1] + __shfl_xor(lsum[1], 32);
    const float i0 = 1.0f / l0, i1 = lam / l1;
    float ss = 0.f;
#pragma unroll
    for (int dvb = 0; dvb < 2; ++dvb)
#pragma unroll
        for (int i = 0; i < 16; ++i) { const float o = O[0][dvb][i] * i0 - O[1][dvb][i] * i1; O[0][dvb][i] = o; ss += o * o; }
    ss += __shfl_xor(ss, 32);
    const float rn = rsqrtf(ss * (1.0f / 64.0f) + LN_EPS) * out_scale;
    const float* sw = F.in[20] + (size_t)ly * 64;
    const int b = bh >> 3, head = bh & 7;
    const size_t row = qpos < SEQ ? (size_t)b * SEQ + qpos : (size_t)RLAT + b * CTXL + (qpos - SEQ);
    bf16_t* dst = (bf16_t*)(F.ws + WS_MIX) + row * DM + 256 + head * 64;
#pragma unroll
    for (int dvb = 0; dvb < 2; ++dvb)
#pragma unroll
        for (int g = 0; g < 4; ++g) { const int dv = dvb * 32 + 8 * g + 4 * hh;
            const f32x4 w4 = *(const f32x4*)(sw + dv);
            u32x2 w; w.x = cvt_pk_bf16(O[0][dvb][4 * g] * rn * w4[0], O[0][dvb][4 * g + 1] * rn * w4[1]); w.y = cvt_pk_bf16(O[0][dvb][4 * g + 2] * rn * w4[2], O[0][dvb][4 * g + 3] * rn * w4[3]);
            *(u32x2*)(dst + dv) = w; }
    __syncthreads();
}

DI void phase_rows_router(const Frame& F, int ly) {
    LAS float* HS = (LAS float*)F.lds;
    LAS float* PART = HS + 16 * 1028;
    LAS int* LCNT = (LAS int*)(PART + 8 * 16 * 64);
    LAS int* LBASE = LCNT + 64;
    LAS int* ASG = LBASE + 64;
    const int lane = F.lane, wave = F.wave;
    const float* MOD = (const float*)(F.ws + WS_MOD);
    const float* g1 = F.in[22] + (size_t)ly * DM; const float* b1 = F.in[23] + (size_t)ly * DM;
    const float* rw = F.in[26] + (size_t)ly * DM * NEXP; const float* rb = F.in[27] + (size_t)ly * NEXP;
    const bool last = ly == DEPTH - 1;
    const int nrows = last ? RLAT : RTOT;
    if (F.tid < 64) LCNT[F.tid] = 0;
    constexpr int HSS = 1028;
    float wreg[128];
#pragma unroll
    for (int i = 0; i < 128; ++i) wreg[i] = rw[(size_t)(wave * 128 + 4 * (i >> 2) + (lane >> 4)) * NEXP + 16 * (i & 3) + (lane & 15)];
    __syncthreads();
    int itn = 0;
    f32x4 va[2][4];
    if (F.bid * 16 < nrows) {
#pragma unroll
        for (int rr = 0; rr < 2; ++rr) { const float* xr = (const float*)(F.ws + WS_X) + (size_t)(F.bid * 16 + wave * 2 + rr) * DM;
#pragma unroll
            for (int j = 0; j < 4; ++j) va[rr][j] = *(const f32x4*)(xr + 4 * lane + 256 * j); } }
    for (int r0 = F.bid * 16; r0 < nrows; r0 += F.G * 16, ++itn) {
#pragma unroll
        for (int rr = 0; rr < 2; ++rr) { const int rl = wave * 2 + rr, row = r0 + rl;
            float* xr = (float*)(F.ws + WS_X) + (size_t)row * DM;
            f32x4 (&v)[4] = va[rr];
            float mu, rstd; ln_stats(v, mu, rstd);
#pragma unroll
            for (int j = 0; j < 4; ++j) { const int c = 4 * lane + 256 * j; const f32x4 g = *(const f32x4*)(g1 + c), bb = *(const f32x4*)(b1 + c);
#pragma unroll
                for (int e = 0; e < 4; ++e) v[j][e] = (v[j][e] - mu) * rstd * g[e] + bb[e];
                *(f32x4*)(xr + c) = v[j]; }
            ln_stats(v, mu, rstd);
            const float* m = MOD + ((size_t)ly * 5 + row_modsel(row)) * 6144;
            bf16_t* hrow = (bf16_t*)(F.ws + WS_H) + (size_t)row * DM;
#pragma unroll
            for (int j = 0; j < 4; ++j) { const int c = 4 * lane + 256 * j; const f32x4 a = *(const f32x4*)(m + 3072 + c), bsc = *(const f32x4*)(m + 4096 + c);
                f32x4 o;
#pragma unroll
                for (int e = 0; e < 4; ++e) o[e] = (v[j][e] - mu) * rstd * (1.f + bsc[e]) + a[e];
                u32x2 w; w.x = cvt_pk_bf16(o[0], o[1]); w.y = cvt_pk_bf16(o[2], o[3]); *(u32x2*)(hrow + c) = w;
                *(LAS f32x4*)(HS + rl * HSS + c) = o; } }
        { const int rn = r0 + F.G * 16;
          if (rn < nrows) {
#pragma unroll
            for (int rr = 0; rr < 2; ++rr) { const float* xr = (const float*)(F.ws + WS_X) + (size_t)(rn + wave * 2 + rr) * DM;
#pragma unroll
                for (int j = 0; j < 4; ++j) va[rr][j] = *(const f32x4*)(xr + 4 * lane + 256 * j); } } }
        asm volatile("s_waitcnt lgkmcnt(0)" ::: "memory"); __builtin_amdgcn_s_barrier();
        { f32x4 acc[4];
#pragma unroll
          for (int nb = 0; nb < 4; ++nb) acc[nb] = (f32x4){0.f, 0.f, 0.f, 0.f};
          const LAS float* hp = HS + (lane & 15) * HSS + wave * 128 + (lane >> 4);
#pragma unroll
          for (int g = 0; g < 32; ++g) { const float a = hp[4 * g];
#pragma unroll
              for (int nb = 0; nb < 4; ++nb) acc[nb] = __builtin_amdgcn_mfma_f32_16x16x4f32(a, wreg[g * 4 + nb], acc[nb], 0, 0, 0); }
#pragma unroll
          for (int nb = 0; nb < 4; ++nb)
#pragma unroll
              for (int e = 0; e < 4; ++e) PART[(wave * 16 + (lane >> 4) * 4 + e) * 64 + nb * 16 + (lane & 15)] = acc[nb][e]; }
        asm volatile("s_waitcnt lgkmcnt(0)" ::: "memory"); __builtin_amdgcn_s_barrier();
#pragma unroll
        for (int rr = 0; rr < 2; ++rr) { const int rl = wave * 2 + rr, row = r0 + rl;
            float lg = 0.f;
#pragma unroll
            for (int w = 0; w < 8; ++w) lg += PART[(w * 16 + rl) * 64 + lane];
            const float s = 1.0f / (1.0f + expf(-lg));
            const float sel = s + rb[lane];
            float m1 = sel;
            m1 = fmaxf(m1, __shfl_xor(m1, 1)); m1 = fmaxf(m1, __shfl_xor(m1, 2)); m1 = fmaxf(m1, __shfl_xor(m1, 4));
            const unsigned long long bal = __ballot(sel == m1);
            const int gbase = lane & ~7;
            const unsigned gmask = (unsigned)((bal >> gbase) & 0xffull);
            const int first = gbase + __builtin_ctz(gmask);
            float m2 = (lane == first) ? -INFINITY : sel;
            m2 = fmaxf(m2, __shfl_xor(m2, 1)); m2 = fmaxf(m2, __shfl_xor(m2, 2)); m2 = fmaxf(m2, __shfl_xor(m2, 4));
            const float gs = m1 + m2;
            const int mygrp = lane >> 3;
            int grank = 0;
#pragma unroll
            for (int g = 0; g < 8; ++g) { const float o = __shfl(gs, g * 8); grank += (o > gs || (o == gs && g < mygrp)) ? 1 : 0; }
            const float msel = grank < 4 ? sel : -INFINITY;
            int rank = 64;
            { float cur = msel;
#pragma unroll 1
              for (int it = 0; it < 8; ++it) { const float m = wave_max(cur); const unsigned long long bl = __ballot(cur == m); const int first2 = (int)__builtin_ctzll(bl);
                  if (lane == first2) { rank = it; cur = -INFINITY; } } }
            const bool chosen = rank < 8;
            const float wsum = wave_sum(chosen ? s : 0.f);
            if (chosen) { const float gate = s / wsum * 2.5f;
                ((float*)(F.ws + WS_TOPG))[(size_t)row * 8 + rank] = gate;
                const int lp = __hip_atomic_fetch_add(LCNT + lane, 1, __ATOMIC_RELAXED, __HIP_MEMORY_SCOPE_WORKGROUP);
                ASG[(itn * 16 + rl) * 8 + rank] = (lane << 20) | lp; } }
        asm volatile("s_waitcnt lgkmcnt(0)" ::: "memory"); __builtin_amdgcn_s_barrier();
    }
    if (F.tid < 64) { const int n = LCNT[F.tid]; LBASE[F.tid] = n ? (int)atomicAdd(F.ctl + CW_CNT + (ly * 64 + F.tid) * CNT_STRIDE, (unsigned)n) : 0; }
    __syncthreads();
    for (int a = F.tid; a < itn * 128; a += NTHR) { const int it = a >> 7, rl = (a >> 3) & 15, slot = a & 7; const int row = F.bid * 16 + it * F.G * 16 + rl;
        const int v = ASG[a], e = v >> 20, lp = v & 0xfffff;
        ((int*)(F.ws + WS_LIST))[(size_t)e * RTOT + LBASE[e] + lp] = row * 8 + slot;
        ((int*)(F.ws + WS_TOPE))[(size_t)row * 8 + slot] = (e << 20) | (LBASE[e] + lp); }
    __syncthreads();
}

DI void bf8_fma(const u32x4 w, float g, float (&y)[8]) {
    y[0] += bflo(w.x) * g; y[1] += bfhi(w.x) * g; y[2] += bflo(w.y) * g; y[3] += bfhi(w.y) * g; y[4] += bflo(w.z) * g; y[5] += bfhi(w.z) * g; y[6] += bflo(w.w) * g; y[7] += bfhi(w.w) * g;
}
DI void phase_combine(const Frame& F, int ly) {
    const int gw = F.bid * 8 + F.wave, nw = F.G * 8, lane = F.lane;
    const bool last = ly == DEPTH - 1;
    const int nrows = last ? RLAT : RTOT;
    const float* MOD = (const float*)(F.ws + WS_MOD);
    const float* g2w = F.in[24] + (size_t)ly * DM; const float* b2w = F.in[25] + (size_t)ly * DM;
    const bf16_t* YB = (const bf16_t*)(F.ws + WS_YB);
    const MoeTab T = moe_tables(F, ly);
    for (int row = gw; row < nrows; row += nw) {
        const float* gates = (const float*)(F.ws + WS_TOPG) + (size_t)row * 8;
        const int* posr = (const int*)(F.ws + WS_TOPE) + (size_t)row * 8;
        u32x4 yr[9][2];
#pragma unroll
        for (int s9 = 0; s9 < 9; ++s9) { size_t yrow;
            if (s9 < 8) { const int v = posr[s9]; yrow = (size_t)T.tstart[v >> 20] * 256 + (v & 0xfffff); } else yrow = (size_t)T.tstart[NEXP] * 256 + row;
#pragma unroll
            for (int hf = 0; hf < 2; ++hf) yr[s9][hf] = __builtin_nontemporal_load((const u32x4*)(YB + yrow * DM + hf * 512 + 8 * lane)); }
        float* xr = (float*)(F.ws + WS_X) + (size_t)row * DM;
        f32x4 xv[4];
#pragma unroll
        for (int hf = 0; hf < 2; ++hf) { xv[2 * hf] = *(const f32x4*)(xr + hf * 512 + 8 * lane); xv[2 * hf + 1] = *(const f32x4*)(xr + hf * 512 + 8 * lane + 4); }
        float y[2][8];
#pragma unroll
        for (int hf = 0; hf < 2; ++hf) {
#pragma unroll
            for (int e = 0; e < 8; ++e) y[hf][e] = 0.f;
            bf8_fma(yr[8][hf], 1.0f, y[hf]);
#pragma unroll
            for (int s8 = 0; s8 < 8; ++s8) bf8_fma(yr[s8][hf], gates[s8], y[hf]); }
        const float* m = MOD + ((size_t)ly * 5 + row_modsel(row)) * 6144;
        f32x4 v[4];
#pragma unroll
        for (int q = 0; q < 4; ++q) { const int c = (q >> 1) * 512 + 8 * lane + (q & 1) * 4; const f32x4 g2 = *(const f32x4*)(m + 5120 + c);
#pragma unroll
            for (int e = 0; e < 4; ++e) v[q][e] = xv[q][e] * ALPHA + g2[e] * y[q >> 1][(q & 1) * 4 + e]; }
        float mu, rstd; ln_stats(v, mu, rstd);
#pragma unroll
        for (int q = 0; q < 4; ++q) { const int c = (q >> 1) * 512 + 8 * lane + (q & 1) * 4; const f32x4 g = *(const f32x4*)(g2w + c), bb = *(const f32x4*)(b2w + c);
#pragma unroll
            for (int e = 0; e < 4; ++e) v[q][e] = (v[q][e] - mu) * rstd * g[e] + bb[e];
            if (last) *(f32x4*)(F.out + (size_t)row * DM + c) = v[q]; else *(f32x4*)(xr + c) = v[q]; }
        if (!last) { const float* mn = MOD + ((size_t)(ly + 1) * 5 + row_modsel(row)) * 6144;
            ln_stats(v, mu, rstd);
            bf16_t* hrow = (bf16_t*)(F.ws + WS_H) + (size_t)row * DM;
#pragma unroll
            for (int hf = 0; hf < 2; ++hf) { const int c = hf * 512 + 8 * lane; float o[8];
#pragma unroll
                for (int q = 0; q < 2; ++q) { const f32x4 sh = *(const f32x4*)(mn + c + 4 * q), sc = *(const f32x4*)(mn + 1024 + c + 4 * q);
#pragma unroll
                    for (int e = 0; e < 4; ++e) o[4 * q + e] = (v[2 * hf + q][e] - mu) * rstd * (1.f + sc[e]) + sh[e]; }
                u32x4 w; w.x = cvt_pk_bf16(o[0], o[1]); w.y = cvt_pk_bf16(o[2], o[3]); w.z = cvt_pk_bf16(o[4], o[5]); w.w = cvt_pk_bf16(o[6], o[7]);
                *(u32x4*)(hrow + c) = w; } }
    }
}

PHASE_FN void ph_pre0(const Frame& F0) { const Frame F = relaunder(F0); prep_small(F, 0); prep_mod(F); prep_filters(F); prep_tables(F); }
PHASE_FN void ph_pre1(const Frame& F0) { const Frame F = relaunder(F0); prep_invl1(F); phase_init_h(F); }
PHASE_FN void ph_win(const Frame& F0, int ly) { const Frame F = relaunder(F0);
    pg8::Gemm g{(const bf16_t*)(F.ws + WS_H), (const bf16_t*)(F.ws + WS_WIN), DM, F.tid};
    pg8::StaticOrder S; S.init(RTOT / 256, NWIN / 256, F.G, F.bid);
    EpiWin E{F.ws, ly};
    pg8::gemm_phase<EpiWin, pg8::StaticOrder>(F.lds, g, S, E);
}
constexpr int NSTREAM = 0;
PHASE_FN void ph_mix(const Frame& F0, int ly) { const Frame F = relaunder(F0);
    volatile LAS unsigned* MISC = (volatile LAS unsigned*)(F.lds + LDS_MISC);
    const bool last = ly == DEPTH - 1;
    if (!last) { pg8::Gemm g{(const bf16_t*)(F.ws + WS_DFTC), (const bf16_t*)(F.ws + WS_YTC), 2 * CTXL, F.tid};
      pg8::StaticOrder S; S.init(1, 4, F.G, (F.bid + F.G - 64) % F.G);
      EpiFnet E{F.ws, 1};
      pg8::gemm_phase<EpiFnet, pg8::StaticOrder>(F.lds, g, S, E); }
    __syncthreads();
    for (;;) {
        __syncthreads();
        if (F.tid == 0) MISC[16] = atomicAdd(F.ctl + CW_ATTN + 64 * ly, 1u);
        __syncthreads();
        const int uid = (int)MISC[16];
        if (uid >= 256 + 256 + (last ? 512 : 544)) break;
        const Frame Fu = relaunder(F);
        if (uid < 256) { if (KIND(4)) { hyena_fft_unit(Fu, ly, uid); if (!last) hyena_ctx_unit(Fu, ly, uid); } }
        else if (uid < 512) { if (KIND(3)) fnet_fft_unit(Fu, uid - 256); }
        else if (KIND(5)) { const float* lm = (const float*)(Fu.ws + WS_LAM) + 2 * ly; attn_unit(Fu, ly, uid - 512, lm[0], 1.0f - lm[1]); }
    }
    prep_experts(F, ly, CW_PREPQ, 0, PREP_SPLIT);
}
PHASE_FN void ph_wout(const Frame& F0, int ly) { const Frame F = relaunder(F0);
    pg8::Gemm g{(const bf16_t*)(F.ws + WS_MIX), (const bf16_t*)(F.ws + WS_WOUT), DM, F.tid};
    pg8::StaticOrder S; S.init(ly == DEPTH - 1 ? RLAT / 256 : RTOT / 256, DM / 256, F.G, F.bid);
    EpiWout E{F.ws, ly, F.in[0], F.in[2]};
    pg8::gemm_phase<EpiWout, pg8::StaticOrder>(F.lds, g, S, E);
    __syncthreads();
    prep_experts(F, ly, CW_PREPQ2, PREP_SPLIT, PREP_SPLIT2);
}
PHASE_FN void ph_router(const Frame& F0, int ly) { const Frame F = relaunder(F0); phase_rows_router(F, ly); prep_experts(F, ly, CW_PREPQ4, PREP_SPLIT2, 3 * 1040); }
PHASE_FN void ph_moe1(const Frame& F0, int ly) { const Frame F = relaunder(F0);
    const MoeTab T = moe_tables(F, ly);
    pg8::Gemm g{(const bf16_t*)(F.ws + WS_H), (const bf16_t*)(F.ws + WS_WGU), DM, F.tid};
    MoeSched<true> S{T, (const int*)(F.ws + WS_LIST), F.G, F.bid, 2, 1};
    EpiMoe1 E{F.ws};
    pg8::gemm_phase<EpiMoe1, MoeSched<true>>(F.lds, g, S, E);
    __syncthreads();
    if (ly + 1 < DEPTH) prep_small_dyn(F, ly + 1);
}
PHASE_FN void ph_moe2(const Frame& F0, int ly) { const Frame F = relaunder(F0);
    const MoeTab T = moe_tables(F, ly);
    pg8::Gemm g{(const bf16_t*)(F.ws + WS_ACT), (const bf16_t*)(F.ws + WS_WD), DEXP, F.tid};
    MoeSched<false> S{T, (const int*)(F.ws + WS_LIST), F.G, F.bid, 4, 2};
    EpiMoe2 E{F.ws};
    pg8::gemm_phase<EpiMoe2, MoeSched<false>>(F.lds, g, S, E);
}
PHASE_FN void ph_combine(const Frame& F0, int ly) { const Frame F = relaunder(F0); phase_combine(F, ly); }

constexpr int PH_PER_LAYER = 7, N_PHASES = 2 + DEPTH * PH_PER_LAYER;

__global__ void __launch_bounds__(NTHR, 2) hybrid_fwd(Params prm) {
    extern __shared__ __attribute__((aligned(16))) unsigned char lds_raw[];
    Frame F;
    F.in = prm.in; F.out = prm.out; F.ws = prm.ws; F.lds = (LAS unsigned char*)lds_raw; F.ctl = (unsigned*)(prm.ws + WS_CTL);
    F.tid = threadIdx.x; F.lane = F.tid & 63; F.wave = __builtin_amdgcn_readfirstlane(F.tid >> 6); F.G = gridDim.x; F.bid = blockIdx.x;
    volatile LAS unsigned* MISC = (volatile LAS unsigned*)(F.lds + LDS_MISC);
    if (F.tid < 64) MISC[F.tid] = 0u;
    __syncthreads();
    const int lo = prm.ph_lo, hi = prm.ph_hi;
    XcdBarrier bar; bar.bar = F.ctl + CW_BAR; bar.x = 0; bar.st = nullptr;
    if (hi - lo > 1) bar = xcd_barrier_post(F.ctl + CW_BAR, MISC);
#define IN(k) (lo <= (k) && (k) < hi)
    unsigned long long pr_acc = 0ull, pr_t0 = 0ull;
#define SEAM(k) do { if (IN(k) && IN((k) + 1)) { unsigned long long _b0 = 0; if ((PROBE_KINDS >> 12) & 1) _b0 = __builtin_amdgcn_s_memrealtime(); xcd_barrier(bar); if ((PROBE_KINDS >> 12) & 1) pr_acc += __builtin_amdgcn_s_memrealtime() - _b0; } } while (0)
#define PR_BEGIN(kind) do { if ((PROBE_KINDS >> (kind)) & 1) pr_t0 = __builtin_amdgcn_s_memrealtime(); } while (0)
#define PR_END(kind) do { if ((PROBE_KINDS >> (kind)) & 1) pr_acc += __builtin_amdgcn_s_memrealtime() - pr_t0; } while (0)

    PR_BEGIN(0); if (IN(0) && KIND(0)) { const Frame Fp = relaunder(F); PR_BEGIN(13); prep_small(Fp, 0); PR_END(13); PR_BEGIN(14); prep_mod(Fp); PR_END(14); PR_BEGIN(15); prep_filters(Fp); PR_END(15); PR_BEGIN(16); prep_tables(Fp); PR_END(16); }
    PR_END(0); SEAM(0);
    PR_BEGIN(1); if (IN(1) && KIND(1)) ph_pre1(F);
    PR_END(1); SEAM(1);

    for (int ly = 0; ly < DEPTH; ++ly) {
        const int p0 = 2 + ly * PH_PER_LAYER;
        PR_BEGIN(2); if (IN(p0) && KIND(2)) ph_win(F, ly);
        PR_END(2); SEAM(p0);
        if (IN(p0 + 1)) { PR_BEGIN(5); ph_mix(F, ly); }
        PR_END(5); SEAM(p0 + 1);
        PR_BEGIN(6); if (IN(p0 + 2) && KIND(6)) ph_wout(F, ly);
        PR_END(6); SEAM(p0 + 2);
        PR_BEGIN(7); if (IN(p0 + 3) && KIND(7)) ph_router(F, ly);
        PR_END(7); SEAM(p0 + 3);
        PR_BEGIN(8); if (IN(p0 + 4) && KIND(8)) ph_moe1(F, ly);
        PR_END(8); SEAM(p0 + 4);
        PR_BEGIN(9); if (IN(p0 + 5) && KIND(9)) ph_moe2(F, ly);
        PR_END(9); SEAM(p0 + 5);
        PR_BEGIN(10); if (IN(p0 + 6) && KIND(10)) { const Frame Fc = relaunder(F); PR_BEGIN(17); phase_combine(Fc, ly); PR_END(17);  }
        PR_END(10); SEAM(p0 + 6);
    }
    if (PROBE_KINDS != 0 && blockIdx.x == 0) {
        const unsigned long long t0 = __builtin_amdgcn_s_memrealtime(), wait = pr_acc * (unsigned long long)PROBE_AMP;
        while (__builtin_amdgcn_s_memrealtime() - t0 < wait) __builtin_amdgcn_s_sleep(8);
    }
#undef IN
#undef SEAM
}

extern "C" void kernel_launch(void* const* d_in, const int* in_sizes, int n_in, void* d_out, int out_size, void* d_ws, size_t ws_size, hipStream_t stream) {
    static int grid = 0;
    if (grid == 0) {
        if (n_in != 34 || out_size != RLAT * DM || ws_size < WS_END) { fprintf(stderr, "kernel_launch: unexpected problem shape (n_in %d out %d ws %zu need %zu)\n", n_in, out_size, ws_size, (size_t)WS_END); grid = -1; return; }
        int dev = 0, cus = 0, per_cu = 0;
        if (hipGetDevice(&dev) != hipSuccess || hipDeviceGetAttribute(&cus, hipDeviceAttributeMultiprocessorCount, dev) != hipSuccess) { grid = -1; return; }
        if (hipFuncSetAttribute((const void*)hybrid_fwd, hipFuncAttributeMaxDynamicSharedMemorySize, LDS_BYTES) != hipSuccess) { fprintf(stderr, "kernel_launch: hipFuncSetAttribute failed\n"); grid = -1; return; }
        if (hipOccupancyMaxActiveBlocksPerMultiprocessor(&per_cu, (const void*)hybrid_fwd, NTHR, LDS_BYTES) != hipSuccess || per_cu < 1)
            fprintf(stderr, "kernel_launch: occupancy query reports %d workgroups per CU\n", per_cu);
        (void)hipGetLastError();
        grid = cus;
    }
    if (grid < 0) return;
    (void)hipMemsetAsync((char*)d_ws + WS_CTL, 0, CTL_BYTES, stream);
    Params p{};
    for (int i = 0; i < 34; ++i) p.in[i] = (const float*)d_in[i];
    p.out = (float*)d_out; p.ws = (unsigned char*)d_ws;
#if MK_PER_PHASE
    for (int ph = 0; ph < N_PHASES; ++ph) { p.ph_lo = ph; p.ph_hi = ph + 1; hipLaunchKernelGGL(hybrid_fwd, dim3(grid), dim3(NTHR), LDS_BYTES, stream, p); }
#else
    p.ph_lo = 0; p.ph_hi = N_PHASES;
    hipLaunchKernelGGL(hybrid_fwd, dim3(grid), dim3(NTHR), LDS_BYTES, stream, p);
#endif
}
```

```cpp
#include <hip/hip_runtime.h>
#include <cstdio>
#include <cstdint>

#ifndef MK_PER_PHASE
#define MK_PER_PHASE 0
#endif

#ifndef PG8_ALIGN
#define PG8_ALIGN 1
#endif
#ifndef PG8_OPAQUE_K
#define PG8_OPAQUE_K 1
#endif
#ifndef MK_OUTLINE
#define MK_OUTLINE 0
#endif
#if MK_OUTLINE
#define PHASE_FN __device__ __attribute__((noinline))
#else
#define PHASE_FN __device__ __forceinline__
#endif
#ifndef PROBE_KINDS
#define PROBE_KINDS 0
#endif
#ifndef PROBE_AMP
#define PROBE_AMP 4
#endif
#ifndef KMASK
#define KMASK 0xFFFF
#endif
#define KIND(k) ((KMASK >> (k)) & 1)
#define LAS __attribute__((address_space(3)))
typedef unsigned short bf16_t;
typedef short bf16x8 __attribute__((ext_vector_type(8)));
typedef short s16x4 __attribute__((ext_vector_type(4)));
typedef float f32x4 __attribute__((ext_vector_type(4)));
typedef float f32x16 __attribute__((ext_vector_type(16)));
typedef unsigned u32x4 __attribute__((ext_vector_type(4)));
typedef unsigned u32x2 __attribute__((ext_vector_type(2)));
#define DI __device__ __forceinline__

constexpr int NB = 4, SEQ = 4096, CTXL = 256, DM = 1024, DEPTH = 4;
constexpr int POS = SEQ + CTXL;
constexpr int RLAT = NB * SEQ, RCTX = NB * CTXL, RTOT = RLAT + RCTX;
constexpr int DIN = 2560, NWIN = 2816;
constexpr int NEXP = 64, DEXP = 256;
constexpr float LN_EPS = 1e-5f;
constexpr float ALPHA = 1.681792830507429f;
constexpr float QSCALE = 0.17677669529663687f * 1.4426950408889634f;
constexpr int MAXTILES = 680;

constexpr size_t AL(size_t x) { return (x + 255) & ~(size_t)255; }
constexpr size_t WS_CTL = 0, CTL_BYTES = 1u << 17;
constexpr size_t WS_X = WS_CTL + CTL_BYTES;
constexpr size_t WS_H = WS_X + AL((size_t)RTOT * DM * 4);
constexpr size_t WS_MOD = WS_H + AL((size_t)RTOT * DM * 2);
constexpr size_t WS_HCL = WS_MOD + AL((size_t)DEPTH * 5 * 6144 * 4);
constexpr size_t WS_HCC = WS_HCL + AL((size_t)DEPTH * 4 * 256 * SEQ * 4);
constexpr size_t WS_INVL1 = WS_HCC + AL((size_t)DEPTH * 4 * 256 * CTXL * 4);
constexpr size_t WS_DFTL = WS_INVL1 + AL((size_t)DEPTH * 2 * 2 * 256 * 4);
constexpr size_t WS_DFTC = WS_DFTL + 256;
constexpr size_t WS_ROPE = WS_DFTC + AL((size_t)CTXL * 2 * CTXL * 2);
constexpr size_t WS_LAM = WS_ROPE + AL(64 * 8 * 2 * 4);
constexpr size_t WS_WIN = WS_LAM + 256;
constexpr size_t WS_WOUT = WS_WIN + AL((size_t)NWIN * DM * 2);
constexpr size_t WS_WGU = WS_WOUT + AL((size_t)DM * DM * 2);
constexpr size_t WS_WD = WS_WGU + AL((size_t)65 * 512 * DM * 2);
constexpr size_t WS_TOPE = WS_WD + AL((size_t)65 * DM * DEXP * 2);
constexpr size_t WS_TOPG = WS_TOPE + AL((size_t)RTOT * 8 * 4);
constexpr size_t WS_LIST = WS_TOPG + AL((size_t)RTOT * 8 * 4);
constexpr size_t WS_SPEC = WS_LIST + AL((size_t)NEXP * RTOT * 4);
constexpr size_t WS_Z1 = WS_SPEC + AL((size_t)256 * 2 * 8192 * 8);
constexpr size_t WS_U = WS_Z1 + AL((size_t)256 * SEQ * 4 * 4);
constexpr size_t WS_Q = WS_U;
constexpr size_t WS_K = WS_Q + AL((size_t)NB * 8 * POS * 64 * 2);
constexpr size_t WS_V = WS_K + AL((size_t)NB * 8 * POS * 64 * 2);
constexpr size_t WS_HYT = WS_V + AL((size_t)NB * 8 * POS * 64 * 2);
constexpr size_t WS_YTL = WS_HYT + AL((size_t)NB * 768 * POS * 4);
constexpr size_t WS_YTC = WS_YTL + AL((size_t)1024 * 8192 * 2);
constexpr size_t WS_MIX = WS_YTC + AL((size_t)1024 * 512 * 2);
constexpr size_t WS_U1_END = WS_MIX + AL((size_t)RTOT * DM * 2);
constexpr size_t WS_ACT = WS_U;
constexpr size_t WS_YB = WS_ACT + AL((size_t)MAXTILES * 256 * DEXP * 2);
constexpr size_t WS_U2_END = WS_YB + AL((size_t)MAXTILES * 256 * DM * 2);
constexpr size_t WS_END = WS_U2_END > WS_U1_END ? WS_U2_END : WS_U1_END;

constexpr int CW_BAR = 0;
constexpr int CW_ATTN = 4096;
constexpr int CW_PREPQ = 4096 + 1024;
constexpr int CW_PREPQ2 = 4096 + 1536;
constexpr int CW_PREPQ3 = 4096 + 2048;
constexpr int CW_PREPQ4 = 4096 + 2560;
constexpr int PREP_SPLIT2 = 2640;
constexpr int PREP_SPLIT = 1200;
constexpr int CW_KMAX = 4096 + 512;
constexpr int CW_CNT = 8192;
constexpr int CNT_STRIDE = 64;

DI unsigned cvt_pk_bf16(float lo, float hi) { unsigned r; asm volatile("v_cvt_pk_bf16_f32 %0, %1, %2" : "=v"(r) : "v"(lo), "v"(hi)); return r; }
DI bf16x8 pack8(float a0, float a1, float a2, float a3, float a4, float a5, float a6, float a7) {
    u32x4 p;
    asm volatile("v_cvt_pk_bf16_f32 %0, %4, %5\n\tv_cvt_pk_bf16_f32 %1, %6, %7\n\tv_cvt_pk_bf16_f32 %2, %8, %9\n\tv_cvt_pk_bf16_f32 %3, %10, %11\n\ts_nop 1"
                 : "=&v"(p[0]), "=&v"(p[1]), "=&v"(p[2]), "=&v"(p[3]) : "v"(a0), "v"(a1), "v"(a2), "v"(a3), "v"(a4), "v"(a5), "v"(a6), "v"(a7));
    return __builtin_bit_cast(bf16x8, p);
}
DI bf16_t f2bf(float x) { return (bf16_t)(cvt_pk_bf16(x, 0.f) & 0xffffu); }
DI float bf2f(unsigned short u) { return __uint_as_float(((unsigned)u) << 16); }
DI float bflo(unsigned w) { return __uint_as_float(w << 16); }
DI float bfhi(unsigned w) { return __uint_as_float(w & 0xffff0000u); }
DI float wave_sum(float v) {
#pragma unroll
    for (int o = 32; o >= 1; o >>= 1) v += __shfl_xor(v, o);
    return v;
}
DI float wave_max(float v) {
#pragma unroll
    for (int o = 32; o >= 1; o >>= 1) v = fmaxf(v, __shfl_xor(v, o));
    return v;
}

#define XB_TMO      128
#define XB_XCNT(j)  (256  + 64 * (j))
#define XB_XSUB(j)  (1280 + 64 * (j))
#define XB_XGEN(j)  (2304 + 64 * (j))
#define XB_TOP      3328
#define XB_TOPGEN   3392
#define XCD_BAR_WORDS 3456
#define XB_SPIN_CAP (1u << 18)

__device__ __forceinline__ unsigned xb_ld(unsigned* p)              { return __hip_atomic_load(p, __ATOMIC_RELAXED, __HIP_MEMORY_SCOPE_AGENT); }
__device__ __forceinline__ unsigned xb_add(unsigned* p, unsigned v) { return __hip_atomic_fetch_add(p, v, __ATOMIC_RELAXED, __HIP_MEMORY_SCOPE_AGENT); }
__device__ __forceinline__ unsigned xb_xcc_id() { return (unsigned)__builtin_amdgcn_s_getreg((3 << 11) | 20) & 0xFu; }
#define XB_SPIN(cond, bar) do { unsigned _sp = 0; while (cond) { __builtin_amdgcn_s_sleep(1); \
    if ((++_sp & 255u) == 0u) { if (xb_ld(&(bar)[XB_TMO])) break; if (_sp > XB_SPIN_CAP) { atomicAdd(&(bar)[XB_TMO], 1u); break; } } } } while (0)

struct XcdBarrier { unsigned* bar; unsigned x; volatile LAS unsigned* st; };

__device__ __forceinline__ XcdBarrier xcd_barrier_post(unsigned* bar, volatile LAS unsigned* st) {
    XcdBarrier b; b.bar = bar; b.x = xb_xcc_id(); b.st = st;
    if (threadIdx.x == 0) (void)xb_add(&bar[XB_XCNT(b.x)], 1u);
    return b;
}
__device__ __forceinline__ void xcd_barrier_complete(unsigned* bar, unsigned x, unsigned& nloc, unsigned& nx) {
    const unsigned G = gridDim.x * gridDim.y * gridDim.z;
    unsigned sum, cnt, mine, sp = 0u;
    for (;;) {
        sum = 0u; cnt = 0u; mine = 0u;
#pragma unroll
        for (unsigned j = 0; j < 16; ++j) { const unsigned c = xb_ld(&bar[XB_XCNT(j)]); sum += c; cnt += (c > 0u) ? 1u : 0u; mine = (j == x) ? c : mine; }
        if (sum == G) break;
        __builtin_amdgcn_s_sleep(1);
        if ((++sp & 255u) == 0u) { if (xb_ld(&bar[XB_TMO])) break; if (sp > XB_SPIN_CAP) { atomicAdd(&bar[XB_TMO], 1u); break; } }
    }
    nloc = mine > 0u ? mine : 1u; nx = cnt > 0u ? cnt : 1u;
}
__device__ __forceinline__ void xcd_barrier(const XcdBarrier& b) {
    asm volatile("s_waitcnt vmcnt(0)" ::: "memory");
    __syncthreads();
    if (threadIdx.x == 0) {
        unsigned* bar = b.bar;
        __builtin_amdgcn_s_waitcnt(0);
        unsigned nloc = b.st[0], nx = b.st[1];
        if (nloc == 0u) { xcd_barrier_complete(bar, b.x, nloc, nx); b.st[0] = nloc; b.st[1] = nx; }
        const unsigned old = xb_add(&bar[XB_XSUB(b.x)], 1u);
        const unsigned gen = old / nloc;
        if (old + 1u == (gen + 1u) * nloc) {
            __builtin_amdgcn_fence(__ATOMIC_RELEASE, "agent");
            asm volatile("s_waitcnt vmcnt(0)" ::: "memory");
            const unsigned og = xb_add(&bar[XB_TOP], 1u);
            const unsigned tg = og / nx;
            if (og + 1u == (tg + 1u) * nx) xb_add(&bar[XB_TOPGEN], 1u);
            else XB_SPIN(xb_ld(&bar[XB_TOPGEN]) == tg, bar);
            __builtin_amdgcn_fence(__ATOMIC_ACQUIRE, "agent");
            xb_add(&bar[XB_XGEN(b.x)], 1u);
            asm volatile("s_waitcnt vmcnt(0)" ::: "memory");
        } else {
            XB_SPIN(xb_ld(&bar[XB_XGEN(b.x)]) == gen, bar);
            __builtin_amdgcn_fence(__ATOMIC_ACQUIRE, "agent");
            asm volatile("s_waitcnt vmcnt(0)" ::: "memory");
        }
    }
    __syncthreads();
}

namespace pg8 {
constexpr int BM = 256, BK = 64, HALF = 128, HTB = HALF * BK * 2, STAGE_BYTES = 8 * HTB, NXCD = 8, WGM = 8;
__host__ __device__ __forceinline__ int lds_byte(int r, int c) { const int st = (r >> 4) * 2 + (c >> 5), rr = r & 15, cc = c & 31, ob = rr * 64 + cc * 2; return st * 1024 + (ob ^ (((ob >> 9) & 1) << 5)); }
__host__ __device__ __forceinline__ void stage_rc(int b, int& R, int& C) { const int st = b / 1024, sb = b % 1024, swz = sb ^ (((sb >> 9) & 1) << 5); R = (st >> 1) * 16 + swz / 64; C = (st & 1) * 32 + (swz % 64) / 2; }
__host__ __device__ __forceinline__ int perm32(int rho) { const int n = rho >> 4, i = rho & 15; return 8 * (i >> 2) + 4 * n + (i & 3); }

struct Unit { int pm, pn, e, lt; };
struct Gemm { const bf16_t* A; const bf16_t* Bt; int K; int tid; };

struct StaticOrder {
    static constexpr bool GATHER = false;
    int nM, nN, nwg, G, c;
    __device__ void init(int nM_, int nN_, int G_, int c_) { nM = nM_; nN = nN_; nwg = nM * nN; G = G_; c = c_; }
    __device__ bool next(int i, Unit& u) const {
        const long L = (long)i * G + c; if (L >= nwg) return false;
        int wgid = (int)L; { const int q = nwg / NXCD, r = nwg % NXCD, xcd = wgid % NXCD, off = wgid / NXCD; wgid = (xcd < r ? xcd * (q + 1) : r * (q + 1) + (xcd - r) * q) + off; }
        const int nig = WGM * nN, gid = wgid / nig, fm = gid * WGM, gsz = (nM - fm) < WGM ? (nM - fm) : WGM;
        u.pm = fm + ((wgid % nig) % gsz); u.pn = (wgid % nig) / gsz; u.e = 0; u.lt = 0; return true;
    }
    __device__ __forceinline__ int arow(const Unit& u, int r) const { return u.pm * BM + r; }
};

template <class Epi, class Sched>
__device__ __forceinline__ void gemm_phase(LAS unsigned char* lds, const Gemm g, const Sched& S, const Epi& E) {
    constexpr bool GA = Sched::GATHER;
    int tid = g.tid; asm volatile("" : "+v"(tid));
    const int wid = __builtin_amdgcn_readfirstlane(tid >> 6), lane = tid & 63, wr = wid >> 2, wc = wid & 3, fr = lane & 15, fq = lane >> 4;
    int K = g.K;
#if PG8_OPAQUE_K
    asm volatile("" : "+s"(K));
#endif
    const int nt = K / BK;
    unsigned voffA[2], voffB[2];
#pragma unroll
    for (int i = 0; i < 2; ++i) { int R, C; stage_rc(tid * 16 + i * 8192, R, C); const int Rb = Epi::PERM ? ((R & ~31) + perm32(R & 31)) : R;
        voffA[i] = (unsigned)(R * K + C) * 2u; voffB[i] = (unsigned)(Rb * K + C) * 2u; }
    const size_t kstep = (size_t)(BK * 2);
    const size_t hstep = (size_t)HALF * K * 2;
    const size_t tstep = 2 * hstep;
    const unsigned ldsw = (unsigned)wid * 1024u;
    const int aoff = lds_byte(wr * 64 + fr, fq * 8), boff = lds_byte(wc * 32 + fr, fq * 8);
#define PG8_SA(b, h) (((b) * 2 + (h)) * HTB)
#define PG8_SB(b, h) ((4 + (b) * 2 + (h)) * HTB)
#define PG8_STAGE(bufoff, gbase, voff) do { _Pragma("unroll") for (int _i = 0; _i < 2; ++_i) \
        __builtin_amdgcn_global_load_lds((const unsigned*)((const char*)(gbase) + (voff)[_i]), (LAS unsigned*)(lds + (bufoff) + ldsw + _i * 8192), 16, 0, 0); } while (0)
#define PG8_STAGEA(bufoff, gbase, o0, o1) do { \
        __builtin_amdgcn_global_load_lds((const unsigned*)((const char*)(gbase) + (o0)), (LAS unsigned*)(lds + (bufoff) + ldsw), 16, 0, 0); \
        __builtin_amdgcn_global_load_lds((const unsigned*)((const char*)(gbase) + (o1)), (LAS unsigned*)(lds + (bufoff) + ldsw + 8192), 16, 0, 0); } while (0)
#define PG8_STA(bufoff, sp, gp, o0, o1) do { if constexpr (GA) PG8_STAGEA(bufoff, gp, o0, o1); else PG8_STAGE(bufoff, sp, voffA); } while (0)
#define PG8_LDA(dst, b, h) do { _Pragma("unroll") for (int m = 0; m < 4; ++m) _Pragma("unroll") for (int k = 0; k < 2; ++k) dst[m][k] = *(const LAS bf16x8*)(lds + PG8_SA(b, h) + aoff + m * 2048 + k * 1024); } while (0)
#define PG8_LDB(dst, b, h) do { _Pragma("unroll") for (int n = 0; n < 2; ++n) _Pragma("unroll") for (int k = 0; k < 2; ++k) dst[n][k] = *(const LAS bf16x8*)(lds + PG8_SB(b, h) + boff + n * 2048 + k * 1024); } while (0)
#define PG8_MMA(ai, bj, At, Bt) do { __builtin_amdgcn_s_setprio(1); _Pragma("unroll") for (int m = 0; m < 4; ++m) _Pragma("unroll") for (int n = 0; n < 2; ++n) _Pragma("unroll") for (int k = 0; k < 2; ++k) \
        acc[ai][bj][m][n] = __builtin_amdgcn_mfma_f32_16x16x32_bf16(Bt[n][k], At[m][k], acc[ai][bj][m][n], 0, 0, 0); __builtin_amdgcn_s_setprio(0); } while (0)
#define PG8_WAIT_V(n) asm volatile("s_waitcnt vmcnt(" #n ")" ::: "memory")
#define PG8_WAIT_L(n) asm volatile("s_waitcnt lgkmcnt(" #n ")" ::: "memory")
#define PG8_BAR __builtin_amdgcn_s_barrier()
#define PG8_SCHED __builtin_amdgcn_sched_barrier(0)
#define PG8_GOFF(u, o00, o01, o10, o11) do { int _tz = g.tid; asm volatile("" : "+v"(_tz)); int _R0, _C0, _R1, _C1; stage_rc(_tz * 16, _R0, _C0); stage_rc(_tz * 16 + 8192, _R1, _C1); \
        o00 = (unsigned)(S.arow(u, _R0) * K + _C0) * 2u; o01 = (unsigned)(S.arow(u, _R1) * K + _C1) * 2u; \
        o10 = (unsigned)(S.arow(u, HALF + _R0) * K + _C0) * 2u; o11 = (unsigned)(S.arow(u, HALF + _R1) * K + _C1) * 2u; } while (0)
    Unit cur, nxt; int ui = 0;
    if (!S.next(0, cur)) return;
    f32x4 acc[2][2][4][2];
#pragma unroll
    for (int a = 0; a < 2; ++a)
#pragma unroll
        for (int b = 0; b < 2; ++b)
#pragma unroll
            for (int m = 0; m < 4; ++m)
#pragma unroll
                for (int n = 0; n < 2; ++n) acc[a][b][m][n] = (f32x4){0.f, 0.f, 0.f, 0.f};
    bf16x8 At[4][2], B0[2][2], B1[2][2];
    const char* const gA = (const char*)g.A;
    unsigned c00 = 0, c01 = 0, c10 = 0, c11 = 0, n00 = 0, n01 = 0, n10 = 0, n11 = 0;
    if constexpr (GA) PG8_GOFF(cur, c00, c01, c10, c11);
    const char* cA = gA + (GA ? (size_t)0 : (size_t)cur.pm * tstep); const char* cB = (const char*)g.Bt + (size_t)cur.pn * tstep;
    PG8_STAGE(PG8_SB(0, 0), cB, voffB); PG8_STAGE(PG8_SB(0, 1), cB + hstep, voffB); PG8_STA(PG8_SA(0, 0), cA, gA, c00, c01); PG8_STA(PG8_SA(0, 1), cA + hstep, gA, c10, c11);
    if (wr == 1) PG8_BAR;
    PG8_WAIT_V(2); PG8_BAR;
    PG8_STAGE(PG8_SB(1, 0), cB + kstep, voffB); PG8_STA(PG8_SA(1, 0), cA + kstep, gA + kstep, c00, c01); PG8_STAGE(PG8_SB(1, 1), cB + hstep + kstep, voffB);
    PG8_WAIT_V(6); PG8_BAR;
    for (;;) {
        const bool has_next = S.next(ui + 1, nxt);
        const char* nA = (has_next && !GA) ? gA + (size_t)nxt.pm * tstep : cA; const char* nB = has_next ? (const char*)g.Bt + (size_t)nxt.pn * tstep : cB;
        if constexpr (GA) { if (has_next) PG8_GOFF(nxt, n00, n01, n10, n11); else { n00 = c00; n01 = c01; n10 = c10; n11 = c11; } }
#pragma unroll 1
        for (int t = 0; t < nt; t += 2) {
            const bool last = (t == nt - 2);
            const char* a1 = cA + (size_t)(t + 1) * kstep;
            const char* a2 = last ? nA : cA + (size_t)(t + 2) * kstep; const char* b2 = last ? nB : cB + (size_t)(t + 2) * kstep;
            const char* a3 = a2 + kstep; const char* b3 = b2 + kstep;
            unsigned x00 = 0, x01 = 0, x10 = 0, x11 = 0;
            if constexpr (GA) { x00 = last ? n00 : c00; x01 = last ? n01 : c01; x10 = last ? n10 : c10; x11 = last ? n11 : c11; }
            PG8_LDB(B0, 0, 0); PG8_LDB(B1, 0, 1); PG8_SCHED; PG8_LDA(At, 0, 0); PG8_STA(PG8_SA(1, 1), a1 + hstep, a1, c10, c11);
            PG8_WAIT_V(8); PG8_WAIT_L(0); PG8_BAR; PG8_MMA(0, 0, At, B0); PG8_MMA(0, 1, At, B1); PG8_BAR; PG8_SCHED;
            PG8_LDA(At, 0, 1); PG8_STAGE(PG8_SB(0, 0), b2, voffB); PG8_STAGE(PG8_SB(0, 1), b2 + hstep, voffB); PG8_STA(PG8_SA(0, 0), a2, a2, x00, x01);
            PG8_WAIT_V(8); PG8_WAIT_L(0); PG8_BAR; PG8_MMA(1, 0, At, B0); PG8_MMA(1, 1, At, B1); PG8_BAR; PG8_SCHED;
            PG8_LDB(B0, 1, 0); PG8_LDB(B1, 1, 1); PG8_SCHED; PG8_LDA(At, 1, 0); PG8_STA(PG8_SA(0, 1), a2 + hstep, a2, x10, x11);
            PG8_WAIT_V(8); PG8_WAIT_L(0); PG8_BAR; PG8_MMA(0, 0, At, B0); PG8_MMA(0, 1, At, B1); PG8_BAR; PG8_SCHED;
            PG8_LDA(At, 1, 1); PG8_STAGE(PG8_SB(1, 0), b3, voffB); PG8_STAGE(PG8_SB(1, 1), b3 + hstep, voffB); PG8_STA(PG8_SA(1, 0), a3, a3, x00, x01);
            PG8_WAIT_V(8); PG8_WAIT_L(0); PG8_BAR; PG8_MMA(1, 0, At, B0); PG8_MMA(1, 1, At, B1); PG8_BAR; PG8_SCHED;
        }
#if PG8_ALIGN
        if (wr == 0) PG8_BAR;
#endif
        { int ln = (int)__builtin_amdgcn_mbcnt_hi(~0u, __builtin_amdgcn_mbcnt_lo(~0u, 0u)); asm volatile("" : "+v"(ln));
          E(acc, cur, wr, wc, ln & 15, ln >> 4); }
        if (!has_next) break;
#pragma unroll
        for (int a = 0; a < 2; ++a)
#pragma unroll
            for (int b = 0; b < 2; ++b)
#pragma unroll
                for (int m = 0; m < 4; ++m)
#pragma unroll
                    for (int n = 0; n < 2; ++n) acc[a][b][m][n] = (f32x4){0.f, 0.f, 0.f, 0.f};
        cur = nxt; cA = nA; cB = nB; ++ui;
        if constexpr (GA) { c00 = n00; c01 = n01; c10 = n10; c11 = n11; }
#if PG8_ALIGN
        if (wr == 1) PG8_BAR;
#endif
    }
    PG8_WAIT_V(0);
#if !PG8_ALIGN
    if (wr == 0) PG8_BAR;
#endif
    PG8_BAR;
#undef PG8_SA
#undef PG8_SB
#undef PG8_STAGE
#undef PG8_STAGEA
#undef PG8_STA
#undef PG8_GOFF
#undef PG8_LDA
#undef PG8_LDB
#undef PG8_MMA
#undef PG8_WAIT_V
#undef PG8_WAIT_L
#undef PG8_BAR
#undef PG8_SCHED
}
}

constexpr int NTHR = 512;
constexpr int LDS_SCRATCH = 139264;
constexpr int LDS_MISC = LDS_SCRATCH;
constexpr int LDS_TAB = LDS_MISC + 256;
constexpr int LDS_BYTES = LDS_TAB + 8192;

struct Params { const float* in[34]; float* out; unsigned char* ws; int ph_lo, ph_hi; };

struct Frame {
    const float* const* in; float* out; unsigned char* ws; LAS unsigned char* lds; unsigned* ctl;
    int tid, lane, wave, G, bid;
};

DI int row_b(int row) { return row < RLAT ? (row >> 12) : ((row - RLAT) >> 8); }
DI int row_pos(int row) { return row < RLAT ? (row & 4095) : (SEQ + ((row - RLAT) & 255)); }
DI int row_modsel(int row) { return row < RLAT ? (row >> 12) : 4; }

DI Frame relaunder(const Frame& F0) {
    Frame F = F0; int wv = F0.wave; asm volatile("" : "+s"(wv));
    int ln = (int)__builtin_amdgcn_mbcnt_hi(~0u, __builtin_amdgcn_mbcnt_lo(~0u, 0u)); asm volatile("" : "+v"(ln));
    F.wave = wv; F.lane = ln; F.tid = wv * 64 + ln;
    __attribute__((address_space(1))) unsigned char* w = (__attribute__((address_space(1))) unsigned char*)F0.ws; asm volatile("" : "+s"(w)); F.ws = (unsigned char*)w;
    F.ctl = (unsigned*)(F.ws + WS_CTL);
    int b = F0.bid, g = F0.G; asm volatile("" : "+s"(b), "+s"(g)); F.bid = b; F.G = g;
    return F;
}

DI void prep_fourier_job(const Frame& F, int ly, int g, int kt) {
    LAS float* FW = (LAS float*)F.lds;
    LAS float* CS = FW + 4096;
    LAS float* P = CS + 128;
    LAS float* W = P + 8192;
    const int t = F.tid;
    const float* fw = F.in[21] + ((size_t)ly * 4 + g) * 4096;
    for (int i = t; i < 4096; i += NTHR) FW[i] = fw[i];
    if (t < 64) { float s, c; sincospif((float)t / 32.0f, &s, &c); CS[t] = c; CS[64 + t] = s; }
    { const float* p = F.in[6] + (size_t)ly * DM * DIN + (size_t)(kt * 64 + (t >> 3)) * DIN + 2304 + g * 64 + (t & 7) * 8;
      const f32x4 a = *(const f32x4*)p, b = *(const f32x4*)(p + 4);
      LAS float* q = W + (t >> 3) * 65 + (t & 7) * 8;
      q[0] = a[0]; q[1] = a[1]; q[2] = a[2]; q[3] = a[3]; q[4] = b[0]; q[5] = b[1]; q[6] = b[2]; q[7] = b[3]; }
    __syncthreads();
    for (int i = t; i < 8192; i += NTHR) {
        const int c = i >> 7, n = i & 127, comp = n >> 6, d = n & 63;
        float s = 0.f;
        for (int j = 0; j < 64; ++j) { const int a = (j * c) & 63; const float tr = comp ? -CS[64 + a] : CS[a]; s += tr * FW[j * 64 + d]; }
        P[c * 128 + n] = s;
    }
    __syncthreads();
    bf16_t* dst = (bf16_t*)(F.ws + WS_WIN);
    { const int k = t >> 3, nb = (t & 7) * 16;
      float o[16];
#pragma unroll
      for (int j = 0; j < 16; ++j) o[j] = 0.f;
      for (int c = 0; c < 64; ++c) { const float w = W[k * 65 + c];
#pragma unroll
          for (int j = 0; j < 16; ++j) o[j] += w * P[c * 128 + nb + j]; }
#pragma unroll
      for (int j = 0; j < 16; ++j) { const int n = nb + j, comp = n >> 6, d = n & 63;
          dst[(size_t)(2304 + comp * 256 + g * 64 + d) * DM + kt * 64 + k] = f2bf(o[j]); } }
    __syncthreads();
}

struct PrepJob { const float* src; bf16_t* dst; int ldn, ldk, row0, hi_step; };
DI PrepJob prep_job(const Frame& F, int ly, int j) {
    constexpr int J1 = 144, J2 = J1 + 64, J3 = J2 + 1040, J4 = J3 + 1040;
    PrepJob r;
    if (j < J1) { const int kb = j / 9, nb = j % 9;
        r.src = F.in[6] + (size_t)ly * DM * DIN + (size_t)kb * 64 * DIN + nb * 256; r.ldn = DIN; r.dst = (bf16_t*)(F.ws + WS_WIN) + kb * 64; r.ldk = DM; r.row0 = nb * 256; r.hi_step = 128;
    } else if (j < J2) { const int q = j - J1, kb = q >> 2, nb = q & 3;
        r.src = F.in[7] + (size_t)ly * DM * DM + (size_t)kb * 64 * DM + nb * 256; r.ldn = DM; r.dst = (bf16_t*)(F.ws + WS_WOUT) + kb * 64; r.ldk = DM; r.row0 = nb * 256; r.hi_step = 128;
    } else if (j < J4) { const bool up = j >= J3; const int q = j - (up ? J3 : J2), e = q >> 4, kb = q & 15;
        const float* src = e < NEXP ? F.in[up ? 29 : 28] + ((size_t)ly * NEXP + e) * DM * DEXP : F.in[up ? 32 : 31] + (size_t)ly * DM * DEXP;
        r.src = src + (size_t)kb * 64 * DEXP; r.ldn = DEXP; r.dst = (bf16_t*)(F.ws + WS_WGU) + kb * 64; r.ldk = DM; r.row0 = e * 512 + (up ? 128 : 0); r.hi_step = 256;
    } else { const int q = j - J4, e = q >> 4, kb = (q >> 2) & 3, nb = q & 3;
        const float* src = e < NEXP ? F.in[30] + ((size_t)ly * NEXP + e) * DEXP * DM : F.in[33] + (size_t)ly * DEXP * DM;
        r.src = src + (size_t)kb * 64 * DM + nb * 256; r.ldn = DM; r.dst = (bf16_t*)(F.ws + WS_WD) + kb * 64; r.ldk = DEXP; r.row0 = e * DM + nb * 256; r.hi_step = 128; }
    return r;
}
DI void prep_load(const Frame& F, const PrepJob& jb, f32x4 (&v)[8]) {
    const float* p = jb.src + (size_t)(8 * (F.tid >> 6)) * jb.ldn + 4 * (F.tid & 63);
#pragma unroll
    for (int i = 0; i < 8; ++i) v[i] = __builtin_nontemporal_load((const f32x4*)(p + (size_t)i * jb.ldn));
}
DI void prep_store(const Frame& F, const PrepJob& jb, const f32x4 (&v)[8]) {
    LAS unsigned char* T = F.lds;
    const int t = F.tid, ln = t & 63, w = t >> 6;
#pragma unroll
    for (int pr = 0; pr < 4; ++pr)
#pragma unroll
        for (int e = 0; e < 4; ++e) *(LAS unsigned*)(T + (4 * ln + e) * 132 + (8 * w + 2 * pr) * 2) = cvt_pk_bf16(v[2 * pr][e], v[2 * pr + 1][e]);
    asm volatile("s_waitcnt lgkmcnt(0)" ::: "memory"); __builtin_amdgcn_s_barrier();
#pragma unroll
    for (int q = 0; q < 4; ++q) { const int n = q * 64 + (t >> 3), ch = t & 7;
        const LAS unsigned* r = (const LAS unsigned*)(T + n * 132 + ch * 16);
        u32x4 o; o.x = r[0]; o.y = r[1]; o.z = r[2]; o.w = r[3];
        *(u32x4*)(jb.dst + (size_t)(jb.row0 + (n >> 7) * jb.hi_step + (n & 127)) * jb.ldk + ch * 8) = o; }
    asm volatile("s_waitcnt lgkmcnt(0)" ::: "memory"); __builtin_amdgcn_s_barrier();
}
DI void prep_small(const Frame& F, int ly) {
    for (int j = F.bid; j < 208; j += F.G) { const PrepJob jb = prep_job(F, ly, j); f32x4 v[8]; prep_load(F, jb, v); prep_store(F, jb, v); }
    for (int q = F.G - 1 - F.bid; q < 64; q += F.G) prep_fourier_job(F, ly, q >> 4, q & 15);
}
DI void prep_small_dyn(const Frame& F0, int ly) {
    const Frame F = relaunder(F0);
    volatile LAS unsigned* MISC = (volatile LAS unsigned*)(F.lds + LDS_MISC);
    for (;;) {
        __syncthreads();
        if (F.tid == 0) MISC[18] = atomicAdd(F.ctl + CW_PREPQ3 + 64 * ly, 1u);
        __syncthreads();
        const int j = (int)MISC[18];
        if (j >= 272) break;
        if (j < 64) prep_fourier_job(F, ly, j >> 4, j & 15);
        else { const PrepJob jb = prep_job(F, ly, j - 64); f32x4 v[8]; prep_load(F, jb, v); prep_store(F, jb, v); }
    }
}
constexpr int PREP_CHUNK = 2, PREP_NJOBS = 3 * 1040;
DI void prep_experts(const Frame& F0, int ly, int cw, int j_lo, int j_hi) {
    const Frame F = relaunder(F0);
    volatile LAS unsigned* MISC = (volatile LAS unsigned*)(F.lds + LDS_MISC);
    for (;;) {
        __syncthreads();
        if (F.tid == 0) MISC[17] = atomicAdd(F.ctl + cw + 64 * ly, (unsigned)PREP_CHUNK);
        __syncthreads();
        const int base = j_lo + (int)MISC[17];
        if (base >= j_hi) break;
        const int end = base + PREP_CHUNK < j_hi ? base + PREP_CHUNK : j_hi;
        int j = base;
        PrepJob cur = prep_job(F, ly, 208 + j); f32x4 va[8]; prep_load(F, cur, va);
#pragma unroll 1
        for (;;) {
            const int jn = j + 1; const bool more = jn < end;
            PrepJob nxt = cur; f32x4 vb[8];
            if (more) { nxt = prep_job(F, ly, 208 + jn); prep_load(F, nxt, vb); }
            prep_store(F, cur, va);
            if (!more) break;
            cur = nxt; j = jn;
#pragma unroll
            for (int i = 0; i < 8; ++i) va[i] = vb[i];
        }
    }
}

DI void prep_mod(const Frame& F) {
    LAS float* S = (LAS float*)F.lds;
    LAS float* RED = S + 5 * 1024;
    const int t = F.tid;
    bool have_s = false;
    for (int u = F.bid; u < DEPTH * 96; u += F.G) {
        const int ly = u / 96, cg = u % 96;
        if (!have_s) {
            for (int i = t; i < 5 * 1024; i += NTHR) { const int r = i >> 10, k = i & 1023; const float x = r < 4 ? F.in[1][r * DM + k] : F.in[3][k]; S[i] = x / (1.f + expf(-x)); }
            __syncthreads(); have_s = true;
        }
        const int tq = t & 15, tk = t >> 4;
        const float* w = F.in[4] + (size_t)ly * DM * 6144 + cg * 64 + tq * 4;
        f32x4 acc[5];
#pragma unroll
        for (int r = 0; r < 5; ++r) acc[r] = (f32x4){0.f, 0.f, 0.f, 0.f};
#pragma unroll 1
        for (int k8 = 0; k8 < 32; k8 += 8) { f32x4 wv[8];
#pragma unroll
            for (int q = 0; q < 8; ++q) wv[q] = *(const f32x4*)(w + (size_t)(tk * 32 + k8 + q) * 6144);
#pragma unroll
            for (int q = 0; q < 8; ++q)
#pragma unroll
                for (int r = 0; r < 5; ++r) acc[r] += wv[q] * S[r * 1024 + tk * 32 + k8 + q]; }
#pragma unroll
        for (int r = 0; r < 5; ++r)
#pragma unroll
            for (int j = 0; j < 4; ++j) RED[(tk * 5 + r) * 64 + tq * 4 + j] = acc[r][j];
        __syncthreads();
        if (t < 320) { const int r = t >> 6, c = t & 63; float s = 0.f;
            for (int q = 0; q < 32; ++q) s += RED[(q * 5 + r) * 64 + c];
            const int col = cg * 64 + c;
            ((float*)(F.ws + WS_MOD))[((size_t)ly * 5 + r) * 6144 + col] = s + F.in[5][(size_t)ly * 6144 + col]; }
        __syncthreads();
    }
}

DI void prep_filters(const Frame& F) {
    LAS float* Z = (LAS float*)F.lds;
    LAS float* A1 = Z + 64 * 33;
    LAS float* A2 = A1 + 4096;
    for (int u = F.G - 1 - F.bid; u < DEPTH * 68; u += F.G) {
        int t = F.tid; asm volatile("" : "+v"(t));
        const int ly = u / 68, ch = u % 68; const bool lat = ch < 64; const int Lx = lat ? SEQ : CTXL, t0 = lat ? ch * 64 : (ch - 64) * 64;
        for (int i = t; i < 64 * 33; i += NTHR) { const int tt = i / 33, f = i % 33; const int ti = t0 + tt;
            float v;
            if (f == 0) v = (float)ti / (float)(Lx - 1);
            else { const int j = (f - 1) & 15; const float fb = 1e-4f + (float)j * ((15.0f - 1e-4f) / 15.0f); const float om = (6.283185307179586f / (float)Lx) * (float)ti;
                   v = f <= 16 ? cosf(fb * om) : -sinf(fb * om); }
            Z[i] = v; }
        __syncthreads();
        const float* w1 = F.in[9] + (size_t)ly * 33 * 64; const float* b1 = F.in[10] + ly * 64; const float* w2 = F.in[11] + (size_t)ly * 4096; const float* b2 = F.in[12] + ly * 64;
        const float* w3 = F.in[13] + (size_t)ly * 64 * 1024; const float* fq = F.in[14] + ly * 64;
        for (int i = t; i < 4096; i += NTHR) { const int tt = i >> 6, h = i & 63; float s = b1[h];
            for (int f = 0; f < 33; ++f) s += Z[tt * 33 + f] * w1[f * 64 + h];
            A1[i] = sinf(fq[h] * s); }
        __syncthreads();
        for (int i = t; i < 4096; i += NTHR) { const int tt = i >> 6, h = i & 63; float s = b2[h];
            for (int j = 0; j < 64; ++j) s += A1[tt * 64 + j] * w2[j * 64 + h];
            A2[i] = sinf(fq[h] * s); }
        __syncthreads();
        { float wr0[64], wr1[64];
#pragma unroll
          for (int j = 0; j < 64; ++j) { wr0[j] = w3[j * 1024 + t]; wr1[j] = w3[j * 1024 + 512 + t]; }
          const int c = t & 255, dir = t >> 8;
          const float delta = fabsf(-3.0701134573253946f + (float)c * ((-15.350567286626973f + 3.0701134573253946f) / 255.0f));
          float* d0 = lat ? (float*)(F.ws + WS_HCL) + ((((size_t)ly * 2 + 0) * 2 + dir) * 256 + c) * SEQ + t0 : (float*)(F.ws + WS_HCC) + ((((size_t)ly * 2 + 0) * 2 + dir) * 256 + c) * CTXL + t0;
          float* d1 = lat ? (float*)(F.ws + WS_HCL) + ((((size_t)ly * 2 + 1) * 2 + dir) * 256 + c) * SEQ + t0 : (float*)(F.ws + WS_HCC) + ((((size_t)ly * 2 + 1) * 2 + dir) * 256 + c) * CTXL + t0;
#pragma unroll 1
          for (int tt = 0; tt < 64; ++tt) { float s0 = 0.f, s1 = 0.f;
#pragma unroll
            for (int j = 0; j < 64; j += 4) { const f32x4 a = *(const LAS f32x4*)(A2 + tt * 64 + j);
                s0 += a[0] * wr0[j] + a[1] * wr0[j + 1] + a[2] * wr0[j + 2] + a[3] * wr0[j + 3]; s1 += a[0] * wr1[j] + a[1] * wr1[j + 1] + a[2] * wr1[j + 2] + a[3] * wr1[j + 3];
                if ((j & 12) == 12) asm volatile("" ::: "memory"); }
            const float dec = expf(-((float)(t0 + tt) / (float)(Lx - 1)) * delta);
            d0[tt] = s0 * dec; d1[tt] = s1 * dec; } }
        __syncthreads();
    }
}

DI void prep_tables(const Frame& F) {
    LAS float* CT = (LAS float*)F.lds;
    const int t = F.tid;
    for (int i = t; i < 4096; i += NTHR) CT[i] = cospif((float)i / 2048.0f);
    __syncthreads();
    bf16_t* DC = (bf16_t*)(F.ws + WS_DFTC);
    for (int i = F.bid * NTHR + t; i < CTXL * 512; i += F.G * NTHR) { const int k = i >> 9, cl = i & 511, comp = cl >> 8, l = cl & 255;
        const int idx = ((k * l) & 255) * 16; DC[i] = f2bf((comp ? CT[(idx - 1024) & 4095] : CT[idx]) * (1.0f / 128.0f)); }
    if (F.bid == (F.G > 1 ? 1 : 0) && t < DEPTH) { const int ly = t; const float lam_init = 0.8f - 0.6f * expf(-0.3f * (float)ly); float s1 = 0.f, s2 = 0.f;
        for (int i = 0; i < 32; ++i) { s1 += F.in[16][ly * 32 + i] * F.in[17][ly * 32 + i]; s2 += F.in[18][ly * 32 + i] * F.in[19][ly * 32 + i]; }
        ((float*)(F.ws + WS_LAM))[2 * ly] = expf(s1) - expf(s2) + lam_init; ((float*)(F.ws + WS_LAM))[2 * ly + 1] = lam_init; }
    if (F.bid == 0) { float* RT = (float*)(F.ws + WS_ROPE);
        for (int i = t; i < 512; i += NTHR) { const int p = i >> 3, n = i & 7; const float inv = powf(10000.0f, -(float)n / 8.0f); float s, c; sincosf((float)p * inv, &s, &c); RT[i * 2] = c; RT[i * 2 + 1] = s; } }
    __syncthreads();
}

DI void prep_invl1(const Frame& F) {
    const int gw = F.bid * 8 + F.wave, nw = F.G * 8;
    for (int j = gw; j < DEPTH * 2 * 2 * 256; j += nw) {
        const int ly = j >> 10, lt = (j >> 9) & 1, n = (j >> 8) & 1, c = j & 255;
        const int Lx = lt ? CTXL : SEQ;
        const float* base = lt ? (const float*)(F.ws + WS_HCC) : (const float*)(F.ws + WS_HCL);
        const f32x4* f0 = (const f32x4*)(base + ((((size_t)ly * 2 + n) * 2 + 0) * 256 + c) * Lx);
        const f32x4* f1 = (const f32x4*)(base + ((((size_t)ly * 2 + n) * 2 + 1) * 256 + c) * Lx);
        float s = 0.f;
        if (lt) { const f32x4 a = f0[F.lane], b = f1[F.lane];
            s = fabsf(a[0]) + fabsf(a[1]) + fabsf(a[2]) + fabsf(a[3]) + (F.lane == 0 ? 0.f : fabsf(b[0])) + fabsf(b[1]) + fabsf(b[2]) + fabsf(b[3]);
        } else { f32x4 a[16], b[16];
#pragma unroll
            for (int q = 0; q < 16; ++q) { a[q] = f0[F.lane + 64 * q]; b[q] = f1[F.lane + 64 * q]; }
#pragma unroll
            for (int q = 0; q < 16; ++q) s += fabsf(a[q][0]) + fabsf(a[q][1]) + fabsf(a[q][2]) + fabsf(a[q][3]) + ((q == 0 && F.lane == 0) ? 0.f : fabsf(b[q][0])) + fabsf(b[q][1]) + fabsf(b[q][2]) + fabsf(b[q][3]); }
        s = wave_sum(s);
        if (F.lane == 0) ((float*)(F.ws + WS_INVL1))[j] = 1.0f / s;
    }
}

DI void ln_stats(const f32x4 (&v)[4], float& mu, float& rstd) {
    float s = 0.f;
#pragma unroll
    for (int j = 0; j < 4; ++j) s += (v[j][0] + v[j][1]) + (v[j][2] + v[j][3]);
    mu = wave_sum(s) * (1.0f / DM);
    float q = 0.f;
#pragma unroll
    for (int j = 0; j < 4; ++j)
#pragma unroll
        for (int e = 0; e < 4; ++e) { const float d = v[j][e] - mu; q += d * d; }
    rstd = rsqrtf(wave_sum(q) * (1.0f / DM) + LN_EPS);
}
DI void ln_mod_store(const f32x4 (&v)[4], const float* sh, const float* sc, bf16_t* hrow, int lane) {
    float mu, rstd; ln_stats(v, mu, rstd);
#pragma unroll
    for (int j = 0; j < 4; ++j) { const int c = 4 * lane + 256 * j; const f32x4 a = *(const f32x4*)(sh + c), b = *(const f32x4*)(sc + c);
        float o[4];
#pragma unroll
        for (int e = 0; e < 4; ++e) o[e] = (v[j][e] - mu) * rstd * (1.f + b[e]) + a[e];
        u32x2 w; w.x = cvt_pk_bf16(o[0], o[1]); w.y = cvt_pk_bf16(o[2], o[3]); *(u32x2*)(hrow + c) = w; }
}

DI void phase_init_h(const Frame& F) {
    const int gw = F.bid * 8 + F.wave, nw = F.G * 8;
    const float* MOD = (const float*)(F.ws + WS_MOD);
    for (int row = gw; row < RTOT; row += nw) {
        const float* xr = row < RLAT ? F.in[0] + (size_t)row * DM : F.in[2] + (size_t)(row - RLAT) * DM;
        f32x4 v[4];
#pragma unroll
        for (int j = 0; j < 4; ++j) v[j] = *(const f32x4*)(xr + 4 * F.lane + 256 * j);
        const float* m = MOD + (size_t)(0 * 5 + row_modsel(row)) * 6144;
        ln_mod_store(v, m, m + 1024, (bf16_t*)(F.ws + WS_H) + (size_t)row * DM, F.lane);
    }
}

struct EpiWin {
    static constexpr bool PERM = true;
    unsigned char* ws; int ly;
    DI void operator()(const f32x4 (&acc)[2][2][4][2], const pg8::Unit& u, int wr, int wc, int fr, int fq) const {
        const bool lat = u.pm < 64; const int b = lat ? (u.pm >> 4) : (u.pm - 64); const int pos0 = lat ? ((u.pm & 15) << 8) : SEQ;
        const int pn = u.pn;
        const float* RT = (const float*)(ws + WS_ROPE);
        float kn[2] = {0.f, 0.f};
#pragma unroll
        for (int ai = 0; ai < 2; ++ai)
#pragma unroll
            for (int m = 0; m < 4; ++m) {
                const int pos = pos0 + ai * 128 + wr * 64 + m * 16 + fr;
#pragma unroll
                for (int bj = 0; bj < 2; ++bj) {
                    const int col = pn * 256 + bj * 128 + wc * 32 + fq * 8;
                    float v[8];
#pragma unroll
                    for (int e = 0; e < 4; ++e) { v[e] = acc[ai][bj][m][0][e]; v[4 + e] = acc[ai][bj][m][1][e]; }
                    if (pn < 3) {
                        float* d = (float*)(ws + WS_HYT) + ((size_t)b * 768 + col) * POS + pos;
#pragma unroll
                        for (int e = 0; e < 8; ++e) d[(size_t)e * POS] = v[e];
                    } else if (pn < 7) {
                        const bool isq = pn < 5; const int cq = col - (isq ? 768 : 1280); const int head = cq >> 6, cc = cq & 63;
                        if (lat) { const int axis = (cc >> 4) & 1, n0 = (cc & 15) >> 1; const int pa = axis ? (pos & 63) : (pos >> 6);
                            const float* rt = RT + (pa * 8 + n0) * 2;
#pragma unroll
                            for (int p = 0; p < 4; ++p) { const float cs = rt[2 * p], sn = rt[2 * p + 1]; const float a = v[2 * p], bb = v[2 * p + 1];
                                v[2 * p] = a * cs - bb * sn; v[2 * p + 1] = a * sn + bb * cs; } }
                        if (isq) {
#pragma unroll
                            for (int e = 0; e < 8; ++e) v[e] *= QSCALE; }
                        u32x4 w; w.x = cvt_pk_bf16(v[0], v[1]); w.y = cvt_pk_bf16(v[2], v[3]); w.z = cvt_pk_bf16(v[4], v[5]); w.w = cvt_pk_bf16(v[6], v[7]);
                        bf16_t* d = (bf16_t*)(ws + (isq ? WS_Q : WS_K)) + (((size_t)b * 8 + head) * POS + pos) * 64 + cc;
                        *(u32x4*)d = w;
                        if (!isq) {
                            float s2 = bflo(w.x) * bflo(w.x) + bfhi(w.x) * bfhi(w.x) + bflo(w.y) * bflo(w.y) + bfhi(w.y) * bfhi(w.y) + bflo(w.z) * bflo(w.z) + bfhi(w.z) * bfhi(w.z) + bflo(w.w) * bflo(w.w) + bfhi(w.w) * bfhi(w.w);
                            s2 += __shfl_xor(s2, 16); s2 += __shfl_xor(s2, 32);
                            kn[bj] = fmaxf(kn[bj], s2); }
                    } else if (pn < 9) {
                        const int cv = col - 1792; const int head = cv >> 6, cc = cv & 63;
                        u32x4 w; w.x = cvt_pk_bf16(v[0], v[1]); w.y = cvt_pk_bf16(v[2], v[3]); w.z = cvt_pk_bf16(v[4], v[5]); w.w = cvt_pk_bf16(v[6], v[7]);
                        *(u32x4*)((bf16_t*)(ws + WS_V) + (((size_t)b * 8 + head) * POS + pos) * 64 + cc) = w;
                    } else {
                        const int cy = col - 2304; const int comp = cy >> 8, gd = cy & 255;
                        if (lat) { bf16_t* d = (bf16_t*)(ws + WS_YTL) + ((size_t)b * 256 + gd) * 8192 + comp * 4096 + pos;
#pragma unroll
                            for (int e = 0; e < 8; ++e) d[(size_t)e * 8192] = f2bf(v[e]);
                        } else { bf16_t* d = (bf16_t*)(ws + WS_YTC) + ((size_t)b * 256 + gd) * 512 + comp * 256 + (pos - SEQ);
#pragma unroll
                            for (int e = 0; e < 8; ++e) d[(size_t)e * 512] = f2bf(v[e]); }
                    }
                }
            }
        if (pn == 5 || pn == 6) {
#pragma unroll
            for (int bj = 0; bj < 2; ++bj) { float m = kn[bj];
                m = fmaxf(m, __shfl_xor(m, 1)); m = fmaxf(m, __shfl_xor(m, 2)); m = fmaxf(m, __shfl_xor(m, 4)); m = fmaxf(m, __shfl_xor(m, 8));
                const int cq = pn * 256 + bj * 128 + wc * 32 - 1280; const int head = cq >> 6, comp = (cq >> 5) & 1;
                if (fr == 0 && fq == 0) atomicMax((unsigned*)(ws + WS_CTL) + CW_KMAX + 64 * ly + (b * 8 + head) * 2 + comp, __float_as_uint(m)); }
        }
    }
};

struct EpiFnet {
    static constexpr bool PERM = true;
    unsigned char* ws; int ctx;
    DI void operator()(const f32x4 (&acc)[2][2][4][2], const pg8::Unit& u, int wr, int wc, int fr, int fq) const {
        const int b = u.pn;
#pragma unroll
        for (int ai = 0; ai < 2; ++ai)
#pragma unroll
            for (int m = 0; m < 4; ++m) {
                const int k = u.pm * 256 + ai * 128 + wr * 64 + m * 16 + fr;
                const size_t row = ctx ? (size_t)(RLAT + b * CTXL + k) : (size_t)(b * SEQ + k);
#pragma unroll
                for (int bj = 0; bj < 2; ++bj) { const int gd = bj * 128 + wc * 32 + fq * 8;
                    const f32x4 v0 = acc[ai][bj][m][0], v1 = acc[ai][bj][m][1];
                    u32x4 w; w.x = cvt_pk_bf16(v0[0], v0[1]); w.y = cvt_pk_bf16(v0[2], v0[3]); w.z = cvt_pk_bf16(v1[0], v1[1]); w.w = cvt_pk_bf16(v1[2], v1[3]);
                    *(u32x4*)((bf16_t*)(ws + WS_MIX) + row * DM + 768 + gd) = w; }
            }
    }
};

struct EpiWout {
    static constexpr bool PERM = false;
    unsigned char* ws; int ly; const float* xlat; const float* xctx;
    DI void operator()(const f32x4 (&acc)[2][2][4][2], const pg8::Unit& u, int wr, int wc, int fr, int fq) const {
        const int msel = u.pm < 64 ? (u.pm >> 4) : 4;
        const float* g1 = (const float*)(ws + WS_MOD) + ((size_t)ly * 5 + msel) * 6144 + 2048;
        const int col0 = u.pn * 256 + wc * 32 + 4 * fq;
        const float* src = ly == 0 ? (u.pm < 64 ? xlat + (size_t)u.pm * 256 * DM : xctx + (size_t)(u.pm - 64) * 256 * DM) : (const float*)(ws + WS_X) + (size_t)u.pm * 256 * DM;
        f32x4 gv[2][2];
#pragma unroll
        for (int bj = 0; bj < 2; ++bj)
#pragma unroll
            for (int n = 0; n < 2; ++n) gv[bj][n] = *(const f32x4*)(g1 + col0 + bj * 128 + n * 16);
#pragma unroll
        for (int ai = 0; ai < 2; ++ai)
#pragma unroll
            for (int m = 0; m < 4; ++m) { const size_t ro = (size_t)(ai * 128 + wr * 64 + m * 16 + fr) * DM + col0;
                float* rowp = (float*)(ws + WS_X) + (size_t)u.pm * 256 * DM + ro;
#pragma unroll
                for (int bj = 0; bj < 2; ++bj)
#pragma unroll
                    for (int n = 0; n < 2; ++n) { const f32x4 xin = *(const f32x4*)(src + ro + bj * 128 + n * 16); *(f32x4*)(rowp + bj * 128 + n * 16) = xin * ALPHA + gv[bj][n] * acc[ai][bj][m][n]; } }
    }
};

struct MoeTab { LAS int* cnt; LAS int* tstart; LAS int* tile_e; int ntiles; };
DI MoeTab moe_tables(const Frame& F, int ly) {
    MoeTab T; T.cnt = (LAS int*)(F.lds + LDS_TAB); T.tstart = T.cnt + 72; T.tile_e = T.tstart + 72;
    __syncthreads();
    if (F.tid < 65) T.cnt[F.tid] = F.tid < NEXP ? (int)__hip_atomic_load(F.ctl + CW_CNT + (ly * 64 + F.tid) * CNT_STRIDE, __ATOMIC_RELAXED, __HIP_MEMORY_SCOPE_AGENT) : (ly == DEPTH - 1 ? RLAT : RTOT);
    __syncthreads();
    if (F.tid == 0) { int s = 0; for (int e = 0; e < 65; ++e) { T.tstart[e] = s; s += (T.cnt[e] + 255) >> 8; } T.tstart[65] = s; }
    __syncthreads();
    const int nt = T.tstart[65];
    for (int e = F.tid; e < 65; e += NTHR) for (int q = T.tstart[e]; q < T.tstart[e + 1]; ++q) if (q < MAXTILES) T.tile_e[q] = e;
    __syncthreads();
    T.ntiles = __builtin_amdgcn_readfirstlane(nt < MAXTILES ? nt : MAXTILES);
    return T;
}
template <bool GATHER_> struct MoeSched {
    static constexpr bool GATHER = GATHER_;
    MoeTab T; const int* list; int G, c, nsub, shift;
    DI bool next(int i, pg8::Unit& u) const {
        const int L = i * G + c; if (L >= T.ntiles * nsub) return false;
        const int tile = L >> shift, j = L & (nsub - 1); const int e = __builtin_amdgcn_readfirstlane(T.tile_e[tile]);
        u.pm = tile; u.pn = e * nsub + j; u.e = e; u.lt = tile - __builtin_amdgcn_readfirstlane(T.tstart[e]); return true;
    }
    DI int arow(const pg8::Unit& u, int r) const {
        if (!GATHER_) return u.pm * 256 + r;
        const int idx = u.lt * 256 + r;
        if (u.e == NEXP) return idx;
        return idx < T.cnt[u.e] ? (list[(size_t)u.e * RTOT + idx] >> 3) : 0;
    }
};
DI float silu_f(float x) { return x / (1.f + __expf(-x)); }
struct EpiMoe1 {
    static constexpr bool PERM = true;
    unsigned char* ws;
    DI void operator()(const f32x4 (&acc)[2][2][4][2], const pg8::Unit& u, int wr, int wc, int fr, int fq) const {
        const int hid = (u.pn & 1) * 128 + wc * 32 + fq * 8;
#pragma unroll
        for (int ai = 0; ai < 2; ++ai)
#pragma unroll
            for (int m = 0; m < 4; ++m) { const size_t row = (size_t)u.pm * 256 + ai * 128 + wr * 64 + m * 16 + fr;
                float o[8];
#pragma unroll
                for (int n = 0; n < 2; ++n)
#pragma unroll
                    for (int e = 0; e < 4; ++e) o[n * 4 + e] = silu_f(acc[ai][0][m][n][e]) * acc[ai][1][m][n][e];
                u32x4 w; w.x = cvt_pk_bf16(o[0], o[1]); w.y = cvt_pk_bf16(o[2], o[3]); w.z = cvt_pk_bf16(o[4], o[5]); w.w = cvt_pk_bf16(o[6], o[7]);
                *(u32x4*)((bf16_t*)(ws + WS_ACT) + row * DEXP + hid) = w; }
    }
};
struct EpiMoe2 {
    static constexpr bool PERM = true;
    unsigned char* ws;
    DI void operator()(const f32x4 (&acc)[2][2][4][2], const pg8::Unit& u, int wr, int wc, int fr, int fq) const {
        const int colb = (u.pn & 3) * 256 + wc * 32 + fq * 8;
#pragma unroll
        for (int ai = 0; ai < 2; ++ai)
#pragma unroll
            for (int m = 0; m < 4; ++m) { const size_t row = (size_t)u.pm * 256 + ai * 128 + wr * 64 + m * 16 + fr;
#pragma unroll
                for (int bj = 0; bj < 2; ++bj) { const f32x4 v0 = acc[ai][bj][m][0], v1 = acc[ai][bj][m][1];
                    u32x4 w; w.x = cvt_pk_bf16(v0[0], v0[1]); w.y = cvt_pk_bf16(v0[2], v0[3]); w.z = cvt_pk_bf16(v1[0], v1[1]); w.w = cvt_pk_bf16(v1[2], v1[3]);
                    __builtin_nontemporal_store(w, (u32x4*)((bf16_t*)(ws + WS_YB) + row * DM + colb + bj * 128)); } }
    }
};

DI float hy_short(const float* hy, int l, int Lx, float w0, float w1, float w2) {
    const float a = l > 0 ? hy[l - 1] : 0.f, b = hy[l], c = l + 1 < Lx ? hy[l + 1] : 0.f;
    return w0 * a + w1 * b + w2 * c;
}
DI void hyena_ctx_unit(const Frame& F, int ly, int c) {
    LAS float* KC = (LAS float*)F.lds;
    LAS float* UC = KC + 1024;
    LAS float* PS = UC + 1024;
    const int t = F.tid;
    const float* HYT = (const float*)(F.ws + WS_HYT);
    const float* scw = F.in[8] + (size_t)ly * 3 * 768;
    const float* invl = (const float*)(F.ws + WS_INVL1) + (size_t)ly * 1024;
    const float bias0 = F.in[15][(size_t)ly * 512 + c], bias1 = F.in[15][(size_t)ly * 512 + 256 + c];
    float wx1[3], wx2[3], wv[3];
#pragma unroll
    for (int j = 0; j < 3; ++j) { wx1[j] = scw[j * 768 + c]; wx2[j] = scw[j * 768 + 256 + c]; wv[j] = scw[j * 768 + 512 + c]; }
    bf16_t* MIX = (bf16_t*)(F.ws + WS_MIX);
    for (int n = 0; n < 2; ++n) { const float inv = invl[(1 * 2 + n) * 256 + c];
        const float* hf = (const float*)(F.ws + WS_HCC) + ((((size_t)ly * 2 + n) * 2 + 0) * 256 + c) * CTXL;
        const float* hb = (const float*)(F.ws + WS_HCC) + ((((size_t)ly * 2 + n) * 2 + 1) * 256 + c) * CTXL;
        for (int i = t; i < 512; i += NTHR) { const int d = i - 256; KC[n * 512 + i] = d >= 0 ? hf[d] * inv : (d > -256 ? hb[-d] * inv : 0.f); } }
    for (int i = t; i < 4 * CTXL; i += NTHR) { const int b = i >> 8, l = i & 255;
        UC[l * 4 + b] = hy_short(HYT + ((size_t)b * 768 + 512 + c) * POS + SEQ, l, CTXL, wv[0], wv[1], wv[2]); }
    __syncthreads();
    const int t0 = (t & 63) * 4, bp = (t >> 6) & 1, sq = t >> 7;
    const int tt = t & 255, bq = t >> 8;
    for (int n = 0; n < 2; ++n) {
        float a[4][2];
#pragma unroll
        for (int j = 0; j < 4; ++j) { a[j][0] = 0.f; a[j][1] = 0.f; }
        const LAS float* kf = KC + n * 512 + 256 + t0;
#pragma unroll 4
        for (int s = sq * 64; s < sq * 64 + 64; ++s) { const float u0 = UC[s * 4 + 2 * bp], u1 = UC[s * 4 + 2 * bp + 1];
#pragma unroll
            for (int j = 0; j < 4; ++j) { const float k = kf[j - s]; a[j][0] += k * u0; a[j][1] += k * u1; } }
#pragma unroll
        for (int j = 0; j < 4; ++j) { PS[(sq * 256 + t0 + j) * 4 + 2 * bp] = a[j][0]; PS[(sq * 256 + t0 + j) * 4 + 2 * bp + 1] = a[j][1]; }
        __syncthreads();
        float y0 = 0.f, y1 = 0.f;
#pragma unroll
        for (int q = 0; q < 4; ++q) { y0 += PS[(q * 256 + tt) * 4 + 2 * bq]; y1 += PS[(q * 256 + tt) * 4 + 2 * bq + 1]; }
        const int xch = n == 0 ? c : 256 + c; const float* wg = n == 0 ? wx1 : wx2; const float bias = n == 0 ? bias0 : bias1;
        const float g0 = hy_short(HYT + ((size_t)(2 * bq) * 768 + xch) * POS + SEQ, tt, CTXL, wg[0], wg[1], wg[2]);
        const float g1 = hy_short(HYT + ((size_t)(2 * bq + 1) * 768 + xch) * POS + SEQ, tt, CTXL, wg[0], wg[1], wg[2]);
        const float z0 = g0 * (y0 + bias * UC[tt * 4 + 2 * bq]), z1 = g1 * (y1 + bias * UC[tt * 4 + 2 * bq + 1]);
        __syncthreads();
        if (n == 0) { UC[tt * 4 + 2 * bq] = z0; UC[tt * 4 + 2 * bq + 1] = z1; __syncthreads(); }
        else { MIX[((size_t)RLAT + (2 * bq) * CTXL + tt) * DM + c] = f2bf(z0); MIX[((size_t)RLAT + (2 * bq + 1) * CTXL + tt) * DM + c] = f2bf(z1); }
    }
    __syncthreads();
}

DI unsigned cx_addr(unsigned e) { return e * 8u + (e >> 5) * 16u; }
constexpr int cx_bytes(int n) { return n * 8 + (n / 32) * 16; }
typedef float f32x2 __attribute__((ext_vector_type(2)));
template <int R> DI constexpr int brev(int q) { int r = 0; for (int i = 1, j = R >> 1; i < R; i <<= 1, j >>= 1) if (q & i) r |= j; return r; }
template <int R, bool INV> DI void dft_inreg(float (&re)[R], float (&im)[R]) {
#pragma unroll
    for (int len = R; len >= 2; len >>= 1) { const int half = len >> 1;
#pragma unroll
        for (int base = 0; base < R; base += len)
#pragma unroll
            for (int j = 0; j < half; ++j) {
                const float ar = re[base + j], ai = im[base + j], br = re[base + j + half], bi = im[base + j + half];
                re[base + j] = ar + br; im[base + j] = ai + bi;
                const float dr = ar - br, di = ai - bi;
                if (j == 0) { re[base + j + half] = dr; im[base + j + half] = di; }
                else if (4 * j == len) { if (INV) { re[base + j + half] = -di; im[base + j + half] = dr; } else { re[base + j + half] = di; im[base + j + half] = -dr; } }
                else { const float c = __builtin_cosf(6.283185307179586f * (float)j / (float)len), sn = (INV ? 1.f : -1.f) * __builtin_sinf(6.283185307179586f * (float)j / (float)len);
                    re[base + j + half] = dr * c - di * sn; im[base + j + half] = dr * sn + di * c; }
            }
    }
}
template <int R, bool INV, int S> DI void fft_bfly(LAS unsigned char* seq, int j) {
    constexpr int Lcur = R * S;
    int jj = j; asm volatile("" : "+v"(jj));
    const int blk = jj / S, o = jj % S;
    LAS unsigned char* p = seq + cx_addr((unsigned)(blk * Lcur + o));
#define FFT_OFF(r) ((r) * S * 8 + ((((r) * S) >> 5) * 16))
    float re[R], im[R];
    if (S == 1) {
#pragma unroll
        for (int r = 0; r < R; r += 2) { const f32x4 v = *(const LAS f32x4*)(p + FFT_OFF(r)); re[r] = v[0]; im[r] = v[1]; re[r + 1] = v[2]; im[r + 1] = v[3]; }
    } else {
#pragma unroll
        for (int r = 0; r < R; ++r) { const f32x2 v = *(const LAS f32x2*)(p + FFT_OFF(r)); re[r] = v[0]; im[r] = v[1]; }
    }
    if (S == 1) {
        dft_inreg<R, INV>(re, im);
    } else {
        const float fr = (float)o * (1.0f / (float)Lcur);
        float wr[R], wi[R];
        wr[1] = __builtin_amdgcn_cosf(fr); wi[1] = INV ? __builtin_amdgcn_sinf(fr) : -__builtin_amdgcn_sinf(fr);
#pragma unroll
        for (int q = 2; q < R; ++q) { const int a = (q & (q - 1)) ? (q & -q) : (q >> 1), bq = q - a;
            wr[q] = wr[a] * wr[bq] - wi[a] * wi[bq]; wi[q] = wr[a] * wi[bq] + wi[a] * wr[bq]; }
        if (!INV) {
            dft_inreg<R, false>(re, im);
#pragma unroll
            for (int q = 1; q < R; ++q) { const int k = brev<R>(q); const float xr = re[k], xi = im[k]; re[k] = xr * wr[q] - xi * wi[q]; im[k] = xr * wi[q] + xi * wr[q]; }
        } else {
#pragma unroll
            for (int q = 1; q < R; ++q) { const float xr = re[q], xi = im[q]; re[q] = xr * wr[q] - xi * wi[q]; im[q] = xr * wi[q] + xi * wr[q]; }
            dft_inreg<R, true>(re, im);
        }
    }
    if (S == 1) {
#pragma unroll
        for (int r = 0; r < R; r += 2) { const int k0 = brev<R>(r), k1 = brev<R>(r + 1); *(LAS f32x4*)(p + FFT_OFF(r)) = (f32x4){re[k0], im[k0], re[k1], im[k1]}; }
    } else {
#pragma unroll
        for (int r = 0; r < R; ++r) { const int k = brev<R>(r); *(LAS f32x2*)(p + FFT_OFF(r)) = (f32x2){re[k], im[k]}; }
    }
#undef FFT_OFF
}
template <bool INV> DI void fft8192x2(LAS unsigned char* lds, int tid) {
    constexpr int SB = cx_bytes(8192);
    if (!INV) {
        fft_bfly<16, false, 512>(lds, tid); __builtin_amdgcn_sched_barrier(0); fft_bfly<16, false, 512>(lds + SB, tid); __syncthreads();
        fft_bfly<16, false, 32>(lds, tid); __builtin_amdgcn_sched_barrier(0); fft_bfly<16, false, 32>(lds + SB, tid); __syncthreads();
        fft_bfly<32, false, 1>(lds + (tid >> 8) * SB, tid & 255); __syncthreads();
    } else {
        fft_bfly<32, true, 1>(lds + (tid >> 8) * SB, tid & 255); __syncthreads();
        fft_bfly<16, true, 32>(lds, tid); __builtin_amdgcn_sched_barrier(0); fft_bfly<16, true, 32>(lds + SB, tid); __syncthreads();
        fft_bfly<16, true, 512>(lds, tid); __builtin_amdgcn_sched_barrier(0); fft_bfly<16, true, 512>(lds + SB, tid); __syncthreads();
    }
}
DI void fft4096x4(LAS unsigned char* lds, int tid) {
    constexpr int SB = cx_bytes(4096);
    const int sq = tid >> 8, j = tid & 255;
    fft_bfly<16, false, 256>(lds + sq * SB, j); __builtin_amdgcn_sched_barrier(0); fft_bfly<16, false, 256>(lds + (sq + 2) * SB, j); __syncthreads();
    fft_bfly<16, false, 16>(lds + sq * SB, j); __builtin_amdgcn_sched_barrier(0); fft_bfly<16, false, 16>(lds + (sq + 2) * SB, j); __syncthreads();
    fft_bfly<16, false, 1>(lds + sq * SB, j); __builtin_amdgcn_sched_barrier(0); fft_bfly<16, false, 1>(lds + (sq + 2) * SB, j); __syncthreads();
}

DI void hy_short8(const float* hp, int l0, float w0, float w1, float w2, float (&out)[8]) {
    const f32x4 h0 = *(const f32x4*)(hp + l0), h1 = *(const f32x4*)(hp + l0 + 4);
    const float hm = l0 > 0 ? hp[l0 - 1] : 0.f, hn = l0 + 8 < SEQ ? hp[l0 + 8] : 0.f;
    const float hv[10] = {hm, h0[0], h0[1], h0[2], h0[3], h1[0], h1[1], h1[2], h1[3], hn};
#pragma unroll
    for (int j = 0; j < 8; ++j) out[j] = w0 * hv[j] + w1 * hv[j + 1] + w2 * hv[j + 2];
}
DI void hyena_fft_unit(const Frame& F, int ly, int c) {
    LAS unsigned char* L = F.lds; constexpr int SB = cx_bytes(8192);
    const int t = F.tid;
    const unsigned pt = cx_addr((unsigned)t), pl = cx_addr((unsigned)t * 8u);
    const float* HYT = (const float*)(F.ws + WS_HYT);
    const float* scw = F.in[8] + (size_t)ly * 3 * 768;
    const float* invl = (const float*)(F.ws + WS_INVL1) + (size_t)ly * 1024;
    const float bias0 = F.in[15][(size_t)ly * 512 + c], bias1 = F.in[15][(size_t)ly * 512 + 256 + c];
    float wx1[3], wx2[3], wv[3];
#pragma unroll
    for (int j = 0; j < 3; ++j) { wx1[j] = scw[j * 768 + c]; wx2[j] = scw[j * 768 + 256 + c]; wv[j] = scw[j * 768 + 512 + c]; }
    f32x2* SPEC = (f32x2*)(F.ws + WS_SPEC) + (size_t)c * 2 * 8192;
#pragma unroll
    for (int n = 0; n < 2; ++n) { const float inv = invl[(0 * 2 + n) * 256 + c] * (1.0f / 8192.0f);
        const float* hf = (const float*)(F.ws + WS_HCL) + ((((size_t)ly * 2 + n) * 2 + 0) * 256 + c) * SEQ;
        const float* hb = (const float*)(F.ws + WS_HCL) + ((((size_t)ly * 2 + n) * 2 + 1) * 256 + c) * SEQ;
        float fv[16];
#pragma unroll
        for (int k = 0; k < 8; ++k) { fv[k] = hf[t + 512 * k]; const int i = SEQ + t + 512 * k; fv[8 + k] = i > SEQ ? hb[8192 - i] : 0.f; }
#pragma unroll
        for (int k = 0; k < 16; ++k) *(LAS f32x2*)(L + n * SB + (pt + 4352u * (unsigned)(k))) = (f32x2){fv[k] * inv, 0.f}; }
    __syncthreads();
    fft8192x2<false>(L, t);
#pragma unroll
    for (int n = 0; n < 2; ++n)
#pragma unroll
        for (int k = 0; k < 16; ++k) SPEC[n * 8192 + t + 512 * k] = *(const LAS f32x2*)(L + n * SB + (pt + 4352u * (unsigned)(k)));
    __syncthreads();
    const int l0 = t * 8;
#pragma unroll 1
    for (int sp = 0; sp < 2; ++sp) {
        float za[8], zb[8];
        hy_short8(HYT + ((size_t)(2 * sp) * 768 + 512 + c) * POS, l0, wv[0], wv[1], wv[2], za);
        hy_short8(HYT + ((size_t)(2 * sp + 1) * 768 + 512 + c) * POS, l0, wv[0], wv[1], wv[2], zb);
#pragma unroll
        for (int j = 0; j < 8; j += 2) {
            *(LAS f32x4*)(L + sp * SB + (pl + 8u * (unsigned)(j))) = (f32x4){za[j], zb[j], za[j + 1], zb[j + 1]};
            *(LAS f32x4*)(L + sp * SB + (pl + 34816u + 8u * (unsigned)(j))) = (f32x4){0.f, 0.f, 0.f, 0.f}; }
    }
    __syncthreads();
    float* Z1 = (float*)(F.ws + WS_Z1) + (size_t)c * 4 * SEQ;
    bf16_t* MIX = (bf16_t*)(F.ws + WS_MIX);
#pragma unroll 1
    for (int n = 0; n < 2; ++n) {
        fft8192x2<false>(L, t);
#pragma unroll 1
        for (int k0 = 0; k0 < 16; k0 += 8) { f32x2 h[8];
#pragma unroll
          for (int k = 0; k < 8; ++k) h[k] = SPEC[n * 8192 + t + 512 * (k0 + k)];
#pragma unroll
          for (int k = 0; k < 8; ++k) { const unsigned ad = (pt + 4352u * (unsigned)(k0 + k));
            const f32x2 a = *(const LAS f32x2*)(L + ad), b = *(const LAS f32x2*)(L + SB + ad);
            *(LAS f32x2*)(L + ad) = (f32x2){a[0] * h[k][0] - a[1] * h[k][1], a[0] * h[k][1] + a[1] * h[k][0]};
            *(LAS f32x2*)(L + SB + ad) = (f32x2){b[0] * h[k][0] - b[1] * h[k][1], b[0] * h[k][1] + b[1] * h[k][0]}; } }
        __syncthreads();
        fft8192x2<true>(L, t);
        const int xch = n == 0 ? c : 256 + c; const float* wg = n == 0 ? wx1 : wx2; const float bias = n == 0 ? bias0 : bias1;
#pragma unroll 1
        for (int sp = 0; sp < 2; ++sp) {
            float zo[2][8];
#pragma unroll
            for (int h2 = 0; h2 < 2; ++h2) { const int bb = 2 * sp + h2;
                float g[8], zin[8];
                hy_short8(HYT + ((size_t)bb * 768 + xch) * POS, l0, wg[0], wg[1], wg[2], g);
                if (n == 0) hy_short8(HYT + ((size_t)bb * 768 + 512 + c) * POS, l0, wv[0], wv[1], wv[2], zin);
                else { const f32x4 q0 = *(const f32x4*)(Z1 + (size_t)bb * SEQ + l0), q1 = *(const f32x4*)(Z1 + (size_t)bb * SEQ + l0 + 4);
                    zin[0] = q0[0]; zin[1] = q0[1]; zin[2] = q0[2]; zin[3] = q0[3]; zin[4] = q1[0]; zin[5] = q1[1]; zin[6] = q1[2]; zin[7] = q1[3]; }
#pragma unroll
                for (int j = 0; j < 8; ++j) { const float y = ((const LAS float*)(L + sp * SB + (pl + 8u * (unsigned)(j))))[h2]; zo[h2][j] = g[j] * (y + bias * zin[j]); }
                if (n == 0) { *(f32x4*)(Z1 + (size_t)bb * SEQ + l0) = (f32x4){zo[h2][0], zo[h2][1], zo[h2][2], zo[h2][3]}; *(f32x4*)(Z1 + (size_t)bb * SEQ + l0 + 4) = (f32x4){zo[h2][4], zo[h2][5], zo[h2][6], zo[h2][7]}; }
                else {
#pragma unroll
                    for (int j = 0; j < 8; ++j) MIX[((size_t)bb * SEQ + l0 + j) * DM + c] = f2bf(zo[h2][j]); }
            }
            if (n == 0) {
#pragma unroll
                for (int j = 0; j < 8; j += 2) {
                    *(LAS f32x4*)(L + sp * SB + (pl + 8u * (unsigned)(j))) = (f32x4){zo[0][j], zo[1][j], zo[0][j + 1], zo[1][j + 1]};
                    *(LAS f32x4*)(L + sp * SB + (pl + 34816u + 8u * (unsigned)(j))) = (f32x4){0.f, 0.f, 0.f, 0.f}; }
            }
        }
        __syncthreads();
    }
}

DI void fnet_fft_unit(const Frame& F, int u) {
    LAS unsigned char* L = F.lds; constexpr int SB = cx_bytes(4096);
    const int t = F.tid, b = u >> 6, gd0 = (u & 63) * 4;
    const bf16_t* YT = (const bf16_t*)(F.ws + WS_YTL) + ((size_t)b * 256 + gd0) * 8192;
    for (int i = t; i < 4 * 512; i += NTHR) { const int q = i >> 9, l0 = (i & 511) * 8;
        const u32x4 r = *(const u32x4*)(YT + (size_t)q * 8192 + l0), m = *(const u32x4*)(YT + (size_t)q * 8192 + 4096 + l0);
        const float rr[8] = {bflo(r.x), bfhi(r.x), bflo(r.y), bfhi(r.y), bflo(r.z), bfhi(r.z), bflo(r.w), bfhi(r.w)};
        const float mm[8] = {bflo(m.x), bfhi(m.x), bflo(m.y), bfhi(m.y), bflo(m.z), bfhi(m.z), bflo(m.w), bfhi(m.w)};
#pragma unroll
        for (int j = 0; j < 8; j += 2) *(LAS f32x4*)(L + q * SB + cx_addr(l0 + j)) = (f32x4){rr[j], mm[j], rr[j + 1], mm[j + 1]}; }
    __syncthreads();
    fft4096x4(L, t);
    bf16_t* MIX = (bf16_t*)(F.ws + WS_MIX);
#pragma unroll
    for (int i = 0; i < 8; ++i) { const int p = t + 512 * i; const int f = (p >> 8) + 16 * ((p >> 4) & 15) + 256 * (p & 15);
        float v[4];
#pragma unroll
        for (int q = 0; q < 4; ++q) v[q] = (*(const LAS f32x2*)(L + q * SB + cx_addr(p)))[0] * (1.0f / 512.0f);
        u32x2 w; w.x = cvt_pk_bf16(v[0], v[1]); w.y = cvt_pk_bf16(v[2], v[3]);
        *(u32x2*)(MIX + ((size_t)b * SEQ + f) * DM + 768 + gd0) = w; }
    __syncthreads();
}

DI void attn_unit(const Frame& F, int ly, int uid, float lam, float out_scale) {
    const int t = F.tid, lane = F.lane, wave = F.wave;
    LAS unsigned char* L = F.lds;
    constexpr int KOFF = 0, VOFF = 16384, TB = 32768, NBUF = 4;
    int bh, q0, k_lo, k_hi;
    if (uid < 512) { bh = uid >> 4; q0 = (uid & 15) << 8; k_lo = 0; k_hi = POS; }
    else { bh = uid - 512; q0 = SEQ; k_lo = SEQ; k_hi = POS; }
    const bf16_t* Qg = (const bf16_t*)(F.ws + WS_Q) + (size_t)bh * POS * 64;
    const bf16_t* Kg = (const bf16_t*)(F.ws + WS_K) + (size_t)bh * POS * 64;
    const bf16_t* Vg = (const bf16_t*)(F.ws + WS_V) + (size_t)bh * POS * 64;
    const int qi = lane & 31, hh = lane >> 5;
    const int qpos = q0 + wave * 32 + qi;
    bf16x8 qf[2][2];
    float q2[2] = {0.f, 0.f};
#pragma unroll
    for (int comp = 0; comp < 2; ++comp)
#pragma unroll
        for (int ks = 0; ks < 2; ++ks) { qf[comp][ks] = *(const bf16x8*)(Qg + (size_t)qpos * 64 + comp * 32 + ks * 16 + hh * 8);
#pragma unroll
            for (int j = 0; j < 8; ++j) { const float x = bf2f((unsigned short)qf[comp][ks][j]); q2[comp] += x * x; } }
    q2[0] += __shfl_xor(q2[0], 32); q2[1] += __shfl_xor(q2[1], 32);
    float kmax2[2];
    kmax2[0] = __uint_as_float(F.ctl[CW_KMAX + 64 * ly + bh * 2]); kmax2[1] = __uint_as_float(F.ctl[CW_KMAX + 64 * ly + bh * 2 + 1]);
    f32x16 negm;
    { const float m = -fmaxf(sqrtf(q2[0] * kmax2[0]), sqrtf(q2[1] * kmax2[1])) * 1.0001f;
#pragma unroll
      for (int i = 0; i < 16; ++i) negm[i] = m; }
    f32x16 O[2][2];
#pragma unroll
    for (int a = 0; a < 2; ++a)
#pragma unroll
        for (int b = 0; b < 2; ++b)
#pragma unroll
            for (int i = 0; i < 16; ++i) O[a][b][i] = 0.f;
    float lsum[2] = {0.f, 0.f};
    const int sk = t >> 3, sl = t & 7;
    const int kch = sl ^ ((sk >> 1) & 7);
    const int vch = (((sl >> 1) ^ (sk & 3)) << 1) | (sl & 1);
    const bf16_t* kgp = Kg + (size_t)(k_lo + sk) * 64 + kch * 8;
    const bf16_t* vgp = Vg + (size_t)(k_lo + sk) * 64 + vch * 8;
    const unsigned wvb = (unsigned)wave * 1024u;
    const int ntile = (k_hi - k_lo) >> 7;
#define ATT_DMA(tile, bufi) do { const size_t go = (size_t)(tile) * 128 * 64; \
        __builtin_amdgcn_global_load_lds((const unsigned*)(kgp + go), (LAS unsigned*)(L + KOFF + (bufi) * TB + wvb), 16, 0, 0); \
        __builtin_amdgcn_global_load_lds((const unsigned*)(kgp + go + 4096), (LAS unsigned*)(L + KOFF + (bufi) * TB + 8192 + wvb), 16, 0, 0); \
        __builtin_amdgcn_global_load_lds((const unsigned*)(vgp + go), (LAS unsigned*)(L + VOFF + (bufi) * TB + wvb), 16, 0, 0); \
        __builtin_amdgcn_global_load_lds((const unsigned*)(vgp + go + 4096), (LAS unsigned*)(L + VOFF + (bufi) * TB + 8192 + wvb), 16, 0, 0); } while (0)
    ATT_DMA(0, 0);
    if (ntile > 1) ATT_DMA(1, 1);
    if (ntile > 2) ATT_DMA(2, 2);
    if (ntile > 2) asm volatile("s_waitcnt vmcnt(8)" ::: "memory"); else if (ntile > 1) asm volatile("s_waitcnt vmcnt(4)" ::: "memory"); else asm volatile("s_waitcnt vmcnt(0)" ::: "memory");
    __builtin_amdgcn_s_barrier();
    const int p4 = lane & 3, q4 = (lane & 15) >> 2, blk = (lane >> 4) & 1;
    const int keyq = 4 * hh + q4;
    const unsigned va0 = (unsigned)(keyq * 128 + (((0 + blk) ^ (keyq & 3)) << 5) + p4 * 8), va1 = (unsigned)(keyq * 128 + (((2 + blk) ^ (keyq & 3)) << 5) + p4 * 8);
    const int ksw = (qi >> 1) & 7;
    const unsigned ka00 = (unsigned)(qi * 128 + (((0 + hh) ^ ksw) << 4)), ka01 = (unsigned)(qi * 128 + (((2 + hh) ^ ksw) << 4));
    const unsigned ka10 = (unsigned)(qi * 128 + (((4 + hh) ^ ksw) << 4)), ka11 = (unsigned)(qi * 128 + (((6 + hh) ^ ksw) << 4));
    typedef __bf16 bf16x8n __attribute__((ext_vector_type(8)));
    typedef float f32x8 __attribute__((ext_vector_type(8)));
#define ATT_PACK(S, s8) __builtin_bit_cast(bf16x8, __builtin_convertvector((f32x8){S[8 * (s8)], S[8 * (s8) + 1], S[8 * (s8) + 2], S[8 * (s8) + 3], S[8 * (s8) + 4], S[8 * (s8) + 5], S[8 * (s8) + 6], S[8 * (s8) + 7]}, bf16x8n))
#define ATT_MFMA(a, b, c) __builtin_amdgcn_mfma_f32_32x32x16_bf16((a), (b), (c), 0, 0, 0)
    f32x16 S0, S1;
    bf16x8 p1a, p1b, vp00, vp01, vp10, vp11;
#pragma unroll
    for (int j = 0; j < 8; ++j) { p1a[j] = 0; p1b[j] = 0; vp00[j] = 0; vp01[j] = 0; vp10[j] = 0; vp11[j] = 0; }
    for (int it = 0; it < ntile; ++it) {
        const int buf = it & (NBUF - 1);
        if (it + 3 < ntile) ATT_DMA(it + 3, (it + 3) & (NBUF - 1));
        const unsigned kbb = KOFF + buf * TB, vbb = VOFF + buf * TB;
        { const bf16x8 k00 = *(const LAS bf16x8*)(L + kbb + ka00), k01 = *(const LAS bf16x8*)(L + kbb + ka01);
          S0 = ATT_MFMA(k00, qf[0][0], negm); S0 = ATT_MFMA(k01, qf[0][1], S0); }
#pragma unroll 2
        for (int kb = 0; kb < 4; ++kb) {
            const unsigned kro = kbb + kb * 4096, vro = vbb + kb * 4096;
            s16x4 r0, r1, r2, r3, r4, r5, r6, r7;
            { const unsigned a0 = vro + va0, a1 = vro + va1;
              asm volatile("ds_read_b64_tr_b16 %0, %8\n\tds_read_b64_tr_b16 %1, %8 offset:1024\n\tds_read_b64_tr_b16 %2, %8 offset:2048\n\tds_read_b64_tr_b16 %3, %8 offset:3072\n\t"
                           "ds_read_b64_tr_b16 %4, %9\n\tds_read_b64_tr_b16 %5, %9 offset:1024\n\tds_read_b64_tr_b16 %6, %9 offset:2048\n\tds_read_b64_tr_b16 %7, %9 offset:3072"
                           : "=&v"(r0), "=&v"(r1), "=&v"(r2), "=&v"(r3), "=&v"(r4), "=&v"(r5), "=&v"(r6), "=&v"(r7) : "v"(a0), "v"(a1) : "memory"); }
            const bf16x8 k10 = *(const LAS bf16x8*)(L + kro + ka10), k11 = *(const LAS bf16x8*)(L + kro + ka11);
            O[1][0] = ATT_MFMA(vp00, p1a, O[1][0]); O[1][1] = ATT_MFMA(vp01, p1a, O[1][1]);
            O[1][0] = ATT_MFMA(vp10, p1b, O[1][0]); O[1][1] = ATT_MFMA(vp11, p1b, O[1][1]);
            S1 = ATT_MFMA(k10, qf[1][0], negm); S1 = ATT_MFMA(k11, qf[1][1], S1);
            float ps0 = 0.f;
#pragma unroll
            for (int i = 0; i < 16; ++i) { S0[i] = __builtin_amdgcn_exp2f(S0[i]); ps0 += S0[i]; }
            lsum[0] += ps0;
            const bf16x8 p0a = ATT_PACK(S0, 0), p0b = ATT_PACK(S0, 1);
            __builtin_amdgcn_sched_group_barrier(0x008, 1, 0); __builtin_amdgcn_sched_group_barrier(0x400, 3, 0);
            __builtin_amdgcn_sched_group_barrier(0x008, 1, 0); __builtin_amdgcn_sched_group_barrier(0x400, 3, 0);
            __builtin_amdgcn_sched_group_barrier(0x008, 1, 0); __builtin_amdgcn_sched_group_barrier(0x400, 3, 0);
            __builtin_amdgcn_sched_group_barrier(0x008, 1, 0); __builtin_amdgcn_sched_group_barrier(0x400, 3, 0);
            __builtin_amdgcn_sched_group_barrier(0x008, 1, 0); __builtin_amdgcn_sched_group_barrier(0x400, 2, 0);
            __builtin_amdgcn_sched_group_barrier(0x008, 1, 0); __builtin_amdgcn_sched_group_barrier(0x400, 2, 0);
            asm volatile("s_waitcnt lgkmcnt(0)" : "+v"(r0), "+v"(r1), "+v"(r2), "+v"(r3), "+v"(r4), "+v"(r5), "+v"(r6), "+v"(r7));
            vp00 = __builtin_shufflevector(r0, r1, 0, 1, 2, 3, 4, 5, 6, 7); vp10 = __builtin_shufflevector(r2, r3, 0, 1, 2, 3, 4, 5, 6, 7);
            vp01 = __builtin_shufflevector(r4, r5, 0, 1, 2, 3, 4, 5, 6, 7); vp11 = __builtin_shufflevector(r6, r7, 0, 1, 2, 3, 4, 5, 6, 7);
            O[0][0] = ATT_MFMA(vp00, p0a, O[0][0]); O[0][1] = ATT_MFMA(vp01, p0a, O[0][1]);
            O[0][0] = ATT_MFMA(vp10, p0b, O[0][0]); O[0][1] = ATT_MFMA(vp11, p0b, O[0][1]);
            { const bf16x8 k00 = *(const LAS bf16x8*)(L + kro + 4096 + ka00), k01 = *(const LAS bf16x8*)(L + kro + 4096 + ka01);
                S0 = ATT_MFMA(k00, qf[0][0], negm); S0 = ATT_MFMA(k01, qf[0][1], S0); }
            float ps1 = 0.f;
#pragma unroll
            for (int i = 0; i < 16; ++i) { S1[i] = __builtin_amdgcn_exp2f(S1[i]); ps1 += S1[i]; }
            lsum[1] += ps1;
            p1a = ATT_PACK(S1, 0); p1b = ATT_PACK(S1, 1);
            __builtin_amdgcn_sched_group_barrier(0x008, 1, 1); __builtin_amdgcn_sched_group_barrier(0x400, 3, 1);
            __builtin_amdgcn_sched_group_barrier(0x008, 1, 1); __builtin_amdgcn_sched_group_barrier(0x400, 3, 1);
            __builtin_amdgcn_sched_group_barrier(0x008, 1, 1); __builtin_amdgcn_sched_group_barrier(0x400, 3, 1);
            __builtin_amdgcn_sched_group_barrier(0x008, 1, 1); __builtin_amdgcn_sched_group_barrier(0x400, 3, 1);
            __builtin_amdgcn_sched_group_barrier(0x008, 1, 1); __builtin_amdgcn_sched_group_barrier(0x400, 2, 1);
            __builtin_amdgcn_sched_group_barrier(0x008, 1, 1); __builtin_amdgcn_sched_group_barrier(0x400, 2, 1);
        }
        if (it + 3 < ntile) asm volatile("s_waitcnt vmcnt(8)\n\ts_waitcnt lgkmcnt(0)" ::: "memory");
        else if (it + 2 < ntile) asm volatile("s_waitcnt vmcnt(4)\n\ts_waitcnt lgkmcnt(0)" ::: "memory");
        else asm volatile("s_waitcnt vmcnt(0)\n\ts_waitcnt lgkmcnt(0)" ::: "memory");
        __builtin_amdgcn_s_barrier();
    }
    O[1][0] = ATT_MFMA(vp00, p1a, O[1][0]); O[1][1] = ATT_MFMA(vp01, p1a, O[1][1]);
    O[1][0] = ATT_MFMA(vp10, p1b, O[1][0]); O[1][1] = ATT_MFMA(vp11, p1b, O[1][1]);
#undef ATT_DMA
#undef ATT_PACK
#undef ATT_MFMA
    const float l0 = lsum[0] + __shfl_xor(lsum[0], 32), l1 = lsum[1] + __shfl_xor(lsum[1], 32);
    const float i0 = 1.0f / l0, i1 = lam / l1;
    float ss = 0.f;
#pragma unroll
    for (int dvb = 0; dvb < 2; ++dvb)
#pragma unroll
        for (int i = 0; i < 16; ++i) { const float o = O[0][dvb][i] * i0 - O[1][dvb][i] * i1; O[0][dvb][i] = o; ss += o * o; }
    ss += __shfl_xor(ss, 32);
    const float rn = rsqrtf(ss * (1.0f / 64.0f) + LN_EPS) * out_scale;
    const float* sw = F.in[20] + (size_t)ly * 64;
    const int b = bh >> 3, head = bh & 7;
    const size_t row = qpos < SEQ ? (size_t)b * SEQ + qpos : (size_t)RLAT + b * CTXL + (qpos - SEQ);
    bf16_t* dst = (bf16_t*)(F.ws + WS_MIX) + row * DM + 256 + head * 64;
#pragma unroll
    for (int dvb = 0; dvb < 2; ++dvb)
#pragma unroll
        for (int g = 0; g < 4; ++g) { const int dv = dvb * 32 + 8 * g + 4 * hh;
            const f32x4 w4 = *(const f32x4*)(sw + dv);
            u32x2 w; w.x = cvt_pk_bf16(O[0][dvb][4 * g] * rn * w4[0], O[0][dvb][4 * g + 1] * rn * w4[1]); w.y = cvt_pk_bf16(O[0][dvb][4 * g + 2] * rn * w4[2], O[0][dvb][4 * g + 3] * rn * w4[3]);
            *(u32x2*)(dst + dv) = w; }
    __syncthreads();
}

DI void phase_rows_router(const Frame& F, int ly) {
    LAS float* HS = (LAS float*)F.lds;
    LAS float* PART = HS + 16 * 1028;
    LAS int* LCNT = (LAS int*)(PART + 8 * 16 * 64);
    LAS int* LBASE = LCNT + 64;
    LAS int* ASG = LBASE + 64;
    const int lane = F.lane, wave = F.wave;
    const float* MOD = (const float*)(F.ws + WS_MOD);
    const float* g1 = F.in[22] + (size_t)ly * DM; const float* b1 = F.in[23] + (size_t)ly * DM;
    const float* rw = F.in[26] + (size_t)ly * DM * NEXP; const float* rb = F.in[27] + (size_t)ly * NEXP;
    const bool last = ly == DEPTH - 1;
    const int nrows = last ? RLAT : RTOT;
    if (F.tid < 64) LCNT[F.tid] = 0;
    constexpr int HSS = 1028;
    float wreg[128];
#pragma unroll
    for (int i = 0; i < 128; ++i) wreg[i] = rw[(size_t)(wave * 128 + 4 * (i >> 2) + (lane >> 4)) * NEXP + 16 * (i & 3) + (lane & 15)];
    __syncthreads();
    int itn = 0;
    f32x4 va[2][4];
    if (F.bid * 16 < nrows) {
#pragma unroll
        for (int rr = 0; rr < 2; ++rr) { const float* xr = (const float*)(F.ws + WS_X) + (size_t)(F.bid * 16 + wave * 2 + rr) * DM;
#pragma unroll
            for (int j = 0; j < 4; ++j) va[rr][j] = *(const f32x4*)(xr + 4 * lane + 256 * j); } }
    for (int r0 = F.bid * 16; r0 < nrows; r0 += F.G * 16, ++itn) {
#pragma unroll
        for (int rr = 0; rr < 2; ++rr) { const int rl = wave * 2 + rr, row = r0 + rl;
            float* xr = (float*)(F.ws + WS_X) + (size_t)row * DM;
            f32x4 (&v)[4] = va[rr];
            float mu, rstd; ln_stats(v, mu, rstd);
#pragma unroll
            for (int j = 0; j < 4; ++j) { const int c = 4 * lane + 256 * j; const f32x4 g = *(const f32x4*)(g1 + c), bb = *(const f32x4*)(b1 + c);
#pragma unroll
                for (int e = 0; e < 4; ++e) v[j][e] = (v[j][e] - mu) * rstd * g[e] + bb[e];
                *(f32x4*)(xr + c) = v[j]; }
            ln_stats(v, mu, rstd);
            const float* m = MOD + ((size_t)ly * 5 + row_modsel(row)) * 6144;
            bf16_t* hrow = (bf16_t*)(F.ws + WS_H) + (size_t)row * DM;
#pragma unroll
            for (int j = 0; j < 4; ++j) { const int c = 4 * lane + 256 * j; const f32x4 a = *(const f32x4*)(m + 3072 + c), bsc = *(const f32x4*)(m + 4096 + c);
                f32x4 o;
#pragma unroll
                for (int e = 0; e < 4; ++e) o[e] = (v[j][e] - mu) * rstd * (1.f + bsc[e]) + a[e];
                u32x2 w; w.x = cvt_pk_bf16(o[0], o[1]); w.y = cvt_pk_bf16(o[2], o[3]); *(u32x2*)(hrow + c) = w;
                *(LAS f32x4*)(HS + rl * HSS + c) = o; } }
        { const int rn = r0 + F.G * 16;
          if (rn < nrows) {
#pragma unroll
            for (int rr = 0; rr < 2; ++rr) { const float* xr = (const float*)(F.ws + WS_X) + (size_t)(rn + wave * 2 + rr) * DM;
#pragma unroll
                for (int j = 0; j < 4; ++j) va[rr][j] = *(const f32x4*)(xr + 4 * lane + 256 * j); } } }
        asm volatile("s_waitcnt lgkmcnt(0)" ::: "memory"); __builtin_amdgcn_s_barrier();
        { f32x4 acc[4];
#pragma unroll
          for (int nb = 0; nb < 4; ++nb) acc[nb] = (f32x4){0.f, 0.f, 0.f, 0.f};
          const LAS float* hp = HS + (lane & 15) * HSS + wave * 128 + (lane >> 4);
#pragma unroll
          for (int g = 0; g < 32; ++g) { const float a = hp[4 * g];
#pragma unroll
              for (int nb = 0; nb < 4; ++nb) acc[nb] = __builtin_amdgcn_mfma_f32_16x16x4f32(a, wreg[g * 4 + nb], acc[nb], 0, 0, 0); }
#pragma unroll
          for (int nb = 0; nb < 4; ++nb)
#pragma unroll
              for (int e = 0; e < 4; ++e) PART[(wave * 16 + (lane >> 4) * 4 + e) * 64 + nb * 16 + (lane & 15)] = acc[nb][e]; }
        asm volatile("s_waitcnt lgkmcnt(0)" ::: "memory"); __builtin_amdgcn_s_barrier();
#pragma unroll
        for (int rr = 0; rr < 2; ++rr) { const int rl = wave * 2 + rr, row = r0 + rl;
            float lg = 0.f;
#pragma unroll
            for (int w = 0; w < 8; ++w) lg += PART[(w * 16 + rl) * 64 + lane];
            const float s = 1.0f / (1.0f + expf(-lg));
            const float sel = s + rb[lane];
            float m1 = sel;
            m1 = fmaxf(m1, __shfl_xor(m1, 1)); m1 = fmaxf(m1, __shfl_xor(m1, 2)); m1 = fmaxf(m1, __shfl_xor(m1, 4));
            const unsigned long long bal = __ballot(sel == m1);
            const int gbase = lane & ~7;
            const unsigned gmask = (unsigned)((bal >> gbase) & 0xffull);
            const int first = gbase + __builtin_ctz(gmask);
            float m2 = (lane == first) ? -INFINITY : sel;
            m2 = fmaxf(m2, __shfl_xor(m2, 1)); m2 = fmaxf(m2, __shfl_xor(m2, 2)); m2 = fmaxf(m2, __shfl_xor(m2, 4));
            const float gs = m1 + m2;
            const int mygrp = lane >> 3;
            int grank = 0;
#pragma unroll
            for (int g = 0; g < 8; ++g) { const float o = __shfl(gs, g * 8); grank += (o > gs || (o == gs && g < mygrp)) ? 1 : 0; }
            const float msel = grank < 4 ? sel : -INFINITY;
            int rank = 64;
            { float cur = msel;
#pragma unroll 1
              for (int it = 0; it < 8; ++it) { const float m = wave_max(cur); const unsigned long long bl = __ballot(cur == m); const int first2 = (int)__builtin_ctzll(bl);
                  if (lane == first2) { rank = it; cur = -INFINITY; } } }
            const bool chosen = rank < 8;
            const float wsum = wave_sum(chosen ? s : 0.f);
            if (chosen) { const float gate = s / wsum * 2.5f;
                ((float*)(F.ws + WS_TOPG))[(size_t)row * 8 + rank] = gate;
                const int lp = __hip_atomic_fetch_add(LCNT + lane, 1, __ATOMIC_RELAXED, __HIP_MEMORY_SCOPE_WORKGROUP);
                ASG[(itn * 16 + rl) * 8 + rank] = (lane << 20) | lp; } }
        asm volatile("s_waitcnt lgkmcnt(0)" ::: "memory"); __builtin_amdgcn_s_barrier();
    }
    if (F.tid < 64) { const int n = LCNT[F.tid]; LBASE[F.tid] = n ? (int)atomicAdd(F.ctl + CW_CNT + (ly * 64 + F.tid) * CNT_STRIDE, (unsigned)n) : 0; }
    __syncthreads();
    for (int a = F.tid; a < itn * 128; a += NTHR) { const int it = a >> 7, rl = (a >> 3) & 15, slot = a & 7; const int row = F.bid * 16 + it * F.G * 16 + rl;
        const int v = ASG[a], e = v >> 20, lp = v & 0xfffff;
        ((int*)(F.ws + WS_LIST))[(size_t)e * RTOT + LBASE[e] + lp] = row * 8 + slot;
        ((int*)(F.ws + WS_TOPE))[(size_t)row * 8 + slot] = (e << 20) | (LBASE[e] + lp); }
    __syncthreads();
}

DI void bf8_fma(const u32x4 w, float g, float (&y)[8]) {
    y[0] += bflo(w.x) * g; y[1] += bfhi(w.x) * g; y[2] += bflo(w.y) * g; y[3] += bfhi(w.y) * g; y[4] += bflo(w.z) * g; y[5] += bfhi(w.z) * g; y[6] += bflo(w.w) * g; y[7] += bfhi(w.w) * g;
}
DI void phase_combine(const Frame& F, int ly) {
    const int gw = F.bid * 8 + F.wave, nw = F.G * 8, lane = F.lane;
    const bool last = ly == DEPTH - 1;
    const int nrows = last ? RLAT : RTOT;
    const float* MOD = (const float*)(F.ws + WS_MOD);
    const float* g2w = F.in[24] + (size_t)ly * DM; const float* b2w = F.in[25] + (size_t)ly * DM;
    const bf16_t* YB = (const bf16_t*)(F.ws + WS_YB);
    const MoeTab T = moe_tables(F, ly);
    for (int row = gw; row < nrows; row += nw) {
        const float* gates = (const float*)(F.ws + WS_TOPG) + (size_t)row * 8;
        const int* posr = (const int*)(F.ws + WS_TOPE) + (size_t)row * 8;
        u32x4 yr[9][2];
#pragma unroll
        for (int s9 = 0; s9 < 9; ++s9) { size_t yrow;
            if (s9 < 8) { const int v = posr[s9]; yrow = (size_t)T.tstart[v >> 20] * 256 + (v & 0xfffff); } else yrow = (size_t)T.tstart[NEXP] * 256 + row;
#pragma unroll
            for (int hf = 0; hf < 2; ++hf) yr[s9][hf] = __builtin_nontemporal_load((const u32x4*)(YB + yrow * DM + hf * 512 + 8 * lane)); }
        float* xr = (float*)(F.ws + WS_X) + (size_t)row * DM;
        f32x4 xv[4];
#pragma unroll
        for (int hf = 0; hf < 2; ++hf) { xv[2 * hf] = *(const f32x4*)(xr + hf * 512 + 8 * lane); xv[2 * hf + 1] = *(const f32x4*)(xr + hf * 512 + 8 * lane + 4); }
        float y[2][8];
#pragma unroll
        for (int hf = 0; hf < 2; ++hf) {
#pragma unroll
            for (int e = 0; e < 8; ++e) y[hf][e] = 0.f;
            bf8_fma(yr[8][hf], 1.0f, y[hf]);
#pragma unroll
            for (int s8 = 0; s8 < 8; ++s8) bf8_fma(yr[s8][hf], gates[s8], y[hf]); }
        const float* m = MOD + ((size_t)ly * 5 + row_modsel(row)) * 6144;
        f32x4 v[4];
#pragma unroll
        for (int q = 0; q < 4; ++q) { const int c = (q >> 1) * 512 + 8 * lane + (q & 1) * 4; const f32x4 g2 = *(const f32x4*)(m + 5120 + c);
#pragma unroll
            for (int e = 0; e < 4; ++e) v[q][e] = xv[q][e] * ALPHA + g2[e] * y[q >> 1][(q & 1) * 4 + e]; }
        float mu, rstd; ln_stats(v, mu, rstd);
#pragma unroll
        for (int q = 0; q < 4; ++q) { const int c = (q >> 1) * 512 + 8 * lane + (q & 1) * 4; const f32x4 g = *(const f32x4*)(g2w + c), bb = *(const f32x4*)(b2w + c);
#pragma unroll
            for (int e = 0; e < 4; ++e) v[q][e] = (v[q][e] - mu) * rstd * g[e] + bb[e];
            if (last) *(f32x4*)(F.out + (size_t)row * DM + c) = v[q]; else *(f32x4*)(xr + c) = v[q]; }
        if (!last) { const float* mn = MOD + ((size_t)(ly + 1) * 5 + row_modsel(row)) * 6144;
            ln_stats(v, mu, rstd);
            bf16_t* hrow = (bf16_t*)(F.ws + WS_H) + (size_t)row * DM;
#pragma unroll
            for (int hf = 0; hf < 2; ++hf) { const int c = hf * 512 + 8 * lane; float o[8];
#pragma unroll
                for (int q = 0; q < 2; ++q) { const f32x4 sh = *(const f32x4*)(mn + c + 4 * q), sc = *(const f32x4*)(mn + 1024 + c + 4 * q);
#pragma unroll
                    for (int e = 0; e < 4; ++e) o[4 * q + e] = (v[2 * hf + q][e] - mu) * rstd * (1.f + sc[e]) + sh[e]; }
                u32x4 w; w.x = cvt_pk_bf16(o[0], o[1]); w.y = cvt_pk_bf16(o[2], o[3]); w.z = cvt_pk_bf16(o[4], o[5]); w.w = cvt_pk_bf16(o[6], o[7]);
                *(u32x4*)(hrow + c) = w; } }
    }
}

PHASE_FN void ph_pre0(const Frame& F0) { const Frame F = relaunder(F0); prep_small(F, 0); prep_mod(F); prep_filters(F); prep_tables(F); }
PHASE_FN void ph_pre1(const Frame& F0) { const Frame F = relaunder(F0); prep_invl1(F); phase_init_h(F); }
PHASE_FN void ph_win(const Frame& F0, int ly) { const Frame F = relaunder(F0);
    pg8::Gemm g{(const bf16_t*)(F.ws + WS_H), (const bf16_t*)(F.ws + WS_WIN), DM, F.tid};
    pg8::StaticOrder S; S.init(RTOT / 256, NWIN / 256, F.G, F.bid);
    EpiWin E{F.ws, ly};
    pg8::gemm_phase<EpiWin, pg8::StaticOrder>(F.lds, g, S, E);
}
constexpr int NSTREAM = 0;
PHASE_FN void ph_mix(const Frame& F0, int ly) { const Frame F = relaunder(F0);
    volatile LAS unsigned* MISC = (volatile LAS unsigned*)(F.lds + LDS_MISC);
    const bool last = ly == DEPTH - 1;
    if (!last) { pg8::Gemm g{(const bf16_t*)(F.ws + WS_DFTC), (const bf16_t*)(F.ws + WS_YTC), 2 * CTXL, F.tid};
      pg8::StaticOrder S; S.init(1, 4, F.G, (F.bid + F.G - 64) % F.G);
      EpiFnet E{F.ws, 1};
      pg8::gemm_phase<EpiFnet, pg8::StaticOrder>(F.lds, g, S, E); }
    __syncthreads();
    for (;;) {
        __syncthreads();
        if (F.tid == 0) MISC[16] = atomicAdd(F.ctl + CW_ATTN + 64 * ly, 1u);
        __syncthreads();
        const int uid = (int)MISC[16];
        if (uid >= 256 + 256 + (last ? 512 : 544)) break;
        const Frame Fu = relaunder(F);
        if (uid < 256) { if (KIND(4)) { hyena_fft_unit(Fu, ly, uid); if (!last) hyena_ctx_unit(Fu, ly, uid); } }
        else if (uid < 512) { if (KIND(3)) fnet_fft_unit(Fu, uid - 256); }
        else if (KIND(5)) { const float* lm = (const float*)(Fu.ws + WS_LAM) + 2 * ly; attn_unit(Fu, ly, uid - 512, lm[0], 1.0f - lm[1]); }
    }
    prep_experts(F, ly, CW_PREPQ, 0, PREP_SPLIT);
}
PHASE_FN void ph_wout(const Frame& F0, int ly) { const Frame F = relaunder(F0);
    pg8::Gemm g{(const bf16_t*)(F.ws + WS_MIX), (const bf16_t*)(F.ws + WS_WOUT), DM, F.tid};
    pg8::StaticOrder S; S.init(ly == DEPTH - 1 ? RLAT / 256 : RTOT / 256, DM / 256, F.G, F.bid);
    EpiWout E{F.ws, ly, F.in[0], F.in[2]};
    pg8::gemm_phase<EpiWout, pg8::StaticOrder>(F.lds, g, S, E);
    __syncthreads();
    prep_experts(F, ly, CW_PREPQ2, PREP_SPLIT, PREP_SPLIT2);
}
PHASE_FN void ph_router(const Frame& F0, int ly) { const Frame F = relaunder(F0); phase_rows_router(F, ly); prep_experts(F, ly, CW_PREPQ4, PREP_SPLIT2, 3 * 1040); }
PHASE_FN void ph_moe1(const Frame& F0, int ly) { const Frame F = relaunder(F0);
    const MoeTab T = moe_tables(F, ly);
    pg8::Gemm g{(const bf16_t*)(F.ws + WS_H), (const bf16_t*)(F.ws + WS_WGU), DM, F.tid};
    MoeSched<true> S{T, (const int*)(F.ws + WS_LIST), F.G, F.bid, 2, 1};
    EpiMoe1 E{F.ws};
    pg8::gemm_phase<EpiMoe1, MoeSched<true>>(F.lds, g, S, E);
    __syncthreads();
    if (ly + 1 < DEPTH) prep_small_dyn(F, ly + 1);
}
PHASE_FN void ph_moe2(const Frame& F0, int ly) { const Frame F = relaunder(F0);
    const MoeTab T = moe_tables(F, ly);
    pg8::Gemm g{(const bf16_t*)(F.ws + WS_ACT), (const bf16_t*)(F.ws + WS_WD), DEXP, F.tid};
    MoeSched<false> S{T, (const int*)(F.ws + WS_LIST), F.G, F.bid, 4, 2};
    EpiMoe2 E{F.ws};
    pg8::gemm_phase<EpiMoe2, MoeSched<false>>(F.lds, g, S, E);
}
PHASE_FN void ph_combine(const Frame& F0, int ly) { const Frame F = relaunder(F0); phase_combine(F, ly); }

constexpr int PH_PER_LAYER = 7, N_PHASES = 2 + DEPTH * PH_PER_LAYER;

__global__ void __launch_bounds__(NTHR, 2) hybrid_fwd(Params prm) {
    extern __shared__ __attribute__((aligned(16))) unsigned char lds_raw[];
    Frame F;
    F.in = prm.in; F.out = prm.out; F.ws = prm.ws; F.lds = (LAS unsigned char*)lds_raw; F.ctl = (unsigned*)(prm.ws + WS_CTL);
    F.tid = threadIdx.x; F.lane = F.tid & 63; F.wave = __builtin_amdgcn_readfirstlane(F.tid >> 6); F.G = gridDim.x; F.bid = blockIdx.x;
    volatile LAS unsigned* MISC = (volatile LAS unsigned*)(F.lds + LDS_MISC);
    if (F.tid < 64) MISC[F.tid] = 0u;
    __syncthreads();
    const int lo = prm.ph_lo, hi = prm.ph_hi;
    XcdBarrier bar; bar.bar = F.ctl + CW_BAR; bar.x = 0; bar.st = nullptr;
    if (hi - lo > 1) bar = xcd_barrier_post(F.ctl + CW_BAR, MISC);
#define IN(k) (lo <= (k) && (k) < hi)
    unsigned long long pr_acc = 0ull, pr_t0 = 0ull;
#define SEAM(k) do { if (IN(k) && IN((k) + 1)) { unsigned long long _b0 = 0; if ((PROBE_KINDS >> 12) & 1) _b0 = __builtin_amdgcn_s_memrealtime(); xcd_barrier(bar); if ((PROBE_KINDS >> 12) & 1) pr_acc += __builtin_amdgcn_s_memrealtime() - _b0; } } while (0)
#define PR_BEGIN(kind) do { if ((PROBE_KINDS >> (kind)) & 1) pr_t0 = __builtin_amdgcn_s_memrealtime(); } while (0)
#define PR_END(kind) do { if ((PROBE_KINDS >> (kind)) & 1) pr_acc += __builtin_amdgcn_s_memrealtime() - pr_t0; } while (0)

    PR_BEGIN(0); if (IN(0) && KIND(0)) { const Frame Fp = relaunder(F); PR_BEGIN(13); prep_small(Fp, 0); PR_END(13); PR_BEGIN(14); prep_mod(Fp); PR_END(14); PR_BEGIN(15); prep_filters(Fp); PR_END(15); PR_BEGIN(16); prep_tables(Fp); PR_END(16); }
    PR_END(0); SEAM(0);
    PR_BEGIN(1); if (IN(1) && KIND(1)) ph_pre1(F);
    PR_END(1); SEAM(1);

    for (int ly = 0; ly < DEPTH; ++ly) {
        const int p0 = 2 + ly * PH_PER_LAYER;
        PR_BEGIN(2); if (IN(p0) && KIND(2)) ph_win(F, ly);
        PR_END(2); SEAM(p0);
        if (IN(p0 + 1)) { PR_BEGIN(5); ph_mix(F, ly); }
        PR_END(5); SEAM(p0 + 1);
        PR_BEGIN(6); if (IN(p0 + 2) && KIND(6)) ph_wout(F, ly);
        PR_END(6); SEAM(p0 + 2);
        PR_BEGIN(7); if (IN(p0 + 3) && KIND(7)) ph_router(F, ly);
        PR_END(7); SEAM(p0 + 3);
        PR_BEGIN(8); if (IN(p0 + 4) && KIND(8)) ph_moe1(F, ly);
        PR_END(8); SEAM(p0 + 4);
        PR_BEGIN(9); if (IN(p0 + 5) && KIND(9)) ph_moe2(F, ly);
        PR_END(9); SEAM(p0 + 5);
        PR_BEGIN(10); if (IN(p0 + 6) && KIND(10)) { const Frame Fc = relaunder(F); PR_BEGIN(17); phase_combine(Fc, ly); PR_END(17);  }
        PR_END(10); SEAM(p0 + 6);
    }
    if (PROBE_KINDS != 0 && blockIdx.x == 0) {
        const unsigned long long t0 = __builtin_amdgcn_s_memrealtime(), wait = pr_acc * (unsigned long long)PROBE_AMP;
        while (__builtin_amdgcn_s_memrealtime() - t0 < wait) __builtin_amdgcn_s_sleep(8);
    }
#undef IN
#undef SEAM
}

extern "C" void kernel_launch(void* const* d_in, const int* in_sizes, int n_in, void* d_out, int out_size, void* d_ws, size_t ws_size, hipStream_t stream) {
    static int grid = 0;
    if (grid == 0) {
        if (n_in != 34 || out_size != RLAT * DM || ws_size < WS_END) { fprintf(stderr, "kernel_launch: unexpected problem shape (n_in %d out %d ws %zu need %zu)\n", n_in, out_size, ws_size, (size_t)WS_END); grid = -1; return; }
        int dev = 0, cus = 0, per_cu = 0;
        if (hipGetDevice(&dev) != hipSuccess || hipDeviceGetAttribute(&cus, hipDeviceAttributeMultiprocessorCount, dev) != hipSuccess) { grid = -1; return; }
        if (hipFuncSetAttribute((const void*)hybrid_fwd, hipFuncAttributeMaxDynamicSharedMemorySize, LDS_BYTES) != hipSuccess) { fprintf(stderr, "kernel_launch: hipFuncSetAttribute failed\n"); grid = -1; return; }
        if (hipOccupancyMaxActiveBlocksPerMultiprocessor(&per_cu, (const void*)hybrid_fwd, NTHR, LDS_BYTES) != hipSuccess || per_cu < 1)
            fprintf(stderr, "kernel_launch: occupancy query reports %d workgroups per CU\n", per_cu);
        (void)hipGetLastError();
        grid = cus;
    }
    if (grid < 0) return;
    (void)hipMemsetAsync((char*)d_ws + WS_CTL, 0, CTL_BYTES, stream);
    Params p{};
    for (int i = 0; i < 34; ++i) p.in[i] = (const float*)d_in[i];
    p.out = (float*)d_out; p.ws = (unsigned char*)d_ws;
#if MK_PER_PHASE
    for (int ph = 0; ph < N_PHASES; ++ph) { p.ph_lo = ph; p.ph_hi = ph + 1; hipLaunchKernelGGL(hybrid_fwd, dim3(grid), dim3(NTHR), LDS_BYTES, stream, p); }
#else
    p.ph_lo = 0; p.ph_hi = N_PHASES;
    hipLaunchKernelGGL(hybrid_fwd, dim3(grid), dim3(NTHR), LDS_BYTES, stream, p);
#endif
}
```

```cpp
#include <hip/hip_runtime.h>
#include <cstdio>
#include <cstdint>

#ifndef MK_PER_PHASE
#define MK_PER_PHASE 0
#endif

#ifndef PG8_ALIGN
#define PG8_ALIGN 1
#endif
#ifndef PG8_OPAQUE_K
#define PG8_OPAQUE_K 1
#endif
#ifndef MK_OUTLINE
#define MK_OUTLINE 0
#endif
#if MK_OUTLINE
#define PHASE_FN __device__ __attribute__((noinline))
#else
#define PHASE_FN __device__ __forceinline__
#endif
#ifndef PROBE_KINDS
#define PROBE_KINDS 0
#endif
#ifndef PROBE_AMP
#define PROBE_AMP 4
#endif
#ifndef KMASK
#define KMASK 0xFFFF
#endif
#define KIND(k) ((KMASK >> (k)) & 1)
#define LAS __attribute__((address_space(3)))
typedef unsigned short bf16_t;
typedef short bf16x8 __attribute__((ext_vector_type(8)));
typedef short s16x4 __attribute__((ext_vector_type(4)));
typedef float f32x4 __attribute__((ext_vector_type(4)));
typedef float f32x16 __attribute__((ext_vector_type(16)));
typedef unsigned u32x4 __attribute__((ext_vector_type(4)));
typedef unsigned u32x2 __attribute__((ext_vector_type(2)));
#define DI __device__ __forceinline__

constexpr int NB = 4, SEQ = 4096, CTXL = 256, DM = 1024, DEPTH = 4;
constexpr int POS = SEQ + CTXL;
constexpr int RLAT = NB * SEQ, RCTX = NB * CTXL, RTOT = RLAT + RCTX;
constexpr int DIN = 2560, NWIN = 2816;
constexpr int NEXP = 64, DEXP = 256;
constexpr float LN_EPS = 1e-5f;
constexpr float ALPHA = 1.681792830507429f;
constexpr float QSCALE = 0.17677669529663687f * 1.4426950408889634f;
constexpr int MAXTILES = 680;

constexpr size_t AL(size_t x) { return (x + 255) & ~(size_t)255; }
constexpr size_t WS_CTL = 0, CTL_BYTES = 1u << 17;
constexpr size_t WS_X = WS_CTL + CTL_BYTES;
constexpr size_t WS_H = WS_X + AL((size_t)RTOT * DM * 4);
constexpr size_t WS_MOD = WS_H + AL((size_t)RTOT * DM * 2);
constexpr size_t WS_HCL = WS_MOD + AL((size_t)DEPTH * 5 * 6144 * 4);
constexpr size_t WS_HCC = WS_HCL + AL((size_t)DEPTH * 4 * 256 * SEQ * 4);
constexpr size_t WS_INVL1 = WS_HCC + AL((size_t)DEPTH * 4 * 256 * CTXL * 4);
constexpr size_t WS_DFTL = WS_INVL1 + AL((size_t)DEPTH * 2 * 2 * 256 * 4);
constexpr size_t WS_DFTC = WS_DFTL + 256;
constexpr size_t WS_ROPE = WS_DFTC + AL((size_t)CTXL * 2 * CTXL * 2);
constexpr size_t WS_LAM = WS_ROPE + AL(64 * 8 * 2 * 4);
constexpr size_t WS_WIN = WS_LAM + 256;
constexpr size_t WS_WOUT = WS_WIN + AL((size_t)NWIN * DM * 2);
constexpr size_t WS_WGU = WS_WOUT + AL((size_t)DM * DM * 2);
constexpr size_t WS_WD = WS_WGU + AL((size_t)65 * 512 * DM * 2);
constexpr size_t WS_TOPE = WS_WD + AL((size_t)65 * DM * DEXP * 2);
constexpr size_t WS_TOPG = WS_TOPE + AL((size_t)RTOT * 8 * 4);
constexpr size_t WS_LIST = WS_TOPG + AL((size_t)RTOT * 8 * 4);
constexpr size_t WS_SPEC = WS_LIST + AL((size_t)NEXP * RTOT * 4);
constexpr size_t WS_Z1 = WS_SPEC + AL((size_t)256 * 2 * 8192 * 8);
constexpr size_t WS_U = WS_Z1 + AL((size_t)256 * SEQ * 4 * 4);
constexpr size_t WS_Q = WS_U;
constexpr size_t WS_K = WS_Q + AL((size_t)NB * 8 * POS * 64 * 2);
constexpr size_t WS_V = WS_K + AL((size_t)NB * 8 * POS * 64 * 2);
constexpr size_t WS_HYT = WS_V + AL((size_t)NB * 8 * POS * 64 * 2);
constexpr size_t WS_YTL = WS_HYT + AL((size_t)NB * 768 * POS * 4);
constexpr size_t WS_YTC = WS_YTL + AL((size_t)1024 * 8192 * 2);
constexpr size_t WS_MIX = WS_YTC + AL((size_t)1024 * 512 * 2);
constexpr size_t WS_U1_END = WS_MIX + AL((size_t)RTOT * DM * 2);
constexpr size_t WS_ACT = WS_U;
constexpr size_t WS_YB = WS_ACT + AL((size_t)MAXTILES * 256 * DEXP * 2);
constexpr size_t WS_U2_END = WS_YB + AL((size_t)MAXTILES * 256 * DM * 2);
constexpr size_t WS_END = WS_U2_END > WS_U1_END ? WS_U2_END : WS_U1_END;

constexpr int CW_BAR = 0;
constexpr int CW_ATTN = 4096;
constexpr int CW_PREPQ = 4096 + 1024;
constexpr int CW_PREPQ2 = 4096 + 1536;
constexpr int CW_PREPQ3 = 4096 + 2048;
constexpr int CW_PREPQ4 = 4096 + 2560;
constexpr int PREP_SPLIT2 = 2640;
constexpr int PREP_SPLIT = 1200;
constexpr int CW_KMAX = 4096 + 512;
constexpr int CW_CNT = 8192;
constexpr int CNT_STRIDE = 64;

DI unsigned cvt_pk_bf16(float lo, float hi) { unsigned r; asm volatile("v_cvt_pk_bf16_f32 %0, %1, %2" : "=v"(r) : "v"(lo), "v"(hi)); return r; }
DI bf16x8 pack8(float a0, float a1, float a2, float a3, float a4, float a5, float a6, float a7) {
    u32x4 p;
    asm volatile("v_cvt_pk_bf16_f32 %0, %4, %5\n\tv_cvt_pk_bf16_f32 %1, %6, %7\n\tv_cvt_pk_bf16_f32 %2, %8, %9\n\tv_cvt_pk_bf16_f32 %3, %10, %11\n\ts_nop 1"
                 : "=&v"(p[0]), "=&v"(p[1]), "=&v"(p[2]), "=&v"(p[3]) : "v"(a0), "v"(a1), "v"(a2), "v"(a3), "v"(a4), "v"(a5), "v"(a6), "v"(a7));
    return __builtin_bit_cast(bf16x8, p);
}
DI bf16_t f2bf(float x) { return (bf16_t)(cvt_pk_bf16(x, 0.f) & 0xffffu); }
DI float bf2f(unsigned short u) { return __uint_as_float(((unsigned)u) << 16); }
DI float bflo(unsigned w) { return __uint_as_float(w << 16); }
DI float bfhi(unsigned w) { return __uint_as_float(w & 0xffff0000u); }
DI float wave_sum(float v) {
#pragma unroll
    for (int o = 32; o >= 1; o >>= 1) v += __shfl_xor(v, o);
    return v;
}
DI float wave_max(float v) {
#pragma unroll
    for (int o = 32; o >= 1; o >>= 1) v = fmaxf(v, __shfl_xor(v, o));
    return v;
}

#define XB_TMO      128
#define XB_XCNT(j)  (256  + 64 * (j))
#define XB_XSUB(j)  (1280 + 64 * (j))
#define XB_XGEN(j)  (2304 + 64 * (j))
#define XB_TOP      3328
#define XB_TOPGEN   3392
#define XCD_BAR_WORDS 3456
#define XB_SPIN_CAP (1u << 18)

__device__ __forceinline__ unsigned xb_ld(unsigned* p)              { return __hip_atomic_load(p, __ATOMIC_RELAXED, __HIP_MEMORY_SCOPE_AGENT); }
__device__ __forceinline__ unsigned xb_add(unsigned* p, unsigned v) { return __hip_atomic_fetch_add(p, v, __ATOMIC_RELAXED, __HIP_MEMORY_SCOPE_AGENT); }
__device__ __forceinline__ unsigned xb_xcc_id() { return (unsigned)__builtin_amdgcn_s_getreg((3 << 11) | 20) & 0xFu; }
#define XB_SPIN(cond, bar) do { unsigned _sp = 0; while (cond) { __builtin_amdgcn_s_sleep(1); \
    if ((++_sp & 255u) == 0u) { if (xb_ld(&(bar)[XB_TMO])) break; if (_sp > XB_SPIN_CAP) { atomicAdd(&(bar)[XB_TMO], 1u); break; } } } } while (0)

struct XcdBarrier { unsigned* bar; unsigned x; volatile LAS unsigned* st; };

__device__ __forceinline__ XcdBarrier xcd_barrier_post(unsigned* bar, volatile LAS unsigned* st) {
    XcdBarrier b; b.bar = bar; b.x = xb_xcc_id(); b.st = st;
    if (threadIdx.x == 0) (void)xb_add(&bar[XB_XCNT(b.x)], 1u);
    return b;
}
__device__ __forceinline__ void xcd_barrier_complete(unsigned* bar, unsigned x, unsigned& nloc, unsigned& nx) {
    const unsigned G = gridDim.x * gridDim.y * gridDim.z;
    unsigned sum, cnt, mine, sp = 0u;
    for (;;) {
        sum = 0u; cnt = 0u; mine = 0u;
#pragma unroll
        for (unsigned j = 0; j < 16; ++j) { const unsigned c = xb_ld(&bar[XB_XCNT(j)]); sum += c; cnt += (c > 0u) ? 1u : 0u; mine = (j == x) ? c : mine; }
        if (sum == G) break;
        __builtin_amdgcn_s_sleep(1);
        if ((++sp & 255u) == 0u) { if (xb_ld(&bar[XB_TMO])) break; if (sp > XB_SPIN_CAP) { atomicAdd(&bar[XB_TMO], 1u); break; } }
    }
    nloc = mine > 0u ? mine : 1u; nx = cnt > 0u ? cnt : 1u;
}
__device__ __forceinline__ void xcd_barrier(const XcdBarrier& b) {
    asm volatile("s_waitcnt vmcnt(0)" ::: "memory");
    __syncthreads();
    if (threadIdx.x == 0) {
        unsigned* bar = b.bar;
        __builtin_amdgcn_s_waitcnt(0);
        unsigned nloc = b.st[0], nx = b.st[1];
        if (nloc == 0u) { xcd_barrier_complete(bar, b.x, nloc, nx); b.st[0] = nloc; b.st[1] = nx; }
        const unsigned old = xb_add(&bar[XB_XSUB(b.x)], 1u);
        const unsigned gen = old / nloc;
        if (old + 1u == (gen + 1u) * nloc) {
            __builtin_amdgcn_fence(__ATOMIC_RELEASE, "agent");
            asm volatile("s_waitcnt vmcnt(0)" ::: "memory");
            const unsigned og = xb_add(&bar[XB_TOP], 1u);
            const unsigned tg = og / nx;
            if (og + 1u == (tg + 1u) * nx) xb_add(&bar[XB_TOPGEN], 1u);
            else XB_SPIN(xb_ld(&bar[XB_TOPGEN]) == tg, bar);
            __builtin_amdgcn_fence(__ATOMIC_ACQUIRE, "agent");
            xb_add(&bar[XB_XGEN(b.x)], 1u);
            asm volatile("s_waitcnt vmcnt(0)" ::: "memory");
        } else {
            XB_SPIN(xb_ld(&bar[XB_XGEN(b.x)]) == gen, bar);
            __builtin_amdgcn_fence(__ATOMIC_ACQUIRE, "agent");
            asm volatile("s_waitcnt vmcnt(0)" ::: "memory");
        }
    }
    __syncthreads();
}

namespace pg8 {
constexpr int BM = 256, BK = 64, HALF = 128, HTB = HALF * BK * 2, STAGE_BYTES = 8 * HTB, NXCD = 8, WGM = 8;
__host__ __device__ __forceinline__ int lds_byte(int r, int c) { const int st = (r >> 4) * 2 + (c >> 5), rr = r & 15, cc = c & 31, ob = rr * 64 + cc * 2; return st * 1024 + (ob ^ (((ob >> 9) & 1) << 5)); }
__host__ __device__ __forceinline__ void stage_rc(int b, int& R, int& C) { const int st = b / 1024, sb = b % 1024, swz = sb ^ (((sb >> 9) & 1) << 5); R = (st >> 1) * 16 + swz / 64; C = (st & 1) * 32 + (swz % 64) / 2; }
__host__ __device__ __forceinline__ int perm32(int rho) { const int n = rho >> 4, i = rho & 15; return 8 * (i >> 2) + 4 * n + (i & 3); }

struct Unit { int pm, pn, e, lt; };
struct Gemm { const bf16_t* A; const bf16_t* Bt; int K; int tid; };

struct StaticOrder {
    static constexpr bool GATHER = false;
    int nM, nN, nwg, G, c;
    __device__ void init(int nM_, int nN_, int G_, int c_) { nM = nM_; nN = nN_; nwg = nM * nN; G = G_; c = c_; }
    __device__ bool next(int i, Unit& u) const {
        const long L = (long)i * G + c; if (L >= nwg) return false;
        int wgid = (int)L; { const int q = nwg / NXCD, r = nwg % NXCD, xcd = wgid % NXCD, off = wgid / NXCD; wgid = (xcd < r ? xcd * (q + 1) : r * (q + 1) + (xcd - r) * q) + off; }
        const int nig = WGM * nN, gid = wgid / nig, fm = gid * WGM, gsz = (nM - fm) < WGM ? (nM - fm) : WGM;
        u.pm = fm + ((wgid % nig) % gsz); u.pn = (wgid % nig) / gsz; u.e = 0; u.lt = 0; return true;
    }
    __device__ __forceinline__ int arow(const Unit& u, int r) const { return u.pm * BM + r; }
};

template <class Epi, class Sched>
__device__ __forceinline__ void gemm_phase(LAS unsigned char* lds, const Gemm g, const Sched& S, const Epi& E) {
    constexpr bool GA = Sched::GATHER;
    int tid = g.tid; asm volatile("" : "+v"(tid));
    const int wid = __builtin_amdgcn_readfirstlane(tid >> 6), lane = tid & 63, wr = wid >> 2, wc = wid & 3, fr = lane & 15, fq = lane >> 4;
    int K = g.K;
#if PG8_OPAQUE_K
    asm volatile("" : "+s"(K));
#endif
    const int nt = K / BK;
    unsigned voffA[2], voffB[2];
#pragma unroll
    for (int i = 0; i < 2; ++i) { int R, C; stage_rc(tid * 16 + i * 8192, R, C); const int Rb = Epi::PERM ? ((R & ~31) + perm32(R & 31)) : R;
        voffA[i] = (unsigned)(R * K + C) * 2u; voffB[i] = (unsigned)(Rb * K + C) * 2u; }
    const size_t kstep = (size_t)(BK * 2);
    const size_t hstep = (size_t)HALF * K * 2;
    const size_t tstep = 2 * hstep;
    const unsigned ldsw = (unsigned)wid * 1024u;
    const int aoff = lds_byte(wr * 64 + fr, fq * 8), boff = lds_byte(wc * 32 + fr, fq * 8);
#define PG8_SA(b, h) (((b) * 2 + (h)) * HTB)
#define PG8_SB(b, h) ((4 + (b) * 2 + (h)) * HTB)
#define PG8_STAGE(bufoff, gbase, voff) do { _Pragma("unroll") for (int _i = 0; _i < 2; ++_i) \
        __builtin_amdgcn_global_load_lds((const unsigned*)((const char*)(gbase) + (voff)[_i]), (LAS unsigned*)(lds + (bufoff) + ldsw + _i * 8192), 16, 0, 0); } while (0)
#define PG8_STAGEA(bufoff, gbase, o0, o1) do { \
        __builtin_amdgcn_global_load_lds((const unsigned*)((const char*)(gbase) + (o0)), (LAS unsigned*)(lds + (bufoff) + ldsw), 16, 0, 0); \
        __builtin_amdgcn_global_load_lds((const unsigned*)((const char*)(gbase) + (o1)), (LAS unsigned*)(lds + (bufoff) + ldsw + 8192), 16, 0, 0); } while (0)
#define PG8_STA(bufoff, sp, gp, o0, o1) do { if constexpr (GA) PG8_STAGEA(bufoff, gp, o0, o1); else PG8_STAGE(bufoff, sp, voffA); } while (0)
#define PG8_LDA(dst, b, h) do { _Pragma("unroll") for (int m = 0; m < 4; ++m) _Pragma("unroll") for (int k = 0; k < 2; ++k) dst[m][k] = *(const LAS bf16x8*)(lds + PG8_SA(b, h) + aoff + m * 2048 + k * 1024); } while (0)
#define PG8_LDB(dst, b, h) do { _Pragma("unroll") for (int n = 0; n < 2; ++n) _Pragma("unroll") for (int k = 0; k < 2; ++k) dst[n][k] = *(const LAS bf16x8*)(lds + PG8_SB(b, h) + boff + n * 2048 + k * 1024); } while (0)
#define PG8_MMA(ai, bj, At, Bt) do { __builtin_amdgcn_s_setprio(1); _Pragma("unroll") for (int m = 0; m < 4; ++m) _Pragma("unroll") for (int n = 0; n < 2; ++n) _Pragma("unroll") for (int k = 0; k < 2; ++k) \
        acc[ai][bj][m][n] = __builtin_amdgcn_mfma_f32_16x16x32_bf16(Bt[n][k], At[m][k], acc[ai][bj][m][n], 0, 0, 0); __builtin_amdgcn_s_setprio(0); } while (0)
#define PG8_WAIT_V(n) asm volatile("s_waitcnt vmcnt(" #n ")" ::: "memory")
#define PG8_WAIT_L(n) asm volatile("s_waitcnt lgkmcnt(" #n ")" ::: "memory")
#define PG8_BAR __builtin_amdgcn_s_barrier()
#define PG8_SCHED __builtin_amdgcn_sched_barrier(0)
#define PG8_GOFF(u, o00, o01, o10, o11) do { int _tz = g.tid; asm volatile("" : "+v"(_tz)); int _R0, _C0, _R1, _C1; stage_rc(_tz * 16, _R0, _C0); stage_rc(_tz * 16 + 8192, _R1, _C1); \
        o00 = (unsigned)(S.arow(u, _R0) * K + _C0) * 2u; o01 = (unsigned)(S.arow(u, _R1) * K + _C1) * 2u; \
        o10 = (unsigned)(S.arow(u, HALF + _R0) * K + _C0) * 2u; o11 = (unsigned)(S.arow(u, HALF + _R1) * K + _C1) * 2u; } while (0)
    Unit cur, nxt; int ui = 0;
    if (!S.next(0, cur)) return;
    f32x4 acc[2][2][4][2];
#pragma unroll
    for (int a = 0; a < 2; ++a)
#pragma unroll
        for (int b = 0; b < 2; ++b)
#pragma unroll
            for (int m = 0; m < 4; ++m)
#pragma unroll
                for (int n = 0; n < 2; ++n) acc[a][b][m][n] = (f32x4){0.f, 0.f, 0.f, 0.f};
    bf16x8 At[4][2], B0[2][2], B1[2][2];
    const char* const gA = (const char*)g.A;
    unsigned c00 = 0, c01 = 0, c10 = 0, c11 = 0, n00 = 0, n01 = 0, n10 = 0, n11 = 0;
    if constexpr (GA) PG8_GOFF(cur, c00, c01, c10, c11);
    const char* cA = gA + (GA ? (size_t)0 : (size_t)cur.pm * tstep); const char* cB = (const char*)g.Bt + (size_t)cur.pn * tstep;
    PG8_STAGE(PG8_SB(0, 0), cB, voffB); PG8_STAGE(PG8_SB(0, 1), cB + hstep, voffB); PG8_STA(PG8_SA(0, 0), cA, gA, c00, c01); PG8_STA(PG8_SA(0, 1), cA + hstep, gA, c10, c11);
    if (wr == 1) PG8_BAR;
    PG8_WAIT_V(2); PG8_BAR;
    PG8_STAGE(PG8_SB(1, 0), cB + kstep, voffB); PG8_STA(PG8_SA(1, 0), cA + kstep, gA + kstep, c00, c01); PG8_STAGE(PG8_SB(1, 1), cB + hstep + kstep, voffB);
    PG8_WAIT_V(6); PG8_BAR;
    for (;;) {
        const bool has_next = S.next(ui + 1, nxt);
        const char* nA = (has_next && !GA) ? gA + (size_t)nxt.pm * tstep : cA; const char* nB = has_next ? (const char*)g.Bt + (size_t)nxt.pn * tstep : cB;
        if constexpr (GA) { if (has_next) PG8_GOFF(nxt, n00, n01, n10, n11); else { n00 = c00; n01 = c01; n10 = c10; n11 = c11; } }
#pragma unroll 1
        for (int t = 0; t < nt; t += 2) {
            const bool last = (t == nt - 2);
            const char* a1 = cA + (size_t)(t + 1) * kstep;
            const char* a2 = last ? nA : cA + (size_t)(t + 2) * kstep; const char* b2 = last ? nB : cB + (size_t)(t + 2) * kstep;
            const char* a3 = a2 + kstep; const char* b3 = b2 + kstep;
            unsigned x00 = 0, x01 = 0, x10 = 0, x11 = 0;
            if constexpr (GA) { x00 = last ? n00 : c00; x01 = last ? n01 : c01; x10 = last ? n10 : c10; x11 = last ? n11 : c11; }
            PG8_LDB(B0, 0, 0); PG8_LDB(B1, 0, 1); PG8_SCHED; PG8_LDA(At, 0, 0); PG8_STA(PG8_SA(1, 1), a1 + hstep, a1, c10, c11);
            PG8_WAIT_V(8); PG8_WAIT_L(0); PG8_BAR; PG8_MMA(0, 0, At, B0); PG8_MMA(0, 1, At, B1); PG8_BAR; PG8_SCHED;
            PG8_LDA(At, 0, 1); PG8_STAGE(PG8_SB(0, 0), b2, voffB); PG8_STAGE(PG8_SB(0, 1), b2 + hstep, voffB); PG8_STA(PG8_SA(0, 0), a2, a2, x00, x01);
            PG8_WAIT_V(8); PG8_WAIT_L(0); PG8_BAR; PG8_MMA(1, 0, At, B0); PG8_MMA(1, 1, At, B1); PG8_BAR; PG8_SCHED;
            PG8_LDB(B0, 1, 0); PG8_LDB(B1, 1, 1); PG8_SCHED; PG8_LDA(At, 1, 0); PG8_STA(PG8_SA(0, 1), a2 + hstep, a2, x10, x11);
            PG8_WAIT_V(8); PG8_WAIT_L(0); PG8_BAR; PG8_MMA(0, 0, At, B0); PG8_MMA(0, 1, At, B1); PG8_BAR; PG8_SCHED;
            PG8_LDA(At, 1, 1); PG8_STAGE(PG8_SB(1, 0), b3, voffB); PG8_STAGE(PG8_SB(1, 1), b3 + hstep, voffB); PG8_STA(PG8_SA(1, 0), a3, a3, x00, x01);
            PG8_WAIT_V(8); PG8_WAIT_L(0); PG8_BAR; PG8_MMA(1, 0, At, B0); PG8_MMA(1, 1, At, B1); PG8_BAR; PG8_SCHED;
        }
#if PG8_ALIGN
        if (wr == 0) PG8_BAR;
#endif
        { int ln = (int)__builtin_amdgcn_mbcnt_hi(~0u, __builtin_amdgcn_mbcnt_lo(~0u, 0u)); asm volatile("" : "+v"(ln));
          E(acc, cur, wr, wc, ln & 15, ln >> 4); }
        if (!has_next) break;
#pragma unroll
        for (int a = 0; a < 2; ++a)
#pragma unroll
            for (int b = 0; b < 2; ++b)
#pragma unroll
                for (int m = 0; m < 4; ++m)
#pragma unroll
                    for (int n = 0; n < 2; ++n) acc[a][b][m][n] = (f32x4){0.f, 0.f, 0.f, 0.f};
        cur = nxt; cA = nA; cB = nB; ++ui;
        if constexpr (GA) { c00 = n00; c01 = n01; c10 = n10; c11 = n11; }
#if PG8_ALIGN
        if (wr == 1) PG8_BAR;
#endif
    }
    PG8_WAIT_V(0);
#if !PG8_ALIGN
    if (wr == 0) PG8_BAR;
#endif
    PG8_BAR;
#undef PG8_SA
#undef PG8_SB
#undef PG8_STAGE
#undef PG8_STAGEA
#undef PG8_STA
#undef PG8_GOFF
#undef PG8_LDA
#undef PG8_LDB
#undef PG8_MMA
#undef PG8_WAIT_V
#undef PG8_WAIT_L
#undef PG8_BAR
#undef PG8_SCHED
}
}

constexpr int NTHR = 512;
constexpr int LDS_SCRATCH = 139264;
constexpr int LDS_MISC = LDS_SCRATCH;
constexpr int LDS_TAB = LDS_MISC + 256;
constexpr int LDS_BYTES = LDS_TAB + 8192;

struct Params { const float* in[34]; float* out; unsigned char* ws; int ph_lo, ph_hi; };

struct Frame {
    const float* const* in; float* out; unsigned char* ws; LAS unsigned char* lds; unsigned* ctl;
    int tid, lane, wave, G, bid;
};

DI int row_b(int row) { return row < RLAT ? (row >> 12) : ((row - RLAT) >> 8); }
DI int row_pos(int row) { return row < RLAT ? (row & 4095) : (SEQ + ((row - RLAT) & 255)); }
DI int row_modsel(int row) { return row < RLAT ? (row >> 12) : 4; }

DI Frame relaunder(const Frame& F0) {
    Frame F = F0; int wv = F0.wave; asm volatile("" : "+s"(wv));
    int ln = (int)__builtin_amdgcn_mbcnt_hi(~0u, __builtin_amdgcn_mbcnt_lo(~0u, 0u)); asm volatile("" : "+v"(ln));
    F.wave = wv; F.lane = ln; F.tid = wv * 64 + ln;
    __attribute__((address_space(1))) unsigned char* w = (__attribute__((address_space(1))) unsigned char*)F0.ws; asm volatile("" : "+s"(w)); F.ws = (unsigned char*)w;
    F.ctl = (unsigned*)(F.ws + WS_CTL);
    int b = F0.bid, g = F0.G; asm volatile("" : "+s"(b), "+s"(g)); F.bid = b; F.G = g;
    return F;
}

DI void prep_fourier_job(const Frame& F, int ly, int g, int kt) {
    LAS float* FW = (LAS float*)F.lds;
    LAS float* CS = FW + 4096;
    LAS float* P = CS + 128;
    LAS float* W = P + 8192;
    const int t = F.tid;
    const float* fw = F.in[21] + ((size_t)ly * 4 + g) * 4096;
    for (int i = t; i < 4096; i += NTHR) FW[i] = fw[i];
    if (t < 64) { float s, c; sincospif((float)t / 32.0f, &s, &c); CS[t] = c; CS[64 + t] = s; }
    { const float* p = F.in[6] + (size_t)ly * DM * DIN + (size_t)(kt * 64 + (t >> 3)) * DIN + 2304 + g * 64 + (t & 7) * 8;
      const f32x4 a = *(const f32x4*)p, b = *(const f32x4*)(p + 4);
      LAS float* q = W + (t >> 3) * 65 + (t & 7) * 8;
      q[0] = a[0]; q[1] = a[1]; q[2] = a[2]; q[3] = a[3]; q[4] = b[0]; q[5] = b[1]; q[6] = b[2]; q[7] = b[3]; }
    __syncthreads();
    for (int i = t; i < 8192; i += NTHR) {
        const int c = i >> 7, n = i & 127, comp = n >> 6, d = n & 63;
        float s = 0.f;
        for (int j = 0; j < 64; ++j) { const int a = (j * c) & 63; const float tr = comp ? -CS[64 + a] : CS[a]; s += tr * FW[j * 64 + d]; }
        P[c * 128 + n] = s;
    }
    __syncthreads();
    bf16_t* dst = (bf16_t*)(F.ws + WS_WIN);
    { const int k = t >> 3, nb = (t & 7) * 16;
      float o[16];
#pragma unroll
      for (int j = 0; j < 16; ++j) o[j] = 0.f;
      for (int c = 0; c < 64; ++c) { const float w = W[k * 65 + c];
#pragma unroll
          for (int j = 0; j < 16; ++j) o[j] += w * P[c * 128 + nb + j]; }
#pragma unroll
      for (int j = 0; j < 16; ++j) { const int n = nb + j, comp = n >> 6, d = n & 63;
          dst[(size_t)(2304 + comp * 256 + g * 64 + d) * DM + kt * 64 + k] = f2bf(o[j]); } }
    __syncthreads();
}

struct PrepJob { const float* src; bf16_t* dst; int ldn, ldk, row0, hi_step; };
DI PrepJob prep_job(const Frame& F, int ly, int j) {
    constexpr int J1 = 144, J2 = J1 + 64, J3 = J2 + 1040, J4 = J3 + 1040;
    PrepJob r;
    if (j < J1) { const int kb = j / 9, nb = j % 9;
        r.src = F.in[6] + (size_t)ly * DM * DIN + (size_t)kb * 64 * DIN + nb * 256; r.ldn = DIN; r.dst = (bf16_t*)(F.ws + WS_WIN) + kb * 64; r.ldk = DM; r.row0 = nb * 256; r.hi_step = 128;
    } else if (j < J2) { const int q = j - J1, kb = q >> 2, nb = q & 3;
        r.src = F.in[7] + (size_t)ly * DM * DM + (size_t)kb * 64 * DM + nb * 256; r.ldn = DM; r.dst = (bf16_t*)(F.ws + WS_WOUT) + kb * 64; r.ldk = DM; r.row0 = nb * 256; r.hi_step = 128;
    } else if (j < J4) { const bool up = j >= J3; const int q = j - (up ? J3 : J2), e = q >> 4, kb = q & 15;
        const float* src = e < NEXP ? F.in[up ? 29 : 28] + ((size_t)ly * NEXP + e) * DM * DEXP : F.in[up ? 32 : 31] + (size_t)ly * DM * DEXP;
        r.src = src + (size_t)kb * 64 * DEXP; r.ldn = DEXP; r.dst = (bf16_t*)(F.ws + WS_WGU) + kb * 64; r.ldk = DM; r.row0 = e * 512 + (up ? 128 : 0); r.hi_step = 256;
    } else { const int q = j - J4, e = q >> 4, kb = (q >> 2) & 3, nb = q & 3;
        const float* src = e < NEXP ? F.in[30] + ((size_t)ly * NEXP + e) * DEXP * DM : F.in[33] + (size_t)ly * DEXP * DM;
        r.src = src + (size_t)kb * 64 * DM + nb * 256; r.ldn = DM; r.dst = (bf16_t*)(F.ws + WS_WD) + kb * 64; r.ldk = DEXP; r.row0 = e * DM + nb * 256; r.hi_step = 128; }
    return r;
}
DI void prep_load(const Frame& F, const PrepJob& jb, f32x4 (&v)[8]) {
    const float* p = jb.src + (size_t)(8 * (F.tid >> 6)) * jb.ldn + 4 * (F.tid & 63);
#pragma unroll
    for (int i = 0; i < 8; ++i) v[i] = __builtin_nontemporal_load((const f32x4*)(p + (size_t)i * jb.ldn));
}
DI void prep_store(const Frame& F, const PrepJob& jb, const f32x4 (&v)[8]) {
    LAS unsigned char* T = F.lds;
    const int t = F.tid, ln = t & 63, w = t >> 6;
#pragma unroll
    for (int pr = 0; pr < 4; ++pr)
#pragma unroll
        for (int e = 0; e < 4; ++e) *(LAS unsigned*)(T + (4 * ln + e) * 132 + (8 * w + 2 * pr) * 2) = cvt_pk_bf16(v[2 * pr][e], v[2 * pr + 1][e]);
    asm volatile("s_waitcnt lgkmcnt(0)" ::: "memory"); __builtin_amdgcn_s_barrier();
#pragma unroll
    for (int q = 0; q < 4; ++q) { const int n = q * 64 + (t >> 3), ch = t & 7;
        const LAS unsigned* r = (const LAS unsigned*)(T + n * 132 + ch * 16);
        u32x4 o; o.x = r[0]; o.y = r[1]; o.z = r[2]; o.w = r[3];
        *(u32x4*)(jb.dst + (size_t)(jb.row0 + (n >> 7) * jb.hi_step + (n & 127)) * jb.ldk + ch * 8) = o; }
    asm volatile("s_waitcnt lgkmcnt(0)" ::: "memory"); __builtin_amdgcn_s_barrier();
}
DI void prep_small(const Frame& F, int ly) {
    for (int j = F.bid; j < 208; j += F.G) { const PrepJob jb = prep_job(F, ly, j); f32x4 v[8]; prep_load(F, jb, v); prep_store(F, jb, v); }
    for (int q = F.G - 1 - F.bid; q < 64; q += F.G) prep_fourier_job(F, ly, q >> 4, q & 15);
}
DI void prep_small_dyn(const Frame& F0, int ly) {
    const Frame F = relaunder(F0);
    volatile LAS unsigned* MISC = (volatile LAS unsigned*)(F.lds + LDS_MISC);
    for (;;) {
        __syncthreads();
        if (F.tid == 0) MISC[18] = atomicAdd(F.ctl + CW_PREPQ3 + 64 * ly, 1u);
        __syncthreads();
        const int j = (int)MISC[18];
        if (j >= 272) break;
        if (j < 64) prep_fourier_job(F, ly, j >> 4, j & 15);
        else { const PrepJob jb = prep_job(F, ly, j - 64); f32x4 v[8]; prep_load(F, jb, v); prep_store(F, jb, v); }
    }
}
constexpr int PREP_CHUNK = 2, PREP_NJOBS = 3 * 1040;
DI void prep_experts(const Frame& F0, int ly, int cw, int j_lo, int j_hi) {
    const Frame F = relaunder(F0);
    volatile LAS unsigned* MISC = (volatile LAS unsigned*)(F.lds + LDS_MISC);
    for (;;) {
        __syncthreads();
        if (F.tid == 0) MISC[17] = atomicAdd(F.ctl + cw + 64 * ly, (unsigned)PREP_CHUNK);
        __syncthreads();
        const int base = j_lo + (int)MISC[17];
        if (base >= j_hi) break;
        const int end = base + PREP_CHUNK < j_hi ? base + PREP_CHUNK : j_hi;
        int j = base;
        PrepJob cur = prep_job(F, ly, 208 + j); f32x4 va[8]; prep_load(F, cur, va);
#pragma unroll 1
        for (;;) {
            const int jn = j + 1; const bool more = jn < end;
            PrepJob nxt = cur; f32x4 vb[8];
            if (more) { nxt = prep_job(F, ly, 208 + jn); prep_load(F, nxt, vb); }
            prep_store(F, cur, va);
            if (!more) break;
            cur = nxt; j = jn;
#pragma unroll
            for (int i = 0; i < 8; ++i) va[i] = vb[i];
        }
    }
}

DI void prep_mod(const Frame& F) {
    LAS float* S = (LAS float*)F.lds;
    LAS float* RED = S + 5 * 1024;
    const int t = F.tid;
    bool have_s = false;
    for (int u = F.bid; u < DEPTH * 96; u += F.G) {
        const int ly = u / 96, cg = u % 96;
        if (!have_s) {
            for (int i = t; i < 5 * 1024; i += NTHR) { const int r = i >> 10, k = i & 1023; const float x = r < 4 ? F.in[1][r * DM + k] : F.in[3][k]; S[i] = x / (1.f + expf(-x)); }
            __syncthreads(); have_s = true;
        }
        const int tq = t & 15, tk = t >> 4;
        const float* w = F.in[4] + (size_t)ly * DM * 6144 + cg * 64 + tq * 4;
        f32x4 acc[5];
#pragma unroll
        for (int r = 0; r < 5; ++r) acc[r] = (f32x4){0.f, 0.f, 0.f, 0.f};
#pragma unroll 1
        for (int k8 = 0; k8 < 32; k8 += 8) { f32x4 wv[8];
#pragma unroll
            for (int q = 0; q < 8; ++q) wv[q] = *(const f32x4*)(w + (size_t)(tk * 32 + k8 + q) * 6144);
#pragma unroll
            for (int q = 0; q < 8; ++q)
#pragma unroll
                for (int r = 0; r < 5; ++r) acc[r] += wv[q] * S[r * 1024 + tk * 32 + k8 + q]; }
#pragma unroll
        for (int r = 0; r < 5; ++r)
#pragma unroll
            for (int j = 0; j < 4; ++j) RED[(tk * 5 + r) * 64 + tq * 4 + j] = acc[r][j];
        __syncthreads();
        if (t < 320) { const int r = t >> 6, c = t & 63; float s = 0.f;
            for (int q = 0; q < 32; ++q) s += RED[(q * 5 + r) * 64 + c];
            const int col = cg * 64 + c;
            ((float*)(F.ws + WS_MOD))[((size_t)ly * 5 + r) * 6144 + col] = s + F.in[5][(size_t)ly * 6144 + col]; }
        __syncthreads();
    }
}

DI void prep_filters(const Frame& F) {
    LAS float* Z = (LAS float*)F.lds;
    LAS float* A1 = Z + 64 * 33;
    LAS float* A2 = A1 + 4096;
    for (int u = F.G - 1 - F.bid; u < DEPTH * 68; u += F.G) {
        int t = F.tid; asm volatile("" : "+v"(t));
        const int ly = u / 68, ch = u % 68; const bool lat = ch < 64; const int Lx = lat ? SEQ : CTXL, t0 = lat ? ch * 64 : (ch - 64) * 64;
        for (int i = t; i < 64 * 33; i += NTHR) { const int tt = i / 33, f = i % 33; const int ti = t0 + tt;
            float v;
            if (f == 0) v = (float)ti / (float)(Lx - 1);
            else { const int j = (f - 1) & 15; const float fb = 1e-4f + (float)j * ((15.0f - 1e-4f) / 15.0f); const float om = (6.283185307179586f / (float)Lx) * (float)ti;
                   v = f <= 16 ? cosf(fb * om) : -sinf(fb * om); }
            Z[i] = v; }
        __syncthreads();
        const float* w1 = F.in[9] + (size_t)ly * 33 * 64; const float* b1 = F.in[10] + ly * 64; const float* w2 = F.in[11] + (size_t)ly * 4096; const float* b2 = F.in[12] + ly * 64;
        const float* w3 = F.in[13] + (size_t)ly * 64 * 1024; const float* fq = F.in[14] + ly * 64;
        for (int i = t; i < 4096; i += NTHR) { const int tt = i >> 6, h = i & 63; float s = b1[h];
            for (int f = 0; f < 33; ++f) s += Z[tt * 33 + f] * w1[f * 64 + h];
            A1[i] = sinf(fq[h] * s); }
        __syncthreads();
        for (int i = t; i < 4096; i += NTHR) { const int tt = i >> 6, h = i & 63; float s = b2[h];
            for (int j = 0; j < 64; ++j) s += A1[tt * 64 + j] * w2[j * 64 + h];
            A2[i] = sinf(fq[h] * s); }
        __syncthreads();
        { float wr0[64], wr1[64];
#pragma unroll
          for (int j = 0; j < 64; ++j) { wr0[j] = w3[j * 1024 + t]; wr1[j] = w3[j * 1024 + 512 + t]; }
          const int c = t & 255, dir = t >> 8;
          const float delta = fabsf(-3.0701134573253946f + (float)c * ((-15.350567286626973f + 3.0701134573253946f) / 255.0f));
          float* d0 = lat ? (float*)(F.ws + WS_HCL) + ((((size_t)ly * 2 + 0) * 2 + dir) * 256 + c) * SEQ + t0 : (float*)(F.ws + WS_HCC) + ((((size_t)ly * 2 + 0) * 2 + dir) * 256 + c) * CTXL + t0;
          float* d1 = lat ? (float*)(F.ws + WS_HCL) + ((((size_t)ly * 2 + 1) * 2 + dir) * 256 + c) * SEQ + t0 : (float*)(F.ws + WS_HCC) + ((((size_t)ly * 2 + 1) * 2 + dir) * 256 + c) * CTXL + t0;
#pragma unroll 1
          for (int tt = 0; tt < 64; ++tt) { float s0 = 0.f, s1 = 0.f;
#pragma unroll
            for (int j = 0; j < 64; j += 4) { const f32x4 a = *(const LAS f32x4*)(A2 + tt * 64 + j);
                s0 += a[0] * wr0[j] + a[1] * wr0[j + 1] + a[2] * wr0[j + 2] + a[3] * wr0[j + 3]; s1 += a[0] * wr1[j] + a[1] * wr1[j + 1] + a[2] * wr1[j + 2] + a[3] * wr1[j + 3];
                if ((j & 12) == 12) asm volatile("" ::: "memory"); }
            const float dec = expf(-((float)(t0 + tt) / (float)(Lx - 1)) * delta);
            d0[tt] = s0 * dec; d1[tt] = s1 * dec; } }
        __syncthreads();
    }
}

DI void prep_tables(const Frame& F) {
    LAS float* CT = (LAS float*)F.lds;
    const int t = F.tid;
    for (int i = t; i < 4096; i += NTHR) CT[i] = cospif((float)i / 2048.0f);
    __syncthreads();
    bf16_t* DC = (bf16_t*)(F.ws + WS_DFTC);
    for (int i = F.bid * NTHR + t; i < CTXL * 512; i += F.G * NTHR) { const int k = i >> 9, cl = i & 511, comp = cl >> 8, l = cl & 255;
        const int idx = ((k * l) & 255) * 16; DC[i] = f2bf((comp ? CT[(idx - 1024) & 4095] : CT[idx]) * (1.0f / 128.0f)); }
    if (F.bid == (F.G > 1 ? 1 : 0) && t < DEPTH) { const int ly = t; const float lam_init = 0.8f - 0.6f * expf(-0.3f * (float)ly); float s1 = 0.f, s2 = 0.f;
        for (int i = 0; i < 32; ++i) { s1 += F.in[16][ly * 32 + i] * F.in[17][ly * 32 + i]; s2 += F.in[18][ly * 32 + i] * F.in[19][ly * 32 + i]; }
        ((float*)(F.ws + WS_LAM))[2 * ly] = expf(s1) - expf(s2) + lam_init; ((float*)(F.ws + WS_LAM))[2 * ly + 1] = lam_init; }
    if (F.bid == 0) { float* RT = (float*)(F.ws + WS_ROPE);
        for (int i = t; i < 512; i += NTHR) { const int p = i >> 3, n = i & 7; const float inv = powf(10000.0f, -(float)n / 8.0f); float s, c; sincosf((float)p * inv, &s, &c); RT[i * 2] = c; RT[i * 2 + 1] = s; } }
    __syncthreads();
}

DI void prep_invl1(const Frame& F) {
    const int gw = F.bid * 8 + F.wave, nw = F.G * 8;
    for (int j = gw; j < DEPTH * 2 * 2 * 256; j += nw) {
        const int ly = j >> 10, lt = (j >> 9) & 1, n = (j >> 8) & 1, c = j & 255;
        const int Lx = lt ? CTXL : SEQ;
        const float* base = lt ? (const float*)(F.ws + WS_HCC) : (const float*)(F.ws + WS_HCL);
        const f32x4* f0 = (const f32x4*)(base + ((((size_t)ly * 2 + n) * 2 + 0) * 256 + c) * Lx);
        const f32x4* f1 = (const f32x4*)(base + ((((size_t)ly * 2 + n) * 2 + 1) * 256 + c) * Lx);
        float s = 0.f;
        if (lt) { const f32x4 a = f0[F.lane], b = f1[F.lane];
            s = fabsf(a[0]) + fabsf(a[1]) + fabsf(a[2]) + fabsf(a[3]) + (F.lane == 0 ? 0.f : fabsf(b[0])) + fabsf(b[1]) + fabsf(b[2]) + fabsf(b[3]);
        } else { f32x4 a[16], b[16];
#pragma unroll
            for (int q = 0; q < 16; ++q) { a[q] = f0[F.lane + 64 * q]; b[q] = f1[F.lane + 64 * q]; }
#pragma unroll
            for (int q = 0; q < 16; ++q) s += fabsf(a[q][0]) + fabsf(a[q][1]) + fabsf(a[q][2]) + fabsf(a[q][3]) + ((q == 0 && F.lane == 0) ? 0.f : fabsf(b[q][0])) + fabsf(b[q][1]) + fabsf(b[q][2]) + fabsf(b[q][3]); }
        s = wave_sum(s);
        if (F.lane == 0) ((float*)(F.ws + WS_INVL1))[j] = 1.0f / s;
    }
}

DI void ln_stats(const f32x4 (&v)[4], float& mu, float& rstd) {
    float s = 0.f;
#pragma unroll
    for (int j = 0; j < 4; ++j) s += (v[j][0] + v[j][1]) + (v[j][2] + v[j][3]);
    mu = wave_sum(s) * (1.0f / DM);
    float q = 0.f;
#pragma unroll
    for (int j = 0; j < 4; ++j)
#pragma unroll
        for (int e = 0; e < 4; ++e) { const float d = v[j][e] - mu; q += d * d; }
    rstd = rsqrtf(wave_sum(q) * (1.0f / DM) + LN_EPS);
}
DI void ln_mod_store(const f32x4 (&v)[4], const float* sh, const float* sc, bf16_t* hrow, int lane) {
    float mu, rstd; ln_stats(v, mu, rstd);
#pragma unroll
    for (int j = 0; j < 4; ++j) { const int c = 4 * lane + 256 * j; const f32x4 a = *(const f32x4*)(sh + c), b = *(const f32x4*)(sc + c);
        float o[4];
#pragma unroll
        for (int e = 0; e < 4; ++e) o[e] = (v[j][e] - mu) * rstd * (1.f + b[e]) + a[e];
        u32x2 w; w.x = cvt_pk_bf16(o[0], o[1]); w.y = cvt_pk_bf16(o[2], o[3]); *(u32x2*)(hrow + c) = w; }
}

DI void phase_init_h(const Frame& F) {
    const int gw = F.bid * 8 + F.wave, nw = F.G * 8;
    const float* MOD = (const float*)(F.ws + WS_MOD);
    for (int row = gw; row < RTOT; row += nw) {
        const float* xr = row < RLAT ? F.in[0] + (size_t)row * DM : F.in[2] + (size_t)(row - RLAT) * DM;
        f32x4 v[4];
#pragma unroll
        for (int j = 0; j < 4; ++j) v[j] = *(const f32x4*)(xr + 4 * F.lane + 256 * j);
        const float* m = MOD + (size_t)(0 * 5 + row_modsel(row)) * 6144;
        ln_mod_store(v, m, m + 1024, (bf16_t*)(F.ws + WS_H) + (size_t)row * DM, F.lane);
    }
}

struct EpiWin {
    static constexpr bool PERM = true;
    unsigned char* ws; int ly;
    DI void operator()(const f32x4 (&acc)[2][2][4][2], const pg8::Unit& u, int wr, int wc, int fr, int fq) const {
        const bool lat = u.pm < 64; const int b = lat ? (u.pm >> 4) : (u.pm - 64); const int pos0 = lat ? ((u.pm & 15) << 8) : SEQ;
        const int pn = u.pn;
        const float* RT = (const float*)(ws + WS_ROPE);
        float kn[2] = {0.f, 0.f};
#pragma unroll
        for (int ai = 0; ai < 2; ++ai)
#pragma unroll
            for (int m = 0; m < 4; ++m) {
                const int pos = pos0 + ai * 128 + wr * 64 + m * 16 + fr;
#pragma unroll
                for (int bj = 0; bj < 2; ++bj) {
                    const int col = pn * 256 + bj * 128 + wc * 32 + fq * 8;
                    float v[8];
#pragma unroll
                    for (int e = 0; e < 4; ++e) { v[e] = acc[ai][bj][m][0][e]; v[4 + e] = acc[ai][bj][m][1][e]; }
                    if (pn < 3) {
                        float* d = (float*)(ws + WS_HYT) + ((size_t)b * 768 + col) * POS + pos;
#pragma unroll
                        for (int e = 0; e < 8; ++e) d[(size_t)e * POS] = v[e];
                    } else if (pn < 7) {
                        const bool isq = pn < 5; const int cq = col - (isq ? 768 : 1280); const int head = cq >> 6, cc = cq & 63;
                        if (lat) { const int axis = (cc >> 4) & 1, n0 = (cc & 15) >> 1; const int pa = axis ? (pos & 63) : (pos >> 6);
                            const float* rt = RT + (pa * 8 + n0) * 2;
#pragma unroll
                            for (int p = 0; p < 4; ++p) { const float cs = rt[2 * p], sn = rt[2 * p + 1]; const float a = v[2 * p], bb = v[2 * p + 1];
                                v[2 * p] = a * cs - bb * sn; v[2 * p + 1] = a * sn + bb * cs; } }
                        if (isq) {
#pragma unroll
                            for (int e = 0; e < 8; ++e) v[e] *= QSCALE; }
                        u32x4 w; w.x = cvt_pk_bf16(v[0], v[1]); w.y = cvt_pk_bf16(v[2], v[3]); w.z = cvt_pk_bf16(v[4], v[5]); w.w = cvt_pk_bf16(v[6], v[7]);
                        bf16_t* d = (bf16_t*)(ws + (isq ? WS_Q : WS_K)) + (((size_t)b * 8 + head) * POS + pos) * 64 + cc;
                        *(u32x4*)d = w;
                        if (!isq) {
                            float s2 = bflo(w.x) * bflo(w.x) + bfhi(w.x) * bfhi(w.x) + bflo(w.y) * bflo(w.y) + bfhi(w.y) * bfhi(w.y) + bflo(w.z) * bflo(w.z) + bfhi(w.z) * bfhi(w.z) + bflo(w.w) * bflo(w.w) + bfhi(w.w) * bfhi(w.w);
                            s2 += __shfl_xor(s2, 16); s2 += __shfl_xor(s2, 32);
                            kn[bj] = fmaxf(kn[bj], s2); }
                    } else if (pn < 9) {
                        const int cv = col - 1792; const int head = cv >> 6, cc = cv & 63;
                        u32x4 w; w.x = cvt_pk_bf16(v[0], v[1]); w.y = cvt_pk_bf16(v[2], v[3]); w.z = cvt_pk_bf16(v[4], v[5]); w.w = cvt_pk_bf16(v[6], v[7]);
                        *(u32x4*)((bf16_t*)(ws + WS_V) + (((size_t)b * 8 + head) * POS + pos) * 64 + cc) = w;
                    } else {
                        const int cy = col - 2304; const int comp = cy >> 8, gd = cy & 255;
                        if (lat) { bf16_t* d = (bf16_t*)(ws + WS_YTL) + ((size_t)b * 256 + gd) * 8192 + comp * 4096 + pos;
#pragma unroll
                            for (int e = 0; e < 8; ++e) d[(size_t)e * 8192] = f2bf(v[e]);
                        } else { bf16_t* d = (bf16_t*)(ws + WS_YTC) + ((size_t)b * 256 + gd) * 512 + comp * 256 + (pos - SEQ);
#pragma unroll
                            for (int e = 0; e < 8; ++e) d[(size_t)e * 512] = f2bf(v[e]); }
                    }
                }
            }
        if (pn == 5 || pn == 6) {
#pragma unroll
            for (int bj = 0; bj < 2; ++bj) { float m = kn[bj];
                m = fmaxf(m, __shfl_xor(m, 1)); m = fmaxf(m, __shfl_xor(m, 2)); m = fmaxf(m, __shfl_xor(m, 4)); m = fmaxf(m, __shfl_xor(m, 8));
                const int cq = pn * 256 + bj * 128 + wc * 32 - 1280; const int head = cq >> 6, comp = (cq >> 5) & 1;
                if (fr == 0 && fq == 0) atomicMax((unsigned*)(ws + WS_CTL) + CW_KMAX + 64 * ly + (b * 8 + head) * 2 + comp, __float_as_uint(m)); }
        }
    }
};

struct EpiFnet {
    static constexpr bool PERM = true;
    unsigned char* ws; int ctx;
    DI void operator()(const f32x4 (&acc)[2][2][4][2], const pg8::Unit& u, int wr, int wc, int fr, int fq) const {
        const int b = u.pn;
#pragma unroll
        for (int ai = 0; ai < 2; ++ai)
#pragma unroll
            for (int m = 0; m < 4; ++m) {
                const int k = u.pm * 256 + ai * 128 + wr * 64 + m * 16 + fr;
                const size_t row = ctx ? (size_t)(RLAT + b * CTXL + k) : (size_t)(b * SEQ + k);
#pragma unroll
                for (int bj = 0; bj < 2; ++bj) { const int gd = bj * 128 + wc * 32 + fq * 8;
                    const f32x4 v0 = acc[ai][bj][m][0], v1 = acc[ai][bj][m][1];
                    u32x4 w; w.x = cvt_pk_bf16(v0[0], v0[1]); w.y = cvt_pk_bf16(v0[2], v0[3]); w.z = cvt_pk_bf16(v1[0], v1[1]); w.w = cvt_pk_bf16(v1[2], v1[3]);
                    *(u32x4*)((bf16_t*)(ws + WS_MIX) + row * DM + 768 + gd) = w; }
            }
    }
};

struct EpiWout {
    static constexpr bool PERM = false;
    unsigned char* ws; int ly; const float* xlat; const float* xctx;
    DI void operator()(const f32x4 (&acc)[2][2][4][2], const pg8::Unit& u, int wr, int wc, int fr, int fq) const {
        const int msel = u.pm < 64 ? (u.pm >> 4) : 4;
        const float* g1 = (const float*)(ws + WS_MOD) + ((size_t)ly * 5 + msel) * 6144 + 2048;
        const int col0 = u.pn * 256 + wc * 32 + 4 * fq;
        const float* src = ly == 0 ? (u.pm < 64 ? xlat + (size_t)u.pm * 256 * DM : xctx + (size_t)(u.pm - 64) * 256 * DM) : (const float*)(ws + WS_X) + (size_t)u.pm * 256 * DM;
        f32x4 gv[2][2];
#pragma unroll
        for (int bj = 0; bj < 2; ++bj)
#pragma unroll
            for (int n = 0; n < 2; ++n) gv[bj][n] = *(const f32x4*)(g1 + col0 + bj * 128 + n * 16);
#pragma unroll
        for (int ai = 0; ai < 2; ++ai)
#pragma unroll
            for (int m = 0; m < 4; ++m) { const size_t ro = (size_t)(ai * 128 + wr * 64 + m * 16 + fr) * DM + col0;
                float* rowp = (float*)(ws + WS_X) + (size_t)u.pm * 256 * DM + ro;
#pragma unroll
                for (int bj = 0; bj < 2; ++bj)
#pragma unroll
                    for (int n = 0; n < 2; ++n) { const f32x4 xin = *(const f32x4*)(src + ro + bj * 128 + n * 16); *(f32x4*)(rowp + bj * 128 + n * 16) = xin * ALPHA + gv[bj][n] * acc[ai][bj][m][n]; } }
    }
};

struct MoeTab { LAS int* cnt; LAS int* tstart; LAS int* tile_e; int ntiles; };
DI MoeTab moe_tables(const Frame& F, int ly) {
    MoeTab T; T.cnt = (LAS int*)(F.lds + LDS_TAB); T.tstart = T.cnt + 72; T.tile_e = T.tstart + 72;
    __syncthreads();
    if (F.tid < 65) T.cnt[F.tid] = F.tid < NEXP ? (int)__hip_atomic_load(F.ctl + CW_CNT + (ly * 64 + F.tid) * CNT_STRIDE, __ATOMIC_RELAXED, __HIP_MEMORY_SCOPE_AGENT) : (ly == DEPTH - 1 ? RLAT : RTOT);
    __syncthreads();
    if (F.tid == 0) { int s = 0; for (int e = 0; e < 65; ++e) { T.tstart[e] = s; s += (T.cnt[e] + 255) >> 8; } T.tstart[65] = s; }
    __syncthreads();
    const int nt = T.tstart[65];
    for (int e = F.tid; e < 65; e += NTHR) for (int q = T.tstart[e]; q < T.tstart[e + 1]; ++q) if (q < MAXTILES) T.tile_e[q] = e;
    __syncthreads();
    T.ntiles = __builtin_amdgcn_readfirstlane(nt < MAXTILES ? nt : MAXTILES);
    return T;
}
template <bool GATHER_> struct MoeSched {
    static constexpr bool GATHER = GATHER_;
    MoeTab T; const int* list; int G, c, nsub, shift;
    DI bool next(int i, pg8::Unit& u) const {
        const int L = i * G + c; if (L >= T.ntiles * nsub) return false;
        const int tile = L >> shift, j = L & (nsub - 1); const int e = __builtin_amdgcn_readfirstlane(T.tile_e[tile]);
        u.pm = tile; u.pn = e * nsub + j; u.e = e; u.lt = tile - __builtin_amdgcn_readfirstlane(T.tstart[e]); return true;
    }
    DI int arow(const pg8::Unit& u, int r) const {
        if (!GATHER_) return u.pm * 256 + r;
        const int idx = u.lt * 256 + r;
        if (u.e == NEXP) return idx;
        return idx < T.cnt[u.e] ? (list[(size_t)u.e * RTOT + idx] >> 3) : 0;
    }
};
DI float silu_f(float x) { return x / (1.f + __expf(-x)); }
struct EpiMoe1 {
    static constexpr bool PERM = true;
    unsigned char* ws;
    DI void operator()(const f32x4 (&acc)[2][2][4][2], const pg8::Unit& u, int wr, int wc, int fr, int fq) const {
        const int hid = (u.pn & 1) * 128 + wc * 32 + fq * 8;
#pragma unroll
        for (int ai = 0; ai < 2; ++ai)
#pragma unroll
            for (int m = 0; m < 4; ++m) { const size_t row = (size_t)u.pm * 256 + ai * 128 + wr * 64 + m * 16 + fr;
                float o[8];
#pragma unroll
                for (int n = 0; n < 2; ++n)
#pragma unroll
                    for (int e = 0; e < 4; ++e) o[n * 4 + e] = silu_f(acc[ai][0][m][n][e]) * acc[ai][1][m][n][e];
                u32x4 w; w.x = cvt_pk_bf16(o[0], o[1]); w.y = cvt_pk_bf16(o[2], o[3]); w.z = cvt_pk_bf16(o[4], o[5]); w.w = cvt_pk_bf16(o[6], o[7]);
                *(u32x4*)((bf16_t*)(ws + WS_ACT) + row * DEXP + hid) = w; }
    }
};
struct EpiMoe2 {
    static constexpr bool PERM = true;
    unsigned char* ws;
    DI void operator()(const f32x4 (&acc)[2][2][4][2], const pg8::Unit& u, int wr, int wc, int fr, int fq) const {
        const int colb = (u.pn & 3) * 256 + wc * 32 + fq * 8;
#pragma unroll
        for (int ai = 0; ai < 2; ++ai)
#pragma unroll
            for (int m = 0; m < 4; ++m) { const size_t row = (size_t)u.pm * 256 + ai * 128 + wr * 64 + m * 16 + fr;
#pragma unroll
                for (int bj = 0; bj < 2; ++bj) { const f32x4 v0 = acc[ai][bj][m][0], v1 = acc[ai][bj][m][1];
                    u32x4 w; w.x = cvt_pk_bf16(v0[0], v0[1]); w.y = cvt_pk_bf16(v0[2], v0[3]); w.z = cvt_pk_bf16(v1[0], v1[1]); w.w = cvt_pk_bf16(v1[2], v1[3]);
                    __builtin_nontemporal_store(w, (u32x4*)((bf16_t*)(ws + WS_YB) + row * DM + colb + bj * 128)); } }
    }
};

DI float hy_short(const float* hy, int l, int Lx, float w0, float w1, float w2) {
    const float a = l > 0 ? hy[l - 1] : 0.f, b = hy[l], c = l + 1 < Lx ? hy[l + 1] : 0.f;
    return w0 * a + w1 * b + w2 * c;
}
DI void hyena_ctx_unit(const Frame& F, int ly, int c) {
    LAS float* KC = (LAS float*)F.lds;
    LAS float* UC = KC + 1024;
    LAS float* PS = UC + 1024;
    const int t = F.tid;
    const float* HYT = (const float*)(F.ws + WS_HYT);
    const float* scw = F.in[8] + (size_t)ly * 3 * 768;
    const float* invl = (const float*)(F.ws + WS_INVL1) + (size_t)ly * 1024;
    const float bias0 = F.in[15][(size_t)ly * 512 + c], bias1 = F.in[15][(size_t)ly * 512 + 256 + c];
    float wx1[3], wx2[3], wv[3];
#pragma unroll
    for (int j = 0; j < 3; ++j) { wx1[j] = scw[j * 768 + c]; wx2[j] = scw[j * 768 + 256 + c]; wv[j] = scw[j * 768 + 512 + c]; }
    bf16_t* MIX = (bf16_t*)(F.ws + WS_MIX);
    for (int n = 0; n < 2; ++n) { const float inv = invl[(1 * 2 + n) * 256 + c];
        const float* hf = (const float*)(F.ws + WS_HCC) + ((((size_t)ly * 2 + n) * 2 + 0) * 256 + c) * CTXL;
        const float* hb = (const float*)(F.ws + WS_HCC) + ((((size_t)ly * 2 + n) * 2 + 1) * 256 + c) * CTXL;
        for (int i = t; i < 512; i += NTHR) { const int d = i - 256; KC[n * 512 + i] = d >= 0 ? hf[d] * inv : (d > -256 ? hb[-d] * inv : 0.f); } }
    for (int i = t; i < 4 * CTXL; i += NTHR) { const int b = i >> 8, l = i & 255;
        UC[l * 4 + b] = hy_short(HYT + ((size_t)b * 768 + 512 + c) * POS + SEQ, l, CTXL, wv[0], wv[1], wv[2]); }
    __syncthreads();
    const int t0 = (t & 63) * 4, bp = (t >> 6) & 1, sq = t >> 7;
    const int tt = t & 255, bq = t >> 8;
    for (int n = 0; n < 2; ++n) {
        float a[4][2];
#pragma unroll
        for (int j = 0; j < 4; ++j) { a[j][0] = 0.f; a[j][1] = 0.f; }
        const LAS float* kf = KC + n * 512 + 256 + t0;
#pragma unroll 4
        for (int s = sq * 64; s < sq * 64 + 64; ++s) { const float u0 = UC[s * 4 + 2 * bp], u1 = UC[s * 4 + 2 * bp + 1];
#pragma unroll
            for (int j = 0; j < 4; ++j) { const float k = kf[j - s]; a[j][0] += k * u0; a[j][1] += k * u1; } }
#pragma unroll
        for (int j = 0; j < 4; ++j) { PS[(sq * 256 + t0 + j) * 4 + 2 * bp] = a[j][0]; PS[(sq * 256 + t0 + j) * 4 + 2 * bp + 1] = a[j][1]; }
        __syncthreads();
        float y0 = 0.f, y1 = 0.f;
#pragma unroll
        for (int q = 0; q < 4; ++q) { y0 += PS[(q * 256 + tt) * 4 + 2 * bq]; y1 += PS[(q * 256 + tt) * 4 + 2 * bq + 1]; }
        const int xch = n == 0 ? c : 256 + c; const float* wg = n == 0 ? wx1 : wx2; const float bias = n == 0 ? bias0 : bias1;
        const float g0 = hy_short(HYT + ((size_t)(2 * bq) * 768 + xch) * POS + SEQ, tt, CTXL, wg[0], wg[1], wg[2]);
        const float g1 = hy_short(HYT + ((size_t)(2 * bq + 1) * 768 + xch) * POS + SEQ, tt, CTXL, wg[0], wg[1], wg[2]);
        const float z0 = g0 * (y0 + bias * UC[tt * 4 + 2 * bq]), z1 = g1 * (y1 + bias * UC[tt * 4 + 2 * bq + 1]);
        __syncthreads();
        if (n == 0) { UC[tt * 4 + 2 * bq] = z0; UC[tt * 4 + 2 * bq + 1] = z1; __syncthreads(); }
        else { MIX[((size_t)RLAT + (2 * bq) * CTXL + tt) * DM + c] = f2bf(z0); MIX[((size_t)RLAT + (2 * bq + 1) * CTXL + tt) * DM + c] = f2bf(z1); }
    }
    __syncthreads();
}

DI unsigned cx_addr(unsigned e) { return e * 8u + (e >> 5) * 16u; }
constexpr int cx_bytes(int n) { return n * 8 + (n / 32) * 16; }
typedef float f32x2 __attribute__((ext_vector_type(2)));
template <int R> DI constexpr int brev(int q) { int r = 0; for (int i = 1, j = R >> 1; i < R; i <<= 1, j >>= 1) if (q & i) r |= j; return r; }
typedef f32x2 cx;
DI cx cx_mul(cx x, float c, float s) { const cx sw = __builtin_shufflevector(x, x, 1, 0); return x * c + sw * (cx){-s, s}; }
DI cx cx_cmul(cx x, cx y) { const cx sw = __builtin_shufflevector(x, x, 1, 0), y0 = __builtin_shufflevector(y, y, 0, 0), y1 = __builtin_shufflevector(y, y, 1, 1);
    return x * y0 + sw * (y1 * (cx){-1.f, 1.f}); }
template <int R, bool INV> DI void dft_inreg(cx (&v)[R]) {
#pragma unroll
    for (int len = R; len >= 2; len >>= 1) { const int half = len >> 1;
#pragma unroll
        for (int base = 0; base < R; base += len)
#pragma unroll
            for (int j = 0; j < half; ++j) { const cx a = v[base + j], bq = v[base + j + half]; v[base + j] = a + bq; v[base + j + half] = a - bq; }
#pragma unroll
        for (int base = 0; base < R; base += len)
#pragma unroll
            for (int j = 1; j < half; ++j) { const cx d = v[base + j + half];
                if (4 * j == len) v[base + j + half] = INV ? (cx){-d[1], d[0]} : (cx){d[1], -d[0]};
                else { const float c = __builtin_cosf(6.283185307179586f * (float)j / (float)len), sn = (INV ? 1.f : -1.f) * __builtin_sinf(6.283185307179586f * (float)j / (float)len);
                    v[base + j + half] = cx_mul(d, c, sn); } }
    }
}
template <int R, bool INV, int S> DI void fft_bfly(LAS unsigned char* seq, int j) {
    constexpr int Lcur = R * S;
    int jj = j; asm volatile("" : "+v"(jj));
    const int blk = jj / S, o = jj % S;
    LAS unsigned char* p = seq + cx_addr((unsigned)(blk * Lcur + o));
#define FFT_OFF(r) ((r) * S * 8 + ((((r) * S) >> 5) * 16))
    cx v[R];
    if (S == 1) {
#pragma unroll
        for (int r = 0; r < R; r += 2) { const f32x4 q = *(const LAS f32x4*)(p + FFT_OFF(r)); v[r] = (cx){q[0], q[1]}; v[r + 1] = (cx){q[2], q[3]}; }
    } else {
#pragma unroll
        for (int r = 0; r < R; ++r) v[r] = *(const LAS f32x2*)(p + FFT_OFF(r));
    }
    if (S == 1) {
        dft_inreg<R, INV>(v);
    } else {
        const float fr = (float)o * (1.0f / (float)Lcur);
        cx w[R];
        w[1] = (cx){__builtin_amdgcn_cosf(fr), INV ? __builtin_amdgcn_sinf(fr) : -__builtin_amdgcn_sinf(fr)};
#pragma unroll
        for (int q = 2; q < R; ++q) { const int a = (q & (q - 1)) ? (q & -q) : (q >> 1), bq = q - a;
            w[q] = cx_cmul(w[a], w[bq]); }
        if (!INV) {
            dft_inreg<R, false>(v);
#pragma unroll
            for (int q = 1; q < R; ++q) { const int k = brev<R>(q); v[k] = cx_cmul(v[k], w[q]); }
        } else {
#pragma unroll
            for (int q = 1; q < R; ++q) v[q] = cx_cmul(v[q], w[q]);
            dft_inreg<R, true>(v);
        }
    }
    if (S == 1) {
#pragma unroll
        for (int r = 0; r < R; r += 2) { const int k0 = brev<R>(r), k1 = brev<R>(r + 1); *(LAS f32x4*)(p + FFT_OFF(r)) = (f32x4){v[k0][0], v[k0][1], v[k1][0], v[k1][1]}; }
    } else {
#pragma unroll
        for (int r = 0; r < R; ++r) { const int k = brev<R>(r); *(LAS f32x2*)(p + FFT_OFF(r)) = v[k]; }
    }
#undef FFT_OFF
}
template <bool INV> DI void fft8192x2(LAS unsigned char* lds, int tid) {
    constexpr int SB = cx_bytes(8192);
    if (!INV) {
        fft_bfly<16, false, 512>(lds, tid); __builtin_amdgcn_sched_barrier(0); fft_bfly<16, false, 512>(lds + SB, tid); __syncthreads();
        fft_bfly<16, false, 32>(lds, tid); __builtin_amdgcn_sched_barrier(0); fft_bfly<16, false, 32>(lds + SB, tid); __syncthreads();
        fft_bfly<32, false, 1>(lds + (tid >> 8) * SB, tid & 255); __syncthreads();
    } else {
        fft_bfly<32, true, 1>(lds + (tid >> 8) * SB, tid & 255); __syncthreads();
        fft_bfly<16, true, 32>(lds, tid); __builtin_amdgcn_sched_barrier(0); fft_bfly<16, true, 32>(lds + SB, tid); __syncthreads();
        fft_bfly<16, true, 512>(lds, tid); __builtin_amdgcn_sched_barrier(0); fft_bfly<16, true, 512>(lds + SB, tid); __syncthreads();
    }
}
DI void fft4096x4(LAS unsigned char* lds, int tid) {
    constexpr int SB = cx_bytes(4096);
    const int sq = tid >> 8, j = tid & 255;
    fft_bfly<16, false, 256>(lds + sq * SB, j); __builtin_amdgcn_sched_barrier(0); fft_bfly<16, false, 256>(lds + (sq + 2) * SB, j); __syncthreads();
    fft_bfly<16, false, 16>(lds + sq * SB, j); __builtin_amdgcn_sched_barrier(0); fft_bfly<16, false, 16>(lds + (sq + 2) * SB, j); __syncthreads();
    fft_bfly<16, false, 1>(lds + sq * SB, j); __builtin_amdgcn_sched_barrier(0); fft_bfly<16, false, 1>(lds + (sq + 2) * SB, j); __syncthreads();
}

DI void hy_short8(const float* hp, int l0, float w0, float w1, float w2, float (&out)[8]) {
    const f32x4 h0 = *(const f32x4*)(hp + l0), h1 = *(const f32x4*)(hp + l0 + 4);
    const float hm = l0 > 0 ? hp[l0 - 1] : 0.f, hn = l0 + 8 < SEQ ? hp[l0 + 8] : 0.f;
    const float hv[10] = {hm, h0[0], h0[1], h0[2], h0[3], h1[0], h1[1], h1[2], h1[3], hn};
#pragma unroll
    for (int j = 0; j < 8; ++j) out[j] = w0 * hv[j] + w1 * hv[j + 1] + w2 * hv[j + 2];
}
DI void hyena_fft_unit(const Frame& F, int ly, int c) {
    LAS unsigned char* L = F.lds; constexpr int SB = cx_bytes(8192);
    const int t = F.tid;
    const unsigned pt = cx_addr((unsigned)t), pl = cx_addr((unsigned)t * 8u);
    const float* HYT = (const float*)(F.ws + WS_HYT);
    const float* scw = F.in[8] + (size_t)ly * 3 * 768;
    const float* invl = (const float*)(F.ws + WS_INVL1) + (size_t)ly * 1024;
    const float bias0 = F.in[15][(size_t)ly * 512 + c], bias1 = F.in[15][(size_t)ly * 512 + 256 + c];
    float wx1[3], wx2[3], wv[3];
#pragma unroll
    for (int j = 0; j < 3; ++j) { wx1[j] = scw[j * 768 + c]; wx2[j] = scw[j * 768 + 256 + c]; wv[j] = scw[j * 768 + 512 + c]; }
    f32x2* SPEC = (f32x2*)(F.ws + WS_SPEC) + (size_t)c * 2 * 8192;
#pragma unroll
    for (int n = 0; n < 2; ++n) { const float inv = invl[(0 * 2 + n) * 256 + c] * (1.0f / 8192.0f);
        const float* hf = (const float*)(F.ws + WS_HCL) + ((((size_t)ly * 2 + n) * 2 + 0) * 256 + c) * SEQ;
        const float* hb = (const float*)(F.ws + WS_HCL) + ((((size_t)ly * 2 + n) * 2 + 1) * 256 + c) * SEQ;
        float fv[16];
#pragma unroll
        for (int k = 0; k < 8; ++k) { fv[k] = hf[t + 512 * k]; const int i = SEQ + t + 512 * k; fv[8 + k] = i > SEQ ? hb[8192 - i] : 0.f; }
#pragma unroll
        for (int k = 0; k < 16; ++k) *(LAS f32x2*)(L + n * SB + (pt + 4352u * (unsigned)(k))) = (f32x2){fv[k] * inv, 0.f}; }
    __syncthreads();
    fft8192x2<false>(L, t);
#pragma unroll
    for (int n = 0; n < 2; ++n)
#pragma unroll
        for (int k = 0; k < 16; ++k) SPEC[n * 8192 + t + 512 * k] = *(const LAS f32x2*)(L + n * SB + (pt + 4352u * (unsigned)(k)));
    __syncthreads();
    const int l0 = t * 8;
#pragma unroll 1
    for (int sp = 0; sp < 2; ++sp) {
        float za[8], zb[8];
        hy_short8(HYT + ((size_t)(2 * sp) * 768 + 512 + c) * POS, l0, wv[0], wv[1], wv[2], za);
        hy_short8(HYT + ((size_t)(2 * sp + 1) * 768 + 512 + c) * POS, l0, wv[0], wv[1], wv[2], zb);
#pragma unroll
        for (int j = 0; j < 8; j += 2) {
            *(LAS f32x4*)(L + sp * SB + (pl + 8u * (unsigned)(j))) = (f32x4){za[j], zb[j], za[j + 1], zb[j + 1]};
            *(LAS f32x4*)(L + sp * SB + (pl + 34816u + 8u * (unsigned)(j))) = (f32x4){0.f, 0.f, 0.f, 0.f}; }
    }
    __syncthreads();
    float* Z1 = (float*)(F.ws + WS_Z1) + (size_t)c * 4 * SEQ;
    bf16_t* MIX = (bf16_t*)(F.ws + WS_MIX);
#pragma unroll 1
    for (int n = 0; n < 2; ++n) {
        fft8192x2<false>(L, t);
#pragma unroll 1
        for (int k0 = 0; k0 < 16; k0 += 8) { f32x2 h[8];
#pragma unroll
          for (int k = 0; k < 8; ++k) h[k] = SPEC[n * 8192 + t + 512 * (k0 + k)];
#pragma unroll
          for (int k = 0; k < 8; ++k) { const unsigned ad = (pt + 4352u * (unsigned)(k0 + k));
            const f32x2 a = *(const LAS f32x2*)(L + ad), b = *(const LAS f32x2*)(L + SB + ad);
            *(LAS f32x2*)(L + ad) = (f32x2){a[0] * h[k][0] - a[1] * h[k][1], a[0] * h[k][1] + a[1] * h[k][0]};
            *(LAS f32x2*)(L + SB + ad) = (f32x2){b[0] * h[k][0] - b[1] * h[k][1], b[0] * h[k][1] + b[1] * h[k][0]}; } }
        __syncthreads();
        fft8192x2<true>(L, t);
        const int xch = n == 0 ? c : 256 + c; const float* wg = n == 0 ? wx1 : wx2; const float bias = n == 0 ? bias0 : bias1;
#pragma unroll 1
        for (int sp = 0; sp < 2; ++sp) {
            float zo[2][8];
#pragma unroll
            for (int h2 = 0; h2 < 2; ++h2) { const int bb = 2 * sp + h2;
                float g[8], zin[8];
                hy_short8(HYT + ((size_t)bb * 768 + xch) * POS, l0, wg[0], wg[1], wg[2], g);
                if (n == 0) hy_short8(HYT + ((size_t)bb * 768 + 512 + c) * POS, l0, wv[0], wv[1], wv[2], zin);
                else { const f32x4 q0 = *(const f32x4*)(Z1 + (size_t)bb * SEQ + l0), q1 = *(const f32x4*)(Z1 + (size_t)bb * SEQ + l0 + 4);
                    zin[0] = q0[0]; zin[1] = q0[1]; zin[2] = q0[2]; zin[3] = q0[3]; zin[4] = q1[0]; zin[5] = q1[1]; zin[6] = q1[2]; zin[7] = q1[3]; }
#pragma unroll
                for (int j = 0; j < 8; ++j) { const float y = ((const LAS float*)(L + sp * SB + (pl + 8u * (unsigned)(j))))[h2]; zo[h2][j] = g[j] * (y + bias * zin[j]); }
                if (n == 0) { *(f32x4*)(Z1 + (size_t)bb * SEQ + l0) = (f32x4){zo[h2][0], zo[h2][1], zo[h2][2], zo[h2][3]}; *(f32x4*)(Z1 + (size_t)bb * SEQ + l0 + 4) = (f32x4){zo[h2][4], zo[h2][5], zo[h2][6], zo[h2][7]}; }
                else {
#pragma unroll
                    for (int j = 0; j < 8; ++j) MIX[((size_t)bb * SEQ + l0 + j) * DM + c] = f2bf(zo[h2][j]); }
            }
            if (n == 0) {
#pragma unroll
                for (int j = 0; j < 8; j += 2) {
                    *(LAS f32x4*)(L + sp * SB + (pl + 8u * (unsigned)(j))) = (f32x4){zo[0][j], zo[1][j], zo[0][j + 1], zo[1][j + 1]};
                    *(LAS f32x4*)(L + sp * SB + (pl + 34816u + 8u * (unsigned)(j))) = (f32x4){0.f, 0.f, 0.f, 0.f}; }
            }
        }
        __syncthreads();
    }
}

DI void fnet_fft_unit(const Frame& F, int u) {
    LAS unsigned char* L = F.lds; constexpr int SB = cx_bytes(4096);
    const int t = F.tid, b = u >> 6, gd0 = (u & 63) * 4;
    const bf16_t* YT = (const bf16_t*)(F.ws + WS_YTL) + ((size_t)b * 256 + gd0) * 8192;
    for (int i = t; i < 4 * 512; i += NTHR) { const int q = i >> 9, l0 = (i & 511) * 8;
        const u32x4 r = *(const u32x4*)(YT + (size_t)q * 8192 + l0), m = *(const u32x4*)(YT + (size_t)q * 8192 + 4096 + l0);
        const float rr[8] = {bflo(r.x), bfhi(r.x), bflo(r.y), bfhi(r.y), bflo(r.z), bfhi(r.z), bflo(r.w), bfhi(r.w)};
        const float mm[8] = {bflo(m.x), bfhi(m.x), bflo(m.y), bfhi(m.y), bflo(m.z), bfhi(m.z), bflo(m.w), bfhi(m.w)};
#pragma unroll
        for (int j = 0; j < 8; j += 2) *(LAS f32x4*)(L + q * SB + cx_addr(l0 + j)) = (f32x4){rr[j], mm[j], rr[j + 1], mm[j + 1]}; }
    __syncthreads();
    fft4096x4(L, t);
    bf16_t* MIX = (bf16_t*)(F.ws + WS_MIX);
#pragma unroll
    for (int i = 0; i < 8; ++i) { const int p = t + 512 * i; const int f = (p >> 8) + 16 * ((p >> 4) & 15) + 256 * (p & 15);
        float v[4];
#pragma unroll
        for (int q = 0; q < 4; ++q) v[q] = (*(const LAS f32x2*)(L + q * SB + cx_addr(p)))[0] * (1.0f / 512.0f);
        u32x2 w; w.x = cvt_pk_bf16(v[0], v[1]); w.y = cvt_pk_bf16(v[2], v[3]);
        *(u32x2*)(MIX + ((size_t)b * SEQ + f) * DM + 768 + gd0) = w; }
    __syncthreads();
}

DI void attn_unit(const Frame& F, int ly, int uid, float lam, float out_scale) {
    const int t = F.tid, lane = F.lane, wave = F.wave;
    LAS unsigned char* L = F.lds;
    constexpr int KOFF = 0, VOFF = 16384, TB = 32768, NBUF = 4;
    int bh, q0, k_lo, k_hi;
    if (uid < 512) { bh = uid >> 4; q0 = (uid & 15) << 8; k_lo = 0; k_hi = POS; }
    else { bh = uid - 512; q0 = SEQ; k_lo = SEQ; k_hi = POS; }
    const bf16_t* Qg = (const bf16_t*)(F.ws + WS_Q) + (size_t)bh * POS * 64;
    const bf16_t* Kg = (const bf16_t*)(F.ws + WS_K) + (size_t)bh * POS * 64;
    const bf16_t* Vg = (const bf16_t*)(F.ws + WS_V) + (size_t)bh * POS * 64;
    const int qi = lane & 31, hh = lane >> 5;
    const int qpos = q0 + wave * 32 + qi;
    bf16x8 qf[2][2];
    float q2[2] = {0.f, 0.f};
#pragma unroll
    for (int comp = 0; comp < 2; ++comp)
#pragma unroll
        for (int ks = 0; ks < 2; ++ks) { qf[comp][ks] = *(const bf16x8*)(Qg + (size_t)qpos * 64 + comp * 32 + ks * 16 + hh * 8);
#pragma unroll
            for (int j = 0; j < 8; ++j) { const float x = bf2f((unsigned short)qf[comp][ks][j]); q2[comp] += x * x; } }
    q2[0] += __shfl_xor(q2[0], 32); q2[1] += __shfl_xor(q2[1], 32);
    float kmax2[2];
    kmax2[0] = __uint_as_float(F.ctl[CW_KMAX + 64 * ly + bh * 2]); kmax2[1] = __uint_as_float(F.ctl[CW_KMAX + 64 * ly + bh * 2 + 1]);
    f32x16 negm;
    { const float m = -fmaxf(sqrtf(q2[0] * kmax2[0]), sqrtf(q2[1] * kmax2[1])) * 1.0001f;
#pragma unroll
      for (int i = 0; i < 16; ++i) negm[i] = m; }
    f32x16 O[2][2];
#pragma unroll
    for (int a = 0; a < 2; ++a)
#pragma unroll
        for (int b = 0; b < 2; ++b)
#pragma unroll
            for (int i = 0; i < 16; ++i) O[a][b][i] = 0.f;
    float lsum[2] = {0.f, 0.f};
    const int sk = t >> 3, sl = t & 7;
    const int kch = sl ^ ((sk >> 1) & 7);
    const int vch = (((sl >> 1) ^ (sk & 3)) << 1) | (sl & 1);
    const bf16_t* kgp = Kg + (size_t)(k_lo + sk) * 64 + kch * 8;
    const bf16_t* vgp = Vg + (size_t)(k_lo + sk) * 64 + vch * 8;
    const unsigned wvb = (unsigned)wave * 1024u;
    const int ntile = (k_hi - k_lo) >> 7;
#define ATT_DMA(tile, bufi) do { const size_t go = (size_t)(tile) * 128 * 64; \
        __builtin_amdgcn_global_load_lds((const unsigned*)(kgp + go), (LAS unsigned*)(L + KOFF + (bufi) * TB + wvb), 16, 0, 0); \
        __builtin_amdgcn_global_load_lds((const unsigned*)(kgp + go + 4096), (LAS unsigned*)(L + KOFF + (bufi) * TB + 8192 + wvb), 16, 0, 0); \
        __builtin_amdgcn_global_load_lds((const unsigned*)(vgp + go), (LAS unsigned*)(L + VOFF + (bufi) * TB + wvb), 16, 0, 0); \
        __builtin_amdgcn_global_load_lds((const unsigned*)(vgp + go + 4096), (LAS unsigned*)(L + VOFF + (bufi) * TB + 8192 + wvb), 16, 0, 0); } while (0)
    ATT_DMA(0, 0);
    if (ntile > 1) ATT_DMA(1, 1);
    if (ntile > 2) ATT_DMA(2, 2);
    if (ntile > 2) asm volatile("s_waitcnt vmcnt(8)" ::: "memory"); else if (ntile > 1) asm volatile("s_waitcnt vmcnt(4)" ::: "memory"); else asm volatile("s_waitcnt vmcnt(0)" ::: "memory");
    __builtin_amdgcn_s_barrier();
    const int p4 = lane & 3, q4 = (lane & 15) >> 2, blk = (lane >> 4) & 1;
    const int keyq = 4 * hh + q4;
    const unsigned va0 = (unsigned)(keyq * 128 + (((0 + blk) ^ (keyq & 3)) << 5) + p4 * 8), va1 = (unsigned)(keyq * 128 + (((2 + blk) ^ (keyq & 3)) << 5) + p4 * 8);
    const int ksw = (qi >> 1) & 7;
    const unsigned ka00 = (unsigned)(qi * 128 + (((0 + hh) ^ ksw) << 4)), ka01 = (unsigned)(qi * 128 + (((2 + hh) ^ ksw) << 4));
    const unsigned ka10 = (unsigned)(qi * 128 + (((4 + hh) ^ ksw) << 4)), ka11 = (unsigned)(qi * 128 + (((6 + hh) ^ ksw) << 4));
    typedef __bf16 bf16x8n __attribute__((ext_vector_type(8)));
    typedef float f32x8 __attribute__((ext_vector_type(8)));
#define ATT_PACK(S, s8) __builtin_bit_cast(bf16x8, __builtin_convertvector((f32x8){S[8 * (s8)], S[8 * (s8) + 1], S[8 * (s8) + 2], S[8 * (s8) + 3], S[8 * (s8) + 4], S[8 * (s8) + 5], S[8 * (s8) + 6], S[8 * (s8) + 7]}, bf16x8n))
#define ATT_MFMA(a, b, c) __builtin_amdgcn_mfma_f32_32x32x16_bf16((a), (b), (c), 0, 0, 0)
    f32x16 S0, S1;
    bf16x8 p1a, p1b, vp00, vp01, vp10, vp11;
#pragma unroll
    for (int j = 0; j < 8; ++j) { p1a[j] = 0; p1b[j] = 0; vp00[j] = 0; vp01[j] = 0; vp10[j] = 0; vp11[j] = 0; }
    for (int it = 0; it < ntile; ++it) {
        const int buf = it & (NBUF - 1);
        if (it + 3 < ntile) ATT_DMA(it + 3, (it + 3) & (NBUF - 1));
        const unsigned kbb = KOFF + buf * TB, vbb = VOFF + buf * TB;
        { const bf16x8 k00 = *(const LAS bf16x8*)(L + kbb + ka00), k01 = *(const LAS bf16x8*)(L + kbb + ka01);
          S0 = ATT_MFMA(k00, qf[0][0], negm); S0 = ATT_MFMA(k01, qf[0][1], S0); }
#pragma unroll 2
        for (int kb = 0; kb < 4; ++kb) {
            const unsigned kro = kbb + kb * 4096, vro = vbb + kb * 4096;
            s16x4 r0, r1, r2, r3, r4, r5, r6, r7;
            { const unsigned a0 = vro + va0, a1 = vro + va1;
              asm volatile("ds_read_b64_tr_b16 %0, %8\n\tds_read_b64_tr_b16 %1, %8 offset:1024\n\tds_read_b64_tr_b16 %2, %8 offset:2048\n\tds_read_b64_tr_b16 %3, %8 offset:3072\n\t"
                           "ds_read_b64_tr_b16 %4, %9\n\tds_read_b64_tr_b16 %5, %9 offset:1024\n\tds_read_b64_tr_b16 %6, %9 offset:2048\n\tds_read_b64_tr_b16 %7, %9 offset:3072"
                           : "=&v"(r0), "=&v"(r1), "=&v"(r2), "=&v"(r3), "=&v"(r4), "=&v"(r5), "=&v"(r6), "=&v"(r7) : "v"(a0), "v"(a1) : "memory"); }
            const bf16x8 k10 = *(const LAS bf16x8*)(L + kro + ka10), k11 = *(const LAS bf16x8*)(L + kro + ka11);
            O[1][0] = ATT_MFMA(vp00, p1a, O[1][0]); O[1][1] = ATT_MFMA(vp01, p1a, O[1][1]);
            O[1][0] = ATT_MFMA(vp10, p1b, O[1][0]); O[1][1] = ATT_MFMA(vp11, p1b, O[1][1]);
            S1 = ATT_MFMA(k10, qf[1][0], negm); S1 = ATT_MFMA(k11, qf[1][1], S1);
            float ps0 = 0.f;
#pragma unroll
            for (int i = 0; i < 16; ++i) { S0[i] = __builtin_amdgcn_exp2f(S0[i]); ps0 += S0[i]; }
            lsum[0] += ps0;
            const bf16x8 p0a = ATT_PACK(S0, 0), p0b = ATT_PACK(S0, 1);
            __builtin_amdgcn_sched_group_barrier(0x008, 1, 0); __builtin_amdgcn_sched_group_barrier(0x400, 3, 0);
            __builtin_amdgcn_sched_group_barrier(0x008, 1, 0); __builtin_amdgcn_sched_group_barrier(0x400, 3, 0);
            __builtin_amdgcn_sched_group_barrier(0x008, 1, 0); __builtin_amdgcn_sched_group_barrier(0x400, 3, 0);
            __builtin_amdgcn_sched_group_barrier(0x008, 1, 0); __builtin_amdgcn_sched_group_barrier(0x400, 3, 0);
            __builtin_amdgcn_sched_group_barrier(0x008, 1, 0); __builtin_amdgcn_sched_group_barrier(0x400, 2, 0);
            __builtin_amdgcn_sched_group_barrier(0x008, 1, 0); __builtin_amdgcn_sched_group_barrier(0x400, 2, 0);
            asm volatile("s_waitcnt lgkmcnt(0)" : "+v"(r0), "+v"(r1), "+v"(r2), "+v"(r3), "+v"(r4), "+v"(r5), "+v"(r6), "+v"(r7));
            vp00 = __builtin_shufflevector(r0, r1, 0, 1, 2, 3, 4, 5, 6, 7); vp10 = __builtin_shufflevector(r2, r3, 0, 1, 2, 3, 4, 5, 6, 7);
            vp01 = __builtin_shufflevector(r4, r5, 0, 1, 2, 3, 4, 5, 6, 7); vp11 = __builtin_shufflevector(r6, r7, 0, 1, 2, 3, 4, 5, 6, 7);
            O[0][0] = ATT_MFMA(vp00, p0a, O[0][0]); O[0][1] = ATT_MFMA(vp01, p0a, O[0][1]);
            O[0][0] = ATT_MFMA(vp10, p0b, O[0][0]); O[0][1] = ATT_MFMA(vp11, p0b, O[0][1]);
            { const bf16x8 k00 = *(const LAS bf16x8*)(L + kro + 4096 + ka00), k01 = *(const LAS bf16x8*)(L + kro + 4096 + ka01);
                S0 = ATT_MFMA(k00, qf[0][0], negm); S0 = ATT_MFMA(k01, qf[0][1], S0); }
            float ps1 = 0.f;
#pragma unroll
            for (int i = 0; i < 16; ++i) { S1[i] = __builtin_amdgcn_exp2f(S1[i]); ps1 += S1[i]; }
            lsum[1] += ps1;
            p1a = ATT_PACK(S1, 0); p1b = ATT_PACK(S1, 1);
            __builtin_amdgcn_sched_group_barrier(0x008, 1, 1); __builtin_amdgcn_sched_group_barrier(0x400, 3, 1);
            __builtin_amdgcn_sched_group_barrier(0x008, 1, 1); __builtin_amdgcn_sched_group_barrier(0x400, 3, 1);
            __builtin_amdgcn_sched_group_barrier(0x008, 1, 1); __builtin_amdgcn_sched_group_barrier(0x400, 3, 1);
            __builtin_amdgcn_sched_group_barrier(0x008, 1, 1); __builtin_amdgcn_sched_group_barrier(0x400, 3, 1);
            __builtin_amdgcn_sched_group_barrier(0x008, 1, 1); __builtin_amdgcn_sched_group_barrier(0x400, 2, 1);
            __builtin_amdgcn_sched_group_barrier(0x008, 1, 1); __builtin_amdgcn_sched_group_barrier(0x400, 2, 1);
        }
        if (it + 3 < ntile) asm volatile("s_waitcnt vmcnt(8)\n\ts_waitcnt lgkmcnt(0)" ::: "memory");
        else if (it + 2 < ntile) asm volatile("s_waitcnt vmcnt(4)\n\ts_waitcnt lgkmcnt(0)" ::: "memory");
        else asm volatile("s_waitcnt vmcnt(0)\n\ts_waitcnt lgkmcnt(0)" ::: "memory");
        __builtin_amdgcn_s_barrier();
    }
    O[1][0] = ATT_MFMA(vp00, p1a, O[1][0]); O[1][1] = ATT_MFMA(vp01, p1a, O[1][1]);
    O[1][0] = ATT_MFMA(vp10, p1b, O[1][0]); O[1][1] = ATT_MFMA(vp11, p1b, O[1][1]);
#undef ATT_DMA
#undef ATT_PACK
#undef ATT_MFMA
    const float l0 = lsum[0] + __shfl_xor(lsum[0], 32), l1 = lsum[1] + __shfl_xor(lsum[1], 32);
    const float i0 = 1.0f / l0, i1 = lam / l1;
    float ss = 0.f;
#pragma unroll
    for (int dvb = 0; dvb < 2; ++dvb)
#pragma unroll
        for (int i = 0; i < 16; ++i) { const float o = O[0][dvb][i] * i0 - O[1][dvb][i] * i1; O[0][dvb][i] = o; ss += o * o; }
    ss += __shfl_xor(ss, 32);
    const float rn = rsqrtf(ss * (1.0f / 64.0f) + LN_EPS) * out_scale;
    const float* sw = F.in[20] + (size_t)ly * 64;
    const int b = bh >> 3, head = bh & 7;
    const size_t row = qpos < SEQ ? (size_t)b * SEQ + qpos : (size_t)RLAT + b * CTXL + (qpos - SEQ);
    bf16_t* dst = (bf16_t*)(F.ws + WS_MIX) + row * DM + 256 + head * 64;
#pragma unroll
    for (int dvb = 0; dvb < 2; ++dvb)
#pragma unroll
        for (int g = 0; g < 4; ++g) { const int dv = dvb * 32 + 8 * g + 4 * hh;
            const f32x4 w4 = *(const f32x4*)(sw + dv);
            u32x2 w; w.x = cvt_pk_bf16(O[0][dvb][4 * g] * rn * w4[0], O[0][dvb][4 * g + 1] * rn * w4[1]); w.y = cvt_pk_bf16(O[0][dvb][4 * g + 2] * rn * w4[2], O[0][dvb][4 * g + 3] * rn * w4[3]);
            *(u32x2*)(dst + dv) = w; }
    __syncthreads();
}

DI void phase_rows_router(const Frame& F, int ly) {
    LAS float* HS = (LAS float*)F.lds;
    LAS float* PART = HS + 16 * 1028;
    LAS int* LCNT = (LAS int*)(PART + 8 * 16 * 64);
    LAS int* LBASE = LCNT + 64;
    LAS int* ASG = LBASE + 64;
    const int lane = F.lane, wave = F.wave;
    const float* MOD = (const float*)(F.ws + WS_MOD);
    const float* g1 = F.in[22] + (size_t)ly * DM; const float* b1 = F.in[23] + (size_t)ly * DM;
    const float* rw = F.in[26] + (size_t)ly * DM * NEXP; const float* rb = F.in[27] + (size_t)ly * NEXP;
    const bool last = ly == DEPTH - 1;
    const int nrows = last ? RLAT : RTOT;
    if (F.tid < 64) LCNT[F.tid] = 0;
    constexpr int HSS = 1028;
    float wreg[128];
#pragma unroll
    for (int i = 0; i < 128; ++i) wreg[i] = rw[(size_t)(wave * 128 + 4 * (i >> 2) + (lane >> 4)) * NEXP + 16 * (i & 3) + (lane & 15)];
    __syncthreads();
    int itn = 0;
    f32x4 va[2][4];
    if (F.bid * 16 < nrows) {
#pragma unroll
        for (int rr = 0; rr < 2; ++rr) { const float* xr = (const float*)(F.ws + WS_X) + (size_t)(F.bid * 16 + wave * 2 + rr) * DM;
#pragma unroll
            for (int j = 0; j < 4; ++j) va[rr][j] = *(const f32x4*)(xr + 4 * lane + 256 * j); } }
    for (int r0 = F.bid * 16; r0 < nrows; r0 += F.G * 16, ++itn) {
#pragma unroll
        for (int rr = 0; rr < 2; ++rr) { const int rl = wave * 2 + rr, row = r0 + rl;
            float* xr = (float*)(F.ws + WS_X) + (size_t)row * DM;
            f32x4 (&v)[4] = va[rr];
            float mu, rstd; ln_stats(v, mu, rstd);
#pragma unroll
            for (int j = 0; j < 4; ++j) { const int c = 4 * lane + 256 * j; const f32x4 g = *(const f32x4*)(g1 + c), bb = *(const f32x4*)(b1 + c);
#pragma unroll
                for (int e = 0; e < 4; ++e) v[j][e] = (v[j][e] - mu) * rstd * g[e] + bb[e];
                *(f32x4*)(xr + c) = v[j]; }
            ln_stats(v, mu, rstd);
            const float* m = MOD + ((size_t)ly * 5 + row_modsel(row)) * 6144;
            bf16_t* hrow = (bf16_t*)(F.ws + WS_H) + (size_t)row * DM;
#pragma unroll
            for (int j = 0; j < 4; ++j) { const int c = 4 * lane + 256 * j; const f32x4 a = *(const f32x4*)(m + 3072 + c), bsc = *(const f32x4*)(m + 4096 + c);
                f32x4 o;
#pragma unroll
                for (int e = 0; e < 4; ++e) o[e] = (v[j][e] - mu) * rstd * (1.f + bsc[e]) + a[e];
                u32x2 w; w.x = cvt_pk_bf16(o[0], o[1]); w.y = cvt_pk_bf16(o[2], o[3]); *(u32x2*)(hrow + c) = w;
                *(LAS f32x4*)(HS + rl * HSS + c) = o; } }
        { const int rn = r0 + F.G * 16;
          if (rn < nrows) {
#pragma unroll
            for (int rr = 0; rr < 2; ++rr) { const float* xr = (const float*)(F.ws + WS_X) + (size_t)(rn + wave * 2 + rr) * DM;
#pragma unroll
                for (int j = 0; j < 4; ++j) va[rr][j] = *(const f32x4*)(xr + 4 * lane + 256 * j); } } }
        asm volatile("s_waitcnt lgkmcnt(0)" ::: "memory"); __builtin_amdgcn_s_barrier();
        { f32x4 acc[4];
#pragma unroll
          for (int nb = 0; nb < 4; ++nb) acc[nb] = (f32x4){0.f, 0.f, 0.f, 0.f};
          const LAS float* hp = HS + (lane & 15) * HSS + wave * 128 + (lane >> 4);
#pragma unroll
          for (int g = 0; g < 32; ++g) { const float a = hp[4 * g];
#pragma unroll
              for (int nb = 0; nb < 4; ++nb) acc[nb] = __builtin_amdgcn_mfma_f32_16x16x4f32(a, wreg[g * 4 + nb], acc[nb], 0, 0, 0); }
#pragma unroll
          for (int nb = 0; nb < 4; ++nb)
#pragma unroll
              for (int e = 0; e < 4; ++e) PART[(wave * 16 + (lane >> 4) * 4 + e) * 64 + nb * 16 + (lane & 15)] = acc[nb][e]; }
        asm volatile("s_waitcnt lgkmcnt(0)" ::: "memory"); __builtin_amdgcn_s_barrier();
#pragma unroll
        for (int rr = 0; rr < 2; ++rr) { const int rl = wave * 2 + rr, row = r0 + rl;
            float lg = 0.f;
#pragma unroll
            for (int w = 0; w < 8; ++w) lg += PART[(w * 16 + rl) * 64 + lane];
            const float s = 1.0f / (1.0f + expf(-lg));
            const float sel = s + rb[lane];
            float m1 = sel;
            m1 = fmaxf(m1, __shfl_xor(m1, 1)); m1 = fmaxf(m1, __shfl_xor(m1, 2)); m1 = fmaxf(m1, __shfl_xor(m1, 4));
            const unsigned long long bal = __ballot(sel == m1);
            const int gbase = lane & ~7;
            const unsigned gmask = (unsigned)((bal >> gbase) & 0xffull);
            const int first = gbase + __builtin_ctz(gmask);
            float m2 = (lane == first) ? -INFINITY : sel;
            m2 = fmaxf(m2, __shfl_xor(m2, 1)); m2 = fmaxf(m2, __shfl_xor(m2, 2)); m2 = fmaxf(m2, __shfl_xor(m2, 4));
            const float gs = m1 + m2;
            const int mygrp = lane >> 3;
            int grank = 0;
#pragma unroll
            for (int g = 0; g < 8; ++g) { const float o = __shfl(gs, g * 8); grank += (o > gs || (o == gs && g < mygrp)) ? 1 : 0; }
            const float msel = grank < 4 ? sel : -INFINITY;
            int rank = 64;
            { float cur = msel;
#pragma unroll 1
              for (int it = 0; it < 8; ++it) { const float m = wave_max(cur); const unsigned long long bl = __ballot(cur == m); const int first2 = (int)__builtin_ctzll(bl);
                  if (lane == first2) { rank = it; cur = -INFINITY; } } }
            const bool chosen = rank < 8;
            const float wsum = wave_sum(chosen ? s : 0.f);
            if (chosen) { const float gate = s / wsum * 2.5f;
                ((float*)(F.ws + WS_TOPG))[(size_t)row * 8 + rank] = gate;
                const int lp = __hip_atomic_fetch_add(LCNT + lane, 1, __ATOMIC_RELAXED, __HIP_MEMORY_SCOPE_WORKGROUP);
                ASG[(itn * 16 + rl) * 8 + rank] = (lane << 20) | lp; } }
        asm volatile("s_waitcnt lgkmcnt(0)" ::: "memory"); __builtin_amdgcn_s_barrier();
    }
    if (F.tid < 64) { const int n = LCNT[F.tid]; LBASE[F.tid] = n ? (int)atomicAdd(F.ctl + CW_CNT + (ly * 64 + F.tid) * CNT_STRIDE, (unsigned)n) : 0; }
    __syncthreads();
    for (int a = F.tid; a < itn * 128; a += NTHR) { const int it = a >> 7, rl = (a >> 3) & 15, slot = a & 7; const int row = F.bid * 16 + it * F.G * 16 + rl;
        const int v = ASG[a], e = v >> 20, lp = v & 0xfffff;
        ((int*)(F.ws + WS_LIST))[(size_t)e * RTOT + LBASE[e] + lp] = row * 8 + slot;
        ((int*)(F.ws + WS_TOPE))[(size_t)row * 8 + slot] = (e << 20) | (LBASE[e] + lp); }
    __syncthreads();
}

DI void bf8_fma(const u32x4 w, float g, float (&y)[8]) {
    y[0] += bflo(w.x) * g; y[1] += bfhi(w.x) * g; y[2] += bflo(w.y) * g; y[3] += bfhi(w.y) * g; y[4] += bflo(w.z) * g; y[5] += bfhi(w.z) * g; y[6] += bflo(w.w) * g; y[7] += bfhi(w.w) * g;
}
DI void phase_combine(const Frame& F, int ly) {
    const int gw = F.bid * 8 + F.wave, nw = F.G * 8, lane = F.lane;
    const bool last = ly == DEPTH - 1;
    const int nrows = last ? RLAT : RTOT;
    const float* MOD = (const float*)(F.ws + WS_MOD);
    const float* g2w = F.in[24] + (size_t)ly * DM; const float* b2w = F.in[25] + (size_t)ly * DM;
    const bf16_t* YB = (const bf16_t*)(F.ws + WS_YB);
    const MoeTab T = moe_tables(F, ly);
    for (int row = gw; row < nrows; row += nw) {
        const float* gates = (const float*)(F.ws + WS_TOPG) + (size_t)row * 8;
        const int* posr = (const int*)(F.ws + WS_TOPE) + (size_t)row * 8;
        u32x4 yr[9][2];
#pragma unroll
        for (int s9 = 0; s9 < 9; ++s9) { size_t yrow;
            if (s9 < 8) { const int v = posr[s9]; yrow = (size_t)T.tstart[v >> 20] * 256 + (v & 0xfffff); } else yrow = (size_t)T.tstart[NEXP] * 256 + row;
#pragma unroll
            for (int hf = 0; hf < 2; ++hf) yr[s9][hf] = __builtin_nontemporal_load((const u32x4*)(YB + yrow * DM + hf * 512 + 8 * lane)); }
        float* xr = (float*)(F.ws + WS_X) + (size_t)row * DM;
        f32x4 xv[4];
#pragma unroll
        for (int hf = 0; hf < 2; ++hf) { xv[2 * hf] = *(const f32x4*)(xr + hf * 512 + 8 * lane); xv[2 * hf + 1] = *(const f32x4*)(xr + hf * 512 + 8 * lane + 4); }
        float y[2][8];
#pragma unroll
        for (int hf = 0; hf < 2; ++hf) {
#pragma unroll
            for (int e = 0; e < 8; ++e) y[hf][e] = 0.f;
            bf8_fma(yr[8][hf], 1.0f, y[hf]);
#pragma unroll
            for (int s8 = 0; s8 < 8; ++s8) bf8_fma(yr[s8][hf], gates[s8], y[hf]); }
        const float* m = MOD + ((size_t)ly * 5 + row_modsel(row)) * 6144;
        f32x4 v[4];
#pragma unroll
        for (int q = 0; q < 4; ++q) { const int c = (q >> 1) * 512 + 8 * lane + (q & 1) * 4; const f32x4 g2 = *(const f32x4*)(m + 5120 + c);
#pragma unroll
            for (int e = 0; e < 4; ++e) v[q][e] = xv[q][e] * ALPHA + g2[e] * y[q >> 1][(q & 1) * 4 + e]; }
        float mu, rstd; ln_stats(v, mu, rstd);
#pragma unroll
        for (int q = 0; q < 4; ++q) { const int c = (q >> 1) * 512 + 8 * lane + (q & 1) * 4; const f32x4 g = *(const f32x4*)(g2w + c), bb = *(const f32x4*)(b2w + c);
#pragma unroll
            for (int e = 0; e < 4; ++e) v[q][e] = (v[q][e] - mu) * rstd * g[e] + bb[e];
            if (last) *(f32x4*)(F.out + (size_t)row * DM + c) = v[q]; else *(f32x4*)(xr + c) = v[q]; }
        if (!last) { const float* mn = MOD + ((size_t)(ly + 1) * 5 + row_modsel(row)) * 6144;
            ln_stats(v, mu, rstd);
            bf16_t* hrow = (bf16_t*)(F.ws + WS_H) + (size_t)row * DM;
#pragma unroll
            for (int hf = 0; hf < 2; ++hf) { const int c = hf * 512 + 8 * lane; float o[8];
#pragma unroll
                for (int q = 0; q < 2; ++q) { const f32x4 sh = *(const f32x4*)(mn + c + 4 * q), sc = *(const f32x4*)(mn + 1024 + c + 4 * q);
#pragma unroll
                    for (int e = 0; e < 4; ++e) o[4 * q + e] = (v[2 * hf + q][e] - mu) * rstd * (1.f + sc[e]) + sh[e]; }
                u32x4 w; w.x = cvt_pk_bf16(o[0], o[1]); w.y = cvt_pk_bf16(o[2], o[3]); w.z = cvt_pk_bf16(o[4], o[5]); w.w = cvt_pk_bf16(o[6], o[7]);
                *(u32x4*)(hrow + c) = w; } }
    }
}

PHASE_FN void ph_pre0(const Frame& F0) { const Frame F = relaunder(F0); prep_small(F, 0); prep_mod(F); prep_filters(F); prep_tables(F); }
PHASE_FN void ph_pre1(const Frame& F0) { const Frame F = relaunder(F0); prep_invl1(F); phase_init_h(F); }
PHASE_FN void ph_win(const Frame& F0, int ly) { const Frame F = relaunder(F0);
    pg8::Gemm g{(const bf16_t*)(F.ws + WS_H), (const bf16_t*)(F.ws + WS_WIN), DM, F.tid};
    pg8::StaticOrder S; S.init(RTOT / 256, NWIN / 256, F.G, F.bid);
    EpiWin E{F.ws, ly};
    pg8::gemm_phase<EpiWin, pg8::StaticOrder>(F.lds, g, S, E);
}
constexpr int NSTREAM = 0;
PHASE_FN void ph_mix(const Frame& F0, int ly) { const Frame F = relaunder(F0);
    volatile LAS unsigned* MISC = (volatile LAS unsigned*)(F.lds + LDS_MISC);
    const bool last = ly == DEPTH - 1;
    if (!last) { pg8::Gemm g{(const bf16_t*)(F.ws + WS_DFTC), (const bf16_t*)(F.ws + WS_YTC), 2 * CTXL, F.tid};
      pg8::StaticOrder S; S.init(1, 4, F.G, (F.bid + F.G - 64) % F.G);
      EpiFnet E{F.ws, 1};
      pg8::gemm_phase<EpiFnet, pg8::StaticOrder>(F.lds, g, S, E); }
    __syncthreads();
    for (;;) {
        __syncthreads();
        if (F.tid == 0) MISC[16] = atomicAdd(F.ctl + CW_ATTN + 64 * ly, 1u);
        __syncthreads();
        const int uid = (int)MISC[16];
        if (uid >= 256 + 256 + (last ? 512 : 544)) break;
        const Frame Fu = relaunder(F);
        if (uid < 256) { if (KIND(4)) { hyena_fft_unit(Fu, ly, uid); if (!last) hyena_ctx_unit(Fu, ly, uid); } }
        else if (uid < 512) { if (KIND(3)) fnet_fft_unit(Fu, uid - 256); }
        else if (KIND(5)) { const float* lm = (const float*)(Fu.ws + WS_LAM) + 2 * ly; attn_unit(Fu, ly, uid - 512, lm[0], 1.0f - lm[1]); }
    }
    prep_experts(F, ly, CW_PREPQ, 0, PREP_SPLIT);
}
PHASE_FN void ph_wout(const Frame& F0, int ly) { const Frame F = relaunder(F0);
    pg8::Gemm g{(const bf16_t*)(F.ws + WS_MIX), (const bf16_t*)(F.ws + WS_WOUT), DM, F.tid};
    pg8::StaticOrder S; S.init(ly == DEPTH - 1 ? RLAT / 256 : RTOT / 256, DM / 256, F.G, F.bid);
    EpiWout E{F.ws, ly, F.in[0], F.in[2]};
    pg8::gemm_phase<EpiWout, pg8::StaticOrder>(F.lds, g, S, E);
    __syncthreads();
    prep_experts(F, ly, CW_PREPQ2, PREP_SPLIT, PREP_SPLIT2);
}
PHASE_FN void ph_router(const Frame& F0, int ly) { const Frame F = relaunder(F0); phase_rows_router(F, ly); prep_experts(F, ly, CW_PREPQ4, PREP_SPLIT2, 3 * 1040); }
PHASE_FN void ph_moe1(const Frame& F0, int ly) { const Frame F = relaunder(F0);
    const MoeTab T = moe_tables(F, ly);
    pg8::Gemm g{(const bf16_t*)(F.ws + WS_H), (const bf16_t*)(F.ws + WS_WGU), DM, F.tid};
    MoeSched<true> S{T, (const int*)(F.ws + WS_LIST), F.G, F.bid, 2, 1};
    EpiMoe1 E{F.ws};
    pg8::gemm_phase<EpiMoe1, MoeSched<true>>(F.lds, g, S, E);
    __syncthreads();
    if (ly + 1 < DEPTH) prep_small_dyn(F, ly + 1);
}
PHASE_FN void ph_moe2(const Frame& F0, int ly) { const Frame F = relaunder(F0);
    const MoeTab T = moe_tables(F, ly);
    pg8::Gemm g{(const bf16_t*)(F.ws + WS_ACT), (const bf16_t*)(F.ws + WS_WD), DEXP, F.tid};
    MoeSched<false> S{T, (const int*)(F.ws + WS_LIST), F.G, F.bid, 4, 2};
    EpiMoe2 E{F.ws};
    pg8::gemm_phase<EpiMoe2, MoeSched<false>>(F.lds, g, S, E);
}
PHASE_FN void ph_combine(const Frame& F0, int ly) { const Frame F = relaunder(F0); phase_combine(F, ly); }

constexpr int PH_PER_LAYER = 7, N_PHASES = 2 + DEPTH * PH_PER_LAYER;

__global__ void __launch_bounds__(NTHR, 2) hybrid_fwd(Params prm) {
    extern __shared__ __attribute__((aligned(16))) unsigned char lds_raw[];
    Frame F;
    F.in = prm.in; F.out = prm.out; F.ws = prm.ws; F.lds = (LAS unsigned char*)lds_raw; F.ctl = (unsigned*)(prm.ws + WS_CTL);
    F.tid = threadIdx.x; F.lane = F.tid & 63; F.wave = __builtin_amdgcn_readfirstlane(F.tid >> 6); F.G = gridDim.x; F.bid = blockIdx.x;
    volatile LAS unsigned* MISC = (volatile LAS unsigned*)(F.lds + LDS_MISC);
    if (F.tid < 64) MISC[F.tid] = 0u;
    __syncthreads();
    const int lo = prm.ph_lo, hi = prm.ph_hi;
    XcdBarrier bar; bar.bar = F.ctl + CW_BAR; bar.x = 0; bar.st = nullptr;
    if (hi - lo > 1) bar = xcd_barrier_post(F.ctl + CW_BAR, MISC);
#define IN(k) (lo <= (k) && (k) < hi)
    unsigned long long pr_acc = 0ull, pr_t0 = 0ull;
#define SEAM(k) do { if (IN(k) && IN((k) + 1)) { unsigned long long _b0 = 0; if ((PROBE_KINDS >> 12) & 1) _b0 = __builtin_amdgcn_s_memrealtime(); xcd_barrier(bar); if ((PROBE_KINDS >> 12) & 1) pr_acc += __builtin_amdgcn_s_memrealtime() - _b0; } } while (0)
#define PR_BEGIN(kind) do { if ((PROBE_KINDS >> (kind)) & 1) pr_t0 = __builtin_amdgcn_s_memrealtime(); } while (0)
#define PR_END(kind) do { if ((PROBE_KINDS >> (kind)) & 1) pr_acc += __builtin_amdgcn_s_memrealtime() - pr_t0; } while (0)

    PR_BEGIN(0); if (IN(0) && KIND(0)) { const Frame Fp = relaunder(F); PR_BEGIN(13); prep_small(Fp, 0); PR_END(13); PR_BEGIN(14); prep_mod(Fp); PR_END(14); PR_BEGIN(15); prep_filters(Fp); PR_END(15); PR_BEGIN(16); prep_tables(Fp); PR_END(16); }
    PR_END(0); SEAM(0);
    PR_BEGIN(1); if (IN(1) && KIND(1)) ph_pre1(F);
    PR_END(1); SEAM(1);

    for (int ly = 0; ly < DEPTH; ++ly) {
        const int p0 = 2 + ly * PH_PER_LAYER;
        PR_BEGIN(2); if (IN(p0) && KIND(2)) ph_win(F, ly);
        PR_END(2); SEAM(p0);
        if (IN(p0 + 1)) { PR_BEGIN(5); ph_mix(F, ly); }
        PR_END(5); SEAM(p0 + 1);
        PR_BEGIN(6); if (IN(p0 + 2) && KIND(6)) ph_wout(F, ly);
        PR_END(6); SEAM(p0 + 2);
        PR_BEGIN(7); if (IN(p0 + 3) && KIND(7)) ph_router(F, ly);
        PR_END(7); SEAM(p0 + 3);
        PR_BEGIN(8); if (IN(p0 + 4) && KIND(8)) ph_moe1(F, ly);
        PR_END(8); SEAM(p0 + 4);
        PR_BEGIN(9); if (IN(p0 + 5) && KIND(9)) ph_moe2(F, ly);
        PR_END(9); SEAM(p0 + 5);
        PR_BEGIN(10); if (IN(p0 + 6) && KIND(10)) { const Frame Fc = relaunder(F); PR_BEGIN(17); phase_combine(Fc, ly); PR_END(17);  }
        PR_END(10); SEAM(p0 + 6);
    }
    if (PROBE_KINDS != 0 && blockIdx.x == 0) {
        const unsigned long long t0 = __builtin_amdgcn_s_memrealtime(), wait = pr_acc * (unsigned long long)PROBE_AMP;
        while (__builtin_amdgcn_s_memrealtime() - t0 < wait) __builtin_amdgcn_s_sleep(8);
    }
#undef IN
#undef SEAM
}

extern "C" void kernel_launch(void* const* d_in, const int* in_sizes, int n_in, void* d_out, int out_size, void* d_ws, size_t ws_size, hipStream_t stream) {
    static int grid = 0;
    if (grid == 0) {
        if (n_in != 34 || out_size != RLAT * DM || ws_size < WS_END) { fprintf(stderr, "kernel_launch: unexpected problem shape (n_in %d out %d ws %zu need %zu)\n", n_in, out_size, ws_size, (size_t)WS_END); grid = -1; return; }
        int dev = 0, cus = 0, per_cu = 0;
        if (hipGetDevice(&dev) != hipSuccess || hipDeviceGetAttribute(&cus, hipDeviceAttributeMultiprocessorCount, dev) != hipSuccess) { grid = -1; return; }
        if (hipFuncSetAttribute((const void*)hybrid_fwd, hipFuncAttributeMaxDynamicSharedMemorySize, LDS_BYTES) != hipSuccess) { fprintf(stderr, "kernel_launch: hipFuncSetAttribute failed\n"); grid = -1; return; }
        if (hipOccupancyMaxActiveBlocksPerMultiprocessor(&per_cu, (const void*)hybrid_fwd, NTHR, LDS_BYTES) != hipSuccess || per_cu < 1)
            fprintf(stderr, "kernel_launch: occupancy query reports %d workgroups per CU\n", per_cu);
        (void)hipGetLastError();
        grid = cus;
    }
    if (grid < 0) return;
    (void)hipMemsetAsync((char*)d_ws + WS_CTL, 0, CTL_BYTES, stream);
    Params p{};
    for (int i = 0; i < 34; ++i) p.in[i] = (const float*)d_in[i];
    p.out = (float*)d_out; p.ws = (unsigned char*)d_ws;
#if MK_PER_PHASE
    for (int ph = 0; ph < N_PHASES; ++ph) { p.ph_lo = ph; p.ph_hi = ph + 1; hipLaunchKernelGGL(hybrid_fwd, dim3(grid), dim3(NTHR), LDS_BYTES, stream, p); }
#else
    p.ph_lo = 0; p.ph_hi = N_PHASES;
    hipLaunchKernelGGL(hybrid_fwd, dim3(grid), dim3(NTHR), LDS_BYTES, stream, p);
#endif
}
```

```cpp
#include <hip/hip_runtime.h>
#include <cstdio>
#include <cstdint>

#ifndef MK_PER_PHASE
#define MK_PER_PHASE 0
#endif

#ifndef PG8_ALIGN
#define PG8_ALIGN 1
#endif
#ifndef PG8_OPAQUE_K
#define PG8_OPAQUE_K 1
#endif
#ifndef MK_OUTLINE
#define MK_OUTLINE 0
#endif
#if MK_OUTLINE
#define PHASE_FN __device__ __attribute__((noinline))
#else
#define PHASE_FN __device__ __forceinline__
#endif
#ifndef PROBE_KINDS
#define PROBE_KINDS 0
#endif
#ifndef PROBE_AMP
#define PROBE_AMP 4
#endif
#ifndef KMASK
#define KMASK 0xFFFF
#endif
#define KIND(k) ((KMASK >> (k)) & 1)
#define LAS __attribute__((address_space(3)))
typedef unsigned short bf16_t;
typedef short bf16x8 __attribute__((ext_vector_type(8)));
typedef short s16x4 __attribute__((ext_vector_type(4)));
typedef float f32x4 __attribute__((ext_vector_type(4)));
typedef float f32x16 __attribute__((ext_vector_type(16)));
typedef unsigned u32x4 __attribute__((ext_vector_type(4)));
typedef unsigned u32x2 __attribute__((ext_vector_type(2)));
#define DI __device__ __forceinline__

constexpr int NB = 4, SEQ = 4096, CTXL = 256, DM = 1024, DEPTH = 4;
constexpr int POS = SEQ + CTXL;
constexpr int RLAT = NB * SEQ, RCTX = NB * CTXL, RTOT = RLAT + RCTX;
constexpr int DIN = 2560, NWIN = 2816;
constexpr int NEXP = 64, DEXP = 256;
constexpr float LN_EPS = 1e-5f;
constexpr float ALPHA = 1.681792830507429f;
constexpr float QSCALE = 0.17677669529663687f * 1.4426950408889634f;
constexpr int MAXTILES = 680;

constexpr size_t AL(size_t x) { return (x + 255) & ~(size_t)255; }
constexpr size_t WS_CTL = 0, CTL_BYTES = 1u << 17;
constexpr size_t WS_X = WS_CTL + CTL_BYTES;
constexpr size_t WS_H = WS_X + AL((size_t)RTOT * DM * 4);
constexpr size_t WS_MOD = WS_H + AL((size_t)RTOT * DM * 2);
constexpr size_t WS_HCL = WS_MOD + AL((size_t)DEPTH * 5 * 6144 * 4);
constexpr size_t WS_HCC = WS_HCL + AL((size_t)DEPTH * 4 * 256 * SEQ * 4);
constexpr size_t WS_INVL1 = WS_HCC + AL((size_t)DEPTH * 4 * 256 * CTXL * 4);
constexpr size_t WS_DFTL = WS_INVL1 + AL((size_t)DEPTH * 2 * 2 * 256 * 4);
constexpr size_t WS_DFTC = WS_DFTL + 256;
constexpr size_t WS_ROPE = WS_DFTC + AL((size_t)CTXL * 2 * CTXL * 2);
constexpr size_t WS_LAM = WS_ROPE + AL(64 * 8 * 2 * 4);
constexpr size_t WS_WIN = WS_LAM + 256;
constexpr size_t WS_WOUT = WS_WIN + AL((size_t)NWIN * DM * 2);
constexpr size_t WS_WGU = WS_WOUT + AL((size_t)DM * DM * 2);
constexpr size_t WS_WD = WS_WGU + AL((size_t)65 * 512 * DM * 2);
constexpr size_t WS_TOPE = WS_WD + AL((size_t)65 * DM * DEXP * 2);
constexpr size_t WS_TOPG = WS_TOPE + AL((size_t)RTOT * 8 * 4);
constexpr size_t WS_LIST = WS_TOPG + AL((size_t)RTOT * 8 * 4);
constexpr size_t WS_SPEC = WS_LIST + AL((size_t)NEXP * RTOT * 4);
constexpr size_t WS_Z1 = WS_SPEC + AL((size_t)256 * 2 * 8192 * 8);
constexpr size_t WS_U = WS_Z1 + AL((size_t)256 * SEQ * 4 * 4);
constexpr size_t WS_Q = WS_U;
constexpr size_t WS_K = WS_Q + AL((size_t)NB * 8 * POS * 64 * 2);
constexpr size_t WS_V = WS_K + AL((size_t)NB * 8 * POS * 64 * 2);
constexpr size_t WS_HYT = WS_V + AL((size_t)NB * 8 * POS * 64 * 2);
constexpr size_t WS_YTL = WS_HYT + AL((size_t)NB * 768 * POS * 4);
constexpr size_t WS_YTC = WS_YTL + AL((size_t)1024 * 8192 * 2);
constexpr size_t WS_MIX = WS_YTC + AL((size_t)1024 * 512 * 2);
constexpr size_t WS_U1_END = WS_MIX + AL((size_t)RTOT * DM * 2);
constexpr size_t WS_ACT = WS_U;
constexpr size_t WS_YB = WS_ACT + AL((size_t)MAXTILES * 256 * DEXP * 2);
constexpr size_t WS_U2_END = WS_YB + AL((size_t)MAXTILES * 256 * DM * 2);
constexpr size_t WS_END = WS_U2_END > WS_U1_END ? WS_U2_END : WS_U1_END;

constexpr int CW_BAR = 0;
constexpr int CW_ATTN = 4096;
constexpr int CW_PREPQ = 4096 + 1024;
constexpr int CW_PREPQ2 = 4096 + 1536;
constexpr int CW_PREPQ3 = 4096 + 2048;
constexpr int CW_PREPQ4 = 4096 + 2560;
constexpr int PREP_SPLIT2 = 2640;
constexpr int PREP_SPLIT = 1200;
constexpr int CW_KMAX = 4096 + 512;
constexpr int CW_CNT = 8192;
constexpr int CNT_STRIDE = 64;

DI unsigned cvt_pk_bf16(float lo, float hi) { unsigned r; asm volatile("v_cvt_pk_bf16_f32 %0, %1, %2" : "=v"(r) : "v"(lo), "v"(hi)); return r; }
DI bf16x8 pack8(float a0, float a1, float a2, float a3, float a4, float a5, float a6, float a7) {
    u32x4 p;
    asm volatile("v_cvt_pk_bf16_f32 %0, %4, %5\n\tv_cvt_pk_bf16_f32 %1, %6, %7\n\tv_cvt_pk_bf16_f32 %2, %8, %9\n\tv_cvt_pk_bf16_f32 %3, %10, %11\n\ts_nop 1"
                 : "=&v"(p[0]), "=&v"(p[1]), "=&v"(p[2]), "=&v"(p[3]) : "v"(a0), "v"(a1), "v"(a2), "v"(a3), "v"(a4), "v"(a5), "v"(a6), "v"(a7));
    return __builtin_bit_cast(bf16x8, p);
}
DI bf16_t f2bf(float x) { return (bf16_t)(cvt_pk_bf16(x, 0.f) & 0xffffu); }
DI float bf2f(unsigned short u) { return __uint_as_float(((unsigned)u) << 16); }
DI float bflo(unsigned w) { return __uint_as_float(w << 16); }
DI float bfhi(unsigned w) { return __uint_as_float(w & 0xffff0000u); }
DI float wave_sum(float v) {
    v += __builtin_bit_cast(float, __builtin_amdgcn_update_dpp(0, __builtin_bit_cast(int, v), 0xB1, 0xf, 0xf, true));
    v += __builtin_bit_cast(float, __builtin_amdgcn_update_dpp(0, __builtin_bit_cast(int, v), 0x4E, 0xf, 0xf, true));
    v += __builtin_bit_cast(float, __builtin_amdgcn_update_dpp(0, __builtin_bit_cast(int, v), 0x141, 0xf, 0xf, true));
    v += __builtin_bit_cast(float, __builtin_amdgcn_update_dpp(0, __builtin_bit_cast(int, v), 0x140, 0xf, 0xf, true));
    const int iv = __builtin_bit_cast(int, v);
    return (__builtin_bit_cast(float, __builtin_amdgcn_readlane(iv, 0)) + __builtin_bit_cast(float, __builtin_amdgcn_readlane(iv, 16)))
         + (__builtin_bit_cast(float, __builtin_amdgcn_readlane(iv, 32)) + __builtin_bit_cast(float, __builtin_amdgcn_readlane(iv, 48)));
}
DI float group8_max(float v) {
    v = fmaxf(v, __builtin_bit_cast(float, __builtin_amdgcn_update_dpp(0, __builtin_bit_cast(int, v), 0xB1, 0xf, 0xf, true)));
    v = fmaxf(v, __builtin_bit_cast(float, __builtin_amdgcn_update_dpp(0, __builtin_bit_cast(int, v), 0x4E, 0xf, 0xf, true)));
    return fmaxf(v, __builtin_bit_cast(float, __builtin_amdgcn_update_dpp(0, __builtin_bit_cast(int, v), 0x141, 0xf, 0xf, true)));
}
DI float wave_max(float v) {
    v = fmaxf(v, __builtin_bit_cast(float, __builtin_amdgcn_update_dpp(0, __builtin_bit_cast(int, v), 0xB1, 0xf, 0xf, true)));
    v = fmaxf(v, __builtin_bit_cast(float, __builtin_amdgcn_update_dpp(0, __builtin_bit_cast(int, v), 0x4E, 0xf, 0xf, true)));
    v = fmaxf(v, __builtin_bit_cast(float, __builtin_amdgcn_update_dpp(0, __builtin_bit_cast(int, v), 0x141, 0xf, 0xf, true)));
    v = fmaxf(v, __builtin_bit_cast(float, __builtin_amdgcn_update_dpp(0, __builtin_bit_cast(int, v), 0x140, 0xf, 0xf, true)));
    const int iv = __builtin_bit_cast(int, v);
    return fmaxf(fmaxf(__builtin_bit_cast(float, __builtin_amdgcn_readlane(iv, 0)), __builtin_bit_cast(float, __builtin_amdgcn_readlane(iv, 16))),
                 fmaxf(__builtin_bit_cast(float, __builtin_amdgcn_readlane(iv, 32)), __builtin_bit_cast(float, __builtin_amdgcn_readlane(iv, 48))));
}

#define XB_TMO      128
#define XB_XCNT(j)  (256  + 64 * (j))
#define XB_XSUB(j)  (1280 + 64 * (j))
#define XB_XGEN(j)  (2304 + 64 * (j))
#define XB_TOP      3328
#define XB_TOPGEN   3392
#define XCD_BAR_WORDS 3456
#define XB_SPIN_CAP (1u << 18)

__device__ __forceinline__ unsigned xb_ld(unsigned* p)              { return __hip_atomic_load(p, __ATOMIC_RELAXED, __HIP_MEMORY_SCOPE_AGENT); }
__device__ __forceinline__ unsigned xb_add(unsigned* p, unsigned v) { return __hip_atomic_fetch_add(p, v, __ATOMIC_RELAXED, __HIP_MEMORY_SCOPE_AGENT); }
__device__ __forceinline__ unsigned xb_xcc_id() { return (unsigned)__builtin_amdgcn_s_getreg((3 << 11) | 20) & 0xFu; }
#define XB_SPIN(cond, bar) do { unsigned _sp = 0; while (cond) { __builtin_amdgcn_s_sleep(1); \
    if ((++_sp & 255u) == 0u) { if (xb_ld(&(bar)[XB_TMO])) break; if (_sp > XB_SPIN_CAP) { atomicAdd(&(bar)[XB_TMO], 1u); break; } } } } while (0)

struct XcdBarrier { unsigned* bar; unsigned x; volatile LAS unsigned* st; };

__device__ __forceinline__ XcdBarrier xcd_barrier_post(unsigned* bar, volatile LAS unsigned* st) {
    XcdBarrier b; b.bar = bar; b.x = xb_xcc_id(); b.st = st;
    if (threadIdx.x == 0) (void)xb_add(&bar[XB_XCNT(b.x)], 1u);
    return b;
}
__device__ __forceinline__ void xcd_barrier_complete(unsigned* bar, unsigned x, unsigned& nloc, unsigned& nx) {
    const unsigned G = gridDim.x * gridDim.y * gridDim.z;
    unsigned sum, cnt, mine, sp = 0u;
    for (;;) {
        sum = 0u; cnt = 0u; mine = 0u;
#pragma unroll
        for (unsigned j = 0; j < 16; ++j) { const unsigned c = xb_ld(&bar[XB_XCNT(j)]); sum += c; cnt += (c > 0u) ? 1u : 0u; mine = (j == x) ? c : mine; }
        if (sum == G) break;
        __builtin_amdgcn_s_sleep(1);
        if ((++sp & 255u) == 0u) { if (xb_ld(&bar[XB_TMO])) break; if (sp > XB_SPIN_CAP) { atomicAdd(&bar[XB_TMO], 1u); break; } }
    }
    nloc = mine > 0u ? mine : 1u; nx = cnt > 0u ? cnt : 1u;
}
__device__ __forceinline__ void xcd_barrier(const XcdBarrier& b) {
    asm volatile("s_waitcnt vmcnt(0)" ::: "memory");
    __syncthreads();
    if (threadIdx.x == 0) {
        unsigned* bar = b.bar;
        __builtin_amdgcn_s_waitcnt(0);
        unsigned nloc = b.st[0], nx = b.st[1];
        if (nloc == 0u) { xcd_barrier_complete(bar, b.x, nloc, nx); b.st[0] = nloc; b.st[1] = nx; }
        const unsigned old = xb_add(&bar[XB_XSUB(b.x)], 1u);
        const unsigned gen = old / nloc;
        if (old + 1u == (gen + 1u) * nloc) {
            __builtin_amdgcn_fence(__ATOMIC_RELEASE, "agent");
            asm volatile("s_waitcnt vmcnt(0)" ::: "memory");
            const unsigned og = xb_add(&bar[XB_TOP], 1u);
            const unsigned tg = og / nx;
            if (og + 1u == (tg + 1u) * nx) xb_add(&bar[XB_TOPGEN], 1u);
            else XB_SPIN(xb_ld(&bar[XB_TOPGEN]) == tg, bar);
            __builtin_amdgcn_fence(__ATOMIC_ACQUIRE, "agent");
            xb_add(&bar[XB_XGEN(b.x)], 1u);
            asm volatile("s_waitcnt vmcnt(0)" ::: "memory");
        } else {
            XB_SPIN(xb_ld(&bar[XB_XGEN(b.x)]) == gen, bar);
            __builtin_amdgcn_fence(__ATOMIC_ACQUIRE, "agent");
            asm volatile("s_waitcnt vmcnt(0)" ::: "memory");
        }
    }
    __syncthreads();
}

namespace pg8 {
constexpr int BM = 256, BK = 64, HALF = 128, HTB = HALF * BK * 2, STAGE_BYTES = 8 * HTB, NXCD = 8, WGM = 8;
__host__ __device__ __forceinline__ int lds_byte(int r, int c) { const int st = (r >> 4) * 2 + (c >> 5), rr = r & 15, cc = c & 31, ob = rr * 64 + cc * 2; return st * 1024 + (ob ^ (((ob >> 9) & 1) << 5)); }
__host__ __device__ __forceinline__ void stage_rc(int b, int& R, int& C) { const int st = b / 1024, sb = b % 1024, swz = sb ^ (((sb >> 9) & 1) << 5); R = (st >> 1) * 16 + swz / 64; C = (st & 1) * 32 + (swz % 64) / 2; }
__host__ __device__ __forceinline__ int perm32(int rho) { const int n = rho >> 4, i = rho & 15; return 8 * (i >> 2) + 4 * n + (i & 3); }

struct Unit { int pm, pn, e, lt; };
struct Gemm { const bf16_t* A; const bf16_t* Bt; int K; int tid; };

struct StaticOrder {
    static constexpr bool GATHER = false;
    int nM, nN, nwg, G, c;
    __device__ void init(int nM_, int nN_, int G_, int c_) { nM = nM_; nN = nN_; nwg = nM * nN; G = G_; c = c_; }
    __device__ bool next(int i, Unit& u) const {
        const long L = (long)i * G + c; if (L >= nwg) return false;
        int wgid = (int)L; { const int q = nwg / NXCD, r = nwg % NXCD, xcd = wgid % NXCD, off = wgid / NXCD; wgid = (xcd < r ? xcd * (q + 1) : r * (q + 1) + (xcd - r) * q) + off; }
        const int nig = WGM * nN, gid = wgid / nig, fm = gid * WGM, gsz = (nM - fm) < WGM ? (nM - fm) : WGM;
        u.pm = fm + ((wgid % nig) % gsz); u.pn = (wgid % nig) / gsz; u.e = 0; u.lt = 0; return true;
    }
    __device__ __forceinline__ int arow(const Unit& u, int r) const { return u.pm * BM + r; }
};

template <class Epi, class Sched>
__device__ __forceinline__ void gemm_phase(LAS unsigned char* lds, const Gemm g, const Sched& S, const Epi& E) {
    constexpr bool GA = Sched::GATHER;
    int tid = g.tid; asm volatile("" : "+v"(tid));
    const int wid = __builtin_amdgcn_readfirstlane(tid >> 6), lane = tid & 63, wr = wid >> 2, wc = wid & 3, fr = lane & 15, fq = lane >> 4;
    int K = g.K;
#if PG8_OPAQUE_K
    asm volatile("" : "+s"(K));
#endif
    const int nt = K / BK;
    unsigned voffA[2], voffB[2];
#pragma unroll
    for (int i = 0; i < 2; ++i) { int R, C; stage_rc(tid * 16 + i * 8192, R, C); const int Rb = Epi::PERM ? ((R & ~31) + perm32(R & 31)) : R;
        voffA[i] = (unsigned)(R * K + C) * 2u; voffB[i] = (unsigned)(Rb * K + C) * 2u; }
    const size_t kstep = (size_t)(BK * 2);
    const size_t hstep = (size_t)HALF * K * 2;
    const size_t tstep = 2 * hstep;
    const unsigned ldsw = (unsigned)wid * 1024u;
    const int aoff = lds_byte(wr * 64 + fr, fq * 8), boff = lds_byte(wc * 32 + fr, fq * 8);
#define PG8_SA(b, h) (((b) * 2 + (h)) * HTB)
#define PG8_SB(b, h) ((4 + (b) * 2 + (h)) * HTB)
#define PG8_STAGE(bufoff, gbase, voff) do { _Pragma("unroll") for (int _i = 0; _i < 2; ++_i) \
        __builtin_amdgcn_global_load_lds((const unsigned*)((const char*)(gbase) + (voff)[_i]), (LAS unsigned*)(lds + (bufoff) + ldsw + _i * 8192), 16, 0, 0); } while (0)
#define PG8_STAGEA(bufoff, gbase, o0, o1) do { \
        __builtin_amdgcn_global_load_lds((const unsigned*)((const char*)(gbase) + (o0)), (LAS unsigned*)(lds + (bufoff) + ldsw), 16, 0, 0); \
        __builtin_amdgcn_global_load_lds((const unsigned*)((const char*)(gbase) + (o1)), (LAS unsigned*)(lds + (bufoff) + ldsw + 8192), 16, 0, 0); } while (0)
#define PG8_STA(bufoff, sp, gp, o0, o1) do { if constexpr (GA) PG8_STAGEA(bufoff, gp, o0, o1); else PG8_STAGE(bufoff, sp, voffA); } while (0)
#define PG8_LDA(dst, b, h) do { _Pragma("unroll") for (int m = 0; m < 4; ++m) _Pragma("unroll") for (int k = 0; k < 2; ++k) dst[m][k] = *(const LAS bf16x8*)(lds + PG8_SA(b, h) + aoff + m * 2048 + k * 1024); } while (0)
#define PG8_LDB(dst, b, h) do { _Pragma("unroll") for (int n = 0; n < 2; ++n) _Pragma("unroll") for (int k = 0; k < 2; ++k) dst[n][k] = *(const LAS bf16x8*)(lds + PG8_SB(b, h) + boff + n * 2048 + k * 1024); } while (0)
#define PG8_MMA(ai, bj, At, Bt) do { __builtin_amdgcn_s_setprio(1); _Pragma("unroll") for (int m = 0; m < 4; ++m) _Pragma("unroll") for (int n = 0; n < 2; ++n) _Pragma("unroll") for (int k = 0; k < 2; ++k) \
        acc[ai][bj][m][n] = __builtin_amdgcn_mfma_f32_16x16x32_bf16(Bt[n][k], At[m][k], acc[ai][bj][m][n], 0, 0, 0); __builtin_amdgcn_s_setprio(0); } while (0)
#define PG8_WAIT_V(n) asm volatile("s_waitcnt vmcnt(" #n ")" ::: "memory")
#define PG8_WAIT_L(n) asm volatile("s_waitcnt lgkmcnt(" #n ")" ::: "memory")
#define PG8_BAR __builtin_amdgcn_s_barrier()
#define PG8_SCHED __builtin_amdgcn_sched_barrier(0)
#define PG8_GOFF(u, o00, o01, o10, o11) do { int _tz = g.tid; asm volatile("" : "+v"(_tz)); int _R0, _C0, _R1, _C1; stage_rc(_tz * 16, _R0, _C0); stage_rc(_tz * 16 + 8192, _R1, _C1); \
        o00 = (unsigned)(S.arow(u, _R0) * K + _C0) * 2u; o01 = (unsigned)(S.arow(u, _R1) * K + _C1) * 2u; \
        o10 = (unsigned)(S.arow(u, HALF + _R0) * K + _C0) * 2u; o11 = (unsigned)(S.arow(u, HALF + _R1) * K + _C1) * 2u; } while (0)
    Unit cur, nxt; int ui = 0;
    if (!S.next(0, cur)) return;
    f32x4 acc[2][2][4][2];
#pragma unroll
    for (int a = 0; a < 2; ++a)
#pragma unroll
        for (int b = 0; b < 2; ++b)
#pragma unroll
            for (int m = 0; m < 4; ++m)
#pragma unroll
                for (int n = 0; n < 2; ++n) acc[a][b][m][n] = (f32x4){0.f, 0.f, 0.f, 0.f};
    bf16x8 At[4][2], B0[2][2], B1[2][2];
    const char* const gA = (const char*)g.A;
    unsigned c00 = 0, c01 = 0, c10 = 0, c11 = 0, n00 = 0, n01 = 0, n10 = 0, n11 = 0;
    if constexpr (GA) PG8_GOFF(cur, c00, c01, c10, c11);
    const char* cA = gA + (GA ? (size_t)0 : (size_t)cur.pm * tstep); const char* cB = (const char*)g.Bt + (size_t)cur.pn * tstep;
    PG8_STAGE(PG8_SB(0, 0), cB, voffB); PG8_STAGE(PG8_SB(0, 1), cB + hstep, voffB); PG8_STA(PG8_SA(0, 0), cA, gA, c00, c01); PG8_STA(PG8_SA(0, 1), cA + hstep, gA, c10, c11);
    if (wr == 1) PG8_BAR;
    PG8_WAIT_V(2); PG8_BAR;
    PG8_STAGE(PG8_SB(1, 0), cB + kstep, voffB); PG8_STA(PG8_SA(1, 0), cA + kstep, gA + kstep, c00, c01); PG8_STAGE(PG8_SB(1, 1), cB + hstep + kstep, voffB);
    PG8_WAIT_V(6); PG8_BAR;
    for (;;) {
        const bool has_next = S.next(ui + 1, nxt);
        const char* nA = (has_next && !GA) ? gA + (size_t)nxt.pm * tstep : cA; const char* nB = has_next ? (const char*)g.Bt + (size_t)nxt.pn * tstep : cB;
        if constexpr (GA) { if (has_next) PG8_GOFF(nxt, n00, n01, n10, n11); else { n00 = c00; n01 = c01; n10 = c10; n11 = c11; } }
#pragma unroll 1
        for (int t = 0; t < nt; t += 2) {
            const bool last = (t == nt - 2);
            const char* a1 = cA + (size_t)(t + 1) * kstep;
            const char* a2 = last ? nA : cA + (size_t)(t + 2) * kstep; const char* b2 = last ? nB : cB + (size_t)(t + 2) * kstep;
            const char* a3 = a2 + kstep; const char* b3 = b2 + kstep;
            unsigned x00 = 0, x01 = 0, x10 = 0, x11 = 0;
            if constexpr (GA) { x00 = last ? n00 : c00; x01 = last ? n01 : c01; x10 = last ? n10 : c10; x11 = last ? n11 : c11; }
            PG8_LDB(B0, 0, 0); PG8_LDB(B1, 0, 1); PG8_SCHED; PG8_LDA(At, 0, 0); PG8_STA(PG8_SA(1, 1), a1 + hstep, a1, c10, c11);
            PG8_WAIT_V(8); PG8_WAIT_L(0); PG8_BAR; PG8_MMA(0, 0, At, B0); PG8_MMA(0, 1, At, B1); PG8_BAR; PG8_SCHED;
            PG8_LDA(At, 0, 1); PG8_STAGE(PG8_SB(0, 0), b2, voffB); PG8_STAGE(PG8_SB(0, 1), b2 + hstep, voffB); PG8_STA(PG8_SA(0, 0), a2, a2, x00, x01);
            PG8_WAIT_V(8); PG8_WAIT_L(0); PG8_BAR; PG8_MMA(1, 0, At, B0); PG8_MMA(1, 1, At, B1); PG8_BAR; PG8_SCHED;
            PG8_LDB(B0, 1, 0); PG8_LDB(B1, 1, 1); PG8_SCHED; PG8_LDA(At, 1, 0); PG8_STA(PG8_SA(0, 1), a2 + hstep, a2, x10, x11);
            PG8_WAIT_V(8); PG8_WAIT_L(0); PG8_BAR; PG8_MMA(0, 0, At, B0); PG8_MMA(0, 1, At, B1); PG8_BAR; PG8_SCHED;
            PG8_LDA(At, 1, 1); PG8_STAGE(PG8_SB(1, 0), b3, voffB); PG8_STAGE(PG8_SB(1, 1), b3 + hstep, voffB); PG8_STA(PG8_SA(1, 0), a3, a3, x00, x01);
            PG8_WAIT_V(8); PG8_WAIT_L(0); PG8_BAR; PG8_MMA(1, 0, At, B0); PG8_MMA(1, 1, At, B1); PG8_BAR; PG8_SCHED;
        }
#if PG8_ALIGN
        if (wr == 0) PG8_BAR;
#endif
        { int ln = (int)__builtin_amdgcn_mbcnt_hi(~0u, __builtin_amdgcn_mbcnt_lo(~0u, 0u)); asm volatile("" : "+v"(ln));
          E(acc, cur, wr, wc, ln & 15, ln >> 4); }
        if (!has_next) break;
#pragma unroll
        for (int a = 0; a < 2; ++a)
#pragma unroll
            for (int b = 0; b < 2; ++b)
#pragma unroll
                for (int m = 0; m < 4; ++m)
#pragma unroll
                    for (int n = 0; n < 2; ++n) acc[a][b][m][n] = (f32x4){0.f, 0.f, 0.f, 0.f};
        cur = nxt; cA = nA; cB = nB; ++ui;
        if constexpr (GA) { c00 = n00; c01 = n01; c10 = n10; c11 = n11; }
#if PG8_ALIGN
        if (wr == 1) PG8_BAR;
#endif
    }
    PG8_WAIT_V(0);
#if !PG8_ALIGN
    if (wr == 0) PG8_BAR;
#endif
    PG8_BAR;
#undef PG8_SA
#undef PG8_SB
#undef PG8_STAGE
#undef PG8_STAGEA
#undef PG8_STA
#undef PG8_GOFF
#undef PG8_LDA
#undef PG8_LDB
#undef PG8_MMA
#undef PG8_WAIT_V
#undef PG8_WAIT_L
#undef PG8_BAR
#undef PG8_SCHED
}
}

constexpr int NTHR = 512;
constexpr int LDS_SCRATCH = 139264;
constexpr int LDS_MISC = LDS_SCRATCH;
constexpr int LDS_TAB = LDS_MISC + 256;
constexpr int LDS_BYTES = LDS_TAB + 8192;

struct Params { const float* in[34]; float* out; unsigned char* ws; int ph_lo, ph_hi; };

struct Frame {
    const float* const* in; float* out; unsigned char* ws; LAS unsigned char* lds; unsigned* ctl;
    int tid, lane, wave, G, bid;
};

DI int row_b(int row) { return row < RLAT ? (row >> 12) : ((row - RLAT) >> 8); }
DI int row_pos(int row) { return row < RLAT ? (row & 4095) : (SEQ + ((row - RLAT) & 255)); }
DI int row_modsel(int row) { return row < RLAT ? (row >> 12) : 4; }

DI Frame relaunder(const Frame& F0) {
    Frame F = F0; int wv = F0.wave; asm volatile("" : "+s"(wv));
    int ln = (int)__builtin_amdgcn_mbcnt_hi(~0u, __builtin_amdgcn_mbcnt_lo(~0u, 0u)); asm volatile("" : "+v"(ln));
    F.wave = wv; F.lane = ln; F.tid = wv * 64 + ln;
    __attribute__((address_space(1))) unsigned char* w = (__attribute__((address_space(1))) unsigned char*)F0.ws; asm volatile("" : "+s"(w)); F.ws = (unsigned char*)w;
    F.ctl = (unsigned*)(F.ws + WS_CTL);
    int b = F0.bid, g = F0.G; asm volatile("" : "+s"(b), "+s"(g)); F.bid = b; F.G = g;
    return F;
}

DI void prep_fourier_job(const Frame& F, int ly, int g, int kt) {
    LAS float* FW = (LAS float*)F.lds;
    LAS float* CS = FW + 4096;
    LAS float* P = CS + 128;
    LAS float* W = P + 8192;
    const int t = F.tid;
    const float* fw = F.in[21] + ((size_t)ly * 4 + g) * 4096;
    for (int i = t; i < 4096; i += NTHR) FW[i] = fw[i];
    if (t < 64) { float s, c; sincospif((float)t / 32.0f, &s, &c); CS[t] = c; CS[64 + t] = s; }
    { const float* p = F.in[6] + (size_t)ly * DM * DIN + (size_t)(kt * 64 + (t >> 3)) * DIN + 2304 + g * 64 + (t & 7) * 8;
      const f32x4 a = *(const f32x4*)p, b = *(const f32x4*)(p + 4);
      LAS float* q = W + (t >> 3) * 65 + (t & 7) * 8;
      q[0] = a[0]; q[1] = a[1]; q[2] = a[2]; q[3] = a[3]; q[4] = b[0]; q[5] = b[1]; q[6] = b[2]; q[7] = b[3]; }
    __syncthreads();
    for (int i = t; i < 8192; i += NTHR) {
        const int c = i >> 7, n = i & 127, comp = n >> 6, d = n & 63;
        float s = 0.f;
        for (int j = 0; j < 64; ++j) { const int a = (j * c) & 63; const float tr = comp ? -CS[64 + a] : CS[a]; s += tr * FW[j * 64 + d]; }
        P[c * 128 + n] = s;
    }
    __syncthreads();
    bf16_t* dst = (bf16_t*)(F.ws + WS_WIN);
    { const int k = t >> 3, nb = (t & 7) * 16;
      float o[16];
#pragma unroll
      for (int j = 0; j < 16; ++j) o[j] = 0.f;
      for (int c = 0; c < 64; ++c) { const float w = W[k * 65 + c];
#pragma unroll
          for (int j = 0; j < 16; ++j) o[j] += w * P[c * 128 + nb + j]; }
#pragma unroll
      for (int j = 0; j < 16; ++j) { const int n = nb + j, comp = n >> 6, d = n & 63;
          dst[(size_t)(2304 + comp * 256 + g * 64 + d) * DM + kt * 64 + k] = f2bf(o[j]); } }
    __syncthreads();
}

struct PrepJob { const float* src; bf16_t* dst; int ldn, ldk, row0, hi_step; };
DI PrepJob prep_job(const Frame& F, int ly, int j) {
    constexpr int J1 = 144, J2 = J1 + 64, J3 = J2 + 1040, J4 = J3 + 1040;
    PrepJob r;
    if (j < J1) { const int kb = j / 9, nb = j % 9;
        r.src = F.in[6] + (size_t)ly * DM * DIN + (size_t)kb * 64 * DIN + nb * 256; r.ldn = DIN; r.dst = (bf16_t*)(F.ws + WS_WIN) + kb * 64; r.ldk = DM; r.row0 = nb * 256; r.hi_step = 128;
    } else if (j < J2) { const int q = j - J1, kb = q >> 2, nb = q & 3;
        r.src = F.in[7] + (size_t)ly * DM * DM + (size_t)kb * 64 * DM + nb * 256; r.ldn = DM; r.dst = (bf16_t*)(F.ws + WS_WOUT) + kb * 64; r.ldk = DM; r.row0 = nb * 256; r.hi_step = 128;
    } else if (j < J4) { const bool up = j >= J3; const int q = j - (up ? J3 : J2), e = q >> 4, kb = q & 15;
        const float* src = e < NEXP ? F.in[up ? 29 : 28] + ((size_t)ly * NEXP + e) * DM * DEXP : F.in[up ? 32 : 31] + (size_t)ly * DM * DEXP;
        r.src = src + (size_t)kb * 64 * DEXP; r.ldn = DEXP; r.dst = (bf16_t*)(F.ws + WS_WGU) + kb * 64; r.ldk = DM; r.row0 = e * 512 + (up ? 128 : 0); r.hi_step = 256;
    } else { const int q = j - J4, e = q >> 4, kb = (q >> 2) & 3, nb = q & 3;
        const float* src = e < NEXP ? F.in[30] + ((size_t)ly * NEXP + e) * DEXP * DM : F.in[33] + (size_t)ly * DEXP * DM;
        r.src = src + (size_t)kb * 64 * DM + nb * 256; r.ldn = DM; r.dst = (bf16_t*)(F.ws + WS_WD) + kb * 64; r.ldk = DEXP; r.row0 = e * DM + nb * 256; r.hi_step = 128; }
    return r;
}
DI void prep_load(const Frame& F, const PrepJob& jb, f32x4 (&v)[8]) {
    const float* p = jb.src + (size_t)(8 * (F.tid >> 6)) * jb.ldn + 4 * (F.tid & 63);
#pragma unroll
    for (int i = 0; i < 8; ++i) v[i] = __builtin_nontemporal_load((const f32x4*)(p + (size_t)i * jb.ldn));
}
DI void prep_store(const Frame& F, const PrepJob& jb, const f32x4 (&v)[8]) {
    LAS unsigned char* T = F.lds;
    const int t = F.tid, ln = t & 63, w = t >> 6;
#pragma unroll
    for (int pr = 0; pr < 4; ++pr)
#pragma unroll
        for (int e = 0; e < 4; ++e) *(LAS unsigned*)(T + (4 * ln + e) * 132 + (8 * w + 2 * pr) * 2) = cvt_pk_bf16(v[2 * pr][e], v[2 * pr + 1][e]);
    asm volatile("s_waitcnt lgkmcnt(0)" ::: "memory"); __builtin_amdgcn_s_barrier();
#pragma unroll
    for (int q = 0; q < 4; ++q) { const int n = q * 64 + (t >> 3), ch = t & 7;
        const LAS unsigned* r = (const LAS unsigned*)(T + n * 132 + ch * 16);
        u32x4 o; o.x = r[0]; o.y = r[1]; o.z = r[2]; o.w = r[3];
        *(u32x4*)(jb.dst + (size_t)(jb.row0 + (n >> 7) * jb.hi_step + (n & 127)) * jb.ldk + ch * 8) = o; }
    asm volatile("s_waitcnt lgkmcnt(0)" ::: "memory"); __builtin_amdgcn_s_barrier();
}
DI void prep_small(const Frame& F, int ly) {
    for (int j = F.bid; j < 208; j += F.G) { const PrepJob jb = prep_job(F, ly, j); f32x4 v[8]; prep_load(F, jb, v); prep_store(F, jb, v); }
    for (int q = F.G - 1 - F.bid; q < 64; q += F.G) prep_fourier_job(F, ly, q >> 4, q & 15);
}
DI void prep_small_dyn(const Frame& F0, int ly) {
    const Frame F = relaunder(F0);
    volatile LAS unsigned* MISC = (volatile LAS unsigned*)(F.lds + LDS_MISC);
    for (;;) {
        __syncthreads();
        if (F.tid == 0) MISC[18] = atomicAdd(F.ctl + CW_PREPQ3 + 64 * ly, 1u);
        __syncthreads();
        const int j = (int)MISC[18];
        if (j >= 272) break;
        if (j < 64) prep_fourier_job(F, ly, j >> 4, j & 15);
        else { const PrepJob jb = prep_job(F, ly, j - 64); f32x4 v[8]; prep_load(F, jb, v); prep_store(F, jb, v); }
    }
}
constexpr int PREP_CHUNK = 2, PREP_NJOBS = 3 * 1040;
DI void prep_experts(const Frame& F0, int ly, int cw, int j_lo, int j_hi) {
    const Frame F = relaunder(F0);
    volatile LAS unsigned* MISC = (volatile LAS unsigned*)(F.lds + LDS_MISC);
    for (;;) {
        __syncthreads();
        if (F.tid == 0) MISC[17] = atomicAdd(F.ctl + cw + 64 * ly, (unsigned)PREP_CHUNK);
        __syncthreads();
        const int base = j_lo + (int)MISC[17];
        if (base >= j_hi) break;
        const int end = base + PREP_CHUNK < j_hi ? base + PREP_CHUNK : j_hi;
        int j = base;
        PrepJob cur = prep_job(F, ly, 208 + j); f32x4 va[8]; prep_load(F, cur, va);
#pragma unroll 1
        for (;;) {
            const int jn = j + 1; const bool more = jn < end;
            PrepJob nxt = cur; f32x4 vb[8];
            if (more) { nxt = prep_job(F, ly, 208 + jn); prep_load(F, nxt, vb); }
            prep_store(F, cur, va);
            if (!more) break;
            cur = nxt; j = jn;
#pragma unroll
            for (int i = 0; i < 8; ++i) va[i] = vb[i];
        }
    }
}

DI void prep_mod(const Frame& F) {
    LAS float* S = (LAS float*)F.lds;
    LAS float* RED = S + 5 * 1024;
    const int t = F.tid;
    bool have_s = false;
    for (int u = F.bid; u < DEPTH * 96; u += F.G) {
        const int ly = u / 96, cg = u % 96;
        if (!have_s) {
            for (int i = t; i < 5 * 1024; i += NTHR) { const int r = i >> 10, k = i & 1023; const float x = r < 4 ? F.in[1][r * DM + k] : F.in[3][k]; S[i] = x / (1.f + expf(-x)); }
            __syncthreads(); have_s = true;
        }
        const int tq = t & 15, tk = t >> 4;
        const float* w = F.in[4] + (size_t)ly * DM * 6144 + cg * 64 + tq * 4;
        f32x4 acc[5];
#pragma unroll
        for (int r = 0; r < 5; ++r) acc[r] = (f32x4){0.f, 0.f, 0.f, 0.f};
#pragma unroll 1
        for (int k8 = 0; k8 < 32; k8 += 8) { f32x4 wv[8];
#pragma unroll
            for (int q = 0; q < 8; ++q) wv[q] = *(const f32x4*)(w + (size_t)(tk * 32 + k8 + q) * 6144);
#pragma unroll
            for (int q = 0; q < 8; ++q)
#pragma unroll
                for (int r = 0; r < 5; ++r) acc[r] += wv[q] * S[r * 1024 + tk * 32 + k8 + q]; }
#pragma unroll
        for (int r = 0; r < 5; ++r)
#pragma unroll
            for (int j = 0; j < 4; ++j) RED[(tk * 5 + r) * 64 + tq * 4 + j] = acc[r][j];
        __syncthreads();
        if (t < 320) { const int r = t >> 6, c = t & 63; float s = 0.f;
            for (int q = 0; q < 32; ++q) s += RED[(q * 5 + r) * 64 + c];
            const int col = cg * 64 + c;
            ((float*)(F.ws + WS_MOD))[((size_t)ly * 5 + r) * 6144 + col] = s + F.in[5][(size_t)ly * 6144 + col]; }
        __syncthreads();
    }
}

DI void prep_filters(const Frame& F) {
    LAS float* Z = (LAS float*)F.lds;
    LAS float* A1 = Z + 64 * 33;
    LAS float* A2 = A1 + 4096;
    for (int u = F.G - 1 - F.bid; u < DEPTH * 68; u += F.G) {
        int t = F.tid; asm volatile("" : "+v"(t));
        const int ly = u / 68, ch = u % 68; const bool lat = ch < 64; const int Lx = lat ? SEQ : CTXL, t0 = lat ? ch * 64 : (ch - 64) * 64;
        for (int i = t; i < 64 * 33; i += NTHR) { const int tt = i / 33, f = i % 33; const int ti = t0 + tt;
            float v;
            if (f == 0) v = (float)ti / (float)(Lx - 1);
            else { const int j = (f - 1) & 15; const float fb = 1e-4f + (float)j * ((15.0f - 1e-4f) / 15.0f); const float om = (6.283185307179586f / (float)Lx) * (float)ti;
                   v = f <= 16 ? cosf(fb * om) : -sinf(fb * om); }
            Z[i] = v; }
        __syncthreads();
        const float* w1 = F.in[9] + (size_t)ly * 33 * 64; const float* b1 = F.in[10] + ly * 64; const float* w2 = F.in[11] + (size_t)ly * 4096; const float* b2 = F.in[12] + ly * 64;
        const float* w3 = F.in[13] + (size_t)ly * 64 * 1024; const float* fq = F.in[14] + ly * 64;
        for (int i = t; i < 4096; i += NTHR) { const int tt = i >> 6, h = i & 63; float s = b1[h];
            for (int f = 0; f < 33; ++f) s += Z[tt * 33 + f] * w1[f * 64 + h];
            A1[i] = sinf(fq[h] * s); }
        __syncthreads();
        for (int i = t; i < 4096; i += NTHR) { const int tt = i >> 6, h = i & 63; float s = b2[h];
            for (int j = 0; j < 64; ++j) s += A1[tt * 64 + j] * w2[j * 64 + h];
            A2[i] = sinf(fq[h] * s); }
        __syncthreads();
        { float wr0[64], wr1[64];
#pragma unroll
          for (int j = 0; j < 64; ++j) { wr0[j] = w3[j * 1024 + t]; wr1[j] = w3[j * 1024 + 512 + t]; }
          const int c = t & 255, dir = t >> 8;
          const float delta = fabsf(-3.0701134573253946f + (float)c * ((-15.350567286626973f + 3.0701134573253946f) / 255.0f));
          float* d0 = lat ? (float*)(F.ws + WS_HCL) + ((((size_t)ly * 2 + 0) * 2 + dir) * 256 + c) * SEQ + t0 : (float*)(F.ws + WS_HCC) + ((((size_t)ly * 2 + 0) * 2 + dir) * 256 + c) * CTXL + t0;
          float* d1 = lat ? (float*)(F.ws + WS_HCL) + ((((size_t)ly * 2 + 1) * 2 + dir) * 256 + c) * SEQ + t0 : (float*)(F.ws + WS_HCC) + ((((size_t)ly * 2 + 1) * 2 + dir) * 256 + c) * CTXL + t0;
#pragma unroll 1
          for (int tt = 0; tt < 64; ++tt) { float s0 = 0.f, s1 = 0.f;
#pragma unroll
            for (int j = 0; j < 64; j += 4) { const f32x4 a = *(const LAS f32x4*)(A2 + tt * 64 + j);
                s0 += a[0] * wr0[j] + a[1] * wr0[j + 1] + a[2] * wr0[j + 2] + a[3] * wr0[j + 3]; s1 += a[0] * wr1[j] + a[1] * wr1[j + 1] + a[2] * wr1[j + 2] + a[3] * wr1[j + 3];
                if ((j & 12) == 12) asm volatile("" ::: "memory"); }
            const float dec = expf(-((float)(t0 + tt) / (float)(Lx - 1)) * delta);
            d0[tt] = s0 * dec; d1[tt] = s1 * dec; } }
        __syncthreads();
    }
}

DI void prep_tables(const Frame& F) {
    LAS float* CT = (LAS float*)F.lds;
    const int t = F.tid;
    for (int i = t; i < 4096; i += NTHR) CT[i] = cospif((float)i / 2048.0f);
    __syncthreads();
    bf16_t* DC = (bf16_t*)(F.ws + WS_DFTC);
    for (int i = F.bid * NTHR + t; i < CTXL * 512; i += F.G * NTHR) { const int k = i >> 9, cl = i & 511, comp = cl >> 8, l = cl & 255;
        const int idx = ((k * l) & 255) * 16; DC[i] = f2bf((comp ? CT[(idx - 1024) & 4095] : CT[idx]) * (1.0f / 128.0f)); }
    if (F.bid == (F.G > 1 ? 1 : 0) && t < DEPTH) { const int ly = t; const float lam_init = 0.8f - 0.6f * expf(-0.3f * (float)ly); float s1 = 0.f, s2 = 0.f;
        for (int i = 0; i < 32; ++i) { s1 += F.in[16][ly * 32 + i] * F.in[17][ly * 32 + i]; s2 += F.in[18][ly * 32 + i] * F.in[19][ly * 32 + i]; }
        ((float*)(F.ws + WS_LAM))[2 * ly] = expf(s1) - expf(s2) + lam_init; ((float*)(F.ws + WS_LAM))[2 * ly + 1] = lam_init; }
    if (F.bid == 0) { float* RT = (float*)(F.ws + WS_ROPE);
        for (int i = t; i < 512; i += NTHR) { const int p = i >> 3, n = i & 7; const float inv = powf(10000.0f, -(float)n / 8.0f); float s, c; sincosf((float)p * inv, &s, &c); RT[i * 2] = c; RT[i * 2 + 1] = s; } }
    __syncthreads();
}

DI void prep_invl1(const Frame& F) {
    const int gw = F.bid * 8 + F.wave, nw = F.G * 8;
    for (int j = gw; j < DEPTH * 2 * 2 * 256; j += nw) {
        const int ly = j >> 10, lt = (j >> 9) & 1, n = (j >> 8) & 1, c = j & 255;
        const int Lx = lt ? CTXL : SEQ;
        const float* base = lt ? (const float*)(F.ws + WS_HCC) : (const float*)(F.ws + WS_HCL);
        const f32x4* f0 = (const f32x4*)(base + ((((size_t)ly * 2 + n) * 2 + 0) * 256 + c) * Lx);
        const f32x4* f1 = (const f32x4*)(base + ((((size_t)ly * 2 + n) * 2 + 1) * 256 + c) * Lx);
        float s = 0.f;
        if (lt) { const f32x4 a = f0[F.lane], b = f1[F.lane];
            s = fabsf(a[0]) + fabsf(a[1]) + fabsf(a[2]) + fabsf(a[3]) + (F.lane == 0 ? 0.f : fabsf(b[0])) + fabsf(b[1]) + fabsf(b[2]) + fabsf(b[3]);
        } else { f32x4 a[16], b[16];
#pragma unroll
            for (int q = 0; q < 16; ++q) { a[q] = f0[F.lane + 64 * q]; b[q] = f1[F.lane + 64 * q]; }
#pragma unroll
            for (int q = 0; q < 16; ++q) s += fabsf(a[q][0]) + fabsf(a[q][1]) + fabsf(a[q][2]) + fabsf(a[q][3]) + ((q == 0 && F.lane == 0) ? 0.f : fabsf(b[q][0])) + fabsf(b[q][1]) + fabsf(b[q][2]) + fabsf(b[q][3]); }
        s = wave_sum(s);
        if (F.lane == 0) ((float*)(F.ws + WS_INVL1))[j] = 1.0f / s;
    }
}

DI void ln_stats(const f32x4 (&v)[4], float& mu, float& rstd) {
    float s = 0.f;
#pragma unroll
    for (int j = 0; j < 4; ++j) s += (v[j][0] + v[j][1]) + (v[j][2] + v[j][3]);
    mu = wave_sum(s) * (1.0f / DM);
    float q = 0.f;
#pragma unroll
    for (int j = 0; j < 4; ++j)
#pragma unroll
        for (int e = 0; e < 4; ++e) { const float d = v[j][e] - mu; q += d * d; }
    rstd = rsqrtf(wave_sum(q) * (1.0f / DM) + LN_EPS);
}
DI void ln_mod_store(const f32x4 (&v)[4], const float* sh, const float* sc, bf16_t* hrow, int lane) {
    float mu, rstd; ln_stats(v, mu, rstd);
#pragma unroll
    for (int j = 0; j < 4; ++j) { const int c = 4 * lane + 256 * j; const f32x4 a = *(const f32x4*)(sh + c), b = *(const f32x4*)(sc + c);
        float o[4];
#pragma unroll
        for (int e = 0; e < 4; ++e) o[e] = (v[j][e] - mu) * rstd * (1.f + b[e]) + a[e];
        u32x2 w; w.x = cvt_pk_bf16(o[0], o[1]); w.y = cvt_pk_bf16(o[2], o[3]); *(u32x2*)(hrow + c) = w; }
}

DI void phase_init_h(const Frame& F) {
    const int gw = F.bid * 8 + F.wave, nw = F.G * 8;
    const float* MOD = (const float*)(F.ws + WS_MOD);
    for (int row = gw; row < RTOT; row += nw) {
        const float* xr = row < RLAT ? F.in[0] + (size_t)row * DM : F.in[2] + (size_t)(row - RLAT) * DM;
        f32x4 v[4];
#pragma unroll
        for (int j = 0; j < 4; ++j) v[j] = *(const f32x4*)(xr + 4 * F.lane + 256 * j);
        const float* m = MOD + (size_t)(0 * 5 + row_modsel(row)) * 6144;
        ln_mod_store(v, m, m + 1024, (bf16_t*)(F.ws + WS_H) + (size_t)row * DM, F.lane);
    }
}

struct EpiWin {
    static constexpr bool PERM = true;
    unsigned char* ws; int ly;
    DI void operator()(const f32x4 (&acc)[2][2][4][2], const pg8::Unit& u, int wr, int wc, int fr, int fq) const {
        const bool lat = u.pm < 64; const int b = lat ? (u.pm >> 4) : (u.pm - 64); const int pos0 = lat ? ((u.pm & 15) << 8) : SEQ;
        const int pn = u.pn;
        const float* RT = (const float*)(ws + WS_ROPE);
        float kn[2] = {0.f, 0.f};
#pragma unroll
        for (int ai = 0; ai < 2; ++ai)
#pragma unroll
            for (int m = 0; m < 4; ++m) {
                const int pos = pos0 + ai * 128 + wr * 64 + m * 16 + fr;
#pragma unroll
                for (int bj = 0; bj < 2; ++bj) {
                    const int col = pn * 256 + bj * 128 + wc * 32 + fq * 8;
                    float v[8];
#pragma unroll
                    for (int e = 0; e < 4; ++e) { v[e] = acc[ai][bj][m][0][e]; v[4 + e] = acc[ai][bj][m][1][e]; }
                    if (pn < 3) {
                        float* d = (float*)(ws + WS_HYT) + ((size_t)b * 768 + col) * POS + pos;
#pragma unroll
                        for (int e = 0; e < 8; ++e) d[(size_t)e * POS] = v[e];
                    } else if (pn < 7) {
                        const bool isq = pn < 5; const int cq = col - (isq ? 768 : 1280); const int head = cq >> 6, cc = cq & 63;
                        if (lat) { const int axis = (cc >> 4) & 1, n0 = (cc & 15) >> 1; const int pa = axis ? (pos & 63) : (pos >> 6);
                            const float* rt = RT + (pa * 8 + n0) * 2;
#pragma unroll
                            for (int p = 0; p < 4; ++p) { const float cs = rt[2 * p], sn = rt[2 * p + 1]; const float a = v[2 * p], bb = v[2 * p + 1];
                                v[2 * p] = a * cs - bb * sn; v[2 * p + 1] = a * sn + bb * cs; } }
                        if (isq) {
#pragma unroll
                            for (int e = 0; e < 8; ++e) v[e] *= QSCALE; }
                        u32x4 w; w.x = cvt_pk_bf16(v[0], v[1]); w.y = cvt_pk_bf16(v[2], v[3]); w.z = cvt_pk_bf16(v[4], v[5]); w.w = cvt_pk_bf16(v[6], v[7]);
                        bf16_t* d = (bf16_t*)(ws + (isq ? WS_Q : WS_K)) + (((size_t)b * 8 + head) * POS + pos) * 64 + cc;
                        *(u32x4*)d = w;
                        if (!isq) {
                            float s2 = bflo(w.x) * bflo(w.x) + bfhi(w.x) * bfhi(w.x) + bflo(w.y) * bflo(w.y) + bfhi(w.y) * bfhi(w.y) + bflo(w.z) * bflo(w.z) + bfhi(w.z) * bfhi(w.z) + bflo(w.w) * bflo(w.w) + bfhi(w.w) * bfhi(w.w);
                            s2 += __shfl_xor(s2, 16); s2 += __shfl_xor(s2, 32);
                            kn[bj] = fmaxf(kn[bj], s2); }
                    } else if (pn < 9) {
                        const int cv = col - 1792; const int head = cv >> 6, cc = cv & 63;
                        u32x4 w; w.x = cvt_pk_bf16(v[0], v[1]); w.y = cvt_pk_bf16(v[2], v[3]); w.z = cvt_pk_bf16(v[4], v[5]); w.w = cvt_pk_bf16(v[6], v[7]);
                        *(u32x4*)((bf16_t*)(ws + WS_V) + (((size_t)b * 8 + head) * POS + pos) * 64 + cc) = w;
                    } else {
                        const int cy = col - 2304; const int comp = cy >> 8, gd = cy & 255;
                        if (lat) { bf16_t* d = (bf16_t*)(ws + WS_YTL) + ((size_t)b * 256 + gd) * 8192 + comp * 4096 + pos;
#pragma unroll
                            for (int e = 0; e < 8; ++e) d[(size_t)e * 8192] = f2bf(v[e]);
                        } else { bf16_t* d = (bf16_t*)(ws + WS_YTC) + ((size_t)b * 256 + gd) * 512 + comp * 256 + (pos - SEQ);
#pragma unroll
                            for (int e = 0; e < 8; ++e) d[(size_t)e * 512] = f2bf(v[e]); }
                    }
                }
            }
        if (pn == 5 || pn == 6) {
#pragma unroll
            for (int bj = 0; bj < 2; ++bj) { float m = kn[bj];
                m = fmaxf(m, __shfl_xor(m, 1)); m = fmaxf(m, __shfl_xor(m, 2)); m = fmaxf(m, __shfl_xor(m, 4)); m = fmaxf(m, __shfl_xor(m, 8));
                const int cq = pn * 256 + bj * 128 + wc * 32 - 1280; const int head = cq >> 6, comp = (cq >> 5) & 1;
                if (fr == 0 && fq == 0) atomicMax((unsigned*)(ws + WS_CTL) + CW_KMAX + 64 * ly + (b * 8 + head) * 2 + comp, __float_as_uint(m)); }
        }
    }
};

struct EpiFnet {
    static constexpr bool PERM = true;
    unsigned char* ws; int ctx;
    DI void operator()(const f32x4 (&acc)[2][2][4][2], const pg8::Unit& u, int wr, int wc, int fr, int fq) const {
        const int b = u.pn;
#pragma unroll
        for (int ai = 0; ai < 2; ++ai)
#pragma unroll
            for (int m = 0; m < 4; ++m) {
                const int k = u.pm * 256 + ai * 128 + wr * 64 + m * 16 + fr;
                const size_t row = ctx ? (size_t)(RLAT + b * CTXL + k) : (size_t)(b * SEQ + k);
#pragma unroll
                for (int bj = 0; bj < 2; ++bj) { const int gd = bj * 128 + wc * 32 + fq * 8;
                    const f32x4 v0 = acc[ai][bj][m][0], v1 = acc[ai][bj][m][1];
                    u32x4 w; w.x = cvt_pk_bf16(v0[0], v0[1]); w.y = cvt_pk_bf16(v0[2], v0[3]); w.z = cvt_pk_bf16(v1[0], v1[1]); w.w = cvt_pk_bf16(v1[2], v1[3]);
                    *(u32x4*)((bf16_t*)(ws + WS_MIX) + row * DM + 768 + gd) = w; }
            }
    }
};

struct EpiWout {
    static constexpr bool PERM = false;
    unsigned char* ws; int ly; const float* xlat; const float* xctx;
    DI void operator()(const f32x4 (&acc)[2][2][4][2], const pg8::Unit& u, int wr, int wc, int fr, int fq) const {
        const int msel = u.pm < 64 ? (u.pm >> 4) : 4;
        const float* g1 = (const float*)(ws + WS_MOD) + ((size_t)ly * 5 + msel) * 6144 + 2048;
        const int col0 = u.pn * 256 + wc * 32 + 4 * fq;
        const float* src = ly == 0 ? (u.pm < 64 ? xlat + (size_t)u.pm * 256 * DM : xctx + (size_t)(u.pm - 64) * 256 * DM) : (const float*)(ws + WS_X) + (size_t)u.pm * 256 * DM;
        f32x4 gv[2][2];
#pragma unroll
        for (int bj = 0; bj < 2; ++bj)
#pragma unroll
            for (int n = 0; n < 2; ++n) gv[bj][n] = *(const f32x4*)(g1 + col0 + bj * 128 + n * 16);
#pragma unroll
        for (int ai = 0; ai < 2; ++ai)
#pragma unroll
            for (int m = 0; m < 4; ++m) { const size_t ro = (size_t)(ai * 128 + wr * 64 + m * 16 + fr) * DM + col0;
                float* rowp = (float*)(ws + WS_X) + (size_t)u.pm * 256 * DM + ro;
#pragma unroll
                for (int bj = 0; bj < 2; ++bj)
#pragma unroll
                    for (int n = 0; n < 2; ++n) { const f32x4 xin = *(const f32x4*)(src + ro + bj * 128 + n * 16); *(f32x4*)(rowp + bj * 128 + n * 16) = xin * ALPHA + gv[bj][n] * acc[ai][bj][m][n]; } }
    }
};

struct MoeTab { LAS int* cnt; LAS int* tstart; LAS int* tile_e; int ntiles; };
DI MoeTab moe_tables(const Frame& F, int ly) {
    MoeTab T; T.cnt = (LAS int*)(F.lds + LDS_TAB); T.tstart = T.cnt + 72; T.tile_e = T.tstart + 72;
    __syncthreads();
    if (F.tid < 65) T.cnt[F.tid] = F.tid < NEXP ? (int)__hip_atomic_load(F.ctl + CW_CNT + (ly * 64 + F.tid) * CNT_STRIDE, __ATOMIC_RELAXED, __HIP_MEMORY_SCOPE_AGENT) : (ly == DEPTH - 1 ? RLAT : RTOT);
    __syncthreads();
    if (F.tid == 0) { int s = 0; for (int e = 0; e < 65; ++e) { T.tstart[e] = s; s += (T.cnt[e] + 255) >> 8; } T.tstart[65] = s; }
    __syncthreads();
    const int nt = T.tstart[65];
    for (int e = F.tid; e < 65; e += NTHR) for (int q = T.tstart[e]; q < T.tstart[e + 1]; ++q) if (q < MAXTILES) T.tile_e[q] = e;
    __syncthreads();
    T.ntiles = __builtin_amdgcn_readfirstlane(nt < MAXTILES ? nt : MAXTILES);
    return T;
}
template <bool GATHER_> struct MoeSched {
    static constexpr bool GATHER = GATHER_;
    MoeTab T; const int* list; int G, c, nsub, shift;
    DI bool next(int i, pg8::Unit& u) const {
        const int L = i * G + c; if (L >= T.ntiles * nsub) return false;
        const int tile = L >> shift, j = L & (nsub - 1); const int e = __builtin_amdgcn_readfirstlane(T.tile_e[tile]);
        u.pm = tile; u.pn = e * nsub + j; u.e = e; u.lt = tile - __builtin_amdgcn_readfirstlane(T.tstart[e]); return true;
    }
    DI int arow(const pg8::Unit& u, int r) const {
        if (!GATHER_) return u.pm * 256 + r;
        const int idx = u.lt * 256 + r;
        if (u.e == NEXP) return idx;
        return idx < T.cnt[u.e] ? (list[(size_t)u.e * RTOT + idx] >> 3) : 0;
    }
};
DI float silu_f(float x) { return x / (1.f + __expf(-x)); }
struct EpiMoe1 {
    static constexpr bool PERM = true;
    unsigned char* ws;
    DI void operator()(const f32x4 (&acc)[2][2][4][2], const pg8::Unit& u, int wr, int wc, int fr, int fq) const {
        const int hid = (u.pn & 1) * 128 + wc * 32 + fq * 8;
#pragma unroll
        for (int ai = 0; ai < 2; ++ai)
#pragma unroll
            for (int m = 0; m < 4; ++m) { const size_t row = (size_t)u.pm * 256 + ai * 128 + wr * 64 + m * 16 + fr;
                float o[8];
#pragma unroll
                for (int n = 0; n < 2; ++n)
#pragma unroll
                    for (int e = 0; e < 4; ++e) o[n * 4 + e] = silu_f(acc[ai][0][m][n][e]) * acc[ai][1][m][n][e];
                u32x4 w; w.x = cvt_pk_bf16(o[0], o[1]); w.y = cvt_pk_bf16(o[2], o[3]); w.z = cvt_pk_bf16(o[4], o[5]); w.w = cvt_pk_bf16(o[6], o[7]);
                *(u32x4*)((bf16_t*)(ws + WS_ACT) + row * DEXP + hid) = w; }
    }
};
struct EpiMoe2 {
    static constexpr bool PERM = true;
    unsigned char* ws;
    DI void operator()(const f32x4 (&acc)[2][2][4][2], const pg8::Unit& u, int wr, int wc, int fr, int fq) const {
        const int colb = (u.pn & 3) * 256 + wc * 32 + fq * 8;
#pragma unroll
        for (int ai = 0; ai < 2; ++ai)
#pragma unroll
            for (int m = 0; m < 4; ++m) { const size_t row = (size_t)u.pm * 256 + ai * 128 + wr * 64 + m * 16 + fr;
#pragma unroll
                for (int bj = 0; bj < 2; ++bj) { const f32x4 v0 = acc[ai][bj][m][0], v1 = acc[ai][bj][m][1];
                    u32x4 w; w.x = cvt_pk_bf16(v0[0], v0[1]); w.y = cvt_pk_bf16(v0[2], v0[3]); w.z = cvt_pk_bf16(v1[0], v1[1]); w.w = cvt_pk_bf16(v1[2], v1[3]);
                    __builtin_nontemporal_store(w, (u32x4*)((bf16_t*)(ws + WS_YB) + row * DM + colb + bj * 128)); } }
    }
};

DI float hy_short(const float* hy, int l, int Lx, float w0, float w1, float w2) {
    const float a = l > 0 ? hy[l - 1] : 0.f, b = hy[l], c = l + 1 < Lx ? hy[l + 1] : 0.f;
    return w0 * a + w1 * b + w2 * c;
}
DI void hyena_ctx_unit(const Frame& F, int ly, int c) {
    LAS float* KC = (LAS float*)F.lds;
    LAS float* UC = KC + 1024;
    LAS float* PS = UC + 1024;
    const int t = F.tid;
    const float* HYT = (const float*)(F.ws + WS_HYT);
    const float* scw = F.in[8] + (size_t)ly * 3 * 768;
    const float* invl = (const float*)(F.ws + WS_INVL1) + (size_t)ly * 1024;
    const float bias0 = F.in[15][(size_t)ly * 512 + c], bias1 = F.in[15][(size_t)ly * 512 + 256 + c];
    float wx1[3], wx2[3], wv[3];
#pragma unroll
    for (int j = 0; j < 3; ++j) { wx1[j] = scw[j * 768 + c]; wx2[j] = scw[j * 768 + 256 + c]; wv[j] = scw[j * 768 + 512 + c]; }
    bf16_t* MIX = (bf16_t*)(F.ws + WS_MIX);
    for (int n = 0; n < 2; ++n) { const float inv = invl[(1 * 2 + n) * 256 + c];
        const float* hf = (const float*)(F.ws + WS_HCC) + ((((size_t)ly * 2 + n) * 2 + 0) * 256 + c) * CTXL;
        const float* hb = (const float*)(F.ws + WS_HCC) + ((((size_t)ly * 2 + n) * 2 + 1) * 256 + c) * CTXL;
        for (int i = t; i < 512; i += NTHR) { const int d = i - 256; KC[n * 512 + i] = d >= 0 ? hf[d] * inv : (d > -256 ? hb[-d] * inv : 0.f); } }
    for (int i = t; i < 4 * CTXL; i += NTHR) { const int b = i >> 8, l = i & 255;
        UC[l * 4 + b] = hy_short(HYT + ((size_t)b * 768 + 512 + c) * POS + SEQ, l, CTXL, wv[0], wv[1], wv[2]); }
    __syncthreads();
    const int t0 = (t & 63) * 4, bp = (t >> 6) & 1, sq = t >> 7;
    const int tt = t & 255, bq = t >> 8;
    for (int n = 0; n < 2; ++n) {
        float a[4][2];
#pragma unroll
        for (int j = 0; j < 4; ++j) { a[j][0] = 0.f; a[j][1] = 0.f; }
        const LAS float* kf = KC + n * 512 + 256 + t0;
#pragma unroll 4
        for (int s = sq * 64; s < sq * 64 + 64; ++s) { const float u0 = UC[s * 4 + 2 * bp], u1 = UC[s * 4 + 2 * bp + 1];
#pragma unroll
            for (int j = 0; j < 4; ++j) { const float k = kf[j - s]; a[j][0] += k * u0; a[j][1] += k * u1; } }
#pragma unroll
        for (int j = 0; j < 4; ++j) { PS[(sq * 256 + t0 + j) * 4 + 2 * bp] = a[j][0]; PS[(sq * 256 + t0 + j) * 4 + 2 * bp + 1] = a[j][1]; }
        __syncthreads();
        float y0 = 0.f, y1 = 0.f;
#pragma unroll
        for (int q = 0; q < 4; ++q) { y0 += PS[(q * 256 + tt) * 4 + 2 * bq]; y1 += PS[(q * 256 + tt) * 4 + 2 * bq + 1]; }
        const int xch = n == 0 ? c : 256 + c; const float* wg = n == 0 ? wx1 : wx2; const float bias = n == 0 ? bias0 : bias1;
        const float g0 = hy_short(HYT + ((size_t)(2 * bq) * 768 + xch) * POS + SEQ, tt, CTXL, wg[0], wg[1], wg[2]);
        const float g1 = hy_short(HYT + ((size_t)(2 * bq + 1) * 768 + xch) * POS + SEQ, tt, CTXL, wg[0], wg[1], wg[2]);
        const float z0 = g0 * (y0 + bias * UC[tt * 4 + 2 * bq]), z1 = g1 * (y1 + bias * UC[tt * 4 + 2 * bq + 1]);
        __syncthreads();
        if (n == 0) { UC[tt * 4 + 2 * bq] = z0; UC[tt * 4 + 2 * bq + 1] = z1; __syncthreads(); }
        else { MIX[((size_t)RLAT + (2 * bq) * CTXL + tt) * DM + c] = f2bf(z0); MIX[((size_t)RLAT + (2 * bq + 1) * CTXL + tt) * DM + c] = f2bf(z1); }
    }
    __syncthreads();
}

DI unsigned cx_addr(unsigned e) { return e * 8u + (e >> 5) * 16u; }
constexpr int cx_bytes(int n) { return n * 8 + (n / 32) * 16; }
typedef float f32x2 __attribute__((ext_vector_type(2)));
template <int R> DI constexpr int brev(int q) { int r = 0; for (int i = 1, j = R >> 1; i < R; i <<= 1, j >>= 1) if (q & i) r |= j; return r; }
typedef f32x2 cx;
DI cx cx_mul(cx x, float c, float s) { const cx sw = __builtin_shufflevector(x, x, 1, 0); return x * c + sw * (cx){-s, s}; }
DI cx cx_cmul(cx x, cx y) { const cx sw = __builtin_shufflevector(x, x, 1, 0), y0 = __builtin_shufflevector(y, y, 0, 0), y1 = __builtin_shufflevector(y, y, 1, 1);
    return x * y0 + sw * (y1 * (cx){-1.f, 1.f}); }
template <int R, bool INV> DI void dft_inreg(cx (&v)[R]) {
#pragma unroll
    for (int len = R; len >= 2; len >>= 1) { const int half = len >> 1;
#pragma unroll
        for (int base = 0; base < R; base += len)
#pragma unroll
            for (int j = 0; j < half; ++j) { const cx a = v[base + j], bq = v[base + j + half]; v[base + j] = a + bq; v[base + j + half] = a - bq; }
#pragma unroll
        for (int base = 0; base < R; base += len)
#pragma unroll
            for (int j = 1; j < half; ++j) { const cx d = v[base + j + half];
                if (4 * j == len) v[base + j + half] = INV ? (cx){-d[1], d[0]} : (cx){d[1], -d[0]};
                else { const float c = __builtin_cosf(6.283185307179586f * (float)j / (float)len), sn = (INV ? 1.f : -1.f) * __builtin_sinf(6.283185307179586f * (float)j / (float)len);
                    v[base + j + half] = cx_mul(d, c, sn); } }
    }
}
template <int R, bool INV, int S> DI void fft_bfly(LAS unsigned char* seq, int j) {
    constexpr int Lcur = R * S;
    int jj = j; asm volatile("" : "+v"(jj));
    const int blk = jj / S, o = jj % S;
    LAS unsigned char* p = seq + cx_addr((unsigned)(blk * Lcur + o));
#define FFT_OFF(r) ((r) * S * 8 + ((((r) * S) >> 5) * 16))
    cx v[R];
    if (S == 1) {
#pragma unroll
        for (int r = 0; r < R; r += 2) { const f32x4 q = *(const LAS f32x4*)(p + FFT_OFF(r)); v[r] = (cx){q[0], q[1]}; v[r + 1] = (cx){q[2], q[3]}; }
    } else {
#pragma unroll
        for (int r = 0; r < R; ++r) v[r] = *(const LAS f32x2*)(p + FFT_OFF(r));
    }
    if (S == 1) {
        dft_inreg<R, INV>(v);
    } else {
        const float fr = (float)o * (1.0f / (float)Lcur);
        cx w[R];
        w[1] = (cx){__builtin_amdgcn_cosf(fr), INV ? __builtin_amdgcn_sinf(fr) : -__builtin_amdgcn_sinf(fr)};
#pragma unroll
        for (int q = 2; q < R; ++q) { const int a = (q & (q - 1)) ? (q & -q) : (q >> 1), bq = q - a;
            w[q] = cx_cmul(w[a], w[bq]); }
        if (!INV) {
            dft_inreg<R, false>(v);
#pragma unroll
            for (int q = 1; q < R; ++q) { const int k = brev<R>(q); v[k] = cx_cmul(v[k], w[q]); }
        } else {
#pragma unroll
            for (int q = 1; q < R; ++q) v[q] = cx_cmul(v[q], w[q]);
            dft_inreg<R, true>(v);
        }
    }
    if (S == 1) {
#pragma unroll
        for (int r = 0; r < R; r += 2) { const int k0 = brev<R>(r), k1 = brev<R>(r + 1); *(LAS f32x4*)(p + FFT_OFF(r)) = (f32x4){v[k0][0], v[k0][1], v[k1][0], v[k1][1]}; }
    } else {
#pragma unroll
        for (int r = 0; r < R; ++r) { const int k = brev<R>(r); *(LAS f32x2*)(p + FFT_OFF(r)) = v[k]; }
    }
#undef FFT_OFF
}
template <bool INV> DI void fft8192x2(LAS unsigned char* lds, int tid) {
    constexpr int SB = cx_bytes(8192);
    if (!INV) {
        fft_bfly<16, false, 512>(lds, tid); __builtin_amdgcn_sched_barrier(0); fft_bfly<16, false, 512>(lds + SB, tid); __syncthreads();
        fft_bfly<16, false, 32>(lds, tid); __builtin_amdgcn_sched_barrier(0); fft_bfly<16, false, 32>(lds + SB, tid); __syncthreads();
        fft_bfly<32, false, 1>(lds + (tid >> 8) * SB, tid & 255); __syncthreads();
    } else {
        fft_bfly<32, true, 1>(lds + (tid >> 8) * SB, tid & 255); __syncthreads();
        fft_bfly<16, true, 32>(lds, tid); __builtin_amdgcn_sched_barrier(0); fft_bfly<16, true, 32>(lds + SB, tid); __syncthreads();
        fft_bfly<16, true, 512>(lds, tid); __builtin_amdgcn_sched_barrier(0); fft_bfly<16, true, 512>(lds + SB, tid); __syncthreads();
    }
}
DI void fft4096x4(LAS unsigned char* lds, int tid) {
    constexpr int SB = cx_bytes(4096);
    const int sq = tid >> 8, j = tid & 255;
    fft_bfly<16, false, 256>(lds + sq * SB, j); __builtin_amdgcn_sched_barrier(0); fft_bfly<16, false, 256>(lds + (sq + 2) * SB, j); __syncthreads();
    fft_bfly<16, false, 16>(lds + sq * SB, j); __builtin_amdgcn_sched_barrier(0); fft_bfly<16, false, 16>(lds + (sq + 2) * SB, j); __syncthreads();
    fft_bfly<16, false, 1>(lds + sq * SB, j); __builtin_amdgcn_sched_barrier(0); fft_bfly<16, false, 1>(lds + (sq + 2) * SB, j); __syncthreads();
}

DI void hy_short8(const float* hp, int l0, float w0, float w1, float w2, float (&out)[8]) {
    const f32x4 h0 = *(const f32x4*)(hp + l0), h1 = *(const f32x4*)(hp + l0 + 4);
    const float hm = l0 > 0 ? hp[l0 - 1] : 0.f, hn = l0 + 8 < SEQ ? hp[l0 + 8] : 0.f;
    const float hv[10] = {hm, h0[0], h0[1], h0[2], h0[3], h1[0], h1[1], h1[2], h1[3], hn};
#pragma unroll
    for (int j = 0; j < 8; ++j) out[j] = w0 * hv[j] + w1 * hv[j + 1] + w2 * hv[j + 2];
}
DI void hyena_fft_unit(const Frame& F, int ly, int c) {
    LAS unsigned char* L = F.lds; constexpr int SB = cx_bytes(8192);
    const int t = F.tid;
    const unsigned pt = cx_addr((unsigned)t), pl = cx_addr((unsigned)t * 8u);
    const float* HYT = (const float*)(F.ws + WS_HYT);
    const float* scw = F.in[8] + (size_t)ly * 3 * 768;
    const float* invl = (const float*)(F.ws + WS_INVL1) + (size_t)ly * 1024;
    const float bias0 = F.in[15][(size_t)ly * 512 + c], bias1 = F.in[15][(size_t)ly * 512 + 256 + c];
    float wx1[3], wx2[3], wv[3];
#pragma unroll
    for (int j = 0; j < 3; ++j) { wx1[j] = scw[j * 768 + c]; wx2[j] = scw[j * 768 + 256 + c]; wv[j] = scw[j * 768 + 512 + c]; }
    f32x2* SPEC = (f32x2*)(F.ws + WS_SPEC) + (size_t)c * 2 * 8192;
#pragma unroll
    for (int n = 0; n < 2; ++n) { const float inv = invl[(0 * 2 + n) * 256 + c] * (1.0f / 8192.0f);
        const float* hf = (const float*)(F.ws + WS_HCL) + ((((size_t)ly * 2 + n) * 2 + 0) * 256 + c) * SEQ;
        const float* hb = (const float*)(F.ws + WS_HCL) + ((((size_t)ly * 2 + n) * 2 + 1) * 256 + c) * SEQ;
        float fv[16];
#pragma unroll
        for (int k = 0; k < 8; ++k) { fv[k] = hf[t + 512 * k]; const int i = SEQ + t + 512 * k; fv[8 + k] = i > SEQ ? hb[8192 - i] : 0.f; }
#pragma unroll
        for (int k = 0; k < 16; ++k) *(LAS f32x2*)(L + n * SB + (pt + 4352u * (unsigned)(k))) = (f32x2){fv[k] * inv, 0.f}; }
    __syncthreads();
    fft8192x2<false>(L, t);
#pragma unroll
    for (int n = 0; n < 2; ++n)
#pragma unroll
        for (int k = 0; k < 16; ++k) SPEC[n * 8192 + t + 512 * k] = *(const LAS f32x2*)(L + n * SB + (pt + 4352u * (unsigned)(k)));
    __syncthreads();
    const int l0 = t * 8;
#pragma unroll 1
    for (int sp = 0; sp < 2; ++sp) {
        float za[8], zb[8];
        hy_short8(HYT + ((size_t)(2 * sp) * 768 + 512 + c) * POS, l0, wv[0], wv[1], wv[2], za);
        hy_short8(HYT + ((size_t)(2 * sp + 1) * 768 + 512 + c) * POS, l0, wv[0], wv[1], wv[2], zb);
#pragma unroll
        for (int j = 0; j < 8; j += 2) {
            *(LAS f32x4*)(L + sp * SB + (pl + 8u * (unsigned)(j))) = (f32x4){za[j], zb[j], za[j + 1], zb[j + 1]};
            *(LAS f32x4*)(L + sp * SB + (pl + 34816u + 8u * (unsigned)(j))) = (f32x4){0.f, 0.f, 0.f, 0.f}; }
    }
    __syncthreads();
    float* Z1 = (float*)(F.ws + WS_Z1) + (size_t)c * 4 * SEQ;
    bf16_t* MIX = (bf16_t*)(F.ws + WS_MIX);
#pragma unroll 1
    for (int n = 0; n < 2; ++n) {
        fft8192x2<false>(L, t);
#pragma unroll 1
        for (int k0 = 0; k0 < 16; k0 += 8) { f32x2 h[8];
#pragma unroll
          for (int k = 0; k < 8; ++k) h[k] = SPEC[n * 8192 + t + 512 * (k0 + k)];
#pragma unroll
          for (int k = 0; k < 8; ++k) { const unsigned ad = (pt + 4352u * (unsigned)(k0 + k));
            const f32x2 a = *(const LAS f32x2*)(L + ad), b = *(const LAS f32x2*)(L + SB + ad);
            *(LAS f32x2*)(L + ad) = (f32x2){a[0] * h[k][0] - a[1] * h[k][1], a[0] * h[k][1] + a[1] * h[k][0]};
            *(LAS f32x2*)(L + SB + ad) = (f32x2){b[0] * h[k][0] - b[1] * h[k][1], b[0] * h[k][1] + b[1] * h[k][0]}; } }
        __syncthreads();
        fft8192x2<true>(L, t);
        const int xch = n == 0 ? c : 256 + c; const float* wg = n == 0 ? wx1 : wx2; const float bias = n == 0 ? bias0 : bias1;
#pragma unroll 1
        for (int sp = 0; sp < 2; ++sp) {
            float zo[2][8];
#pragma unroll
            for (int h2 = 0; h2 < 2; ++h2) { const int bb = 2 * sp + h2;
                float g[8], zin[8];
                hy_short8(HYT + ((size_t)bb * 768 + xch) * POS, l0, wg[0], wg[1], wg[2], g);
                if (n == 0) hy_short8(HYT + ((size_t)bb * 768 + 512 + c) * POS, l0, wv[0], wv[1], wv[2], zin);
                else { const f32x4 q0 = *(const f32x4*)(Z1 + (size_t)bb * SEQ + l0), q1 = *(const f32x4*)(Z1 + (size_t)bb * SEQ + l0 + 4);
                    zin[0] = q0[0]; zin[1] = q0[1]; zin[2] = q0[2]; zin[3] = q0[3]; zin[4] = q1[0]; zin[5] = q1[1]; zin[6] = q1[2]; zin[7] = q1[3]; }
#pragma unroll
                for (int j = 0; j < 8; ++j) { const float y = ((const LAS float*)(L + sp * SB + (pl + 8u * (unsigned)(j))))[h2]; zo[h2][j] = g[j] * (y + bias * zin[j]); }
                if (n == 0) { *(f32x4*)(Z1 + (size_t)bb * SEQ + l0) = (f32x4){zo[h2][0], zo[h2][1], zo[h2][2], zo[h2][3]}; *(f32x4*)(Z1 + (size_t)bb * SEQ + l0 + 4) = (f32x4){zo[h2][4], zo[h2][5], zo[h2][6], zo[h2][7]}; }
                else {
#pragma unroll
                    for (int j = 0; j < 8; ++j) MIX[((size_t)bb * SEQ + l0 + j) * DM + c] = f2bf(zo[h2][j]); }
            }
            if (n == 0) {
#pragma unroll
                for (int j = 0; j < 8; j += 2) {
                    *(LAS f32x4*)(L + sp * SB + (pl + 8u * (unsigned)(j))) = (f32x4){zo[0][j], zo[1][j], zo[0][j + 1], zo[1][j + 1]};
                    *(LAS f32x4*)(L + sp * SB + (pl + 34816u + 8u * (unsigned)(j))) = (f32x4){0.f, 0.f, 0.f, 0.f}; }
            }
        }
        __syncthreads();
    }
}

DI void fnet_fft_unit(const Frame& F, int u) {
    LAS unsigned char* L = F.lds; constexpr int SB = cx_bytes(4096);
    const int t = F.tid, b = u >> 6, gd0 = (u & 63) * 4;
    const bf16_t* YT = (const bf16_t*)(F.ws + WS_YTL) + ((size_t)b * 256 + gd0) * 8192;
    for (int i = t; i < 4 * 512; i += NTHR) { const int q = i >> 9, l0 = (i & 511) * 8;
        const u32x4 r = *(const u32x4*)(YT + (size_t)q * 8192 + l0), m = *(const u32x4*)(YT + (size_t)q * 8192 + 4096 + l0);
        const float rr[8] = {bflo(r.x), bfhi(r.x), bflo(r.y), bfhi(r.y), bflo(r.z), bfhi(r.z), bflo(r.w), bfhi(r.w)};
        const float mm[8] = {bflo(m.x), bfhi(m.x), bflo(m.y), bfhi(m.y), bflo(m.z), bfhi(m.z), bflo(m.w), bfhi(m.w)};
#pragma unroll
        for (int j = 0; j < 8; j += 2) *(LAS f32x4*)(L + q * SB + cx_addr(l0 + j)) = (f32x4){rr[j], mm[j], rr[j + 1], mm[j + 1]}; }
    __syncthreads();
    fft4096x4(L, t);
    bf16_t* MIX = (bf16_t*)(F.ws + WS_MIX);
#pragma unroll
    for (int i = 0; i < 8; ++i) { const int p = t + 512 * i; const int f = (p >> 8) + 16 * ((p >> 4) & 15) + 256 * (p & 15);
        float v[4];
#pragma unroll
        for (int q = 0; q < 4; ++q) v[q] = (*(const LAS f32x2*)(L + q * SB + cx_addr(p)))[0] * (1.0f / 512.0f);
        u32x2 w; w.x = cvt_pk_bf16(v[0], v[1]); w.y = cvt_pk_bf16(v[2], v[3]);
        *(u32x2*)(MIX + ((size_t)b * SEQ + f) * DM + 768 + gd0) = w; }
    __syncthreads();
}

DI void attn_unit(const Frame& F, int ly, int uid, float lam, float out_scale) {
    const int t = F.tid, lane = F.lane, wave = F.wave;
    LAS unsigned char* L = F.lds;
    constexpr int KOFF = 0, VOFF = 16384, TB = 32768, NBUF = 4;
    int bh, q0, k_lo, k_hi;
    if (uid < 512) { bh = uid >> 4; q0 = (uid & 15) << 8; k_lo = 0; k_hi = POS; }
    else { bh = uid - 512; q0 = SEQ; k_lo = SEQ; k_hi = POS; }
    const bf16_t* Qg = (const bf16_t*)(F.ws + WS_Q) + (size_t)bh * POS * 64;
    const bf16_t* Kg = (const bf16_t*)(F.ws + WS_K) + (size_t)bh * POS * 64;
    const bf16_t* Vg = (const bf16_t*)(F.ws + WS_V) + (size_t)bh * POS * 64;
    const int qi = lane & 31, hh = lane >> 5;
    const int qpos = q0 + wave * 32 + qi;
    bf16x8 qf[2][2];
    float q2[2] = {0.f, 0.f};
#pragma unroll
    for (int comp = 0; comp < 2; ++comp)
#pragma unroll
        for (int ks = 0; ks < 2; ++ks) { qf[comp][ks] = *(const bf16x8*)(Qg + (size_t)qpos * 64 + comp * 32 + ks * 16 + hh * 8);
#pragma unroll
            for (int j = 0; j < 8; ++j) { const float x = bf2f((unsigned short)qf[comp][ks][j]); q2[comp] += x * x; } }
    q2[0] += __shfl_xor(q2[0], 32); q2[1] += __shfl_xor(q2[1], 32);
    float kmax2[2];
    kmax2[0] = __uint_as_float(F.ctl[CW_KMAX + 64 * ly + bh * 2]); kmax2[1] = __uint_as_float(F.ctl[CW_KMAX + 64 * ly + bh * 2 + 1]);
    f32x16 negm;
    { const float m = -fmaxf(sqrtf(q2[0] * kmax2[0]), sqrtf(q2[1] * kmax2[1])) * 1.0001f;
#pragma unroll
      for (int i = 0; i < 16; ++i) negm[i] = m; }
    f32x16 O[2][2];
#pragma unroll
    for (int a = 0; a < 2; ++a)
#pragma unroll
        for (int b = 0; b < 2; ++b)
#pragma unroll
            for (int i = 0; i < 16; ++i) O[a][b][i] = 0.f;
    float lsum[2] = {0.f, 0.f};
    const int sk = t >> 3, sl = t & 7;
    const int kch = sl ^ ((sk >> 1) & 7);
    const int vch = (((sl >> 1) ^ (sk & 3)) << 1) | (sl & 1);
    const bf16_t* kgp = Kg + (size_t)(k_lo + sk) * 64 + kch * 8;
    const bf16_t* vgp = Vg + (size_t)(k_lo + sk) * 64 + vch * 8;
    const unsigned wvb = (unsigned)wave * 1024u;
    const int ntile = (k_hi - k_lo) >> 7;
#define ATT_DMA(tile, bufi) do { const size_t go = (size_t)(tile) * 128 * 64; \
        __builtin_amdgcn_global_load_lds((const unsigned*)(kgp + go), (LAS unsigned*)(L + KOFF + (bufi) * TB + wvb), 16, 0, 0); \
        __builtin_amdgcn_global_load_lds((const unsigned*)(kgp + go + 4096), (LAS unsigned*)(L + KOFF + (bufi) * TB + 8192 + wvb), 16, 0, 0); \
        __builtin_amdgcn_global_load_lds((const unsigned*)(vgp + go), (LAS unsigned*)(L + VOFF + (bufi) * TB + wvb), 16, 0, 0); \
        __builtin_amdgcn_global_load_lds((const unsigned*)(vgp + go + 4096), (LAS unsigned*)(L + VOFF + (bufi) * TB + 8192 + wvb), 16, 0, 0); } while (0)
    ATT_DMA(0, 0);
    if (ntile > 1) ATT_DMA(1, 1);
    if (ntile > 2) ATT_DMA(2, 2);
    if (ntile > 2) asm volatile("s_waitcnt vmcnt(8)" ::: "memory"); else if (ntile > 1) asm volatile("s_waitcnt vmcnt(4)" ::: "memory"); else asm volatile("s_waitcnt vmcnt(0)" ::: "memory");
    __builtin_amdgcn_s_barrier();
    const int p4 = lane & 3, q4 = (lane & 15) >> 2, blk = (lane >> 4) & 1;
    const int keyq = 4 * hh + q4;
    const unsigned va0 = (unsigned)(keyq * 128 + (((0 + blk) ^ (keyq & 3)) << 5) + p4 * 8), va1 = (unsigned)(keyq * 128 + (((2 + blk) ^ (keyq & 3)) << 5) + p4 * 8);
    const int ksw = (qi >> 1) & 7;
    const unsigned ka00 = (unsigned)(qi * 128 + (((0 + hh) ^ ksw) << 4)), ka01 = (unsigned)(qi * 128 + (((2 + hh) ^ ksw) << 4));
    const unsigned ka10 = (unsigned)(qi * 128 + (((4 + hh) ^ ksw) << 4)), ka11 = (unsigned)(qi * 128 + (((6 + hh) ^ ksw) << 4));
    typedef __bf16 bf16x8n __attribute__((ext_vector_type(8)));
    typedef float f32x8 __attribute__((ext_vector_type(8)));
#define ATT_PACK(S, s8) __builtin_bit_cast(bf16x8, __builtin_convertvector((f32x8){S[8 * (s8)], S[8 * (s8) + 1], S[8 * (s8) + 2], S[8 * (s8) + 3], S[8 * (s8) + 4], S[8 * (s8) + 5], S[8 * (s8) + 6], S[8 * (s8) + 7]}, bf16x8n))
#define ATT_MFMA(a, b, c) __builtin_amdgcn_mfma_f32_32x32x16_bf16((a), (b), (c), 0, 0, 0)
    f32x16 S0, S1;
    bf16x8 p1a, p1b, vp00, vp01, vp10, vp11;
#pragma unroll
    for (int j = 0; j < 8; ++j) { p1a[j] = 0; p1b[j] = 0; vp00[j] = 0; vp01[j] = 0; vp10[j] = 0; vp11[j] = 0; }
    for (int it = 0; it < ntile; ++it) {
        const int buf = it & (NBUF - 1);
        if (it + 3 < ntile) ATT_DMA(it + 3, (it + 3) & (NBUF - 1));
        const unsigned kbb = KOFF + buf * TB, vbb = VOFF + buf * TB;
        { const bf16x8 k00 = *(const LAS bf16x8*)(L + kbb + ka00), k01 = *(const LAS bf16x8*)(L + kbb + ka01);
          S0 = ATT_MFMA(k00, qf[0][0], negm); S0 = ATT_MFMA(k01, qf[0][1], S0); }
#pragma unroll 2
        for (int kb = 0; kb < 4; ++kb) {
            const unsigned kro = kbb + kb * 4096, vro = vbb + kb * 4096;
            s16x4 r0, r1, r2, r3, r4, r5, r6, r7;
            { const unsigned a0 = vro + va0, a1 = vro + va1;
              asm volatile("ds_read_b64_tr_b16 %0, %8\n\tds_read_b64_tr_b16 %1, %8 offset:1024\n\tds_read_b64_tr_b16 %2, %8 offset:2048\n\tds_read_b64_tr_b16 %3, %8 offset:3072\n\t"
                           "ds_read_b64_tr_b16 %4, %9\n\tds_read_b64_tr_b16 %5, %9 offset:1024\n\tds_read_b64_tr_b16 %6, %9 offset:2048\n\tds_read_b64_tr_b16 %7, %9 offset:3072"
                           : "=&v"(r0), "=&v"(r1), "=&v"(r2), "=&v"(r3), "=&v"(r4), "=&v"(r5), "=&v"(r6), "=&v"(r7) : "v"(a0), "v"(a1) : "memory"); }
            const bf16x8 k10 = *(const LAS bf16x8*)(L + kro + ka10), k11 = *(const LAS bf16x8*)(L + kro + ka11);
            O[1][0] = ATT_MFMA(vp00, p1a, O[1][0]); O[1][1] = ATT_MFMA(vp01, p1a, O[1][1]);
            O[1][0] = ATT_MFMA(vp10, p1b, O[1][0]); O[1][1] = ATT_MFMA(vp11, p1b, O[1][1]);
            S1 = ATT_MFMA(k10, qf[1][0], negm); S1 = ATT_MFMA(k11, qf[1][1], S1);
            float ps0 = 0.f;
#pragma unroll
            for (int i = 0; i < 16; ++i) { S0[i] = __builtin_amdgcn_exp2f(S0[i]); ps0 += S0[i]; }
            lsum[0] += ps0;
            const bf16x8 p0a = ATT_PACK(S0, 0), p0b = ATT_PACK(S0, 1);
            __builtin_amdgcn_sched_group_barrier(0x008, 1, 0); __builtin_amdgcn_sched_group_barrier(0x400, 3, 0);
            __builtin_amdgcn_sched_group_barrier(0x008, 1, 0); __builtin_amdgcn_sched_group_barrier(0x400, 3, 0);
            __builtin_amdgcn_sched_group_barrier(0x008, 1, 0); __builtin_amdgcn_sched_group_barrier(0x400, 3, 0);
            __builtin_amdgcn_sched_group_barrier(0x008, 1, 0); __builtin_amdgcn_sched_group_barrier(0x400, 3, 0);
            __builtin_amdgcn_sched_group_barrier(0x008, 1, 0); __builtin_amdgcn_sched_group_barrier(0x400, 2, 0);
            __builtin_amdgcn_sched_group_barrier(0x008, 1, 0); __builtin_amdgcn_sched_group_barrier(0x400, 2, 0);
            asm volatile("s_waitcnt lgkmcnt(0)" : "+v"(r0), "+v"(r1), "+v"(r2), "+v"(r3), "+v"(r4), "+v"(r5), "+v"(r6), "+v"(r7));
            vp00 = __builtin_shufflevector(r0, r1, 0, 1, 2, 3, 4, 5, 6, 7); vp10 = __builtin_shufflevector(r2, r3, 0, 1, 2, 3, 4, 5, 6, 7);
            vp01 = __builtin_shufflevector(r4, r5, 0, 1, 2, 3, 4, 5, 6, 7); vp11 = __builtin_shufflevector(r6, r7, 0, 1, 2, 3, 4, 5, 6, 7);
            O[0][0] = ATT_MFMA(vp00, p0a, O[0][0]); O[0][1] = ATT_MFMA(vp01, p0a, O[0][1]);
            O[0][0] = ATT_MFMA(vp10, p0b, O[0][0]); O[0][1] = ATT_MFMA(vp11, p0b, O[0][1]);
            { const bf16x8 k00 = *(const LAS bf16x8*)(L + kro + 4096 + ka00), k01 = *(const LAS bf16x8*)(L + kro + 4096 + ka01);
                S0 = ATT_MFMA(k00, qf[0][0], negm); S0 = ATT_MFMA(k01, qf[0][1], S0); }
            float ps1 = 0.f;
#pragma unroll
            for (int i = 0; i < 16; ++i) { S1[i] = __builtin_amdgcn_exp2f(S1[i]); ps1 += S1[i]; }
            lsum[1] += ps1;
            p1a = ATT_PACK(S1, 0); p1b = ATT_PACK(S1, 1);
            __builtin_amdgcn_sched_group_barrier(0x008, 1, 1); __builtin_amdgcn_sched_group_barrier(0x400, 3, 1);
            __builtin_amdgcn_sched_group_barrier(0x008, 1, 1); __builtin_amdgcn_sched_group_barrier(0x400, 3, 1);
            __builtin_amdgcn_sched_group_barrier(0x008, 1, 1); __builtin_amdgcn_sched_group_barrier(0x400, 3, 1);
            __builtin_amdgcn_sched_group_barrier(0x008, 1, 1); __builtin_amdgcn_sched_group_barrier(0x400, 3, 1);
            __builtin_amdgcn_sched_group_barrier(0x008, 1, 1); __builtin_amdgcn_sched_group_barrier(0x400, 2, 1);
            __builtin_amdgcn_sched_group_barrier(0x008, 1, 1); __builtin_amdgcn_sched_group_barrier(0x400, 2, 1);
        }
        if (it + 3 < ntile) asm volatile("s_waitcnt vmcnt(8)\n\ts_waitcnt lgkmcnt(0)" ::: "memory");
        else if (it + 2 < ntile) asm volatile("s_waitcnt vmcnt(4)\n\ts_waitcnt lgkmcnt(0)" ::: "memory");
        else asm volatile("s_waitcnt vmcnt(0)\n\ts_waitcnt lgkmcnt(0)" ::: "memory");
        __builtin_amdgcn_s_barrier();
    }
    O[1][0] = ATT_MFMA(vp00, p1a, O[1][0]); O[1][1] = ATT_MFMA(vp01, p1a, O[1][1]);
    O[1][0] = ATT_MFMA(vp10, p1b, O[1][0]); O[1][1] = ATT_MFMA(vp11, p1b, O[1][1]);
#undef ATT_DMA
#undef ATT_PACK
#undef ATT_MFMA
    const float l0 = lsum[0] + __shfl_xor(lsum[0], 32), l1 = lsum[1] + __shfl_xor(lsum[1], 32);
    const float i0 = 1.0f / l0, i1 = lam / l1;
    float ss = 0.f;
#pragma unroll
    for (int dvb = 0; dvb < 2; ++dvb)
#pragma unroll
        for (int i = 0; i < 16; ++i) { const float o = O[0][dvb][i] * i0 - O[1][dvb][i] * i1; O[0][dvb][i] = o; ss += o * o; }
    ss += __shfl_xor(ss, 32);
    const float rn = rsqrtf(ss * (1.0f / 64.0f) + LN_EPS) * out_scale;
    const float* sw = F.in[20] + (size_t)ly * 64;
    const int b = bh >> 3, head = bh & 7;
    const size_t row = qpos < SEQ ? (size_t)b * SEQ + qpos : (size_t)RLAT + b * CTXL + (qpos - SEQ);
    bf16_t* dst = (bf16_t*)(F.ws + WS_MIX) + row * DM + 256 + head * 64;
#pragma unroll
    for (int dvb = 0; dvb < 2; ++dvb)
#pragma unroll
        for (int g = 0; g < 4; ++g) { const int dv = dvb * 32 + 8 * g + 4 * hh;
            const f32x4 w4 = *(const f32x4*)(sw + dv);
            u32x2 w; w.x = cvt_pk_bf16(O[0][dvb][4 * g] * rn * w4[0], O[0][dvb][4 * g + 1] * rn * w4[1]); w.y = cvt_pk_bf16(O[0][dvb][4 * g + 2] * rn * w4[2], O[0][dvb][4 * g + 3] * rn * w4[3]);
            *(u32x2*)(dst + dv) = w; }
    __syncthreads();
}

DI void phase_rows_router(const Frame& F, int ly) {
    LAS float* HS = (LAS float*)F.lds;
    LAS float* PART = HS + 16 * 1028;
    LAS int* LCNT = (LAS int*)(PART + 8 * 16 * 64);
    LAS int* LBASE = LCNT + 64;
    LAS int* ASG = LBASE + 64;
    const int lane = F.lane, wave = F.wave;
    const float* MOD = (const float*)(F.ws + WS_MOD);
    const float* g1 = F.in[22] + (size_t)ly * DM; const float* b1 = F.in[23] + (size_t)ly * DM;
    const float* rw = F.in[26] + (size_t)ly * DM * NEXP; const float* rb = F.in[27] + (size_t)ly * NEXP;
    const bool last = ly == DEPTH - 1;
    const int nrows = last ? RLAT : RTOT;
    if (F.tid < 64) LCNT[F.tid] = 0;
    constexpr int HSS = 1028;
    float wreg[128];
#pragma unroll
    for (int i = 0; i < 128; ++i) wreg[i] = rw[(size_t)(wave * 128 + 4 * (i >> 2) + (lane >> 4)) * NEXP + 16 * (i & 3) + (lane & 15)];
    __syncthreads();
    int itn = 0;
    f32x4 va[2][4];
    if (F.bid * 16 < nrows) {
#pragma unroll
        for (int rr = 0; rr < 2; ++rr) { const float* xr = (const float*)(F.ws + WS_X) + (size_t)(F.bid * 16 + wave * 2 + rr) * DM;
#pragma unroll
            for (int j = 0; j < 4; ++j) va[rr][j] = *(const f32x4*)(xr + 4 * lane + 256 * j); } }
    for (int r0 = F.bid * 16; r0 < nrows; r0 += F.G * 16, ++itn) {
#pragma unroll
        for (int rr = 0; rr < 2; ++rr) { const int rl = wave * 2 + rr, row = r0 + rl;
            float* xr = (float*)(F.ws + WS_X) + (size_t)row * DM;
            f32x4 (&v)[4] = va[rr];
            float mu, rstd; ln_stats(v, mu, rstd);
#pragma unroll
            for (int j = 0; j < 4; ++j) { const int c = 4 * lane + 256 * j; const f32x4 g = *(const f32x4*)(g1 + c), bb = *(const f32x4*)(b1 + c);
#pragma unroll
                for (int e = 0; e < 4; ++e) v[j][e] = (v[j][e] - mu) * rstd * g[e] + bb[e];
                *(f32x4*)(xr + c) = v[j]; }
            ln_stats(v, mu, rstd);
            const float* m = MOD + ((size_t)ly * 5 + row_modsel(row)) * 6144;
            bf16_t* hrow = (bf16_t*)(F.ws + WS_H) + (size_t)row * DM;
#pragma unroll
            for (int j = 0; j < 4; ++j) { const int c = 4 * lane + 256 * j; const f32x4 a = *(const f32x4*)(m + 3072 + c), bsc = *(const f32x4*)(m + 4096 + c);
                f32x4 o;
#pragma unroll
                for (int e = 0; e < 4; ++e) o[e] = (v[j][e] - mu) * rstd * (1.f + bsc[e]) + a[e];
                u32x2 w; w.x = cvt_pk_bf16(o[0], o[1]); w.y = cvt_pk_bf16(o[2], o[3]); *(u32x2*)(hrow + c) = w;
                *(LAS f32x4*)(HS + rl * HSS + c) = o; } }
        { const int rn = r0 + F.G * 16;
          if (rn < nrows) {
#pragma unroll
            for (int rr = 0; rr < 2; ++rr) { const float* xr = (const float*)(F.ws + WS_X) + (size_t)(rn + wave * 2 + rr) * DM;
#pragma unroll
                for (int j = 0; j < 4; ++j) va[rr][j] = *(const f32x4*)(xr + 4 * lane + 256 * j); } } }
        asm volatile("s_waitcnt lgkmcnt(0)" ::: "memory"); __builtin_amdgcn_s_barrier();
        { f32x4 acc[4];
#pragma unroll
          for (int nb = 0; nb < 4; ++nb) acc[nb] = (f32x4){0.f, 0.f, 0.f, 0.f};
          const LAS float* hp = HS + (lane & 15) * HSS + wave * 128 + (lane >> 4);
#pragma unroll
          for (int g = 0; g < 32; ++g) { const float a = hp[4 * g];
#pragma unroll
              for (int nb = 0; nb < 4; ++nb) acc[nb] = __builtin_amdgcn_mfma_f32_16x16x4f32(a, wreg[g * 4 + nb], acc[nb], 0, 0, 0); }
#pragma unroll
          for (int nb = 0; nb < 4; ++nb)
#pragma unroll
              for (int e = 0; e < 4; ++e) PART[(wave * 16 + (lane >> 4) * 4 + e) * 64 + nb * 16 + (lane & 15)] = acc[nb][e]; }
        asm volatile("s_waitcnt lgkmcnt(0)" ::: "memory"); __builtin_amdgcn_s_barrier();
#pragma unroll
        for (int rr = 0; rr < 2; ++rr) { const int rl = wave * 2 + rr, row = r0 + rl;
            float lg = 0.f;
#pragma unroll
            for (int w = 0; w < 8; ++w) lg += PART[(w * 16 + rl) * 64 + lane];
            const float s = 1.0f / (1.0f + expf(-lg));
            const float sel = s + rb[lane];
            const float m1 = group8_max(sel);
            const unsigned long long bal = __ballot(sel == m1);
            const int gbase = lane & ~7;
            const unsigned gmask = (unsigned)((bal >> gbase) & 0xffull);
            const int first = gbase + __builtin_ctz(gmask);
            const float m2 = group8_max((lane == first) ? -INFINITY : sel);
            const float gs = m1 + m2;
            const int mygrp = lane >> 3;
            int grank = 0;
#pragma unroll
            for (int g = 0; g < 8; ++g) { const float o = __builtin_bit_cast(float, __builtin_amdgcn_readlane(__builtin_bit_cast(int, gs), g * 8)); grank += (o > gs || (o == gs && g < mygrp)) ? 1 : 0; }
            const float msel = grank < 4 ? sel : -INFINITY;
            int rank = 64;
            { float cur = msel;
#pragma unroll 1
              for (int it = 0; it < 8; ++it) { const float m = wave_max(cur); const unsigned long long bl = __ballot(cur == m); const int first2 = (int)__builtin_ctzll(bl);
                  if (lane == first2) { rank = it; cur = -INFINITY; } } }
            const bool chosen = rank < 8;
            const float wsum = wave_sum(chosen ? s : 0.f);
            if (chosen) { const float gate = s / wsum * 2.5f;
                ((float*)(F.ws + WS_TOPG))[(size_t)row * 8 + rank] = gate;
                const int lp = __hip_atomic_fetch_add(LCNT + lane, 1, __ATOMIC_RELAXED, __HIP_MEMORY_SCOPE_WORKGROUP);
                ASG[(itn * 16 + rl) * 8 + rank] = (lane << 20) | lp; } }
        asm volatile("s_waitcnt lgkmcnt(0)" ::: "memory"); __builtin_amdgcn_s_barrier();
    }
    if (F.tid < 64) { const int n = LCNT[F.tid]; LBASE[F.tid] = n ? (int)atomicAdd(F.ctl + CW_CNT + (ly * 64 + F.tid) * CNT_STRIDE, (unsigned)n) : 0; }
    __syncthreads();
    for (int a = F.tid; a < itn * 128; a += NTHR) { const int it = a >> 7, rl = (a >> 3) & 15, slot = a & 7; const int row = F.bid * 16 + it * F.G * 16 + rl;
        const int v = ASG[a], e = v >> 20, lp = v & 0xfffff;
        ((int*)(F.ws + WS_LIST))[(size_t)e * RTOT + LBASE[e] + lp] = row * 8 + slot;
        ((int*)(F.ws + WS_TOPE))[(size_t)row * 8 + slot] = (e << 20) | (LBASE[e] + lp); }
    __syncthreads();
}

DI void bf8_fma(const u32x4 w, float g, float (&y)[8]) {
    y[0] += bflo(w.x) * g; y[1] += bfhi(w.x) * g; y[2] += bflo(w.y) * g; y[3] += bfhi(w.y) * g; y[4] += bflo(w.z) * g; y[5] += bfhi(w.z) * g; y[6] += bflo(w.w) * g; y[7] += bfhi(w.w) * g;
}
DI void phase_combine(const Frame& F, int ly) {
    const int gw = F.bid * 8 + F.wave, nw = F.G * 8, lane = F.lane;
    const bool last = ly == DEPTH - 1;
    const int nrows = last ? RLAT : RTOT;
    const float* MOD = (const float*)(F.ws + WS_MOD);
    const float* g2w = F.in[24] + (size_t)ly * DM; const float* b2w = F.in[25] + (size_t)ly * DM;
    const bf16_t* YB = (const bf16_t*)(F.ws + WS_YB);
    const MoeTab T = moe_tables(F, ly);
    for (int row = gw; row < nrows; row += nw) {
        const float* gates = (const float*)(F.ws + WS_TOPG) + (size_t)row * 8;
        const int* posr = (const int*)(F.ws + WS_TOPE) + (size_t)row * 8;
        u32x4 yr[9][2];
#pragma unroll
        for (int s9 = 0; s9 < 9; ++s9) { size_t yrow;
            if (s9 < 8) { const int v = posr[s9]; yrow = (size_t)T.tstart[v >> 20] * 256 + (v & 0xfffff); } else yrow = (size_t)T.tstart[NEXP] * 256 + row;
#pragma unroll
            for (int hf = 0; hf < 2; ++hf) yr[s9][hf] = __builtin_nontemporal_load((const u32x4*)(YB + yrow * DM + hf * 512 + 8 * lane)); }
        float* xr = (float*)(F.ws + WS_X) + (size_t)row * DM;
        f32x4 xv[4];
#pragma unroll
        for (int hf = 0; hf < 2; ++hf) { xv[2 * hf] = *(const f32x4*)(xr + hf * 512 + 8 * lane); xv[2 * hf + 1] = *(const f32x4*)(xr + hf * 512 + 8 * lane + 4); }
        float y[2][8];
#pragma unroll
        for (int hf = 0; hf < 2; ++hf) {
#pragma unroll
            for (int e = 0; e < 8; ++e) y[hf][e] = 0.f;
            bf8_fma(yr[8][hf], 1.0f, y[hf]);
#pragma unroll
            for (int s8 = 0; s8 < 8; ++s8) bf8_fma(yr[s8][hf], gates[s8], y[hf]); }
        const float* m = MOD + ((size_t)ly * 5 + row_modsel(row)) * 6144;
        f32x4 v[4];
#pragma unroll
        for (int q = 0; q < 4; ++q) { const int c = (q >> 1) * 512 + 8 * lane + (q & 1) * 4; const f32x4 g2 = *(const f32x4*)(m + 5120 + c);
#pragma unroll
            for (int e = 0; e < 4; ++e) v[q][e] = xv[q][e] * ALPHA + g2[e] * y[q >> 1][(q & 1) * 4 + e]; }
        float mu, rstd; ln_stats(v, mu, rstd);
#pragma unroll
        for (int q = 0; q < 4; ++q) { const int c = (q >> 1) * 512 + 8 * lane + (q & 1) * 4; const f32x4 g = *(const f32x4*)(g2w + c), bb = *(const f32x4*)(b2w + c);
#pragma unroll
            for (int e = 0; e < 4; ++e) v[q][e] = (v[q][e] - mu) * rstd * g[e] + bb[e];
            if (last) *(f32x4*)(F.out + (size_t)row * DM + c) = v[q]; else *(f32x4*)(xr + c) = v[q]; }
        if (!last) { const float* mn = MOD + ((size_t)(ly + 1) * 5 + row_modsel(row)) * 6144;
            ln_stats(v, mu, rstd);
            bf16_t* hrow = (bf16_t*)(F.ws + WS_H) + (size_t)row * DM;
#pragma unroll
            for (int hf = 0; hf < 2; ++hf) { const int c = hf * 512 + 8 * lane; float o[8];
#pragma unroll
                for (int q = 0; q < 2; ++q) { const f32x4 sh = *(const f32x4*)(mn + c + 4 * q), sc = *(const f32x4*)(mn + 1024 + c + 4 * q);
#pragma unroll
                    for (int e = 0; e < 4; ++e) o[4 * q + e] = (v[2 * hf + q][e] - mu) * rstd * (1.f + sc[e]) + sh[e]; }
                u32x4 w; w.x = cvt_pk_bf16(o[0], o[1]); w.y = cvt_pk_bf16(o[2], o[3]); w.z = cvt_pk_bf16(o[4], o[5]); w.w = cvt_pk_bf16(o[6], o[7]);
                *(u32x4*)(hrow + c) = w; } }
    }
}

PHASE_FN void ph_pre0(const Frame& F0) { const Frame F = relaunder(F0); prep_small(F, 0); prep_mod(F); prep_filters(F); prep_tables(F); }
PHASE_FN void ph_pre1(const Frame& F0) { const Frame F = relaunder(F0); prep_invl1(F); phase_init_h(F); }
PHASE_FN void ph_win(const Frame& F0, int ly) { const Frame F = relaunder(F0);
    pg8::Gemm g{(const bf16_t*)(F.ws + WS_H), (const bf16_t*)(F.ws + WS_WIN), DM, F.tid};
    pg8::StaticOrder S; S.init(RTOT / 256, NWIN / 256, F.G, F.bid);
    EpiWin E{F.ws, ly};
    pg8::gemm_phase<EpiWin, pg8::StaticOrder>(F.lds, g, S, E);
}
constexpr int NSTREAM = 0;
PHASE_FN void ph_mix(const Frame& F0, int ly) { const Frame F = relaunder(F0);
    volatile LAS unsigned* MISC = (volatile LAS unsigned*)(F.lds + LDS_MISC);
    const bool last = ly == DEPTH - 1;
    if (!last) { pg8::Gemm g{(const bf16_t*)(F.ws + WS_DFTC), (const bf16_t*)(F.ws + WS_YTC), 2 * CTXL, F.tid};
      pg8::StaticOrder S; S.init(1, 4, F.G, (F.bid + F.G - 64) % F.G);
      EpiFnet E{F.ws, 1};
      pg8::gemm_phase<EpiFnet, pg8::StaticOrder>(F.lds, g, S, E); }
    __syncthreads();
    for (;;) {
        __syncthreads();
        if (F.tid == 0) MISC[16] = atomicAdd(F.ctl + CW_ATTN + 64 * ly, 1u);
        __syncthreads();
        const int uid = (int)MISC[16];
        if (uid >= 256 + 256 + (last ? 512 : 544)) break;
        const Frame Fu = relaunder(F);
        if (uid < 256) { if (KIND(4)) { hyena_fft_unit(Fu, ly, uid); if (!last) hyena_ctx_unit(Fu, ly, uid); } }
        else if (uid < 512) { if (KIND(3)) fnet_fft_unit(Fu, uid - 256); }
        else if (KIND(5)) { const float* lm = (const float*)(Fu.ws + WS_LAM) + 2 * ly; attn_unit(Fu, ly, uid - 512, lm[0], 1.0f - lm[1]); }
    }
    prep_experts(F, ly, CW_PREPQ, 0, PREP_SPLIT);
}
PHASE_FN void ph_wout(const Frame& F0, int ly) { const Frame F = relaunder(F0);
    pg8::Gemm g{(const bf16_t*)(F.ws + WS_MIX), (const bf16_t*)(F.ws + WS_WOUT), DM, F.tid};
    pg8::StaticOrder S; S.init(ly == DEPTH - 1 ? RLAT / 256 : RTOT / 256, DM / 256, F.G, F.bid);
    EpiWout E{F.ws, ly, F.in[0], F.in[2]};
    pg8::gemm_phase<EpiWout, pg8::StaticOrder>(F.lds, g, S, E);
    __syncthreads();
    prep_experts(F, ly, CW_PREPQ2, PREP_SPLIT, PREP_SPLIT2);
}
PHASE_FN void ph_router(const Frame& F0, int ly) { const Frame F = relaunder(F0); phase_rows_router(F, ly); prep_experts(F, ly, CW_PREPQ4, PREP_SPLIT2, 3 * 1040); }
PHASE_FN void ph_moe1(const Frame& F0, int ly) { const Frame F = relaunder(F0);
    const MoeTab T = moe_tables(F, ly);
    pg8::Gemm g{(const bf16_t*)(F.ws + WS_H), (const bf16_t*)(F.ws + WS_WGU), DM, F.tid};
    MoeSched<true> S{T, (const int*)(F.ws + WS_LIST), F.G, F.bid, 2, 1};
    EpiMoe1 E{F.ws};
    pg8::gemm_phase<EpiMoe1, MoeSched<true>>(F.lds, g, S, E);
    __syncthreads();
    if (ly + 1 < DEPTH) prep_small_dyn(F, ly + 1);
}
PHASE_FN void ph_moe2(const Frame& F0, int ly) { const Frame F = relaunder(F0);
    const MoeTab T = moe_tables(F, ly);
    pg8::Gemm g{(const bf16_t*)(F.ws + WS_ACT), (const bf16_t*)(F.ws + WS_WD), DEXP, F.tid};
    MoeSched<false> S{T, (const int*)(F.ws + WS_LIST), F.G, F.bid, 4, 2};
    EpiMoe2 E{F.ws};
    pg8::gemm_phase<EpiMoe2, MoeSched<false>>(F.lds, g, S, E);
}
PHASE_FN void ph_combine(const Frame& F0, int ly) { const Frame F = relaunder(F0); phase_combine(F, ly); }

constexpr int PH_PER_LAYER = 7, N_PHASES = 2 + DEPTH * PH_PER_LAYER;

__global__ void __launch_bounds__(NTHR, 2) hybrid_fwd(Params prm) {
    extern __shared__ __attribute__((aligned(16))) unsigned char lds_raw[];
    Frame F;
    F.in = prm.in; F.out = prm.out; F.ws = prm.ws; F.lds = (LAS unsigned char*)lds_raw; F.ctl = (unsigned*)(prm.ws + WS_CTL);
    F.tid = threadIdx.x; F.lane = F.tid & 63; F.wave = __builtin_amdgcn_readfirstlane(F.tid >> 6); F.G = gridDim.x; F.bid = blockIdx.x;
    volatile LAS unsigned* MISC = (volatile LAS unsigned*)(F.lds + LDS_MISC);
    if (F.tid < 64) MISC[F.tid] = 0u;
    __syncthreads();
    const int lo = prm.ph_lo, hi = prm.ph_hi;
    XcdBarrier bar; bar.bar = F.ctl + CW_BAR; bar.x = 0; bar.st = nullptr;
    if (hi - lo > 1) bar = xcd_barrier_post(F.ctl + CW_BAR, MISC);
#define IN(k) (lo <= (k) && (k) < hi)
    unsigned long long pr_acc = 0ull, pr_t0 = 0ull;
#define SEAM(k) do { if (IN(k) && IN((k) + 1)) { unsigned long long _b0 = 0; if ((PROBE_KINDS >> 12) & 1) _b0 = __builtin_amdgcn_s_memrealtime(); xcd_barrier(bar); if ((PROBE_KINDS >> 12) & 1) pr_acc += __builtin_amdgcn_s_memrealtime() - _b0; } } while (0)
#define PR_BEGIN(kind) do { if ((PROBE_KINDS >> (kind)) & 1) pr_t0 = __builtin_amdgcn_s_memrealtime(); } while (0)
#define PR_END(kind) do { if ((PROBE_KINDS >> (kind)) & 1) pr_acc += __builtin_amdgcn_s_memrealtime() - pr_t0; } while (0)

    PR_BEGIN(0); if (IN(0) && KIND(0)) { const Frame Fp = relaunder(F); PR_BEGIN(13); prep_small(Fp, 0); PR_END(13); PR_BEGIN(14); prep_mod(Fp); PR_END(14); PR_BEGIN(15); prep_filters(Fp); PR_END(15); PR_BEGIN(16); prep_tables(Fp); PR_END(16); }
    PR_END(0); SEAM(0);
    PR_BEGIN(1); if (IN(1) && KIND(1)) ph_pre1(F);
    PR_END(1); SEAM(1);

    for (int ly = 0; ly < DEPTH; ++ly) {
        const int p0 = 2 + ly * PH_PER_LAYER;
        PR_BEGIN(2); if (IN(p0) && KIND(2)) ph_win(F, ly);
        PR_END(2); SEAM(p0);
        if (IN(p0 + 1)) { PR_BEGIN(5); ph_mix(F, ly); }
        PR_END(5); SEAM(p0 + 1);
        PR_BEGIN(6); if (IN(p0 + 2) && KIND(6)) ph_wout(F, ly);
        PR_END(6); SEAM(p0 + 2);
        PR_BEGIN(7); if (IN(p0 + 3) && KIND(7)) ph_router(F, ly);
        PR_END(7); SEAM(p0 + 3);
        PR_BEGIN(8); if (IN(p0 + 4) && KIND(8)) ph_moe1(F, ly);
        PR_END(8); SEAM(p0 + 4);
        PR_BEGIN(9); if (IN(p0 + 5) && KIND(9)) ph_moe2(F, ly);
        PR_END(9); SEAM(p0 + 5);
        PR_BEGIN(10); if (IN(p0 + 6) && KIND(10)) { const Frame Fc = relaunder(F); PR_BEGIN(17); phase_combine(Fc, ly); PR_END(17);  }
        PR_END(10); SEAM(p0 + 6);
    }
    if (PROBE_KINDS != 0 && blockIdx.x == 0) {
        const unsigned long long t0 = __builtin_amdgcn_s_memrealtime(), wait = pr_acc * (unsigned long long)PROBE_AMP;
        while (__builtin_amdgcn_s_memrealtime() - t0 < wait) __builtin_amdgcn_s_sleep(8);
    }
#undef IN
#undef SEAM
}

extern "C" void kernel_launch(void* const* d_in, const int* in_sizes, int n_in, void* d_out, int out_size, void* d_ws, size_t ws_size, hipStream_t stream) {
    static int grid = 0;
    if (grid == 0) {
        if (n_in != 34 || out_size != RLAT * DM || ws_size < WS_END) { fprintf(stderr, "kernel_launch: unexpected problem shape (n_in %d out %d ws %zu need %zu)\n", n_in, out_size, ws_size, (size_t)WS_END); grid = -1; return; }
        int dev = 0, cus = 0, per_cu = 0;
        if (hipGetDevice(&dev) != hipSuccess || hipDeviceGetAttribute(&cus, hipDeviceAttributeMultiprocessorCount, dev) != hipSuccess) { grid = -1; return; }
        if (hipFuncSetAttribute((const void*)hybrid_fwd, hipFuncAttributeMaxDynamicSharedMemorySize, LDS_BYTES) != hipSuccess) { fprintf(stderr, "kernel_launch: hipFuncSetAttribute failed\n"); grid = -1; return; }
        if (hipOccupancyMaxActiveBlocksPerMultiprocessor(&per_cu, (const void*)hybrid_fwd, NTHR, LDS_BYTES) != hipSuccess || per_cu < 1)
            fprintf(stderr, "kernel_launch: occupancy query reports %d workgroups per CU\n", per_cu);
        (void)hipGetLastError();
        grid = cus;
    }
    if (grid < 0) return;
    (void)hipMemsetAsync((char*)d_ws + WS_CTL, 0, CTL_BYTES, stream);
    Params p{};
    for (int i = 0; i < 34; ++i) p.in[i] = (const float*)d_in[i];
    p.out = (float*)d_out; p.ws = (unsigned char*)d_ws;
#if MK_PER_PHASE
    for (int ph = 0; ph < N_PHASES; ++ph) { p.ph_lo = ph; p.ph_hi = ph + 1; hipLaunchKernelGGL(hybrid_fwd, dim3(grid), dim3(NTHR), LDS_BYTES, stream, p); }
#else
    p.ph_lo = 0; p.ph_hi = N_PHASES;
    hipLaunchKernelGGL(hybrid_fwd, dim3(grid), dim3(NTHR), LDS_BYTES, stream, p);
#endif
}
```

```cpp
#include <hip/hip_runtime.h>
#include <cstdio>
#include <cstdint>

#ifndef MK_PER_PHASE
#define MK_PER_PHASE 0
#endif

#ifndef PG8_ALIGN
#define PG8_ALIGN 1
#endif
#ifndef PG8_OPAQUE_K
#define PG8_OPAQUE_K 1
#endif
#ifndef MK_OUTLINE
#define MK_OUTLINE 0
#endif
#if MK_OUTLINE
#define PHASE_FN __device__ __attribute__((noinline))
#else
#define PHASE_FN __device__ __forceinline__
#endif
#ifndef PROBE_KINDS
#define PROBE_KINDS 0
#endif
#ifndef PROBE_AMP
#define PROBE_AMP 4
#endif
#ifndef KMASK
#define KMASK 0xFFFF
#endif
#define KIND(k) ((KMASK >> (k)) & 1)
#define LAS __attribute__((address_space(3)))
typedef unsigned short bf16_t;
typedef short bf16x8 __attribute__((ext_vector_type(8)));
typedef short s16x4 __attribute__((ext_vector_type(4)));
typedef float f32x4 __attribute__((ext_vector_type(4)));
typedef float f32x2 __attribute__((ext_vector_type(2)));
typedef float f32x16 __attribute__((ext_vector_type(16)));
typedef unsigned u32x4 __attribute__((ext_vector_type(4)));
typedef unsigned u32x2 __attribute__((ext_vector_type(2)));
#define DI __device__ __forceinline__

constexpr int NB = 4, SEQ = 4096, CTXL = 256, DM = 1024, DEPTH = 4;
constexpr int POS = SEQ + CTXL;
constexpr int RLAT = NB * SEQ, RCTX = NB * CTXL, RTOT = RLAT + RCTX;
constexpr int DIN = 2560, NWIN = 2816;
constexpr int NEXP = 64, DEXP = 256;
constexpr float LN_EPS = 1e-5f;
constexpr float ALPHA = 1.681792830507429f;
constexpr float QSCALE = 0.17677669529663687f * 1.4426950408889634f;
constexpr int MAXTILES = 680;

constexpr size_t AL(size_t x) { return (x + 255) & ~(size_t)255; }
constexpr size_t WS_CTL = 0, CTL_BYTES = 1u << 17;
constexpr size_t WS_X = WS_CTL + CTL_BYTES;
constexpr size_t WS_H = WS_X + AL((size_t)RTOT * DM * 4);
constexpr size_t WS_MOD = WS_H + AL((size_t)RTOT * DM * 2);
constexpr size_t WS_HCL = WS_MOD + AL((size_t)DEPTH * 5 * 6144 * 4);
constexpr size_t WS_HCC = WS_HCL + AL((size_t)DEPTH * 4 * 256 * SEQ * 4);
constexpr size_t WS_INVL1 = WS_HCC + AL((size_t)DEPTH * 4 * 256 * CTXL * 4);
constexpr size_t WS_DFTL = WS_INVL1 + AL((size_t)DEPTH * 2 * 2 * 256 * 4);
constexpr size_t WS_DFTC = WS_DFTL + 256;
constexpr size_t WS_ROPE = WS_DFTC + AL((size_t)CTXL * 2 * CTXL * 2);
constexpr size_t WS_LAM = WS_ROPE + AL(64 * 8 * 2 * 4);
constexpr size_t WS_WIN = WS_LAM + 256;
constexpr size_t WS_WOUT = WS_WIN + AL((size_t)NWIN * DM * 2);
constexpr size_t WS_WGU = WS_WOUT + AL((size_t)DM * DM * 2);
constexpr size_t WS_WD = WS_WGU + AL((size_t)65 * 512 * DM * 2);
constexpr size_t WS_TOPE = WS_WD + AL((size_t)65 * DM * DEXP * 2);
constexpr size_t WS_TOPG = WS_TOPE + AL((size_t)RTOT * 8 * 4);
constexpr size_t WS_LIST = WS_TOPG + AL((size_t)RTOT * 8 * 4);
constexpr size_t WS_SPEC = WS_LIST + AL((size_t)NEXP * RTOT * 4);
constexpr size_t WS_Z1 = WS_SPEC + AL((size_t)256 * 2 * 8192 * 8);
constexpr size_t WS_U = WS_Z1 + AL((size_t)256 * SEQ * 4 * 4);
constexpr size_t WS_Q = WS_U;
constexpr size_t WS_K = WS_Q + AL((size_t)NB * 8 * POS * 64 * 2);
constexpr size_t WS_V = WS_K + AL((size_t)NB * 8 * POS * 64 * 2);
constexpr size_t WS_HYT = WS_V + AL((size_t)NB * 8 * POS * 64 * 2);
constexpr size_t WS_YTL = WS_HYT + AL((size_t)NB * 768 * POS * 4);
constexpr size_t WS_YTC = WS_YTL + AL((size_t)1024 * 8192 * 2);
constexpr size_t WS_MIX = WS_YTC + AL((size_t)1024 * 512 * 2);
constexpr size_t WS_U1_END = WS_MIX + AL((size_t)RTOT * DM * 2);
constexpr size_t WS_ACT = WS_U;
constexpr size_t WS_YB = WS_ACT + AL((size_t)MAXTILES * 256 * DEXP * 2);
constexpr size_t WS_U2_END = WS_YB + AL((size_t)MAXTILES * 256 * DM * 2);
constexpr size_t WS_END = WS_U2_END > WS_U1_END ? WS_U2_END : WS_U1_END;

constexpr int CW_BAR = 0;
constexpr int CW_ATTN = 4096;
constexpr int CW_PREPQ = 4096 + 1024;
constexpr int CW_PREPQ2 = 4096 + 1536;
constexpr int CW_PREPQ3 = 4096 + 2048;
constexpr int CW_PREPQ4 = 4096 + 2560;
constexpr int PREP_SPLIT2 = 2640;
constexpr int PREP_SPLIT = 1200;
constexpr int CW_KMAX = 4096 + 512;
constexpr int CW_CNT = 8192;
constexpr int CNT_STRIDE = 64;

DI unsigned cvt_pk_bf16(float lo, float hi) { unsigned r; asm volatile("v_cvt_pk_bf16_f32 %0, %1, %2" : "=v"(r) : "v"(lo), "v"(hi)); return r; }
DI bf16x8 pack8(float a0, float a1, float a2, float a3, float a4, float a5, float a6, float a7) {
    u32x4 p;
    asm volatile("v_cvt_pk_bf16_f32 %0, %4, %5\n\tv_cvt_pk_bf16_f32 %1, %6, %7\n\tv_cvt_pk_bf16_f32 %2, %8, %9\n\tv_cvt_pk_bf16_f32 %3, %10, %11\n\ts_nop 1"
                 : "=&v"(p[0]), "=&v"(p[1]), "=&v"(p[2]), "=&v"(p[3]) : "v"(a0), "v"(a1), "v"(a2), "v"(a3), "v"(a4), "v"(a5), "v"(a6), "v"(a7));
    return __builtin_bit_cast(bf16x8, p);
}
DI bf16_t f2bf(float x) { return (bf16_t)(cvt_pk_bf16(x, 0.f) & 0xffffu); }
DI float bf2f(unsigned short u) { return __uint_as_float(((unsigned)u) << 16); }
DI float bflo(unsigned w) { return __uint_as_float(w << 16); }
DI float bfhi(unsigned w) { return __uint_as_float(w & 0xffff0000u); }
DI float wave_sum(float v) {
    v += __builtin_bit_cast(float, __builtin_amdgcn_update_dpp(0, __builtin_bit_cast(int, v), 0xB1, 0xf, 0xf, true));
    v += __builtin_bit_cast(float, __builtin_amdgcn_update_dpp(0, __builtin_bit_cast(int, v), 0x4E, 0xf, 0xf, true));
    v += __builtin_bit_cast(float, __builtin_amdgcn_update_dpp(0, __builtin_bit_cast(int, v), 0x141, 0xf, 0xf, true));
    v += __builtin_bit_cast(float, __builtin_amdgcn_update_dpp(0, __builtin_bit_cast(int, v), 0x140, 0xf, 0xf, true));
    const int iv = __builtin_bit_cast(int, v);
    return (__builtin_bit_cast(float, __builtin_amdgcn_readlane(iv, 0)) + __builtin_bit_cast(float, __builtin_amdgcn_readlane(iv, 16)))
         + (__builtin_bit_cast(float, __builtin_amdgcn_readlane(iv, 32)) + __builtin_bit_cast(float, __builtin_amdgcn_readlane(iv, 48)));
}
DI float group8_max(float v) {
    v = fmaxf(v, __builtin_bit_cast(float, __builtin_amdgcn_update_dpp(0, __builtin_bit_cast(int, v), 0xB1, 0xf, 0xf, true)));
    v = fmaxf(v, __builtin_bit_cast(float, __builtin_amdgcn_update_dpp(0, __builtin_bit_cast(int, v), 0x4E, 0xf, 0xf, true)));
    return fmaxf(v, __builtin_bit_cast(float, __builtin_amdgcn_update_dpp(0, __builtin_bit_cast(int, v), 0x141, 0xf, 0xf, true)));
}
DI float wave_max(float v) {
    v = fmaxf(v, __builtin_bit_cast(float, __builtin_amdgcn_update_dpp(0, __builtin_bit_cast(int, v), 0xB1, 0xf, 0xf, true)));
    v = fmaxf(v, __builtin_bit_cast(float, __builtin_amdgcn_update_dpp(0, __builtin_bit_cast(int, v), 0x4E, 0xf, 0xf, true)));
    v = fmaxf(v, __builtin_bit_cast(float, __builtin_amdgcn_update_dpp(0, __builtin_bit_cast(int, v), 0x141, 0xf, 0xf, true)));
    v = fmaxf(v, __builtin_bit_cast(float, __builtin_amdgcn_update_dpp(0, __builtin_bit_cast(int, v), 0x140, 0xf, 0xf, true)));
    const int iv = __builtin_bit_cast(int, v);
    return fmaxf(fmaxf(__builtin_bit_cast(float, __builtin_amdgcn_readlane(iv, 0)), __builtin_bit_cast(float, __builtin_amdgcn_readlane(iv, 16))),
                 fmaxf(__builtin_bit_cast(float, __builtin_amdgcn_readlane(iv, 32)), __builtin_bit_cast(float, __builtin_amdgcn_readlane(iv, 48))));
}

#define XB_TMO      128
#define XB_XCNT(j)  (256  + 64 * (j))
#define XB_XSUB(j)  (1280 + 64 * (j))
#define XB_XGEN(j)  (2304 + 64 * (j))
#define XB_TOP      3328
#define XB_TOPGEN   3392
#define XCD_BAR_WORDS 3456
#define XB_SPIN_CAP (1u << 18)

__device__ __forceinline__ unsigned xb_ld(unsigned* p)              { return __hip_atomic_load(p, __ATOMIC_RELAXED, __HIP_MEMORY_SCOPE_AGENT); }
__device__ __forceinline__ unsigned xb_add(unsigned* p, unsigned v) { return __hip_atomic_fetch_add(p, v, __ATOMIC_RELAXED, __HIP_MEMORY_SCOPE_AGENT); }
__device__ __forceinline__ unsigned xb_xcc_id() { return (unsigned)__builtin_amdgcn_s_getreg((3 << 11) | 20) & 0xFu; }
#define XB_SPIN(cond, bar) do { unsigned _sp = 0; while (cond) { __builtin_amdgcn_s_sleep(1); \
    if ((++_sp & 255u) == 0u) { if (xb_ld(&(bar)[XB_TMO])) break; if (_sp > XB_SPIN_CAP) { atomicAdd(&(bar)[XB_TMO], 1u); break; } } } } while (0)

struct XcdBarrier { unsigned* bar; unsigned x; volatile LAS unsigned* st; };

__device__ __forceinline__ XcdBarrier xcd_barrier_post(unsigned* bar, volatile LAS unsigned* st) {
    XcdBarrier b; b.bar = bar; b.x = xb_xcc_id(); b.st = st;
    if (threadIdx.x == 0) (void)xb_add(&bar[XB_XCNT(b.x)], 1u);
    return b;
}
__device__ __forceinline__ void xcd_barrier_complete(unsigned* bar, unsigned x, unsigned& nloc, unsigned& nx) {
    const unsigned G = gridDim.x * gridDim.y * gridDim.z;
    unsigned sum, cnt, mine, sp = 0u;
    for (;;) {
        sum = 0u; cnt = 0u; mine = 0u;
#pragma unroll
        for (unsigned j = 0; j < 16; ++j) { const unsigned c = xb_ld(&bar[XB_XCNT(j)]); sum += c; cnt += (c > 0u) ? 1u : 0u; mine = (j == x) ? c : mine; }
        if (sum == G) break;
        __builtin_amdgcn_s_sleep(1);
        if ((++sp & 255u) == 0u) { if (xb_ld(&bar[XB_TMO])) break; if (sp > XB_SPIN_CAP) { atomicAdd(&bar[XB_TMO], 1u); break; } }
    }
    nloc = mine > 0u ? mine : 1u; nx = cnt > 0u ? cnt : 1u;
}
__device__ __forceinline__ void xcd_barrier(const XcdBarrier& b) {
    asm volatile("s_waitcnt vmcnt(0)" ::: "memory");
    __syncthreads();
    if (threadIdx.x == 0) {
        unsigned* bar = b.bar;
        __builtin_amdgcn_s_waitcnt(0);
        unsigned nloc = b.st[0], nx = b.st[1];
        if (nloc == 0u) { xcd_barrier_complete(bar, b.x, nloc, nx); b.st[0] = nloc; b.st[1] = nx; }
        const unsigned old = xb_add(&bar[XB_XSUB(b.x)], 1u);
        const unsigned gen = old / nloc;
        if (old + 1u == (gen + 1u) * nloc) {
            __builtin_amdgcn_fence(__ATOMIC_RELEASE, "agent");
            asm volatile("s_waitcnt vmcnt(0)" ::: "memory");
            const unsigned og = xb_add(&bar[XB_TOP], 1u);
            const unsigned tg = og / nx;
            if (og + 1u == (tg + 1u) * nx) xb_add(&bar[XB_TOPGEN], 1u);
            else XB_SPIN(xb_ld(&bar[XB_TOPGEN]) == tg, bar);
            __builtin_amdgcn_fence(__ATOMIC_ACQUIRE, "agent");
            xb_add(&bar[XB_XGEN(b.x)], 1u);
            asm volatile("s_waitcnt vmcnt(0)" ::: "memory");
        } else {
            XB_SPIN(xb_ld(&bar[XB_XGEN(b.x)]) == gen, bar);
            __builtin_amdgcn_fence(__ATOMIC_ACQUIRE, "agent");
            asm volatile("s_waitcnt vmcnt(0)" ::: "memory");
        }
    }
    __syncthreads();
}

namespace pg8 {
constexpr int BM = 256, BK = 64, HALF = 128, HTB = HALF * BK * 2, STAGE_BYTES = 8 * HTB, NXCD = 8, WGM = 8;
__host__ __device__ __forceinline__ int lds_byte(int r, int c) { const int st = (r >> 4) * 2 + (c >> 5), rr = r & 15, cc = c & 31, ob = rr * 64 + cc * 2; return st * 1024 + (ob ^ (((ob >> 9) & 1) << 5)); }
__host__ __device__ __forceinline__ void stage_rc(int b, int& R, int& C) { const int st = b / 1024, sb = b % 1024, swz = sb ^ (((sb >> 9) & 1) << 5); R = (st >> 1) * 16 + swz / 64; C = (st & 1) * 32 + (swz % 64) / 2; }
__host__ __device__ __forceinline__ int perm32(int rho) { const int n = rho >> 4, i = rho & 15; return 8 * (i >> 2) + 4 * n + (i & 3); }

struct Unit { int pm, pn, e, lt; };
struct Gemm { const bf16_t* A; const bf16_t* Bt; int K; int tid; };

struct StaticOrder {
    static constexpr bool GATHER = false;
    int nM, nN, nwg, G, c;
    __device__ void init(int nM_, int nN_, int G_, int c_) { nM = nM_; nN = nN_; nwg = nM * nN; G = G_; c = c_; }
    __device__ bool next(int i, Unit& u) const {
        const long L = (long)i * G + c; if (L >= nwg) return false;
        int wgid = (int)L; { const int q = nwg / NXCD, r = nwg % NXCD, xcd = wgid % NXCD, off = wgid / NXCD; wgid = (xcd < r ? xcd * (q + 1) : r * (q + 1) + (xcd - r) * q) + off; }
        const int nig = WGM * nN, gid = wgid / nig, fm = gid * WGM, gsz = (nM - fm) < WGM ? (nM - fm) : WGM;
        u.pm = fm + ((wgid % nig) % gsz); u.pn = (wgid % nig) / gsz; u.e = 0; u.lt = 0; return true;
    }
    __device__ __forceinline__ int arow(const Unit& u, int r) const { return u.pm * BM + r; }
};

template <class Epi, class Sched>
__device__ __forceinline__ void gemm_phase(LAS unsigned char* lds, const Gemm g, const Sched& S, const Epi& E) {
    constexpr bool GA = Sched::GATHER;
    int tid = g.tid; asm volatile("" : "+v"(tid));
    const int wid = __builtin_amdgcn_readfirstlane(tid >> 6), lane = tid & 63, wr = wid >> 2, wc = wid & 3, fr = lane & 15, fq = lane >> 4;
    int K = g.K;
#if PG8_OPAQUE_K
    asm volatile("" : "+s"(K));
#endif
    const int nt = K / BK;
    unsigned voffA[2], voffB[2];
#pragma unroll
    for (int i = 0; i < 2; ++i) { int R, C; stage_rc(tid * 16 + i * 8192, R, C); const int Rb = Epi::PERM ? ((R & ~31) + perm32(R & 31)) : R;
        voffA[i] = (unsigned)(R * K + C) * 2u; voffB[i] = (unsigned)(Rb * K + C) * 2u; }
    const size_t kstep = (size_t)(BK * 2);
    const size_t hstep = (size_t)HALF * K * 2;
    const size_t tstep = 2 * hstep;
    const unsigned ldsw = (unsigned)wid * 1024u;
    const int aoff = lds_byte(wr * 64 + fr, fq * 8), boff = lds_byte(wc * 32 + fr, fq * 8);
#define PG8_SA(b, h) (((b) * 2 + (h)) * HTB)
#define PG8_SB(b, h) ((4 + (b) * 2 + (h)) * HTB)
#define PG8_STAGE(bufoff, gbase, voff) do { _Pragma("unroll") for (int _i = 0; _i < 2; ++_i) \
        __builtin_amdgcn_global_load_lds((const unsigned*)((const char*)(gbase) + (voff)[_i]), (LAS unsigned*)(lds + (bufoff) + ldsw + _i * 8192), 16, 0, 0); } while (0)
#define PG8_STAGEA(bufoff, gbase, o0, o1) do { \
        __builtin_amdgcn_global_load_lds((const unsigned*)((const char*)(gbase) + (o0)), (LAS unsigned*)(lds + (bufoff) + ldsw), 16, 0, 0); \
        __builtin_amdgcn_global_load_lds((const unsigned*)((const char*)(gbase) + (o1)), (LAS unsigned*)(lds + (bufoff) + ldsw + 8192), 16, 0, 0); } while (0)
#define PG8_STA(bufoff, sp, gp, o0, o1) do { if constexpr (GA) PG8_STAGEA(bufoff, gp, o0, o1); else PG8_STAGE(bufoff, sp, voffA); } while (0)
#define PG8_LDA(dst, b, h) do { _Pragma("unroll") for (int m = 0; m < 4; ++m) _Pragma("unroll") for (int k = 0; k < 2; ++k) dst[m][k] = *(const LAS bf16x8*)(lds + PG8_SA(b, h) + aoff + m * 2048 + k * 1024); } while (0)
#define PG8_LDB(dst, b, h) do { _Pragma("unroll") for (int n = 0; n < 2; ++n) _Pragma("unroll") for (int k = 0; k < 2; ++k) dst[n][k] = *(const LAS bf16x8*)(lds + PG8_SB(b, h) + boff + n * 2048 + k * 1024); } while (0)
#define PG8_MMA(ai, bj, At, Bt) do { __builtin_amdgcn_s_setprio(1); _Pragma("unroll") for (int m = 0; m < 4; ++m) _Pragma("unroll") for (int n = 0; n < 2; ++n) _Pragma("unroll") for (int k = 0; k < 2; ++k) \
        acc[ai][bj][m][n] = __builtin_amdgcn_mfma_f32_16x16x32_bf16(Bt[n][k], At[m][k], acc[ai][bj][m][n], 0, 0, 0); __builtin_amdgcn_s_setprio(0); } while (0)
#define PG8_WAIT_V(n) asm volatile("s_waitcnt vmcnt(" #n ")" ::: "memory")
#define PG8_WAIT_L(n) asm volatile("s_waitcnt lgkmcnt(" #n ")" ::: "memory")
#define PG8_BAR __builtin_amdgcn_s_barrier()
#define PG8_SCHED __builtin_amdgcn_sched_barrier(0)
#define PG8_GOFF(u, o00, o01, o10, o11) do { int _tz = g.tid; asm volatile("" : "+v"(_tz)); int _R0, _C0, _R1, _C1; stage_rc(_tz * 16, _R0, _C0); stage_rc(_tz * 16 + 8192, _R1, _C1); \
        o00 = (unsigned)(S.arow(u, _R0) * K + _C0) * 2u; o01 = (unsigned)(S.arow(u, _R1) * K + _C1) * 2u; \
        o10 = (unsigned)(S.arow(u, HALF + _R0) * K + _C0) * 2u; o11 = (unsigned)(S.arow(u, HALF + _R1) * K + _C1) * 2u; } while (0)
    Unit cur, nxt; int ui = 0;
    if (!S.next(0, cur)) return;
    f32x4 acc[2][2][4][2];
#pragma unroll
    for (int a = 0; a < 2; ++a)
#pragma unroll
        for (int b = 0; b < 2; ++b)
#pragma unroll
            for (int m = 0; m < 4; ++m)
#pragma unroll
                for (int n = 0; n < 2; ++n) acc[a][b][m][n] = (f32x4){0.f, 0.f, 0.f, 0.f};
    bf16x8 At[4][2], B0[2][2], B1[2][2];
    const char* const gA = (const char*)g.A;
    unsigned c00 = 0, c01 = 0, c10 = 0, c11 = 0, n00 = 0, n01 = 0, n10 = 0, n11 = 0;
    if constexpr (GA) PG8_GOFF(cur, c00, c01, c10, c11);
    const char* cA = gA + (GA ? (size_t)0 : (size_t)cur.pm * tstep); const char* cB = (const char*)g.Bt + (size_t)cur.pn * tstep;
    PG8_STAGE(PG8_SB(0, 0), cB, voffB); PG8_STAGE(PG8_SB(0, 1), cB + hstep, voffB); PG8_STA(PG8_SA(0, 0), cA, gA, c00, c01); PG8_STA(PG8_SA(0, 1), cA + hstep, gA, c10, c11);
    if (wr == 1) PG8_BAR;
    PG8_WAIT_V(2); PG8_BAR;
    PG8_STAGE(PG8_SB(1, 0), cB + kstep, voffB); PG8_STA(PG8_SA(1, 0), cA + kstep, gA + kstep, c00, c01); PG8_STAGE(PG8_SB(1, 1), cB + hstep + kstep, voffB);
    PG8_WAIT_V(6); PG8_BAR;
    for (;;) {
        const bool has_next = S.next(ui + 1, nxt);
        const char* nA = (has_next && !GA) ? gA + (size_t)nxt.pm * tstep : cA; const char* nB = has_next ? (const char*)g.Bt + (size_t)nxt.pn * tstep : cB;
        if constexpr (GA) { if (has_next) PG8_GOFF(nxt, n00, n01, n10, n11); else { n00 = c00; n01 = c01; n10 = c10; n11 = c11; } }
#pragma unroll 1
        for (int t = 0; t < nt; t += 2) {
            const bool last = (t == nt - 2);
            const char* a1 = cA + (size_t)(t + 1) * kstep;
            const char* a2 = last ? nA : cA + (size_t)(t + 2) * kstep; const char* b2 = last ? nB : cB + (size_t)(t + 2) * kstep;
            const char* a3 = a2 + kstep; const char* b3 = b2 + kstep;
            unsigned x00 = 0, x01 = 0, x10 = 0, x11 = 0;
            if constexpr (GA) { x00 = last ? n00 : c00; x01 = last ? n01 : c01; x10 = last ? n10 : c10; x11 = last ? n11 : c11; }
            PG8_LDB(B0, 0, 0); PG8_LDB(B1, 0, 1); PG8_SCHED; PG8_LDA(At, 0, 0); PG8_STA(PG8_SA(1, 1), a1 + hstep, a1, c10, c11);
            PG8_WAIT_V(8); PG8_WAIT_L(0); PG8_BAR; PG8_MMA(0, 0, At, B0); PG8_MMA(0, 1, At, B1); PG8_BAR; PG8_SCHED;
            PG8_LDA(At, 0, 1); PG8_STAGE(PG8_SB(0, 0), b2, voffB); PG8_STAGE(PG8_SB(0, 1), b2 + hstep, voffB); PG8_STA(PG8_SA(0, 0), a2, a2, x00, x01);
            PG8_WAIT_V(8); PG8_WAIT_L(0); PG8_BAR; PG8_MMA(1, 0, At, B0); PG8_MMA(1, 1, At, B1); PG8_BAR; PG8_SCHED;
            PG8_LDB(B0, 1, 0); PG8_LDB(B1, 1, 1); PG8_SCHED; PG8_LDA(At, 1, 0); PG8_STA(PG8_SA(0, 1), a2 + hstep, a2, x10, x11);
            PG8_WAIT_V(8); PG8_WAIT_L(0); PG8_BAR; PG8_MMA(0, 0, At, B0); PG8_MMA(0, 1, At, B1); PG8_BAR; PG8_SCHED;
            PG8_LDA(At, 1, 1); PG8_STAGE(PG8_SB(1, 0), b3, voffB); PG8_STAGE(PG8_SB(1, 1), b3 + hstep, voffB); PG8_STA(PG8_SA(1, 0), a3, a3, x00, x01);
            PG8_WAIT_V(8); PG8_WAIT_L(0); PG8_BAR; PG8_MMA(1, 0, At, B0); PG8_MMA(1, 1, At, B1); PG8_BAR; PG8_SCHED;
        }
#if PG8_ALIGN
        if (wr == 0) PG8_BAR;
#endif
        { int ln = (int)__builtin_amdgcn_mbcnt_hi(~0u, __builtin_amdgcn_mbcnt_lo(~0u, 0u)); asm volatile("" : "+v"(ln));
          E(acc, cur, wr, wc, ln & 15, ln >> 4); }
        if (!has_next) break;
#pragma unroll
        for (int a = 0; a < 2; ++a)
#pragma unroll
            for (int b = 0; b < 2; ++b)
#pragma unroll
                for (int m = 0; m < 4; ++m)
#pragma unroll
                    for (int n = 0; n < 2; ++n) acc[a][b][m][n] = (f32x4){0.f, 0.f, 0.f, 0.f};
        cur = nxt; cA = nA; cB = nB; ++ui;
        if constexpr (GA) { c00 = n00; c01 = n01; c10 = n10; c11 = n11; }
#if PG8_ALIGN
        if (wr == 1) PG8_BAR;
#endif
    }
    PG8_WAIT_V(0);
#if !PG8_ALIGN
    if (wr == 0) PG8_BAR;
#endif
    PG8_BAR;
#undef PG8_SA
#undef PG8_SB
#undef PG8_STAGE
#undef PG8_STAGEA
#undef PG8_STA
#undef PG8_GOFF
#undef PG8_LDA
#undef PG8_LDB
#undef PG8_MMA
#undef PG8_WAIT_V
#undef PG8_WAIT_L
#undef PG8_BAR
#undef PG8_SCHED
}
}

constexpr int NTHR = 512;
constexpr int LDS_SCRATCH = 139264;
constexpr int LDS_MISC = LDS_SCRATCH;
constexpr int LDS_TAB = LDS_MISC + 256;
constexpr int LDS_BYTES = LDS_TAB + 8192;

struct Params { const float* in[34]; float* out; unsigned char* ws; int ph_lo, ph_hi; };

struct Frame {
    const float* const* in; float* out; unsigned char* ws; LAS unsigned char* lds; unsigned* ctl;
    int tid, lane, wave, G, bid;
};

#define RP_BEGIN(kind) unsigned long long _rp##kind = 0ull; if ((PROBE_KINDS >> (kind)) & 1) _rp##kind = __builtin_amdgcn_s_memrealtime()
#define RP_END(kind) do { if ((PROBE_KINDS >> (kind)) & 1) { if (F.tid == 0) { volatile LAS unsigned long long* _A = (volatile LAS unsigned long long*)(F.lds + LDS_MISC + 128); *_A = *_A + (__builtin_amdgcn_s_memrealtime() - _rp##kind); } } } while (0)
DI int row_b(int row) { return row < RLAT ? (row >> 12) : ((row - RLAT) >> 8); }
DI int row_pos(int row) { return row < RLAT ? (row & 4095) : (SEQ + ((row - RLAT) & 255)); }
DI int row_modsel(int row) { return row < RLAT ? (row >> 12) : 4; }

DI Frame relaunder(const Frame& F0) {
    Frame F = F0; int wv = F0.wave; asm volatile("" : "+s"(wv));
    int ln = (int)__builtin_amdgcn_mbcnt_hi(~0u, __builtin_amdgcn_mbcnt_lo(~0u, 0u)); asm volatile("" : "+v"(ln));
    F.wave = wv; F.lane = ln; F.tid = wv * 64 + ln;
    __attribute__((address_space(1))) unsigned char* w = (__attribute__((address_space(1))) unsigned char*)F0.ws; asm volatile("" : "+s"(w)); F.ws = (unsigned char*)w;
    F.ctl = (unsigned*)(F.ws + WS_CTL);
    int b = F0.bid, g = F0.G; asm volatile("" : "+s"(b), "+s"(g)); F.bid = b; F.G = g;
    return F;
}

DI void prep_fourier_job(const Frame& F, int ly, int g, int kt) {
    LAS float* FW = (LAS float*)F.lds;
    LAS float* CS = FW + 4096;
    LAS float* P = CS + 128;
    LAS float* W = P + 8192;
    const int t = F.tid;
    const float* fw = F.in[21] + ((size_t)ly * 4 + g) * 4096;
    for (int i = t; i < 4096; i += NTHR) FW[i] = fw[i];
    if (t < 64) { float s, c; sincospif((float)t / 32.0f, &s, &c); CS[t] = c; CS[64 + t] = s; }
    { const float* p = F.in[6] + (size_t)ly * DM * DIN + (size_t)(kt * 64 + (t >> 3)) * DIN + 2304 + g * 64 + (t & 7) * 8;
      const f32x4 a = *(const f32x4*)p, b = *(const f32x4*)(p + 4);
      LAS float* q = W + (t >> 3) * 65 + (t & 7) * 8;
      q[0] = a[0]; q[1] = a[1]; q[2] = a[2]; q[3] = a[3]; q[4] = b[0]; q[5] = b[1]; q[6] = b[2]; q[7] = b[3]; }
    __syncthreads();
    for (int i = t; i < 8192; i += NTHR) {
        const int c = i >> 7, n = i & 127, comp = n >> 6, d = n & 63;
        float s = 0.f;
        for (int j = 0; j < 64; ++j) { const int a = (j * c) & 63; const float tr = comp ? -CS[64 + a] : CS[a]; s += tr * FW[j * 64 + d]; }
        P[c * 128 + n] = s;
    }
    __syncthreads();
    bf16_t* dst = (bf16_t*)(F.ws + WS_WIN);
    { const int k = t >> 3, nb = (t & 7) * 16;
      float o[16];
#pragma unroll
      for (int j = 0; j < 16; ++j) o[j] = 0.f;
      for (int c = 0; c < 64; ++c) { const float w = W[k * 65 + c];
#pragma unroll
          for (int j = 0; j < 16; ++j) o[j] += w * P[c * 128 + nb + j]; }
#pragma unroll
      for (int j = 0; j < 16; ++j) { const int n = nb + j, comp = n >> 6, d = n & 63;
          dst[(size_t)(2304 + comp * 256 + g * 64 + d) * DM + kt * 64 + k] = f2bf(o[j]); } }
    __syncthreads();
}

struct PrepJob { const float* src; bf16_t* dst; int ldn, ldk, row0, hi_step; };
DI PrepJob prep_job(const Frame& F, int ly, int j) {
    constexpr int J1 = 144, J2 = J1 + 64, J3 = J2 + 1040, J4 = J3 + 1040;
    PrepJob r;
    if (j < J1) { const int kb = j / 9, nb = j % 9;
        r.src = F.in[6] + (size_t)ly * DM * DIN + (size_t)kb * 64 * DIN + nb * 256; r.ldn = DIN; r.dst = (bf16_t*)(F.ws + WS_WIN) + kb * 64; r.ldk = DM; r.row0 = nb * 256; r.hi_step = 128;
    } else if (j < J2) { const int q = j - J1, kb = q >> 2, nb = q & 3;
        r.src = F.in[7] + (size_t)ly * DM * DM + (size_t)kb * 64 * DM + nb * 256; r.ldn = DM; r.dst = (bf16_t*)(F.ws + WS_WOUT) + kb * 64; r.ldk = DM; r.row0 = nb * 256; r.hi_step = 128;
    } else if (j < J4) { const bool up = j >= J3; const int q = j - (up ? J3 : J2), e = q >> 4, kb = q & 15;
        const float* src = e < NEXP ? F.in[up ? 29 : 28] + ((size_t)ly * NEXP + e) * DM * DEXP : F.in[up ? 32 : 31] + (size_t)ly * DM * DEXP;
        r.src = src + (size_t)kb * 64 * DEXP; r.ldn = DEXP; r.dst = (bf16_t*)(F.ws + WS_WGU) + kb * 64; r.ldk = DM; r.row0 = e * 512 + (up ? 128 : 0); r.hi_step = 256;
    } else { const int q = j - J4, e = q >> 4, kb = (q >> 2) & 3, nb = q & 3;
        const float* src = e < NEXP ? F.in[30] + ((size_t)ly * NEXP + e) * DEXP * DM : F.in[33] + (size_t)ly * DEXP * DM;
        r.src = src + (size_t)kb * 64 * DM + nb * 256; r.ldn = DM; r.dst = (bf16_t*)(F.ws + WS_WD) + kb * 64; r.ldk = DEXP; r.row0 = e * DM + nb * 256; r.hi_step = 128; }
    return r;
}
DI void prep_load(const Frame& F, const PrepJob& jb, f32x4 (&v)[8]) {
    const float* p = jb.src + (size_t)(8 * (F.tid >> 6)) * jb.ldn + 4 * (F.tid & 63);
#pragma unroll
    for (int i = 0; i < 8; ++i) v[i] = __builtin_nontemporal_load((const f32x4*)(p + (size_t)i * jb.ldn));
}
DI void prep_store(const Frame& F, const PrepJob& jb, const f32x4 (&v)[8]) {
    LAS unsigned char* T = F.lds;
    const int t = F.tid, ln = t & 63, w = t >> 6;
#pragma unroll
    for (int pr = 0; pr < 4; ++pr)
#pragma unroll
        for (int e = 0; e < 4; ++e) *(LAS unsigned*)(T + (4 * ln + e) * 132 + (8 * w + 2 * pr) * 2) = cvt_pk_bf16(v[2 * pr][e], v[2 * pr + 1][e]);
    asm volatile("s_waitcnt lgkmcnt(0)" ::: "memory"); __builtin_amdgcn_s_barrier();
#pragma unroll
    for (int q = 0; q < 4; ++q) { const int n = q * 64 + (t >> 3), ch = t & 7;
        const LAS unsigned* r = (const LAS unsigned*)(T + n * 132 + ch * 16);
        u32x4 o; o.x = r[0]; o.y = r[1]; o.z = r[2]; o.w = r[3];
        *(u32x4*)(jb.dst + (size_t)(jb.row0 + (n >> 7) * jb.hi_step + (n & 127)) * jb.ldk + ch * 8) = o; }
    asm volatile("s_waitcnt lgkmcnt(0)" ::: "memory"); __builtin_amdgcn_s_barrier();
}
DI void prep_small(const Frame& F, int ly) {
    for (int j = F.bid; j < 208; j += F.G) { const PrepJob jb = prep_job(F, ly, j); f32x4 v[8]; prep_load(F, jb, v); prep_store(F, jb, v); }
    for (int q = F.G - 1 - F.bid; q < 64; q += F.G) prep_fourier_job(F, ly, q >> 4, q & 15);
}
DI void prep_small_dyn(const Frame& F0, int ly) {
    const Frame F = relaunder(F0);
    volatile LAS unsigned* MISC = (volatile LAS unsigned*)(F.lds + LDS_MISC);
    for (;;) {
        __syncthreads();
        if (F.tid == 0) MISC[18] = atomicAdd(F.ctl + CW_PREPQ3 + 64 * ly, 1u);
        __syncthreads();
        const int j = (int)MISC[18];
        if (j >= 272) break;
        if (j < 64) prep_fourier_job(F, ly, j >> 4, j & 15);
        else { const PrepJob jb = prep_job(F, ly, j - 64); f32x4 v[8]; prep_load(F, jb, v); prep_store(F, jb, v); }
    }
}
constexpr int PREP_CHUNK = 2, PREP_NJOBS = 3 * 1040;
DI void prep_experts(const Frame& F0, int ly, int cw, int j_lo, int j_hi) {
    const Frame F = relaunder(F0);
    volatile LAS unsigned* MISC = (volatile LAS unsigned*)(F.lds + LDS_MISC);
    for (;;) {
        __syncthreads();
        if (F.tid == 0) MISC[17] = atomicAdd(F.ctl + cw + 64 * ly, (unsigned)PREP_CHUNK);
        __syncthreads();
        const int base = j_lo + (int)MISC[17];
        if (base >= j_hi) break;
        const int end = base + PREP_CHUNK < j_hi ? base + PREP_CHUNK : j_hi;
        int j = base;
        PrepJob cur = prep_job(F, ly, 208 + j); f32x4 va[8]; prep_load(F, cur, va);
#pragma unroll 1
        for (;;) {
            const int jn = j + 1; const bool more = jn < end;
            PrepJob nxt = cur; f32x4 vb[8];
            if (more) { nxt = prep_job(F, ly, 208 + jn); prep_load(F, nxt, vb); }
            prep_store(F, cur, va);
            if (!more) break;
            cur = nxt; j = jn;
#pragma unroll
            for (int i = 0; i < 8; ++i) va[i] = vb[i];
        }
    }
}

DI void prep_mod(const Frame& F) {
    LAS float* S = (LAS float*)F.lds;
    LAS float* RED = S + 5 * 1024;
    const int t = F.tid;
    bool have_s = false;
    for (int u = F.bid; u < DEPTH * 96; u += F.G) {
        const int ly = u / 96, cg = u % 96;
        if (!have_s) {
            for (int i = t; i < 5 * 1024; i += NTHR) { const int r = i >> 10, k = i & 1023; const float x = r < 4 ? F.in[1][r * DM + k] : F.in[3][k]; S[i] = x / (1.f + expf(-x)); }
            __syncthreads(); have_s = true;
        }
        const int tq = t & 15, tk = t >> 4;
        const float* w = F.in[4] + (size_t)ly * DM * 6144 + cg * 64 + tq * 4;
        f32x4 acc[5];
#pragma unroll
        for (int r = 0; r < 5; ++r) acc[r] = (f32x4){0.f, 0.f, 0.f, 0.f};
#pragma unroll 1
        for (int k8 = 0; k8 < 32; k8 += 8) { f32x4 wv[8];
#pragma unroll
            for (int q = 0; q < 8; ++q) wv[q] = *(const f32x4*)(w + (size_t)(tk * 32 + k8 + q) * 6144);
#pragma unroll
            for (int q = 0; q < 8; ++q)
#pragma unroll
                for (int r = 0; r < 5; ++r) acc[r] += wv[q] * S[r * 1024 + tk * 32 + k8 + q]; }
#pragma unroll
        for (int r = 0; r < 5; ++r)
#pragma unroll
            for (int j = 0; j < 4; ++j) RED[(tk * 5 + r) * 64 + tq * 4 + j] = acc[r][j];
        __syncthreads();
        if (t < 320) { const int r = t >> 6, c = t & 63; float s = 0.f;
            for (int q = 0; q < 32; ++q) s += RED[(q * 5 + r) * 64 + c];
            const int col = cg * 64 + c;
            ((float*)(F.ws + WS_MOD))[((size_t)ly * 5 + r) * 6144 + col] = s + F.in[5][(size_t)ly * 6144 + col]; }
        __syncthreads();
    }
}

DI void prep_filters(const Frame& F) {
    LAS float* Z = (LAS float*)F.lds;
    LAS float* A1 = Z + 64 * 33;
    LAS float* A2 = A1 + 4096;
    for (int u = F.G - 1 - F.bid; u < DEPTH * 68; u += F.G) {
        int t = F.tid; asm volatile("" : "+v"(t));
        const int ly = u / 68, ch = u % 68; const bool lat = ch < 64; const int Lx = lat ? SEQ : CTXL, t0 = lat ? ch * 64 : (ch - 64) * 64;
        for (int i = t; i < 64 * 33; i += NTHR) { const int tt = i / 33, f = i % 33; const int ti = t0 + tt;
            float v;
            if (f == 0) v = (float)ti / (float)(Lx - 1);
            else { const int j = (f - 1) & 15; const float fb = 1e-4f + (float)j * ((15.0f - 1e-4f) / 15.0f); const float om = (6.283185307179586f / (float)Lx) * (float)ti;
                   v = f <= 16 ? cosf(fb * om) : -sinf(fb * om); }
            Z[i] = v; }
        __syncthreads();
        const float* w1 = F.in[9] + (size_t)ly * 33 * 64; const float* b1 = F.in[10] + ly * 64; const float* w2 = F.in[11] + (size_t)ly * 4096; const float* b2 = F.in[12] + ly * 64;
        const float* w3 = F.in[13] + (size_t)ly * 64 * 1024; const float* fq = F.in[14] + ly * 64;
        for (int i = t; i < 4096; i += NTHR) { const int tt = i >> 6, h = i & 63; float s = b1[h];
            for (int f = 0; f < 33; ++f) s += Z[tt * 33 + f] * w1[f * 64 + h];
            A1[i] = sinf(fq[h] * s); }
        __syncthreads();
        for (int i = t; i < 4096; i += NTHR) { const int tt = i >> 6, h = i & 63; float s = b2[h];
            for (int j = 0; j < 64; ++j) s += A1[tt * 64 + j] * w2[j * 64 + h];
            A2[i] = sinf(fq[h] * s); }
        __syncthreads();
        { float wr0[64], wr1[64];
#pragma unroll
          for (int j = 0; j < 64; ++j) { wr0[j] = w3[j * 1024 + t]; wr1[j] = w3[j * 1024 + 512 + t]; }
          const int c = t & 255, dir = t >> 8;
          const float delta = fabsf(-3.0701134573253946f + (float)c * ((-15.350567286626973f + 3.0701134573253946f) / 255.0f));
          float* d0 = lat ? (float*)(F.ws + WS_HCL) + ((((size_t)ly * 2 + 0) * 2 + dir) * 256 + c) * SEQ + t0 : (float*)(F.ws + WS_HCC) + ((((size_t)ly * 2 + 0) * 2 + dir) * 256 + c) * CTXL + t0;
          float* d1 = lat ? (float*)(F.ws + WS_HCL) + ((((size_t)ly * 2 + 1) * 2 + dir) * 256 + c) * SEQ + t0 : (float*)(F.ws + WS_HCC) + ((((size_t)ly * 2 + 1) * 2 + dir) * 256 + c) * CTXL + t0;
#pragma unroll 1
          for (int tt = 0; tt < 64; ++tt) { float s0 = 0.f, s1 = 0.f;
#pragma unroll
            for (int j = 0; j < 64; j += 4) { const f32x4 a = *(const LAS f32x4*)(A2 + tt * 64 + j);
                s0 += a[0] * wr0[j] + a[1] * wr0[j + 1] + a[2] * wr0[j + 2] + a[3] * wr0[j + 3]; s1 += a[0] * wr1[j] + a[1] * wr1[j + 1] + a[2] * wr1[j + 2] + a[3] * wr1[j + 3];
                if ((j & 12) == 12) asm volatile("" ::: "memory"); }
            const float dec = expf(-((float)(t0 + tt) / (float)(Lx - 1)) * delta);
            d0[tt] = s0 * dec; d1[tt] = s1 * dec; } }
        __syncthreads();
    }
}

DI void prep_tables(const Frame& F) {
    LAS float* CT = (LAS float*)F.lds;
    const int t = F.tid;
    for (int i = t; i < 4096; i += NTHR) CT[i] = cospif((float)i / 2048.0f);
    __syncthreads();
    bf16_t* DC = (bf16_t*)(F.ws + WS_DFTC);
    for (int i = F.bid * NTHR + t; i < CTXL * 512; i += F.G * NTHR) { const int k = i >> 9, cl = i & 511, comp = cl >> 8, l = cl & 255;
        const int idx = ((k * l) & 255) * 16; DC[i] = f2bf((comp ? CT[(idx - 1024) & 4095] : CT[idx]) * (1.0f / 128.0f)); }
    if (F.bid == (F.G > 1 ? 1 : 0) && t < DEPTH) { const int ly = t; const float lam_init = 0.8f - 0.6f * expf(-0.3f * (float)ly); float s1 = 0.f, s2 = 0.f;
        for (int i = 0; i < 32; ++i) { s1 += F.in[16][ly * 32 + i] * F.in[17][ly * 32 + i]; s2 += F.in[18][ly * 32 + i] * F.in[19][ly * 32 + i]; }
        ((float*)(F.ws + WS_LAM))[2 * ly] = expf(s1) - expf(s2) + lam_init; ((float*)(F.ws + WS_LAM))[2 * ly + 1] = lam_init; }
    if (F.bid == 0) { float* RT = (float*)(F.ws + WS_ROPE);
        for (int i = t; i < 512; i += NTHR) { const int p = i >> 3, n = i & 7; const float inv = powf(10000.0f, -(float)n / 8.0f); float s, c; sincosf((float)p * inv, &s, &c); RT[i * 2] = c; RT[i * 2 + 1] = s; } }
    __syncthreads();
}

DI void prep_invl1(const Frame& F) {
    const int gw = F.bid * 8 + F.wave, nw = F.G * 8;
    for (int j = gw; j < DEPTH * 2 * 2 * 256; j += nw) {
        const int ly = j >> 10, lt = (j >> 9) & 1, n = (j >> 8) & 1, c = j & 255;
        const int Lx = lt ? CTXL : SEQ;
        const float* base = lt ? (const float*)(F.ws + WS_HCC) : (const float*)(F.ws + WS_HCL);
        const f32x4* f0 = (const f32x4*)(base + ((((size_t)ly * 2 + n) * 2 + 0) * 256 + c) * Lx);
        const f32x4* f1 = (const f32x4*)(base + ((((size_t)ly * 2 + n) * 2 + 1) * 256 + c) * Lx);
        float s = 0.f;
        if (lt) { const f32x4 a = f0[F.lane], b = f1[F.lane];
            s = fabsf(a[0]) + fabsf(a[1]) + fabsf(a[2]) + fabsf(a[3]) + (F.lane == 0 ? 0.f : fabsf(b[0])) + fabsf(b[1]) + fabsf(b[2]) + fabsf(b[3]);
        } else { f32x4 a[16], b[16];
#pragma unroll
            for (int q = 0; q < 16; ++q) { a[q] = f0[F.lane + 64 * q]; b[q] = f1[F.lane + 64 * q]; }
#pragma unroll
            for (int q = 0; q < 16; ++q) s += fabsf(a[q][0]) + fabsf(a[q][1]) + fabsf(a[q][2]) + fabsf(a[q][3]) + ((q == 0 && F.lane == 0) ? 0.f : fabsf(b[q][0])) + fabsf(b[q][1]) + fabsf(b[q][2]) + fabsf(b[q][3]); }
        s = wave_sum(s);
        if (F.lane == 0) ((float*)(F.ws + WS_INVL1))[j] = 1.0f / s;
    }
}

DI void ln_stats(const f32x4 (&v)[4], float& mu, float& rstd) {
    float s = 0.f;
#pragma unroll
    for (int j = 0; j < 4; ++j) s += (v[j][0] + v[j][1]) + (v[j][2] + v[j][3]);
    mu = wave_sum(s) * (1.0f / DM);
    float q = 0.f;
#pragma unroll
    for (int j = 0; j < 4; ++j)
#pragma unroll
        for (int e = 0; e < 4; ++e) { const float d = v[j][e] - mu; q += d * d; }
    rstd = rsqrtf(wave_sum(q) * (1.0f / DM) + LN_EPS);
}
DI void ln_mod_store(const f32x4 (&v)[4], const float* sh, const float* sc, bf16_t* hrow, int lane) {
    float mu, rstd; ln_stats(v, mu, rstd);
#pragma unroll
    for (int j = 0; j < 4; ++j) { const int c = 4 * lane + 256 * j; const f32x4 a = *(const f32x4*)(sh + c), b = *(const f32x4*)(sc + c);
        float o[4];
#pragma unroll
        for (int e = 0; e < 4; ++e) o[e] = (v[j][e] - mu) * rstd * (1.f + b[e]) + a[e];
        u32x2 w; w.x = cvt_pk_bf16(o[0], o[1]); w.y = cvt_pk_bf16(o[2], o[3]); *(u32x2*)(hrow + c) = w; }
}

DI void phase_init_h(const Frame& F) {
    const int gw = F.bid * 8 + F.wave, nw = F.G * 8;
    const float* MOD = (const float*)(F.ws + WS_MOD);
    for (int row = gw; row < RTOT; row += nw) {
        const float* xr = row < RLAT ? F.in[0] + (size_t)row * DM : F.in[2] + (size_t)(row - RLAT) * DM;
        f32x4 v[4];
#pragma unroll
        for (int j = 0; j < 4; ++j) v[j] = *(const f32x4*)(xr + 4 * F.lane + 256 * j);
        const float* m = MOD + (size_t)(0 * 5 + row_modsel(row)) * 6144;
        ln_mod_store(v, m, m + 1024, (bf16_t*)(F.ws + WS_H) + (size_t)row * DM, F.lane);
    }
}

struct EpiWin {
    static constexpr bool PERM = true;
    unsigned char* ws; int ly;
    DI void operator()(const f32x4 (&acc)[2][2][4][2], const pg8::Unit& u, int wr, int wc, int fr, int fq) const {
        const bool lat = u.pm < 64; const int b = lat ? (u.pm >> 4) : (u.pm - 64); const int pos0 = lat ? ((u.pm & 15) << 8) : SEQ;
        const int pn = u.pn;
        const float* RT = (const float*)(ws + WS_ROPE);
        float kn[2] = {0.f, 0.f};
#pragma unroll
        for (int ai = 0; ai < 2; ++ai)
#pragma unroll
            for (int m = 0; m < 4; ++m) {
                const int pos = pos0 + ai * 128 + wr * 64 + m * 16 + fr;
#pragma unroll
                for (int bj = 0; bj < 2; ++bj) {
                    const int col = pn * 256 + bj * 128 + wc * 32 + fq * 8;
                    float v[8];
#pragma unroll
                    for (int e = 0; e < 4; ++e) { v[e] = acc[ai][bj][m][0][e]; v[4 + e] = acc[ai][bj][m][1][e]; }
                    if (pn < 3) {
                        float* d = (float*)(ws + WS_HYT) + ((size_t)b * 768 + col) * POS + pos;
#pragma unroll
                        for (int e = 0; e < 8; ++e) d[(size_t)e * POS] = v[e];
                    } else if (pn < 7) {
                        const bool isq = pn < 5; const int cq = col - (isq ? 768 : 1280); const int head = cq >> 6, cc = cq & 63;
                        if (lat) { const int axis = (cc >> 4) & 1, n0 = (cc & 15) >> 1; const int pa = axis ? (pos & 63) : (pos >> 6);
                            const float* rt = RT + (pa * 8 + n0) * 2;
#pragma unroll
                            for (int p = 0; p < 4; ++p) { const float cs = rt[2 * p], sn = rt[2 * p + 1]; const float a = v[2 * p], bb = v[2 * p + 1];
                                v[2 * p] = a * cs - bb * sn; v[2 * p + 1] = a * sn + bb * cs; } }
                        if (isq) {
#pragma unroll
                            for (int e = 0; e < 8; ++e) v[e] *= QSCALE; }
                        u32x4 w; w.x = cvt_pk_bf16(v[0], v[1]); w.y = cvt_pk_bf16(v[2], v[3]); w.z = cvt_pk_bf16(v[4], v[5]); w.w = cvt_pk_bf16(v[6], v[7]);
                        bf16_t* d = (bf16_t*)(ws + (isq ? WS_Q : WS_K)) + (((size_t)b * 8 + head) * POS + pos) * 64 + cc;
                        *(u32x4*)d = w;
                        if (!isq) {
                            float s2 = bflo(w.x) * bflo(w.x) + bfhi(w.x) * bfhi(w.x) + bflo(w.y) * bflo(w.y) + bfhi(w.y) * bfhi(w.y) + bflo(w.z) * bflo(w.z) + bfhi(w.z) * bfhi(w.z) + bflo(w.w) * bflo(w.w) + bfhi(w.w) * bfhi(w.w);
                            s2 += __shfl_xor(s2, 16); s2 += __shfl_xor(s2, 32);
                            kn[bj] = fmaxf(kn[bj], s2); }
                    } else if (pn < 9) {
                        const int cv = col - 1792; const int head = cv >> 6, cc = cv & 63;
                        u32x4 w; w.x = cvt_pk_bf16(v[0], v[1]); w.y = cvt_pk_bf16(v[2], v[3]); w.z = cvt_pk_bf16(v[4], v[5]); w.w = cvt_pk_bf16(v[6], v[7]);
                        *(u32x4*)((bf16_t*)(ws + WS_V) + (((size_t)b * 8 + head) * POS + pos) * 64 + cc) = w;
                    } else {
                        const int cy = col - 2304; const int comp = cy >> 8, gd = cy & 255;
                        if (lat) { bf16_t* d = (bf16_t*)(ws + WS_YTL) + ((size_t)b * 256 + gd) * 8192 + comp * 4096 + pos;
#pragma unroll
                            for (int e = 0; e < 8; ++e) d[(size_t)e * 8192] = f2bf(v[e]);
                        } else { bf16_t* d = (bf16_t*)(ws + WS_YTC) + ((size_t)b * 256 + gd) * 512 + comp * 256 + (pos - SEQ);
#pragma unroll
                            for (int e = 0; e < 8; ++e) d[(size_t)e * 512] = f2bf(v[e]); }
                    }
                }
            }
        if (pn == 5 || pn == 6) {
#pragma unroll
            for (int bj = 0; bj < 2; ++bj) { float m = kn[bj];
                m = fmaxf(m, __shfl_xor(m, 1)); m = fmaxf(m, __shfl_xor(m, 2)); m = fmaxf(m, __shfl_xor(m, 4)); m = fmaxf(m, __shfl_xor(m, 8));
                const int cq = pn * 256 + bj * 128 + wc * 32 - 1280; const int head = cq >> 6, comp = (cq >> 5) & 1;
                if (fr == 0 && fq == 0) atomicMax((unsigned*)(ws + WS_CTL) + CW_KMAX + 64 * ly + (b * 8 + head) * 2 + comp, __float_as_uint(m)); }
        }
    }
};

struct EpiFnet {
    static constexpr bool PERM = true;
    unsigned char* ws; int ctx;
    DI void operator()(const f32x4 (&acc)[2][2][4][2], const pg8::Unit& u, int wr, int wc, int fr, int fq) const {
        const int b = u.pn;
#pragma unroll
        for (int ai = 0; ai < 2; ++ai)
#pragma unroll
            for (int m = 0; m < 4; ++m) {
                const int k = u.pm * 256 + ai * 128 + wr * 64 + m * 16 + fr;
                const size_t row = ctx ? (size_t)(RLAT + b * CTXL + k) : (size_t)(b * SEQ + k);
#pragma unroll
                for (int bj = 0; bj < 2; ++bj) { const int gd = bj * 128 + wc * 32 + fq * 8;
                    const f32x4 v0 = acc[ai][bj][m][0], v1 = acc[ai][bj][m][1];
                    u32x4 w; w.x = cvt_pk_bf16(v0[0], v0[1]); w.y = cvt_pk_bf16(v0[2], v0[3]); w.z = cvt_pk_bf16(v1[0], v1[1]); w.w = cvt_pk_bf16(v1[2], v1[3]);
                    *(u32x4*)((bf16_t*)(ws + WS_MIX) + row * DM + 768 + gd) = w; }
            }
    }
};

struct EpiWout {
    static constexpr bool PERM = false;
    unsigned char* ws; int ly; const float* xlat; const float* xctx;
    DI void operator()(const f32x4 (&acc)[2][2][4][2], const pg8::Unit& u, int wr, int wc, int fr, int fq) const {
        const int msel = u.pm < 64 ? (u.pm >> 4) : 4;
        const float* g1 = (const float*)(ws + WS_MOD) + ((size_t)ly * 5 + msel) * 6144 + 2048;
        const int col0 = u.pn * 256 + wc * 32 + 4 * fq;
        const float* src = ly == 0 ? (u.pm < 64 ? xlat + (size_t)u.pm * 256 * DM : xctx + (size_t)(u.pm - 64) * 256 * DM) : (const float*)(ws + WS_X) + (size_t)u.pm * 256 * DM;
        f32x4 gv[2][2];
#pragma unroll
        for (int bj = 0; bj < 2; ++bj)
#pragma unroll
            for (int n = 0; n < 2; ++n) gv[bj][n] = *(const f32x4*)(g1 + col0 + bj * 128 + n * 16);
#pragma unroll
        for (int ai = 0; ai < 2; ++ai)
#pragma unroll
            for (int m = 0; m < 4; ++m) { const size_t ro = (size_t)(ai * 128 + wr * 64 + m * 16 + fr) * DM + col0;
                float* rowp = (float*)(ws + WS_X) + (size_t)u.pm * 256 * DM + ro;
#pragma unroll
                for (int bj = 0; bj < 2; ++bj)
#pragma unroll
                    for (int n = 0; n < 2; ++n) { const f32x4 xin = *(const f32x4*)(src + ro + bj * 128 + n * 16); *(f32x4*)(rowp + bj * 128 + n * 16) = xin * ALPHA + gv[bj][n] * acc[ai][bj][m][n]; } }
    }
};

struct MoeTab { LAS int* cnt; LAS int* tstart; LAS int* tile_e; int ntiles; };
DI MoeTab moe_tables(const Frame& F, int ly) {
    MoeTab T; T.cnt = (LAS int*)(F.lds + LDS_TAB); T.tstart = T.cnt + 72; T.tile_e = T.tstart + 72;
    __syncthreads();
    if (F.tid < 65) T.cnt[F.tid] = F.tid < NEXP ? (int)__hip_atomic_load(F.ctl + CW_CNT + (ly * 64 + F.tid) * CNT_STRIDE, __ATOMIC_RELAXED, __HIP_MEMORY_SCOPE_AGENT) : (ly == DEPTH - 1 ? RLAT : RTOT);
    __syncthreads();
    if (F.tid == 0) { int s = 0; for (int e = 0; e < 65; ++e) { T.tstart[e] = s; s += (T.cnt[e] + 255) >> 8; } T.tstart[65] = s; }
    __syncthreads();
    const int nt = T.tstart[65];
    for (int e = F.tid; e < 65; e += NTHR) for (int q = T.tstart[e]; q < T.tstart[e + 1]; ++q) if (q < MAXTILES) T.tile_e[q] = e;
    __syncthreads();
    T.ntiles = __builtin_amdgcn_readfirstlane(nt < MAXTILES ? nt : MAXTILES);
    return T;
}
template <bool GATHER_> struct MoeSched {
    static constexpr bool GATHER = GATHER_;
    MoeTab T; const int* list; int G, c, nsub, shift;
    DI bool next(int i, pg8::Unit& u) const {
        const int L = i * G + c; if (L >= T.ntiles * nsub) return false;
        const int tile = L >> shift, j = L & (nsub - 1); const int e = __builtin_amdgcn_readfirstlane(T.tile_e[tile]);
        u.pm = tile; u.pn = e * nsub + j; u.e = e; u.lt = tile - __builtin_amdgcn_readfirstlane(T.tstart[e]); return true;
    }
    DI int arow(const pg8::Unit& u, int r) const {
        if (!GATHER_) return u.pm * 256 + r;
        const int idx = u.lt * 256 + r;
        if (u.e == NEXP) return idx;
        return idx < T.cnt[u.e] ? (list[(size_t)u.e * RTOT + idx] >> 3) : 0;
    }
};
DI float silu_f(float x) { return x * __builtin_amdgcn_rcpf(1.f + __builtin_amdgcn_exp2f(x * -1.4426950408889634f)); }
struct EpiMoe1 {
    static constexpr bool PERM = true;
    unsigned char* ws;
    DI void operator()(const f32x4 (&acc)[2][2][4][2], const pg8::Unit& u, int wr, int wc, int fr, int fq) const {
        const int hid = (u.pn & 1) * 128 + wc * 32 + fq * 8;
#pragma unroll
        for (int ai = 0; ai < 2; ++ai)
#pragma unroll
            for (int m = 0; m < 4; ++m) { const size_t row = (size_t)u.pm * 256 + ai * 128 + wr * 64 + m * 16 + fr;
                float o[8];
#pragma unroll
                for (int n = 0; n < 2; ++n)
#pragma unroll
                    for (int e = 0; e < 4; ++e) o[n * 4 + e] = silu_f(acc[ai][0][m][n][e]) * acc[ai][1][m][n][e];
                u32x4 w; w.x = cvt_pk_bf16(o[0], o[1]); w.y = cvt_pk_bf16(o[2], o[3]); w.z = cvt_pk_bf16(o[4], o[5]); w.w = cvt_pk_bf16(o[6], o[7]);
                *(u32x4*)((bf16_t*)(ws + WS_ACT) + row * DEXP + hid) = w; }
    }
};
struct EpiMoe2 {
    static constexpr bool PERM = true;
    unsigned char* ws;
    DI void operator()(const f32x4 (&acc)[2][2][4][2], const pg8::Unit& u, int wr, int wc, int fr, int fq) const {
        const int colb = (u.pn & 3) * 256 + wc * 32 + fq * 8;
#pragma unroll
        for (int ai = 0; ai < 2; ++ai)
#pragma unroll
            for (int m = 0; m < 4; ++m) { const size_t row = (size_t)u.pm * 256 + ai * 128 + wr * 64 + m * 16 + fr;
#pragma unroll
                for (int bj = 0; bj < 2; ++bj) { const f32x4 v0 = acc[ai][bj][m][0], v1 = acc[ai][bj][m][1];
                    u32x4 w; w.x = cvt_pk_bf16(v0[0], v0[1]); w.y = cvt_pk_bf16(v0[2], v0[3]); w.z = cvt_pk_bf16(v1[0], v1[1]); w.w = cvt_pk_bf16(v1[2], v1[3]);
                    __builtin_nontemporal_store(w, (u32x4*)((bf16_t*)(ws + WS_YB) + row * DM + colb + bj * 128)); } }
    }
};

DI float hy_short(const float* hy, int l, int Lx, float w0, float w1, float w2) {
    const float a = l > 0 ? hy[l - 1] : 0.f, b = hy[l], c = l + 1 < Lx ? hy[l + 1] : 0.f;
    return w0 * a + w1 * b + w2 * c;
}
DI void hyena_ctx_unit(const Frame& F, int ly, int c) {
    LAS float* KC = (LAS float*)F.lds;
    LAS float* UC = KC + 1024;
    LAS float* PS = UC + 1024;
    const int t = F.tid;
    const float* HYT = (const float*)(F.ws + WS_HYT);
    const float* scw = F.in[8] + (size_t)ly * 3 * 768;
    const float* invl = (const float*)(F.ws + WS_INVL1) + (size_t)ly * 1024;
    const float bias0 = F.in[15][(size_t)ly * 512 + c], bias1 = F.in[15][(size_t)ly * 512 + 256 + c];
    float wx1[3], wx2[3], wv[3];
#pragma unroll
    for (int j = 0; j < 3; ++j) { wx1[j] = scw[j * 768 + c]; wx2[j] = scw[j * 768 + 256 + c]; wv[j] = scw[j * 768 + 512 + c]; }
    bf16_t* MIX = (bf16_t*)(F.ws + WS_MIX);
    for (int n = 0; n < 2; ++n) { const float inv = invl[(1 * 2 + n) * 256 + c];
        const float* hf = (const float*)(F.ws + WS_HCC) + ((((size_t)ly * 2 + n) * 2 + 0) * 256 + c) * CTXL;
        const float* hb = (const float*)(F.ws + WS_HCC) + ((((size_t)ly * 2 + n) * 2 + 1) * 256 + c) * CTXL;
        for (int i = t; i < 512; i += NTHR) { const int d = i - 256; KC[n * 512 + i] = d >= 0 ? hf[d] * inv : (d > -256 ? hb[-d] * inv : 0.f); } }
    for (int i = t; i < 4 * CTXL; i += NTHR) { const int b = i >> 8, l = i & 255;
        UC[l * 4 + b] = hy_short(HYT + ((size_t)b * 768 + 512 + c) * POS + SEQ, l, CTXL, wv[0], wv[1], wv[2]); }
    __syncthreads();
    const int t0 = (t & 63) * 4, bp = (t >> 6) & 1, sq = t >> 7;
    const int tt = t & 255, bq = t >> 8;
    for (int n = 0; n < 2; ++n) {
        float a[4][2];
#pragma unroll
        for (int j = 0; j < 4; ++j) { a[j][0] = 0.f; a[j][1] = 0.f; }
        const LAS float* kf = KC + n * 512 + 256 + t0;
#pragma unroll 4
        for (int s = sq * 64; s < sq * 64 + 64; ++s) { const float u0 = UC[s * 4 + 2 * bp], u1 = UC[s * 4 + 2 * bp + 1];
#pragma unroll
            for (int j = 0; j < 4; ++j) { const float k = kf[j - s]; a[j][0] += k * u0; a[j][1] += k * u1; } }
#pragma unroll
        for (int j = 0; j < 4; ++j) { PS[(sq * 256 + t0 + j) * 4 + 2 * bp] = a[j][0]; PS[(sq * 256 + t0 + j) * 4 + 2 * bp + 1] = a[j][1]; }
        __syncthreads();
        float y0 = 0.f, y1 = 0.f;
#pragma unroll
        for (int q = 0; q < 4; ++q) { y0 += PS[(q * 256 + tt) * 4 + 2 * bq]; y1 += PS[(q * 256 + tt) * 4 + 2 * bq + 1]; }
        const int xch = n == 0 ? c : 256 + c; const float* wg = n == 0 ? wx1 : wx2; const float bias = n == 0 ? bias0 : bias1;
        const float g0 = hy_short(HYT + ((size_t)(2 * bq) * 768 + xch) * POS + SEQ, tt, CTXL, wg[0], wg[1], wg[2]);
        const float g1 = hy_short(HYT + ((size_t)(2 * bq + 1) * 768 + xch) * POS + SEQ, tt, CTXL, wg[0], wg[1], wg[2]);
        const float z0 = g0 * (y0 + bias * UC[tt * 4 + 2 * bq]), z1 = g1 * (y1 + bias * UC[tt * 4 + 2 * bq + 1]);
        __syncthreads();
        if (n == 0) { UC[tt * 4 + 2 * bq] = z0; UC[tt * 4 + 2 * bq + 1] = z1; __syncthreads(); }
        else { MIX[((size_t)RLAT + (2 * bq) * CTXL + tt) * DM + c] = f2bf(z0); MIX[((size_t)RLAT + (2 * bq + 1) * CTXL + tt) * DM + c] = f2bf(z1); }
    }
    __syncthreads();
}

DI unsigned cx_addr(unsigned e) { return e * 8u + (e >> 5) * 16u; }
constexpr int cx_bytes(int n) { return n * 8 + (n / 32) * 16; }
template <int R> DI constexpr int brev(int q) { int r = 0; for (int i = 1, j = R >> 1; i < R; i <<= 1, j >>= 1) if (q & i) r |= j; return r; }
typedef f32x2 cx;
DI cx cx_mul(cx x, float c, float s) { const cx sw = __builtin_shufflevector(x, x, 1, 0); return x * c + sw * (cx){-s, s}; }
DI cx cx_cmul(cx x, cx y) { const cx sw = __builtin_shufflevector(x, x, 1, 0), y0 = __builtin_shufflevector(y, y, 0, 0), y1 = __builtin_shufflevector(y, y, 1, 1);
    return x * y0 + sw * (y1 * (cx){-1.f, 1.f}); }
template <int R, bool INV> DI void dft_inreg(cx (&v)[R]) {
#pragma unroll
    for (int len = R; len >= 2; len >>= 1) { const int half = len >> 1;
#pragma unroll
        for (int base = 0; base < R; base += len)
#pragma unroll
            for (int j = 0; j < half; ++j) { const cx a = v[base + j], bq = v[base + j + half]; v[base + j] = a + bq; v[base + j + half] = a - bq; }
#pragma unroll
        for (int base = 0; base < R; base += len)
#pragma unroll
            for (int j = 1; j < half; ++j) { const cx d = v[base + j + half];
                if (4 * j == len) v[base + j + half] = INV ? (cx){-d[1], d[0]} : (cx){d[1], -d[0]};
                else { const float c = __builtin_cosf(6.283185307179586f * (float)j / (float)len), sn = (INV ? 1.f : -1.f) * __builtin_sinf(6.283185307179586f * (float)j / (float)len);
                    v[base + j + half] = cx_mul(d, c, sn); } }
    }
}
template <int R, bool INV, int S> DI void fft_bfly(LAS unsigned char* seq, int j) {
    constexpr int Lcur = R * S;
    int jj = j; asm volatile("" : "+v"(jj));
    const int blk = jj / S, o = jj % S;
    LAS unsigned char* p = seq + cx_addr((unsigned)(blk * Lcur + o));
#define FFT_OFF(r) ((r) * S * 8 + ((((r) * S) >> 5) * 16))
    cx v[R];
    if (S == 1) {
#pragma unroll
        for (int r = 0; r < R; r += 2) { const f32x4 q = *(const LAS f32x4*)(p + FFT_OFF(r)); v[r] = (cx){q[0], q[1]}; v[r + 1] = (cx){q[2], q[3]}; }
    } else {
#pragma unroll
        for (int r = 0; r < R; ++r) v[r] = *(const LAS f32x2*)(p + FFT_OFF(r));
    }
    if (S == 1) {
        dft_inreg<R, INV>(v);
    } else {
        const float fr = (float)o * (1.0f / (float)Lcur);
        cx w[R];
        w[1] = (cx){__builtin_amdgcn_cosf(fr), INV ? __builtin_amdgcn_sinf(fr) : -__builtin_amdgcn_sinf(fr)};
#pragma unroll
        for (int q = 2; q < R; ++q) { const int a = (q & (q - 1)) ? (q & -q) : (q >> 1), bq = q - a;
            w[q] = cx_cmul(w[a], w[bq]); }
        if (!INV) {
            dft_inreg<R, false>(v);
#pragma unroll
            for (int q = 1; q < R; ++q) { const int k = brev<R>(q); v[k] = cx_cmul(v[k], w[q]); }
        } else {
#pragma unroll
            for (int q = 1; q < R; ++q) v[q] = cx_cmul(v[q], w[q]);
            dft_inreg<R, true>(v);
        }
    }
    if (S == 1) {
#pragma unroll
        for (int r = 0; r < R; r += 2) { const int k0 = brev<R>(r), k1 = brev<R>(r + 1); *(LAS f32x4*)(p + FFT_OFF(r)) = (f32x4){v[k0][0], v[k0][1], v[k1][0], v[k1][1]}; }
    } else {
#pragma unroll
        for (int r = 0; r < R; ++r) { const int k = brev<R>(r); *(LAS f32x2*)(p + FFT_OFF(r)) = v[k]; }
    }
#undef FFT_OFF
}
template <bool INV> DI void fft8192x2(LAS unsigned char* lds, int tid) {
    constexpr int SB = cx_bytes(8192);
    if (!INV) {
        fft_bfly<16, false, 512>(lds, tid); __builtin_amdgcn_sched_barrier(0); fft_bfly<16, false, 512>(lds + SB, tid); __syncthreads();
        fft_bfly<16, false, 32>(lds, tid); __builtin_amdgcn_sched_barrier(0); fft_bfly<16, false, 32>(lds + SB, tid); __syncthreads();
        fft_bfly<32, false, 1>(lds + (tid >> 8) * SB, tid & 255); __syncthreads();
    } else {
        fft_bfly<32, true, 1>(lds + (tid >> 8) * SB, tid & 255); __syncthreads();
        fft_bfly<16, true, 32>(lds, tid); __builtin_amdgcn_sched_barrier(0); fft_bfly<16, true, 32>(lds + SB, tid); __syncthreads();
        fft_bfly<16, true, 512>(lds, tid); __builtin_amdgcn_sched_barrier(0); fft_bfly<16, true, 512>(lds + SB, tid); __syncthreads();
    }
}
DI void fft4096x4(LAS unsigned char* lds, int tid) {
    constexpr int SB = cx_bytes(4096);
    const int sq = tid >> 8, j = tid & 255;
    fft_bfly<16, false, 256>(lds + sq * SB, j); __builtin_amdgcn_sched_barrier(0); fft_bfly<16, false, 256>(lds + (sq + 2) * SB, j); __syncthreads();
    fft_bfly<16, false, 16>(lds + sq * SB, j); __builtin_amdgcn_sched_barrier(0); fft_bfly<16, false, 16>(lds + (sq + 2) * SB, j); __syncthreads();
    fft_bfly<16, false, 1>(lds + sq * SB, j); __builtin_amdgcn_sched_barrier(0); fft_bfly<16, false, 1>(lds + (sq + 2) * SB, j); __syncthreads();
}

DI void hy_short8(const float* hp, int l0, float w0, float w1, float w2, float (&out)[8]) {
    const f32x4 h0 = *(const f32x4*)(hp + l0), h1 = *(const f32x4*)(hp + l0 + 4);
    const float hm = l0 > 0 ? hp[l0 - 1] : 0.f, hn = l0 + 8 < SEQ ? hp[l0 + 8] : 0.f;
    const float hv[10] = {hm, h0[0], h0[1], h0[2], h0[3], h1[0], h1[1], h1[2], h1[3], hn};
#pragma unroll
    for (int j = 0; j < 8; ++j) out[j] = w0 * hv[j] + w1 * hv[j + 1] + w2 * hv[j + 2];
}
DI void hyena_fft_unit(const Frame& F, int ly, int c) {
    LAS unsigned char* L = F.lds; constexpr int SB = cx_bytes(8192);
    const int t = F.tid;
    const unsigned pt = cx_addr((unsigned)t), pl = cx_addr((unsigned)t * 8u);
    const float* HYT = (const float*)(F.ws + WS_HYT);
    const float* scw = F.in[8] + (size_t)ly * 3 * 768;
    const float* invl = (const float*)(F.ws + WS_INVL1) + (size_t)ly * 1024;
    const float bias0 = F.in[15][(size_t)ly * 512 + c], bias1 = F.in[15][(size_t)ly * 512 + 256 + c];
    float wx1[3], wx2[3], wv[3];
#pragma unroll
    for (int j = 0; j < 3; ++j) { wx1[j] = scw[j * 768 + c]; wx2[j] = scw[j * 768 + 256 + c]; wv[j] = scw[j * 768 + 512 + c]; }
    f32x2* SPEC = (f32x2*)(F.ws + WS_SPEC) + (size_t)c * 2 * 8192;
#pragma unroll
    for (int n = 0; n < 2; ++n) { const float inv = invl[(0 * 2 + n) * 256 + c] * (1.0f / 8192.0f);
        const float* hf = (const float*)(F.ws + WS_HCL) + ((((size_t)ly * 2 + n) * 2 + 0) * 256 + c) * SEQ;
        const float* hb = (const float*)(F.ws + WS_HCL) + ((((size_t)ly * 2 + n) * 2 + 1) * 256 + c) * SEQ;
        float fv[16];
#pragma unroll
        for (int k = 0; k < 8; ++k) { fv[k] = hf[t + 512 * k]; const int i = SEQ + t + 512 * k; fv[8 + k] = i > SEQ ? hb[8192 - i] : 0.f; }
#pragma unroll
        for (int k = 0; k < 16; ++k) *(LAS f32x2*)(L + n * SB + (pt + 4352u * (unsigned)(k))) = (f32x2){fv[k] * inv, 0.f}; }
    __syncthreads();
    fft8192x2<false>(L, t);
#pragma unroll
    for (int n = 0; n < 2; ++n)
#pragma unroll
        for (int k = 0; k < 16; ++k) SPEC[n * 8192 + t + 512 * k] = *(const LAS f32x2*)(L + n * SB + (pt + 4352u * (unsigned)(k)));
    __syncthreads();
    const int l0 = t * 8;
#pragma unroll 1
    for (int sp = 0; sp < 2; ++sp) {
        float za[8], zb[8];
        hy_short8(HYT + ((size_t)(2 * sp) * 768 + 512 + c) * POS, l0, wv[0], wv[1], wv[2], za);
        hy_short8(HYT + ((size_t)(2 * sp + 1) * 768 + 512 + c) * POS, l0, wv[0], wv[1], wv[2], zb);
#pragma unroll
        for (int j = 0; j < 8; j += 2) {
            *(LAS f32x4*)(L + sp * SB + (pl + 8u * (unsigned)(j))) = (f32x4){za[j], zb[j], za[j + 1], zb[j + 1]};
            *(LAS f32x4*)(L + sp * SB + (pl + 34816u + 8u * (unsigned)(j))) = (f32x4){0.f, 0.f, 0.f, 0.f}; }
    }
    __syncthreads();
    float* Z1 = (float*)(F.ws + WS_Z1) + (size_t)c * 4 * SEQ;
    bf16_t* MIX = (bf16_t*)(F.ws + WS_MIX);
#pragma unroll 1
    for (int n = 0; n < 2; ++n) {
        fft8192x2<false>(L, t);
#pragma unroll 1
        for (int k0 = 0; k0 < 16; k0 += 8) { f32x2 h[8];
#pragma unroll
          for (int k = 0; k < 8; ++k) h[k] = SPEC[n * 8192 + t + 512 * (k0 + k)];
#pragma unroll
          for (int k = 0; k < 8; ++k) { const unsigned ad = (pt + 4352u * (unsigned)(k0 + k));
            const f32x2 a = *(const LAS f32x2*)(L + ad), b = *(const LAS f32x2*)(L + SB + ad);
            *(LAS f32x2*)(L + ad) = (f32x2){a[0] * h[k][0] - a[1] * h[k][1], a[0] * h[k][1] + a[1] * h[k][0]};
            *(LAS f32x2*)(L + SB + ad) = (f32x2){b[0] * h[k][0] - b[1] * h[k][1], b[0] * h[k][1] + b[1] * h[k][0]}; } }
        __syncthreads();
        fft8192x2<true>(L, t);
        const int xch = n == 0 ? c : 256 + c; const float* wg = n == 0 ? wx1 : wx2; const float bias = n == 0 ? bias0 : bias1;
#pragma unroll 1
        for (int sp = 0; sp < 2; ++sp) {
            float zo[2][8];
#pragma unroll
            for (int h2 = 0; h2 < 2; ++h2) { const int bb = 2 * sp + h2;
                float g[8], zin[8];
                hy_short8(HYT + ((size_t)bb * 768 + xch) * POS, l0, wg[0], wg[1], wg[2], g);
                if (n == 0) hy_short8(HYT + ((size_t)bb * 768 + 512 + c) * POS, l0, wv[0], wv[1], wv[2], zin);
                else { const f32x4 q0 = *(const f32x4*)(Z1 + (size_t)bb * SEQ + l0), q1 = *(const f32x4*)(Z1 + (size_t)bb * SEQ + l0 + 4);
                    zin[0] = q0[0]; zin[1] = q0[1]; zin[2] = q0[2]; zin[3] = q0[3]; zin[4] = q1[0]; zin[5] = q1[1]; zin[6] = q1[2]; zin[7] = q1[3]; }
#pragma unroll
                for (int j = 0; j < 8; ++j) { const float y = ((const LAS float*)(L + sp * SB + (pl + 8u * (unsigned)(j))))[h2]; zo[h2][j] = g[j] * (y + bias * zin[j]); }
                if (n == 0) { *(f32x4*)(Z1 + (size_t)bb * SEQ + l0) = (f32x4){zo[h2][0], zo[h2][1], zo[h2][2], zo[h2][3]}; *(f32x4*)(Z1 + (size_t)bb * SEQ + l0 + 4) = (f32x4){zo[h2][4], zo[h2][5], zo[h2][6], zo[h2][7]}; }
                else {
#pragma unroll
                    for (int j = 0; j < 8; ++j) MIX[((size_t)bb * SEQ + l0 + j) * DM + c] = f2bf(zo[h2][j]); }
            }
            if (n == 0) {
#pragma unroll
                for (int j = 0; j < 8; j += 2) {
                    *(LAS f32x4*)(L + sp * SB + (pl + 8u * (unsigned)(j))) = (f32x4){zo[0][j], zo[1][j], zo[0][j + 1], zo[1][j + 1]};
                    *(LAS f32x4*)(L + sp * SB + (pl + 34816u + 8u * (unsigned)(j))) = (f32x4){0.f, 0.f, 0.f, 0.f}; }
            }
        }
        __syncthreads();
    }
}

DI void fnet_fft_unit(const Frame& F, int u) {
    LAS unsigned char* L = F.lds; constexpr int SB = cx_bytes(4096);
    const int t = F.tid, b = u >> 6, gd0 = (u & 63) * 4;
    const bf16_t* YT = (const bf16_t*)(F.ws + WS_YTL) + ((size_t)b * 256 + gd0) * 8192;
    for (int i = t; i < 4 * 512; i += NTHR) { const int q = i >> 9, l0 = (i & 511) * 8;
        const u32x4 r = *(const u32x4*)(YT + (size_t)q * 8192 + l0), m = *(const u32x4*)(YT + (size_t)q * 8192 + 4096 + l0);
        const float rr[8] = {bflo(r.x), bfhi(r.x), bflo(r.y), bfhi(r.y), bflo(r.z), bfhi(r.z), bflo(r.w), bfhi(r.w)};
        const float mm[8] = {bflo(m.x), bfhi(m.x), bflo(m.y), bfhi(m.y), bflo(m.z), bfhi(m.z), bflo(m.w), bfhi(m.w)};
#pragma unroll
        for (int j = 0; j < 8; j += 2) *(LAS f32x4*)(L + q * SB + cx_addr(l0 + j)) = (f32x4){rr[j], mm[j], rr[j + 1], mm[j + 1]}; }
    __syncthreads();
    fft4096x4(L, t);
    bf16_t* MIX = (bf16_t*)(F.ws + WS_MIX);
#pragma unroll
    for (int i = 0; i < 8; ++i) { const int p = t + 512 * i; const int f = (p >> 8) + 16 * ((p >> 4) & 15) + 256 * (p & 15);
        float v[4];
#pragma unroll
        for (int q = 0; q < 4; ++q) v[q] = (*(const LAS f32x2*)(L + q * SB + cx_addr(p)))[0] * (1.0f / 512.0f);
        u32x2 w; w.x = cvt_pk_bf16(v[0], v[1]); w.y = cvt_pk_bf16(v[2], v[3]);
        *(u32x2*)(MIX + ((size_t)b * SEQ + f) * DM + 768 + gd0) = w; }
    __syncthreads();
}

DI void attn_unit(const Frame& F, int ly, int uid, float lam, float out_scale) {
    const int t = F.tid, lane = F.lane, wave = F.wave;
    LAS unsigned char* L = F.lds;
    constexpr int KOFF = 0, VOFF = 16384, TB = 32768, NBUF = 4;
    int bh, q0, k_lo, k_hi;
    if (uid < 512) { bh = uid >> 4; q0 = (uid & 15) << 8; k_lo = 0; k_hi = POS; }
    else { bh = uid - 512; q0 = SEQ; k_lo = SEQ; k_hi = POS; }
    const bf16_t* Qg = (const bf16_t*)(F.ws + WS_Q) + (size_t)bh * POS * 64;
    const bf16_t* Kg = (const bf16_t*)(F.ws + WS_K) + (size_t)bh * POS * 64;
    const bf16_t* Vg = (const bf16_t*)(F.ws + WS_V) + (size_t)bh * POS * 64;
    const int qi = lane & 31, hh = lane >> 5;
    const int qpos = q0 + wave * 32 + qi;
    bf16x8 qf[2][2];
    float q2[2] = {0.f, 0.f};
#pragma unroll
    for (int comp = 0; comp < 2; ++comp)
#pragma unroll
        for (int ks = 0; ks < 2; ++ks) { qf[comp][ks] = *(const bf16x8*)(Qg + (size_t)qpos * 64 + comp * 32 + ks * 16 + hh * 8);
#pragma unroll
            for (int j = 0; j < 8; ++j) { const float x = bf2f((unsigned short)qf[comp][ks][j]); q2[comp] += x * x; } }
    q2[0] += __shfl_xor(q2[0], 32); q2[1] += __shfl_xor(q2[1], 32);
    float kmax2[2];
    kmax2[0] = __uint_as_float(F.ctl[CW_KMAX + 64 * ly + bh * 2]); kmax2[1] = __uint_as_float(F.ctl[CW_KMAX + 64 * ly + bh * 2 + 1]);
    f32x16 negm;
    { const float m = -fmaxf(sqrtf(q2[0] * kmax2[0]), sqrtf(q2[1] * kmax2[1])) * 1.0001f;
#pragma unroll
      for (int i = 0; i < 16; ++i) negm[i] = m; }
    f32x16 O[2][2];
#pragma unroll
    for (int a = 0; a < 2; ++a)
#pragma unroll
        for (int b = 0; b < 2; ++b)
#pragma unroll
            for (int i = 0; i < 16; ++i) O[a][b][i] = 0.f;
    f32x2 ls2[2] = {(f32x2){0.f, 0.f}, (f32x2){0.f, 0.f}};
    const int sk = t >> 3, sl = t & 7;
    const int kch = sl ^ ((sk >> 1) & 7);
    const int vch = (((sl >> 1) ^ (sk & 3)) << 1) | (sl & 1);
    const bf16_t* kgp = Kg + (size_t)(k_lo + sk) * 64 + kch * 8;
    const bf16_t* vgp = Vg + (size_t)(k_lo + sk) * 64 + vch * 8;
    const unsigned wvb = (unsigned)wave * 1024u;
    const int ntile = (k_hi - k_lo) >> 7;
#define ATT_DMA(tile, bufi) do { const size_t go = (size_t)(tile) * 128 * 64; \
        __builtin_amdgcn_global_load_lds((const unsigned*)(kgp + go), (LAS unsigned*)(L + KOFF + (bufi) * TB + wvb), 16, 0, 0); \
        __builtin_amdgcn_global_load_lds((const unsigned*)(kgp + go + 4096), (LAS unsigned*)(L + KOFF + (bufi) * TB + 8192 + wvb), 16, 0, 0); \
        __builtin_amdgcn_global_load_lds((const unsigned*)(vgp + go), (LAS unsigned*)(L + VOFF + (bufi) * TB + wvb), 16, 0, 0); \
        __builtin_amdgcn_global_load_lds((const unsigned*)(vgp + go + 4096), (LAS unsigned*)(L + VOFF + (bufi) * TB + 8192 + wvb), 16, 0, 0); } while (0)
    ATT_DMA(0, 0);
    if (ntile > 1) ATT_DMA(1, 1);
    if (ntile > 2) ATT_DMA(2, 2);
    if (ntile > 2) asm volatile("s_waitcnt vmcnt(8)" ::: "memory"); else if (ntile > 1) asm volatile("s_waitcnt vmcnt(4)" ::: "memory"); else asm volatile("s_waitcnt vmcnt(0)" ::: "memory");
    __builtin_amdgcn_s_barrier();
    const int p4 = lane & 3, q4 = (lane & 15) >> 2, blk = (lane >> 4) & 1;
    const int keyq = 4 * hh + q4;
    const unsigned va0 = (unsigned)(keyq * 128 + (((0 + blk) ^ (keyq & 3)) << 5) + p4 * 8), va1 = (unsigned)(keyq * 128 + (((2 + blk) ^ (keyq & 3)) << 5) + p4 * 8);
    const int ksw = (qi >> 1) & 7;
    const unsigned ka00 = (unsigned)(qi * 128 + (((0 + hh) ^ ksw) << 4)), ka01 = (unsigned)(qi * 128 + (((2 + hh) ^ ksw) << 4));
    const unsigned ka10 = (unsigned)(qi * 128 + (((4 + hh) ^ ksw) << 4)), ka11 = (unsigned)(qi * 128 + (((6 + hh) ^ ksw) << 4));
    typedef __bf16 bf16x8n __attribute__((ext_vector_type(8)));
    typedef float f32x8 __attribute__((ext_vector_type(8)));
#define ATT_PACK(S, s8) __builtin_bit_cast(bf16x8, __builtin_convertvector((f32x8){S[8 * (s8)], S[8 * (s8) + 1], S[8 * (s8) + 2], S[8 * (s8) + 3], S[8 * (s8) + 4], S[8 * (s8) + 5], S[8 * (s8) + 6], S[8 * (s8) + 7]}, bf16x8n))
#define ATT_MFMA(a, b, c) __builtin_amdgcn_mfma_f32_32x32x16_bf16((a), (b), (c), 0, 0, 0)
    f32x16 S0, S1;
    bf16x8 p1a, p1b, vp00, vp01, vp10, vp11;
#pragma unroll
    for (int j = 0; j < 8; ++j) { p1a[j] = 0; p1b[j] = 0; vp00[j] = 0; vp01[j] = 0; vp10[j] = 0; vp11[j] = 0; }
    for (int it = 0; it < ntile; ++it) {
        const int buf = it & (NBUF - 1);
        if (it + 3 < ntile) ATT_DMA(it + 3, (it + 3) & (NBUF - 1));
        const unsigned kbb = KOFF + buf * TB, vbb = VOFF + buf * TB;
        { const bf16x8 k00 = *(const LAS bf16x8*)(L + kbb + ka00), k01 = *(const LAS bf16x8*)(L + kbb + ka01);
          S0 = ATT_MFMA(k00, qf[0][0], negm); S0 = ATT_MFMA(k01, qf[0][1], S0); }
#pragma unroll 2
        for (int kb = 0; kb < 4; ++kb) {
            const unsigned kro = kbb + kb * 4096, vro = vbb + kb * 4096;
            s16x4 r0, r1, r2, r3, r4, r5, r6, r7;
            { const unsigned a0 = vro + va0, a1 = vro + va1;
              asm volatile("ds_read_b64_tr_b16 %0, %8\n\tds_read_b64_tr_b16 %1, %8 offset:1024\n\tds_read_b64_tr_b16 %2, %8 offset:2048\n\tds_read_b64_tr_b16 %3, %8 offset:3072\n\t"
                           "ds_read_b64_tr_b16 %4, %9\n\tds_read_b64_tr_b16 %5, %9 offset:1024\n\tds_read_b64_tr_b16 %6, %9 offset:2048\n\tds_read_b64_tr_b16 %7, %9 offset:3072"
                           : "=&v"(r0), "=&v"(r1), "=&v"(r2), "=&v"(r3), "=&v"(r4), "=&v"(r5), "=&v"(r6), "=&v"(r7) : "v"(a0), "v"(a1) : "memory"); }
            const bf16x8 k10 = *(const LAS bf16x8*)(L + kro + ka10), k11 = *(const LAS bf16x8*)(L + kro + ka11);
            O[1][0] = ATT_MFMA(vp00, p1a, O[1][0]); O[1][1] = ATT_MFMA(vp01, p1a, O[1][1]);
            O[1][0] = ATT_MFMA(vp10, p1b, O[1][0]); O[1][1] = ATT_MFMA(vp11, p1b, O[1][1]);
            S1 = ATT_MFMA(k10, qf[1][0], negm); S1 = ATT_MFMA(k11, qf[1][1], S1);
#pragma unroll
            for (int i = 0; i < 16; ++i) S0[i] = __builtin_amdgcn_exp2f(S0[i]);
#pragma unroll
            for (int i = 0; i < 16; i += 2) ls2[0] += (f32x2){S0[i], S0[i + 1]};
            const bf16x8 p0a = ATT_PACK(S0, 0), p0b = ATT_PACK(S0, 1);
            __builtin_amdgcn_sched_group_barrier(0x008, 1, 0); __builtin_amdgcn_sched_group_barrier(0x400, 3, 0);
            __builtin_amdgcn_sched_group_barrier(0x008, 1, 0); __builtin_amdgcn_sched_group_barrier(0x400, 3, 0);
            __builtin_amdgcn_sched_group_barrier(0x008, 1, 0); __builtin_amdgcn_sched_group_barrier(0x400, 3, 0);
            __builtin_amdgcn_sched_group_barrier(0x008, 1, 0); __builtin_amdgcn_sched_group_barrier(0x400, 3, 0);
            __builtin_amdgcn_sched_group_barrier(0x008, 1, 0); __builtin_amdgcn_sched_group_barrier(0x400, 2, 0);
            __builtin_amdgcn_sched_group_barrier(0x008, 1, 0); __builtin_amdgcn_sched_group_barrier(0x400, 2, 0);
            asm volatile("s_waitcnt lgkmcnt(0)" : "+v"(r0), "+v"(r1), "+v"(r2), "+v"(r3), "+v"(r4), "+v"(r5), "+v"(r6), "+v"(r7));
            vp00 = __builtin_shufflevector(r0, r1, 0, 1, 2, 3, 4, 5, 6, 7); vp10 = __builtin_shufflevector(r2, r3, 0, 1, 2, 3, 4, 5, 6, 7);
            vp01 = __builtin_shufflevector(r4, r5, 0, 1, 2, 3, 4, 5, 6, 7); vp11 = __builtin_shufflevector(r6, r7, 0, 1, 2, 3, 4, 5, 6, 7);
            O[0][0] = ATT_MFMA(vp00, p0a, O[0][0]); O[0][1] = ATT_MFMA(vp01, p0a, O[0][1]);
            O[0][0] = ATT_MFMA(vp10, p0b, O[0][0]); O[0][1] = ATT_MFMA(vp11, p0b, O[0][1]);
            { const bf16x8 k00 = *(const LAS bf16x8*)(L + kro + 4096 + ka00), k01 = *(const LAS bf16x8*)(L + kro + 4096 + ka01);
                S0 = ATT_MFMA(k00, qf[0][0], negm); S0 = ATT_MFMA(k01, qf[0][1], S0); }
#pragma unroll
            for (int i = 0; i < 16; ++i) S1[i] = __builtin_amdgcn_exp2f(S1[i]);
#pragma unroll
            for (int i = 0; i < 16; i += 2) ls2[1] += (f32x2){S1[i], S1[i + 1]};
            p1a = ATT_PACK(S1, 0); p1b = ATT_PACK(S1, 1);
            __builtin_amdgcn_sched_group_barrier(0x008, 1, 1); __builtin_amdgcn_sched_group_barrier(0x400, 3, 1);
            __builtin_amdgcn_sched_group_barrier(0x008, 1, 1); __builtin_amdgcn_sched_group_barrier(0x400, 3, 1);
            __builtin_amdgcn_sched_group_barrier(0x008, 1, 1); __builtin_amdgcn_sched_group_barrier(0x400, 3, 1);
            __builtin_amdgcn_sched_group_barrier(0x008, 1, 1); __builtin_amdgcn_sched_group_barrier(0x400, 3, 1);
            __builtin_amdgcn_sched_group_barrier(0x008, 1, 1); __builtin_amdgcn_sched_group_barrier(0x400, 2, 1);
            __builtin_amdgcn_sched_group_barrier(0x008, 1, 1); __builtin_amdgcn_sched_group_barrier(0x400, 2, 1);
        }
        if (it + 3 < ntile) asm volatile("s_waitcnt vmcnt(8)\n\ts_waitcnt lgkmcnt(0)" ::: "memory");
        else if (it + 2 < ntile) asm volatile("s_waitcnt vmcnt(4)\n\ts_waitcnt lgkmcnt(0)" ::: "memory");
        else asm volatile("s_waitcnt vmcnt(0)\n\ts_waitcnt lgkmcnt(0)" ::: "memory");
        __builtin_amdgcn_s_barrier();
    }
    O[1][0] = ATT_MFMA(vp00, p1a, O[1][0]); O[1][1] = ATT_MFMA(vp01, p1a, O[1][1]);
    O[1][0] = ATT_MFMA(vp10, p1b, O[1][0]); O[1][1] = ATT_MFMA(vp11, p1b, O[1][1]);
#undef ATT_DMA
#undef ATT_PACK
#undef ATT_MFMA
    const float lsum[2] = {ls2[0][0] + ls2[0][1], ls2[1][0] + ls2[1][1]};
    const float l0 = lsum[0] + __shfl_xor(lsum[0], 32), l1 = lsum[1] + __shfl_xor(lsum[1], 32);
    const float i0 = 1.0f / l0, i1 = lam / l1;
    float ss = 0.f;
#pragma unroll
    for (int dvb = 0; dvb < 2; ++dvb)
#pragma unroll
        for (int i = 0; i < 16; ++i) { const float o = O[0][dvb][i] * i0 - O[1][dvb][i] * i1; O[0][dvb][i] = o; ss += o * o; }
    ss += __shfl_xor(ss, 32);
    const float rn = rsqrtf(ss * (1.0f / 64.0f) + LN_EPS) * out_scale;
    const float* sw = F.in[20] + (size_t)ly * 64;
    const int b = bh >> 3, head = bh & 7;
    const size_t row = qpos < SEQ ? (size_t)b * SEQ + qpos : (size_t)RLAT + b * CTXL + (qpos - SEQ);
    bf16_t* dst = (bf16_t*)(F.ws + WS_MIX) + row * DM + 256 + head * 64;
#pragma unroll
    for (int dvb = 0; dvb < 2; ++dvb)
#pragma unroll
        for (int g = 0; g < 4; ++g) { const int dv = dvb * 32 + 8 * g + 4 * hh;
            const f32x4 w4 = *(const f32x4*)(sw + dv);
            u32x2 w; w.x = cvt_pk_bf16(O[0][dvb][4 * g] * rn * w4[0], O[0][dvb][4 * g + 1] * rn * w4[1]); w.y = cvt_pk_bf16(O[0][dvb][4 * g + 2] * rn * w4[2], O[0][dvb][4 * g + 3] * rn * w4[3]);
            *(u32x2*)(dst + dv) = w; }
    __syncthreads();
}

DI void phase_rows_router(const Frame& F, int ly) {
    LAS float* HS = (LAS float*)F.lds;
    LAS float* PART = HS + 16 * 1028;
    LAS int* LCNT = (LAS int*)(PART + 8 * 16 * 64);
    LAS int* LBASE = LCNT + 64;
    LAS int* ASG = LBASE + 64;
    LAS float* GATE = (LAS float*)(ASG + 80 * 8);
    LAS float* GB = GATE + 80 * 8;
    LAS float* MODL = GB + 2048;
    const int lane = F.lane, wave = F.wave;
    const float* MOD = (const float*)(F.ws + WS_MOD);
    const float* g1 = F.in[22] + (size_t)ly * DM; const float* b1 = F.in[23] + (size_t)ly * DM;
    const float* rw = F.in[26] + (size_t)ly * DM * NEXP; const float* rb = F.in[27] + (size_t)ly * NEXP;
    const bool last = ly == DEPTH - 1;
    const int nrows = last ? RLAT : RTOT;
    RP_BEGIN(18);
    if (F.tid < 64) LCNT[F.tid] = 0;
    constexpr int HSS = 1028;
    { const int i = F.tid * 4; *(LAS f32x4*)(GB + i) = i < 1024 ? *(const f32x4*)(g1 + i) : *(const f32x4*)(b1 + (i - 1024)); }
    f32x4 wreg[32];
#pragma unroll
    for (int g = 0; g < 32; ++g) wreg[g] = *(const f32x4*)(rw + (size_t)(wave * 128 + 4 * g + (lane >> 4)) * NEXP + 4 * (lane & 15));
    int itn = 0;
    f32x4 va[2][4];
    if (F.bid * 16 < nrows) {
#pragma unroll
        for (int rr = 0; rr < 2; ++rr) { const float* xr = (const float*)(F.ws + WS_X) + (size_t)(F.bid * 16 + wave * 2 + rr) * DM;
#pragma unroll
            for (int j = 0; j < 4; ++j) va[rr][j] = *(const f32x4*)(xr + 4 * lane + 256 * j); }
        const float* m = MOD + ((size_t)ly * 5 + row_modsel(F.bid * 16)) * 6144;
        __builtin_amdgcn_global_load_lds((const unsigned*)(m + 3072 + 4 * F.tid), (LAS unsigned*)((LAS unsigned char*)MODL + wave * 1024), 16, 0, 0); }
    asm volatile("s_waitcnt vmcnt(0)" ::: "memory");
    __syncthreads();
    RP_END(18);
    RP_BEGIN(19);
    for (int r0 = F.bid * 16; r0 < nrows; r0 += F.G * 16, ++itn) {
#pragma unroll
        for (int rr = 0; rr < 2; ++rr) { const int rl = wave * 2 + rr, row = r0 + rl;
            bf16_t* hrow = (bf16_t*)(F.ws + WS_H) + (size_t)row * DM;
            const LAS float* ML = MODL + (itn & 1) * 2048;
            f32x4 (&v)[4] = va[rr];
            float mu, rstd; ln_stats(v, mu, rstd);
#pragma unroll
            for (int j = 0; j < 4; ++j) { const int c = 4 * lane + 256 * j; const f32x4 g = *(const LAS f32x4*)(GB + c), bb = *(const LAS f32x4*)(GB + 1024 + c);
#pragma unroll
                for (int e = 0; e < 4; ++e) v[j][e] = (v[j][e] - mu) * rstd * g[e] + bb[e]; }
            ln_stats(v, mu, rstd);
#pragma unroll
            for (int j = 0; j < 4; ++j) { const int c = 4 * lane + 256 * j; const f32x4 pa = *(const LAS f32x4*)(ML + c), psc = *(const LAS f32x4*)(ML + 1024 + c);
                f32x4 o;
#pragma unroll
                for (int e = 0; e < 4; ++e) o[e] = (v[j][e] - mu) * rstd * (1.f + psc[e]) + pa[e];
                u32x2 w; w.x = cvt_pk_bf16(o[0], o[1]); w.y = cvt_pk_bf16(o[2], o[3]); *(u32x2*)(hrow + c) = w;
                *(LAS f32x4*)(HS + rl * HSS + c) = o; } }
        { const int rn = r0 + F.G * 16;
          if (rn < nrows) {
#pragma unroll
            for (int rr = 0; rr < 2; ++rr) { const float* xr = (const float*)(F.ws + WS_X) + (size_t)(rn + wave * 2 + rr) * DM;
#pragma unroll
                for (int j = 0; j < 4; ++j) va[rr][j] = *(const f32x4*)(xr + 4 * lane + 256 * j); }
            const float* m = MOD + ((size_t)ly * 5 + row_modsel(rn)) * 6144;
            __builtin_amdgcn_global_load_lds((const unsigned*)(m + 3072 + 4 * F.tid), (LAS unsigned*)((LAS unsigned char*)MODL + ((itn + 1) & 1) * 8192 + wave * 1024), 16, 0, 0); } }
        asm volatile("s_waitcnt lgkmcnt(0)" ::: "memory"); __builtin_amdgcn_s_barrier();
        { f32x4 acc[4];
#pragma unroll
          for (int nb = 0; nb < 4; ++nb) acc[nb] = (f32x4){0.f, 0.f, 0.f, 0.f};
          const LAS float* hp = HS + (lane & 15) * HSS + wave * 128 + (lane >> 4);
#pragma unroll
          for (int g = 0; g < 32; ++g) { const float a = hp[4 * g];
#pragma unroll
              for (int nb = 0; nb < 4; ++nb) acc[nb] = __builtin_amdgcn_mfma_f32_16x16x4f32(a, wreg[g][nb], acc[nb], 0, 0, 0); }
#pragma unroll
          for (int e = 0; e < 4; ++e) *(LAS f32x4*)(PART + (wave * 16 + (lane >> 4) * 4 + e) * 64 + 4 * (lane & 15)) = (f32x4){acc[0][e], acc[1][e], acc[2][e], acc[3][e]}; }
        asm volatile("s_waitcnt lgkmcnt(0)" ::: "memory"); __builtin_amdgcn_s_barrier();
        { const float rbl = rb[lane];
          float s[2], msel[2];
#pragma unroll
          for (int rr = 0; rr < 2; ++rr) { const int rl = wave * 2 + rr;
            float lg = 0.f;
#pragma unroll
            for (int w = 0; w < 8; ++w) lg += PART[(w * 16 + rl) * 64 + lane];
            s[rr] = 1.0f / (1.0f + expf(-lg));
            const float sel = s[rr] + rbl;
            const float m1 = group8_max(sel);
            const unsigned long long bal = __ballot(sel == m1);
            const int gbase = lane & ~7;
            const unsigned gmask = (unsigned)((bal >> gbase) & 0xffull);
            const int first = gbase + __builtin_ctz(gmask);
            const float m2 = group8_max((lane == first) ? -INFINITY : sel);
            const float gs = m1 + m2;
            const int mygrp = lane >> 3;
            int grank = 0;
#pragma unroll
            for (int g = 0; g < 8; ++g) { const float o = __builtin_bit_cast(float, __builtin_amdgcn_readlane(__builtin_bit_cast(int, gs), g * 8)); grank += (o > gs || (o == gs && g < mygrp)) ? 1 : 0; }
            msel[rr] = grank < 4 ? sel : -INFINITY; }
          int rank[2] = {64, 64};
          { float cur0 = msel[0], cur1 = msel[1];
#pragma unroll
            for (int it = 0; it < 8; ++it) { const float m0 = wave_max(cur0), m1 = wave_max(cur1);
                const int f0 = (int)__builtin_ctzll(__ballot(cur0 == m0)), f1 = (int)__builtin_ctzll(__ballot(cur1 == m1));
                if (lane == f0) { rank[0] = it; cur0 = -INFINITY; }
                if (lane == f1) { rank[1] = it; cur1 = -INFINITY; } } }
#pragma unroll
          for (int rr = 0; rr < 2; ++rr) { const int rl = wave * 2 + rr;
            const bool chosen = rank[rr] < 8;
            const float wsum = wave_sum(chosen ? s[rr] : 0.f);
            if (chosen) { const float gate = s[rr] / wsum * 2.5f;
                const int lp = __hip_atomic_fetch_add(LCNT + lane, 1, __ATOMIC_RELAXED, __HIP_MEMORY_SCOPE_WORKGROUP);
                GATE[(itn * 16 + rl) * 8 + rank[rr]] = gate;
                ASG[(itn * 16 + rl) * 8 + rank[rr]] = (lane << 20) | lp; } } }
        asm volatile("s_waitcnt vmcnt(0) lgkmcnt(0)" ::: "memory"); __builtin_amdgcn_s_barrier();
    }
    RP_END(19);
    RP_BEGIN(20);
    if (F.tid < 64) { const int n = LCNT[F.tid]; LBASE[F.tid] = n ? (int)atomicAdd(F.ctl + CW_CNT + (ly * 64 + F.tid) * CNT_STRIDE, (unsigned)n) : 0; }
    __syncthreads();
    for (int a = F.tid; a < itn * 128; a += NTHR) { const int it = a >> 7, rl = (a >> 3) & 15, slot = a & 7; const int row = F.bid * 16 + it * F.G * 16 + rl;
        const int v = ASG[a], e = v >> 20, lp = v & 0xfffff;
        ((float*)(F.ws + WS_TOPG))[(size_t)row * 8 + slot] = GATE[a];
        ((int*)(F.ws + WS_LIST))[(size_t)e * RTOT + LBASE[e] + lp] = row * 8 + slot;
        ((int*)(F.ws + WS_TOPE))[(size_t)row * 8 + slot] = (e << 20) | (LBASE[e] + lp); }
    __syncthreads();
    RP_END(20);
}

DI void bf8_fma(const u32x4 w, float g, float (&y)[8]) {
    y[0] += bflo(w.x) * g; y[1] += bfhi(w.x) * g; y[2] += bflo(w.y) * g; y[3] += bfhi(w.y) * g; y[4] += bflo(w.z) * g; y[5] += bfhi(w.z) * g; y[6] += bflo(w.w) * g; y[7] += bfhi(w.w) * g;
}
DI void phase_combine(const Frame& F, int ly) {
    const int gw = F.bid * 8 + F.wave, nw = F.G * 8, lane = F.lane;
    const bool last = ly == DEPTH - 1;
    const int nrows = last ? RLAT : RTOT;
    const float* MOD = (const float*)(F.ws + WS_MOD);
    const float* g2w = F.in[24] + (size_t)ly * DM; const float* b2w = F.in[25] + (size_t)ly * DM;
    const float* g1w = F.in[22] + (size_t)ly * DM; const float* b1w = F.in[23] + (size_t)ly * DM;
    const bf16_t* YB = (const bf16_t*)(F.ws + WS_YB);
    const MoeTab T = moe_tables(F, ly);
    for (int row = gw; row < nrows; row += nw) {
        const float* gates = (const float*)(F.ws + WS_TOPG) + (size_t)row * 8;
        const int* posr = (const int*)(F.ws + WS_TOPE) + (size_t)row * 8;
        u32x4 yr[9][2];
#pragma unroll
        for (int s9 = 0; s9 < 9; ++s9) { size_t yrow;
            if (s9 < 8) { const int v = posr[s9]; yrow = (size_t)T.tstart[v >> 20] * 256 + (v & 0xfffff); } else yrow = (size_t)T.tstart[NEXP] * 256 + row;
#pragma unroll
            for (int hf = 0; hf < 2; ++hf) yr[s9][hf] = __builtin_nontemporal_load((const u32x4*)(YB + yrow * DM + hf * 512 + 8 * lane)); }
        float* xr = (float*)(F.ws + WS_X) + (size_t)row * DM;
        f32x4 xv[4];
#pragma unroll
        for (int hf = 0; hf < 2; ++hf) { xv[2 * hf] = *(const f32x4*)(xr + hf * 512 + 8 * lane); xv[2 * hf + 1] = *(const f32x4*)(xr + hf * 512 + 8 * lane + 4); }
        float y[2][8];
#pragma unroll
        for (int hf = 0; hf < 2; ++hf) {
#pragma unroll
            for (int e = 0; e < 8; ++e) y[hf][e] = 0.f;
            bf8_fma(yr[8][hf], 1.0f, y[hf]);
#pragma unroll
            for (int s8 = 0; s8 < 8; ++s8) bf8_fma(yr[s8][hf], gates[s8], y[hf]); }
        const float* m = MOD + ((size_t)ly * 5 + row_modsel(row)) * 6144;
        float mu, rstd; ln_stats(xv, mu, rstd);
        f32x4 v[4];
#pragma unroll
        for (int q = 0; q < 4; ++q) { const int c = (q >> 1) * 512 + 8 * lane + (q & 1) * 4; const f32x4 g2 = *(const f32x4*)(m + 5120 + c), g1v = *(const f32x4*)(g1w + c), b1v = *(const f32x4*)(b1w + c);
#pragma unroll
            for (int e = 0; e < 4; ++e) { const float x1 = (xv[q][e] - mu) * rstd * g1v[e] + b1v[e]; v[q][e] = x1 * ALPHA + g2[e] * y[q >> 1][(q & 1) * 4 + e]; } }
        ln_stats(v, mu, rstd);
#pragma unroll
        for (int q = 0; q < 4; ++q) { const int c = (q >> 1) * 512 + 8 * lane + (q & 1) * 4; const f32x4 g = *(const f32x4*)(g2w + c), bb = *(const f32x4*)(b2w + c);
#pragma unroll
            for (int e = 0; e < 4; ++e) v[q][e] = (v[q][e] - mu) * rstd * g[e] + bb[e];
            if (last) *(f32x4*)(F.out + (size_t)row * DM + c) = v[q]; else *(f32x4*)(xr + c) = v[q]; }
        if (!last) { const float* mn = MOD + ((size_t)(ly + 1) * 5 + row_modsel(row)) * 6144;
            ln_stats(v, mu, rstd);
            bf16_t* hrow = (bf16_t*)(F.ws + WS_H) + (size_t)row * DM;
#pragma unroll
            for (int hf = 0; hf < 2; ++hf) { const int c = hf * 512 + 8 * lane; float o[8];
#pragma unroll
                for (int q = 0; q < 2; ++q) { const f32x4 sh = *(const f32x4*)(mn + c + 4 * q), sc = *(const f32x4*)(mn + 1024 + c + 4 * q);
#pragma unroll
                    for (int e = 0; e < 4; ++e) o[4 * q + e] = (v[2 * hf + q][e] - mu) * rstd * (1.f + sc[e]) + sh[e]; }
                u32x4 w; w.x = cvt_pk_bf16(o[0], o[1]); w.y = cvt_pk_bf16(o[2], o[3]); w.z = cvt_pk_bf16(o[4], o[5]); w.w = cvt_pk_bf16(o[6], o[7]);
                *(u32x4*)(hrow + c) = w; } }
    }
}

PHASE_FN void ph_pre0(const Frame& F0) { const Frame F = relaunder(F0); prep_small(F, 0); prep_mod(F); prep_filters(F); prep_tables(F); }
PHASE_FN void ph_pre1(const Frame& F0) { const Frame F = relaunder(F0); prep_invl1(F); phase_init_h(F); }
PHASE_FN void ph_win(const Frame& F0, int ly) { const Frame F = relaunder(F0);
    pg8::Gemm g{(const bf16_t*)(F.ws + WS_H), (const bf16_t*)(F.ws + WS_WIN), DM, F.tid};
    pg8::StaticOrder S; S.init(RTOT / 256, NWIN / 256, F.G, F.bid);
    EpiWin E{F.ws, ly};
    pg8::gemm_phase<EpiWin, pg8::StaticOrder>(F.lds, g, S, E);
}
constexpr int NSTREAM = 0;
PHASE_FN void ph_mix(const Frame& F0, int ly) { const Frame F = relaunder(F0);
    volatile LAS unsigned* MISC = (volatile LAS unsigned*)(F.lds + LDS_MISC);
    const bool last = ly == DEPTH - 1;
    if (!last) { pg8::Gemm g{(const bf16_t*)(F.ws + WS_DFTC), (const bf16_t*)(F.ws + WS_YTC), 2 * CTXL, F.tid};
      pg8::StaticOrder S; S.init(1, 4, F.G, (F.bid + F.G - 64) % F.G);
      EpiFnet E{F.ws, 1};
      pg8::gemm_phase<EpiFnet, pg8::StaticOrder>(F.lds, g, S, E); }
    __syncthreads();
    for (;;) {
        __syncthreads();
        if (F.tid == 0) MISC[16] = atomicAdd(F.ctl + CW_ATTN + 64 * ly, 1u);
        __syncthreads();
        const int uid = (int)MISC[16];
        if (uid >= 256 + 256 + (last ? 512 : 544)) break;
        const Frame Fu = relaunder(F);
        const int nat = last ? 512 : 544;
        if (uid < nat) { if (KIND(5)) { const float* lm = (const float*)(Fu.ws + WS_LAM) + 2 * ly; attn_unit(Fu, ly, uid, lm[0], 1.0f - lm[1]); } }
        else if (uid < nat + 256) { if (KIND(4)) { hyena_fft_unit(Fu, ly, uid - nat); if (!last) hyena_ctx_unit(Fu, ly, uid - nat); } }
        else if (KIND(3)) fnet_fft_unit(Fu, uid - 256 - nat);
    }
    prep_experts(F, ly, CW_PREPQ, 0, PREP_SPLIT);
}
PHASE_FN void ph_wout(const Frame& F0, int ly) { const Frame F = relaunder(F0);
    pg8::Gemm g{(const bf16_t*)(F.ws + WS_MIX), (const bf16_t*)(F.ws + WS_WOUT), DM, F.tid};
    pg8::StaticOrder S; S.init(ly == DEPTH - 1 ? RLAT / 256 : RTOT / 256, DM / 256, F.G, F.bid);
    EpiWout E{F.ws, ly, F.in[0], F.in[2]};
    pg8::gemm_phase<EpiWout, pg8::StaticOrder>(F.lds, g, S, E);
    __syncthreads();
    prep_experts(F, ly, CW_PREPQ2, PREP_SPLIT, PREP_SPLIT2);
}
PHASE_FN void ph_router(const Frame& F0, int ly) { const Frame F = relaunder(F0); phase_rows_router(F, ly); prep_experts(F, ly, CW_PREPQ4, PREP_SPLIT2, 3 * 1040); }
PHASE_FN void ph_moe1(const Frame& F0, int ly) { const Frame F = relaunder(F0);
    const MoeTab T = moe_tables(F, ly);
    pg8::Gemm g{(const bf16_t*)(F.ws + WS_H), (const bf16_t*)(F.ws + WS_WGU), DM, F.tid};
    MoeSched<true> S{T, (const int*)(F.ws + WS_LIST), F.G, F.bid, 2, 1};
    EpiMoe1 E{F.ws};
    pg8::gemm_phase<EpiMoe1, MoeSched<true>>(F.lds, g, S, E);
    __syncthreads();
    if (ly + 1 < DEPTH) prep_small_dyn(F, ly + 1);
}
PHASE_FN void ph_moe2(const Frame& F0, int ly) { const Frame F = relaunder(F0);
    const MoeTab T = moe_tables(F, ly);
    pg8::Gemm g{(const bf16_t*)(F.ws + WS_ACT), (const bf16_t*)(F.ws + WS_WD), DEXP, F.tid};
    MoeSched<false> S{T, (const int*)(F.ws + WS_LIST), F.G, F.bid, 4, 2};
    EpiMoe2 E{F.ws};
    pg8::gemm_phase<EpiMoe2, MoeSched<false>>(F.lds, g, S, E);
}
PHASE_FN void ph_combine(const Frame& F0, int ly) { const Frame F = relaunder(F0); phase_combine(F, ly); }

constexpr int PH_PER_LAYER = 7, N_PHASES = 2 + DEPTH * PH_PER_LAYER;

__global__ void __launch_bounds__(NTHR, 2) hybrid_fwd(Params prm) {
    extern __shared__ __attribute__((aligned(16))) unsigned char lds_raw[];
    Frame F;
    F.in = prm.in; F.out = prm.out; F.ws = prm.ws; F.lds = (LAS unsigned char*)lds_raw; F.ctl = (unsigned*)(prm.ws + WS_CTL);
    F.tid = threadIdx.x; F.lane = F.tid & 63; F.wave = __builtin_amdgcn_readfirstlane(F.tid >> 6); F.G = gridDim.x; F.bid = blockIdx.x;
    volatile LAS unsigned* MISC = (volatile LAS unsigned*)(F.lds + LDS_MISC);
    if (F.tid < 64) MISC[F.tid] = 0u;
    __syncthreads();
    const int lo = prm.ph_lo, hi = prm.ph_hi;
    XcdBarrier bar; bar.bar = F.ctl + CW_BAR; bar.x = 0; bar.st = nullptr;
    if (hi - lo > 1) bar = xcd_barrier_post(F.ctl + CW_BAR, MISC);
#define IN(k) (lo <= (k) && (k) < hi)
    unsigned long long pr_acc = 0ull, pr_t0 = 0ull;
#define SEAM(k) do { if (IN(k) && IN((k) + 1)) { unsigned long long _b0 = 0; if ((PROBE_KINDS >> 12) & 1) _b0 = __builtin_amdgcn_s_memrealtime(); xcd_barrier(bar); if ((PROBE_KINDS >> 12) & 1) pr_acc += __builtin_amdgcn_s_memrealtime() - _b0; } } while (0)
#define PR_BEGIN(kind) do { if ((PROBE_KINDS >> (kind)) & 1) pr_t0 = __builtin_amdgcn_s_memrealtime(); } while (0)
#define PR_END(kind) do { if ((PROBE_KINDS >> (kind)) & 1) pr_acc += __builtin_amdgcn_s_memrealtime() - pr_t0; } while (0)

    PR_BEGIN(0); if (IN(0) && KIND(0)) { const Frame Fp = relaunder(F); PR_BEGIN(13); prep_small(Fp, 0); PR_END(13); PR_BEGIN(14); prep_mod(Fp); PR_END(14); PR_BEGIN(15); prep_filters(Fp); PR_END(15); PR_BEGIN(16); prep_tables(Fp); PR_END(16); }
    PR_END(0); SEAM(0);
    PR_BEGIN(1); if (IN(1) && KIND(1)) ph_pre1(F);
    PR_END(1); SEAM(1);

    for (int ly = 0; ly < DEPTH; ++ly) {
        const int p0 = 2 + ly * PH_PER_LAYER;
        PR_BEGIN(2); if (IN(p0) && KIND(2)) ph_win(F, ly);
        PR_END(2); SEAM(p0);
        if (IN(p0 + 1)) { PR_BEGIN(5); ph_mix(F, ly); }
        PR_END(5); SEAM(p0 + 1);
        PR_BEGIN(6); if (IN(p0 + 2) && KIND(6)) ph_wout(F, ly);
        PR_END(6); SEAM(p0 + 2);
        PR_BEGIN(7); if (IN(p0 + 3) && KIND(7)) ph_router(F, ly);
        PR_END(7); SEAM(p0 + 3);
        PR_BEGIN(8); if (IN(p0 + 4) && KIND(8)) ph_moe1(F, ly);
        PR_END(8); SEAM(p0 + 4);
        PR_BEGIN(9); if (IN(p0 + 5) && KIND(9)) ph_moe2(F, ly);
        PR_END(9); SEAM(p0 + 5);
        PR_BEGIN(10); if (IN(p0 + 6) && KIND(10)) { const Frame Fc = relaunder(F); PR_BEGIN(17); phase_combine(Fc, ly); PR_END(17);  }
        PR_END(10); SEAM(p0 + 6);
    }
    if (PROBE_KINDS != 0 && blockIdx.x == 0) {
        __syncthreads(); pr_acc += *(volatile LAS unsigned long long*)(F.lds + LDS_MISC + 128);
        const unsigned long long t0 = __builtin_amdgcn_s_memrealtime(), wait = pr_acc * (unsigned long long)PROBE_AMP;
        while (__builtin_amdgcn_s_memrealtime() - t0 < wait) __builtin_amdgcn_s_sleep(8);
    }
#undef IN
#undef SEAM
}

extern "C" void kernel_launch(void* const* d_in, const int* in_sizes, int n_in, void* d_out, int out_size, void* d_ws, size_t ws_size, hipStream_t stream) {
    static int grid = 0;
    if (grid == 0) {
        if (n_in != 34 || out_size != RLAT * DM || ws_size < WS_END) { fprintf(stderr, "kernel_launch: unexpected problem shape (n_in %d out %d ws %zu need %zu)\n", n_in, out_size, ws_size, (size_t)WS_END); grid = -1; return; }
        int dev = 0, cus = 0, per_cu = 0;
        if (hipGetDevice(&dev) != hipSuccess || hipDeviceGetAttribute(&cus, hipDeviceAttributeMultiprocessorCount, dev) != hipSuccess) { grid = -1; return; }
        if (hipFuncSetAttribute((const void*)hybrid_fwd, hipFuncAttributeMaxDynamicSharedMemorySize, LDS_BYTES) != hipSuccess) { fprintf(stderr, "kernel_launch: hipFuncSetAttribute failed\n"); grid = -1; return; }
        if (hipOccupancyMaxActiveBlocksPerMultiprocessor(&per_cu, (const void*)hybrid_fwd, NTHR, LDS_BYTES) != hipSuccess || per_cu < 1)
            fprintf(stderr, "kernel_launch: occupancy query reports %d workgroups per CU\n", per_cu);
        (void)hipGetLastError();
        grid = cus;
    }
    if (grid < 0) return;
    (void)hipMemsetAsync((char*)d_ws + WS_CTL, 0, CTL_BYTES, stream);
    Params p{};
    for (int i = 0; i < 34; ++i) p.in[i] = (const float*)d_in[i];
    p.out = (float*)d_out; p.ws = (unsigned char*)d_ws;
#if MK_PER_PHASE
    for (int ph = 0; ph < N_PHASES; ++ph) { p.ph_lo = ph; p.ph_hi = ph + 1; hipLaunchKernelGGL(hybrid_fwd, dim3(grid), dim3(NTHR), LDS_BYTES, stream, p); }
#else
    p.ph_lo = 0; p.ph_hi = N_PHASES;
    hipLaunchKernelGGL(hybrid_fwd, dim3(grid), dim3(NTHR), LDS_BYTES, stream, p);
#endif
}
```
